# Optimizing an MI355X kernel written in HIP

```python
import jax, jax.numpy as jnp
from jax import lax
import numpy as np

D_MODEL = 1024
BATCH = 32
SEQ = 256
DEPTH = 4
DEC_BATCH = 4
DEC_SEQ = 4096
PAST_LEN = 256

GRID_W = 64
N_MIXERS = 3
D_INNER = D_MODEL
RMS_EPS = 1e-6
RWKV_HEAD = 64
RWKV_HEADS = D_INNER // RWKV_HEAD
DECAY_LORA = 64
ICL_LORA = 64
GN_EPS = 64e-5
HEAD_DIM = 64
N_HEADS = D_INNER // HEAD_DIM
KV_HEADS = 4
Q_PER_KV = N_HEADS // KV_HEADS
ROPE_FREQS = HEAD_DIM // 4
ROPE_BASE = 10000.0
Q_BLOCK = 128
ATTN_IN_COLS = (N_HEADS + 2 * KV_HEADS) * HEAD_DIM + D_INNER
CONV_W = 3
N_LAYERS_A = (DEPTH + 2) // 3
N_LAYERS_B = (DEPTH + 1) // 3
N_LAYERS_C = DEPTH // 3

kernel_name = 'hybrid_rwkv7_gqa_shortconv_diffusion_step'


def rmsnorm(x, w):
    x32 = x.astype(jnp.float32)
    y = x32 * lax.rsqrt(jnp.mean(x32 * x32, axis=-1, keepdims=True) + RMS_EPS)
    return (y * w.astype(jnp.float32)).astype(x.dtype)


def neighbours(x):
    z = jnp.zeros_like(x[:, :1])
    prev = jnp.concatenate([z, x[:, :-1]], axis=1)
    nxt = jnp.concatenate([x[:, 1:], z], axis=1)
    return prev, nxt


def axial_rope_tables(rows):
    row = jnp.repeat(jnp.arange(rows), GRID_W)
    col = jnp.tile(jnp.arange(GRID_W), rows)
    inv = ROPE_BASE ** (-jnp.arange(ROPE_FREQS, dtype=jnp.float32) / ROPE_FREQS)
    ang = jnp.stack([row, col], axis=-1).astype(jnp.float32)[:, :, None] * inv
    return jnp.cos(ang), jnp.sin(ang)


def rope2d(x, cos, sin):
    xa = x.astype(jnp.float32).reshape(x.shape[:-1] + (2, 2, ROPE_FREQS))
    x1, x2 = xa[..., 0, :], xa[..., 1, :]
    c, s = cos[:, None], sin[:, None]
    out = jnp.stack([x1 * c - x2 * s, x2 * c + x1 * s], axis=-2)
    return out.reshape(x.shape).astype(x.dtype)


def block_attention(q, k, v):
    b, s = q.shape[:2]
    nb = s // Q_BLOCK
    qb = q.reshape(b, nb, Q_BLOCK, KV_HEADS, Q_PER_KV, HEAD_DIM).swapaxes(0, 1)
    scale = HEAD_DIM ** -0.5

    def one_block(qi):
        sc = jnp.einsum('bqkgd,btkd->bkgqt', qi, k).astype(jnp.float32) * scale
        pr = jax.nn.softmax(sc, axis=-1).astype(v.dtype)
        return jnp.einsum('bkgqt,btkd->bqkgd', pr, v)

    o = lax.map(one_block, qb)
    return o.swapaxes(0, 1).reshape(b, s, N_HEADS * HEAD_DIM)


def bidir_delta_scan(r, w, k, v, kk, a, s0):
    def orient(t):
        return jnp.concatenate([t[:, :, :1], jnp.flip(t[:, :, 1:], axis=1)], axis=2)

    xs = tuple(jnp.moveaxis(orient(t), 1, 0) for t in (r, w, k, v, kk, a))

    def step(S, inp):
        r_t, w_t, k_t, v_t, kk_t, a_t = inp
        sa = jnp.einsum('bdhvk,bdhk->bdhv', S, -kk_t)
        S = (S * w_t[..., None, :] + sa[..., None] * (kk_t * a_t)[..., None, :]
             + v_t[..., None] * k_t[..., None, :])
        return S, jnp.einsum('bdhvk,bdhk->bdhv', S, r_t)

    s_final, ys = lax.scan(step, s0, xs)
    return orient(jnp.moveaxis(ys, 0, 1)), s_final


def rwkv_mixer(h, p, j, s0):
    b, s, _ = h.shape
    prev, nxt = neighbours(h)
    xx = 0.5 * (prev + nxt) - h
    xs = h[:, :, None, :] + xx[:, :, None, :] * p['rwkv_mu'][j]
    rkvg = jnp.einsum('bsmd,mde->bsme', xs[:, :, :4], p['rwkv_w_in'][j])
    r, k, v, g = rkvg[:, :, 0], rkvg[:, :, 1], rkvg[:, :, 2], rkvg[:, :, 3]
    xw, xa = xs[:, :, 4], xs[:, :, 5]
    lw = p['rwkv_decay0'][j] + jnp.einsum(
        'bszr,zre->bsze', jnp.tanh(jnp.einsum('bsd,zdr->bszr', xw, p['rwkv_decay1'][j])), p['rwkv_decay2'][j])
    decay = jnp.exp(-jnp.exp(-jax.nn.softplus(-lw.astype(jnp.float32)) - 0.5))
    icl = jax.nn.sigmoid((p['rwkv_icl0'][j] + jnp.einsum(
        'bszr,zre->bsze', jnp.einsum('bsd,zdr->bszr', xa, p['rwkv_icl1'][j]), p['rwkv_icl2'][j])).astype(jnp.float32))

    def heads(t):
        return t.reshape(t.shape[:-1] + (RWKV_HEADS, RWKV_HEAD)).astype(jnp.float32)

    kk = heads(k * p['rwkv_k_k'][j])
    kk = kk / jnp.maximum(jnp.sqrt(jnp.sum(kk * kk, axis=-1, keepdims=True)), 1e-12)
    k_dir = k[:, :, None].astype(jnp.float32) * (1.0 + (icl - 1.0) * p['rwkv_k_a'][j].astype(jnp.float32))
    r_h, v_h, k_h, w_h, a_h = heads(r), heads(v), heads(k_dir), heads(decay), heads(icl)

    def two(t):
        return jnp.broadcast_to(t[:, :, None], (b, s, 2) + t.shape[2:])

    y, s_final = bidir_delta_scan(two(r_h), w_h, k_h, two(v_h), two(kk), a_h, s0)
    y = y.sum(axis=2)
    mu = jnp.mean(y, axis=-1, keepdims=True)
    var = jnp.mean(jnp.square(y - mu), axis=-1, keepdims=True)
    y = ((y - mu) * lax.rsqrt(var + GN_EPS)).reshape(b, s, D_INNER)
    y = y * p['rwkv_gn_w'][j].astype(jnp.float32) + p['rwkv_gn_b'][j].astype(jnp.float32)
    bonus = (jnp.sum(r_h[:, :, None] * k_h * p['rwkv_r_k'][j].astype(jnp.float32), axis=-1, keepdims=True)
             * v_h[:, :, None]).sum(axis=2).reshape(b, s, D_INNER)
    out = ((y + bonus) * jax.nn.silu(g.astype(jnp.float32))).astype(h.dtype)
    return out @ p['rwkv_w_out'][j], s_final.astype(h.dtype)


def attn_qkvg(h, p, j):
    b, s, _ = h.shape
    nq, nk = N_HEADS * HEAD_DIM, KV_HEADS * HEAD_DIM
    proj = h @ p['attn_w_in'][j]
    q = rmsnorm(proj[..., :nq].reshape(b, s, N_HEADS, HEAD_DIM), p['attn_q_norm'][j])
    k = rmsnorm(proj[..., nq:nq + nk].reshape(b, s, KV_HEADS, HEAD_DIM), p['attn_k_norm'][j])
    v = proj[..., nq + nk:nq + 2 * nk].reshape(b, s, KV_HEADS, HEAD_DIM)
    g = proj[..., nq + 2 * nk:]
    return q, k, v, g


def attn_context(h, p, j):
    q, k, v, g = attn_qkvg(h, p, j)
    o = block_attention(q, k, v)
    return (o * jax.nn.silu(g)) @ p['attn_w_out'][j], (k, v)


def attn_latent(h, p, j, k_ctx, v_ctx, cos, sin):
    q, k, v, g = attn_qkvg(h, p, j)
    q, k = rope2d(q, cos, sin), rope2d(k, cos, sin)
    k_all = jnp.concatenate([k, k_ctx.astype(k.dtype)], axis=1)
    v_all = jnp.concatenate([v, v_ctx.astype(v.dtype)], axis=1)
    o = block_attention(q, k_all, v_all)
    return (o * jax.nn.silu(g)) @ p['attn_w_out'][j]


def conv_mixer(h, p, j):
    proj = h @ p['conv_w_in'][j]
    bg, cg, u, g = jnp.split(proj, 4, axis=-1)
    u = cg * u
    prev, nxt = neighbours(u)
    w = p['conv_w'][j]
    u = prev * w[0] + u * w[1] + nxt * w[2] + p['conv_b'][j]
    return (bg * u * jax.nn.silu(g)) @ p['conv_w_out'][j]


def sublayer(x, cond, p, i, mixer_fn):
    ada = jax.nn.silu(cond) @ p['w_ada'][i] + p['b_ada'][i]
    shift, scale, gate = jnp.split(ada[:, None, :], 3, axis=-1)
    h = rmsnorm(x, p['norm_pre'][i]) * (1.0 + scale) + shift
    m, extra = mixer_fn(h)
    return x + gate * rmsnorm(m, p['norm_post'][i]), extra


def setup_inputs(seed: int = 0) -> dict:
    key = jax.random.key(seed)
    ks = iter(jax.random.split(key, 64))
    D, E = D_MODEL, D_INNER

    def nrm(shape, scale):
        return jax.random.normal(next(ks), shape, jnp.float32) * scale

    def uni(shape):
        return jax.random.uniform(next(ks), shape, jnp.float32)

    return {
        'x_prompt': nrm((BATCH, SEQ, D), 1.0),
        'x_sample': nrm((DEC_BATCH, DEC_SEQ, D), 1.0),
        'state_rwkv': nrm((DEC_BATCH, N_LAYERS_A, 2, RWKV_HEADS, RWKV_HEAD, RWKV_HEAD), 0.3),
        'cache_k': nrm((DEC_BATCH, N_LAYERS_B, PAST_LEN, KV_HEADS, HEAD_DIM), 1.0),
        'cache_v': nrm((DEC_BATCH, N_LAYERS_B, PAST_LEN, KV_HEADS, HEAD_DIM), 1.0),
        'c': nrm((DEC_BATCH, D), 1.0),
        'c_ctx': nrm((D,), 1.0),
        'norm_pre': 1.0 + nrm((DEPTH, D), 0.02),
        'norm_post': 1.0 + nrm((DEPTH, D), 0.02),
        'w_ada': nrm((DEPTH, D, 3 * D), 0.5 * D ** -0.5),
        'b_ada': nrm((DEPTH, 3 * D), 0.02),
        'rwkv_mu': uni((N_LAYERS_A, 6, D)),
        'rwkv_w_in': nrm((N_LAYERS_A, 4, D, E), D ** -0.5),
        'rwkv_decay0': nrm((N_LAYERS_A, 2, E), 0.5),
        'rwkv_decay1': nrm((N_LAYERS_A, 2, D, DECAY_LORA), D ** -0.5),
        'rwkv_decay2': nrm((N_LAYERS_A, 2, DECAY_LORA, E), 0.3 * DECAY_LORA ** -0.5),
        'rwkv_icl0': nrm((N_LAYERS_A, 2, E), 0.5),
        'rwkv_icl1': nrm((N_LAYERS_A, 2, D, ICL_LORA), D ** -0.5),
        'rwkv_icl2': nrm((N_LAYERS_A, 2, ICL_LORA, E), 0.3 * ICL_LORA ** -0.5),
        'rwkv_k_k': 0.85 + nrm((N_LAYERS_A, E), 0.02),
        'rwkv_k_a': 1.0 + nrm((N_LAYERS_A, E), 0.02),
        'rwkv_r_k': nrm((N_LAYERS_A, RWKV_HEADS, RWKV_HEAD), 0.1),
        'rwkv_gn_w': 1.0 + nrm((N_LAYERS_A, E), 0.02),
        'rwkv_gn_b': nrm((N_LAYERS_A, E), 0.02),
        'rwkv_w_out': nrm((N_LAYERS_A, E, D), E ** -0.5),
        'attn_w_in': nrm((N_LAYERS_B, D, ATTN_IN_COLS), D ** -0.5),
        'attn_q_norm': 1.0 + nrm((N_LAYERS_B, HEAD_DIM), 0.02),
        'attn_k_norm': 1.0 + nrm((N_LAYERS_B, HEAD_DIM), 0.02),
        'attn_w_out': nrm((N_LAYERS_B, E, D), E ** -0.5),
        'conv_w_in': nrm((N_LAYERS_C, D, 4 * E), D ** -0.5),
        'conv_w': nrm((N_LAYERS_C, CONV_W, E), CONV_W ** -0.5),
        'conv_b': nrm((N_LAYERS_C, E), 0.02),
        'conv_w_out': nrm((N_LAYERS_C, E, D), E ** -0.5),
    }


def reference(x_prompt, x_sample, state_rwkv, cache_k, cache_v, c, c_ctx,
              norm_pre, norm_post, w_ada, b_ada,
              rwkv_mu, rwkv_w_in, rwkv_decay0, rwkv_decay1, rwkv_decay2,
              rwkv_icl0, rwkv_icl1, rwkv_icl2, rwkv_k_k, rwkv_k_a, rwkv_r_k,
              rwkv_gn_w, rwkv_gn_b, rwkv_w_out,
              attn_w_in, attn_q_norm, attn_k_norm, attn_w_out,
              conv_w_in, conv_w, conv_b, conv_w_out):
    p = dict(norm_pre=norm_pre, norm_post=norm_post, w_ada=w_ada, b_ada=b_ada,
             rwkv_mu=rwkv_mu, rwkv_w_in=rwkv_w_in, rwkv_decay0=rwkv_decay0,
             rwkv_decay1=rwkv_decay1, rwkv_decay2=rwkv_decay2, rwkv_icl0=rwkv_icl0,
             rwkv_icl1=rwkv_icl1, rwkv_icl2=rwkv_icl2, rwkv_k_k=rwkv_k_k, rwkv_k_a=rwkv_k_a,
             rwkv_r_k=rwkv_r_k, rwkv_gn_w=rwkv_gn_w, rwkv_gn_b=rwkv_gn_b, rwkv_w_out=rwkv_w_out,
             attn_w_in=attn_w_in, attn_q_norm=attn_q_norm, attn_k_norm=attn_k_norm,
             attn_w_out=attn_w_out, conv_w_in=conv_w_in, conv_w=conv_w, conv_b=conv_b,
             conv_w_out=conv_w_out)

    x = x_prompt
    cond_ctx = c_ctx[None, :]
    new_s, new_k, new_v = [], [], []
    for i in range(DEPTH):
        j, kind = i // N_MIXERS, i % N_MIXERS
        if kind == 0:
            s0 = jnp.zeros((x.shape[0], 2, RWKV_HEADS, RWKV_HEAD, RWKV_HEAD), jnp.float32)
            x, st = sublayer(x, cond_ctx, p, i, lambda h: rwkv_mixer(h, p, j, s0))
            new_s.append(st)
        elif kind == 1:
            x, kv = sublayer(x, cond_ctx, p, i, lambda h: attn_context(h, p, j))
            new_k.append(kv[0])
            new_v.append(kv[1])
        else:
            x, _ = sublayer(x, cond_ctx, p, i, lambda h: (conv_mixer(h, p, j), None))
    y_prompt = x

    rows = x_sample.shape[1] // GRID_W
    cos, sin = axial_rope_tables(rows)
    x = x_sample
    for i in range(DEPTH):
        j, kind = i // N_MIXERS, i % N_MIXERS
        if kind == 0:
            s0 = state_rwkv[:, j].astype(jnp.float32)
            x, _ = sublayer(x, c, p, i, lambda h: rwkv_mixer(h, p, j, s0))
        elif kind == 1:
            x, _ = sublayer(x, c, p, i, lambda h: (attn_latent(h, p, j, cache_k[:, j], cache_v[:, j], cos, sin), None))
        else:
            x, _ = sublayer(x, c, p, i, lambda h: (conv_mixer(h, p, j), None))
    y_sample = x

    return (y_prompt, y_sample, jnp.stack(new_s, axis=1), jnp.stack(new_k, axis=1), jnp.stack(new_v, axis=1))
```

```cpp
#include <hip/hip_runtime.h>
#include <hip/hip_cooperative_groups.h>
#include <cstdio>
namespace cg = cooperative_groups;

typedef unsigned short bf16_t;
using bf16x8 = __attribute__((ext_vector_type(8))) short;
using f32x16 = __attribute__((ext_vector_type(16))) float;
using u32x4 = __attribute__((ext_vector_type(4))) unsigned;
using u32x2 = __attribute__((ext_vector_type(2))) unsigned;

#define NT 512
#define DI __device__ __forceinline__
#define MFMA32(a, b, c) __builtin_amdgcn_mfma_f32_32x32x16_bf16((a), (b), (c), 0, 0, 0)

struct P { const float* in[33]; float* out; unsigned char* ws; };

constexpr size_t WS_ADA = 0;
constexpr size_t WS_ROPE = 262144;
constexpr size_t WS_BON = 327680;
constexpr size_t WS_HID = WS_BON + 2097152;
constexpr size_t WS_W = WS_HID + 8388608;
constexpr size_t WS_SLOT = WS_W + 39845888;
constexpr size_t SLOT_ELEMS = (size_t)16384 * 1024;
constexpr int RW_IN0 = 0, RW_OUT0 = 4352, RW_STRIDE = 5376, AT_IN = 10752, AT_OUT = 13312, CV_IN = 14336, CV_OUT = 18432;
constexpr size_t OUT_YP = 0, OUT_YS = 8388608, OUT_ST = 25165824, OUT_CK = 33554432, OUT_CV = 35651584;
constexpr int LDS_BYTES = 135168;

DI unsigned f2bf(float x) { unsigned u = __float_as_uint(x); u += 0x7fffu + ((u >> 16) & 1u); return u >> 16; }
DI unsigned pack2(float a, float b) { return f2bf(a) | (f2bf(b) << 16); }
DI float bflo(unsigned u) { return __uint_as_float(u << 16); }
DI float bfhi(unsigned u) { return __uint_as_float(u & 0xffff0000u); }
DI float bf1(bf16_t u) { return __uint_as_float(((unsigned)u) << 16); }
DI float wave_sum(float v) { for (int o = 32; o > 0; o >>= 1) v += __shfl_xor(v, o); return v; }
template <int CTRL> DI float dppf(float v) { return __int_as_float(__builtin_amdgcn_update_dpp(0, __float_as_int(v), CTRL, 0xF, 0xF, true)); }
DI float reduce16(float v) { v += dppf<0xB1>(v); v += dppf<0x4E>(v); v += dppf<0x141>(v); v += dppf<0x140>(v); return v; }
DI float quad_sum(float v) { v += dppf<0xB1>(v); v += dppf<0x4E>(v); return v; }
DI float silu(float x) { return x / (1.f + __expf(-x)); }
DI int otid() { int t = threadIdx.x; asm volatile("" : "+v"(t)); return t; }

DI void conv_tiles(const float* __restrict__ src, int N, bf16_t* __restrict__ dst, float* lds) {
  const int tid = otid();
  const int tilesN = N >> 6, ntiles = 16 * tilesN;
  for (int tile = blockIdx.x; tile < ntiles; tile += gridDim.x) {
    const int kt = tile / tilesN, nt = tile - kt * tilesN, k0 = kt * 64, n0 = nt * 64;
#pragma unroll
    for (int i = 0; i < 8; ++i) { const int k = (tid >> 6) + 8 * i, n = tid & 63; lds[k * 65 + n] = src[(size_t)(k0 + k) * N + n0 + n]; }
    __syncthreads();
    { const int n = tid >> 3, kc = (tid & 7) * 8; u32x4 o;
#pragma unroll
      for (int j = 0; j < 4; ++j) o[j] = pack2(lds[(kc + 2 * j) * 65 + n], lds[(kc + 2 * j + 1) * 65 + n]);
      *(u32x4*)(dst + (size_t)(n0 + n) * 1024 + k0 + kc) = o; }
    __syncthreads();
  }
}

DI void phase0(const P& p, unsigned char* ldsb) {
  float* lds = (float*)ldsb;
  const int tid = otid();
  bf16_t* W = (bf16_t*)(p.ws + WS_W);
  for (int j = 0; j < 2; ++j) {
    for (int m = 0; m < 4; ++m) conv_tiles(p.in[12] + (size_t)(j * 4 + m) * 1048576, 1024, W + (size_t)(RW_IN0 + j * RW_STRIDE + m * 1024) * 1024, lds);
    for (int z = 0; z < 2; ++z) conv_tiles(p.in[14] + (size_t)(j * 2 + z) * 65536, 64, W + (size_t)(RW_IN0 + j * RW_STRIDE + 4096 + z * 64) * 1024, lds);
    for (int z = 0; z < 2; ++z) conv_tiles(p.in[17] + (size_t)(j * 2 + z) * 65536, 64, W + (size_t)(RW_IN0 + j * RW_STRIDE + 4224 + z * 64) * 1024, lds);
    conv_tiles(p.in[24] + (size_t)j * 1048576, 1024, W + (size_t)(RW_OUT0 + j * RW_STRIDE) * 1024, lds);
  }
  conv_tiles(p.in[25], 2560, W + (size_t)AT_IN * 1024, lds);
  conv_tiles(p.in[28], 1024, W + (size_t)AT_OUT * 1024, lds);
  conv_tiles(p.in[29], 4096, W + (size_t)CV_IN * 1024, lds);
  conv_tiles(p.in[32], 1024, W + (size_t)CV_OUT * 1024, lds);
  {
    float* scond = lds;
    float* red = lds + 5120;
    for (int e = tid; e < 5120; e += NT) { const int cnd = e >> 10, k = e & 1023; const float cv = cnd == 0 ? p.in[6][k] : p.in[5][(cnd - 1) * 1024 + k]; scond[e] = silu(cv); }
    __syncthreads();
    float* ada = (float*)(p.ws + WS_ADA);
    for (int task = blockIdx.x; task < 192; task += gridDim.x) {
      const int layer = task / 48, n0 = (task % 48) * 64, c = tid & 63, kg = tid >> 6;
      float a0 = 0.f, a1 = 0.f, a2 = 0.f, a3 = 0.f, a4 = 0.f;
      const float* wp = p.in[9] + ((size_t)layer * 1024 + kg * 128) * 3072 + n0 + c;
#pragma unroll 8
      for (int k = 0; k < 128; ++k) { const float w = wp[(size_t)k * 3072]; const int kk = kg * 128 + k;
        a0 += scond[kk] * w; a1 += scond[1024 + kk] * w; a2 += scond[2048 + kk] * w; a3 += scond[3072 + kk] * w; a4 += scond[4096 + kk] * w; }
      red[(kg * 5 + 0) * 64 + c] = a0; red[(kg * 5 + 1) * 64 + c] = a1; red[(kg * 5 + 2) * 64 + c] = a2; red[(kg * 5 + 3) * 64 + c] = a3; red[(kg * 5 + 4) * 64 + c] = a4;
      __syncthreads();
      if (tid < 320) { const int cnd = tid >> 6; float s = p.in[10][layer * 3072 + n0 + c];
#pragma unroll
        for (int q = 0; q < 8; ++q) s += red[(q * 5 + cnd) * 64 + c];
        ada[(cnd * 4 + layer) * 3072 + n0 + c] = s; }
      __syncthreads();
    }
  }
  if (blockIdx.x == gridDim.x - 1) {
    float* rope = (float*)(p.ws + WS_ROPE);
    for (int e = tid; e < 1024; e += NT) {
      const int pos = e >> 4, f = e & 15;
      double inv = 1.0; for (int q = 0; q < f; ++q) inv *= 0.5623413251903491;
      double ang = (double)pos * inv;
      const double twopi = 6.283185307179586476925286766559;
      double n = __builtin_rint(ang / twopi); double rr = ang - n * twopi;
      double r2 = rr * rr, sn = 0.0, cs = 0.0, ts = rr, tc = 1.0;
      for (int q = 0; q < 16; ++q) { cs += tc; sn += ts; tc = -tc * r2 / (double)((2 * q + 1) * (2 * q + 2)); ts = -ts * r2 / (double)((2 * q + 2) * (2 * q + 3)); }
      rope[e * 2] = (float)cs; rope[e * 2 + 1] = (float)sn;
    }
  }
}

DI void phase_norm(const P& p, int g, int lpost, int lpre, const float* __restrict__ xsrc, float* __restrict__ xdst,
                   const bf16_t* __restrict__ Mb, bf16_t* __restrict__ H) {
  const int T = g ? 16384 : 8192;
  const int tid = otid(); const int lane = tid & 63, wave = tid >> 6;
  const float* ada = (const float*)(p.ws + WS_ADA);
  for (int t = blockIdx.x * 8 + wave; t < T; t += gridDim.x * 8) {
    const int cond = g ? 1 + (t >> 12) : 0;
    float4 x[4];
#pragma unroll
    for (int i = 0; i < 4; ++i) x[i] = *(const float4*)(xsrc + (size_t)t * 1024 + 256 * i + 4 * lane);
    if (lpost >= 0) {
      float m[16]; float ss = 0.f;
#pragma unroll
      for (int i = 0; i < 4; ++i) { const u32x2 u = *(const u32x2*)(Mb + (size_t)t * 1024 + 256 * i + 4 * lane);
        m[4 * i] = bflo(u[0]); m[4 * i + 1] = bfhi(u[0]); m[4 * i + 2] = bflo(u[1]); m[4 * i + 3] = bfhi(u[1]); }
#pragma unroll
      for (int i = 0; i < 16; ++i) ss += m[i] * m[i];
      ss = wave_sum(ss);
      const float rs = rsqrtf(ss * (1.f / 1024.f) + 1e-6f);
      const float* gate = ada + (cond * 4 + lpost) * 3072 + 2048;
      const float* wpo = p.in[8] + lpost * 1024;
#pragma unroll
      for (int i = 0; i < 4; ++i) { const int c = 256 * i + 4 * lane; const float4 gt = *(const float4*)(gate + c); const float4 wv = *(const float4*)(wpo + c);
        x[i].x += gt.x * (m[4 * i] * rs * wv.x); x[i].y += gt.y * (m[4 * i + 1] * rs * wv.y); x[i].z += gt.z * (m[4 * i + 2] * rs * wv.z); x[i].w += gt.w * (m[4 * i + 3] * rs * wv.w);
        *(float4*)(xdst + (size_t)t * 1024 + c) = x[i]; }
    }
    if (lpre >= 0) {
      float ss = 0.f;
#pragma unroll
      for (int i = 0; i < 4; ++i) ss += x[i].x * x[i].x + x[i].y * x[i].y + x[i].z * x[i].z + x[i].w * x[i].w;
      ss = wave_sum(ss);
      const float rs = rsqrtf(ss * (1.f / 1024.f) + 1e-6f);
      const float* sh = ada + (cond * 4 + lpre) * 3072; const float* sc = sh + 1024; const float* wpr = p.in[7] + lpre * 1024;
#pragma unroll
      for (int i = 0; i < 4; ++i) { const int c = 256 * i + 4 * lane; const float4 s4 = *(const float4*)(sh + c); const float4 c4 = *(const float4*)(sc + c); const float4 wv = *(const float4*)(wpr + c);
        u32x2 o; o[0] = pack2(x[i].x * rs * wv.x * (1.f + c4.x) + s4.x, x[i].y * rs * wv.y * (1.f + c4.y) + s4.y);
        o[1] = pack2(x[i].z * rs * wv.z * (1.f + c4.z) + s4.z, x[i].w * rs * wv.w * (1.f + c4.w) + s4.w);
        *(u32x2*)(H + (size_t)t * 1024 + c) = o; }
    }
  }
}

DI void phase_cache_copy(const P& p) {
  bf16_t* Kb = (bf16_t*)(p.ws + WS_SLOT) + 4 * SLOT_ELEMS; bf16_t* Vt = Kb + SLOT_ELEMS / 2;
  for (int e = blockIdx.x * NT + otid(); e < 262144; e += gridDim.x * NT) {
    const int c = e & 255, pp = (e >> 8) & 255, b = e >> 16; const int kvh = c >> 6, d = c & 63;
    Kb[((size_t)b * 4352 + 4096 + pp) * 256 + c] = (bf16_t)f2bf(p.in[3][e]);
    Vt[((size_t)(b * 4 + kvh) * 64 + d) * 4352 + 4096 + pp] = (bf16_t)f2bf(p.in[4][e]);
  }
}

template <int SHIFT> DI void ld_half(const bf16_t* __restrict__ A, int t, int k, int Lmask, u32x4 (&raw)[4]) {
  raw[1] = *(const u32x4*)(A + (size_t)t * 1024 + k);
  raw[2] = *(const u32x4*)(A + (size_t)(t + 1) * 1024 + k);
  if (SHIFT) {
    raw[0] = (u32x4){0u, 0u, 0u, 0u}; raw[3] = (u32x4){0u, 0u, 0u, 0u};
    if ((t & Lmask) != 0) raw[0] = *(const u32x4*)(A + (size_t)(t - 1) * 1024 + k);
    if (((t + 1) & Lmask) != Lmask) raw[3] = *(const u32x4*)(A + (size_t)(t + 2) * 1024 + k);
  }
}
DI u32x4 mix3(const u32x4& c, const u32x4& pz, const u32x4& nz, const float* smu, int k) {
  const float4 m0 = *(const float4*)(smu + k), m1 = *(const float4*)(smu + k + 4);
  const float mu[8] = {m0.x, m0.y, m0.z, m0.w, m1.x, m1.y, m1.z, m1.w};
  u32x4 o;
#pragma unroll
  for (int i = 0; i < 4; ++i) {
    const float h0 = bflo(c[i]), h1 = bfhi(c[i]);
    const float x0 = h0 + (0.5f * (bflo(pz[i]) + bflo(nz[i])) - h0) * mu[2 * i];
    const float x1 = h1 + (0.5f * (bfhi(pz[i]) + bfhi(nz[i])) - h1) * mu[2 * i + 1];
    o[i] = pack2(x0, x1);
  }
  return o;
}
template <int SHIFT> DI void st_half(unsigned char* dst, const u32x4 (&raw)[4], const float* smu, int k) {
  if (!SHIFT) { *(u32x4*)dst = raw[1]; *(u32x4*)(dst + 144) = raw[2]; }
  else { *(u32x4*)dst = mix3(raw[1], raw[0], raw[2], smu, k); *(u32x4*)(dst + 144) = mix3(raw[2], raw[1], raw[3], smu, k); }
}

template <int SHIFT, int EPI>
DI void phase_gemm(const P& p, int g, const bf16_t* __restrict__ A, const bf16_t* __restrict__ Bt, int M, int N,
                   const float* __restrict__ mu, int Lmask, bf16_t* __restrict__ dst, int rw, unsigned char* lds) {
  const int tid = otid(), lane = tid & 63, wave = tid >> 6;
  const int wm = wave >> 1, wn = wave & 1, r = lane & 31, h = lane >> 5;
  const int ntn = N >> 7, ntiles = ntn * (M >> 8);
  float* Cs = (float*)lds;
  float* smu = (float*)(lds + 110592);
  for (int tile = blockIdx.x; tile < ntiles; tile += gridDim.x) {
    const int mt = tile / ntn, nt = tile - mt * ntn; const int m0 = mt * 256, n0 = nt * 128;
    f32x16 acc[2][2];
#pragma unroll
    for (int a = 0; a < 2; ++a)
#pragma unroll
      for (int b = 0; b < 2; ++b)
#pragma unroll
        for (int i = 0; i < 16; ++i) acc[a][b][i] = 0.f;
    if (SHIFT) {
      const float* mup = mu + (nt < 32 ? (nt >> 3) : (nt == 32 ? 4 : 5)) * 1024;
      smu[tid] = mup[tid]; smu[tid + 512] = mup[tid + 512];
      __syncthreads();
    }
    u32x4 raw[4], rb[2];
    const int arow = 4 * (tid >> 3), akc = (tid & 7) * 8;
#pragma unroll
    for (int hf = 0; hf < 2; ++hf) { ld_half<SHIFT>(A, m0 + arow + 2 * hf, akc, Lmask, raw); st_half<SHIFT>(lds + (arow + 2 * hf) * 144 + akc * 2, raw, smu, akc); }
#pragma unroll
    for (int i = 0; i < 2; ++i) { const int id = tid + 512 * i; rb[i] = *(const u32x4*)(Bt + (size_t)(n0 + (id >> 3)) * 1024 + (id & 7) * 8); }
#pragma unroll
    for (int i = 0; i < 2; ++i) { const int id = tid + 512 * i; *(u32x4*)(lds + 36864 + (id >> 3) * 144 + (id & 7) * 16) = rb[i]; }
    __syncthreads();
    for (int kt = 0; kt < 16; ++kt) {
      unsigned char* cur = lds + (kt & 1) * 55296; unsigned char* nxt = lds + ((kt + 1) & 1) * 55296;
      const int k1 = (kt + 1) * 64;
      if (kt < 15) {
        ld_half<SHIFT>(A, m0 + arow, k1 + akc, Lmask, raw);
#pragma unroll
        for (int i = 0; i < 2; ++i) { const int id = tid + 512 * i; rb[i] = *(const u32x4*)(Bt + (size_t)(n0 + (id >> 3)) * 1024 + k1 + (id & 7) * 8); }
      }
#pragma unroll
      for (int ks = 0; ks < 4; ++ks) {
        const int ko = (ks * 16 + h * 8) * 2;
        const bf16x8 a0 = *(const bf16x8*)(cur + (wm * 64 + r) * 144 + ko);
        const bf16x8 a1 = *(const bf16x8*)(cur + (wm * 64 + 32 + r) * 144 + ko);
        const bf16x8 b0 = *(const bf16x8*)(cur + 36864 + (wn * 64 + r) * 144 + ko);
        const bf16x8 b1 = *(const bf16x8*)(cur + 36864 + (wn * 64 + 32 + r) * 144 + ko);
        acc[0][0] = MFMA32(a0, b0, acc[0][0]); acc[0][1] = MFMA32(a0, b1, acc[0][1]);
        acc[1][0] = MFMA32(a1, b0, acc[1][0]); acc[1][1] = MFMA32(a1, b1, acc[1][1]);
        if (ks == 1 && kt < 15) {
          st_half<SHIFT>(nxt + arow * 144 + akc * 2, raw, smu, k1 + akc);
          ld_half<SHIFT>(A, m0 + arow + 2, k1 + akc, Lmask, raw);
        }
      }
      if (kt < 15) {
        st_half<SHIFT>(nxt + (arow + 2) * 144 + akc * 2, raw, smu, k1 + akc);
#pragma unroll
        for (int i = 0; i < 2; ++i) { const int id = tid + 512 * i; *(u32x4*)(nxt + 36864 + (id >> 3) * 144 + (id & 7) * 16) = rb[i]; }
      }
      __syncthreads();
    }
#pragma unroll
    for (int mi = 0; mi < 2; ++mi)
#pragma unroll
      for (int ni = 0; ni < 2; ++ni)
#pragma unroll
        for (int i = 0; i < 16; ++i) {
          const int row = wm * 64 + mi * 32 + (i & 3) + 8 * (i >> 2) + 4 * h, col = wn * 64 + ni * 32 + r;
          Cs[row * 132 + col] = acc[mi][ni][i];
        }
    __syncthreads();
    if (EPI == 0) {
#pragma unroll
      for (int i = 0; i < 8; ++i) {
        const int id = tid + 512 * i, row = id >> 4, cc = (id & 15) * 8;
        float4 v0 = *(const float4*)(Cs + row * 132 + cc), v1 = *(const float4*)(Cs + row * 132 + cc + 4);
        if (rw && nt == 32) { v0.x = tanhf(v0.x); v0.y = tanhf(v0.y); v0.z = tanhf(v0.z); v0.w = tanhf(v0.w); v1.x = tanhf(v1.x); v1.y = tanhf(v1.y); v1.z = tanhf(v1.z); v1.w = tanhf(v1.w); }
        u32x4 o; o[0] = pack2(v0.x, v0.y); o[1] = pack2(v0.z, v0.w); o[2] = pack2(v1.x, v1.y); o[3] = pack2(v1.z, v1.w);
        if (rw && nt >= 32) *(u32x4*)((bf16_t*)(p.ws + WS_HID) + (size_t)(m0 + row) * 256 + (nt - 32) * 128 + cc) = o;
        else *(u32x4*)(dst + (size_t)(nt >> 3) * SLOT_ELEMS + (size_t)(m0 + row) * 1024 + (nt & 7) * 128 + cc) = o;
      }
    } else {
      const int row = tid & 255, hh = tid >> 8; const int t = m0 + row;
      float x[64];
#pragma unroll
      for (int q = 0; q < 16; ++q) { const float4 v = *(const float4*)(Cs + row * 132 + hh * 64 + 4 * q); x[4 * q] = v.x; x[4 * q + 1] = v.y; x[4 * q + 2] = v.z; x[4 * q + 3] = v.w; }
      bf16_t* slots = (bf16_t*)(p.ws + WS_SLOT);
      const int L = g ? 4096 : 256, Ltot = g ? 4352 : 256;
      const int b = g ? (t >> 12) : (t >> 8), s = t & (L - 1);
      if (nt < 10) {
        int vz = 0; asm volatile("" : "+v"(vz));
        const float* nw = (nt < 8 ? p.in[26] : p.in[27]) + vz;
        float ss = 0.f;
#pragma unroll
        for (int d = 0; d < 64; ++d) ss += x[d] * x[d];
        const float rs = rsqrtf(ss * (1.f / 64.f) + 1e-6f);
#pragma unroll
        for (int d = 0; d < 64; ++d) x[d] *= rs * nw[d];
        if (g == 0 && nt >= 8) {
          float* ck = p.out + OUT_CK + (size_t)t * 256 + ((nt - 8) * 2 + hh) * 64;
#pragma unroll
          for (int q = 0; q < 16; ++q) *(float4*)(ck + 4 * q) = make_float4(x[4 * q], x[4 * q + 1], x[4 * q + 2], x[4 * q + 3]);
        }
        if (g == 1) {
          const float2* rope = (const float2*)(p.ws + WS_ROPE);
          const int ri = s >> 6, ci = s & 63;
#pragma unroll
          for (int f = 0; f < 16; ++f) {
            const float2 cr = rope[ri * 16 + f]; const float x1 = x[f], x2 = x[16 + f];
            x[f] = x1 * cr.x - x2 * cr.y; x[16 + f] = x2 * cr.x + x1 * cr.y;
            const float2 cc = rope[ci * 16 + f]; const float y1 = x[32 + f], y2 = x[48 + f];
            x[32 + f] = y1 * cc.x - y2 * cc.y; x[48 + f] = y2 * cc.x + y1 * cc.y;
          }
        }
        bf16_t* dq = nt < 8 ? slots + 2 * SLOT_ELEMS + (size_t)t * 1024 + (nt * 2 + hh) * 64
                            : slots + 4 * SLOT_ELEMS + ((size_t)b * Ltot + s) * 256 + ((nt - 8) * 2 + hh) * 64;
#pragma unroll
        for (int q = 0; q < 8; ++q) { u32x4 o; o[0] = pack2(x[8 * q], x[8 * q + 1]); o[1] = pack2(x[8 * q + 2], x[8 * q + 3]); o[2] = pack2(x[8 * q + 4], x[8 * q + 5]); o[3] = pack2(x[8 * q + 6], x[8 * q + 7]); *(u32x4*)(dq + 8 * q) = o; }
      } else if (nt < 12) {
        const int kvh = (nt - 10) * 2 + hh;
        if (g == 0) {
          float* cv = p.out + OUT_CV + (size_t)t * 256 + kvh * 64;
#pragma unroll
          for (int q = 0; q < 16; ++q) *(float4*)(cv + 4 * q) = make_float4(x[4 * q], x[4 * q + 1], x[4 * q + 2], x[4 * q + 3]);
        }
        bf16_t* vt = slots + 4 * SLOT_ELEMS + SLOT_ELEMS / 2 + ((size_t)(b * 4 + kvh) * 64) * Ltot + s;
#pragma unroll
        for (int d = 0; d < 64; ++d) { *vt = (bf16_t)f2bf(x[d]); vt += Ltot; asm volatile("" : "+v"(vt)); }
      } else {
        bf16_t* dg = slots + 3 * SLOT_ELEMS + (size_t)t * 1024 + (nt - 12) * 128 + hh * 64;
#pragma unroll
        for (int q = 0; q < 8; ++q) { u32x4 o; o[0] = pack2(x[8 * q], x[8 * q + 1]); o[1] = pack2(x[8 * q + 2], x[8 * q + 3]); o[2] = pack2(x[8 * q + 4], x[8 * q + 5]); o[3] = pack2(x[8 * q + 6], x[8 * q + 7]); *(u32x4*)(dg + 8 * q) = o; }
      }
    }
    __syncthreads();
  }
}

DI void phase_scan(const P& p, int g, int jl, unsigned char* lds) {
  const int tid = otid(), lane = tid & 63, wave = tid >> 6;
  const int L = g ? 4096 : 256, B = g ? 4 : 32, nchunk = L >> 6;
  float* sR = (float*)lds; float* sW = sR + 4096; float* sKD = sW + 4096; float* sKK = sKD + 4096; float* sKKA = sKK + 4096;
  float* sV = sKKA + 4096;
  float* sY = sV + 2048;
  bf16_t* sHW = (bf16_t*)(sY + 2048);
  bf16_t* sHA = sHW + 64 * 72;
  const bf16_t* slots = (const bf16_t*)(p.ws + WS_SLOT);
  const bf16_t* Rg = slots + 1 * SLOT_ELEMS; const bf16_t* Kg = slots + 2 * SLOT_ELEMS; const bf16_t* Vg = slots + 3 * SLOT_ELEMS;
  const bf16_t* hid = (const bf16_t*)(p.ws + WS_HID);
  float* bon = (float*)(p.ws + WS_BON);
  const int ntasks = B * 64;
  for (int task = blockIdx.x; task < ntasks; task += gridDim.x) {
    const int half = task & 1, z = (task >> 1) & 1, head = (task >> 2) & 15, b = task >> 6;
    bf16_t* Yg = (bf16_t*)(p.ws + WS_SLOT) + (z ? 0 : 5) * SLOT_ELEMS;
    const int mat = wave >> 2, mt = (wave >> 1) & 1, ntt = wave & 1, r = lane & 31, h = lane >> 5;
    bf16x8 bfr[4];
    { const float* W2 = (mat ? p.in[18] : p.in[15]) + (size_t)(jl * 2 + z) * 65536 + head * 64 + 32 * ntt + r;
#pragma unroll
      for (int kk = 0; kk < 4; ++kk)
#pragma unroll
        for (int j = 0; j < 8; ++j) bfr[kk][j] = (short)f2bf(W2[(size_t)(16 * kk + 8 * h + j) * 1024]);
    }
    const float bias = (mat ? p.in[16] : p.in[13])[(jl * 2 + z) * 1024 + head * 64 + 32 * ntt + r];
    const float kkc = p.in[19][jl * 1024 + head * 64 + lane], kac = p.in[20][jl * 1024 + head * 64 + lane], rkc = p.in[21][jl * 1024 + head * 64 + lane];
    const int rowl = 4 * wave + (lane >> 4), sl = lane & 15;
    const int vrow = half * 32 + rowl;
    float S0, S1, S2, S3;
    const size_t stidx = ((((size_t)(b * 2 + jl) * 2 + z) * 16 + head) * 64 + vrow) * 64 + 4 * sl;
    if (g) { const float4 s4 = *(const float4*)(p.in[2] + stidx); S0 = s4.x; S1 = s4.y; S2 = s4.z; S3 = s4.w; }
    else { S0 = S1 = S2 = S3 = 0.f; }
    for (int ci = 0; ci < nchunk; ++ci) {
#pragma unroll
      for (int i = 0; i < 5; ++i) {
        const int id = tid + 512 * i; const int arr = id >> 9, s = (id >> 3) & 63, cc = (id & 7) * 8;
        const int tl = z ? (L - 1 - (ci * 64 + s)) : (ci * 64 + s);
        const size_t tok = (size_t)b * L + tl;
        if (arr < 3) {
          const bf16_t* src = (arr == 0 ? Rg : (arr == 1 ? Kg : Vg)) + tok * 1024 + head * 64 + cc;
          const u32x4 u = *(const u32x4*)src;
          if (arr < 2) { float* d = (arr == 0 ? sR : sKD) + s * 64 + cc;
            *(float4*)d = make_float4(bflo(u[0]), bfhi(u[0]), bflo(u[1]), bfhi(u[1])); *(float4*)(d + 4) = make_float4(bflo(u[2]), bfhi(u[2]), bflo(u[3]), bfhi(u[3])); }
          else if ((cc >> 5) == half) { float* d = sV + s * 32 + (cc & 31);
            *(float4*)d = make_float4(bflo(u[0]), bfhi(u[0]), bflo(u[1]), bfhi(u[1])); *(float4*)(d + 4) = make_float4(bflo(u[2]), bfhi(u[2]), bflo(u[3]), bfhi(u[3])); }
        } else {
          const u32x4 u = *(const u32x4*)(hid + tok * 256 + (arr - 3) * 128 + z * 64 + cc);
          *(u32x4*)((arr == 3 ? sHW : sHA) + s * 72 + cc) = u;
        }
      }
      __syncthreads();
      {
        f32x16 acc;
#pragma unroll
        for (int i = 0; i < 16; ++i) acc[i] = 0.f;
        const bf16_t* sH = mat ? sHA : sHW;
#pragma unroll
        for (int kk = 0; kk < 4; ++kk) { const bf16x8 a = *(const bf16x8*)(sH + (32 * mt + r) * 72 + 16 * kk + 8 * h); acc = MFMA32(a, bfr[kk], acc); }
#pragma unroll
        for (int i = 0; i < 16; ++i) {
          const int srow = 32 * mt + (i & 3) + 8 * (i >> 2) + 4 * h, c = 32 * ntt + r;
          const float xv = acc[i] + bias;
          if (mat == 0) { const float nl = -xv; const float sp = fmaxf(nl, 0.f) + log1pf(__expf(-fabsf(nl))); sW[srow * 64 + c] = __expf(-__expf(-sp - 0.5f)); }
          else sKKA[srow * 64 + c] = 1.f / (1.f + __expf(-xv));
        }
      }
      __syncthreads();
#pragma unroll
      for (int i = 0; i < 8; ++i) {
        const int s = wave + 8 * i; const int c = lane;
        const float kraw = sKD[s * 64 + c], a = sKKA[s * 64 + c], rr = sR[s * 64 + c];
        const float pk = kraw * kkc; const float ss = wave_sum(pk * pk);
        const float kk = pk / fmaxf(sqrtf(ss), 1e-12f);
        const float kd = kraw * (1.f + (a - 1.f) * kac);
        const float bs = wave_sum(rr * kd * rkc);
        sKD[s * 64 + c] = kd; sKK[s * 64 + c] = kk; sKKA[s * 64 + c] = kk * a;
        if (half == 0 && c == 0) { const int tl = z ? (L - 1 - (ci * 64 + s)) : (ci * 64 + s); bon[(((size_t)b * L + tl) * 16 + head) * 2 + z] = bs; }
      }
      __syncthreads();
#pragma unroll 2
      for (int s = 0; s < 64; ++s) {
        const float4 k4 = *(const float4*)(sKK + s * 64 + 4 * sl);
        const float4 w4 = *(const float4*)(sW + s * 64 + 4 * sl);
        const float4 a4 = *(const float4*)(sKKA + s * 64 + 4 * sl);
        const float4 d4 = *(const float4*)(sKD + s * 64 + 4 * sl);
        const float4 r4 = *(const float4*)(sR + s * 64 + 4 * sl);
        const float vv = sV[s * 32 + rowl];
        float pa = S0 * k4.x + S1 * k4.y + S2 * k4.z + S3 * k4.w;
        pa = reduce16(pa);
        const float sa = -pa;
        S0 = S0 * w4.x + sa * a4.x + vv * d4.x; S1 = S1 * w4.y + sa * a4.y + vv * d4.y;
        S2 = S2 * w4.z + sa * a4.z + vv * d4.z; S3 = S3 * w4.w + sa * a4.w + vv * d4.w;
        float y = S0 * r4.x + S1 * r4.y + S2 * r4.z + S3 * r4.w;
        y = reduce16(y);
        if (sl == 0) sY[s * 32 + rowl] = y;
      }
      __syncthreads();
      { const int s = tid >> 3, c4 = (tid & 7) * 4; const int tl = z ? (L - 1 - (ci * 64 + s)) : (ci * 64 + s);
        const float4 y4 = *(const float4*)(sY + s * 32 + c4); u32x2 o; o[0] = pack2(y4.x, y4.y); o[1] = pack2(y4.z, y4.w);
        *(u32x2*)(Yg + ((size_t)b * L + tl) * 1024 + head * 64 + half * 32 + c4) = o; }
    }
    if (g == 0) *(float4*)(p.out + OUT_ST + stidx) = make_float4(S0, S1, S2, S3);
    __syncthreads();
  }
}

DI void phase_rwkv_combine(const P& p, int g, int jl) {
  const int T = g ? 16384 : 8192;
  const int tid = otid(); const int lane = tid & 63, wave = tid >> 6;
  bf16_t* slots = (bf16_t*)(p.ws + WS_SLOT);
  const float* bon = (const float*)(p.ws + WS_BON);
  for (int t = blockIdx.x * 8 + wave; t < T; t += gridDim.x * 8) {
    const size_t o = (size_t)t * 1024 + 16 * lane; const int head = lane >> 2;
    float y[16], v[16], gg[16];
#pragma unroll
    for (int q = 0; q < 2; ++q) {
      const u32x4 a = *(const u32x4*)(slots + 5 * SLOT_ELEMS + o + 8 * q), bq = *(const u32x4*)(slots + 0 * SLOT_ELEMS + o + 8 * q);
      const u32x4 vq = *(const u32x4*)(slots + 3 * SLOT_ELEMS + o + 8 * q), gq = *(const u32x4*)(slots + 4 * SLOT_ELEMS + o + 8 * q);
#pragma unroll
      for (int i = 0; i < 4; ++i) { y[8 * q + 2 * i] = bflo(a[i]) + bflo(bq[i]); y[8 * q + 2 * i + 1] = bfhi(a[i]) + bfhi(bq[i]);
        v[8 * q + 2 * i] = bflo(vq[i]); v[8 * q + 2 * i + 1] = bfhi(vq[i]); gg[8 * q + 2 * i] = bflo(gq[i]); gg[8 * q + 2 * i + 1] = bfhi(gq[i]); }
    }
    float s = 0.f;
#pragma unroll
    for (int i = 0; i < 16; ++i) s += y[i];
    const float mean = quad_sum(s) * (1.f / 64.f);
    float vs = 0.f;
#pragma unroll
    for (int i = 0; i < 16; ++i) { const float d = y[i] - mean; vs += d * d; }
    const float rstd = rsqrtf(quad_sum(vs) * (1.f / 64.f) + 64e-5f);
    const float bs = bon[((size_t)t * 16 + head) * 2] + bon[((size_t)t * 16 + head) * 2 + 1];
    const float* gw = p.in[22] + jl * 1024 + 16 * lane; const float* gb = p.in[23] + jl * 1024 + 16 * lane;
    float ov[16];
#pragma unroll
    for (int i = 0; i < 16; ++i) ov[i] = ((y[i] - mean) * rstd * gw[i] + gb[i] + bs * v[i]) * silu(gg[i]);
#pragma unroll
    for (int q = 0; q < 2; ++q) { u32x4 w; w[0] = pack2(ov[8 * q], ov[8 * q + 1]); w[1] = pack2(ov[8 * q + 2], ov[8 * q + 3]); w[2] = pack2(ov[8 * q + 4], ov[8 * q + 5]); w[3] = pack2(ov[8 * q + 6], ov[8 * q + 7]);
      *(u32x4*)(slots + 4 * SLOT_ELEMS + o + 8 * q) = w; }
  }
}

DI void phase_conv(const P& p, int g) {
  const int T = g ? 16384 : 8192, Lmask = g ? 4095 : 255;
  bf16_t* slots = (bf16_t*)(p.ws + WS_SLOT);
  const bf16_t* BG = slots + 2 * SLOT_ELEMS; const bf16_t* CG = slots + 3 * SLOT_ELEMS; const bf16_t* U = slots + 4 * SLOT_ELEMS; const bf16_t* G = slots + 5 * SLOT_ELEMS;
  bf16_t* O = slots;
  for (int e = blockIdx.x * NT + otid(); e < T * 128; e += gridDim.x * NT) {
    const int t = e >> 7, c = (e & 127) * 8; const size_t o = (size_t)t * 1024 + c; const int tl = t & Lmask;
    const u32x4 zz = {0u, 0u, 0u, 0u};
    const u32x4 c1 = *(const u32x4*)(CG + o), u1 = *(const u32x4*)(U + o);
    const u32x4 c0 = tl != 0 ? *(const u32x4*)(CG + o - 1024) : zz, u0 = tl != 0 ? *(const u32x4*)(U + o - 1024) : zz;
    const u32x4 c2 = tl != Lmask ? *(const u32x4*)(CG + o + 1024) : zz, u2 = tl != Lmask ? *(const u32x4*)(U + o + 1024) : zz;
    const u32x4 bg = *(const u32x4*)(BG + o), gg = *(const u32x4*)(G + o);
    const float* cw = p.in[30]; const float* cb = p.in[31];
    u32x4 w;
#pragma unroll
    for (int i = 0; i < 4; ++i) {
      const int ch = c + 2 * i;
      const float lo = bflo(bg[i]) * (cw[ch] * bflo(c0[i]) * bflo(u0[i]) + cw[1024 + ch] * bflo(c1[i]) * bflo(u1[i]) + cw[2048 + ch] * bflo(c2[i]) * bflo(u2[i]) + cb[ch]) * silu(bflo(gg[i]));
      const float hi = bfhi(bg[i]) * (cw[ch + 1] * bfhi(c0[i]) * bfhi(u0[i]) + cw[1024 + ch + 1] * bfhi(c1[i]) * bfhi(u1[i]) + cw[2048 + ch + 1] * bfhi(c2[i]) * bfhi(u2[i]) + cb[ch + 1]) * silu(bfhi(gg[i]));
      w[i] = pack2(lo, hi);
    }
    *(u32x4*)(O + o) = w;
  }
}

DI void phase_attn(const P& p, int g, unsigned char* lds) {
  const int tid = otid(), lane = tid & 63, wave = tid >> 6, r = lane & 31, h = lane >> 5;
  const int L = g ? 4096 : 256, Ltot = g ? 4352 : 256, B = g ? 4 : 32;
  const int nq = L >> 6, ntasks = B * 4 * nq, nkt = Ltot >> 6;
  bf16_t* slots = (bf16_t*)(p.ws + WS_SLOT);
  bf16_t* Q = slots + 2 * SLOT_ELEMS; const bf16_t* G = slots + 3 * SLOT_ELEMS;
  const bf16_t* Kb = slots + 4 * SLOT_ELEMS; const bf16_t* Vt = Kb + SLOT_ELEMS / 2;
  const float SC = 0.125f * 1.4426950408889634f;
  for (int task = blockIdx.x; task < ntasks; task += gridDim.x) {
    const int qt = task % nq, kvh = (task / nq) & 3, b = task / (nq * 4);
    const int head = kvh * 4 + (wave >> 1); const int q0 = qt * 64 + (wave & 1) * 32;
    const size_t tok = (size_t)b * L + q0 + r;
    bf16x8 qf[4];
#pragma unroll
    for (int ds = 0; ds < 4; ++ds) qf[ds] = *(const bf16x8*)(Q + tok * 1024 + head * 64 + ds * 16 + h * 8);
    float m = -1e30f, lsum = 0.f;
    f32x16 O0, O1;
#pragma unroll
    for (int i = 0; i < 16; ++i) { O0[i] = 0.f; O1[i] = 0.f; }
    const int lrow = tid >> 3, lc = (tid & 7) * 8;
    const bf16_t* gK = Kb + ((size_t)b * Ltot + lrow) * 256 + kvh * 64 + lc;
    const bf16_t* gV = Vt + ((size_t)(b * 4 + kvh) * 64 + lrow) * Ltot + lc;
    u32x4 rk = *(const u32x4*)gK, rv = *(const u32x4*)gV;
    *(u32x4*)(lds + lrow * 144 + lc * 2) = rk; *(u32x4*)(lds + 9216 + lrow * 144 + lc * 2) = rv;
    __syncthreads();
    for (int kt = 0; kt < nkt; ++kt) {
      const unsigned char* cur = lds + (kt & 1) * 18432; unsigned char* nxt = lds + ((kt + 1) & 1) * 18432;
      if (kt + 1 < nkt) { rk = *(const u32x4*)(gK + (size_t)(kt + 1) * 64 * 256); rv = *(const u32x4*)(gV + (kt + 1) * 64); }
      f32x16 s0, s1;
#pragma unroll
      for (int i = 0; i < 16; ++i) { s0[i] = 0.f; s1[i] = 0.f; }
#pragma unroll
      for (int ds = 0; ds < 4; ++ds) {
        const bf16x8 a0 = *(const bf16x8*)(cur + r * 144 + (ds * 16 + h * 8) * 2);
        const bf16x8 a1 = *(const bf16x8*)(cur + (32 + r) * 144 + (ds * 16 + h * 8) * 2);
        s0 = MFMA32(a0, qf[ds], s0); s1 = MFMA32(a1, qf[ds], s1);
      }
      float tmax = s0[0];
#pragma unroll
      for (int i = 1; i < 16; ++i) tmax = fmaxf(tmax, s0[i]);
#pragma unroll
      for (int i = 0; i < 16; ++i) tmax = fmaxf(tmax, s1[i]);
      tmax = fmaxf(tmax, __shfl_xor(tmax, 32));
      const float mnew = fmaxf(m, tmax * SC);
      const float alpha = __builtin_amdgcn_exp2f(m - mnew);
      float ps = 0.f;
#pragma unroll
      for (int i = 0; i < 16; ++i) { s0[i] = __builtin_amdgcn_exp2f(s0[i] * SC - mnew); s1[i] = __builtin_amdgcn_exp2f(s1[i] * SC - mnew); ps += s0[i] + s1[i]; }
      lsum = lsum * alpha + ps; m = mnew;
#pragma unroll
      for (int i = 0; i < 16; ++i) { O0[i] *= alpha; O1[i] *= alpha; }
      const unsigned char* vs = cur + 9216;
#pragma unroll
      for (int kb = 0; kb < 2; ++kb)
#pragma unroll
        for (int s = 0; s < 2; ++s) {
          u32x4 pk;
#pragma unroll
          for (int j = 0; j < 4; ++j) pk[j] = kb ? pack2(s1[8 * s + 2 * j], s1[8 * s + 2 * j + 1]) : pack2(s0[8 * s + 2 * j], s0[8 * s + 2 * j + 1]);
          const bf16x8 pf = __builtin_bit_cast(bf16x8, pk);
          const int ko = (32 * kb + 16 * s + 4 * h) * 2;
          { const u32x2 lo = *(const u32x2*)(vs + r * 144 + ko), hi = *(const u32x2*)(vs + r * 144 + ko + 16);
            u32x4 av; av[0] = lo[0]; av[1] = lo[1]; av[2] = hi[0]; av[3] = hi[1];
            O0 = MFMA32(__builtin_bit_cast(bf16x8, av), pf, O0); }
          { const u32x2 lo = *(const u32x2*)(vs + (32 + r) * 144 + ko), hi = *(const u32x2*)(vs + (32 + r) * 144 + ko + 16);
            u32x4 av; av[0] = lo[0]; av[1] = lo[1]; av[2] = hi[0]; av[3] = hi[1];
            O1 = MFMA32(__builtin_bit_cast(bf16x8, av), pf, O1); }
        }
      if (kt + 1 < nkt) { *(u32x4*)(nxt + lrow * 144 + lc * 2) = rk; *(u32x4*)(nxt + 9216 + lrow * 144 + lc * 2) = rv; }
      __syncthreads();
    }
    lsum += __shfl_xor(lsum, 32);
    const float inv = 1.f / lsum;
#pragma unroll
    for (int db = 0; db < 2; ++db)
#pragma unroll
      for (int i4 = 0; i4 < 4; ++i4) {
        const size_t o = tok * 1024 + head * 64 + 32 * db + 8 * i4 + 4 * h;
        const u32x2 gq = *(const u32x2*)(G + o);
        const float v0 = (db ? O1[4 * i4] : O0[4 * i4]) * inv, v1 = (db ? O1[4 * i4 + 1] : O0[4 * i4 + 1]) * inv;
        const float v2 = (db ? O1[4 * i4 + 2] : O0[4 * i4 + 2]) * inv, v3 = (db ? O1[4 * i4 + 3] : O0[4 * i4 + 3]) * inv;
        u32x2 w; w[0] = pack2(v0 * silu(bflo(gq[0])), v1 * silu(bfhi(gq[0]))); w[1] = pack2(v2 * silu(bflo(gq[1])), v3 * silu(bfhi(gq[1])));
        *(u32x2*)(Q + o) = w;
      }
  }
}

__global__ void __launch_bounds__(NT) mega(P p) {
  extern __shared__ __attribute__((aligned(16))) unsigned char lds[];
  cg::grid_group grid = cg::this_grid();
  phase0(p, lds);
  grid.sync();
  bf16_t* slots = (bf16_t*)(p.ws + WS_SLOT);
  const bf16_t* W = (const bf16_t*)(p.ws + WS_W);
  for (int step = 0; step < 50; ++step) {
    const int g = step / 25, rem = step - g * 25, layer = rem / 5, sub = rem - layer * 5;
    const int kind = layer % 3, jl = layer / 3;
    const int T = g ? 16384 : 8192, Lmask = g ? 4095 : 255;
    int op = -1;
    if (layer == 4) op = (sub == 0) ? 0 : -1;
    else if (sub == 0) op = 0;
    else if (kind == 0) op = sub == 1 ? 1 : (sub == 2 ? 2 : (sub == 3 ? 3 : 4));
    else if (kind == 1) op = sub == 1 ? 5 : (sub == 2 ? 6 : (sub == 3 ? 4 : -1));
    else op = sub == 1 ? 4 : (sub == 2 ? 7 : (sub == 3 ? 4 : -1));
    if (op < 0) continue;
    if (op == 0) {
      const float* xin = p.in[g]; float* xout = p.out + (g ? OUT_YS : OUT_YP);
      phase_norm(p, g, layer - 1, layer < 4 ? layer : -1, layer <= 1 ? xin : xout, xout, slots + SLOT_ELEMS, slots);
      if (kind == 1 && g == 1 && layer < 4) phase_cache_copy(p);
    } else if (op == 1) {
      phase_gemm<1, 0>(p, g, slots, W + (size_t)(RW_IN0 + jl * RW_STRIDE) * 1024, T, 4352, p.in[11] + jl * 6144, Lmask, slots + SLOT_ELEMS, 1, lds);
    } else if (op == 2) {
      phase_scan(p, g, jl, lds);
    } else if (op == 3) {
      phase_rwkv_combine(p, g, jl);
    } else if (op == 4) {
      const bf16_t* A; const bf16_t* Bt; int N; bf16_t* dst;
      if (sub == 1) { A = slots; Bt = W + (size_t)CV_IN * 1024; N = 4096; dst = slots + 2 * SLOT_ELEMS; }
      else {
        N = 1024; dst = slots + SLOT_ELEMS;
        if (kind == 0) { A = slots + 4 * SLOT_ELEMS; Bt = W + (size_t)(RW_OUT0 + jl * RW_STRIDE) * 1024; }
        else if (kind == 1) { A = slots + 2 * SLOT_ELEMS; Bt = W + (size_t)AT_OUT * 1024; }
        else { A = slots; Bt = W + (size_t)CV_OUT * 1024; }
      }
      phase_gemm<0, 0>(p, g, A, Bt, T, N, nullptr, 0, dst, 0, lds);
    } else if (op == 5) {
      phase_gemm<0, 1>(p, g, slots, W + (size_t)AT_IN * 1024, T, 2560, nullptr, 0, nullptr, 0, lds);
    } else if (op == 6) {
      phase_attn(p, g, lds);
    } else {
      phase_conv(p, g);
    }
    if (!(g == 1 && layer == 4)) grid.sync();
  }
}

extern "C" void kernel_launch(void* const* d_in, const int* in_sizes, int n_in, void* d_out, int out_size, void* d_ws, size_t ws_size, hipStream_t stream) {
  static int grid_blocks = 0;
  if (!grid_blocks) {
    int dev = 0, cus = 0, per_cu = 0;
    hipGetDevice(&dev);
    hipDeviceGetAttribute(&cus, hipDeviceAttributeMultiprocessorCount, dev);
    hipFuncSetAttribute((const void*)mega, hipFuncAttributeMaxDynamicSharedMemorySize, LDS_BYTES);
    hipOccupancyMaxActiveBlocksPerMultiprocessor(&per_cu, (const void*)mega, NT, LDS_BYTES);
    if (per_cu < 1) per_cu = 1;
    if (per_cu > 1) per_cu = 1;
    grid_blocks = cus * per_cu;
    if (ws_size < WS_SLOT + 6 * SLOT_ELEMS * 2) fprintf(stderr, "workspace too small: %zu\n", ws_size);
  }
  P p{};
  for (int i = 0; i < 33; ++i) p.in[i] = (const float*)d_in[i];
  p.out = (float*)d_out; p.ws = (unsigned char*)d_ws;
  void* args[] = {&p};
  hipError_t e = hipLaunchCooperativeKernel((const void*)mega, dim3(grid_blocks), dim3(NT), args, LDS_BYTES, stream);
  if (e != hipSuccess) fprintf(stderr, "cooperative launch failed: %s (grid %d)\n", hipGetErrorString(e), grid_blocks);
}
```

```cpp
#include <hip/hip_runtime.h>
#include <hip/hip_cooperative_groups.h>
#include <cstdio>
namespace cg = cooperative_groups;

typedef unsigned short bf16_t;
using bf16x8 = __attribute__((ext_vector_type(8))) short;
using f32x16 = __attribute__((ext_vector_type(16))) float;
using u32x4 = __attribute__((ext_vector_type(4))) unsigned;
using u32x2 = __attribute__((ext_vector_type(2))) unsigned;

#define NT 512
#ifndef REP_GEMM
#define REP_GEMM 1
#endif
#ifndef REP_SCAN
#define REP_SCAN 1
#endif
#ifndef REP_ATTN
#define REP_ATTN 1
#endif
#ifndef REP_SYNC
#define REP_SYNC 1
#endif
#define DI __device__ __forceinline__
#define MFMA32(a, b, c) __builtin_amdgcn_mfma_f32_32x32x16_bf16((a), (b), (c), 0, 0, 0)

struct P { const float* in[33]; float* out; unsigned char* ws; };

constexpr size_t WS_ADA = 0;
constexpr size_t WS_ROPE = 262144;
constexpr size_t WS_BON = 327680;
constexpr size_t WS_HID = WS_BON + 2097152;
constexpr size_t WS_W = WS_HID + 8388608;
constexpr size_t WS_SLOT = WS_W + 39845888;
constexpr size_t SLOT_ELEMS = (size_t)16384 * 1024;
constexpr int RW_IN0 = 0, RW_OUT0 = 4352, RW_STRIDE = 5376, AT_IN = 10752, AT_OUT = 13312, CV_IN = 14336, CV_OUT = 18432;
constexpr size_t OUT_YP = 0, OUT_YS = 8388608, OUT_ST = 25165824, OUT_CK = 33554432, OUT_CV = 35651584;
constexpr int LDS_BYTES = 135168;

DI unsigned f2bf(float x) { unsigned u = __float_as_uint(x); u += 0x7fffu + ((u >> 16) & 1u); return u >> 16; }
DI unsigned pack2(float a, float b) { return f2bf(a) | (f2bf(b) << 16); }
DI float bflo(unsigned u) { return __uint_as_float(u << 16); }
DI float bfhi(unsigned u) { return __uint_as_float(u & 0xffff0000u); }
DI float bf1(bf16_t u) { return __uint_as_float(((unsigned)u) << 16); }

template <int CTRL> DI float dppf(float v) { return __int_as_float(__builtin_amdgcn_update_dpp(0, __float_as_int(v), CTRL, 0xF, 0xF, true)); }
DI float reduce16(float v) { v += dppf<0xB1>(v); v += dppf<0x4E>(v); v += dppf<0x141>(v); v += dppf<0x140>(v); return v; }
DI float wave_sum(float v) { v = reduce16(v); v += __shfl_xor(v, 16); v += __shfl_xor(v, 32); return v; }
DI float quad_sum(float v) { v += dppf<0xB1>(v); v += dppf<0x4E>(v); return v; }
DI float silu(float x) { return x / (1.f + __expf(-x)); }
DI int opq(int v) { asm volatile("" : "+s"(v)); return v; }
DI int otid() { int t = threadIdx.x; asm volatile("" : "+v"(t)); return t; }

DI void conv_tiles(const float* __restrict__ src, int N, bf16_t* __restrict__ dst, float* lds) {
  const int tid = otid();
  const int tilesN = N >> 6, ntiles = 16 * tilesN;
  for (int tile = blockIdx.x; tile < ntiles; tile += gridDim.x) {
    const int kt = tile / tilesN, nt = tile - kt * tilesN, k0 = kt * 64, n0 = nt * 64;
#pragma unroll
    for (int i = 0; i < 8; ++i) { const int k = (tid >> 6) + 8 * i, n = tid & 63; lds[k * 65 + n] = src[(size_t)(k0 + k) * N + n0 + n]; }
    __syncthreads();
    { const int n = tid >> 3, kc = (tid & 7) * 8; u32x4 o;
#pragma unroll
      for (int j = 0; j < 4; ++j) o[j] = pack2(lds[(kc + 2 * j) * 65 + n], lds[(kc + 2 * j + 1) * 65 + n]);
      *(u32x4*)(dst + (size_t)(n0 + n) * 1024 + k0 + kc) = o; }
    __syncthreads();
  }
}

DI void phase0(const P& p, unsigned char* ldsb) {
  float* lds = (float*)ldsb;
  const int tid = otid();
  bf16_t* W = (bf16_t*)(p.ws + WS_W);
#pragma unroll 1
  for (int e = 0; e < opq(22); ++e) {
    const float* src; int N, drow;
    if (e < 18) {
      const int j = e / 9, q = e - j * 9;
      if (q < 4) { src = p.in[12] + (size_t)(j * 4 + q) * 1048576; N = 1024; drow = RW_IN0 + j * RW_STRIDE + q * 1024; }
      else if (q < 6) { src = p.in[14] + (size_t)(j * 2 + q - 4) * 65536; N = 64; drow = RW_IN0 + j * RW_STRIDE + 4096 + (q - 4) * 64; }
      else if (q < 8) { src = p.in[17] + (size_t)(j * 2 + q - 6) * 65536; N = 64; drow = RW_IN0 + j * RW_STRIDE + 4224 + (q - 6) * 64; }
      else { src = p.in[24] + (size_t)j * 1048576; N = 1024; drow = RW_OUT0 + j * RW_STRIDE; }
    } else if (e == 18) { src = p.in[25]; N = 2560; drow = AT_IN; }
    else if (e == 19) { src = p.in[28]; N = 1024; drow = AT_OUT; }
    else if (e == 20) { src = p.in[29]; N = 4096; drow = CV_IN; }
    else { src = p.in[32]; N = 1024; drow = CV_OUT; }
    conv_tiles(src, N, W + (size_t)drow * 1024, lds);
  }
  {
    float* scond = lds;
    float* red = lds + 5120;
    for (int e = tid; e < 5120; e += NT) { const int cnd = e >> 10, k = e & 1023; const float cv = cnd == 0 ? p.in[6][k] : p.in[5][(cnd - 1) * 1024 + k]; scond[e] = silu(cv); }
    __syncthreads();
    float* ada = (float*)(p.ws + WS_ADA);
    for (int task = blockIdx.x; task < 192; task += gridDim.x) {
      const int layer = task / 48, n0 = (task % 48) * 64, c = tid & 63, kg = tid >> 6;
      float a0 = 0.f, a1 = 0.f, a2 = 0.f, a3 = 0.f, a4 = 0.f;
      const float* wp = p.in[9] + ((size_t)layer * 1024 + kg * 128) * 3072 + n0 + c;
#pragma unroll 8
      for (int k = 0; k < 128; ++k) { const float w = wp[(size_t)k * 3072]; const int kk = kg * 128 + k;
        a0 += scond[kk] * w; a1 += scond[1024 + kk] * w; a2 += scond[2048 + kk] * w; a3 += scond[3072 + kk] * w; a4 += scond[4096 + kk] * w; }
      red[(kg * 5 + 0) * 64 + c] = a0; red[(kg * 5 + 1) * 64 + c] = a1; red[(kg * 5 + 2) * 64 + c] = a2; red[(kg * 5 + 3) * 64 + c] = a3; red[(kg * 5 + 4) * 64 + c] = a4;
      __syncthreads();
      if (tid < 320) { const int cnd = tid >> 6; float s = p.in[10][layer * 3072 + n0 + c];
#pragma unroll
        for (int q = 0; q < 8; ++q) s += red[(q * 5 + cnd) * 64 + c];
        ada[(cnd * 4 + layer) * 3072 + n0 + c] = s; }
      __syncthreads();
    }
  }
  if (blockIdx.x == gridDim.x - 1) {
    float* rope = (float*)(p.ws + WS_ROPE);
    for (int e = tid; e < 1024; e += NT) {
      const int pos = e >> 4, f = e & 15;
      double inv = 1.0; for (int q = 0; q < f; ++q) inv *= 0.5623413251903491;
      double ang = (double)pos * inv;
      const double twopi = 6.283185307179586476925286766559;
      double n = __builtin_rint(ang / twopi); double rr = ang - n * twopi;
      double r2 = rr * rr, sn = 0.0, cs = 0.0, ts = rr, tc = 1.0;
      for (int q = 0; q < 16; ++q) { cs += tc; sn += ts; tc = -tc * r2 / (double)((2 * q + 1) * (2 * q + 2)); ts = -ts * r2 / (double)((2 * q + 2) * (2 * q + 3)); }
      rope[e * 2] = (float)cs; rope[e * 2 + 1] = (float)sn;
    }
  }
}

DI void phase_norm(const P& p, int g, int lpost, int lpre, const float* __restrict__ xsrc, float* __restrict__ xdst,
                   const bf16_t* __restrict__ Mb, bf16_t* __restrict__ H) {
  const int T = g ? 16384 : 8192;
  const int tid = otid(); const int lane = tid & 63, wave = tid >> 6;
  const float* ada = (const float*)(p.ws + WS_ADA);
  for (int t = blockIdx.x * 8 + wave; t < T; t += gridDim.x * 8) {
    const int cond = g ? 1 + (t >> 12) : 0;
    float4 x[4];
#pragma unroll
    for (int i = 0; i < 4; ++i) x[i] = *(const float4*)(xsrc + (size_t)t * 1024 + 256 * i + 4 * lane);
    if (lpost >= 0) {
      float m[16]; float ss = 0.f;
#pragma unroll
      for (int i = 0; i < 4; ++i) { const u32x2 u = *(const u32x2*)(Mb + (size_t)t * 1024 + 256 * i + 4 * lane);
        m[4 * i] = bflo(u[0]); m[4 * i + 1] = bfhi(u[0]); m[4 * i + 2] = bflo(u[1]); m[4 * i + 3] = bfhi(u[1]); }
#pragma unroll
      for (int i = 0; i < 16; ++i) ss += m[i] * m[i];
      ss = wave_sum(ss);
      const float rs = rsqrtf(ss * (1.f / 1024.f) + 1e-6f);
      const float* gate = ada + (cond * 4 + lpost) * 3072 + 2048;
      const float* wpo = p.in[8] + lpost * 1024;
#pragma unroll
      for (int i = 0; i < 4; ++i) { const int c = 256 * i + 4 * lane; const float4 gt = *(const float4*)(gate + c); const float4 wv = *(const float4*)(wpo + c);
        x[i].x += gt.x * (m[4 * i] * rs * wv.x); x[i].y += gt.y * (m[4 * i + 1] * rs * wv.y); x[i].z += gt.z * (m[4 * i + 2] * rs * wv.z); x[i].w += gt.w * (m[4 * i + 3] * rs * wv.w);
        *(float4*)(xdst + (size_t)t * 1024 + c) = x[i]; }
    }
    if (lpre >= 0) {
      float ss = 0.f;
#pragma unroll
      for (int i = 0; i < 4; ++i) ss += x[i].x * x[i].x + x[i].y * x[i].y + x[i].z * x[i].z + x[i].w * x[i].w;
      ss = wave_sum(ss);
      const float rs = rsqrtf(ss * (1.f / 1024.f) + 1e-6f);
      const float* sh = ada + (cond * 4 + lpre) * 3072; const float* sc = sh + 1024; const float* wpr = p.in[7] + lpre * 1024;
#pragma unroll
      for (int i = 0; i < 4; ++i) { const int c = 256 * i + 4 * lane; const float4 s4 = *(const float4*)(sh + c); const float4 c4 = *(const float4*)(sc + c); const float4 wv = *(const float4*)(wpr + c);
        u32x2 o; o[0] = pack2(x[i].x * rs * wv.x * (1.f + c4.x) + s4.x, x[i].y * rs * wv.y * (1.f + c4.y) + s4.y);
        o[1] = pack2(x[i].z * rs * wv.z * (1.f + c4.z) + s4.z, x[i].w * rs * wv.w * (1.f + c4.w) + s4.w);
        *(u32x2*)(H + (size_t)t * 1024 + c) = o; }
    }
  }
}

DI void phase_cache_copy(const P& p) {
  bf16_t* Kb = (bf16_t*)(p.ws + WS_SLOT) + 4 * SLOT_ELEMS; bf16_t* Vt = Kb + SLOT_ELEMS / 2;
  for (int e = blockIdx.x * NT + otid(); e < 262144; e += gridDim.x * NT) {
    const int c = e & 255, pp = (e >> 8) & 255, b = e >> 16; const int kvh = c >> 6, d = c & 63;
    Kb[((size_t)b * 4352 + 4096 + pp) * 256 + c] = (bf16_t)f2bf(p.in[3][e]);
    Vt[((size_t)(b * 4 + kvh) * 64 + d) * 4352 + 4096 + pp] = (bf16_t)f2bf(p.in[4][e]);
  }
}

template <int SHIFT> DI void ld_half(const bf16_t* __restrict__ A, int t, int k, int Lmask, u32x4 (&raw)[4]) {
  raw[1] = *(const u32x4*)(A + (size_t)t * 1024 + k);
  raw[2] = *(const u32x4*)(A + (size_t)(t + 1) * 1024 + k);
  if (SHIFT) {
    raw[0] = (u32x4){0u, 0u, 0u, 0u}; raw[3] = (u32x4){0u, 0u, 0u, 0u};
    if ((t & Lmask) != 0) raw[0] = *(const u32x4*)(A + (size_t)(t - 1) * 1024 + k);
    if (((t + 1) & Lmask) != Lmask) raw[3] = *(const u32x4*)(A + (size_t)(t + 2) * 1024 + k);
  }
}
DI u32x4 mix3(const u32x4& c, const u32x4& pz, const u32x4& nz, const float* smu, int k) {
  const float4 m0 = *(const float4*)(smu + k), m1 = *(const float4*)(smu + k + 4);
  const float mu[8] = {m0.x, m0.y, m0.z, m0.w, m1.x, m1.y, m1.z, m1.w};
  u32x4 o;
#pragma unroll
  for (int i = 0; i < 4; ++i) {
    const float h0 = bflo(c[i]), h1 = bfhi(c[i]);
    const float x0 = h0 + (0.5f * (bflo(pz[i]) + bflo(nz[i])) - h0) * mu[2 * i];
    const float x1 = h1 + (0.5f * (bfhi(pz[i]) + bfhi(nz[i])) - h1) * mu[2 * i + 1];
    o[i] = pack2(x0, x1);
  }
  return o;
}
template <int SHIFT> DI void st_half(unsigned char* dst, const u32x4 (&raw)[4], const float* smu, int k) {
  if (!SHIFT) { *(u32x4*)dst = raw[1]; *(u32x4*)(dst + 144) = raw[2]; }
  else { *(u32x4*)dst = mix3(raw[1], raw[0], raw[2], smu, k); *(u32x4*)(dst + 144) = mix3(raw[2], raw[1], raw[3], smu, k); }
}

template <int SHIFT, int EPI>
DI void phase_gemm(const P& p, int g, const bf16_t* __restrict__ A, const bf16_t* __restrict__ Bt, int M, int N,
                   const float* __restrict__ mu, int Lmask, bf16_t* __restrict__ dst, int rw, unsigned char* lds) {
  const int tid = otid(), lane = tid & 63, wave = tid >> 6;
  const int wm = wave >> 1, wn = wave & 1, r = lane & 31, h = lane >> 5;
  const int ntn = N >> 7, ntiles = ntn * (M >> 8);
  float* Cs = (float*)lds;
  float* smu = (float*)(lds + 110592);
  for (int tile = blockIdx.x; tile < ntiles; tile += gridDim.x) {
    const int mt = tile / ntn, nt = tile - mt * ntn; const int m0 = mt * 256, n0 = nt * 128;
    f32x16 acc[2][2];
#pragma unroll
    for (int a = 0; a < 2; ++a)
#pragma unroll
      for (int b = 0; b < 2; ++b)
#pragma unroll
        for (int i = 0; i < 16; ++i) acc[a][b][i] = 0.f;
    if (SHIFT) {
      const float* mup = mu + (nt < 32 ? (nt >> 3) : (nt == 32 ? 4 : 5)) * 1024;
      smu[tid] = mup[tid]; smu[tid + 512] = mup[tid + 512];
      __syncthreads();
    }
    u32x4 raw[4], rb[2];
    const int arow = 4 * (tid >> 3), akc = (tid & 7) * 8;
#pragma unroll
    for (int hf = 0; hf < 2; ++hf) { ld_half<SHIFT>(A, m0 + arow + 2 * hf, akc, Lmask, raw); st_half<SHIFT>(lds + (arow + 2 * hf) * 144 + akc * 2, raw, smu, akc); }
#pragma unroll
    for (int i = 0; i < 2; ++i) { const int id = tid + 512 * i; rb[i] = *(const u32x4*)(Bt + (size_t)(n0 + (id >> 3)) * 1024 + (id & 7) * 8); }
#pragma unroll
    for (int i = 0; i < 2; ++i) { const int id = tid + 512 * i; *(u32x4*)(lds + 36864 + (id >> 3) * 144 + (id & 7) * 16) = rb[i]; }
    __syncthreads();
    for (int kt = 0; kt < 16; ++kt) {
      unsigned char* cur = lds + (kt & 1) * 55296; unsigned char* nxt = lds + ((kt + 1) & 1) * 55296;
      const int k1 = (kt + 1) * 64;
      if (kt < 15) {
        ld_half<SHIFT>(A, m0 + arow, k1 + akc, Lmask, raw);
        rb[0] = *(const u32x4*)(Bt + (size_t)(n0 + (tid >> 3)) * 1024 + k1 + (tid & 7) * 8);
      }
#pragma unroll
      for (int ks = 0; ks < 4; ++ks) {
        const int ko = (ks * 16 + h * 8) * 2;
        const bf16x8 a0 = *(const bf16x8*)(cur + (wm * 64 + r) * 144 + ko);
        const bf16x8 a1 = *(const bf16x8*)(cur + (wm * 64 + 32 + r) * 144 + ko);
        const bf16x8 b0 = *(const bf16x8*)(cur + 36864 + (wn * 64 + r) * 144 + ko);
        const bf16x8 b1 = *(const bf16x8*)(cur + 36864 + (wn * 64 + 32 + r) * 144 + ko);
        acc[0][0] = MFMA32(a0, b0, acc[0][0]); acc[0][1] = MFMA32(a0, b1, acc[0][1]);
        acc[1][0] = MFMA32(a1, b0, acc[1][0]); acc[1][1] = MFMA32(a1, b1, acc[1][1]);
        if (ks == 1 && kt < 15) {
          st_half<SHIFT>(nxt + arow * 144 + akc * 2, raw, smu, k1 + akc);
          *(u32x4*)(nxt + 36864 + (tid >> 3) * 144 + (tid & 7) * 16) = rb[0];
          ld_half<SHIFT>(A, m0 + arow + 2, k1 + akc, Lmask, raw);
          rb[0] = *(const u32x4*)(Bt + (size_t)(n0 + 64 + (tid >> 3)) * 1024 + k1 + (tid & 7) * 8);
        }
      }
      if (kt < 15) {
        st_half<SHIFT>(nxt + (arow + 2) * 144 + akc * 2, raw, smu, k1 + akc);
        *(u32x4*)(nxt + 36864 + (64 + (tid >> 3)) * 144 + (tid & 7) * 16) = rb[0];
      }
      __syncthreads();
    }
#pragma unroll
    for (int mi = 0; mi < 2; ++mi)
#pragma unroll
      for (int ni = 0; ni < 2; ++ni)
#pragma unroll
        for (int i = 0; i < 16; ++i) {
          const int row = wm * 64 + mi * 32 + (i & 3) + 8 * (i >> 2) + 4 * h, col = wn * 64 + ni * 32 + r;
          Cs[row * 132 + col] = acc[mi][ni][i];
        }
    __syncthreads();
    if (EPI == 0) {
#pragma unroll
      for (int i = 0; i < 8; ++i) {
        const int id = tid + 512 * i, row = id >> 4, cc = (id & 15) * 8;
        float4 v0 = *(const float4*)(Cs + row * 132 + cc), v1 = *(const float4*)(Cs + row * 132 + cc + 4);
        if (rw && nt == 32) { v0.x = tanhf(v0.x); v0.y = tanhf(v0.y); v0.z = tanhf(v0.z); v0.w = tanhf(v0.w); v1.x = tanhf(v1.x); v1.y = tanhf(v1.y); v1.z = tanhf(v1.z); v1.w = tanhf(v1.w); }
        u32x4 o; o[0] = pack2(v0.x, v0.y); o[1] = pack2(v0.z, v0.w); o[2] = pack2(v1.x, v1.y); o[3] = pack2(v1.z, v1.w);
        if (rw && nt >= 32) *(u32x4*)((bf16_t*)(p.ws + WS_HID) + (size_t)(m0 + row) * 256 + (nt - 32) * 128 + cc) = o;
        else *(u32x4*)(dst + (size_t)(nt >> 3) * SLOT_ELEMS + (size_t)(m0 + row) * 1024 + (nt & 7) * 128 + cc) = o;
      }
    } else {
      const int row = tid & 255, hh = tid >> 8; const int t = m0 + row;
      float x[64];
#pragma unroll
      for (int q = 0; q < 16; ++q) { const float4 v = *(const float4*)(Cs + row * 132 + hh * 64 + 4 * q); x[4 * q] = v.x; x[4 * q + 1] = v.y; x[4 * q + 2] = v.z; x[4 * q + 3] = v.w; }
      bf16_t* slots = (bf16_t*)(p.ws + WS_SLOT);
      const int L = g ? 4096 : 256, Ltot = g ? 4352 : 256;
      const int b = g ? (t >> 12) : (t >> 8), s = t & (L - 1);
      if (nt < 10) {
        int vz = 0; asm volatile("" : "+v"(vz));
        const float* nw = (nt < 8 ? p.in[26] : p.in[27]) + vz;
        float ss = 0.f;
#pragma unroll
        for (int d = 0; d < 64; ++d) ss += x[d] * x[d];
        const float rs = rsqrtf(ss * (1.f / 64.f) + 1e-6f);
#pragma unroll
        for (int d = 0; d < 64; ++d) x[d] *= rs * nw[d];
        if (g == 0 && nt >= 8) {
          float* ck = p.out + OUT_CK + (size_t)t * 256 + ((nt - 8) * 2 + hh) * 64;
#pragma unroll
          for (int q = 0; q < 16; ++q) *(float4*)(ck + 4 * q) = make_float4(x[4 * q], x[4 * q + 1], x[4 * q + 2], x[4 * q + 3]);
        }
        if (g == 1) {
          const float2* rope = (const float2*)(p.ws + WS_ROPE);
          const int ri = s >> 6, ci = s & 63;
#pragma unroll
          for (int f = 0; f < 16; ++f) {
            const float2 cr = rope[ri * 16 + f]; const float x1 = x[f], x2 = x[16 + f];
            x[f] = x1 * cr.x - x2 * cr.y; x[16 + f] = x2 * cr.x + x1 * cr.y;
            const float2 cc = rope[ci * 16 + f]; const float y1 = x[32 + f], y2 = x[48 + f];
            x[32 + f] = y1 * cc.x - y2 * cc.y; x[48 + f] = y2 * cc.x + y1 * cc.y;
          }
        }
        bf16_t* dq = nt < 8 ? slots + 2 * SLOT_ELEMS + (size_t)t * 1024 + (nt * 2 + hh) * 64
                            : slots + 4 * SLOT_ELEMS + ((size_t)b * Ltot + s) * 256 + ((nt - 8) * 2 + hh) * 64;
#pragma unroll
        for (int q = 0; q < 8; ++q) { u32x4 o; o[0] = pack2(x[8 * q], x[8 * q + 1]); o[1] = pack2(x[8 * q + 2], x[8 * q + 3]); o[2] = pack2(x[8 * q + 4], x[8 * q + 5]); o[3] = pack2(x[8 * q + 6], x[8 * q + 7]); *(u32x4*)(dq + 8 * q) = o; }
      } else if (nt < 12) {
        const int kvh = (nt - 10) * 2 + hh;
        if (g == 0) {
          float* cv = p.out + OUT_CV + (size_t)t * 256 + kvh * 64;
#pragma unroll
          for (int q = 0; q < 16; ++q) *(float4*)(cv + 4 * q) = make_float4(x[4 * q], x[4 * q + 1], x[4 * q + 2], x[4 * q + 3]);
        }
        bf16_t* vt = slots + 4 * SLOT_ELEMS + SLOT_ELEMS / 2 + ((size_t)(b * 4 + kvh) * 64) * Ltot + s;
#pragma unroll
        for (int d = 0; d < 64; ++d) { *vt = (bf16_t)f2bf(x[d]); vt += Ltot; asm volatile("" : "+v"(vt)); }
      } else {
        bf16_t* dg = slots + 3 * SLOT_ELEMS + (size_t)t * 1024 + (nt - 12) * 128 + hh * 64;
#pragma unroll
        for (int q = 0; q < 8; ++q) { u32x4 o; o[0] = pack2(x[8 * q], x[8 * q + 1]); o[1] = pack2(x[8 * q + 2], x[8 * q + 3]); o[2] = pack2(x[8 * q + 4], x[8 * q + 5]); o[3] = pack2(x[8 * q + 6], x[8 * q + 7]); *(u32x4*)(dg + 8 * q) = o; }
      }
    }
    __syncthreads();
  }
}

DI void phase_scan(const P& p, int g, int jl, unsigned char* lds) {
  const int tid = otid(), lane = tid & 63, wave = tid >> 6;
  const int L = g ? 4096 : 256, B = g ? 4 : 32, nchunk = L >> 6;
  float* sR = (float*)lds; float* sW = sR + 4096; float* sKD = sW + 4096; float* sKK = sKD + 4096; float* sKKA = sKK + 4096;
  float* sV = sKKA + 4096;
  float* sY = sV + 2048;
  bf16_t* sHW = (bf16_t*)(sY + 2048);
  bf16_t* sHA = sHW + 64 * 72;
  const bf16_t* slots = (const bf16_t*)(p.ws + WS_SLOT);
  const bf16_t* Rg = slots + 1 * SLOT_ELEMS; const bf16_t* Kg = slots + 2 * SLOT_ELEMS; const bf16_t* Vg = slots + 3 * SLOT_ELEMS;
  const bf16_t* hid = (const bf16_t*)(p.ws + WS_HID);
  float* bon = (float*)(p.ws + WS_BON);
  const int ntasks = B * 64;
  for (int task = blockIdx.x; task < ntasks; task += gridDim.x) {
    const int half = task & 1, z = (task >> 1) & 1, head = (task >> 2) & 15, b = task >> 6;
    bf16_t* Yg = (bf16_t*)(p.ws + WS_SLOT) + (z ? 0 : 5) * SLOT_ELEMS;
    const int mat = wave >> 2, mt = (wave >> 1) & 1, ntt = wave & 1, r = lane & 31, h = lane >> 5;
    bf16x8 bfr[4];
    { const float* W2 = (mat ? p.in[18] : p.in[15]) + (size_t)(jl * 2 + z) * 65536 + head * 64 + 32 * ntt + r;
#pragma unroll
      for (int kk = 0; kk < 4; ++kk)
#pragma unroll
        for (int j = 0; j < 8; ++j) bfr[kk][j] = (short)f2bf(W2[(size_t)(16 * kk + 8 * h + j) * 1024]);
    }
    const float bias = (mat ? p.in[16] : p.in[13])[(jl * 2 + z) * 1024 + head * 64 + 32 * ntt + r];
    const float kkc = p.in[19][jl * 1024 + head * 64 + lane], kac = p.in[20][jl * 1024 + head * 64 + lane], rkc = p.in[21][jl * 1024 + head * 64 + lane];
    const int rowl = 4 * wave + (lane >> 4), sl = lane & 15;
    const int vrow = half * 32 + rowl;
    float S0, S1, S2, S3;
    const size_t stidx = ((((size_t)(b * 2 + jl) * 2 + z) * 16 + head) * 64 + vrow) * 64 + 4 * sl;
    if (g) { const float4 s4 = *(const float4*)(p.in[2] + stidx); S0 = s4.x; S1 = s4.y; S2 = s4.z; S3 = s4.w; }
    else { S0 = S1 = S2 = S3 = 0.f; }
    u32x4 pre[5];
#define SCAN_LOAD(ci_)                                                                                   \
    _Pragma("unroll") for (int i = 0; i < 5; ++i) {                                                      \
      const int id = tid + 512 * i; const int arr = id >> 9, s = (id >> 3) & 63, cc = (id & 7) * 8;      \
      const int tl = z ? (L - 1 - ((ci_) * 64 + s)) : ((ci_) * 64 + s);                                  \
      const size_t tok = (size_t)b * L + tl;                                                             \
      if (arr < 3) pre[i] = *(const u32x4*)((arr == 0 ? Rg : (arr == 1 ? Kg : Vg)) + tok * 1024 + head * 64 + cc); \
      else pre[i] = *(const u32x4*)(hid + tok * 256 + (arr - 3) * 128 + z * 64 + cc);                    \
    }
    SCAN_LOAD(0)
    for (int ci = 0; ci < nchunk; ++ci) {
#pragma unroll
      for (int i = 0; i < 5; ++i) {
        const int id = tid + 512 * i; const int arr = id >> 9, s = (id >> 3) & 63, cc = (id & 7) * 8;
        const u32x4 u = pre[i];
        if (arr < 2) { float* d = (arr == 0 ? sR : sKD) + s * 64 + cc;
          *(float4*)d = make_float4(bflo(u[0]), bfhi(u[0]), bflo(u[1]), bfhi(u[1])); *(float4*)(d + 4) = make_float4(bflo(u[2]), bfhi(u[2]), bflo(u[3]), bfhi(u[3])); }
        else if (arr == 2) { if ((cc >> 5) == half) { float* d = sV + s * 32 + (cc & 31);
          *(float4*)d = make_float4(bflo(u[0]), bfhi(u[0]), bflo(u[1]), bfhi(u[1])); *(float4*)(d + 4) = make_float4(bflo(u[2]), bfhi(u[2]), bflo(u[3]), bfhi(u[3])); } }
        else *(u32x4*)((arr == 3 ? sHW : sHA) + s * 72 + cc) = u;
      }
      __syncthreads();
      {
        f32x16 acc;
#pragma unroll
        for (int i = 0; i < 16; ++i) acc[i] = 0.f;
        const bf16_t* sH = mat ? sHA : sHW;
#pragma unroll
        for (int kk = 0; kk < 4; ++kk) { const bf16x8 a = *(const bf16x8*)(sH + (32 * mt + r) * 72 + 16 * kk + 8 * h); acc = MFMA32(a, bfr[kk], acc); }
#pragma unroll
        for (int i = 0; i < 16; ++i) {
          const int srow = 32 * mt + (i & 3) + 8 * (i >> 2) + 4 * h, c = 32 * ntt + r;
          const float xv = acc[i] + bias;
          if (mat == 0) { const float nl = -xv; const float sp = fmaxf(nl, 0.f) + __logf(1.f + __expf(-fabsf(nl))); sW[srow * 64 + c] = __expf(-__expf(-sp - 0.5f)); }
          else sKKA[srow * 64 + c] = 1.f / (1.f + __expf(-xv));
        }
      }
      __syncthreads();
#pragma unroll
      for (int i = 0; i < 8; ++i) {
        const int s = wave + 8 * i; const int c = lane;
        const float kraw = sKD[s * 64 + c], a = sKKA[s * 64 + c], rr = sR[s * 64 + c];
        const float pk = kraw * kkc; const float ss = wave_sum(pk * pk);
        const float kk = pk / fmaxf(sqrtf(ss), 1e-12f);
        const float kd = kraw * (1.f + (a - 1.f) * kac);
        const float bs = wave_sum(rr * kd * rkc);
        sKD[s * 64 + c] = kd; sKK[s * 64 + c] = kk; sKKA[s * 64 + c] = kk * a;
        if (half == 0 && c == 0) { const int tl = z ? (L - 1 - (ci * 64 + s)) : (ci * 64 + s); bon[(((size_t)b * L + tl) * 16 + head) * 2 + z] = bs; }
      }
      __syncthreads();
      if (ci + 1 < nchunk) { SCAN_LOAD(ci + 1) }
      {
        const float* bK = sKK + 4 * sl; const float* bW = sW + 4 * sl; const float* bA = sKKA + 4 * sl; const float* bD = sKD + 4 * sl; const float* bR = sR + 4 * sl;
        const float* bV = sV + rowl;
        float4 k4 = *(const float4*)bK, w4 = *(const float4*)bW, a4 = *(const float4*)bA, d4 = *(const float4*)bD, r4 = *(const float4*)bR;
        float vv = *bV; float ykeep = 0.f;
#pragma unroll 4
        for (int s = 0; s < 64; ++s) {
          const int sn = (s + 1) & 63;
          const float4 nk4 = *(const float4*)(bK + sn * 64), nw4 = *(const float4*)(bW + sn * 64), na4 = *(const float4*)(bA + sn * 64);
          const float4 nd4 = *(const float4*)(bD + sn * 64), nr4 = *(const float4*)(bR + sn * 64);
          const float nvv = bV[sn * 32];
          float pa = (S0 * k4.x + S1 * k4.y) + (S2 * k4.z + S3 * k4.w);
          pa = reduce16(pa);
          const float sa = -pa;
          S0 = S0 * w4.x + (sa * a4.x + vv * d4.x); S1 = S1 * w4.y + (sa * a4.y + vv * d4.y);
          S2 = S2 * w4.z + (sa * a4.z + vv * d4.z); S3 = S3 * w4.w + (sa * a4.w + vv * d4.w);
          float y = (S0 * r4.x + S1 * r4.y) + (S2 * r4.z + S3 * r4.w);
          y = reduce16(y);
          ykeep = ((s & 15) == sl) ? y : ykeep;
          if ((s & 15) == 15) sY[((s & 48) + sl) * 32 + rowl] = ykeep;
          k4 = nk4; w4 = nw4; a4 = na4; d4 = nd4; r4 = nr4; vv = nvv;
        }
      }
      __syncthreads();
      { const int s = tid >> 3, c4 = (tid & 7) * 4; const int tl = z ? (L - 1 - (ci * 64 + s)) : (ci * 64 + s);
        const float4 y4 = *(const float4*)(sY + s * 32 + c4); u32x2 o; o[0] = pack2(y4.x, y4.y); o[1] = pack2(y4.z, y4.w);
        *(u32x2*)(Yg + ((size_t)b * L + tl) * 1024 + head * 64 + half * 32 + c4) = o; }
    }
#undef SCAN_LOAD
    if (g == 0) *(float4*)(p.out + OUT_ST + stidx) = make_float4(S0, S1, S2, S3);
    __syncthreads();
  }
}

DI void phase_rwkv_combine(const P& p, int g, int jl) {
  const int T = g ? 16384 : 8192;
  const int tid = otid(); const int lane = tid & 63, wave = tid >> 6;
  bf16_t* slots = (bf16_t*)(p.ws + WS_SLOT);
  const float* bon = (const float*)(p.ws + WS_BON);
  for (int t = blockIdx.x * 8 + wave; t < T; t += gridDim.x * 8) {
    const size_t o = (size_t)t * 1024 + 16 * lane; const int head = lane >> 2;
    float y[16], v[16], gg[16];
#pragma unroll
    for (int q = 0; q < 2; ++q) {
      const u32x4 a = *(const u32x4*)(slots + 5 * SLOT_ELEMS + o + 8 * q), bq = *(const u32x4*)(slots + 0 * SLOT_ELEMS + o + 8 * q);
      const u32x4 vq = *(const u32x4*)(slots + 3 * SLOT_ELEMS + o + 8 * q), gq = *(const u32x4*)(slots + 4 * SLOT_ELEMS + o + 8 * q);
#pragma unroll
      for (int i = 0; i < 4; ++i) { y[8 * q + 2 * i] = bflo(a[i]) + bflo(bq[i]); y[8 * q + 2 * i + 1] = bfhi(a[i]) + bfhi(bq[i]);
        v[8 * q + 2 * i] = bflo(vq[i]); v[8 * q + 2 * i + 1] = bfhi(vq[i]); gg[8 * q + 2 * i] = bflo(gq[i]); gg[8 * q + 2 * i + 1] = bfhi(gq[i]); }
    }
    float s = 0.f;
#pragma unroll
    for (int i = 0; i < 16; ++i) s += y[i];
    const float mean = quad_sum(s) * (1.f / 64.f);
    float vs = 0.f;
#pragma unroll
    for (int i = 0; i < 16; ++i) { const float d = y[i] - mean; vs += d * d; }
    const float rstd = rsqrtf(quad_sum(vs) * (1.f / 64.f) + 64e-5f);
    const float bs = bon[((size_t)t * 16 + head) * 2] + bon[((size_t)t * 16 + head) * 2 + 1];
    const float* gw = p.in[22] + jl * 1024 + 16 * lane; const float* gb = p.in[23] + jl * 1024 + 16 * lane;
    float ov[16];
#pragma unroll
    for (int i = 0; i < 16; ++i) ov[i] = ((y[i] - mean) * rstd * gw[i] + gb[i] + bs * v[i]) * silu(gg[i]);
#pragma unroll
    for (int q = 0; q < 2; ++q) { u32x4 w; w[0] = pack2(ov[8 * q], ov[8 * q + 1]); w[1] = pack2(ov[8 * q + 2], ov[8 * q + 3]); w[2] = pack2(ov[8 * q + 4], ov[8 * q + 5]); w[3] = pack2(ov[8 * q + 6], ov[8 * q + 7]);
      *(u32x4*)(slots + 4 * SLOT_ELEMS + o + 8 * q) = w; }
  }
}

DI void phase_conv(const P& p, int g) {
  const int T = g ? 16384 : 8192, Lmask = g ? 4095 : 255;
  bf16_t* slots = (bf16_t*)(p.ws + WS_SLOT);
  const bf16_t* BG = slots + 2 * SLOT_ELEMS; const bf16_t* CG = slots + 3 * SLOT_ELEMS; const bf16_t* U = slots + 4 * SLOT_ELEMS; const bf16_t* G = slots + 5 * SLOT_ELEMS;
  bf16_t* O = slots;
  for (int e = blockIdx.x * NT + otid(); e < T * 128; e += gridDim.x * NT) {
    const int t = e >> 7, c = (e & 127) * 8; const size_t o = (size_t)t * 1024 + c; const int tl = t & Lmask;
    const u32x4 zz = {0u, 0u, 0u, 0u};
    const u32x4 c1 = *(const u32x4*)(CG + o), u1 = *(const u32x4*)(U + o);
    const u32x4 c0 = tl != 0 ? *(const u32x4*)(CG + o - 1024) : zz, u0 = tl != 0 ? *(const u32x4*)(U + o - 1024) : zz;
    const u32x4 c2 = tl != Lmask ? *(const u32x4*)(CG + o + 1024) : zz, u2 = tl != Lmask ? *(const u32x4*)(U + o + 1024) : zz;
    const u32x4 bg = *(const u32x4*)(BG + o), gg = *(const u32x4*)(G + o);
    const float* cw = p.in[30]; const float* cb = p.in[31];
    u32x4 w;
#pragma unroll
    for (int i = 0; i < 4; ++i) {
      const int ch = c + 2 * i;
      const float lo = bflo(bg[i]) * (cw[ch] * bflo(c0[i]) * bflo(u0[i]) + cw[1024 + ch] * bflo(c1[i]) * bflo(u1[i]) + cw[2048 + ch] * bflo(c2[i]) * bflo(u2[i]) + cb[ch]) * silu(bflo(gg[i]));
      const float hi = bfhi(bg[i]) * (cw[ch + 1] * bfhi(c0[i]) * bfhi(u0[i]) + cw[1024 + ch + 1] * bfhi(c1[i]) * bfhi(u1[i]) + cw[2048 + ch + 1] * bfhi(c2[i]) * bfhi(u2[i]) + cb[ch + 1]) * silu(bfhi(gg[i]));
      w[i] = pack2(lo, hi);
    }
    *(u32x4*)(O + o) = w;
  }
}

DI void phase_attn(const P& p, int g, unsigned char* lds) {
  const int tid = otid(), lane = tid & 63, wave = tid >> 6, r = lane & 31, h = lane >> 5;
  const int L = g ? 4096 : 256, Ltot = g ? 4352 : 256, B = g ? 4 : 32;
  const int nq = L >> 6, ntasks = B * 4 * nq, nkt = Ltot >> 6;
  bf16_t* slots = (bf16_t*)(p.ws + WS_SLOT);
  bf16_t* Q = slots + 2 * SLOT_ELEMS; const bf16_t* G = slots + 3 * SLOT_ELEMS;
  const bf16_t* Kb = slots + 4 * SLOT_ELEMS; const bf16_t* Vt = Kb + SLOT_ELEMS / 2;
  const float SC = 0.125f * 1.4426950408889634f;
  for (int task = blockIdx.x; task < ntasks; task += gridDim.x) {
    const int qt = task % nq, kvh = (task / nq) & 3, b = task / (nq * 4);
    const int head = kvh * 4 + (wave >> 1); const int q0 = qt * 64 + (wave & 1) * 32;
    const size_t tok = (size_t)b * L + q0 + r;
    bf16x8 qf[4];
#pragma unroll
    for (int ds = 0; ds < 4; ++ds) qf[ds] = *(const bf16x8*)(Q + tok * 1024 + head * 64 + ds * 16 + h * 8);
    float m = -1e30f, lsum = 0.f;
    f32x16 O0, O1;
#pragma unroll
    for (int i = 0; i < 16; ++i) { O0[i] = 0.f; O1[i] = 0.f; }
    const int lrow = tid >> 3, lc = (tid & 7) * 8;
    const bf16_t* gK = Kb + ((size_t)b * Ltot + lrow) * 256 + kvh * 64 + lc;
    const bf16_t* gV = Vt + ((size_t)(b * 4 + kvh) * 64 + lrow) * Ltot + lc;
    u32x4 rk = *(const u32x4*)gK, rv = *(const u32x4*)gV;
    *(u32x4*)(lds + lrow * 144 + lc * 2) = rk; *(u32x4*)(lds + 9216 + lrow * 144 + lc * 2) = rv;
    __syncthreads();
    for (int kt = 0; kt < nkt; ++kt) {
      const unsigned char* cur = lds + (kt & 1) * 18432; unsigned char* nxt = lds + ((kt + 1) & 1) * 18432;
      if (kt + 1 < nkt) { rk = *(const u32x4*)(gK + (size_t)(kt + 1) * 64 * 256); rv = *(const u32x4*)(gV + (kt + 1) * 64); }
      f32x16 s0, s1;
#pragma unroll
      for (int i = 0; i < 16; ++i) { s0[i] = 0.f; s1[i] = 0.f; }
#pragma unroll
      for (int ds = 0; ds < 4; ++ds) {
        const bf16x8 a0 = *(const bf16x8*)(cur + r * 144 + (ds * 16 + h * 8) * 2);
        const bf16x8 a1 = *(const bf16x8*)(cur + (32 + r) * 144 + (ds * 16 + h * 8) * 2);
        s0 = MFMA32(a0, qf[ds], s0); s1 = MFMA32(a1, qf[ds], s1);
      }
      float tmax = s0[0];
#pragma unroll
      for (int i = 1; i < 16; ++i) tmax = fmaxf(tmax, s0[i]);
#pragma unroll
      for (int i = 0; i < 16; ++i) tmax = fmaxf(tmax, s1[i]);
      tmax = fmaxf(tmax, __shfl_xor(tmax, 32));
      const float mnew = fmaxf(m, tmax * SC);
      const float alpha = __builtin_amdgcn_exp2f(m - mnew);
      float ps = 0.f;
#pragma unroll
      for (int i = 0; i < 16; ++i) { s0[i] = __builtin_amdgcn_exp2f(s0[i] * SC - mnew); s1[i] = __builtin_amdgcn_exp2f(s1[i] * SC - mnew); ps += s0[i] + s1[i]; }
      lsum = lsum * alpha + ps; m = mnew;
#pragma unroll
      for (int i = 0; i < 16; ++i) { O0[i] *= alpha; O1[i] *= alpha; }
      const unsigned char* vs = cur + 9216;
#pragma unroll
      for (int kb = 0; kb < 2; ++kb)
#pragma unroll
        for (int s = 0; s < 2; ++s) {
          u32x4 pk;
#pragma unroll
          for (int j = 0; j < 4; ++j) pk[j] = kb ? pack2(s1[8 * s + 2 * j], s1[8 * s + 2 * j + 1]) : pack2(s0[8 * s + 2 * j], s0[8 * s + 2 * j + 1]);
          const bf16x8 pf = __builtin_bit_cast(bf16x8, pk);
          const int ko = (32 * kb + 16 * s + 4 * h) * 2;
          { const u32x2 lo = *(const u32x2*)(vs + r * 144 + ko), hi = *(const u32x2*)(vs + r * 144 + ko + 16);
            u32x4 av; av[0] = lo[0]; av[1] = lo[1]; av[2] = hi[0]; av[3] = hi[1];
            O0 = MFMA32(__builtin_bit_cast(bf16x8, av), pf, O0); }
          { const u32x2 lo = *(const u32x2*)(vs + (32 + r) * 144 + ko), hi = *(const u32x2*)(vs + (32 + r) * 144 + ko + 16);
            u32x4 av; av[0] = lo[0]; av[1] = lo[1]; av[2] = hi[0]; av[3] = hi[1];
            O1 = MFMA32(__builtin_bit_cast(bf16x8, av), pf, O1); }
        }
      if (kt + 1 < nkt) { *(u32x4*)(nxt + lrow * 144 + lc * 2) = rk; *(u32x4*)(nxt + 9216 + lrow * 144 + lc * 2) = rv; }
      __syncthreads();
    }
    lsum += __shfl_xor(lsum, 32);
    const float inv = 1.f / lsum;
#pragma unroll
    for (int db = 0; db < 2; ++db)
#pragma unroll
      for (int i4 = 0; i4 < 4; ++i4) {
        const size_t o = tok * 1024 + head * 64 + 32 * db + 8 * i4 + 4 * h;
        const u32x2 gq = *(const u32x2*)(G + o);
        const float v0 = (db ? O1[4 * i4] : O0[4 * i4]) * inv, v1 = (db ? O1[4 * i4 + 1] : O0[4 * i4 + 1]) * inv;
        const float v2 = (db ? O1[4 * i4 + 2] : O0[4 * i4 + 2]) * inv, v3 = (db ? O1[4 * i4 + 3] : O0[4 * i4 + 3]) * inv;
        u32x2 w; w[0] = pack2(v0 * silu(bflo(gq[0])), v1 * silu(bfhi(gq[0]))); w[1] = pack2(v2 * silu(bflo(gq[1])), v3 * silu(bfhi(gq[1])));
        *(u32x2*)(slots + 5 * SLOT_ELEMS + o) = w;
      }
  }
}

__global__ void __launch_bounds__(NT) mega(P p) {
  extern __shared__ __attribute__((aligned(16))) unsigned char lds[];
  cg::grid_group grid = cg::this_grid();
  phase0(p, lds);
  grid.sync();
  const P& p0 = p;
  for (int step = 0; step < 50; ++step) {
    const int g = step / 25, rem = step - g * 25, layer = rem / 5, sub = rem - layer * 5;
    const int kind = layer % 3, jl = layer / 3;
    const int T = g ? 16384 : 8192, Lmask = g ? 4095 : 255;
    int op = -1;
    if (layer == 4) op = (sub == 0) ? 0 : -1;
    else if (sub == 0) op = 0;
    else if (kind == 0) op = sub == 1 ? 1 : (sub == 2 ? 2 : (sub == 3 ? 3 : 4));
    else if (kind == 1) op = sub == 1 ? 5 : (sub == 2 ? 6 : (sub == 3 ? 4 : -1));
    else op = sub == 1 ? 4 : (sub == 2 ? 7 : (sub == 3 ? 4 : -1));
    if (op < 0) continue;
    P p = p0;
    { unsigned char* w_ = p0.ws; float* o_ = p0.out; asm volatile("" : "+s"(w_), "+s"(o_)); p.ws = w_; p.out = o_; }
    bf16_t* slots = (bf16_t*)(p.ws + WS_SLOT);
    const bf16_t* W = (const bf16_t*)(p.ws + WS_W);
    if (op == 0) {
      const float* xin = p.in[g]; float* xout = p.out + (g ? OUT_YS : OUT_YP);
      phase_norm(p, g, layer - 1, layer < 4 ? layer : -1, layer <= 1 ? xin : xout, xout, slots + SLOT_ELEMS, slots);
      if (kind == 1 && g == 1 && layer < 4) phase_cache_copy(p);
    } else if (op == 1) {
      for (int rep = 0; rep < opq(REP_GEMM); ++rep) phase_gemm<1, 0>(p, g, slots, W + (size_t)(RW_IN0 + jl * RW_STRIDE) * 1024, T, 4352, p.in[11] + jl * 6144, Lmask, slots + SLOT_ELEMS, 1, lds);
    } else if (op == 2) {
      for (int rep = 0; rep < opq(REP_SCAN); ++rep) phase_scan(p, g, jl, lds);
    } else if (op == 3) {
      phase_rwkv_combine(p, g, jl);
    } else if (op == 4) {
      const bf16_t* A; const bf16_t* Bt; int N; bf16_t* dst;
      if (sub == 1) { A = slots; Bt = W + (size_t)CV_IN * 1024; N = 4096; dst = slots + 2 * SLOT_ELEMS; }
      else {
        N = 1024; dst = slots + SLOT_ELEMS;
        if (kind == 0) { A = slots + 4 * SLOT_ELEMS; Bt = W + (size_t)(RW_OUT0 + jl * RW_STRIDE) * 1024; }
        else if (kind == 1) { A = slots + 5 * SLOT_ELEMS; Bt = W + (size_t)AT_OUT * 1024; }
        else { A = slots; Bt = W + (size_t)CV_OUT * 1024; }
      }
      for (int rep = 0; rep < opq(REP_GEMM); ++rep) phase_gemm<0, 0>(p, g, A, Bt, T, N, nullptr, 0, dst, 0, lds);
    } else if (op == 5) {
      for (int rep = 0; rep < opq(REP_GEMM); ++rep) phase_gemm<0, 1>(p, g, slots, W + (size_t)AT_IN * 1024, T, 2560, nullptr, 0, nullptr, 0, lds);
    } else if (op == 6) {
      for (int rep = 0; rep < opq(REP_ATTN); ++rep) phase_attn(p, g, lds);
    } else {
      phase_conv(p, g);
    }
    if (!(g == 1 && layer == 4)) for (int rep = 0; rep < opq(REP_SYNC); ++rep) grid.sync();
  }
}

extern "C" void kernel_launch(void* const* d_in, const int* in_sizes, int n_in, void* d_out, int out_size, void* d_ws, size_t ws_size, hipStream_t stream) {
  static int grid_blocks = 0;
  if (!grid_blocks) {
    int dev = 0, cus = 0, per_cu = 0;
    hipGetDevice(&dev);
    hipDeviceGetAttribute(&cus, hipDeviceAttributeMultiprocessorCount, dev);
    hipFuncSetAttribute((const void*)mega, hipFuncAttributeMaxDynamicSharedMemorySize, LDS_BYTES);
    hipOccupancyMaxActiveBlocksPerMultiprocessor(&per_cu, (const void*)mega, NT, LDS_BYTES);
    if (per_cu < 1) per_cu = 1;
    if (per_cu > 1) per_cu = 1;
    grid_blocks = cus * per_cu;
    if (ws_size < WS_SLOT + 6 * SLOT_ELEMS * 2) fprintf(stderr, "workspace too small: %zu\n", ws_size);
  }
  P p{};
  for (int i = 0; i < 33; ++i) p.in[i] = (const float*)d_in[i];
  p.out = (float*)d_out; p.ws = (unsigned char*)d_ws;
  void* args[] = {&p};
  hipError_t e = hipLaunchCooperativeKernel((const void*)mega, dim3(grid_blocks), dim3(NT), args, LDS_BYTES, stream);
  if (e != hipSuccess) fprintf(stderr, "cooperative launch failed: %s (grid %d)\n", hipGetErrorString(e), grid_blocks);
}
```

```cpp
#include <hip/hip_runtime.h>
#include <hip/hip_cooperative_groups.h>
#include <cstdio>
namespace cg = cooperative_groups;

typedef unsigned short bf16_t;
using bf16x8 = __attribute__((ext_vector_type(8))) short;
using f32x16 = __attribute__((ext_vector_type(16))) float;
using u32x4 = __attribute__((ext_vector_type(4))) unsigned;
using u32x2 = __attribute__((ext_vector_type(2))) unsigned;

#define NT 512
#ifndef REP_GEMM
#define REP_GEMM 1
#endif
#ifndef REP_SCAN
#define REP_SCAN 1
#endif
#ifndef REP_ATTN
#define REP_ATTN 1
#endif
#ifndef REP_SYNC
#define REP_SYNC 1
#endif
#define DI __device__ __forceinline__
#define MFMA32(a, b, c) __builtin_amdgcn_mfma_f32_32x32x16_bf16((a), (b), (c), 0, 0, 0)

struct P { const float* in[33]; float* out; unsigned char* ws; };

constexpr size_t WS_ADA = 0;
constexpr size_t WS_ROPE = 262144;
constexpr size_t WS_BON = 327680;
constexpr size_t WS_HID = WS_BON + 2097152;
constexpr size_t WS_W = WS_HID + 8388608;
constexpr size_t WS_SLOT = WS_W + 39845888;
constexpr size_t SLOT_ELEMS = (size_t)16384 * 1024;
constexpr int RW_IN0 = 0, RW_OUT0 = 4352, RW_STRIDE = 5376, AT_IN = 10752, AT_OUT = 13312, CV_IN = 14336, CV_OUT = 18432;
constexpr size_t OUT_YP = 0, OUT_YS = 8388608, OUT_ST = 25165824, OUT_CK = 33554432, OUT_CV = 35651584;
constexpr int LDS_BYTES = 135168 + 16;
constexpr size_t WS_BAR = 278528;

DI unsigned f2bf(float x) { unsigned u = __float_as_uint(x); u += 0x7fffu + ((u >> 16) & 1u); return u >> 16; }
DI unsigned pack2(float a, float b) { return f2bf(a) | (f2bf(b) << 16); }
DI float bflo(unsigned u) { return __uint_as_float(u << 16); }
DI float bfhi(unsigned u) { return __uint_as_float(u & 0xffff0000u); }
DI float bf1(bf16_t u) { return __uint_as_float(((unsigned)u) << 16); }

template <int CTRL> DI float dppf(float v) { return __int_as_float(__builtin_amdgcn_update_dpp(0, __float_as_int(v), CTRL, 0xF, 0xF, true)); }
DI float reduce16(float v) { v += dppf<0xB1>(v); v += dppf<0x4E>(v); v += dppf<0x141>(v); v += dppf<0x140>(v); return v; }
DI float wave_sum(float v) { v = reduce16(v); v += __shfl_xor(v, 16); v += __shfl_xor(v, 32); return v; }
DI float quad_sum(float v) { v += dppf<0xB1>(v); v += dppf<0x4E>(v); return v; }
DI float silu(float x) { return x / (1.f + __expf(-x)); }
DI int opq(int v) { asm volatile("" : "+s"(v)); return v; }
DI int otid() { int t = threadIdx.x; asm volatile("" : "+v"(t)); return t; }

DI void conv_tiles(const float* __restrict__ src, int N, bf16_t* __restrict__ dst, float* lds) {
  const int tid = otid();
  const int tilesN = N >> 6, ntiles = 16 * tilesN;
  for (int tile = blockIdx.x; tile < ntiles; tile += gridDim.x) {
    const int kt = tile / tilesN, nt = tile - kt * tilesN, k0 = kt * 64, n0 = nt * 64;
#pragma unroll
    for (int i = 0; i < 8; ++i) { const int k = (tid >> 6) + 8 * i, n = tid & 63; lds[k * 65 + n] = src[(size_t)(k0 + k) * N + n0 + n]; }
    __syncthreads();
    { const int n = tid >> 3, kc = (tid & 7) * 8; u32x4 o;
#pragma unroll
      for (int j = 0; j < 4; ++j) o[j] = pack2(lds[(kc + 2 * j) * 65 + n], lds[(kc + 2 * j + 1) * 65 + n]);
      *(u32x4*)(dst + (size_t)(n0 + n) * 1024 + k0 + kc) = o; }
    __syncthreads();
  }
}

DI void phase0(const P& p, unsigned char* ldsb) {
  float* lds = (float*)ldsb;
  const int tid = otid();
  bf16_t* W = (bf16_t*)(p.ws + WS_W);
#pragma unroll 1
  for (int e = 0; e < opq(22); ++e) {
    const float* src; int N, drow;
    if (e < 18) {
      const int j = e / 9, q = e - j * 9;
      if (q < 4) { src = p.in[12] + (size_t)(j * 4 + q) * 1048576; N = 1024; drow = RW_IN0 + j * RW_STRIDE + q * 1024; }
      else if (q < 6) { src = p.in[14] + (size_t)(j * 2 + q - 4) * 65536; N = 64; drow = RW_IN0 + j * RW_STRIDE + 4096 + (q - 4) * 64; }
      else if (q < 8) { src = p.in[17] + (size_t)(j * 2 + q - 6) * 65536; N = 64; drow = RW_IN0 + j * RW_STRIDE + 4224 + (q - 6) * 64; }
      else { src = p.in[24] + (size_t)j * 1048576; N = 1024; drow = RW_OUT0 + j * RW_STRIDE; }
    } else if (e == 18) { src = p.in[25]; N = 2560; drow = AT_IN; }
    else if (e == 19) { src = p.in[28]; N = 1024; drow = AT_OUT; }
    else if (e == 20) { src = p.in[29]; N = 4096; drow = CV_IN; }
    else { src = p.in[32]; N = 1024; drow = CV_OUT; }
    conv_tiles(src, N, W + (size_t)drow * 1024, lds);
  }
  {
    float* scond = lds;
    float* red = lds + 5120;
    for (int e = tid; e < 5120; e += NT) { const int cnd = e >> 10, k = e & 1023; const float cv = cnd == 0 ? p.in[6][k] : p.in[5][(cnd - 1) * 1024 + k]; scond[e] = silu(cv); }
    __syncthreads();
    float* ada = (float*)(p.ws + WS_ADA);
    for (int task = blockIdx.x; task < 192; task += gridDim.x) {
      const int layer = task / 48, n0 = (task % 48) * 64, c = tid & 63, kg = tid >> 6;
      float a0 = 0.f, a1 = 0.f, a2 = 0.f, a3 = 0.f, a4 = 0.f;
      const float* wp = p.in[9] + ((size_t)layer * 1024 + kg * 128) * 3072 + n0 + c;
#pragma unroll 8
      for (int k = 0; k < 128; ++k) { const float w = wp[(size_t)k * 3072]; const int kk = kg * 128 + k;
        a0 += scond[kk] * w; a1 += scond[1024 + kk] * w; a2 += scond[2048 + kk] * w; a3 += scond[3072 + kk] * w; a4 += scond[4096 + kk] * w; }
      red[(kg * 5 + 0) * 64 + c] = a0; red[(kg * 5 + 1) * 64 + c] = a1; red[(kg * 5 + 2) * 64 + c] = a2; red[(kg * 5 + 3) * 64 + c] = a3; red[(kg * 5 + 4) * 64 + c] = a4;
      __syncthreads();
      if (tid < 320) { const int cnd = tid >> 6; float s = p.in[10][layer * 3072 + n0 + c];
#pragma unroll
        for (int q = 0; q < 8; ++q) s += red[(q * 5 + cnd) * 64 + c];
        ada[(cnd * 4 + layer) * 3072 + n0 + c] = s; }
      __syncthreads();
    }
  }
  if (blockIdx.x == gridDim.x - 1) {
    float* rope = (float*)(p.ws + WS_ROPE);
    for (int e = tid; e < 1024; e += NT) {
      const int pos = e >> 4, f = e & 15;
      double inv = 1.0; for (int q = 0; q < f; ++q) inv *= 0.5623413251903491;
      double ang = (double)pos * inv;
      const double twopi = 6.283185307179586476925286766559;
      double n = __builtin_rint(ang / twopi); double rr = ang - n * twopi;
      double r2 = rr * rr, sn = 0.0, cs = 0.0, ts = rr, tc = 1.0;
      for (int q = 0; q < 16; ++q) { cs += tc; sn += ts; tc = -tc * r2 / (double)((2 * q + 1) * (2 * q + 2)); ts = -ts * r2 / (double)((2 * q + 2) * (2 * q + 3)); }
      rope[e * 2] = (float)cs; rope[e * 2 + 1] = (float)sn;
    }
  }
}

DI void phase_norm(const P& p, int g, int lpost, int lpre, const float* __restrict__ xsrc, float* __restrict__ xdst,
                   const bf16_t* __restrict__ Mb, bf16_t* __restrict__ H) {
  const int T = g ? 16384 : 8192;
  const int tid = otid(); const int lane = tid & 63, wave = tid >> 6;
  const float* ada = (const float*)(p.ws + WS_ADA);
  for (int t = blockIdx.x * 8 + wave; t < T; t += gridDim.x * 8) {
    const int cond = g ? 1 + (t >> 12) : 0;
    float4 x[4];
#pragma unroll
    for (int i = 0; i < 4; ++i) x[i] = *(const float4*)(xsrc + (size_t)t * 1024 + 256 * i + 4 * lane);
    if (lpost >= 0) {
      float m[16]; float ss = 0.f;
#pragma unroll
      for (int i = 0; i < 4; ++i) { const u32x2 u = *(const u32x2*)(Mb + (size_t)t * 1024 + 256 * i + 4 * lane);
        m[4 * i] = bflo(u[0]); m[4 * i + 1] = bfhi(u[0]); m[4 * i + 2] = bflo(u[1]); m[4 * i + 3] = bfhi(u[1]); }
#pragma unroll
      for (int i = 0; i < 16; ++i) ss += m[i] * m[i];
      ss = wave_sum(ss);
      const float rs = rsqrtf(ss * (1.f / 1024.f) + 1e-6f);
      const float* gate = ada + (cond * 4 + lpost) * 3072 + 2048;
      const float* wpo = p.in[8] + lpost * 1024;
#pragma unroll
      for (int i = 0; i < 4; ++i) { const int c = 256 * i + 4 * lane; const float4 gt = *(const float4*)(gate + c); const float4 wv = *(const float4*)(wpo + c);
        x[i].x += gt.x * (m[4 * i] * rs * wv.x); x[i].y += gt.y * (m[4 * i + 1] * rs * wv.y); x[i].z += gt.z * (m[4 * i + 2] * rs * wv.z); x[i].w += gt.w * (m[4 * i + 3] * rs * wv.w);
        *(float4*)(xdst + (size_t)t * 1024 + c) = x[i]; }
    }
    if (lpre >= 0) {
      float ss = 0.f;
#pragma unroll
      for (int i = 0; i < 4; ++i) ss += x[i].x * x[i].x + x[i].y * x[i].y + x[i].z * x[i].z + x[i].w * x[i].w;
      ss = wave_sum(ss);
      const float rs = rsqrtf(ss * (1.f / 1024.f) + 1e-6f);
      const float* sh = ada + (cond * 4 + lpre) * 3072; const float* sc = sh + 1024; const float* wpr = p.in[7] + lpre * 1024;
#pragma unroll
      for (int i = 0; i < 4; ++i) { const int c = 256 * i + 4 * lane; const float4 s4 = *(const float4*)(sh + c); const float4 c4 = *(const float4*)(sc + c); const float4 wv = *(const float4*)(wpr + c);
        u32x2 o; o[0] = pack2(x[i].x * rs * wv.x * (1.f + c4.x) + s4.x, x[i].y * rs * wv.y * (1.f + c4.y) + s4.y);
        o[1] = pack2(x[i].z * rs * wv.z * (1.f + c4.z) + s4.z, x[i].w * rs * wv.w * (1.f + c4.w) + s4.w);
        *(u32x2*)(H + (size_t)t * 1024 + c) = o; }
    }
  }
}

DI void phase_cache_copy(const P& p) {
  bf16_t* Kb = (bf16_t*)(p.ws + WS_SLOT) + 4 * SLOT_ELEMS; bf16_t* Vt = Kb + SLOT_ELEMS / 2;
  for (int e = blockIdx.x * NT + otid(); e < 262144; e += gridDim.x * NT) {
    const int c = e & 255, pp = (e >> 8) & 255, b = e >> 16; const int kvh = c >> 6, d = c & 63;
    Kb[((size_t)b * 4352 + 4096 + pp) * 256 + c] = (bf16_t)f2bf(p.in[3][e]);
    Vt[((size_t)(b * 4 + kvh) * 64 + d) * 4352 + 4096 + pp] = (bf16_t)f2bf(p.in[4][e]);
  }
}

template <int SHIFT> DI void ld_half(const bf16_t* __restrict__ A, int t, int k, int Lmask, u32x4 (&raw)[4]) {
  raw[1] = *(const u32x4*)(A + (size_t)t * 1024 + k);
  raw[2] = *(const u32x4*)(A + (size_t)(t + 1) * 1024 + k);
  if (SHIFT) {
    raw[0] = (u32x4){0u, 0u, 0u, 0u}; raw[3] = (u32x4){0u, 0u, 0u, 0u};
    if ((t & Lmask) != 0) raw[0] = *(const u32x4*)(A + (size_t)(t - 1) * 1024 + k);
    if (((t + 1) & Lmask) != Lmask) raw[3] = *(const u32x4*)(A + (size_t)(t + 2) * 1024 + k);
  }
}
DI u32x4 mix3(const u32x4& c, const u32x4& pz, const u32x4& nz, const float* smu, int k) {
  const float4 m0 = *(const float4*)(smu + k), m1 = *(const float4*)(smu + k + 4);
  const float mu[8] = {m0.x, m0.y, m0.z, m0.w, m1.x, m1.y, m1.z, m1.w};
  u32x4 o;
#pragma unroll
  for (int i = 0; i < 4; ++i) {
    const float h0 = bflo(c[i]), h1 = bfhi(c[i]);
    const float x0 = h0 + (0.5f * (bflo(pz[i]) + bflo(nz[i])) - h0) * mu[2 * i];
    const float x1 = h1 + (0.5f * (bfhi(pz[i]) + bfhi(nz[i])) - h1) * mu[2 * i + 1];
    o[i] = pack2(x0, x1);
  }
  return o;
}
template <int SHIFT> DI void st_half(unsigned char* dst, const u32x4 (&raw)[4], const float* smu, int k) {
  if (!SHIFT) { *(u32x4*)dst = raw[1]; *(u32x4*)(dst + 144) = raw[2]; }
  else { *(u32x4*)dst = mix3(raw[1], raw[0], raw[2], smu, k); *(u32x4*)(dst + 144) = mix3(raw[2], raw[1], raw[3], smu, k); }
}

template <int SHIFT, int EPI>
DI void phase_gemm(const P& p, int g, const bf16_t* __restrict__ A, const bf16_t* __restrict__ Bt, int M, int N,
                   const float* __restrict__ mu, int Lmask, bf16_t* __restrict__ dst, int rw, unsigned char* lds) {
  const int tid = otid(), lane = tid & 63, wave = tid >> 6;
  const int wm = wave >> 1, wn = wave & 1, r = lane & 31, h = lane >> 5;
  const int ntn = N >> 7, ntiles = ntn * (M >> 8);
  float* Cs = (float*)lds;
  float* smu = (float*)(lds + 110592);
  for (int tile = blockIdx.x; tile < ntiles; tile += gridDim.x) {
    const int mt = tile / ntn, nt = tile - mt * ntn; const int m0 = mt * 256, n0 = nt * 128;
    f32x16 acc[2][2];
#pragma unroll
    for (int a = 0; a < 2; ++a)
#pragma unroll
      for (int b = 0; b < 2; ++b)
#pragma unroll
        for (int i = 0; i < 16; ++i) acc[a][b][i] = 0.f;
    if (SHIFT) {
      const float* mup = mu + (nt < 32 ? (nt >> 3) : (nt == 32 ? 4 : 5)) * 1024;
      smu[tid] = mup[tid]; smu[tid + 512] = mup[tid + 512];
      __syncthreads();
    }
    u32x4 raw[4], rb[2];
    const int arow = 4 * (tid >> 3), akc = (tid & 7) * 8;
#pragma unroll
    for (int hf = 0; hf < 2; ++hf) { ld_half<SHIFT>(A, m0 + arow + 2 * hf, akc, Lmask, raw); st_half<SHIFT>(lds + (arow + 2 * hf) * 144 + akc * 2, raw, smu, akc); }
#pragma unroll
    for (int i = 0; i < 2; ++i) { const int id = tid + 512 * i; rb[i] = *(const u32x4*)(Bt + (size_t)(n0 + (id >> 3)) * 1024 + (id & 7) * 8); }
#pragma unroll
    for (int i = 0; i < 2; ++i) { const int id = tid + 512 * i; *(u32x4*)(lds + 36864 + (id >> 3) * 144 + (id & 7) * 16) = rb[i]; }
    __syncthreads();
    for (int kt = 0; kt < 16; ++kt) {
      unsigned char* cur = lds + (kt & 1) * 55296; unsigned char* nxt = lds + ((kt + 1) & 1) * 55296;
      const int k1 = (kt + 1) * 64;
      if (kt < 15) {
        ld_half<SHIFT>(A, m0 + arow, k1 + akc, Lmask, raw);
        rb[0] = *(const u32x4*)(Bt + (size_t)(n0 + (tid >> 3)) * 1024 + k1 + (tid & 7) * 8);
      }
#pragma unroll
      for (int ks = 0; ks < 4; ++ks) {
        const int ko = (ks * 16 + h * 8) * 2;
        const bf16x8 a0 = *(const bf16x8*)(cur + (wm * 64 + r) * 144 + ko);
        const bf16x8 a1 = *(const bf16x8*)(cur + (wm * 64 + 32 + r) * 144 + ko);
        const bf16x8 b0 = *(const bf16x8*)(cur + 36864 + (wn * 64 + r) * 144 + ko);
        const bf16x8 b1 = *(const bf16x8*)(cur + 36864 + (wn * 64 + 32 + r) * 144 + ko);
        acc[0][0] = MFMA32(a0, b0, acc[0][0]); acc[0][1] = MFMA32(a0, b1, acc[0][1]);
        acc[1][0] = MFMA32(a1, b0, acc[1][0]); acc[1][1] = MFMA32(a1, b1, acc[1][1]);
        if (ks == 1 && kt < 15) {
          st_half<SHIFT>(nxt + arow * 144 + akc * 2, raw, smu, k1 + akc);
          *(u32x4*)(nxt + 36864 + (tid >> 3) * 144 + (tid & 7) * 16) = rb[0];
          ld_half<SHIFT>(A, m0 + arow + 2, k1 + akc, Lmask, raw);
          rb[0] = *(const u32x4*)(Bt + (size_t)(n0 + 64 + (tid >> 3)) * 1024 + k1 + (tid & 7) * 8);
        }
      }
      if (kt < 15) {
        st_half<SHIFT>(nxt + (arow + 2) * 144 + akc * 2, raw, smu, k1 + akc);
        *(u32x4*)(nxt + 36864 + (64 + (tid >> 3)) * 144 + (tid & 7) * 16) = rb[0];
      }
      __syncthreads();
    }
#pragma unroll
    for (int mi = 0; mi < 2; ++mi)
#pragma unroll
      for (int ni = 0; ni < 2; ++ni)
#pragma unroll
        for (int i = 0; i < 16; ++i) {
          const int row = wm * 64 + mi * 32 + (i & 3) + 8 * (i >> 2) + 4 * h, col = wn * 64 + ni * 32 + r;
          Cs[row * 132 + col] = acc[mi][ni][i];
        }
    __syncthreads();
    if (EPI == 0) {
#pragma unroll
      for (int i = 0; i < 8; ++i) {
        const int id = tid + 512 * i, row = id >> 4, cc = (id & 15) * 8;
        float4 v0 = *(const float4*)(Cs + row * 132 + cc), v1 = *(const float4*)(Cs + row * 132 + cc + 4);
        if (rw && nt == 32) { v0.x = tanhf(v0.x); v0.y = tanhf(v0.y); v0.z = tanhf(v0.z); v0.w = tanhf(v0.w); v1.x = tanhf(v1.x); v1.y = tanhf(v1.y); v1.z = tanhf(v1.z); v1.w = tanhf(v1.w); }
        u32x4 o; o[0] = pack2(v0.x, v0.y); o[1] = pack2(v0.z, v0.w); o[2] = pack2(v1.x, v1.y); o[3] = pack2(v1.z, v1.w);
        if (rw && nt >= 32) *(u32x4*)((bf16_t*)(p.ws + WS_HID) + (size_t)(m0 + row) * 256 + (nt - 32) * 128 + cc) = o;
        else *(u32x4*)(dst + (size_t)(nt >> 3) * SLOT_ELEMS + (size_t)(m0 + row) * 1024 + (nt & 7) * 128 + cc) = o;
      }
    } else {
      const int row = tid & 255, hh = tid >> 8; const int t = m0 + row;
      float x[64];
#pragma unroll
      for (int q = 0; q < 16; ++q) { const float4 v = *(const float4*)(Cs + row * 132 + hh * 64 + 4 * q); x[4 * q] = v.x; x[4 * q + 1] = v.y; x[4 * q + 2] = v.z; x[4 * q + 3] = v.w; }
      bf16_t* slots = (bf16_t*)(p.ws + WS_SLOT);
      const int L = g ? 4096 : 256, Ltot = g ? 4352 : 256;
      const int b = g ? (t >> 12) : (t >> 8), s = t & (L - 1);
      if (nt < 10) {
        int vz = 0; asm volatile("" : "+v"(vz));
        const float* nw = (nt < 8 ? p.in[26] : p.in[27]) + vz;
        float ss = 0.f;
#pragma unroll
        for (int d = 0; d < 64; ++d) ss += x[d] * x[d];
        const float rs = rsqrtf(ss * (1.f / 64.f) + 1e-6f);
#pragma unroll
        for (int d = 0; d < 64; ++d) x[d] *= rs * nw[d];
        if (g == 0 && nt >= 8) {
          float* ck = p.out + OUT_CK + (size_t)t * 256 + ((nt - 8) * 2 + hh) * 64;
#pragma unroll
          for (int q = 0; q < 16; ++q) *(float4*)(ck + 4 * q) = make_float4(x[4 * q], x[4 * q + 1], x[4 * q + 2], x[4 * q + 3]);
        }
        if (g == 1) {
          const float2* rope = (const float2*)(p.ws + WS_ROPE);
          const int ri = s >> 6, ci = s & 63;
#pragma unroll
          for (int f = 0; f < 16; ++f) {
            const float2 cr = rope[ri * 16 + f]; const float x1 = x[f], x2 = x[16 + f];
            x[f] = x1 * cr.x - x2 * cr.y; x[16 + f] = x2 * cr.x + x1 * cr.y;
            const float2 cc = rope[ci * 16 + f]; const float y1 = x[32 + f], y2 = x[48 + f];
            x[32 + f] = y1 * cc.x - y2 * cc.y; x[48 + f] = y2 * cc.x + y1 * cc.y;
          }
        }
        bf16_t* dq = nt < 8 ? slots + 2 * SLOT_ELEMS + (size_t)t * 1024 + (nt * 2 + hh) * 64
                            : slots + 4 * SLOT_ELEMS + ((size_t)b * Ltot + s) * 256 + ((nt - 8) * 2 + hh) * 64;
#pragma unroll
        for (int q = 0; q < 8; ++q) { u32x4 o; o[0] = pack2(x[8 * q], x[8 * q + 1]); o[1] = pack2(x[8 * q + 2], x[8 * q + 3]); o[2] = pack2(x[8 * q + 4], x[8 * q + 5]); o[3] = pack2(x[8 * q + 6], x[8 * q + 7]); *(u32x4*)(dq + 8 * q) = o; }
      } else if (nt < 12) {
        const int kvh = (nt - 10) * 2 + hh;
        if (g == 0) {
          float* cv = p.out + OUT_CV + (size_t)t * 256 + kvh * 64;
#pragma unroll
          for (int q = 0; q < 16; ++q) *(float4*)(cv + 4 * q) = make_float4(x[4 * q], x[4 * q + 1], x[4 * q + 2], x[4 * q + 3]);
        }
        bf16_t* vt = slots + 4 * SLOT_ELEMS + SLOT_ELEMS / 2 + ((size_t)(b * 4 + kvh) * 64) * Ltot + s;
#pragma unroll
        for (int d = 0; d < 64; ++d) { *vt = (bf16_t)f2bf(x[d]); vt += Ltot; asm volatile("" : "+v"(vt)); }
      } else {
        bf16_t* dg = slots + 3 * SLOT_ELEMS + (size_t)t * 1024 + (nt - 12) * 128 + hh * 64;
#pragma unroll
        for (int q = 0; q < 8; ++q) { u32x4 o; o[0] = pack2(x[8 * q], x[8 * q + 1]); o[1] = pack2(x[8 * q + 2], x[8 * q + 3]); o[2] = pack2(x[8 * q + 4], x[8 * q + 5]); o[3] = pack2(x[8 * q + 6], x[8 * q + 7]); *(u32x4*)(dg + 8 * q) = o; }
      }
    }
    __syncthreads();
  }
}

DI void phase_scan(const P& p, int g, int jl, unsigned char* lds) {
  const int tid = otid(), lane = tid & 63, wave = tid >> 6;
  const int L = g ? 4096 : 256, B = g ? 4 : 32, nchunk = L >> 6;
  float* sR = (float*)lds; float* sW = sR + 4096; float* sKD = sW + 4096; float* sKK = sKD + 4096; float* sKKA = sKK + 4096;
  float* sV = sKKA + 4096;
  float* sY = sV + 2048;
  bf16_t* sHW = (bf16_t*)(sY + 2048);
  bf16_t* sHA = sHW + 64 * 72;
  const bf16_t* slots = (const bf16_t*)(p.ws + WS_SLOT);
  const bf16_t* Rg = slots + 1 * SLOT_ELEMS; const bf16_t* Kg = slots + 2 * SLOT_ELEMS; const bf16_t* Vg = slots + 3 * SLOT_ELEMS;
  const bf16_t* hid = (const bf16_t*)(p.ws + WS_HID);
  float* bon = (float*)(p.ws + WS_BON);
  const int ntasks = B * 64;
  for (int task = blockIdx.x; task < ntasks; task += gridDim.x) {
    const int half = task & 1, z = (task >> 1) & 1, head = (task >> 2) & 15, b = task >> 6;
    bf16_t* Yg = (bf16_t*)(p.ws + WS_SLOT) + (z ? 0 : 5) * SLOT_ELEMS;
    const int mat = wave >> 2, mt = (wave >> 1) & 1, ntt = wave & 1, r = lane & 31, h = lane >> 5;
    bf16x8 bfr[4];
    { const float* W2 = (mat ? p.in[18] : p.in[15]) + (size_t)(jl * 2 + z) * 65536 + head * 64 + 32 * ntt + r;
#pragma unroll
      for (int kk = 0; kk < 4; ++kk)
#pragma unroll
        for (int j = 0; j < 8; ++j) bfr[kk][j] = (short)f2bf(W2[(size_t)(16 * kk + 8 * h + j) * 1024]);
    }
    const float bias = (mat ? p.in[16] : p.in[13])[(jl * 2 + z) * 1024 + head * 64 + 32 * ntt + r];
    const float kkc = p.in[19][jl * 1024 + head * 64 + lane], kac = p.in[20][jl * 1024 + head * 64 + lane], rkc = p.in[21][jl * 1024 + head * 64 + lane];
    const int rowl = 4 * wave + (lane >> 4), sl = lane & 15;
    const int vrow = half * 32 + rowl;
    float S0, S1, S2, S3;
    const size_t stidx = ((((size_t)(b * 2 + jl) * 2 + z) * 16 + head) * 64 + vrow) * 64 + 4 * sl;
    if (g) { const float4 s4 = *(const float4*)(p.in[2] + stidx); S0 = s4.x; S1 = s4.y; S2 = s4.z; S3 = s4.w; }
    else { S0 = S1 = S2 = S3 = 0.f; }
    u32x4 pre[5];
#define SCAN_LOAD(ci_)                                                                                   \
    _Pragma("unroll") for (int i = 0; i < 5; ++i) {                                                      \
      const int id = tid + 512 * i; const int arr = id >> 9, s = (id >> 3) & 63, cc = (id & 7) * 8;      \
      const int tl = z ? (L - 1 - ((ci_) * 64 + s)) : ((ci_) * 64 + s);                                  \
      const size_t tok = (size_t)b * L + tl;                                                             \
      if (arr < 3) pre[i] = *(const u32x4*)((arr == 0 ? Rg : (arr == 1 ? Kg : Vg)) + tok * 1024 + head * 64 + cc); \
      else pre[i] = *(const u32x4*)(hid + tok * 256 + (arr - 3) * 128 + z * 64 + cc);                    \
    }
    SCAN_LOAD(0)
    for (int ci = 0; ci < nchunk; ++ci) {
#pragma unroll
      for (int i = 0; i < 5; ++i) {
        const int id = tid + 512 * i; const int arr = id >> 9, s = (id >> 3) & 63, cc = (id & 7) * 8;
        const u32x4 u = pre[i];
        if (arr < 2) { float* d = (arr == 0 ? sR : sKD) + s * 64 + cc;
          *(float4*)d = make_float4(bflo(u[0]), bfhi(u[0]), bflo(u[1]), bfhi(u[1])); *(float4*)(d + 4) = make_float4(bflo(u[2]), bfhi(u[2]), bflo(u[3]), bfhi(u[3])); }
        else if (arr == 2) { if ((cc >> 5) == half) { float* d = sV + s * 32 + (cc & 31);
          *(float4*)d = make_float4(bflo(u[0]), bfhi(u[0]), bflo(u[1]), bfhi(u[1])); *(float4*)(d + 4) = make_float4(bflo(u[2]), bfhi(u[2]), bflo(u[3]), bfhi(u[3])); } }
        else *(u32x4*)((arr == 3 ? sHW : sHA) + s * 72 + cc) = u;
      }
      __syncthreads();
      {
        f32x16 acc;
#pragma unroll
        for (int i = 0; i < 16; ++i) acc[i] = 0.f;
        const bf16_t* sH = mat ? sHA : sHW;
#pragma unroll
        for (int kk = 0; kk < 4; ++kk) { const bf16x8 a = *(const bf16x8*)(sH + (32 * mt + r) * 72 + 16 * kk + 8 * h); acc = MFMA32(a, bfr[kk], acc); }
#pragma unroll
        for (int i = 0; i < 16; ++i) {
          const int srow = 32 * mt + (i & 3) + 8 * (i >> 2) + 4 * h, c = 32 * ntt + r;
          const float xv = acc[i] + bias;
          if (mat == 0) { const float nl = -xv; const float sp = fmaxf(nl, 0.f) + __logf(1.f + __expf(-fabsf(nl))); sW[srow * 64 + c] = __expf(-__expf(-sp - 0.5f)); }
          else sKKA[srow * 64 + c] = 1.f / (1.f + __expf(-xv));
        }
      }
      __syncthreads();
#pragma unroll
      for (int i = 0; i < 8; ++i) {
        const int s = wave + 8 * i; const int c = lane;
        const float kraw = sKD[s * 64 + c], a = sKKA[s * 64 + c], rr = sR[s * 64 + c];
        const float pk = kraw * kkc; const float ss = wave_sum(pk * pk);
        const float kk = pk / fmaxf(sqrtf(ss), 1e-12f);
        const float kd = kraw * (1.f + (a - 1.f) * kac);
        const float bs = wave_sum(rr * kd * rkc);
        sKD[s * 64 + c] = kd; sKK[s * 64 + c] = kk; sKKA[s * 64 + c] = kk * a;
        if (half == 0 && c == 0) { const int tl = z ? (L - 1 - (ci * 64 + s)) : (ci * 64 + s); bon[(((size_t)b * L + tl) * 16 + head) * 2 + z] = bs; }
      }
      __syncthreads();
      if (ci + 1 < nchunk) { SCAN_LOAD(ci + 1) }
      {
        const float* bK = sKK + 4 * sl; const float* bW = sW + 4 * sl; const float* bA = sKKA + 4 * sl; const float* bD = sKD + 4 * sl; const float* bR = sR + 4 * sl;
        const float* bV = sV + rowl;
        float4 k4 = *(const float4*)bK, w4 = *(const float4*)bW, a4 = *(const float4*)bA, d4 = *(const float4*)bD, r4 = *(const float4*)bR;
        float vv = *bV; float ykeep = 0.f;
#pragma unroll 4
        for (int s = 0; s < 64; ++s) {
          const int sn = (s + 1) & 63;
          const float4 nk4 = *(const float4*)(bK + sn * 64), nw4 = *(const float4*)(bW + sn * 64), na4 = *(const float4*)(bA + sn * 64);
          const float4 nd4 = *(const float4*)(bD + sn * 64), nr4 = *(const float4*)(bR + sn * 64);
          const float nvv = bV[sn * 32];
          float pa = (S0 * k4.x + S1 * k4.y) + (S2 * k4.z + S3 * k4.w);
          pa = reduce16(pa);
          const float sa = -pa;
          S0 = S0 * w4.x + (sa * a4.x + vv * d4.x); S1 = S1 * w4.y + (sa * a4.y + vv * d4.y);
          S2 = S2 * w4.z + (sa * a4.z + vv * d4.z); S3 = S3 * w4.w + (sa * a4.w + vv * d4.w);
          float y = (S0 * r4.x + S1 * r4.y) + (S2 * r4.z + S3 * r4.w);
          y = reduce16(y);
          ykeep = ((s & 15) == sl) ? y : ykeep;
          if ((s & 15) == 15) sY[((s & 48) + sl) * 32 + rowl] = ykeep;
          k4 = nk4; w4 = nw4; a4 = na4; d4 = nd4; r4 = nr4; vv = nvv;
        }
      }
      __syncthreads();
      { const int s = tid >> 3, c4 = (tid & 7) * 4; const int tl = z ? (L - 1 - (ci * 64 + s)) : (ci * 64 + s);
        const float4 y4 = *(const float4*)(sY + s * 32 + c4); u32x2 o; o[0] = pack2(y4.x, y4.y); o[1] = pack2(y4.z, y4.w);
        *(u32x2*)(Yg + ((size_t)b * L + tl) * 1024 + head * 64 + half * 32 + c4) = o; }
    }
#undef SCAN_LOAD
    if (g == 0) *(float4*)(p.out + OUT_ST + stidx) = make_float4(S0, S1, S2, S3);
    __syncthreads();
  }
}

DI void phase_rwkv_combine(const P& p, int g, int jl) {
  const int T = g ? 16384 : 8192;
  const int tid = otid(); const int lane = tid & 63, wave = tid >> 6;
  bf16_t* slots = (bf16_t*)(p.ws + WS_SLOT);
  const float* bon = (const float*)(p.ws + WS_BON);
  for (int t = blockIdx.x * 8 + wave; t < T; t += gridDim.x * 8) {
    const size_t o = (size_t)t * 1024 + 16 * lane; const int head = lane >> 2;
    float y[16], v[16], gg[16];
#pragma unroll
    for (int q = 0; q < 2; ++q) {
      const u32x4 a = *(const u32x4*)(slots + 5 * SLOT_ELEMS + o + 8 * q), bq = *(const u32x4*)(slots + 0 * SLOT_ELEMS + o + 8 * q);
      const u32x4 vq = *(const u32x4*)(slots + 3 * SLOT_ELEMS + o + 8 * q), gq = *(const u32x4*)(slots + 4 * SLOT_ELEMS + o + 8 * q);
#pragma unroll
      for (int i = 0; i < 4; ++i) { y[8 * q + 2 * i] = bflo(a[i]) + bflo(bq[i]); y[8 * q + 2 * i + 1] = bfhi(a[i]) + bfhi(bq[i]);
        v[8 * q + 2 * i] = bflo(vq[i]); v[8 * q + 2 * i + 1] = bfhi(vq[i]); gg[8 * q + 2 * i] = bflo(gq[i]); gg[8 * q + 2 * i + 1] = bfhi(gq[i]); }
    }
    float s = 0.f;
#pragma unroll
    for (int i = 0; i < 16; ++i) s += y[i];
    const float mean = quad_sum(s) * (1.f / 64.f);
    float vs = 0.f;
#pragma unroll
    for (int i = 0; i < 16; ++i) { const float d = y[i] - mean; vs += d * d; }
    const float rstd = rsqrtf(quad_sum(vs) * (1.f / 64.f) + 64e-5f);
    const float bs = bon[((size_t)t * 16 + head) * 2] + bon[((size_t)t * 16 + head) * 2 + 1];
    const float* gw = p.in[22] + jl * 1024 + 16 * lane; const float* gb = p.in[23] + jl * 1024 + 16 * lane;
    float ov[16];
#pragma unroll
    for (int i = 0; i < 16; ++i) ov[i] = ((y[i] - mean) * rstd * gw[i] + gb[i] + bs * v[i]) * silu(gg[i]);
#pragma unroll
    for (int q = 0; q < 2; ++q) { u32x4 w; w[0] = pack2(ov[8 * q], ov[8 * q + 1]); w[1] = pack2(ov[8 * q + 2], ov[8 * q + 3]); w[2] = pack2(ov[8 * q + 4], ov[8 * q + 5]); w[3] = pack2(ov[8 * q + 6], ov[8 * q + 7]);
      *(u32x4*)(slots + 4 * SLOT_ELEMS + o + 8 * q) = w; }
  }
}

DI void phase_conv(const P& p, int g) {
  const int T = g ? 16384 : 8192, Lmask = g ? 4095 : 255;
  bf16_t* slots = (bf16_t*)(p.ws + WS_SLOT);
  const bf16_t* BG = slots + 2 * SLOT_ELEMS; const bf16_t* CG = slots + 3 * SLOT_ELEMS; const bf16_t* U = slots + 4 * SLOT_ELEMS; const bf16_t* G = slots + 5 * SLOT_ELEMS;
  bf16_t* O = slots;
  for (int e = blockIdx.x * NT + otid(); e < T * 128; e += gridDim.x * NT) {
    const int t = e >> 7, c = (e & 127) * 8; const size_t o = (size_t)t * 1024 + c; const int tl = t & Lmask;
    const u32x4 zz = {0u, 0u, 0u, 0u};
    const u32x4 c1 = *(const u32x4*)(CG + o), u1 = *(const u32x4*)(U + o);
    const u32x4 c0 = tl != 0 ? *(const u32x4*)(CG + o - 1024) : zz, u0 = tl != 0 ? *(const u32x4*)(U + o - 1024) : zz;
    const u32x4 c2 = tl != Lmask ? *(const u32x4*)(CG + o + 1024) : zz, u2 = tl != Lmask ? *(const u32x4*)(U + o + 1024) : zz;
    const u32x4 bg = *(const u32x4*)(BG + o), gg = *(const u32x4*)(G + o);
    const float* cw = p.in[30]; const float* cb = p.in[31];
    u32x4 w;
#pragma unroll
    for (int i = 0; i < 4; ++i) {
      const int ch = c + 2 * i;
      const float lo = bflo(bg[i]) * (cw[ch] * bflo(c0[i]) * bflo(u0[i]) + cw[1024 + ch] * bflo(c1[i]) * bflo(u1[i]) + cw[2048 + ch] * bflo(c2[i]) * bflo(u2[i]) + cb[ch]) * silu(bflo(gg[i]));
      const float hi = bfhi(bg[i]) * (cw[ch + 1] * bfhi(c0[i]) * bfhi(u0[i]) + cw[1024 + ch + 1] * bfhi(c1[i]) * bfhi(u1[i]) + cw[2048 + ch + 1] * bfhi(c2[i]) * bfhi(u2[i]) + cb[ch + 1]) * silu(bfhi(gg[i]));
      w[i] = pack2(lo, hi);
    }
    *(u32x4*)(O + o) = w;
  }
}

DI void phase_attn(const P& p, int g, unsigned char* lds) {
  const int tid = otid(), lane = tid & 63, wave = tid >> 6, r = lane & 31, h = lane >> 5;
  const int L = g ? 4096 : 256, Ltot = g ? 4352 : 256, B = g ? 4 : 32;
  const int nq = L >> 6, ntasks = B * 4 * nq, nkt = Ltot >> 6;
  bf16_t* slots = (bf16_t*)(p.ws + WS_SLOT);
  bf16_t* Q = slots + 2 * SLOT_ELEMS; const bf16_t* G = slots + 3 * SLOT_ELEMS;
  const bf16_t* Kb = slots + 4 * SLOT_ELEMS; const bf16_t* Vt = Kb + SLOT_ELEMS / 2;
  const float SC = 0.125f * 1.4426950408889634f;
  for (int task = blockIdx.x; task < ntasks; task += gridDim.x) {
    const int qt = task % nq, kvh = (task / nq) & 3, b = task / (nq * 4);
    const int head = kvh * 4 + (wave >> 1); const int q0 = qt * 64 + (wave & 1) * 32;
    const size_t tok = (size_t)b * L + q0 + r;
    bf16x8 qf[4];
#pragma unroll
    for (int ds = 0; ds < 4; ++ds) qf[ds] = *(const bf16x8*)(Q + tok * 1024 + head * 64 + ds * 16 + h * 8);
    float m = -1e30f, lsum = 0.f;
    f32x16 O0, O1;
#pragma unroll
    for (int i = 0; i < 16; ++i) { O0[i] = 0.f; O1[i] = 0.f; }
    const int lrow = tid >> 3, lc = (tid & 7) * 8;
    const bf16_t* gK = Kb + ((size_t)b * Ltot + lrow) * 256 + kvh * 64 + lc;
    const bf16_t* gV = Vt + ((size_t)(b * 4 + kvh) * 64 + lrow) * Ltot + lc;
    u32x4 rk = *(const u32x4*)gK, rv = *(const u32x4*)gV;
    *(u32x4*)(lds + lrow * 144 + lc * 2) = rk; *(u32x4*)(lds + 9216 + lrow * 144 + lc * 2) = rv;
    __syncthreads();
    for (int kt = 0; kt < nkt; ++kt) {
      const unsigned char* cur = lds + (kt & 1) * 18432; unsigned char* nxt = lds + ((kt + 1) & 1) * 18432;
      if (kt + 1 < nkt) { rk = *(const u32x4*)(gK + (size_t)(kt + 1) * 64 * 256); rv = *(const u32x4*)(gV + (kt + 1) * 64); }
      f32x16 s0, s1;
#pragma unroll
      for (int i = 0; i < 16; ++i) { s0[i] = 0.f; s1[i] = 0.f; }
#pragma unroll
      for (int ds = 0; ds < 4; ++ds) {
        const bf16x8 a0 = *(const bf16x8*)(cur + r * 144 + (ds * 16 + h * 8) * 2);
        const bf16x8 a1 = *(const bf16x8*)(cur + (32 + r) * 144 + (ds * 16 + h * 8) * 2);
        s0 = MFMA32(a0, qf[ds], s0); s1 = MFMA32(a1, qf[ds], s1);
      }
      float tmax = s0[0];
#pragma unroll
      for (int i = 1; i < 16; ++i) tmax = fmaxf(tmax, s0[i]);
#pragma unroll
      for (int i = 0; i < 16; ++i) tmax = fmaxf(tmax, s1[i]);
      tmax = fmaxf(tmax, __shfl_xor(tmax, 32));
      const float mnew = fmaxf(m, tmax * SC);
      const float alpha = __builtin_amdgcn_exp2f(m - mnew);
      float ps = 0.f;
#pragma unroll
      for (int i = 0; i < 16; ++i) { s0[i] = __builtin_amdgcn_exp2f(s0[i] * SC - mnew); s1[i] = __builtin_amdgcn_exp2f(s1[i] * SC - mnew); ps += s0[i] + s1[i]; }
      lsum = lsum * alpha + ps; m = mnew;
#pragma unroll
      for (int i = 0; i < 16; ++i) { O0[i] *= alpha; O1[i] *= alpha; }
      const unsigned char* vs = cur + 9216;
#pragma unroll
      for (int kb = 0; kb < 2; ++kb)
#pragma unroll
        for (int s = 0; s < 2; ++s) {
          u32x4 pk;
#pragma unroll
          for (int j = 0; j < 4; ++j) pk[j] = kb ? pack2(s1[8 * s + 2 * j], s1[8 * s + 2 * j + 1]) : pack2(s0[8 * s + 2 * j], s0[8 * s + 2 * j + 1]);
          const bf16x8 pf = __builtin_bit_cast(bf16x8, pk);
          const int ko = (32 * kb + 16 * s + 4 * h) * 2;
          { const u32x2 lo = *(const u32x2*)(vs + r * 144 + ko), hi = *(const u32x2*)(vs + r * 144 + ko + 16);
            u32x4 av; av[0] = lo[0]; av[1] = lo[1]; av[2] = hi[0]; av[3] = hi[1];
            O0 = MFMA32(__builtin_bit_cast(bf16x8, av), pf, O0); }
          { const u32x2 lo = *(const u32x2*)(vs + (32 + r) * 144 + ko), hi = *(const u32x2*)(vs + (32 + r) * 144 + ko + 16);
            u32x4 av; av[0] = lo[0]; av[1] = lo[1]; av[2] = hi[0]; av[3] = hi[1];
            O1 = MFMA32(__builtin_bit_cast(bf16x8, av), pf, O1); }
        }
      if (kt + 1 < nkt) { *(u32x4*)(nxt + lrow * 144 + lc * 2) = rk; *(u32x4*)(nxt + 9216 + lrow * 144 + lc * 2) = rv; }
      __syncthreads();
    }
    lsum += __shfl_xor(lsum, 32);
    const float inv = 1.f / lsum;
#pragma unroll
    for (int db = 0; db < 2; ++db)
#pragma unroll
      for (int i4 = 0; i4 < 4; ++i4) {
        const size_t o = tok * 1024 + head * 64 + 32 * db + 8 * i4 + 4 * h;
        const u32x2 gq = *(const u32x2*)(G + o);
        const float v0 = (db ? O1[4 * i4] : O0[4 * i4]) * inv, v1 = (db ? O1[4 * i4 + 1] : O0[4 * i4 + 1]) * inv;
        const float v2 = (db ? O1[4 * i4 + 2] : O0[4 * i4 + 2]) * inv, v3 = (db ? O1[4 * i4 + 3] : O0[4 * i4 + 3]) * inv;
        u32x2 w; w[0] = pack2(v0 * silu(bflo(gq[0])), v1 * silu(bfhi(gq[0]))); w[1] = pack2(v2 * silu(bflo(gq[1])), v3 * silu(bfhi(gq[1])));
        *(u32x2*)(slots + 5 * SLOT_ELEMS + o) = w;
      }
  }
}


#define XB_TMO      128
#define XB_XCNT(j)  (256  + 64 * (j))
#define XB_XSUB(j)  (1280 + 64 * (j))
#define XB_XGEN(j)  (2304 + 64 * (j))
#define XB_TOP      3328
#define XB_TOPGEN   3392
#define XCD_BAR_WORDS 3456
#define XB_SPIN_CAP (1u << 22)
#define LAS __attribute__((address_space(3)))
DI unsigned xb_ld(unsigned* p) { return __hip_atomic_load(p, __ATOMIC_RELAXED, __HIP_MEMORY_SCOPE_AGENT); }
DI unsigned xb_add(unsigned* p, unsigned v) { return __hip_atomic_fetch_add(p, v, __ATOMIC_RELAXED, __HIP_MEMORY_SCOPE_AGENT); }
DI unsigned xb_xcc_id() { return (unsigned)__builtin_amdgcn_s_getreg((3 << 11) | 20) & 0xFu; }
#define XB_SPIN(cond, bar) do { unsigned _sp = 0; while (cond) { __builtin_amdgcn_s_sleep(1); \
    if ((++_sp & 255u) == 0u) { if (xb_ld(&(bar)[XB_TMO])) break; if (_sp > XB_SPIN_CAP) { atomicAdd(&(bar)[XB_TMO], 1u); break; } } } } while (0)
struct XcdBarrier { unsigned* bar; unsigned x; volatile LAS unsigned* st; };
DI XcdBarrier xcd_barrier_post(unsigned* bar, volatile LAS unsigned* st) {
  XcdBarrier b; b.bar = bar; b.x = xb_xcc_id(); b.st = st;
  if (threadIdx.x == 0) (void)xb_add(&bar[XB_XCNT(b.x)], 1u);
  return b;
}
DI void xcd_barrier_complete(unsigned* bar, unsigned x, unsigned& nloc, unsigned& nx) {
  const unsigned G = gridDim.x * gridDim.y * gridDim.z;
  unsigned sum, cnt, mine, sp = 0u;
  for (;;) {
    sum = 0u; cnt = 0u; mine = 0u;
#pragma unroll
    for (unsigned j = 0; j < 16; ++j) { const unsigned c = xb_ld(&bar[XB_XCNT(j)]); sum += c; cnt += (c > 0u) ? 1u : 0u; mine = (j == x) ? c : mine; }
    if (sum == G) break;
    __builtin_amdgcn_s_sleep(1);
    if ((++sp & 255u) == 0u) { if (xb_ld(&bar[XB_TMO])) break; if (sp > XB_SPIN_CAP) { atomicAdd(&bar[XB_TMO], 1u); break; } }
  }
  nloc = mine > 0u ? mine : 1u; nx = cnt > 0u ? cnt : 1u;
}
DI void xcd_barrier(const XcdBarrier& b) {
  asm volatile("s_waitcnt vmcnt(0)" ::: "memory");
  __syncthreads();
  if (threadIdx.x == 0) {
    unsigned* bar = b.bar;
    __builtin_amdgcn_s_waitcnt(0);
    unsigned nloc = b.st[0], nx = b.st[1];
    if (nloc == 0u) { xcd_barrier_complete(bar, b.x, nloc, nx); b.st[0] = nloc; b.st[1] = nx; }
    const unsigned old = xb_add(&bar[XB_XSUB(b.x)], 1u);
    const unsigned gen = old / nloc;
    if (old + 1u == (gen + 1u) * nloc) {
      __builtin_amdgcn_fence(__ATOMIC_RELEASE, "agent");
      asm volatile("s_waitcnt vmcnt(0)" ::: "memory");
      const unsigned og = xb_add(&bar[XB_TOP], 1u);
      const unsigned tg = og / nx;
      if (og + 1u == (tg + 1u) * nx) xb_add(&bar[XB_TOPGEN], 1u);
      else XB_SPIN(xb_ld(&bar[XB_TOPGEN]) == tg, bar);
      __builtin_amdgcn_fence(__ATOMIC_ACQUIRE, "agent");
      xb_add(&bar[XB_XGEN(b.x)], 1u);
      asm volatile("s_waitcnt vmcnt(0)" ::: "memory");
    } else {
      XB_SPIN(xb_ld(&bar[XB_XGEN(b.x)]) == gen, bar);
      __builtin_amdgcn_fence(__ATOMIC_ACQUIRE, "agent");
      asm volatile("s_waitcnt vmcnt(0)" ::: "memory");
    }
  }
  __syncthreads();
}

__global__ void __launch_bounds__(NT) mega(P p) {
  extern __shared__ __attribute__((aligned(16))) unsigned char lds[];
  cg::grid_group grid = cg::this_grid();
  volatile LAS unsigned* st = (volatile LAS unsigned*)(lds + 135168);
  if (threadIdx.x < 4) st[threadIdx.x] = 0u;
  __syncthreads();
  const XcdBarrier xbar = xcd_barrier_post((unsigned*)(p.ws + WS_BAR), st);
  phase0(p, lds);
  grid.sync();
  const P& p0 = p;
  for (int step = 0; step < 50; ++step) {
    const int g = step / 25, rem = step - g * 25, layer = rem / 5, sub = rem - layer * 5;
    const int kind = layer % 3, jl = layer / 3;
    const int T = g ? 16384 : 8192, Lmask = g ? 4095 : 255;
    int op = -1;
    if (layer == 4) op = (sub == 0) ? 0 : -1;
    else if (sub == 0) op = 0;
    else if (kind == 0) op = sub == 1 ? 1 : (sub == 2 ? 2 : (sub == 3 ? 3 : 4));
    else if (kind == 1) op = sub == 1 ? 5 : (sub == 2 ? 6 : (sub == 3 ? 4 : -1));
    else op = sub == 1 ? 4 : (sub == 2 ? 7 : (sub == 3 ? 4 : -1));
    if (op < 0) continue;
    P p = p0;
    { unsigned char* w_ = p0.ws; float* o_ = p0.out; asm volatile("" : "+s"(w_), "+s"(o_)); p.ws = w_; p.out = o_; }
    bf16_t* slots = (bf16_t*)(p.ws + WS_SLOT);
    const bf16_t* W = (const bf16_t*)(p.ws + WS_W);
    if (op == 0) {
      const float* xin = p.in[g]; float* xout = p.out + (g ? OUT_YS : OUT_YP);
      phase_norm(p, g, layer - 1, layer < 4 ? layer : -1, layer <= 1 ? xin : xout, xout, slots + SLOT_ELEMS, slots);
      if (kind == 1 && g == 1 && layer < 4) phase_cache_copy(p);
    } else if (op == 1) {
      for (int rep = 0; rep < opq(REP_GEMM); ++rep) phase_gemm<1, 0>(p, g, slots, W + (size_t)(RW_IN0 + jl * RW_STRIDE) * 1024, T, 4352, p.in[11] + jl * 6144, Lmask, slots + SLOT_ELEMS, 1, lds);
    } else if (op == 2) {
      for (int rep = 0; rep < opq(REP_SCAN); ++rep) phase_scan(p, g, jl, lds);
    } else if (op == 3) {
      phase_rwkv_combine(p, g, jl);
    } else if (op == 4) {
      const bf16_t* A; const bf16_t* Bt; int N; bf16_t* dst;
      if (sub == 1) { A = slots; Bt = W + (size_t)CV_IN * 1024; N = 4096; dst = slots + 2 * SLOT_ELEMS; }
      else {
        N = 1024; dst = slots + SLOT_ELEMS;
        if (kind == 0) { A = slots + 4 * SLOT_ELEMS; Bt = W + (size_t)(RW_OUT0 + jl * RW_STRIDE) * 1024; }
        else if (kind == 1) { A = slots + 5 * SLOT_ELEMS; Bt = W + (size_t)AT_OUT * 1024; }
        else { A = slots; Bt = W + (size_t)CV_OUT * 1024; }
      }
      for (int rep = 0; rep < opq(REP_GEMM); ++rep) phase_gemm<0, 0>(p, g, A, Bt, T, N, nullptr, 0, dst, 0, lds);
    } else if (op == 5) {
      for (int rep = 0; rep < opq(REP_GEMM); ++rep) phase_gemm<0, 1>(p, g, slots, W + (size_t)AT_IN * 1024, T, 2560, nullptr, 0, nullptr, 0, lds);
    } else if (op == 6) {
      for (int rep = 0; rep < opq(REP_ATTN); ++rep) phase_attn(p, g, lds);
    } else {
      phase_conv(p, g);
    }
    if (!(g == 1 && layer == 4)) for (int rep = 0; rep < opq(REP_SYNC); ++rep) xcd_barrier(xbar);
  }
}

extern "C" void kernel_launch(void* const* d_in, const int* in_sizes, int n_in, void* d_out, int out_size, void* d_ws, size_t ws_size, hipStream_t stream) {
  static int grid_blocks = 0;
  if (!grid_blocks) {
    int dev = 0, cus = 0, per_cu = 0;
    hipGetDevice(&dev);
    hipDeviceGetAttribute(&cus, hipDeviceAttributeMultiprocessorCount, dev);
    hipFuncSetAttribute((const void*)mega, hipFuncAttributeMaxDynamicSharedMemorySize, LDS_BYTES);
    hipOccupancyMaxActiveBlocksPerMultiprocessor(&per_cu, (const void*)mega, NT, LDS_BYTES);
    if (per_cu < 1) per_cu = 1;
    if (per_cu > 1) per_cu = 1;
    grid_blocks = cus * per_cu;
    if (ws_size < WS_SLOT + 6 * SLOT_ELEMS * 2) fprintf(stderr, "workspace too small: %zu\n", ws_size);
  }
  (void)hipMemsetAsync((unsigned char*)d_ws + WS_BAR, 0, XCD_BAR_WORDS * sizeof(unsigned), stream);
  P p{};
  for (int i = 0; i < 33; ++i) p.in[i] = (const float*)d_in[i];
  p.out = (float*)d_out; p.ws = (unsigned char*)d_ws;
  void* args[] = {&p};
  hipError_t e = hipLaunchCooperativeKernel((const void*)mega, dim3(grid_blocks), dim3(NT), args, LDS_BYTES, stream);
  if (e != hipSuccess) fprintf(stderr, "cooperative launch failed: %s (grid %d)\n", hipGetErrorString(e), grid_blocks);
}
```

```cpp
#include <hip/hip_runtime.h>
#include <hip/hip_cooperative_groups.h>
#include <cstdio>
namespace cg = cooperative_groups;

typedef unsigned short bf16_t;
using bf16x8 = __attribute__((ext_vector_type(8))) short;
using f32x16 = __attribute__((ext_vector_type(16))) float;
using u32x4 = __attribute__((ext_vector_type(4))) unsigned;
using u32x2 = __attribute__((ext_vector_type(2))) unsigned;

#define NT 512
#ifndef REP_GEMM
#define REP_GEMM 1
#endif
#ifndef REP_SCAN
#define REP_SCAN 1
#endif
#ifndef REP_ATTN
#define REP_ATTN 1
#endif
#ifndef REP_SYNC
#define REP_SYNC 1
#endif
#define DI __device__ __forceinline__
#define MFMA32(a, b, c) __builtin_amdgcn_mfma_f32_32x32x16_bf16((a), (b), (c), 0, 0, 0)

struct P { const float* in[33]; float* out; unsigned char* ws; };

constexpr size_t WS_ADA = 0;
constexpr size_t WS_ROPE = 262144;
constexpr size_t WS_BON = 327680;
constexpr size_t WS_HID = WS_BON + 2097152;
constexpr size_t WS_W = WS_HID + 8388608;
constexpr size_t WS_SLOT = WS_W + 39845888;
constexpr size_t SLOT_ELEMS = (size_t)16384 * 1024;
constexpr int RW_IN0 = 0, RW_OUT0 = 4352, RW_STRIDE = 5376, AT_IN = 10752, AT_OUT = 13312, CV_IN = 14336, CV_OUT = 18432;
constexpr size_t OUT_YP = 0, OUT_YS = 8388608, OUT_ST = 25165824, OUT_CK = 33554432, OUT_CV = 35651584;
constexpr int LDS_BYTES = 135168 + 16;
constexpr size_t WS_BAR = 278528;

typedef __bf16 bf16x2_t __attribute__((ext_vector_type(2)));
typedef float f32x2_t __attribute__((ext_vector_type(2)));
DI unsigned pack2(float a, float b) { f32x2_t v = {a, b}; return __builtin_bit_cast(unsigned, __builtin_convertvector(v, bf16x2_t)); }
DI unsigned f2bf(float x) { return (unsigned)__builtin_bit_cast(unsigned short, (__bf16)x); }
DI float bflo(unsigned u) { return __uint_as_float(u << 16); }
DI float bfhi(unsigned u) { return __uint_as_float(u & 0xffff0000u); }
DI float bf1(bf16_t u) { return __uint_as_float(((unsigned)u) << 16); }

template <int CTRL> DI float dppf(float v) { return __int_as_float(__builtin_amdgcn_update_dpp(0, __float_as_int(v), CTRL, 0xF, 0xF, true)); }
DI float reduce16(float v) { v += dppf<0xB1>(v); v += dppf<0x4E>(v); v += dppf<0x141>(v); v += dppf<0x140>(v); return v; }
DI float wave_sum(float v) { v = reduce16(v); v += __shfl_xor(v, 16); v += __shfl_xor(v, 32); return v; }
DI float quad_sum(float v) { v += dppf<0xB1>(v); v += dppf<0x4E>(v); return v; }
DI float silu(float x) { return x / (1.f + __expf(-x)); }
DI int opq(int v) { asm volatile("" : "+s"(v)); return v; }
DI int otid() { int t = threadIdx.x; asm volatile("" : "+v"(t)); return t; }

DI void conv_tiles(const float* __restrict__ src, int N, bf16_t* __restrict__ dst, float* lds) {
  const int tid = otid();
  const int tilesN = N >> 6, ntiles = 16 * tilesN;
  for (int tile = blockIdx.x; tile < ntiles; tile += gridDim.x) {
    const int kt = tile / tilesN, nt = tile - kt * tilesN, k0 = kt * 64, n0 = nt * 64;
#pragma unroll
    for (int i = 0; i < 8; ++i) { const int k = (tid >> 6) + 8 * i, n = tid & 63; lds[k * 65 + n] = src[(size_t)(k0 + k) * N + n0 + n]; }
    __syncthreads();
    { const int n = tid >> 3, kc = (tid & 7) * 8; u32x4 o;
#pragma unroll
      for (int j = 0; j < 4; ++j) o[j] = pack2(lds[(kc + 2 * j) * 65 + n], lds[(kc + 2 * j + 1) * 65 + n]);
      *(u32x4*)(dst + (size_t)(n0 + n) * 1024 + k0 + kc) = o; }
    __syncthreads();
  }
}

DI void phase0(const P& p, unsigned char* ldsb) {
  float* lds = (float*)ldsb;
  const int tid = otid();
  bf16_t* W = (bf16_t*)(p.ws + WS_W);
#pragma unroll 1
  for (int e = 0; e < opq(22); ++e) {
    const float* src; int N, drow;
    if (e < 18) {
      const int j = e / 9, q = e - j * 9;
      if (q < 4) { src = p.in[12] + (size_t)(j * 4 + q) * 1048576; N = 1024; drow = RW_IN0 + j * RW_STRIDE + q * 1024; }
      else if (q < 6) { src = p.in[14] + (size_t)(j * 2 + q - 4) * 65536; N = 64; drow = RW_IN0 + j * RW_STRIDE + 4096 + (q - 4) * 64; }
      else if (q < 8) { src = p.in[17] + (size_t)(j * 2 + q - 6) * 65536; N = 64; drow = RW_IN0 + j * RW_STRIDE + 4224 + (q - 6) * 64; }
      else { src = p.in[24] + (size_t)j * 1048576; N = 1024; drow = RW_OUT0 + j * RW_STRIDE; }
    } else if (e == 18) { src = p.in[25]; N = 2560; drow = AT_IN; }
    else if (e == 19) { src = p.in[28]; N = 1024; drow = AT_OUT; }
    else if (e == 20) { src = p.in[29]; N = 4096; drow = CV_IN; }
    else { src = p.in[32]; N = 1024; drow = CV_OUT; }
    conv_tiles(src, N, W + (size_t)drow * 1024, lds);
  }
  {
    float* scond = lds;
    float* red = lds + 5120;
    for (int e = tid; e < 5120; e += NT) { const int cnd = e >> 10, k = e & 1023; const float cv = cnd == 0 ? p.in[6][k] : p.in[5][(cnd - 1) * 1024 + k]; scond[e] = silu(cv); }
    __syncthreads();
    float* ada = (float*)(p.ws + WS_ADA);
    for (int task = blockIdx.x; task < 192; task += gridDim.x) {
      const int layer = task / 48, n0 = (task % 48) * 64, c = tid & 63, kg = tid >> 6;
      float a0 = 0.f, a1 = 0.f, a2 = 0.f, a3 = 0.f, a4 = 0.f;
      const float* wp = p.in[9] + ((size_t)layer * 1024 + kg * 128) * 3072 + n0 + c;
#pragma unroll 8
      for (int k = 0; k < 128; ++k) { const float w = wp[(size_t)k * 3072]; const int kk = kg * 128 + k;
        a0 += scond[kk] * w; a1 += scond[1024 + kk] * w; a2 += scond[2048 + kk] * w; a3 += scond[3072 + kk] * w; a4 += scond[4096 + kk] * w; }
      red[(kg * 5 + 0) * 64 + c] = a0; red[(kg * 5 + 1) * 64 + c] = a1; red[(kg * 5 + 2) * 64 + c] = a2; red[(kg * 5 + 3) * 64 + c] = a3; red[(kg * 5 + 4) * 64 + c] = a4;
      __syncthreads();
      if (tid < 320) { const int cnd = tid >> 6; float s = p.in[10][layer * 3072 + n0 + c];
#pragma unroll
        for (int q = 0; q < 8; ++q) s += red[(q * 5 + cnd) * 64 + c];
        ada[(cnd * 4 + layer) * 3072 + n0 + c] = s; }
      __syncthreads();
    }
  }
  if (blockIdx.x == gridDim.x - 1) {
    float* rope = (float*)(p.ws + WS_ROPE);
    for (int e = tid; e < 1024; e += NT) {
      const int pos = e >> 4, f = e & 15;
      double inv = 1.0; for (int q = 0; q < f; ++q) inv *= 0.5623413251903491;
      double ang = (double)pos * inv;
      const double twopi = 6.283185307179586476925286766559;
      double n = __builtin_rint(ang / twopi); double rr = ang - n * twopi;
      double r2 = rr * rr, sn = 0.0, cs = 0.0, ts = rr, tc = 1.0;
      for (int q = 0; q < 16; ++q) { cs += tc; sn += ts; tc = -tc * r2 / (double)((2 * q + 1) * (2 * q + 2)); ts = -ts * r2 / (double)((2 * q + 2) * (2 * q + 3)); }
      rope[e * 2] = (float)cs; rope[e * 2 + 1] = (float)sn;
    }
  }
}

DI void phase_norm(const P& p, int g, int lpost, int lpre, const float* __restrict__ xsrc, float* __restrict__ xdst,
                   const bf16_t* __restrict__ Mb, bf16_t* __restrict__ H) {
  const int T = g ? 16384 : 8192;
  const int tid = otid(); const int lane = tid & 63, wave = tid >> 6;
  const float* ada = (const float*)(p.ws + WS_ADA);
  for (int t = blockIdx.x * 8 + wave; t < T; t += gridDim.x * 8) {
    const int cond = g ? 1 + (t >> 12) : 0;
    float4 x[4];
#pragma unroll
    for (int i = 0; i < 4; ++i) x[i] = *(const float4*)(xsrc + (size_t)t * 1024 + 256 * i + 4 * lane);
    if (lpost >= 0) {
      float m[16]; float ss = 0.f;
#pragma unroll
      for (int i = 0; i < 4; ++i) { const u32x2 u = *(const u32x2*)(Mb + (size_t)t * 1024 + 256 * i + 4 * lane);
        m[4 * i] = bflo(u[0]); m[4 * i + 1] = bfhi(u[0]); m[4 * i + 2] = bflo(u[1]); m[4 * i + 3] = bfhi(u[1]); }
#pragma unroll
      for (int i = 0; i < 16; ++i) ss += m[i] * m[i];
      ss = wave_sum(ss);
      const float rs = rsqrtf(ss * (1.f / 1024.f) + 1e-6f);
      const float* gate = ada + (cond * 4 + lpost) * 3072 + 2048;
      const float* wpo = p.in[8] + lpost * 1024;
#pragma unroll
      for (int i = 0; i < 4; ++i) { const int c = 256 * i + 4 * lane; const float4 gt = *(const float4*)(gate + c); const float4 wv = *(const float4*)(wpo + c);
        x[i].x += gt.x * (m[4 * i] * rs * wv.x); x[i].y += gt.y * (m[4 * i + 1] * rs * wv.y); x[i].z += gt.z * (m[4 * i + 2] * rs * wv.z); x[i].w += gt.w * (m[4 * i + 3] * rs * wv.w);
        *(float4*)(xdst + (size_t)t * 1024 + c) = x[i]; }
    }
    if (lpre >= 0) {
      float ss = 0.f;
#pragma unroll
      for (int i = 0; i < 4; ++i) ss += x[i].x * x[i].x + x[i].y * x[i].y + x[i].z * x[i].z + x[i].w * x[i].w;
      ss = wave_sum(ss);
      const float rs = rsqrtf(ss * (1.f / 1024.f) + 1e-6f);
      const float* sh = ada + (cond * 4 + lpre) * 3072; const float* sc = sh + 1024; const float* wpr = p.in[7] + lpre * 1024;
#pragma unroll
      for (int i = 0; i < 4; ++i) { const int c = 256 * i + 4 * lane; const float4 s4 = *(const float4*)(sh + c); const float4 c4 = *(const float4*)(sc + c); const float4 wv = *(const float4*)(wpr + c);
        u32x2 o; o[0] = pack2(x[i].x * rs * wv.x * (1.f + c4.x) + s4.x, x[i].y * rs * wv.y * (1.f + c4.y) + s4.y);
        o[1] = pack2(x[i].z * rs * wv.z * (1.f + c4.z) + s4.z, x[i].w * rs * wv.w * (1.f + c4.w) + s4.w);
        *(u32x2*)(H + (size_t)t * 1024 + c) = o; }
    }
  }
}

DI void phase_cache_copy(const P& p) {
  bf16_t* Kb = (bf16_t*)(p.ws + WS_SLOT) + 4 * SLOT_ELEMS; bf16_t* Vt = Kb + SLOT_ELEMS / 2;
  for (int e = blockIdx.x * NT + otid(); e < 262144; e += gridDim.x * NT) {
    const int c = e & 255, pp = (e >> 8) & 255, b = e >> 16; const int kvh = c >> 6, d = c & 63;
    Kb[((size_t)b * 4352 + 4096 + pp) * 256 + c] = (bf16_t)f2bf(p.in[3][e]);
    Vt[((size_t)(b * 4 + kvh) * 64 + d) * 4352 + 4096 + pp] = (bf16_t)f2bf(p.in[4][e]);
  }
}

template <int SHIFT> DI void ld_half(const bf16_t* __restrict__ A, int t, int k, int Lmask, u32x4 (&raw)[4]) {
  raw[1] = *(const u32x4*)(A + (size_t)t * 1024 + k);
  raw[2] = *(const u32x4*)(A + (size_t)(t + 1) * 1024 + k);
  if (SHIFT) {
    raw[0] = (u32x4){0u, 0u, 0u, 0u}; raw[3] = (u32x4){0u, 0u, 0u, 0u};
    if ((t & Lmask) != 0) raw[0] = *(const u32x4*)(A + (size_t)(t - 1) * 1024 + k);
    if (((t + 1) & Lmask) != Lmask) raw[3] = *(const u32x4*)(A + (size_t)(t + 2) * 1024 + k);
  }
}
DI u32x4 mix3(const u32x4& c, const u32x4& pz, const u32x4& nz, const float* smu, int k) {
  const float4 m0 = *(const float4*)(smu + k), m1 = *(const float4*)(smu + k + 4);
  const float mu[8] = {m0.x, m0.y, m0.z, m0.w, m1.x, m1.y, m1.z, m1.w};
  u32x4 o;
#pragma unroll
  for (int i = 0; i < 4; ++i) {
    const float h0 = bflo(c[i]), h1 = bfhi(c[i]);
    const float x0 = h0 + (0.5f * (bflo(pz[i]) + bflo(nz[i])) - h0) * mu[2 * i];
    const float x1 = h1 + (0.5f * (bfhi(pz[i]) + bfhi(nz[i])) - h1) * mu[2 * i + 1];
    o[i] = pack2(x0, x1);
  }
  return o;
}
template <int SHIFT> DI void st_half(unsigned char* dst, const u32x4 (&raw)[4], const float* smu, int k) {
  if (!SHIFT) { *(u32x4*)dst = raw[1]; *(u32x4*)(dst + 144) = raw[2]; }
  else { *(u32x4*)dst = mix3(raw[1], raw[0], raw[2], smu, k); *(u32x4*)(dst + 144) = mix3(raw[2], raw[1], raw[3], smu, k); }
}

template <int SHIFT, int EPI>
DI void phase_gemm(const P& p, int g, const bf16_t* __restrict__ A, const bf16_t* __restrict__ Bt, int M, int N,
                   const float* __restrict__ mu, int Lmask, bf16_t* __restrict__ dst, int rw, unsigned char* lds) {
  const int tid = otid(), lane = tid & 63, wave = tid >> 6;
  const int wm = wave >> 1, wn = wave & 1, r = lane & 31, h = lane >> 5;
  const int ntn = N >> 7, ntiles = ntn * (M >> 8);
  float* Cs = (float*)lds;
  float* smu = (float*)(lds + 110592);
  for (int tile = blockIdx.x; tile < ntiles; tile += gridDim.x) {
    const int mt = tile / ntn, nt = tile - mt * ntn; const int m0 = mt * 256, n0 = nt * 128;
    f32x16 acc[2][2];
#pragma unroll
    for (int a = 0; a < 2; ++a)
#pragma unroll
      for (int b = 0; b < 2; ++b)
#pragma unroll
        for (int i = 0; i < 16; ++i) acc[a][b][i] = 0.f;
    if (SHIFT) {
      const float* mup = mu + (nt < 32 ? (nt >> 3) : (nt == 32 ? 4 : 5)) * 1024;
      smu[tid] = mup[tid]; smu[tid + 512] = mup[tid + 512];
      __syncthreads();
    }
    u32x4 raw[4], rb[2];
    const int arow = 4 * (tid >> 3), akc = (tid & 7) * 8;
#pragma unroll
    for (int hf = 0; hf < 2; ++hf) { ld_half<SHIFT>(A, m0 + arow + 2 * hf, akc, Lmask, raw); st_half<SHIFT>(lds + (arow + 2 * hf) * 144 + akc * 2, raw, smu, akc); }
#pragma unroll
    for (int i = 0; i < 2; ++i) { const int id = tid + 512 * i; rb[i] = *(const u32x4*)(Bt + (size_t)(n0 + (id >> 3)) * 1024 + (id & 7) * 8); }
#pragma unroll
    for (int i = 0; i < 2; ++i) { const int id = tid + 512 * i; *(u32x4*)(lds + 36864 + (id >> 3) * 144 + (id & 7) * 16) = rb[i]; }
    __syncthreads();
    for (int kt = 0; kt < 16; ++kt) {
      unsigned char* cur = lds + (kt & 1) * 55296; unsigned char* nxt = lds + ((kt + 1) & 1) * 55296;
      const int k1 = (kt + 1) * 64;
      if (kt < 15) {
        ld_half<SHIFT>(A, m0 + arow, k1 + akc, Lmask, raw);
        rb[0] = *(const u32x4*)(Bt + (size_t)(n0 + (tid >> 3)) * 1024 + k1 + (tid & 7) * 8);
      }
#pragma unroll
      for (int ks = 0; ks < 4; ++ks) {
        const int ko = (ks * 16 + h * 8) * 2;
        const bf16x8 a0 = *(const bf16x8*)(cur + (wm * 64 + r) * 144 + ko);
        const bf16x8 a1 = *(const bf16x8*)(cur + (wm * 64 + 32 + r) * 144 + ko);
        const bf16x8 b0 = *(const bf16x8*)(cur + 36864 + (wn * 64 + r) * 144 + ko);
        const bf16x8 b1 = *(const bf16x8*)(cur + 36864 + (wn * 64 + 32 + r) * 144 + ko);
        acc[0][0] = MFMA32(a0, b0, acc[0][0]); acc[0][1] = MFMA32(a0, b1, acc[0][1]);
        acc[1][0] = MFMA32(a1, b0, acc[1][0]); acc[1][1] = MFMA32(a1, b1, acc[1][1]);
        if (ks == 1 && kt < 15) {
          st_half<SHIFT>(nxt + arow * 144 + akc * 2, raw, smu, k1 + akc);
          *(u32x4*)(nxt + 36864 + (tid >> 3) * 144 + (tid & 7) * 16) = rb[0];
          ld_half<SHIFT>(A, m0 + arow + 2, k1 + akc, Lmask, raw);
          rb[0] = *(const u32x4*)(Bt + (size_t)(n0 + 64 + (tid >> 3)) * 1024 + k1 + (tid & 7) * 8);
        }
      }
      if (kt < 15) {
        st_half<SHIFT>(nxt + (arow + 2) * 144 + akc * 2, raw, smu, k1 + akc);
        *(u32x4*)(nxt + 36864 + (64 + (tid >> 3)) * 144 + (tid & 7) * 16) = rb[0];
      }
      __syncthreads();
    }
#pragma unroll
    for (int mi = 0; mi < 2; ++mi)
#pragma unroll
      for (int ni = 0; ni < 2; ++ni)
#pragma unroll
        for (int i = 0; i < 16; ++i) {
          const int row = wm * 64 + mi * 32 + (i & 3) + 8 * (i >> 2) + 4 * h, col = wn * 64 + ni * 32 + r;
          Cs[row * 132 + col] = acc[mi][ni][i];
        }
    __syncthreads();
    if (EPI == 0) {
#pragma unroll
      for (int i = 0; i < 8; ++i) {
        const int id = tid + 512 * i, row = id >> 4, cc = (id & 15) * 8;
        float4 v0 = *(const float4*)(Cs + row * 132 + cc), v1 = *(const float4*)(Cs + row * 132 + cc + 4);
        if (rw && nt == 32) { v0.x = tanhf(v0.x); v0.y = tanhf(v0.y); v0.z = tanhf(v0.z); v0.w = tanhf(v0.w); v1.x = tanhf(v1.x); v1.y = tanhf(v1.y); v1.z = tanhf(v1.z); v1.w = tanhf(v1.w); }
        u32x4 o; o[0] = pack2(v0.x, v0.y); o[1] = pack2(v0.z, v0.w); o[2] = pack2(v1.x, v1.y); o[3] = pack2(v1.z, v1.w);
        if (rw && nt >= 32) *(u32x4*)((bf16_t*)(p.ws + WS_HID) + (size_t)(m0 + row) * 256 + (nt - 32) * 128 + cc) = o;
        else *(u32x4*)(dst + (size_t)(nt >> 3) * SLOT_ELEMS + (size_t)(m0 + row) * 1024 + (nt & 7) * 128 + cc) = o;
      }
    } else {
      const int row = tid & 255, hh = tid >> 8; const int t = m0 + row;
      float x[64];
#pragma unroll
      for (int q = 0; q < 16; ++q) { const float4 v = *(const float4*)(Cs + row * 132 + hh * 64 + 4 * q); x[4 * q] = v.x; x[4 * q + 1] = v.y; x[4 * q + 2] = v.z; x[4 * q + 3] = v.w; }
      bf16_t* slots = (bf16_t*)(p.ws + WS_SLOT);
      const int L = g ? 4096 : 256, Ltot = g ? 4352 : 256;
      const int b = g ? (t >> 12) : (t >> 8), s = t & (L - 1);
      if (nt < 10) {
        int vz = 0; asm volatile("" : "+v"(vz));
        const float* nw = (nt < 8 ? p.in[26] : p.in[27]) + vz;
        float ss = 0.f;
#pragma unroll
        for (int d = 0; d < 64; ++d) ss += x[d] * x[d];
        const float rs = rsqrtf(ss * (1.f / 64.f) + 1e-6f);
#pragma unroll
        for (int d = 0; d < 64; ++d) x[d] *= rs * nw[d];
        if (g == 0 && nt >= 8) {
          float* ck = p.out + OUT_CK + (size_t)t * 256 + ((nt - 8) * 2 + hh) * 64;
#pragma unroll
          for (int q = 0; q < 16; ++q) *(float4*)(ck + 4 * q) = make_float4(x[4 * q], x[4 * q + 1], x[4 * q + 2], x[4 * q + 3]);
        }
        if (g == 1) {
          const float2* rope = (const float2*)(p.ws + WS_ROPE);
          const int ri = s >> 6, ci = s & 63;
#pragma unroll
          for (int f = 0; f < 16; ++f) {
            const float2 cr = rope[ri * 16 + f]; const float x1 = x[f], x2 = x[16 + f];
            x[f] = x1 * cr.x - x2 * cr.y; x[16 + f] = x2 * cr.x + x1 * cr.y;
            const float2 cc = rope[ci * 16 + f]; const float y1 = x[32 + f], y2 = x[48 + f];
            x[32 + f] = y1 * cc.x - y2 * cc.y; x[48 + f] = y2 * cc.x + y1 * cc.y;
          }
        }
        bf16_t* dq = nt < 8 ? slots + 2 * SLOT_ELEMS + (size_t)t * 1024 + (nt * 2 + hh) * 64
                            : slots + 4 * SLOT_ELEMS + ((size_t)b * Ltot + s) * 256 + ((nt - 8) * 2 + hh) * 64;
#pragma unroll
        for (int q = 0; q < 8; ++q) { u32x4 o; o[0] = pack2(x[8 * q], x[8 * q + 1]); o[1] = pack2(x[8 * q + 2], x[8 * q + 3]); o[2] = pack2(x[8 * q + 4], x[8 * q + 5]); o[3] = pack2(x[8 * q + 6], x[8 * q + 7]); *(u32x4*)(dq + 8 * q) = o; }
      } else if (nt < 12) {
        const int kvh = (nt - 10) * 2 + hh;
        if (g == 0) {
          float* cv = p.out + OUT_CV + (size_t)t * 256 + kvh * 64;
#pragma unroll
          for (int q = 0; q < 16; ++q) *(float4*)(cv + 4 * q) = make_float4(x[4 * q], x[4 * q + 1], x[4 * q + 2], x[4 * q + 3]);
        }
        bf16_t* vt = slots + 4 * SLOT_ELEMS + SLOT_ELEMS / 2 + ((size_t)(b * 4 + kvh) * 64) * Ltot + s;
#pragma unroll
        for (int d = 0; d < 64; ++d) { *vt = (bf16_t)f2bf(x[d]); vt += Ltot; asm volatile("" : "+v"(vt)); }
      } else {
        bf16_t* dg = slots + 3 * SLOT_ELEMS + (size_t)t * 1024 + (nt - 12) * 128 + hh * 64;
#pragma unroll
        for (int q = 0; q < 8; ++q) { u32x4 o; o[0] = pack2(x[8 * q], x[8 * q + 1]); o[1] = pack2(x[8 * q + 2], x[8 * q + 3]); o[2] = pack2(x[8 * q + 4], x[8 * q + 5]); o[3] = pack2(x[8 * q + 6], x[8 * q + 7]); *(u32x4*)(dg + 8 * q) = o; }
      }
    }
    __syncthreads();
  }
}

DI u32x4 cat8(const u32x2 lo, const u32x2 hi) { u32x4 v; v[0] = lo[0]; v[1] = lo[1]; v[2] = hi[0]; v[3] = hi[1]; return v; }
DI void phase_scan(const P& p, int g, int jl, unsigned char* lds) {
  const int tid = otid(), lane = tid & 63, wave = tid >> 6, r = lane & 31, h = lane >> 5;
  const int L = g ? 4096 : 256, B = g ? 4 : 32, nsc = L >> 5;
  float* sR = (float*)lds; float* sW = sR + 2048; float* sKD = sW + 2048; float* sKK = sKD + 2048; float* sKKA = sKK + 2048;
  bf16_t* sHW = (bf16_t*)(lds + 40960); bf16_t* sHA = (bf16_t*)(lds + 45568);
  bf16_t* oAL = (bf16_t*)(lds + 50176); bf16_t* oRH = (bf16_t*)(lds + 54784); bf16_t* oBE = (bf16_t*)(lds + 59392); bf16_t* oGA = (bf16_t*)(lds + 64000);
  bf16_t* oBEt = (bf16_t*)(lds + 68608); bf16_t* oGAt = (bf16_t*)(lds + 73728); bf16_t* oUt = (bf16_t*)(lds + 78848); bf16_t* oZt = (bf16_t*)(lds + 83968);
  float* Bm = (float*)(lds + 89088); float* RHS = (float*)(lds + 93696); float* lamC = (float*)(lds + 101888); float* sP = (float*)(lds + 102144);
  unsigned char* frag = lds + 104192;
  const bf16_t* slots = (const bf16_t*)(p.ws + WS_SLOT);
  const bf16_t* Rg = slots + 1 * SLOT_ELEMS; const bf16_t* Kg = slots + 2 * SLOT_ELEMS; const bf16_t* Vg = slots + 3 * SLOT_ELEMS;
  const bf16_t* hid = (const bf16_t*)(p.ws + WS_HID);
  float* bon = (float*)(p.ws + WS_BON);
  const int ntasks = B * 32;
  for (int task = blockIdx.x; task < ntasks; task += gridDim.x) {
    const int z = task & 1, head = (task >> 1) & 15, b = task >> 5;
    bf16_t* Yg = (bf16_t*)(p.ws + WS_SLOT) + (z ? 0 : 5) * SLOT_ELEMS;
    const int mat = (wave >> 1) & 1, ntt = wave & 1;
    unsigned char* lfr = lds + 110336 + (wave & 3) * 4096;
    if (wave < 4) {
      const float* W2 = (mat ? p.in[18] : p.in[15]) + (size_t)(jl * 2 + z) * 65536 + head * 64 + 32 * ntt + r;
#pragma unroll
      for (int kk = 0; kk < 4; ++kk) { u32x4 pk;
#pragma unroll
        for (int j = 0; j < 4; ++j) pk[j] = pack2(W2[(size_t)(16 * kk + 8 * h + 2 * j) * 1024], W2[(size_t)(16 * kk + 8 * h + 2 * j + 1) * 1024]);
        *(u32x4*)(lfr + (kk * 64 + lane) * 16) = pk; }
    }
    const float bias = (mat ? p.in[16] : p.in[13])[(jl * 2 + z) * 1024 + head * 64 + 32 * ntt + r];
    const float kkc = p.in[19][jl * 1024 + head * 64 + lane], kac = p.in[20][jl * 1024 + head * 64 + lane], rkc = p.in[21][jl * 1024 + head * 64 + lane];
    f32x16 st0, st1;
#pragma unroll
    for (int q = 0; q < 16; ++q) { st0[q] = 0.f; st1[q] = 0.f; }
    const size_t stbase = ((((size_t)(b * 2 + jl) * 2 + z) * 16 + head) * 64 + (32 * (wave & 1) + r)) * 64;
    if (g && wave < 2) {
#pragma unroll
      for (int gq = 0; gq < 4; ++gq) {
        const float4 s0 = *(const float4*)(p.in[2] + stbase + 8 * gq + 4 * h), s1 = *(const float4*)(p.in[2] + stbase + 32 + 8 * gq + 4 * h);
        st0[4 * gq] = s0.x; st0[4 * gq + 1] = s0.y; st0[4 * gq + 2] = s0.z; st0[4 * gq + 3] = s0.w;
        st1[4 * gq] = s1.x; st1[4 * gq + 1] = s1.y; st1[4 * gq + 2] = s1.z; st1[4 * gq + 3] = s1.w;
      }
    }
    u32x4 pre[3];
#define SCAN_LOAD(sc_)                                                                                    \
    _Pragma("unroll") for (int i = 0; i < 3; ++i) {                                                       \
      const int id = tid + 512 * i;                                                                       \
      if (id < 1280) {                                                                                    \
        const int arr = id >> 8, s = (id >> 3) & 31, cc = (id & 7) * 8;                                   \
        const int tl = z ? (L - 1 - ((sc_) * 32 + s)) : ((sc_) * 32 + s);                                 \
        const size_t tok = (size_t)b * L + tl;                                                            \
        if (arr < 3) pre[i] = *(const u32x4*)((arr == 0 ? Rg : (arr == 1 ? Kg : Vg)) + tok * 1024 + head * 64 + cc); \
        else pre[i] = *(const u32x4*)(hid + tok * 256 + (arr - 3) * 128 + z * 64 + cc);                   \
      }                                                                                                   \
    }
    SCAN_LOAD(0)
    for (int sc = 0; sc < nsc; ++sc) {
      {
      const int tid = otid(), lane = tid & 63, wave = tid >> 6, r = lane & 31, h = lane >> 5; (void)r; (void)h; (void)lane; (void)wave;
#pragma unroll
      for (int i = 0; i < 3; ++i) {
        const int id = tid + 512 * i;
        if (id < 1280) {
          const int arr = id >> 8, s = (id >> 3) & 31, cc = (id & 7) * 8;
          const u32x4 u = pre[i];
          if (arr < 2) { float* d = (arr == 0 ? sR : sKD) + s * 64 + cc;
            *(float4*)d = make_float4(bflo(u[0]), bfhi(u[0]), bflo(u[1]), bfhi(u[1])); *(float4*)(d + 4) = make_float4(bflo(u[2]), bfhi(u[2]), bflo(u[3]), bfhi(u[3])); }
          else if (arr == 2) {
#pragma unroll
            for (int j = 0; j < 4; ++j) { oUt[(cc + 2 * j) * 40 + s] = (bf16_t)(u[j] & 0xffffu); oUt[(cc + 2 * j + 1) * 40 + s] = (bf16_t)(u[j] >> 16); }
          } else *(u32x4*)((arr == 3 ? sHW : sHA) + s * 72 + cc) = u;
        }
      }
      }
      __syncthreads();
      if (sc + 1 < nsc) { SCAN_LOAD(sc + 1) }
      {
      const int tid = otid(), lane = tid & 63, wave = tid >> 6, r = lane & 31, h = lane >> 5; (void)r; (void)h; (void)lane; (void)wave;
      {
        f32x16 acc;
#pragma unroll
        for (int i = 0; i < 16; ++i) acc[i] = 0.f;
        const int mat = (wave >> 1) & 1, ntt = wave & 1, hi8 = wave >> 2;
        const bf16_t* sH = mat ? sHA : sHW;
#pragma unroll
        for (int kk = 0; kk < 4; ++kk) { const bf16x8 a = *(const bf16x8*)(sH + r * 72 + 16 * kk + 8 * h); const bf16x8 bw = *(const bf16x8*)(lfr + (kk * 64 + lane) * 16); acc = MFMA32(a, bw, acc); }
#pragma unroll
        for (int i = 0; i < 16; ++i) {
          if ((i >> 3) != hi8) continue;
          const int srow = (i & 3) + 8 * (i >> 2) + 4 * h, c = 32 * ntt + r;
          const float xv = acc[i] + bias;
          if (mat == 0) { const float nl = -xv; const float sp = fmaxf(nl, 0.f) + __logf(1.f + __expf(-fabsf(nl))); sW[srow * 64 + c] = __expf(-__expf(-sp - 0.5f)); }
          else sKKA[srow * 64 + c] = 1.f / (1.f + __expf(-xv));
        }
      }
      }
      __syncthreads();
      {
      const int tid = otid(), lane = tid & 63, wave = tid >> 6, r = lane & 31, h = lane >> 5; (void)r; (void)h; (void)lane; (void)wave;
#pragma unroll
      for (int i = 0; i < 4; ++i) {
        const int s = wave + 8 * i; const int c = lane;
        const float kraw = sKD[s * 64 + c], a = sKKA[s * 64 + c], rr = sR[s * 64 + c];
        const float pk = kraw * kkc; const float ss = wave_sum(pk * pk);
        const float kk = pk * rsqrtf(fmaxf(ss, 1e-24f));
        const float kd = kraw * (1.f + (a - 1.f) * kac);
        const float bs = wave_sum(rr * kd * rkc);
        sKD[s * 64 + c] = kd; sKK[s * 64 + c] = kk; sKKA[s * 64 + c] = kk * a;
        if (c == 0) { const int tl = z ? (L - 1 - (sc * 32 + s)) : (sc * 32 + s); bon[(((size_t)b * L + tl) * 16 + head) * 2 + z] = bs; }
      }
      }
      __syncthreads();
      {
        const int k = lane, tq = wave;
        float wq[4];
#pragma unroll
        for (int j = 0; j < 4; ++j) wq[j] = sW[(4 * tq + j) * 64 + k];
        sP[tq * 64 + k] = (wq[0] * wq[1]) * (wq[2] * wq[3]);
        __syncthreads();
        float lam = 1.f;
#pragma unroll
        for (int q = 0; q < 7; ++q) { const float pq = sP[q * 64 + k]; lam *= (q < tq) ? pq : 1.f; }
        u32x2 bt, gt; float nb[4], gg[4];
#pragma unroll
        for (int j = 0; j < 4; ++j) {
          const int t = 4 * tq + j;
          const float lamp = lam; lam = lamp * wq[j];
          const float inv = __builtin_amdgcn_rcpf(lam);
          const float al = lamp * sKK[t * 64 + k], be = sKKA[t * 64 + k] * inv, ga = sKD[t * 64 + k] * inv, rh = lam * sR[t * 64 + k];
          oAL[t * 72 + k] = (bf16_t)f2bf(al); oRH[t * 72 + k] = (bf16_t)f2bf(rh); oBE[t * 72 + k] = (bf16_t)f2bf(be); oGA[t * 72 + k] = (bf16_t)f2bf(ga);
          nb[j] = -be; gg[j] = ga;
        }
        bt[0] = pack2(nb[0], nb[1]); bt[1] = pack2(nb[2], nb[3]); gt[0] = pack2(gg[0], gg[1]); gt[1] = pack2(gg[2], gg[3]);
        *(u32x2*)(oBEt + k * 40 + 4 * tq) = bt; *(u32x2*)(oGAt + k * 40 + 4 * tq) = gt;
        if (tq == 7) lamC[k] = lam;
      }
      __syncthreads();
      {
      const int tid = otid(), lane = tid & 63, wave = tid >> 6, r = lane & 31, h = lane >> 5; (void)r; (void)h; (void)lane; (void)wave;
      if (wave < 4) {
        const bf16_t* As = (wave & 1) ? oGA : oBE; const bf16_t* Bs = (wave < 2) ? oAL : oRH;
        f32x16 x;
#pragma unroll
        for (int q = 0; q < 16; ++q) x[q] = 0.f;
#pragma unroll
        for (int s = 0; s < 4; ++s) { const bf16x8 a = *(const bf16x8*)(As + r * 72 + 16 * s + 8 * h); const bf16x8 bb = *(const bf16x8*)(Bs + r * 72 + 16 * s + 8 * h); x = MFMA32(a, bb, x); }
#pragma unroll
        for (int q = 0; q < 16; ++q) { const int i = (q & 3) + 8 * (q >> 2) + 4 * h; const bool keep = (wave < 2) ? (i < r) : (i <= r); x[q] = keep ? x[q] : 0.f; }
        if (wave == 0) {
#pragma unroll
          for (int gq = 0; gq < 4; ++gq) *(float4*)(Bm + r * 36 + 8 * gq + 4 * h) = make_float4(x[4 * gq], x[4 * gq + 1], x[4 * gq + 2], x[4 * gq + 3]);
        } else {
          const float sg = (wave == 2) ? -1.f : 1.f;
#pragma unroll
          for (int s = 0; s < 2; ++s) { u32x4 pk;
#pragma unroll
            for (int j = 0; j < 4; ++j) pk[j] = pack2(sg * x[8 * s + 2 * j], sg * x[8 * s + 2 * j + 1]);
            *(u32x4*)(frag + (((wave - 1) * 2 + s) * 64 + lane) * 16) = pk; }
        }
      }
      }
      __syncthreads();
      f32x16 y0;
#pragma unroll
      for (int q = 0; q < 16; ++q) y0[q] = 0.f;
      const int vloc = 32 * (wave & 1) + r;
      if (wave < 2) {
        f32x16 a0;
#pragma unroll
        for (int q = 0; q < 16; ++q) a0[q] = 0.f;
#pragma unroll
        for (int kb = 0; kb < 2; ++kb)
#pragma unroll
          for (int s = 0; s < 2; ++s) {
            u32x4 pk;
#pragma unroll
            for (int j = 0; j < 4; ++j) pk[j] = kb ? pack2(st1[8 * s + 2 * j], st1[8 * s + 2 * j + 1]) : pack2(st0[8 * s + 2 * j], st0[8 * s + 2 * j + 1]);
            const bf16x8 sf = __builtin_bit_cast(bf16x8, pk);
            const int ko = 32 * kb + 16 * s + 4 * h;
            const u32x4 aa = cat8(*(const u32x2*)(oAL + r * 72 + ko), *(const u32x2*)(oAL + r * 72 + ko + 8));
            const u32x4 ar = cat8(*(const u32x2*)(oRH + r * 72 + ko), *(const u32x2*)(oRH + r * 72 + ko + 8));
            a0 = MFMA32(__builtin_bit_cast(bf16x8, aa), sf, a0);
            y0 = MFMA32(__builtin_bit_cast(bf16x8, ar), sf, y0);
          }
#pragma unroll
        for (int s = 0; s < 2; ++s) {
          const bf16x8 fg = *(const bf16x8*)(frag + ((0 * 2 + s) * 64 + lane) * 16);
          const bf16x8 fpg = *(const bf16x8*)(frag + ((2 * 2 + s) * 64 + lane) * 16);
          const u32x4 ub = cat8(*(const u32x2*)(oUt + vloc * 40 + 16 * s + 4 * h), *(const u32x2*)(oUt + vloc * 40 + 16 * s + 4 * h + 8));
          a0 = MFMA32(fg, __builtin_bit_cast(bf16x8, ub), a0);
          y0 = MFMA32(fpg, __builtin_bit_cast(bf16x8, ub), y0);
        }
#pragma unroll
        for (int q = 0; q < 16; ++q) RHS[((q & 3) + 8 * (q >> 2) + 4 * h) * 64 + vloc] = a0[q];
        float* park = sR + wave * 3072 + lane * 4;
#pragma unroll
        for (int gq = 0; gq < 4; ++gq) {
          *(float4*)(park + gq * 256) = make_float4(st0[4 * gq], st0[4 * gq + 1], st0[4 * gq + 2], st0[4 * gq + 3]);
          *(float4*)(park + 1024 + gq * 256) = make_float4(st1[4 * gq], st1[4 * gq + 1], st1[4 * gq + 2], st1[4 * gq + 3]);
          *(float4*)(park + 2048 + gq * 256) = make_float4(y0[4 * gq], y0[4 * gq + 1], y0[4 * gq + 2], y0[4 * gq + 3]);
        }
      }
      __syncthreads();
      {
      const int tid = otid(), lane = tid & 63, wave = tid >> 6, r = lane & 31, h = lane >> 5; (void)r; (void)h; (void)lane; (void)wave;
      if (wave < 2) {
        float zv[32];
        const float* Bmo = Bm; const float* RHo = RHS + vloc; asm volatile("" : "+v"(Bmo), "+v"(RHo));
#pragma unroll
        for (int t = 0; t < 32; ++t) zv[t] = 0.f;
        float4 cb[8], nb8[8]; float crhs = RHo[0], nrhs = 0.f;
#pragma unroll
        for (int q = 0; q < 8; ++q) { cb[q] = make_float4(0.f, 0.f, 0.f, 0.f); nb8[q] = make_float4(0.f, 0.f, 0.f, 0.f); }
#pragma unroll
        for (int t = 0; t < 32; ++t) {
          if (t + 1 < 32) {
            nrhs = RHo[(t + 1) * 64];
#pragma unroll
            for (int i4 = 0; i4 < (t + 4) / 4; ++i4) nb8[i4] = *(const float4*)(Bmo + (t + 1) * 36 + 4 * i4);
          }
          float a0s = crhs, a1s = 0.f, a2s = 0.f, a3s = 0.f;
#pragma unroll
          for (int i4 = 0; i4 < (t + 3) / 4; ++i4) {
            a0s -= cb[i4].x * zv[4 * i4]; a1s -= cb[i4].y * zv[4 * i4 + 1]; a2s -= cb[i4].z * zv[4 * i4 + 2]; a3s -= cb[i4].w * zv[4 * i4 + 3];
          }
          zv[t] = (a0s + a1s) + (a2s + a3s);
          asm volatile("" : "+v"(zv[t]) :: "memory");
          crhs = nrhs;
#pragma unroll
          for (int i4 = 0; i4 < 8; ++i4) cb[i4] = nb8[i4];
        }
        if (h == 0) {
#pragma unroll
          for (int q = 0; q < 4; ++q) { u32x4 o;
#pragma unroll
            for (int j = 0; j < 4; ++j) o[j] = pack2(zv[8 * q + 2 * j], zv[8 * q + 2 * j + 1]);
            *(u32x4*)(oZt + vloc * 40 + 8 * q) = o; }
        }
      }
      }
      __syncthreads();
      {
      const int tid = otid(), lane = tid & 63, wave = tid >> 6, r = lane & 31, h = lane >> 5; (void)r; (void)h; (void)lane; (void)wave;
      if (wave < 2) {
        { const float* park = sR + wave * 3072 + lane * 4;
#pragma unroll
          for (int gq = 0; gq < 4; ++gq) {
            const float4 a = *(const float4*)(park + gq * 256), bq = *(const float4*)(park + 1024 + gq * 256), cq = *(const float4*)(park + 2048 + gq * 256);
            st0[4 * gq] = a.x; st0[4 * gq + 1] = a.y; st0[4 * gq + 2] = a.z; st0[4 * gq + 3] = a.w;
            st1[4 * gq] = bq.x; st1[4 * gq + 1] = bq.y; st1[4 * gq + 2] = bq.z; st1[4 * gq + 3] = bq.w;
            y0[4 * gq] = cq.x; y0[4 * gq + 1] = cq.y; y0[4 * gq + 2] = cq.z; y0[4 * gq + 3] = cq.w;
          } }
#pragma unroll
        for (int s = 0; s < 2; ++s) {
          const bf16x8 ub = *(const bf16x8*)(oUt + vloc * 40 + 16 * s + 8 * h), zb = *(const bf16x8*)(oZt + vloc * 40 + 16 * s + 8 * h);
          const bf16x8 g0 = *(const bf16x8*)(oGAt + r * 40 + 16 * s + 8 * h), g1 = *(const bf16x8*)(oGAt + (32 + r) * 40 + 16 * s + 8 * h);
          const bf16x8 b0 = *(const bf16x8*)(oBEt + r * 40 + 16 * s + 8 * h), b1 = *(const bf16x8*)(oBEt + (32 + r) * 40 + 16 * s + 8 * h);
          st0 = MFMA32(g0, ub, st0); st0 = MFMA32(b0, zb, st0);
          st1 = MFMA32(g1, ub, st1); st1 = MFMA32(b1, zb, st1);
          const bf16x8 fpb = *(const bf16x8*)(frag + ((1 * 2 + s) * 64 + lane) * 16);
          const u32x4 z8 = cat8(*(const u32x2*)(oZt + vloc * 40 + 16 * s + 4 * h), *(const u32x2*)(oZt + vloc * 40 + 16 * s + 4 * h + 8));
          y0 = MFMA32(fpb, __builtin_bit_cast(bf16x8, z8), y0);
        }
#pragma unroll
        for (int gq = 0; gq < 4; ++gq) {
          const float4 l0 = *(const float4*)(lamC + 8 * gq + 4 * h), l1 = *(const float4*)(lamC + 32 + 8 * gq + 4 * h);
          st0[4 * gq] *= l0.x; st0[4 * gq + 1] *= l0.y; st0[4 * gq + 2] *= l0.z; st0[4 * gq + 3] *= l0.w;
          st1[4 * gq] *= l1.x; st1[4 * gq + 1] *= l1.y; st1[4 * gq + 2] *= l1.z; st1[4 * gq + 3] *= l1.w;
        }
#pragma unroll
        for (int q = 0; q < 16; ++q) {
          const int t = (q & 3) + 8 * (q >> 2) + 4 * h; const int tl = z ? (L - 1 - (sc * 32 + t)) : (sc * 32 + t);
          Yg[((size_t)b * L + tl) * 1024 + head * 64 + vloc] = (bf16_t)f2bf(y0[q]);
        }
      }
      }
      __syncthreads();
    }
#undef SCAN_LOAD
    if (g == 0 && wave < 2) {
#pragma unroll
      for (int gq = 0; gq < 4; ++gq) {
        *(float4*)(p.out + OUT_ST + stbase + 8 * gq + 4 * h) = make_float4(st0[4 * gq], st0[4 * gq + 1], st0[4 * gq + 2], st0[4 * gq + 3]);
        *(float4*)(p.out + OUT_ST + stbase + 32 + 8 * gq + 4 * h) = make_float4(st1[4 * gq], st1[4 * gq + 1], st1[4 * gq + 2], st1[4 * gq + 3]);
      }
    }
    __syncthreads();
  }
}

DI void phase_rwkv_combine(const P& p, int g, int jl) {
  const int T = g ? 16384 : 8192;
  const int tid = otid(); const int lane = tid & 63, wave = tid >> 6;
  bf16_t* slots = (bf16_t*)(p.ws + WS_SLOT);
  const float* bon = (const float*)(p.ws + WS_BON);
  for (int t = blockIdx.x * 8 + wave; t < T; t += gridDim.x * 8) {
    const size_t o = (size_t)t * 1024 + 16 * lane; const int head = lane >> 2;
    float y[16], v[16], gg[16];
#pragma unroll
    for (int q = 0; q < 2; ++q) {
      const u32x4 a = *(const u32x4*)(slots + 5 * SLOT_ELEMS + o + 8 * q), bq = *(const u32x4*)(slots + 0 * SLOT_ELEMS + o + 8 * q);
      const u32x4 vq = *(const u32x4*)(slots + 3 * SLOT_ELEMS + o + 8 * q), gq = *(const u32x4*)(slots + 4 * SLOT_ELEMS + o + 8 * q);
#pragma unroll
      for (int i = 0; i < 4; ++i) { y[8 * q + 2 * i] = bflo(a[i]) + bflo(bq[i]); y[8 * q + 2 * i + 1] = bfhi(a[i]) + bfhi(bq[i]);
        v[8 * q + 2 * i] = bflo(vq[i]); v[8 * q + 2 * i + 1] = bfhi(vq[i]); gg[8 * q + 2 * i] = bflo(gq[i]); gg[8 * q + 2 * i + 1] = bfhi(gq[i]); }
    }
    float s = 0.f;
#pragma unroll
    for (int i = 0; i < 16; ++i) s += y[i];
    const float mean = quad_sum(s) * (1.f / 64.f);
    float vs = 0.f;
#pragma unroll
    for (int i = 0; i < 16; ++i) { const float d = y[i] - mean; vs += d * d; }
    const float rstd = rsqrtf(quad_sum(vs) * (1.f / 64.f) + 64e-5f);
    const float bs = bon[((size_t)t * 16 + head) * 2] + bon[((size_t)t * 16 + head) * 2 + 1];
    const float* gw = p.in[22] + jl * 1024 + 16 * lane; const float* gb = p.in[23] + jl * 1024 + 16 * lane;
    float ov[16];
#pragma unroll
    for (int i = 0; i < 16; ++i) ov[i] = ((y[i] - mean) * rstd * gw[i] + gb[i] + bs * v[i]) * silu(gg[i]);
#pragma unroll
    for (int q = 0; q < 2; ++q) { u32x4 w; w[0] = pack2(ov[8 * q], ov[8 * q + 1]); w[1] = pack2(ov[8 * q + 2], ov[8 * q + 3]); w[2] = pack2(ov[8 * q + 4], ov[8 * q + 5]); w[3] = pack2(ov[8 * q + 6], ov[8 * q + 7]);
      *(u32x4*)(slots + 4 * SLOT_ELEMS + o + 8 * q) = w; }
  }
}

DI void phase_conv(const P& p, int g) {
  const int T = g ? 16384 : 8192, Lmask = g ? 4095 : 255;
  bf16_t* slots = (bf16_t*)(p.ws + WS_SLOT);
  const bf16_t* BG = slots + 2 * SLOT_ELEMS; const bf16_t* CG = slots + 3 * SLOT_ELEMS; const bf16_t* U = slots + 4 * SLOT_ELEMS; const bf16_t* G = slots + 5 * SLOT_ELEMS;
  bf16_t* O = slots;
  for (int e = blockIdx.x * NT + otid(); e < T * 128; e += gridDim.x * NT) {
    const int t = e >> 7, c = (e & 127) * 8; const size_t o = (size_t)t * 1024 + c; const int tl = t & Lmask;
    const u32x4 zz = {0u, 0u, 0u, 0u};
    const u32x4 c1 = *(const u32x4*)(CG + o), u1 = *(const u32x4*)(U + o);
    const u32x4 c0 = tl != 0 ? *(const u32x4*)(CG + o - 1024) : zz, u0 = tl != 0 ? *(const u32x4*)(U + o - 1024) : zz;
    const u32x4 c2 = tl != Lmask ? *(const u32x4*)(CG + o + 1024) : zz, u2 = tl != Lmask ? *(const u32x4*)(U + o + 1024) : zz;
    const u32x4 bg = *(const u32x4*)(BG + o), gg = *(const u32x4*)(G + o);
    const float* cw = p.in[30]; const float* cb = p.in[31];
    u32x4 w;
#pragma unroll
    for (int i = 0; i < 4; ++i) {
      const int ch = c + 2 * i;
      const float lo = bflo(bg[i]) * (cw[ch] * bflo(c0[i]) * bflo(u0[i]) + cw[1024 + ch] * bflo(c1[i]) * bflo(u1[i]) + cw[2048 + ch] * bflo(c2[i]) * bflo(u2[i]) + cb[ch]) * silu(bflo(gg[i]));
      const float hi = bfhi(bg[i]) * (cw[ch + 1] * bfhi(c0[i]) * bfhi(u0[i]) + cw[1024 + ch + 1] * bfhi(c1[i]) * bfhi(u1[i]) + cw[2048 + ch + 1] * bfhi(c2[i]) * bfhi(u2[i]) + cb[ch + 1]) * silu(bfhi(gg[i]));
      w[i] = pack2(lo, hi);
    }
    *(u32x4*)(O + o) = w;
  }
}

DI void phase_attn(const P& p, int g, unsigned char* lds) {
  const int tid = otid(), lane = tid & 63, wave = tid >> 6, r = lane & 31, h = lane >> 5;
  const int L = g ? 4096 : 256, Ltot = g ? 4352 : 256, B = g ? 4 : 32;
  const int nq = L >> 6, ntasks = B * 4 * nq, nkt = Ltot >> 6;
  bf16_t* slots = (bf16_t*)(p.ws + WS_SLOT);
  bf16_t* Q = slots + 2 * SLOT_ELEMS; const bf16_t* G = slots + 3 * SLOT_ELEMS;
  const bf16_t* Kb = slots + 4 * SLOT_ELEMS; const bf16_t* Vt = Kb + SLOT_ELEMS / 2;
  const float SC = 0.125f * 1.4426950408889634f;
  for (int task = blockIdx.x; task < ntasks; task += gridDim.x) {
    const int qt = task % nq, kvh = (task / nq) & 3, b = task / (nq * 4);
    const int head = kvh * 4 + (wave >> 1); const int q0 = qt * 64 + (wave & 1) * 32;
    const size_t tok = (size_t)b * L + q0 + r;
    bf16x8 qf[4];
#pragma unroll
    for (int ds = 0; ds < 4; ++ds) qf[ds] = *(const bf16x8*)(Q + tok * 1024 + head * 64 + ds * 16 + h * 8);
    float m = -1e30f, lsum = 0.f;
    f32x16 O0, O1;
#pragma unroll
    for (int i = 0; i < 16; ++i) { O0[i] = 0.f; O1[i] = 0.f; }
    const int lrow = tid >> 3, lc = (tid & 7) * 8;
    const bf16_t* gK = Kb + ((size_t)b * Ltot + lrow) * 256 + kvh * 64 + lc;
    const bf16_t* gV = Vt + ((size_t)(b * 4 + kvh) * 64 + lrow) * Ltot + lc;
    u32x4 rk = *(const u32x4*)gK, rv = *(const u32x4*)gV;
    *(u32x4*)(lds + lrow * 144 + lc * 2) = rk; *(u32x4*)(lds + 9216 + lrow * 144 + lc * 2) = rv;
    __syncthreads();
    for (int kt = 0; kt < nkt; ++kt) {
      const unsigned char* cur = lds + (kt & 1) * 18432; unsigned char* nxt = lds + ((kt + 1) & 1) * 18432;
      if (kt + 1 < nkt) { rk = *(const u32x4*)(gK + (size_t)(kt + 1) * 64 * 256); rv = *(const u32x4*)(gV + (kt + 1) * 64); }
      f32x16 s0, s1;
#pragma unroll
      for (int i = 0; i < 16; ++i) { s0[i] = 0.f; s1[i] = 0.f; }
#pragma unroll
      for (int ds = 0; ds < 4; ++ds) {
        const bf16x8 a0 = *(const bf16x8*)(cur + r * 144 + (ds * 16 + h * 8) * 2);
        const bf16x8 a1 = *(const bf16x8*)(cur + (32 + r) * 144 + (ds * 16 + h * 8) * 2);
        s0 = MFMA32(a0, qf[ds], s0); s1 = MFMA32(a1, qf[ds], s1);
      }
      float tmax = s0[0];
#pragma unroll
      for (int i = 1; i < 16; ++i) tmax = fmaxf(tmax, s0[i]);
#pragma unroll
      for (int i = 0; i < 16; ++i) tmax = fmaxf(tmax, s1[i]);
      tmax = fmaxf(tmax, __shfl_xor(tmax, 32));
      const float mnew = fmaxf(m, tmax * SC);
      const float alpha = __builtin_amdgcn_exp2f(m - mnew);
      float ps = 0.f;
#pragma unroll
      for (int i = 0; i < 16; ++i) { s0[i] = __builtin_amdgcn_exp2f(s0[i] * SC - mnew); s1[i] = __builtin_amdgcn_exp2f(s1[i] * SC - mnew); ps += s0[i] + s1[i]; }
      lsum = lsum * alpha + ps; m = mnew;
#pragma unroll
      for (int i = 0; i < 16; ++i) { O0[i] *= alpha; O1[i] *= alpha; }
      const unsigned char* vs = cur + 9216;
#pragma unroll
      for (int kb = 0; kb < 2; ++kb)
#pragma unroll
        for (int s = 0; s < 2; ++s) {
          u32x4 pk;
#pragma unroll
          for (int j = 0; j < 4; ++j) pk[j] = kb ? pack2(s1[8 * s + 2 * j], s1[8 * s + 2 * j + 1]) : pack2(s0[8 * s + 2 * j], s0[8 * s + 2 * j + 1]);
          const bf16x8 pf = __builtin_bit_cast(bf16x8, pk);
          const int ko = (32 * kb + 16 * s + 4 * h) * 2;
          { const u32x2 lo = *(const u32x2*)(vs + r * 144 + ko), hi = *(const u32x2*)(vs + r * 144 + ko + 16);
            u32x4 av; av[0] = lo[0]; av[1] = lo[1]; av[2] = hi[0]; av[3] = hi[1];
            O0 = MFMA32(__builtin_bit_cast(bf16x8, av), pf, O0); }
          { const u32x2 lo = *(const u32x2*)(vs + (32 + r) * 144 + ko), hi = *(const u32x2*)(vs + (32 + r) * 144 + ko + 16);
            u32x4 av; av[0] = lo[0]; av[1] = lo[1]; av[2] = hi[0]; av[3] = hi[1];
            O1 = MFMA32(__builtin_bit_cast(bf16x8, av), pf, O1); }
        }
      if (kt + 1 < nkt) { *(u32x4*)(nxt + lrow * 144 + lc * 2) = rk; *(u32x4*)(nxt + 9216 + lrow * 144 + lc * 2) = rv; }
      __syncthreads();
    }
    lsum += __shfl_xor(lsum, 32);
    const float inv = 1.f / lsum;
#pragma unroll
    for (int db = 0; db < 2; ++db)
#pragma unroll
      for (int i4 = 0; i4 < 4; ++i4) {
        const size_t o = tok * 1024 + head * 64 + 32 * db + 8 * i4 + 4 * h;
        const u32x2 gq = *(const u32x2*)(G + o);
        const float v0 = (db ? O1[4 * i4] : O0[4 * i4]) * inv, v1 = (db ? O1[4 * i4 + 1] : O0[4 * i4 + 1]) * inv;
        const float v2 = (db ? O1[4 * i4 + 2] : O0[4 * i4 + 2]) * inv, v3 = (db ? O1[4 * i4 + 3] : O0[4 * i4 + 3]) * inv;
        u32x2 w; w[0] = pack2(v0 * silu(bflo(gq[0])), v1 * silu(bfhi(gq[0]))); w[1] = pack2(v2 * silu(bflo(gq[1])), v3 * silu(bfhi(gq[1])));
        *(u32x2*)(slots + 5 * SLOT_ELEMS + o) = w;
      }
  }
}


#define XB_TMO      128
#define XB_XCNT(j)  (256  + 64 * (j))
#define XB_XSUB(j)  (1280 + 64 * (j))
#define XB_XGEN(j)  (2304 + 64 * (j))
#define XB_TOP      3328
#define XB_TOPGEN   3392
#define XCD_BAR_WORDS 3456
#define XB_SPIN_CAP (1u << 22)
#define LAS __attribute__((address_space(3)))
DI unsigned xb_ld(unsigned* p) { return __hip_atomic_load(p, __ATOMIC_RELAXED, __HIP_MEMORY_SCOPE_AGENT); }
DI unsigned xb_add(unsigned* p, unsigned v) { return __hip_atomic_fetch_add(p, v, __ATOMIC_RELAXED, __HIP_MEMORY_SCOPE_AGENT); }
DI unsigned xb_xcc_id() { return (unsigned)__builtin_amdgcn_s_getreg((3 << 11) | 20) & 0xFu; }
#define XB_SPIN(cond, bar) do { unsigned _sp = 0; while (cond) { __builtin_amdgcn_s_sleep(1); \
    if ((++_sp & 255u) == 0u) { if (xb_ld(&(bar)[XB_TMO])) break; if (_sp > XB_SPIN_CAP) { atomicAdd(&(bar)[XB_TMO], 1u); break; } } } } while (0)
struct XcdBarrier { unsigned* bar; unsigned x; volatile LAS unsigned* st; };
DI XcdBarrier xcd_barrier_post(unsigned* bar, volatile LAS unsigned* st) {
  XcdBarrier b; b.bar = bar; b.x = xb_xcc_id(); b.st = st;
  if (threadIdx.x == 0) (void)xb_add(&bar[XB_XCNT(b.x)], 1u);
  return b;
}
DI void xcd_barrier_complete(unsigned* bar, unsigned x, unsigned& nloc, unsigned& nx) {
  const unsigned G = gridDim.x * gridDim.y * gridDim.z;
  unsigned sum, cnt, mine, sp = 0u;
  for (;;) {
    sum = 0u; cnt = 0u; mine = 0u;
#pragma unroll
    for (unsigned j = 0; j < 16; ++j) { const unsigned c = xb_ld(&bar[XB_XCNT(j)]); sum += c; cnt += (c > 0u) ? 1u : 0u; mine = (j == x) ? c : mine; }
    if (sum == G) break;
    __builtin_amdgcn_s_sleep(1);
    if ((++sp & 255u) == 0u) { if (xb_ld(&bar[XB_TMO])) break; if (sp > XB_SPIN_CAP) { atomicAdd(&bar[XB_TMO], 1u); break; } }
  }
  nloc = mine > 0u ? mine : 1u; nx = cnt > 0u ? cnt : 1u;
}
DI void xcd_barrier(const XcdBarrier& b) {
  asm volatile("s_waitcnt vmcnt(0)" ::: "memory");
  __syncthreads();
  if (threadIdx.x == 0) {
    unsigned* bar = b.bar;
    __builtin_amdgcn_s_waitcnt(0);
    unsigned nloc = b.st[0], nx = b.st[1];
    if (nloc == 0u) { xcd_barrier_complete(bar, b.x, nloc, nx); b.st[0] = nloc; b.st[1] = nx; }
    const unsigned old = xb_add(&bar[XB_XSUB(b.x)], 1u);
    const unsigned gen = old / nloc;
    if (old + 1u == (gen + 1u) * nloc) {
      __builtin_amdgcn_fence(__ATOMIC_RELEASE, "agent");
      asm volatile("s_waitcnt vmcnt(0)" ::: "memory");
      const unsigned og = xb_add(&bar[XB_TOP], 1u);
      const unsigned tg = og / nx;
      if (og + 1u == (tg + 1u) * nx) xb_add(&bar[XB_TOPGEN], 1u);
      else XB_SPIN(xb_ld(&bar[XB_TOPGEN]) == tg, bar);
      __builtin_amdgcn_fence(__ATOMIC_ACQUIRE, "agent");
      xb_add(&bar[XB_XGEN(b.x)], 1u);
      asm volatile("s_waitcnt vmcnt(0)" ::: "memory");
    } else {
      XB_SPIN(xb_ld(&bar[XB_XGEN(b.x)]) == gen, bar);
      __builtin_amdgcn_fence(__ATOMIC_ACQUIRE, "agent");
      asm volatile("s_waitcnt vmcnt(0)" ::: "memory");
    }
  }
  __syncthreads();
}

__global__ void __launch_bounds__(NT) mega(P p) {
  extern __shared__ __attribute__((aligned(16))) unsigned char lds[];
  cg::grid_group grid = cg::this_grid();
  volatile LAS unsigned* st = (volatile LAS unsigned*)(lds + 135168);
  if (threadIdx.x < 4) st[threadIdx.x] = 0u;
  __syncthreads();
  const XcdBarrier xbar = xcd_barrier_post((unsigned*)(p.ws + WS_BAR), st);
  phase0(p, lds);
  grid.sync();
  const P& p0 = p;
  for (int step = 0; step < 50; ++step) {
    const int g = step / 25, rem = step - g * 25, layer = rem / 5, sub = rem - layer * 5;
    const int kind = layer % 3, jl = layer / 3;
    const int T = g ? 16384 : 8192, Lmask = g ? 4095 : 255;
    int op = -1;
    if (layer == 4) op = (sub == 0) ? 0 : -1;
    else if (sub == 0) op = 0;
    else if (kind == 0) op = sub == 1 ? 1 : (sub == 2 ? 2 : (sub == 3 ? 3 : 4));
    else if (kind == 1) op = sub == 1 ? 5 : (sub == 2 ? 6 : (sub == 3 ? 4 : -1));
    else op = sub == 1 ? 4 : (sub == 2 ? 7 : (sub == 3 ? 4 : -1));
    if (op < 0) continue;
    P p = p0;
    { unsigned char* w_ = p0.ws; float* o_ = p0.out; asm volatile("" : "+s"(w_), "+s"(o_)); p.ws = w_; p.out = o_; }
    bf16_t* slots = (bf16_t*)(p.ws + WS_SLOT);
    const bf16_t* W = (const bf16_t*)(p.ws + WS_W);
    if (op == 0) {
      const float* xin = p.in[g]; float* xout = p.out + (g ? OUT_YS : OUT_YP);
      phase_norm(p, g, layer - 1, layer < 4 ? layer : -1, layer <= 1 ? xin : xout, xout, slots + SLOT_ELEMS, slots);
      if (kind == 1 && g == 1 && layer < 4) phase_cache_copy(p);
    } else if (op == 1) {
      for (int rep = 0; rep < opq(REP_GEMM); ++rep) phase_gemm<1, 0>(p, g, slots, W + (size_t)(RW_IN0 + jl * RW_STRIDE) * 1024, T, 4352, p.in[11] + jl * 6144, Lmask, slots + SLOT_ELEMS, 1, lds);
    } else if (op == 2) {
      for (int rep = 0; rep < opq(REP_SCAN); ++rep) phase_scan(p, g, jl, lds);
    } else if (op == 3) {
      phase_rwkv_combine(p, g, jl);
    } else if (op == 4) {
      const bf16_t* A; const bf16_t* Bt; int N; bf16_t* dst;
      if (sub == 1) { A = slots; Bt = W + (size_t)CV_IN * 1024; N = 4096; dst = slots + 2 * SLOT_ELEMS; }
      else {
        N = 1024; dst = slots + SLOT_ELEMS;
        if (kind == 0) { A = slots + 4 * SLOT_ELEMS; Bt = W + (size_t)(RW_OUT0 + jl * RW_STRIDE) * 1024; }
        else if (kind == 1) { A = slots + 5 * SLOT_ELEMS; Bt = W + (size_t)AT_OUT * 1024; }
        else { A = slots; Bt = W + (size_t)CV_OUT * 1024; }
      }
      for (int rep = 0; rep < opq(REP_GEMM); ++rep) phase_gemm<0, 0>(p, g, A, Bt, T, N, nullptr, 0, dst, 0, lds);
    } else if (op == 5) {
      for (int rep = 0; rep < opq(REP_GEMM); ++rep) phase_gemm<0, 1>(p, g, slots, W + (size_t)AT_IN * 1024, T, 2560, nullptr, 0, nullptr, 0, lds);
    } else if (op == 6) {
      for (int rep = 0; rep < opq(REP_ATTN); ++rep) phase_attn(p, g, lds);
    } else {
      phase_conv(p, g);
    }
    if (!(g == 1 && layer == 4)) for (int rep = 0; rep < opq(REP_SYNC); ++rep) xcd_barrier(xbar);
  }
}

extern "C" void kernel_launch(void* const* d_in, const int* in_sizes, int n_in, void* d_out, int out_size, void* d_ws, size_t ws_size, hipStream_t stream) {
  static int grid_blocks = 0;
  if (!grid_blocks) {
    int dev = 0, cus = 0, per_cu = 0;
    hipGetDevice(&dev);
    hipDeviceGetAttribute(&cus, hipDeviceAttributeMultiprocessorCount, dev);
    hipFuncSetAttribute((const void*)mega, hipFuncAttributeMaxDynamicSharedMemorySize, LDS_BYTES);
    hipOccupancyMaxActiveBlocksPerMultiprocessor(&per_cu, (const void*)mega, NT, LDS_BYTES);
    if (per_cu < 1) per_cu = 1;
    if (per_cu > 1) per_cu = 1;
    grid_blocks = cus * per_cu;
    if (ws_size < WS_SLOT + 6 * SLOT_ELEMS * 2) fprintf(stderr, "workspace too small: %zu\n", ws_size);
  }
  (void)hipMemsetAsync((unsigned char*)d_ws + WS_BAR, 0, XCD_BAR_WORDS * sizeof(unsigned), stream);
  P p{};
  for (int i = 0; i < 33; ++i) p.in[i] = (const float*)d_in[i];
  p.out = (float*)d_out; p.ws = (unsigned char*)d_ws;
  void* args[] = {&p};
  hipError_t e = hipLaunchCooperativeKernel((const void*)mega, dim3(grid_blocks), dim3(NT), args, LDS_BYTES, stream);
  if (e != hipSuccess) fprintf(stderr, "cooperative launch failed: %s (grid %d)\n", hipGetErrorString(e), grid_blocks);
}
```

```cpp
#include <hip/hip_runtime.h>
#include <hip/hip_cooperative_groups.h>
#include <cstdio>
namespace cg = cooperative_groups;

typedef unsigned short bf16_t;
using bf16x8 = __attribute__((ext_vector_type(8))) short;
using f32x16 = __attribute__((ext_vector_type(16))) float;
using u32x4 = __attribute__((ext_vector_type(4))) unsigned;
using u32x2 = __attribute__((ext_vector_type(2))) unsigned;

#define NT 512
#ifndef REP_GEMM
#define REP_GEMM 1
#endif
#ifndef REP_SCAN
#define REP_SCAN 1
#endif
#ifndef REP_ATTN
#define REP_ATTN 1
#endif
#ifndef REP_SYNC
#define REP_SYNC 1
#endif
#define DI __device__ __forceinline__
#define MFMA32(a, b, c) __builtin_amdgcn_mfma_f32_32x32x16_bf16((a), (b), (c), 0, 0, 0)

struct P { const float* in[33]; float* out; unsigned char* ws; };

constexpr size_t WS_ADA = 0;
constexpr size_t WS_ROPE = 262144;
constexpr size_t WS_BON = 327680;
constexpr size_t WS_HID = WS_BON + 2097152;
constexpr size_t WS_W = WS_HID + 8388608;
constexpr size_t WS_SLOT = WS_W + 39845888;
constexpr size_t SLOT_ELEMS = (size_t)16384 * 1024;
constexpr int RW_IN0 = 0, RW_OUT0 = 4352, RW_STRIDE = 5376, AT_IN = 10752, AT_OUT = 13312, CV_IN = 14336, CV_OUT = 18432;
constexpr size_t OUT_YP = 0, OUT_YS = 8388608, OUT_ST = 25165824, OUT_CK = 33554432, OUT_CV = 35651584;
constexpr int LDS_BYTES = 135168 + 16;
constexpr size_t WS_BAR = 278528;

typedef __bf16 bf16x2_t __attribute__((ext_vector_type(2)));
typedef float f32x2_t __attribute__((ext_vector_type(2)));
DI unsigned pack2(float a, float b) { f32x2_t v = {a, b}; return __builtin_bit_cast(unsigned, __builtin_convertvector(v, bf16x2_t)); }
DI unsigned f2bf(float x) { return (unsigned)__builtin_bit_cast(unsigned short, (__bf16)x); }
DI float bflo(unsigned u) { return __uint_as_float(u << 16); }
DI float bfhi(unsigned u) { return __uint_as_float(u & 0xffff0000u); }
DI float bf1(bf16_t u) { return __uint_as_float(((unsigned)u) << 16); }

template <int CTRL> DI float dppf(float v) { return __int_as_float(__builtin_amdgcn_update_dpp(0, __float_as_int(v), CTRL, 0xF, 0xF, true)); }
DI float reduce16(float v) { v += dppf<0xB1>(v); v += dppf<0x4E>(v); v += dppf<0x141>(v); v += dppf<0x140>(v); return v; }
DI float wave_sum(float v) { v = reduce16(v); v += __shfl_xor(v, 16); v += __shfl_xor(v, 32); return v; }
DI float quad_sum(float v) { v += dppf<0xB1>(v); v += dppf<0x4E>(v); return v; }
DI float silu(float x) { return x / (1.f + __expf(-x)); }
DI int opq(int v) { asm volatile("" : "+s"(v)); return v; }
DI int otid() { int t = threadIdx.x; asm volatile("" : "+v"(t)); return t; }

DI void conv_tiles(const float* __restrict__ src, int N, bf16_t* __restrict__ dst, float* lds) {
  const int tid = otid();
  const int tilesN = N >> 6, ntiles = 16 * tilesN;
  for (int tile = blockIdx.x; tile < ntiles; tile += gridDim.x) {
    const int kt = tile / tilesN, nt = tile - kt * tilesN, k0 = kt * 64, n0 = nt * 64;
#pragma unroll
    for (int i = 0; i < 8; ++i) { const int k = (tid >> 6) + 8 * i, n = tid & 63; lds[k * 65 + n] = src[(size_t)(k0 + k) * N + n0 + n]; }
    __syncthreads();
    { const int n = tid >> 3, kc = (tid & 7) * 8; u32x4 o;
#pragma unroll
      for (int j = 0; j < 4; ++j) o[j] = pack2(lds[(kc + 2 * j) * 65 + n], lds[(kc + 2 * j + 1) * 65 + n]);
      *(u32x4*)(dst + (size_t)(n0 + n) * 1024 + k0 + kc) = o; }
    __syncthreads();
  }
}

DI void phase0(const P& p, unsigned char* ldsb) {
  float* lds = (float*)ldsb;
  const int tid = otid();
  bf16_t* W = (bf16_t*)(p.ws + WS_W);
#pragma unroll 1
  for (int e = 0; e < opq(22); ++e) {
    const float* src; int N, drow;
    if (e < 18) {
      const int j = e / 9, q = e - j * 9;
      if (q < 4) { src = p.in[12] + (size_t)(j * 4 + q) * 1048576; N = 1024; drow = RW_IN0 + j * RW_STRIDE + q * 1024; }
      else if (q < 6) { src = p.in[14] + (size_t)(j * 2 + q - 4) * 65536; N = 64; drow = RW_IN0 + j * RW_STRIDE + 4096 + (q - 4) * 64; }
      else if (q < 8) { src = p.in[17] + (size_t)(j * 2 + q - 6) * 65536; N = 64; drow = RW_IN0 + j * RW_STRIDE + 4224 + (q - 6) * 64; }
      else { src = p.in[24] + (size_t)j * 1048576; N = 1024; drow = RW_OUT0 + j * RW_STRIDE; }
    } else if (e == 18) { src = p.in[25]; N = 2560; drow = AT_IN; }
    else if (e == 19) { src = p.in[28]; N = 1024; drow = AT_OUT; }
    else if (e == 20) { src = p.in[29]; N = 4096; drow = CV_IN; }
    else { src = p.in[32]; N = 1024; drow = CV_OUT; }
    conv_tiles(src, N, W + (size_t)drow * 1024, lds);
  }
  {
    float* scond = lds;
    float* red = lds + 5120;
    for (int e = tid; e < 5120; e += NT) { const int cnd = e >> 10, k = e & 1023; const float cv = cnd == 0 ? p.in[6][k] : p.in[5][(cnd - 1) * 1024 + k]; scond[e] = silu(cv); }
    __syncthreads();
    float* ada = (float*)(p.ws + WS_ADA);
    for (int task = blockIdx.x; task < 192; task += gridDim.x) {
      const int layer = task / 48, n0 = (task % 48) * 64, c = tid & 63, kg = tid >> 6;
      float a0 = 0.f, a1 = 0.f, a2 = 0.f, a3 = 0.f, a4 = 0.f;
      const float* wp = p.in[9] + ((size_t)layer * 1024 + kg * 128) * 3072 + n0 + c;
#pragma unroll 8
      for (int k = 0; k < 128; ++k) { const float w = wp[(size_t)k * 3072]; const int kk = kg * 128 + k;
        a0 += scond[kk] * w; a1 += scond[1024 + kk] * w; a2 += scond[2048 + kk] * w; a3 += scond[3072 + kk] * w; a4 += scond[4096 + kk] * w; }
      red[(kg * 5 + 0) * 64 + c] = a0; red[(kg * 5 + 1) * 64 + c] = a1; red[(kg * 5 + 2) * 64 + c] = a2; red[(kg * 5 + 3) * 64 + c] = a3; red[(kg * 5 + 4) * 64 + c] = a4;
      __syncthreads();
      if (tid < 320) { const int cnd = tid >> 6; float s = p.in[10][layer * 3072 + n0 + c];
#pragma unroll
        for (int q = 0; q < 8; ++q) s += red[(q * 5 + cnd) * 64 + c];
        ada[(cnd * 4 + layer) * 3072 + n0 + c] = s; }
      __syncthreads();
    }
  }
  if (blockIdx.x == gridDim.x - 1) {
    float* rope = (float*)(p.ws + WS_ROPE);
    for (int e = tid; e < 1024; e += NT) {
      const int pos = e >> 4, f = e & 15;
      double inv = 1.0; for (int q = 0; q < f; ++q) inv *= 0.5623413251903491;
      double ang = (double)pos * inv;
      const double twopi = 6.283185307179586476925286766559;
      double n = __builtin_rint(ang / twopi); double rr = ang - n * twopi;
      double r2 = rr * rr, sn = 0.0, cs = 0.0, ts = rr, tc = 1.0;
      for (int q = 0; q < 16; ++q) { cs += tc; sn += ts; tc = -tc * r2 / (double)((2 * q + 1) * (2 * q + 2)); ts = -ts * r2 / (double)((2 * q + 2) * (2 * q + 3)); }
      rope[e * 2] = (float)cs; rope[e * 2 + 1] = (float)sn;
    }
  }
}

DI void phase_norm(const P& p, int g, int lpost, int lpre, const float* __restrict__ xsrc, float* __restrict__ xdst,
                   const bf16_t* __restrict__ Mb, bf16_t* __restrict__ H) {
  const int T = g ? 16384 : 8192;
  const int tid = otid(); const int lane = tid & 63, wave = tid >> 6;
  const float* ada = (const float*)(p.ws + WS_ADA);
  for (int t = blockIdx.x * 8 + wave; t < T; t += gridDim.x * 8) {
    const int cond = g ? 1 + (t >> 12) : 0;
    float4 x[4];
#pragma unroll
    for (int i = 0; i < 4; ++i) x[i] = *(const float4*)(xsrc + (size_t)t * 1024 + 256 * i + 4 * lane);
    if (lpost >= 0) {
      float m[16]; float ss = 0.f;
#pragma unroll
      for (int i = 0; i < 4; ++i) { const u32x2 u = *(const u32x2*)(Mb + (size_t)t * 1024 + 256 * i + 4 * lane);
        m[4 * i] = bflo(u[0]); m[4 * i + 1] = bfhi(u[0]); m[4 * i + 2] = bflo(u[1]); m[4 * i + 3] = bfhi(u[1]); }
#pragma unroll
      for (int i = 0; i < 16; ++i) ss += m[i] * m[i];
      ss = wave_sum(ss);
      const float rs = rsqrtf(ss * (1.f / 1024.f) + 1e-6f);
      const float* gate = ada + (cond * 4 + lpost) * 3072 + 2048;
      const float* wpo = p.in[8] + lpost * 1024;
#pragma unroll
      for (int i = 0; i < 4; ++i) { const int c = 256 * i + 4 * lane; const float4 gt = *(const float4*)(gate + c); const float4 wv = *(const float4*)(wpo + c);
        x[i].x += gt.x * (m[4 * i] * rs * wv.x); x[i].y += gt.y * (m[4 * i + 1] * rs * wv.y); x[i].z += gt.z * (m[4 * i + 2] * rs * wv.z); x[i].w += gt.w * (m[4 * i + 3] * rs * wv.w);
        *(float4*)(xdst + (size_t)t * 1024 + c) = x[i]; }
    }
    if (lpre >= 0) {
      float ss = 0.f;
#pragma unroll
      for (int i = 0; i < 4; ++i) ss += x[i].x * x[i].x + x[i].y * x[i].y + x[i].z * x[i].z + x[i].w * x[i].w;
      ss = wave_sum(ss);
      const float rs = rsqrtf(ss * (1.f / 1024.f) + 1e-6f);
      const float* sh = ada + (cond * 4 + lpre) * 3072; const float* sc = sh + 1024; const float* wpr = p.in[7] + lpre * 1024;
#pragma unroll
      for (int i = 0; i < 4; ++i) { const int c = 256 * i + 4 * lane; const float4 s4 = *(const float4*)(sh + c); const float4 c4 = *(const float4*)(sc + c); const float4 wv = *(const float4*)(wpr + c);
        u32x2 o; o[0] = pack2(x[i].x * rs * wv.x * (1.f + c4.x) + s4.x, x[i].y * rs * wv.y * (1.f + c4.y) + s4.y);
        o[1] = pack2(x[i].z * rs * wv.z * (1.f + c4.z) + s4.z, x[i].w * rs * wv.w * (1.f + c4.w) + s4.w);
        *(u32x2*)(H + (size_t)t * 1024 + c) = o; }
    }
  }
}

DI void phase_cache_copy(const P& p) {
  bf16_t* Kb = (bf16_t*)(p.ws + WS_SLOT) + 4 * SLOT_ELEMS; bf16_t* Vt = Kb + SLOT_ELEMS / 2;
  for (int e = blockIdx.x * NT + otid(); e < 262144; e += gridDim.x * NT) {
    const int c = e & 255, pp = (e >> 8) & 255, b = e >> 16; const int kvh = c >> 6, d = c & 63;
    Kb[((size_t)b * 4352 + 4096 + pp) * 256 + c] = (bf16_t)f2bf(p.in[3][e]);
    Vt[((size_t)(b * 4 + kvh) * 64 + d) * 4352 + 4096 + pp] = (bf16_t)f2bf(p.in[4][e]);
  }
}

template <int SHIFT> DI void ld_half(const bf16_t* __restrict__ A, int t, int k, int Lmask, u32x4 (&raw)[4]) {
  raw[1] = *(const u32x4*)(A + (size_t)t * 1024 + k);
  raw[2] = *(const u32x4*)(A + (size_t)(t + 1) * 1024 + k);
  if (SHIFT) {
    raw[0] = (u32x4){0u, 0u, 0u, 0u}; raw[3] = (u32x4){0u, 0u, 0u, 0u};
    if ((t & Lmask) != 0) raw[0] = *(const u32x4*)(A + (size_t)(t - 1) * 1024 + k);
    if (((t + 1) & Lmask) != Lmask) raw[3] = *(const u32x4*)(A + (size_t)(t + 2) * 1024 + k);
  }
}
DI u32x4 mix3(const u32x4& c, const u32x4& pz, const u32x4& nz, const float* smu, int k) {
  const float4 m0 = *(const float4*)(smu + k), m1 = *(const float4*)(smu + k + 4);
  const float mu[8] = {m0.x, m0.y, m0.z, m0.w, m1.x, m1.y, m1.z, m1.w};
  u32x4 o;
#pragma unroll
  for (int i = 0; i < 4; ++i) {
    const float h0 = bflo(c[i]), h1 = bfhi(c[i]);
    const float x0 = h0 + (0.5f * (bflo(pz[i]) + bflo(nz[i])) - h0) * mu[2 * i];
    const float x1 = h1 + (0.5f * (bfhi(pz[i]) + bfhi(nz[i])) - h1) * mu[2 * i + 1];
    o[i] = pack2(x0, x1);
  }
  return o;
}
template <int SHIFT> DI void st_half(unsigned char* dst, const u32x4 (&raw)[4], const float* smu, int k) {
  if (!SHIFT) { *(u32x4*)dst = raw[1]; *(u32x4*)(dst + 144) = raw[2]; }
  else { *(u32x4*)dst = mix3(raw[1], raw[0], raw[2], smu, k); *(u32x4*)(dst + 144) = mix3(raw[2], raw[1], raw[3], smu, k); }
}

template <int SHIFT, int EPI>
DI void phase_gemm(const P& p, int g, const bf16_t* __restrict__ A, const bf16_t* __restrict__ Bt, int M, int N,
                   const float* __restrict__ mu, int Lmask, bf16_t* __restrict__ dst, int rw, unsigned char* lds) {
  const int tid = otid(), lane = tid & 63, wave = tid >> 6;
  const int wm = wave >> 1, wn = wave & 1, r = lane & 31, h = lane >> 5;
  const int ntn = N >> 7, ntiles = ntn * (M >> 8);
  float* Cs = (float*)lds;
  float* smu = (float*)(lds + 110592);
  for (int tile = blockIdx.x; tile < ntiles; tile += gridDim.x) {
    const int mt = tile / ntn, nt = tile - mt * ntn; const int m0 = mt * 256, n0 = nt * 128;
    f32x16 acc[2][2];
#pragma unroll
    for (int a = 0; a < 2; ++a)
#pragma unroll
      for (int b = 0; b < 2; ++b)
#pragma unroll
        for (int i = 0; i < 16; ++i) acc[a][b][i] = 0.f;
    if (SHIFT) {
      const float* mup = mu + (nt < 32 ? (nt >> 3) : (nt == 32 ? 4 : 5)) * 1024;
      smu[tid] = mup[tid]; smu[tid + 512] = mup[tid + 512];
      __syncthreads();
    }
    u32x4 raw[4], rb[2];
    const int arow = 4 * (tid >> 3), akc = (tid & 7) * 8;
#pragma unroll
    for (int hf = 0; hf < 2; ++hf) { ld_half<SHIFT>(A, m0 + arow + 2 * hf, akc, Lmask, raw); st_half<SHIFT>(lds + (arow + 2 * hf) * 144 + akc * 2, raw, smu, akc); }
#pragma unroll
    for (int i = 0; i < 2; ++i) { const int id = tid + 512 * i; rb[i] = *(const u32x4*)(Bt + (size_t)(n0 + (id >> 3)) * 1024 + (id & 7) * 8); }
#pragma unroll
    for (int i = 0; i < 2; ++i) { const int id = tid + 512 * i; *(u32x4*)(lds + 36864 + (id >> 3) * 144 + (id & 7) * 16) = rb[i]; }
    __syncthreads();
    for (int kt = 0; kt < 16; ++kt) {
      unsigned char* cur = lds + (kt & 1) * 55296; unsigned char* nxt = lds + ((kt + 1) & 1) * 55296;
      const int k1 = (kt + 1) * 64;
      if (kt < 15) {
        ld_half<SHIFT>(A, m0 + arow, k1 + akc, Lmask, raw);
        rb[0] = *(const u32x4*)(Bt + (size_t)(n0 + (tid >> 3)) * 1024 + k1 + (tid & 7) * 8);
      }
#pragma unroll
      for (int ks = 0; ks < 4; ++ks) {
        const int ko = (ks * 16 + h * 8) * 2;
        const bf16x8 a0 = *(const bf16x8*)(cur + (wm * 64 + r) * 144 + ko);
        const bf16x8 a1 = *(const bf16x8*)(cur + (wm * 64 + 32 + r) * 144 + ko);
        const bf16x8 b0 = *(const bf16x8*)(cur + 36864 + (wn * 64 + r) * 144 + ko);
        const bf16x8 b1 = *(const bf16x8*)(cur + 36864 + (wn * 64 + 32 + r) * 144 + ko);
        acc[0][0] = MFMA32(a0, b0, acc[0][0]); acc[0][1] = MFMA32(a0, b1, acc[0][1]);
        acc[1][0] = MFMA32(a1, b0, acc[1][0]); acc[1][1] = MFMA32(a1, b1, acc[1][1]);
        if (ks == 1 && kt < 15) {
          st_half<SHIFT>(nxt + arow * 144 + akc * 2, raw, smu, k1 + akc);
          *(u32x4*)(nxt + 36864 + (tid >> 3) * 144 + (tid & 7) * 16) = rb[0];
          ld_half<SHIFT>(A, m0 + arow + 2, k1 + akc, Lmask, raw);
          rb[0] = *(const u32x4*)(Bt + (size_t)(n0 + 64 + (tid >> 3)) * 1024 + k1 + (tid & 7) * 8);
        }
      }
      if (kt < 15) {
        st_half<SHIFT>(nxt + (arow + 2) * 144 + akc * 2, raw, smu, k1 + akc);
        *(u32x4*)(nxt + 36864 + (64 + (tid >> 3)) * 144 + (tid & 7) * 16) = rb[0];
      }
      __syncthreads();
    }
#pragma unroll
    for (int mi = 0; mi < 2; ++mi)
#pragma unroll
      for (int ni = 0; ni < 2; ++ni)
#pragma unroll
        for (int i = 0; i < 16; ++i) {
          const int row = wm * 64 + mi * 32 + (i & 3) + 8 * (i >> 2) + 4 * h, col = wn * 64 + ni * 32 + r;
          Cs[row * 132 + col] = acc[mi][ni][i];
        }
    __syncthreads();
    if (EPI == 0) {
#pragma unroll
      for (int i = 0; i < 8; ++i) {
        const int id = tid + 512 * i, row = id >> 4, cc = (id & 15) * 8;
        float4 v0 = *(const float4*)(Cs + row * 132 + cc), v1 = *(const float4*)(Cs + row * 132 + cc + 4);
        if (rw && nt == 32) { v0.x = tanhf(v0.x); v0.y = tanhf(v0.y); v0.z = tanhf(v0.z); v0.w = tanhf(v0.w); v1.x = tanhf(v1.x); v1.y = tanhf(v1.y); v1.z = tanhf(v1.z); v1.w = tanhf(v1.w); }
        u32x4 o; o[0] = pack2(v0.x, v0.y); o[1] = pack2(v0.z, v0.w); o[2] = pack2(v1.x, v1.y); o[3] = pack2(v1.z, v1.w);
        if (rw && nt >= 32) *(u32x4*)((bf16_t*)(p.ws + WS_HID) + (size_t)(m0 + row) * 256 + (nt - 32) * 128 + cc) = o;
        else *(u32x4*)(dst + (size_t)(nt >> 3) * SLOT_ELEMS + (size_t)(m0 + row) * 1024 + (nt & 7) * 128 + cc) = o;
      }
    } else {
      const int row = tid & 255, hh = tid >> 8; const int t = m0 + row;
      float x[64];
#pragma unroll
      for (int q = 0; q < 16; ++q) { const float4 v = *(const float4*)(Cs + row * 132 + hh * 64 + 4 * q); x[4 * q] = v.x; x[4 * q + 1] = v.y; x[4 * q + 2] = v.z; x[4 * q + 3] = v.w; }
      bf16_t* slots = (bf16_t*)(p.ws + WS_SLOT);
      const int L = g ? 4096 : 256, Ltot = g ? 4352 : 256;
      const int b = g ? (t >> 12) : (t >> 8), s = t & (L - 1);
      if (nt < 10) {
        int vz = 0; asm volatile("" : "+v"(vz));
        const float* nw = (nt < 8 ? p.in[26] : p.in[27]) + vz;
        float ss = 0.f;
#pragma unroll
        for (int d = 0; d < 64; ++d) ss += x[d] * x[d];
        const float rs = rsqrtf(ss * (1.f / 64.f) + 1e-6f);
#pragma unroll
        for (int d = 0; d < 64; ++d) x[d] *= rs * nw[d];
        if (g == 0 && nt >= 8) {
          float* ck = p.out + OUT_CK + (size_t)t * 256 + ((nt - 8) * 2 + hh) * 64;
#pragma unroll
          for (int q = 0; q < 16; ++q) *(float4*)(ck + 4 * q) = make_float4(x[4 * q], x[4 * q + 1], x[4 * q + 2], x[4 * q + 3]);
        }
        if (g == 1) {
          const float2* rope = (const float2*)(p.ws + WS_ROPE);
          const int ri = s >> 6, ci = s & 63;
#pragma unroll
          for (int f = 0; f < 16; ++f) {
            const float2 cr = rope[ri * 16 + f]; const float x1 = x[f], x2 = x[16 + f];
            x[f] = x1 * cr.x - x2 * cr.y; x[16 + f] = x2 * cr.x + x1 * cr.y;
            const float2 cc = rope[ci * 16 + f]; const float y1 = x[32 + f], y2 = x[48 + f];
            x[32 + f] = y1 * cc.x - y2 * cc.y; x[48 + f] = y2 * cc.x + y1 * cc.y;
          }
        }
        bf16_t* dq = nt < 8 ? slots + 2 * SLOT_ELEMS + (size_t)t * 1024 + (nt * 2 + hh) * 64
                            : slots + 4 * SLOT_ELEMS + ((size_t)b * Ltot + s) * 256 + ((nt - 8) * 2 + hh) * 64;
#pragma unroll
        for (int q = 0; q < 8; ++q) { u32x4 o; o[0] = pack2(x[8 * q], x[8 * q + 1]); o[1] = pack2(x[8 * q + 2], x[8 * q + 3]); o[2] = pack2(x[8 * q + 4], x[8 * q + 5]); o[3] = pack2(x[8 * q + 6], x[8 * q + 7]); *(u32x4*)(dq + 8 * q) = o; }
      } else if (nt < 12) {
        const int kvh = (nt - 10) * 2 + hh;
        if (g == 0) {
          float* cv = p.out + OUT_CV + (size_t)t * 256 + kvh * 64;
#pragma unroll
          for (int q = 0; q < 16; ++q) *(float4*)(cv + 4 * q) = make_float4(x[4 * q], x[4 * q + 1], x[4 * q + 2], x[4 * q + 3]);
        }
        bf16_t* vt = slots + 4 * SLOT_ELEMS + SLOT_ELEMS / 2 + ((size_t)(b * 4 + kvh) * 64) * Ltot + s;
#pragma unroll
        for (int d = 0; d < 64; ++d) { *vt = (bf16_t)f2bf(x[d]); vt += Ltot; asm volatile("" : "+v"(vt)); }
      } else {
        bf16_t* dg = slots + 3 * SLOT_ELEMS + (size_t)t * 1024 + (nt - 12) * 128 + hh * 64;
#pragma unroll
        for (int q = 0; q < 8; ++q) { u32x4 o; o[0] = pack2(x[8 * q], x[8 * q + 1]); o[1] = pack2(x[8 * q + 2], x[8 * q + 3]); o[2] = pack2(x[8 * q + 4], x[8 * q + 5]); o[3] = pack2(x[8 * q + 6], x[8 * q + 7]); *(u32x4*)(dg + 8 * q) = o; }
      }
    }
    __syncthreads();
  }
}

DI u32x4 cat8(const u32x2 lo, const u32x2 hi) { u32x4 v; v[0] = lo[0]; v[1] = lo[1]; v[2] = hi[0]; v[3] = hi[1]; return v; }
DI void phase_scan(const P& p, int g, int jl, unsigned char* lds) {
  const int tid = otid(), lane = tid & 63, wave = tid >> 6, r = lane & 31, h = lane >> 5;
  const int L = g ? 4096 : 256, B = g ? 4 : 32, nsc = L >> 5;
  float* sR = (float*)lds; float* sW = sR + 2048; float* sKD = sW + 2048; float* sKK = sKD + 2048; float* sKKA = sKK + 2048;
  bf16_t* sHW = (bf16_t*)(lds + 40960); bf16_t* sHA = (bf16_t*)(lds + 45568);
  bf16_t* oAL = (bf16_t*)(lds + 50176); bf16_t* oRH = (bf16_t*)(lds + 54784); bf16_t* oBE = (bf16_t*)(lds + 59392); bf16_t* oGA = (bf16_t*)(lds + 64000);
  bf16_t* oBEt = (bf16_t*)(lds + 68608); bf16_t* oGAt = (bf16_t*)(lds + 73728); bf16_t* oUt = (bf16_t*)(lds + 78848); bf16_t* oZt = (bf16_t*)(lds + 83968);
  float* Bm = (float*)(lds + 89088); float* RHS = (float*)(lds + 93696); float* lamC = (float*)(lds + 101888); float* sP = (float*)(lds + 102144);
  unsigned char* frag = lds + 104192;
  const bf16_t* slots = (const bf16_t*)(p.ws + WS_SLOT);
  const bf16_t* Rg = slots + 1 * SLOT_ELEMS; const bf16_t* Kg = slots + 2 * SLOT_ELEMS; const bf16_t* Vg = slots + 3 * SLOT_ELEMS;
  const bf16_t* hid = (const bf16_t*)(p.ws + WS_HID);
  float* bon = (float*)(p.ws + WS_BON);
  const int ntasks = B * 32;
  for (int task = blockIdx.x; task < ntasks; task += gridDim.x) {
    const int z = task & 1, head = (task >> 1) & 15, b = task >> 5;
    bf16_t* Yg = (bf16_t*)(p.ws + WS_SLOT) + (z ? 0 : 5) * SLOT_ELEMS;
    const int mat = (wave >> 1) & 1, ntt = wave & 1;
    unsigned char* lfr = lds + 110336 + (wave & 3) * 4096;
    if (wave < 4) {
      const float* W2 = (mat ? p.in[18] : p.in[15]) + (size_t)(jl * 2 + z) * 65536 + head * 64 + 32 * ntt + r;
#pragma unroll
      for (int kk = 0; kk < 4; ++kk) { u32x4 pk;
#pragma unroll
        for (int j = 0; j < 4; ++j) pk[j] = pack2(W2[(size_t)(16 * kk + 8 * h + 2 * j) * 1024], W2[(size_t)(16 * kk + 8 * h + 2 * j + 1) * 1024]);
        *(u32x4*)(lfr + (kk * 64 + lane) * 16) = pk; }
    }
    const float bias = (mat ? p.in[16] : p.in[13])[(jl * 2 + z) * 1024 + head * 64 + 32 * ntt + r];
    const float kkc = p.in[19][jl * 1024 + head * 64 + lane], kac = p.in[20][jl * 1024 + head * 64 + lane], rkc = p.in[21][jl * 1024 + head * 64 + lane];
    f32x16 st0, st1;
#pragma unroll
    for (int q = 0; q < 16; ++q) { st0[q] = 0.f; st1[q] = 0.f; }
    const size_t stbase = ((((size_t)(b * 2 + jl) * 2 + z) * 16 + head) * 64 + (32 * (wave & 1) + r)) * 64;
    if (g && wave < 2) {
#pragma unroll
      for (int gq = 0; gq < 4; ++gq) {
        const float4 s0 = *(const float4*)(p.in[2] + stbase + 8 * gq + 4 * h), s1 = *(const float4*)(p.in[2] + stbase + 32 + 8 * gq + 4 * h);
        st0[4 * gq] = s0.x; st0[4 * gq + 1] = s0.y; st0[4 * gq + 2] = s0.z; st0[4 * gq + 3] = s0.w;
        st1[4 * gq] = s1.x; st1[4 * gq + 1] = s1.y; st1[4 * gq + 2] = s1.z; st1[4 * gq + 3] = s1.w;
      }
    }
    u32x4 pre[3];
#define SCAN_LOAD(sc_)                                                                                    \
    _Pragma("unroll") for (int i = 0; i < 3; ++i) {                                                       \
      const int id = tid + 512 * i;                                                                       \
      if (id < 1280) {                                                                                    \
        const int arr = id >> 8, s = (id >> 3) & 31, cc = (id & 7) * 8;                                   \
        const int tl = z ? (L - 1 - ((sc_) * 32 + s)) : ((sc_) * 32 + s);                                 \
        const size_t tok = (size_t)b * L + tl;                                                            \
        if (arr < 3) pre[i] = *(const u32x4*)((arr == 0 ? Rg : (arr == 1 ? Kg : Vg)) + tok * 1024 + head * 64 + cc); \
        else pre[i] = *(const u32x4*)(hid + tok * 256 + (arr - 3) * 128 + z * 64 + cc);                   \
      }                                                                                                   \
    }
    SCAN_LOAD(0)
    for (int sc = 0; sc < nsc; ++sc) {
      {
      const int tid = otid(), lane = tid & 63, wave = tid >> 6, r = lane & 31, h = lane >> 5; (void)r; (void)h; (void)lane; (void)wave;
#pragma unroll
      for (int i = 0; i < 3; ++i) {
        const int id = tid + 512 * i;
        if (id < 1280) {
          const int arr = id >> 8, s = (id >> 3) & 31, cc = (id & 7) * 8;
          const u32x4 u = pre[i];
          if (arr < 2) { float* d = (arr == 0 ? sR : sKD) + s * 64 + cc;
            *(float4*)d = make_float4(bflo(u[0]), bfhi(u[0]), bflo(u[1]), bfhi(u[1])); *(float4*)(d + 4) = make_float4(bflo(u[2]), bfhi(u[2]), bflo(u[3]), bfhi(u[3])); }
          else if (arr == 2) {
#pragma unroll
            for (int j = 0; j < 4; ++j) { oUt[(cc + 2 * j) * 40 + s] = (bf16_t)(u[j] & 0xffffu); oUt[(cc + 2 * j + 1) * 40 + s] = (bf16_t)(u[j] >> 16); }
          } else *(u32x4*)((arr == 3 ? sHW : sHA) + s * 72 + cc) = u;
        }
      }
      }
      __syncthreads();
      if (sc + 1 < nsc) { SCAN_LOAD(sc + 1) }
      {
      const int tid = otid(), lane = tid & 63, wave = tid >> 6, r = lane & 31, h = lane >> 5; (void)r; (void)h; (void)lane; (void)wave;
      {
        f32x16 acc;
#pragma unroll
        for (int i = 0; i < 16; ++i) acc[i] = 0.f;
        const int mat = (wave >> 1) & 1, ntt = wave & 1, hi8 = wave >> 2;
        const bf16_t* sH = mat ? sHA : sHW;
#pragma unroll
        for (int kk = 0; kk < 4; ++kk) { const bf16x8 a = *(const bf16x8*)(sH + r * 72 + 16 * kk + 8 * h); const bf16x8 bw = *(const bf16x8*)(lfr + (kk * 64 + lane) * 16); acc = MFMA32(a, bw, acc); }
#pragma unroll
        for (int i = 0; i < 16; ++i) {
          if ((i >> 3) != hi8) continue;
          const int srow = (i & 3) + 8 * (i >> 2) + 4 * h, c = 32 * ntt + r;
          const float xv = acc[i] + bias;
          if (mat == 0) { const float nl = -xv; const float sp = fmaxf(nl, 0.f) + __logf(1.f + __expf(-fabsf(nl))); sW[srow * 64 + c] = __expf(-__expf(-sp - 0.5f)); }
          else sKKA[srow * 64 + c] = 1.f / (1.f + __expf(-xv));
        }
      }
      }
      __syncthreads();
      {
      const int tid = otid(), lane = tid & 63, wave = tid >> 6, r = lane & 31, h = lane >> 5; (void)r; (void)h; (void)lane; (void)wave;
#pragma unroll
      for (int i = 0; i < 4; ++i) {
        const int s = wave + 8 * i; const int c = lane;
        const float kraw = sKD[s * 64 + c], a = sKKA[s * 64 + c], rr = sR[s * 64 + c];
        const float pk = kraw * kkc; const float ss = wave_sum(pk * pk);
        const float kk = pk * rsqrtf(fmaxf(ss, 1e-24f));
        const float kd = kraw * (1.f + (a - 1.f) * kac);
        const float bs = wave_sum(rr * kd * rkc);
        sKD[s * 64 + c] = kd; sKK[s * 64 + c] = kk; sKKA[s * 64 + c] = kk * a;
        if (c == 0) { const int tl = z ? (L - 1 - (sc * 32 + s)) : (sc * 32 + s); bon[(((size_t)b * L + tl) * 16 + head) * 2 + z] = bs; }
      }
      }
      __syncthreads();
      {
        const int k = lane, tq = wave;
        float wq[4];
#pragma unroll
        for (int j = 0; j < 4; ++j) wq[j] = sW[(4 * tq + j) * 64 + k];
        sP[tq * 64 + k] = (wq[0] * wq[1]) * (wq[2] * wq[3]);
        __syncthreads();
        float lam = 1.f;
#pragma unroll
        for (int q = 0; q < 7; ++q) { const float pq = sP[q * 64 + k]; lam *= (q < tq) ? pq : 1.f; }
        u32x2 bt, gt; float nb[4], gg[4];
#pragma unroll
        for (int j = 0; j < 4; ++j) {
          const int t = 4 * tq + j;
          const float lamp = lam; lam = lamp * wq[j];
          const float inv = __builtin_amdgcn_rcpf(lam);
          const float al = lamp * sKK[t * 64 + k], be = sKKA[t * 64 + k] * inv, ga = sKD[t * 64 + k] * inv, rh = lam * sR[t * 64 + k];
          oAL[t * 72 + k] = (bf16_t)f2bf(al); oRH[t * 72 + k] = (bf16_t)f2bf(rh); oBE[t * 72 + k] = (bf16_t)f2bf(be); oGA[t * 72 + k] = (bf16_t)f2bf(ga);
          nb[j] = -be; gg[j] = ga;
        }
        bt[0] = pack2(nb[0], nb[1]); bt[1] = pack2(nb[2], nb[3]); gt[0] = pack2(gg[0], gg[1]); gt[1] = pack2(gg[2], gg[3]);
        *(u32x2*)(oBEt + k * 40 + 4 * tq) = bt; *(u32x2*)(oGAt + k * 40 + 4 * tq) = gt;
        if (tq == 7) lamC[k] = lam;
      }
      __syncthreads();
      {
      const int tid = otid(), lane = tid & 63, wave = tid >> 6, r = lane & 31, h = lane >> 5; (void)r; (void)h; (void)lane; (void)wave;
      if (wave < 4) {
        const bf16_t* As = (wave & 1) ? oGA : oBE; const bf16_t* Bs = (wave < 2) ? oAL : oRH;
        f32x16 x;
#pragma unroll
        for (int q = 0; q < 16; ++q) x[q] = 0.f;
#pragma unroll
        for (int s = 0; s < 4; ++s) { const bf16x8 a = *(const bf16x8*)(As + r * 72 + 16 * s + 8 * h); const bf16x8 bb = *(const bf16x8*)(Bs + r * 72 + 16 * s + 8 * h); x = MFMA32(a, bb, x); }
#pragma unroll
        for (int q = 0; q < 16; ++q) { const int i = (q & 3) + 8 * (q >> 2) + 4 * h; const bool keep = (wave < 2) ? (i < r) : (i <= r); x[q] = keep ? x[q] : 0.f; }
        if (wave == 0) {
#pragma unroll
          for (int gq = 0; gq < 4; ++gq) *(float4*)(Bm + r * 36 + 8 * gq + 4 * h) = make_float4(x[4 * gq], x[4 * gq + 1], x[4 * gq + 2], x[4 * gq + 3]);
        } else {
          const float sg = (wave == 2) ? -1.f : 1.f;
#pragma unroll
          for (int s = 0; s < 2; ++s) { u32x4 pk;
#pragma unroll
            for (int j = 0; j < 4; ++j) pk[j] = pack2(sg * x[8 * s + 2 * j], sg * x[8 * s + 2 * j + 1]);
            *(u32x4*)(frag + (((wave - 1) * 2 + s) * 64 + lane) * 16) = pk; }
        }
      }
      }
      __syncthreads();
      f32x16 y0;
#pragma unroll
      for (int q = 0; q < 16; ++q) y0[q] = 0.f;
      const int vloc = 32 * (wave & 1) + r;
      if (wave < 2) {
        f32x16 a0;
#pragma unroll
        for (int q = 0; q < 16; ++q) a0[q] = 0.f;
#pragma unroll
        for (int kb = 0; kb < 2; ++kb)
#pragma unroll
          for (int s = 0; s < 2; ++s) {
            u32x4 pk;
#pragma unroll
            for (int j = 0; j < 4; ++j) pk[j] = kb ? pack2(st1[8 * s + 2 * j], st1[8 * s + 2 * j + 1]) : pack2(st0[8 * s + 2 * j], st0[8 * s + 2 * j + 1]);
            const bf16x8 sf = __builtin_bit_cast(bf16x8, pk);
            const int ko = 32 * kb + 16 * s + 4 * h;
            const u32x4 aa = cat8(*(const u32x2*)(oAL + r * 72 + ko), *(const u32x2*)(oAL + r * 72 + ko + 8));
            const u32x4 ar = cat8(*(const u32x2*)(oRH + r * 72 + ko), *(const u32x2*)(oRH + r * 72 + ko + 8));
            a0 = MFMA32(__builtin_bit_cast(bf16x8, aa), sf, a0);
            y0 = MFMA32(__builtin_bit_cast(bf16x8, ar), sf, y0);
          }
#pragma unroll
        for (int s = 0; s < 2; ++s) {
          const bf16x8 fg = *(const bf16x8*)(frag + ((0 * 2 + s) * 64 + lane) * 16);
          const bf16x8 fpg = *(const bf16x8*)(frag + ((2 * 2 + s) * 64 + lane) * 16);
          const u32x4 ub = cat8(*(const u32x2*)(oUt + vloc * 40 + 16 * s + 4 * h), *(const u32x2*)(oUt + vloc * 40 + 16 * s + 4 * h + 8));
          a0 = MFMA32(fg, __builtin_bit_cast(bf16x8, ub), a0);
          y0 = MFMA32(fpg, __builtin_bit_cast(bf16x8, ub), y0);
        }
#pragma unroll
        for (int q = 0; q < 16; ++q) RHS[((q & 3) + 8 * (q >> 2) + 4 * h) * 64 + vloc] = a0[q];
        float* park = sR + wave * 3072 + lane * 4;
#pragma unroll
        for (int gq = 0; gq < 4; ++gq) {
          *(float4*)(park + gq * 256) = make_float4(st0[4 * gq], st0[4 * gq + 1], st0[4 * gq + 2], st0[4 * gq + 3]);
          *(float4*)(park + 1024 + gq * 256) = make_float4(st1[4 * gq], st1[4 * gq + 1], st1[4 * gq + 2], st1[4 * gq + 3]);
          *(float4*)(park + 2048 + gq * 256) = make_float4(y0[4 * gq], y0[4 * gq + 1], y0[4 * gq + 2], y0[4 * gq + 3]);
        }
      }
      __syncthreads();
      {
      const int tid = otid(), lane = tid & 63, wave = tid >> 6, r = lane & 31, h = lane >> 5; (void)r; (void)h; (void)lane; (void)wave;
      if (wave < 2) {
        float zv[32];
        const __attribute__((address_space(3))) float* Bmo = (const __attribute__((address_space(3))) float*)Bm;
        const __attribute__((address_space(3))) float* RHo = (const __attribute__((address_space(3))) float*)(RHS + vloc);
        asm volatile("" : "+v"(Bmo), "+v"(RHo));
#pragma unroll
        for (int t = 0; t < 32; ++t) zv[t] = 0.f;
        float4 cb[8], nb8[8]; float crhs = RHo[0], nrhs = 0.f;
#pragma unroll
        for (int q = 0; q < 8; ++q) { cb[q] = make_float4(0.f, 0.f, 0.f, 0.f); nb8[q] = make_float4(0.f, 0.f, 0.f, 0.f); }
#pragma unroll
        for (int t = 0; t < 32; ++t) {
          if (t + 1 < 32) {
            nrhs = RHo[(t + 1) * 64];
#pragma unroll
            for (int i4 = 0; i4 < (t + 4) / 4; ++i4) { typedef float f4v __attribute__((ext_vector_type(4))); const f4v q4 = *(const __attribute__((address_space(3))) f4v*)(Bmo + (t + 1) * 36 + 4 * i4); nb8[i4] = make_float4(q4[0], q4[1], q4[2], q4[3]); }
          }
          float a0s = crhs, a1s = 0.f, a2s = 0.f, a3s = 0.f;
#pragma unroll
          for (int i4 = 0; i4 < (t + 3) / 4; ++i4) {
            a0s -= cb[i4].x * zv[4 * i4]; a1s -= cb[i4].y * zv[4 * i4 + 1]; a2s -= cb[i4].z * zv[4 * i4 + 2]; a3s -= cb[i4].w * zv[4 * i4 + 3];
          }
          zv[t] = (a0s + a1s) + (a2s + a3s);
          asm volatile("" : "+v"(zv[t]) :: "memory");
          crhs = nrhs;
#pragma unroll
          for (int i4 = 0; i4 < 8; ++i4) cb[i4] = nb8[i4];
        }
        if (h == 0) {
#pragma unroll
          for (int q = 0; q < 4; ++q) { u32x4 o;
#pragma unroll
            for (int j = 0; j < 4; ++j) o[j] = pack2(zv[8 * q + 2 * j], zv[8 * q + 2 * j + 1]);
            *(u32x4*)(oZt + vloc * 40 + 8 * q) = o; }
        }
      }
      }
      __syncthreads();
      {
      const int tid = otid(), lane = tid & 63, wave = tid >> 6, r = lane & 31, h = lane >> 5; (void)r; (void)h; (void)lane; (void)wave;
      if (wave < 2) {
        { const float* park = sR + wave * 3072 + lane * 4;
#pragma unroll
          for (int gq = 0; gq < 4; ++gq) {
            const float4 a = *(const float4*)(park + gq * 256), bq = *(const float4*)(park + 1024 + gq * 256), cq = *(const float4*)(park + 2048 + gq * 256);
            st0[4 * gq] = a.x; st0[4 * gq + 1] = a.y; st0[4 * gq + 2] = a.z; st0[4 * gq + 3] = a.w;
            st1[4 * gq] = bq.x; st1[4 * gq + 1] = bq.y; st1[4 * gq + 2] = bq.z; st1[4 * gq + 3] = bq.w;
            y0[4 * gq] = cq.x; y0[4 * gq + 1] = cq.y; y0[4 * gq + 2] = cq.z; y0[4 * gq + 3] = cq.w;
          } }
#pragma unroll
        for (int s = 0; s < 2; ++s) {
          const bf16x8 ub = *(const bf16x8*)(oUt + vloc * 40 + 16 * s + 8 * h), zb = *(const bf16x8*)(oZt + vloc * 40 + 16 * s + 8 * h);
          const bf16x8 g0 = *(const bf16x8*)(oGAt + r * 40 + 16 * s + 8 * h), g1 = *(const bf16x8*)(oGAt + (32 + r) * 40 + 16 * s + 8 * h);
          const bf16x8 b0 = *(const bf16x8*)(oBEt + r * 40 + 16 * s + 8 * h), b1 = *(const bf16x8*)(oBEt + (32 + r) * 40 + 16 * s + 8 * h);
          st0 = MFMA32(g0, ub, st0); st0 = MFMA32(b0, zb, st0);
          st1 = MFMA32(g1, ub, st1); st1 = MFMA32(b1, zb, st1);
          const bf16x8 fpb = *(const bf16x8*)(frag + ((1 * 2 + s) * 64 + lane) * 16);
          const u32x4 z8 = cat8(*(const u32x2*)(oZt + vloc * 40 + 16 * s + 4 * h), *(const u32x2*)(oZt + vloc * 40 + 16 * s + 4 * h + 8));
          y0 = MFMA32(fpb, __builtin_bit_cast(bf16x8, z8), y0);
        }
#pragma unroll
        for (int gq = 0; gq < 4; ++gq) {
          const float4 l0 = *(const float4*)(lamC + 8 * gq + 4 * h), l1 = *(const float4*)(lamC + 32 + 8 * gq + 4 * h);
          st0[4 * gq] *= l0.x; st0[4 * gq + 1] *= l0.y; st0[4 * gq + 2] *= l0.z; st0[4 * gq + 3] *= l0.w;
          st1[4 * gq] *= l1.x; st1[4 * gq + 1] *= l1.y; st1[4 * gq + 2] *= l1.z; st1[4 * gq + 3] *= l1.w;
        }
#pragma unroll
        for (int q = 0; q < 16; ++q) {
          const int t = (q & 3) + 8 * (q >> 2) + 4 * h; const int tl = z ? (L - 1 - (sc * 32 + t)) : (sc * 32 + t);
          Yg[((size_t)b * L + tl) * 1024 + head * 64 + vloc] = (bf16_t)f2bf(y0[q]);
        }
      }
      }
      __syncthreads();
    }
#undef SCAN_LOAD
    if (g == 0 && wave < 2) {
#pragma unroll
      for (int gq = 0; gq < 4; ++gq) {
        *(float4*)(p.out + OUT_ST + stbase + 8 * gq + 4 * h) = make_float4(st0[4 * gq], st0[4 * gq + 1], st0[4 * gq + 2], st0[4 * gq + 3]);
        *(float4*)(p.out + OUT_ST + stbase + 32 + 8 * gq + 4 * h) = make_float4(st1[4 * gq], st1[4 * gq + 1], st1[4 * gq + 2], st1[4 * gq + 3]);
      }
    }
    __syncthreads();
  }
}

DI void phase_rwkv_combine(const P& p, int g, int jl) {
  const int T = g ? 16384 : 8192;
  const int tid = otid(); const int lane = tid & 63, wave = tid >> 6;
  bf16_t* slots = (bf16_t*)(p.ws + WS_SLOT);
  const float* bon = (const float*)(p.ws + WS_BON);
  for (int t = blockIdx.x * 8 + wave; t < T; t += gridDim.x * 8) {
    const size_t o = (size_t)t * 1024 + 16 * lane; const int head = lane >> 2;
    float y[16], v[16], gg[16];
#pragma unroll
    for (int q = 0; q < 2; ++q) {
      const u32x4 a = *(const u32x4*)(slots + 5 * SLOT_ELEMS + o + 8 * q), bq = *(const u32x4*)(slots + 0 * SLOT_ELEMS + o + 8 * q);
      const u32x4 vq = *(const u32x4*)(slots + 3 * SLOT_ELEMS + o + 8 * q), gq = *(const u32x4*)(slots + 4 * SLOT_ELEMS + o + 8 * q);
#pragma unroll
      for (int i = 0; i < 4; ++i) { y[8 * q + 2 * i] = bflo(a[i]) + bflo(bq[i]); y[8 * q + 2 * i + 1] = bfhi(a[i]) + bfhi(bq[i]);
        v[8 * q + 2 * i] = bflo(vq[i]); v[8 * q + 2 * i + 1] = bfhi(vq[i]); gg[8 * q + 2 * i] = bflo(gq[i]); gg[8 * q + 2 * i + 1] = bfhi(gq[i]); }
    }
    float s = 0.f;
#pragma unroll
    for (int i = 0; i < 16; ++i) s += y[i];
    const float mean = quad_sum(s) * (1.f / 64.f);
    float vs = 0.f;
#pragma unroll
    for (int i = 0; i < 16; ++i) { const float d = y[i] - mean; vs += d * d; }
    const float rstd = rsqrtf(quad_sum(vs) * (1.f / 64.f) + 64e-5f);
    const float bs = bon[((size_t)t * 16 + head) * 2] + bon[((size_t)t * 16 + head) * 2 + 1];
    const float* gw = p.in[22] + jl * 1024 + 16 * lane; const float* gb = p.in[23] + jl * 1024 + 16 * lane;
    float ov[16];
#pragma unroll
    for (int i = 0; i < 16; ++i) ov[i] = ((y[i] - mean) * rstd * gw[i] + gb[i] + bs * v[i]) * silu(gg[i]);
#pragma unroll
    for (int q = 0; q < 2; ++q) { u32x4 w; w[0] = pack2(ov[8 * q], ov[8 * q + 1]); w[1] = pack2(ov[8 * q + 2], ov[8 * q + 3]); w[2] = pack2(ov[8 * q + 4], ov[8 * q + 5]); w[3] = pack2(ov[8 * q + 6], ov[8 * q + 7]);
      *(u32x4*)(slots + 4 * SLOT_ELEMS + o + 8 * q) = w; }
  }
}

DI void phase_conv(const P& p, int g) {
  const int T = g ? 16384 : 8192, Lmask = g ? 4095 : 255;
  bf16_t* slots = (bf16_t*)(p.ws + WS_SLOT);
  const bf16_t* BG = slots + 2 * SLOT_ELEMS; const bf16_t* CG = slots + 3 * SLOT_ELEMS; const bf16_t* U = slots + 4 * SLOT_ELEMS; const bf16_t* G = slots + 5 * SLOT_ELEMS;
  bf16_t* O = slots;
  for (int e = blockIdx.x * NT + otid(); e < T * 128; e += gridDim.x * NT) {
    const int t = e >> 7, c = (e & 127) * 8; const size_t o = (size_t)t * 1024 + c; const int tl = t & Lmask;
    const u32x4 zz = {0u, 0u, 0u, 0u};
    const u32x4 c1 = *(const u32x4*)(CG + o), u1 = *(const u32x4*)(U + o);
    const u32x4 c0 = tl != 0 ? *(const u32x4*)(CG + o - 1024) : zz, u0 = tl != 0 ? *(const u32x4*)(U + o - 1024) : zz;
    const u32x4 c2 = tl != Lmask ? *(const u32x4*)(CG + o + 1024) : zz, u2 = tl != Lmask ? *(const u32x4*)(U + o + 1024) : zz;
    const u32x4 bg = *(const u32x4*)(BG + o), gg = *(const u32x4*)(G + o);
    const float* cw = p.in[30]; const float* cb = p.in[31];
    u32x4 w;
#pragma unroll
    for (int i = 0; i < 4; ++i) {
      const int ch = c + 2 * i;
      const float lo = bflo(bg[i]) * (cw[ch] * bflo(c0[i]) * bflo(u0[i]) + cw[1024 + ch] * bflo(c1[i]) * bflo(u1[i]) + cw[2048 + ch] * bflo(c2[i]) * bflo(u2[i]) + cb[ch]) * silu(bflo(gg[i]));
      const float hi = bfhi(bg[i]) * (cw[ch + 1] * bfhi(c0[i]) * bfhi(u0[i]) + cw[1024 + ch + 1] * bfhi(c1[i]) * bfhi(u1[i]) + cw[2048 + ch + 1] * bfhi(c2[i]) * bfhi(u2[i]) + cb[ch + 1]) * silu(bfhi(gg[i]));
      w[i] = pack2(lo, hi);
    }
    *(u32x4*)(O + o) = w;
  }
}

DI void phase_attn(const P& p, int g, unsigned char* lds) {
  const int tid = otid(), lane = tid & 63, wave = tid >> 6, r = lane & 31, h = lane >> 5;
  const int L = g ? 4096 : 256, Ltot = g ? 4352 : 256, B = g ? 4 : 32;
  const int nq = L >> 6, ntasks = B * 4 * nq, nkt = Ltot >> 6;
  bf16_t* slots = (bf16_t*)(p.ws + WS_SLOT);
  bf16_t* Q = slots + 2 * SLOT_ELEMS; const bf16_t* G = slots + 3 * SLOT_ELEMS;
  const bf16_t* Kb = slots + 4 * SLOT_ELEMS; const bf16_t* Vt = Kb + SLOT_ELEMS / 2;
  const float SC = 0.125f * 1.4426950408889634f;
  for (int task = blockIdx.x; task < ntasks; task += gridDim.x) {
    const int qt = task % nq, kvh = (task / nq) & 3, b = task / (nq * 4);
    const int head = kvh * 4 + (wave >> 1); const int q0 = qt * 64 + (wave & 1) * 32;
    const size_t tok = (size_t)b * L + q0 + r;
    bf16x8 qf[4];
#pragma unroll
    for (int ds = 0; ds < 4; ++ds) qf[ds] = *(const bf16x8*)(Q + tok * 1024 + head * 64 + ds * 16 + h * 8);
    float m = -1e30f, lsum = 0.f;
    f32x16 O0, O1;
#pragma unroll
    for (int i = 0; i < 16; ++i) { O0[i] = 0.f; O1[i] = 0.f; }
    const int lrow = tid >> 3, lc = (tid & 7) * 8;
    const bf16_t* gK = Kb + ((size_t)b * Ltot + lrow) * 256 + kvh * 64 + lc;
    const bf16_t* gV = Vt + ((size_t)(b * 4 + kvh) * 64 + lrow) * Ltot + lc;
    u32x4 rk = *(const u32x4*)gK, rv = *(const u32x4*)gV;
    *(u32x4*)(lds + lrow * 144 + lc * 2) = rk; *(u32x4*)(lds + 9216 + lrow * 144 + lc * 2) = rv;
    __syncthreads();
    for (int kt = 0; kt < nkt; ++kt) {
      const unsigned char* cur = lds + (kt & 1) * 18432; unsigned char* nxt = lds + ((kt + 1) & 1) * 18432;
      if (kt + 1 < nkt) { rk = *(const u32x4*)(gK + (size_t)(kt + 1) * 64 * 256); rv = *(const u32x4*)(gV + (kt + 1) * 64); }
      f32x16 s0, s1;
#pragma unroll
      for (int i = 0; i < 16; ++i) { s0[i] = 0.f; s1[i] = 0.f; }
#pragma unroll
      for (int ds = 0; ds < 4; ++ds) {
        const bf16x8 a0 = *(const bf16x8*)(cur + r * 144 + (ds * 16 + h * 8) * 2);
        const bf16x8 a1 = *(const bf16x8*)(cur + (32 + r) * 144 + (ds * 16 + h * 8) * 2);
        s0 = MFMA32(a0, qf[ds], s0); s1 = MFMA32(a1, qf[ds], s1);
      }
      float tmax = s0[0];
#pragma unroll
      for (int i = 1; i < 16; ++i) tmax = fmaxf(tmax, s0[i]);
#pragma unroll
      for (int i = 0; i < 16; ++i) tmax = fmaxf(tmax, s1[i]);
      tmax = fmaxf(tmax, __shfl_xor(tmax, 32));
      const float mnew = fmaxf(m, tmax * SC);
      const float alpha = __builtin_amdgcn_exp2f(m - mnew);
      float ps = 0.f;
#pragma unroll
      for (int i = 0; i < 16; ++i) { s0[i] = __builtin_amdgcn_exp2f(s0[i] * SC - mnew); s1[i] = __builtin_amdgcn_exp2f(s1[i] * SC - mnew); ps += s0[i] + s1[i]; }
      lsum = lsum * alpha + ps; m = mnew;
#pragma unroll
      for (int i = 0; i < 16; ++i) { O0[i] *= alpha; O1[i] *= alpha; }
      const unsigned char* vs = cur + 9216;
#pragma unroll
      for (int kb = 0; kb < 2; ++kb)
#pragma unroll
        for (int s = 0; s < 2; ++s) {
          u32x4 pk;
#pragma unroll
          for (int j = 0; j < 4; ++j) pk[j] = kb ? pack2(s1[8 * s + 2 * j], s1[8 * s + 2 * j + 1]) : pack2(s0[8 * s + 2 * j], s0[8 * s + 2 * j + 1]);
          const bf16x8 pf = __builtin_bit_cast(bf16x8, pk);
          const int ko = (32 * kb + 16 * s + 4 * h) * 2;
          { const u32x2 lo = *(const u32x2*)(vs + r * 144 + ko), hi = *(const u32x2*)(vs + r * 144 + ko + 16);
            u32x4 av; av[0] = lo[0]; av[1] = lo[1]; av[2] = hi[0]; av[3] = hi[1];
            O0 = MFMA32(__builtin_bit_cast(bf16x8, av), pf, O0); }
          { const u32x2 lo = *(const u32x2*)(vs + (32 + r) * 144 + ko), hi = *(const u32x2*)(vs + (32 + r) * 144 + ko + 16);
            u32x4 av; av[0] = lo[0]; av[1] = lo[1]; av[2] = hi[0]; av[3] = hi[1];
            O1 = MFMA32(__builtin_bit_cast(bf16x8, av), pf, O1); }
        }
      if (kt + 1 < nkt) { *(u32x4*)(nxt + lrow * 144 + lc * 2) = rk; *(u32x4*)(nxt + 9216 + lrow * 144 + lc * 2) = rv; }
      __syncthreads();
    }
    lsum += __shfl_xor(lsum, 32);
    const float inv = 1.f / lsum;
#pragma unroll
    for (int db = 0; db < 2; ++db)
#pragma unroll
      for (int i4 = 0; i4 < 4; ++i4) {
        const size_t o = tok * 1024 + head * 64 + 32 * db + 8 * i4 + 4 * h;
        const u32x2 gq = *(const u32x2*)(G + o);
        const float v0 = (db ? O1[4 * i4] : O0[4 * i4]) * inv, v1 = (db ? O1[4 * i4 + 1] : O0[4 * i4 + 1]) * inv;
        const float v2 = (db ? O1[4 * i4 + 2] : O0[4 * i4 + 2]) * inv, v3 = (db ? O1[4 * i4 + 3] : O0[4 * i4 + 3]) * inv;
        u32x2 w; w[0] = pack2(v0 * silu(bflo(gq[0])), v1 * silu(bfhi(gq[0]))); w[1] = pack2(v2 * silu(bflo(gq[1])), v3 * silu(bfhi(gq[1])));
        *(u32x2*)(slots + 5 * SLOT_ELEMS + o) = w;
      }
  }
}


#define XB_TMO      128
#define XB_XCNT(j)  (256  + 64 * (j))
#define XB_XSUB(j)  (1280 + 64 * (j))
#define XB_XGEN(j)  (2304 + 64 * (j))
#define XB_TOP      3328
#define XB_TOPGEN   3392
#define XCD_BAR_WORDS 3456
#define XB_SPIN_CAP (1u << 22)
#define LAS __attribute__((address_space(3)))
DI unsigned xb_ld(unsigned* p) { return __hip_atomic_load(p, __ATOMIC_RELAXED, __HIP_MEMORY_SCOPE_AGENT); }
DI unsigned xb_add(unsigned* p, unsigned v) { return __hip_atomic_fetch_add(p, v, __ATOMIC_RELAXED, __HIP_MEMORY_SCOPE_AGENT); }
DI unsigned xb_xcc_id() { return (unsigned)__builtin_amdgcn_s_getreg((3 << 11) | 20) & 0xFu; }
#define XB_SPIN(cond, bar) do { unsigned _sp = 0; while (cond) { __builtin_amdgcn_s_sleep(1); \
    if ((++_sp & 255u) == 0u) { if (xb_ld(&(bar)[XB_TMO])) break; if (_sp > XB_SPIN_CAP) { atomicAdd(&(bar)[XB_TMO], 1u); break; } } } } while (0)
struct XcdBarrier { unsigned* bar; unsigned x; volatile LAS unsigned* st; };
DI XcdBarrier xcd_barrier_post(unsigned* bar, volatile LAS unsigned* st) {
  XcdBarrier b; b.bar = bar; b.x = xb_xcc_id(); b.st = st;
  if (threadIdx.x == 0) (void)xb_add(&bar[XB_XCNT(b.x)], 1u);
  return b;
}
DI void xcd_barrier_complete(unsigned* bar, unsigned x, unsigned& nloc, unsigned& nx) {
  const unsigned G = gridDim.x * gridDim.y * gridDim.z;
  unsigned sum, cnt, mine, sp = 0u;
  for (;;) {
    sum = 0u; cnt = 0u; mine = 0u;
#pragma unroll
    for (unsigned j = 0; j < 16; ++j) { const unsigned c = xb_ld(&bar[XB_XCNT(j)]); sum += c; cnt += (c > 0u) ? 1u : 0u; mine = (j == x) ? c : mine; }
    if (sum == G) break;
    __builtin_amdgcn_s_sleep(1);
    if ((++sp & 255u) == 0u) { if (xb_ld(&bar[XB_TMO])) break; if (sp > XB_SPIN_CAP) { atomicAdd(&bar[XB_TMO], 1u); break; } }
  }
  nloc = mine > 0u ? mine : 1u; nx = cnt > 0u ? cnt : 1u;
}
DI void xcd_barrier(const XcdBarrier& b) {
  asm volatile("s_waitcnt vmcnt(0)" ::: "memory");
  __syncthreads();
  if (threadIdx.x == 0) {
    unsigned* bar = b.bar;
    __builtin_amdgcn_s_waitcnt(0);
    unsigned nloc = b.st[0], nx = b.st[1];
    if (nloc == 0u) { xcd_barrier_complete(bar, b.x, nloc, nx); b.st[0] = nloc; b.st[1] = nx; }
    const unsigned old = xb_add(&bar[XB_XSUB(b.x)], 1u);
    const unsigned gen = old / nloc;
    if (old + 1u == (gen + 1u) * nloc) {
      __builtin_amdgcn_fence(__ATOMIC_RELEASE, "agent");
      asm volatile("s_waitcnt vmcnt(0)" ::: "memory");
      const unsigned og = xb_add(&bar[XB_TOP], 1u);
      const unsigned tg = og / nx;
      if (og + 1u == (tg + 1u) * nx) xb_add(&bar[XB_TOPGEN], 1u);
      else XB_SPIN(xb_ld(&bar[XB_TOPGEN]) == tg, bar);
      __builtin_amdgcn_fence(__ATOMIC_ACQUIRE, "agent");
      xb_add(&bar[XB_XGEN(b.x)], 1u);
      asm volatile("s_waitcnt vmcnt(0)" ::: "memory");
    } else {
      XB_SPIN(xb_ld(&bar[XB_XGEN(b.x)]) == gen, bar);
      __builtin_amdgcn_fence(__ATOMIC_ACQUIRE, "agent");
      asm volatile("s_waitcnt vmcnt(0)" ::: "memory");
    }
  }
  __syncthreads();
}

#define GPTR(T, x) ((T*)(__attribute__((address_space(1))) T*)(x))
__global__ void __launch_bounds__(NT) mega(P p) {
  extern __shared__ __attribute__((aligned(16))) unsigned char lds[];
  cg::grid_group grid = cg::this_grid();
  volatile LAS unsigned* st = (volatile LAS unsigned*)(lds + 135168);
  if (threadIdx.x < 4) st[threadIdx.x] = 0u;
  __syncthreads();
  const XcdBarrier xbar = xcd_barrier_post((unsigned*)(p.ws + WS_BAR), st);
  phase0(p, lds);
  grid.sync();
  const P& p0 = p;
  for (int step = 0; step < 50; ++step) {
    const int g = step / 25, rem = step - g * 25, layer = rem / 5, sub = rem - layer * 5;
    const int kind = layer % 3, jl = layer / 3;
    const int T = g ? 16384 : 8192, Lmask = g ? 4095 : 255;
    int op = -1;
    if (layer == 4) op = (sub == 0) ? 0 : -1;
    else if (sub == 0) op = 0;
    else if (kind == 0) op = sub == 1 ? 1 : (sub == 2 ? 2 : (sub == 3 ? 3 : 4));
    else if (kind == 1) op = sub == 1 ? 5 : (sub == 2 ? 6 : (sub == 3 ? 4 : -1));
    else op = sub == 1 ? 4 : (sub == 2 ? 7 : (sub == 3 ? 4 : -1));
    if (op < 0) continue;
    P p = p0;
    { size_t zo_ = 0; asm volatile("" : "+s"(zo_)); p.ws = p0.ws + zo_; p.out = p0.out + zo_; }
    bf16_t* slots = (bf16_t*)(p.ws + WS_SLOT);
    const bf16_t* W = (const bf16_t*)(p.ws + WS_W);
    if (op == 0) {
      const float* xin = p.in[g]; float* xout = p.out + (g ? OUT_YS : OUT_YP);
      phase_norm(p, g, layer - 1, layer < 4 ? layer : -1, layer <= 1 ? xin : xout, xout, slots + SLOT_ELEMS, slots);
      if (kind == 1 && g == 1 && layer < 4) phase_cache_copy(p);
    } else if (op == 1) {
      for (int rep = 0; rep < opq(REP_GEMM); ++rep) phase_gemm<1, 0>(p, g, slots, W + (size_t)(RW_IN0 + jl * RW_STRIDE) * 1024, T, 4352, p.in[11] + jl * 6144, Lmask, slots + SLOT_ELEMS, 1, lds);
    } else if (op == 2) {
      for (int rep = 0; rep < opq(REP_SCAN); ++rep) phase_scan(p, g, jl, lds);
    } else if (op == 3) {
      phase_rwkv_combine(p, g, jl);
    } else if (op == 4) {
      const bf16_t* A; const bf16_t* Bt; int N; bf16_t* dst;
      if (sub == 1) { A = slots; Bt = W + (size_t)CV_IN * 1024; N = 4096; dst = slots + 2 * SLOT_ELEMS; }
      else {
        N = 1024; dst = slots + SLOT_ELEMS;
        if (kind == 0) { A = slots + 4 * SLOT_ELEMS; Bt = W + (size_t)(RW_OUT0 + jl * RW_STRIDE) * 1024; }
        else if (kind == 1) { A = slots + 5 * SLOT_ELEMS; Bt = W + (size_t)AT_OUT * 1024; }
        else { A = slots; Bt = W + (size_t)CV_OUT * 1024; }
      }
      for (int rep = 0; rep < opq(REP_GEMM); ++rep) phase_gemm<0, 0>(p, g, A, Bt, T, N, nullptr, 0, dst, 0, lds);
    } else if (op == 5) {
      for (int rep = 0; rep < opq(REP_GEMM); ++rep) phase_gemm<0, 1>(p, g, slots, W + (size_t)AT_IN * 1024, T, 2560, nullptr, 0, nullptr, 0, lds);
    } else if (op == 6) {
      for (int rep = 0; rep < opq(REP_ATTN); ++rep) phase_attn(p, g, lds);
    } else {
      phase_conv(p, g);
    }
    if (!(g == 1 && layer == 4)) for (int rep = 0; rep < opq(REP_SYNC); ++rep) xcd_barrier(xbar);
  }
}

extern "C" void kernel_launch(void* const* d_in, const int* in_sizes, int n_in, void* d_out, int out_size, void* d_ws, size_t ws_size, hipStream_t stream) {
  static int grid_blocks = 0;
  if (!grid_blocks) {
    int dev = 0, cus = 0, per_cu = 0;
    hipGetDevice(&dev);
    hipDeviceGetAttribute(&cus, hipDeviceAttributeMultiprocessorCount, dev);
    hipFuncSetAttribute((const void*)mega, hipFuncAttributeMaxDynamicSharedMemorySize, LDS_BYTES);
    hipOccupancyMaxActiveBlocksPerMultiprocessor(&per_cu, (const void*)mega, NT, LDS_BYTES);
    if (per_cu < 1) per_cu = 1;
    if (per_cu > 1) per_cu = 1;
    grid_blocks = cus * per_cu;
    if (ws_size < WS_SLOT + 6 * SLOT_ELEMS * 2) fprintf(stderr, "workspace too small: %zu\n", ws_size);
  }
  (void)hipMemsetAsync((unsigned char*)d_ws + WS_BAR, 0, XCD_BAR_WORDS * sizeof(unsigned), stream);
  P p{};
  for (int i = 0; i < 33; ++i) p.in[i] = (const float*)d_in[i];
  p.out = (float*)d_out; p.ws = (unsigned char*)d_ws;
  void* args[] = {&p};
  hipError_t e = hipLaunchCooperativeKernel((const void*)mega, dim3(grid_blocks), dim3(NT), args, LDS_BYTES, stream);
  if (e != hipSuccess) fprintf(stderr, "cooperative launch failed: %s (grid %d)\n", hipGetErrorString(e), grid_blocks);
}
```

```cpp
#include <hip/hip_runtime.h>
#include <hip/hip_cooperative_groups.h>
#include <cstdio>
namespace cg = cooperative_groups;

typedef unsigned short bf16_t;
using bf16x8 = __attribute__((ext_vector_type(8))) short;
using f32x16 = __attribute__((ext_vector_type(16))) float;
using u32x4 = __attribute__((ext_vector_type(4))) unsigned;
using u32x2 = __attribute__((ext_vector_type(2))) unsigned;

#define NT 512
#ifndef REP_GEMM
#define REP_GEMM 1
#endif
#ifndef REP_SCAN
#define REP_SCAN 1
#endif
#ifndef REP_ATTN
#define REP_ATTN 1
#endif
#ifndef REP_SYNC
#define REP_SYNC 1
#endif
#define DI __device__ __forceinline__
#define MFMA32(a, b, c) __builtin_amdgcn_mfma_f32_32x32x16_bf16((a), (b), (c), 0, 0, 0)

struct P { const float* in[33]; float* out; unsigned char* ws; };

constexpr size_t WS_ADA = 0;
constexpr size_t WS_ROPE = 262144;
constexpr size_t WS_BON = 327680;
constexpr size_t WS_HID = WS_BON + 2097152;
constexpr size_t WS_W = WS_HID + 8388608;
constexpr size_t WS_SLOT = WS_W + 39845888;
constexpr size_t SLOT_ELEMS = (size_t)16384 * 1024;
constexpr int RW_IN0 = 0, RW_OUT0 = 4352, RW_STRIDE = 5376, AT_IN = 10752, AT_OUT = 13312, CV_IN = 14336, CV_OUT = 18432;
constexpr size_t OUT_YP = 0, OUT_YS = 8388608, OUT_ST = 25165824, OUT_CK = 33554432, OUT_CV = 35651584;
constexpr int LDS_BYTES = 135168 + 16;
constexpr size_t WS_BAR = 278528;

typedef __bf16 bf16x2_t __attribute__((ext_vector_type(2)));
typedef float f32x2_t __attribute__((ext_vector_type(2)));
DI unsigned pack2(float a, float b) { f32x2_t v = {a, b}; return __builtin_bit_cast(unsigned, __builtin_convertvector(v, bf16x2_t)); }
DI unsigned f2bf(float x) { return (unsigned)__builtin_bit_cast(unsigned short, (__bf16)x); }
DI float bflo(unsigned u) { return __uint_as_float(u << 16); }
DI float bfhi(unsigned u) { return __uint_as_float(u & 0xffff0000u); }
DI float bf1(bf16_t u) { return __uint_as_float(((unsigned)u) << 16); }

template <int CTRL> DI float dppf(float v) { return __int_as_float(__builtin_amdgcn_update_dpp(0, __float_as_int(v), CTRL, 0xF, 0xF, true)); }
DI float reduce16(float v) { v += dppf<0xB1>(v); v += dppf<0x4E>(v); v += dppf<0x141>(v); v += dppf<0x140>(v); return v; }
DI float wave_sum(float v) { v = reduce16(v); v += __shfl_xor(v, 16); v += __shfl_xor(v, 32); return v; }
DI float quad_sum(float v) { v += dppf<0xB1>(v); v += dppf<0x4E>(v); return v; }
DI float silu(float x) { return x / (1.f + __expf(-x)); }
DI int opq(int v) { asm volatile("" : "+s"(v)); return v; }
DI int otid() { int t = threadIdx.x; asm volatile("" : "+v"(t)); return t; }

DI void conv_tiles(const float* __restrict__ src, int N, bf16_t* __restrict__ dst, float* lds) {
  const int tid = otid();
  const int tilesN = N >> 6, ntiles = 16 * tilesN;
  for (int tile = blockIdx.x; tile < ntiles; tile += gridDim.x) {
    const int kt = tile / tilesN, nt = tile - kt * tilesN, k0 = kt * 64, n0 = nt * 64;
#pragma unroll
    for (int i = 0; i < 8; ++i) { const int k = (tid >> 6) + 8 * i, n = tid & 63; lds[k * 65 + n] = src[(size_t)(k0 + k) * N + n0 + n]; }
    __syncthreads();
    { const int n = tid >> 3, kc = (tid & 7) * 8; u32x4 o;
#pragma unroll
      for (int j = 0; j < 4; ++j) o[j] = pack2(lds[(kc + 2 * j) * 65 + n], lds[(kc + 2 * j + 1) * 65 + n]);
      *(u32x4*)(dst + (size_t)(n0 + n) * 1024 + k0 + kc) = o; }
    __syncthreads();
  }
}

DI void phase0(const P& p, unsigned char* ldsb) {
  float* lds = (float*)ldsb;
  const int tid = otid();
  bf16_t* W = (bf16_t*)(p.ws + WS_W);
#pragma unroll 1
  for (int e = 0; e < opq(22); ++e) {
    const float* src; int N, drow;
    if (e < 18) {
      const int j = e / 9, q = e - j * 9;
      if (q < 4) { src = p.in[12] + (size_t)(j * 4 + q) * 1048576; N = 1024; drow = RW_IN0 + j * RW_STRIDE + q * 1024; }
      else if (q < 6) { src = p.in[14] + (size_t)(j * 2 + q - 4) * 65536; N = 64; drow = RW_IN0 + j * RW_STRIDE + 4096 + (q - 4) * 64; }
      else if (q < 8) { src = p.in[17] + (size_t)(j * 2 + q - 6) * 65536; N = 64; drow = RW_IN0 + j * RW_STRIDE + 4224 + (q - 6) * 64; }
      else { src = p.in[24] + (size_t)j * 1048576; N = 1024; drow = RW_OUT0 + j * RW_STRIDE; }
    } else if (e == 18) { src = p.in[25]; N = 2560; drow = AT_IN; }
    else if (e == 19) { src = p.in[28]; N = 1024; drow = AT_OUT; }
    else if (e == 20) { src = p.in[29]; N = 4096; drow = CV_IN; }
    else { src = p.in[32]; N = 1024; drow = CV_OUT; }
    conv_tiles(src, N, W + (size_t)drow * 1024, lds);
  }
  {
    float* scond = lds;
    float* red = lds + 5120;
    for (int e = tid; e < 5120; e += NT) { const int cnd = e >> 10, k = e & 1023; const float cv = cnd == 0 ? p.in[6][k] : p.in[5][(cnd - 1) * 1024 + k]; scond[e] = silu(cv); }
    __syncthreads();
    float* ada = (float*)(p.ws + WS_ADA);
    for (int task = blockIdx.x; task < 192; task += gridDim.x) {
      const int layer = task / 48, n0 = (task % 48) * 64, c = tid & 63, kg = tid >> 6;
      float a0 = 0.f, a1 = 0.f, a2 = 0.f, a3 = 0.f, a4 = 0.f;
      const float* wp = p.in[9] + ((size_t)layer * 1024 + kg * 128) * 3072 + n0 + c;
#pragma unroll 8
      for (int k = 0; k < 128; ++k) { const float w = wp[(size_t)k * 3072]; const int kk = kg * 128 + k;
        a0 += scond[kk] * w; a1 += scond[1024 + kk] * w; a2 += scond[2048 + kk] * w; a3 += scond[3072 + kk] * w; a4 += scond[4096 + kk] * w; }
      red[(kg * 5 + 0) * 64 + c] = a0; red[(kg * 5 + 1) * 64 + c] = a1; red[(kg * 5 + 2) * 64 + c] = a2; red[(kg * 5 + 3) * 64 + c] = a3; red[(kg * 5 + 4) * 64 + c] = a4;
      __syncthreads();
      if (tid < 320) { const int cnd = tid >> 6; float s = p.in[10][layer * 3072 + n0 + c];
#pragma unroll
        for (int q = 0; q < 8; ++q) s += red[(q * 5 + cnd) * 64 + c];
        ada[(cnd * 4 + layer) * 3072 + n0 + c] = s; }
      __syncthreads();
    }
  }
  if (blockIdx.x == gridDim.x - 1) {
    float* rope = (float*)(p.ws + WS_ROPE);
    for (int e = tid; e < 1024; e += NT) {
      const int pos = e >> 4, f = e & 15;
      double inv = 1.0; for (int q = 0; q < f; ++q) inv *= 0.5623413251903491;
      double ang = (double)pos * inv;
      const double twopi = 6.283185307179586476925286766559;
      double n = __builtin_rint(ang / twopi); double rr = ang - n * twopi;
      double r2 = rr * rr, sn = 0.0, cs = 0.0, ts = rr, tc = 1.0;
      for (int q = 0; q < 16; ++q) { cs += tc; sn += ts; tc = -tc * r2 / (double)((2 * q + 1) * (2 * q + 2)); ts = -ts * r2 / (double)((2 * q + 2) * (2 * q + 3)); }
      rope[e * 2] = (float)cs; rope[e * 2 + 1] = (float)sn;
    }
  }
}

DI void phase_norm(const P& p, int g, int lpost, int lpre, const float* __restrict__ xsrc, float* __restrict__ xdst,
                   const bf16_t* __restrict__ Mb, bf16_t* __restrict__ H) {
  const int T = g ? 16384 : 8192;
  const int tid = otid(); const int lane = tid & 63, wave = tid >> 6;
  const float* ada = (const float*)(p.ws + WS_ADA);
  for (int t = blockIdx.x * 8 + wave; t < T; t += gridDim.x * 8) {
    const int cond = g ? 1 + (t >> 12) : 0;
    float4 x[4];
#pragma unroll
    for (int i = 0; i < 4; ++i) x[i] = *(const float4*)(xsrc + (size_t)t * 1024 + 256 * i + 4 * lane);
    if (lpost >= 0) {
      float m[16]; float ss = 0.f;
#pragma unroll
      for (int i = 0; i < 4; ++i) { const u32x2 u = *(const u32x2*)(Mb + (size_t)t * 1024 + 256 * i + 4 * lane);
        m[4 * i] = bflo(u[0]); m[4 * i + 1] = bfhi(u[0]); m[4 * i + 2] = bflo(u[1]); m[4 * i + 3] = bfhi(u[1]); }
#pragma unroll
      for (int i = 0; i < 16; ++i) ss += m[i] * m[i];
      ss = wave_sum(ss);
      const float rs = rsqrtf(ss * (1.f / 1024.f) + 1e-6f);
      const float* gate = ada + (cond * 4 + lpost) * 3072 + 2048;
      const float* wpo = p.in[8] + lpost * 1024;
#pragma unroll
      for (int i = 0; i < 4; ++i) { const int c = 256 * i + 4 * lane; const float4 gt = *(const float4*)(gate + c); const float4 wv = *(const float4*)(wpo + c);
        x[i].x += gt.x * (m[4 * i] * rs * wv.x); x[i].y += gt.y * (m[4 * i + 1] * rs * wv.y); x[i].z += gt.z * (m[4 * i + 2] * rs * wv.z); x[i].w += gt.w * (m[4 * i + 3] * rs * wv.w);
        *(float4*)(xdst + (size_t)t * 1024 + c) = x[i]; }
    }
    if (lpre >= 0) {
      float ss = 0.f;
#pragma unroll
      for (int i = 0; i < 4; ++i) ss += x[i].x * x[i].x + x[i].y * x[i].y + x[i].z * x[i].z + x[i].w * x[i].w;
      ss = wave_sum(ss);
      const float rs = rsqrtf(ss * (1.f / 1024.f) + 1e-6f);
      const float* sh = ada + (cond * 4 + lpre) * 3072; const float* sc = sh + 1024; const float* wpr = p.in[7] + lpre * 1024;
#pragma unroll
      for (int i = 0; i < 4; ++i) { const int c = 256 * i + 4 * lane; const float4 s4 = *(const float4*)(sh + c); const float4 c4 = *(const float4*)(sc + c); const float4 wv = *(const float4*)(wpr + c);
        u32x2 o; o[0] = pack2(x[i].x * rs * wv.x * (1.f + c4.x) + s4.x, x[i].y * rs * wv.y * (1.f + c4.y) + s4.y);
        o[1] = pack2(x[i].z * rs * wv.z * (1.f + c4.z) + s4.z, x[i].w * rs * wv.w * (1.f + c4.w) + s4.w);
        *(u32x2*)(H + (size_t)t * 1024 + c) = o; }
    }
  }
}

DI void phase_cache_copy(const P& p) {
  bf16_t* Kb = (bf16_t*)(p.ws + WS_SLOT) + 4 * SLOT_ELEMS; bf16_t* Vt = Kb + SLOT_ELEMS / 2;
  for (int e = blockIdx.x * NT + otid(); e < 262144; e += gridDim.x * NT) {
    const int c = e & 255, pp = (e >> 8) & 255, b = e >> 16; const int kvh = c >> 6, d = c & 63;
    Kb[((size_t)b * 4352 + 4096 + pp) * 256 + c] = (bf16_t)f2bf(p.in[3][e]);
    Vt[((size_t)(b * 4 + kvh) * 64 + d) * 4352 + 4096 + pp] = (bf16_t)f2bf(p.in[4][e]);
  }
}

template <int SHIFT> DI void ld_half(const bf16_t* __restrict__ A, int t, int k, int Lmask, u32x4 (&raw)[4]) {
  raw[1] = *(const u32x4*)(A + (size_t)t * 1024 + k);
  raw[2] = *(const u32x4*)(A + (size_t)(t + 1) * 1024 + k);
  if (SHIFT) {
    raw[0] = (u32x4){0u, 0u, 0u, 0u}; raw[3] = (u32x4){0u, 0u, 0u, 0u};
    if ((t & Lmask) != 0) raw[0] = *(const u32x4*)(A + (size_t)(t - 1) * 1024 + k);
    if (((t + 1) & Lmask) != Lmask) raw[3] = *(const u32x4*)(A + (size_t)(t + 2) * 1024 + k);
  }
}
DI u32x4 mix3(const u32x4& c, const u32x4& pz, const u32x4& nz, const float* smu, int k) {
  const float4 m0 = *(const float4*)(smu + k), m1 = *(const float4*)(smu + k + 4);
  const float mu[8] = {m0.x, m0.y, m0.z, m0.w, m1.x, m1.y, m1.z, m1.w};
  u32x4 o;
#pragma unroll
  for (int i = 0; i < 4; ++i) {
    const float h0 = bflo(c[i]), h1 = bfhi(c[i]);
    const float x0 = h0 + (0.5f * (bflo(pz[i]) + bflo(nz[i])) - h0) * mu[2 * i];
    const float x1 = h1 + (0.5f * (bfhi(pz[i]) + bfhi(nz[i])) - h1) * mu[2 * i + 1];
    o[i] = pack2(x0, x1);
  }
  return o;
}
template <int SHIFT> DI void st_half(unsigned char* dst, const u32x4 (&raw)[4], const float* smu, int k) {
  if (!SHIFT) { *(u32x4*)dst = raw[1]; *(u32x4*)(dst + 144) = raw[2]; }
  else { *(u32x4*)dst = mix3(raw[1], raw[0], raw[2], smu, k); *(u32x4*)(dst + 144) = mix3(raw[2], raw[1], raw[3], smu, k); }
}

template <int SHIFT, int EPI>
DI void phase_gemm(const P& p, int g, const bf16_t* __restrict__ A, const bf16_t* __restrict__ Bt, int M, int N,
                   const float* __restrict__ mu, int Lmask, bf16_t* __restrict__ dst, int rw, unsigned char* lds) {
  const int tid = otid(), lane = tid & 63, wave = tid >> 6;
  const int wm = wave >> 1, wn = wave & 1, r = lane & 31, h = lane >> 5;
  const int ntn = N >> 7, ntiles = ntn * (M >> 8);
  float* Cs = (float*)lds;
  float* smu = (float*)(lds + 110592);
  for (int tile = blockIdx.x; tile < ntiles; tile += gridDim.x) {
    const int mt = tile / ntn, nt = tile - mt * ntn; const int m0 = mt * 256, n0 = nt * 128;
    f32x16 acc[2][2];
#pragma unroll
    for (int a = 0; a < 2; ++a)
#pragma unroll
      for (int b = 0; b < 2; ++b)
#pragma unroll
        for (int i = 0; i < 16; ++i) acc[a][b][i] = 0.f;
    if (SHIFT) {
      const float* mup = mu + (nt < 32 ? (nt >> 3) : (nt == 32 ? 4 : 5)) * 1024;
      smu[tid] = mup[tid]; smu[tid + 512] = mup[tid + 512];
      __syncthreads();
    }
    u32x4 raw[4], rb[2];
    const int arow = 4 * (tid >> 3), akc = (tid & 7) * 8;
#pragma unroll
    for (int hf = 0; hf < 2; ++hf) { ld_half<SHIFT>(A, m0 + arow + 2 * hf, akc, Lmask, raw); st_half<SHIFT>(lds + (arow + 2 * hf) * 144 + akc * 2, raw, smu, akc); }
#pragma unroll
    for (int i = 0; i < 2; ++i) { const int id = tid + 512 * i; rb[i] = *(const u32x4*)(Bt + (size_t)(n0 + (id >> 3)) * 1024 + (id & 7) * 8); }
#pragma unroll
    for (int i = 0; i < 2; ++i) { const int id = tid + 512 * i; *(u32x4*)(lds + 36864 + (id >> 3) * 144 + (id & 7) * 16) = rb[i]; }
    __syncthreads();
    for (int kt = 0; kt < 16; ++kt) {
      unsigned char* cur = lds + (kt & 1) * 55296; unsigned char* nxt = lds + ((kt + 1) & 1) * 55296;
      const int k1 = (kt + 1) * 64;
      if (kt < 15) {
        ld_half<SHIFT>(A, m0 + arow, k1 + akc, Lmask, raw);
        rb[0] = *(const u32x4*)(Bt + (size_t)(n0 + (tid >> 3)) * 1024 + k1 + (tid & 7) * 8);
      }
#pragma unroll
      for (int ks = 0; ks < 4; ++ks) {
        const int ko = (ks * 16 + h * 8) * 2;
        const bf16x8 a0 = *(const bf16x8*)(cur + (wm * 64 + r) * 144 + ko);
        const bf16x8 a1 = *(const bf16x8*)(cur + (wm * 64 + 32 + r) * 144 + ko);
        const bf16x8 b0 = *(const bf16x8*)(cur + 36864 + (wn * 64 + r) * 144 + ko);
        const bf16x8 b1 = *(const bf16x8*)(cur + 36864 + (wn * 64 + 32 + r) * 144 + ko);
        acc[0][0] = MFMA32(a0, b0, acc[0][0]); acc[0][1] = MFMA32(a0, b1, acc[0][1]);
        acc[1][0] = MFMA32(a1, b0, acc[1][0]); acc[1][1] = MFMA32(a1, b1, acc[1][1]);
        if (ks == 1 && kt < 15) {
          st_half<SHIFT>(nxt + arow * 144 + akc * 2, raw, smu, k1 + akc);
          *(u32x4*)(nxt + 36864 + (tid >> 3) * 144 + (tid & 7) * 16) = rb[0];
          ld_half<SHIFT>(A, m0 + arow + 2, k1 + akc, Lmask, raw);
          rb[0] = *(const u32x4*)(Bt + (size_t)(n0 + 64 + (tid >> 3)) * 1024 + k1 + (tid & 7) * 8);
        }
      }
      if (kt < 15) {
        st_half<SHIFT>(nxt + (arow + 2) * 144 + akc * 2, raw, smu, k1 + akc);
        *(u32x4*)(nxt + 36864 + (64 + (tid >> 3)) * 144 + (tid & 7) * 16) = rb[0];
      }
      __syncthreads();
    }
#pragma unroll
    for (int mi = 0; mi < 2; ++mi)
#pragma unroll
      for (int ni = 0; ni < 2; ++ni)
#pragma unroll
        for (int i = 0; i < 16; ++i) {
          const int row = wm * 64 + mi * 32 + (i & 3) + 8 * (i >> 2) + 4 * h, col = wn * 64 + ni * 32 + r;
          Cs[row * 132 + col] = acc[mi][ni][i];
        }
    __syncthreads();
    if (EPI == 0) {
#pragma unroll
      for (int i = 0; i < 8; ++i) {
        const int id = tid + 512 * i, row = id >> 4, cc = (id & 15) * 8;
        float4 v0 = *(const float4*)(Cs + row * 132 + cc), v1 = *(const float4*)(Cs + row * 132 + cc + 4);
        if (rw && nt == 32) { v0.x = tanhf(v0.x); v0.y = tanhf(v0.y); v0.z = tanhf(v0.z); v0.w = tanhf(v0.w); v1.x = tanhf(v1.x); v1.y = tanhf(v1.y); v1.z = tanhf(v1.z); v1.w = tanhf(v1.w); }
        u32x4 o; o[0] = pack2(v0.x, v0.y); o[1] = pack2(v0.z, v0.w); o[2] = pack2(v1.x, v1.y); o[3] = pack2(v1.z, v1.w);
        if (rw && nt >= 32) *(u32x4*)((bf16_t*)(p.ws + WS_HID) + (size_t)(m0 + row) * 256 + (nt - 32) * 128 + cc) = o;
        else *(u32x4*)(dst + (size_t)(nt >> 3) * SLOT_ELEMS + (size_t)(m0 + row) * 1024 + (nt & 7) * 128 + cc) = o;
      }
    } else {
      const int row = tid & 255, hh = tid >> 8; const int t = m0 + row;
      float x[64];
#pragma unroll
      for (int q = 0; q < 16; ++q) { const float4 v = *(const float4*)(Cs + row * 132 + hh * 64 + 4 * q); x[4 * q] = v.x; x[4 * q + 1] = v.y; x[4 * q + 2] = v.z; x[4 * q + 3] = v.w; }
      bf16_t* slots = (bf16_t*)(p.ws + WS_SLOT);
      const int L = g ? 4096 : 256, Ltot = g ? 4352 : 256;
      const int b = g ? (t >> 12) : (t >> 8), s = t & (L - 1);
      if (nt < 10) {
        int vz = 0; asm volatile("" : "+v"(vz));
        const float* nw = (nt < 8 ? p.in[26] : p.in[27]) + vz;
        float ss = 0.f;
#pragma unroll
        for (int d = 0; d < 64; ++d) ss += x[d] * x[d];
        const float rs = rsqrtf(ss * (1.f / 64.f) + 1e-6f);
#pragma unroll
        for (int d = 0; d < 64; ++d) x[d] *= rs * nw[d];
        if (g == 0 && nt >= 8) {
          float* ck = p.out + OUT_CK + (size_t)t * 256 + ((nt - 8) * 2 + hh) * 64;
#pragma unroll
          for (int q = 0; q < 16; ++q) *(float4*)(ck + 4 * q) = make_float4(x[4 * q], x[4 * q + 1], x[4 * q + 2], x[4 * q + 3]);
        }
        if (g == 1) {
          const float2* rope = (const float2*)(p.ws + WS_ROPE);
          const int ri = s >> 6, ci = s & 63;
#pragma unroll
          for (int f = 0; f < 16; ++f) {
            const float2 cr = rope[ri * 16 + f]; const float x1 = x[f], x2 = x[16 + f];
            x[f] = x1 * cr.x - x2 * cr.y; x[16 + f] = x2 * cr.x + x1 * cr.y;
            const float2 cc = rope[ci * 16 + f]; const float y1 = x[32 + f], y2 = x[48 + f];
            x[32 + f] = y1 * cc.x - y2 * cc.y; x[48 + f] = y2 * cc.x + y1 * cc.y;
          }
        }
        bf16_t* dq = nt < 8 ? slots + 2 * SLOT_ELEMS + (size_t)t * 1024 + (nt * 2 + hh) * 64
                            : slots + 4 * SLOT_ELEMS + ((size_t)b * Ltot + s) * 256 + ((nt - 8) * 2 + hh) * 64;
#pragma unroll
        for (int q = 0; q < 8; ++q) { u32x4 o; o[0] = pack2(x[8 * q], x[8 * q + 1]); o[1] = pack2(x[8 * q + 2], x[8 * q + 3]); o[2] = pack2(x[8 * q + 4], x[8 * q + 5]); o[3] = pack2(x[8 * q + 6], x[8 * q + 7]); *(u32x4*)(dq + 8 * q) = o; }
      } else if (nt < 12) {
        const int kvh = (nt - 10) * 2 + hh;
        if (g == 0) {
          float* cv = p.out + OUT_CV + (size_t)t * 256 + kvh * 64;
#pragma unroll
          for (int q = 0; q < 16; ++q) *(float4*)(cv + 4 * q) = make_float4(x[4 * q], x[4 * q + 1], x[4 * q + 2], x[4 * q + 3]);
        }
        bf16_t* vt = slots + 4 * SLOT_ELEMS + SLOT_ELEMS / 2 + ((size_t)(b * 4 + kvh) * 64) * Ltot + s;
#pragma unroll
        for (int d = 0; d < 64; ++d) { *vt = (bf16_t)f2bf(x[d]); vt += Ltot; asm volatile("" : "+v"(vt)); }
      } else {
        bf16_t* dg = slots + 3 * SLOT_ELEMS + (size_t)t * 1024 + (nt - 12) * 128 + hh * 64;
#pragma unroll
        for (int q = 0; q < 8; ++q) { u32x4 o; o[0] = pack2(x[8 * q], x[8 * q + 1]); o[1] = pack2(x[8 * q + 2], x[8 * q + 3]); o[2] = pack2(x[8 * q + 4], x[8 * q + 5]); o[3] = pack2(x[8 * q + 6], x[8 * q + 7]); *(u32x4*)(dg + 8 * q) = o; }
      }
    }
    __syncthreads();
  }
}

DI u32x4 cat8(const u32x2 lo, const u32x2 hi) { u32x4 v; v[0] = lo[0]; v[1] = lo[1]; v[2] = hi[0]; v[3] = hi[1]; return v; }
DI void phase_scan(const P& p, int g, int jl, unsigned char* lds) {
  const int tid = otid(), lane = tid & 63, wave = tid >> 6, r = lane & 31, h = lane >> 5;
  const int L = g ? 4096 : 256, B = g ? 4 : 32, nsc = L >> 5;
  float* sR = (float*)lds; float* sW = sR + 2048; float* sKD = sW + 2048; float* sKK = sKD + 2048; float* sKKA = sKK + 2048;
  bf16_t* sHW = (bf16_t*)(lds + 40960); bf16_t* sHA = (bf16_t*)(lds + 45568);
  bf16_t* oAL = (bf16_t*)(lds + 50176); bf16_t* oRH = (bf16_t*)(lds + 54784); bf16_t* oBE = (bf16_t*)(lds + 59392); bf16_t* oGA = (bf16_t*)(lds + 64000);
  bf16_t* oBEt = (bf16_t*)(lds + 68608); bf16_t* oGAt = (bf16_t*)(lds + 73728); bf16_t* oUt = (bf16_t*)(lds + 78848); bf16_t* oZt = (bf16_t*)(lds + 83968);
  float* Bm = (float*)(lds + 89088); float* RHS = (float*)(lds + 93696); float* lamC = (float*)(lds + 101888); float* sP = (float*)(lds + 102144);
  unsigned char* frag = lds + 104192;
  const bf16_t* slots = (const bf16_t*)(p.ws + WS_SLOT);
  const bf16_t* Rg = slots + 1 * SLOT_ELEMS; const bf16_t* Kg = slots + 2 * SLOT_ELEMS; const bf16_t* Vg = slots + 3 * SLOT_ELEMS;
  const bf16_t* hid = (const bf16_t*)(p.ws + WS_HID);
  float* bon = (float*)(p.ws + WS_BON);
  const int ntasks = B * 32;
  for (int task = blockIdx.x; task < ntasks; task += gridDim.x) {
    const int z = task & 1, head = (task >> 1) & 15, b = task >> 5;
    bf16_t* Yg = (bf16_t*)(p.ws + WS_SLOT) + (z ? 0 : 5) * SLOT_ELEMS;
    const int mat = (wave >> 1) & 1, ntt = wave & 1;
    unsigned char* lfr = lds + 110336 + (wave & 3) * 4096;
    if (wave < 4) {
      const float* W2 = (mat ? p.in[18] : p.in[15]) + (size_t)(jl * 2 + z) * 65536 + head * 64 + 32 * ntt + r;
#pragma unroll
      for (int kk = 0; kk < 4; ++kk) { u32x4 pk;
#pragma unroll
        for (int j = 0; j < 4; ++j) pk[j] = pack2(W2[(size_t)(16 * kk + 8 * h + 2 * j) * 1024], W2[(size_t)(16 * kk + 8 * h + 2 * j + 1) * 1024]);
        *(u32x4*)(lfr + (kk * 64 + lane) * 16) = pk; }
    }
    const float bias = (mat ? p.in[16] : p.in[13])[(jl * 2 + z) * 1024 + head * 64 + 32 * ntt + r];
    const float kkc = p.in[19][jl * 1024 + head * 64 + lane], kac = p.in[20][jl * 1024 + head * 64 + lane], rkc = p.in[21][jl * 1024 + head * 64 + lane];
    f32x16 st0, st1;
#pragma unroll
    for (int q = 0; q < 16; ++q) { st0[q] = 0.f; st1[q] = 0.f; }
    const size_t stbase = ((((size_t)(b * 2 + jl) * 2 + z) * 16 + head) * 64 + (32 * (wave & 1) + r)) * 64;
    if (g && wave < 2) {
#pragma unroll
      for (int gq = 0; gq < 4; ++gq) {
        const float4 s0 = *(const float4*)(p.in[2] + stbase + 8 * gq + 4 * h), s1 = *(const float4*)(p.in[2] + stbase + 32 + 8 * gq + 4 * h);
        st0[4 * gq] = s0.x; st0[4 * gq + 1] = s0.y; st0[4 * gq + 2] = s0.z; st0[4 * gq + 3] = s0.w;
        st1[4 * gq] = s1.x; st1[4 * gq + 1] = s1.y; st1[4 * gq + 2] = s1.z; st1[4 * gq + 3] = s1.w;
      }
    }
    u32x4 pre[3];
#define SCAN_LOAD(sc_)                                                                                    \
    _Pragma("unroll") for (int i = 0; i < 3; ++i) {                                                       \
      const int id = tid + 512 * i;                                                                       \
      if (id < 1280) {                                                                                    \
        const int arr = id >> 8, s = (id >> 3) & 31, cc = (id & 7) * 8;                                   \
        const int tl = z ? (L - 1 - ((sc_) * 32 + s)) : ((sc_) * 32 + s);                                 \
        const size_t tok = (size_t)b * L + tl;                                                            \
        if (arr < 3) pre[i] = *(const u32x4*)((arr == 0 ? Rg : (arr == 1 ? Kg : Vg)) + tok * 1024 + head * 64 + cc); \
        else pre[i] = *(const u32x4*)(hid + tok * 256 + (arr - 3) * 128 + z * 64 + cc);                   \
      }                                                                                                   \
    }
    SCAN_LOAD(0)
    for (int sc = 0; sc < nsc; ++sc) {
      {
      const int tid = otid(), lane = tid & 63, wave = tid >> 6, r = lane & 31, h = lane >> 5; (void)r; (void)h; (void)lane; (void)wave;
#pragma unroll
      for (int i = 0; i < 3; ++i) {
        const int id = tid + 512 * i;
        if (id < 1280) {
          const int arr = id >> 8, s = (id >> 3) & 31, cc = (id & 7) * 8;
          const u32x4 u = pre[i];
          if (arr < 2) { float* d = (arr == 0 ? sR : sKD) + s * 64 + cc;
            *(float4*)d = make_float4(bflo(u[0]), bfhi(u[0]), bflo(u[1]), bfhi(u[1])); *(float4*)(d + 4) = make_float4(bflo(u[2]), bfhi(u[2]), bflo(u[3]), bfhi(u[3])); }
          else if (arr == 2) {
#pragma unroll
            for (int j = 0; j < 4; ++j) { oUt[(cc + 2 * j) * 40 + s] = (bf16_t)(u[j] & 0xffffu); oUt[(cc + 2 * j + 1) * 40 + s] = (bf16_t)(u[j] >> 16); }
          } else *(u32x4*)((arr == 3 ? sHW : sHA) + s * 72 + cc) = u;
        }
      }
      }
      __syncthreads();
      if (sc + 1 < nsc) { SCAN_LOAD(sc + 1) }
      {
      const int tid = otid(), lane = tid & 63, wave = tid >> 6, r = lane & 31, h = lane >> 5; (void)r; (void)h; (void)lane; (void)wave;
      {
        f32x16 acc;
#pragma unroll
        for (int i = 0; i < 16; ++i) acc[i] = 0.f;
        const int mat = (wave >> 1) & 1, ntt = wave & 1, hi8 = wave >> 2;
        const bf16_t* sH = mat ? sHA : sHW;
#pragma unroll
        for (int kk = 0; kk < 4; ++kk) { const bf16x8 a = *(const bf16x8*)(sH + r * 72 + 16 * kk + 8 * h); const bf16x8 bw = *(const bf16x8*)(lfr + (kk * 64 + lane) * 16); acc = MFMA32(a, bw, acc); }
#pragma unroll
        for (int i = 0; i < 16; ++i) {
          if ((i >> 3) != hi8) continue;
          const int srow = (i & 3) + 8 * (i >> 2) + 4 * h, c = 32 * ntt + r;
          const float xv = acc[i] + bias;
          const float sg = __builtin_amdgcn_rcpf(1.f + __expf(-xv));
          if (mat == 0) sW[srow * 64 + c] = __expf(-0.60653065971263342f * sg);
          else sKKA[srow * 64 + c] = sg;
        }
      }
      }
      __syncthreads();
      {
      const int tid = otid(), lane = tid & 63, wave = tid >> 6, r = lane & 31, h = lane >> 5; (void)r; (void)h; (void)lane; (void)wave;
#pragma unroll
      for (int i = 0; i < 4; ++i) {
        const int s = wave + 8 * i; const int c = lane;
        const float kraw = sKD[s * 64 + c], a = sKKA[s * 64 + c], rr = sR[s * 64 + c];
        const float pk = kraw * kkc; const float ss = wave_sum(pk * pk);
        const float kk = pk * rsqrtf(fmaxf(ss, 1e-24f));
        const float kd = kraw * (1.f + (a - 1.f) * kac);
        const float bs = wave_sum(rr * kd * rkc);
        sKD[s * 64 + c] = kd; sKK[s * 64 + c] = kk; sKKA[s * 64 + c] = kk * a;
        if (c == 0) { const int tl = z ? (L - 1 - (sc * 32 + s)) : (sc * 32 + s); bon[(((size_t)b * L + tl) * 16 + head) * 2 + z] = bs; }
      }
      }
      __syncthreads();
      {
        const int k = lane, tq = wave;
        float wq[4];
#pragma unroll
        for (int j = 0; j < 4; ++j) wq[j] = sW[(4 * tq + j) * 64 + k];
        sP[tq * 64 + k] = (wq[0] * wq[1]) * (wq[2] * wq[3]);
        __syncthreads();
        float lam = 1.f;
#pragma unroll
        for (int q = 0; q < 7; ++q) { const float pq = sP[q * 64 + k]; lam *= (q < tq) ? pq : 1.f; }
        u32x2 bt, gt; float nb[4], gg[4];
#pragma unroll
        for (int j = 0; j < 4; ++j) {
          const int t = 4 * tq + j;
          const float lamp = lam; lam = lamp * wq[j];
          const float inv = __builtin_amdgcn_rcpf(lam);
          const float al = lamp * sKK[t * 64 + k], be = sKKA[t * 64 + k] * inv, ga = sKD[t * 64 + k] * inv, rh = lam * sR[t * 64 + k];
          oAL[t * 72 + k] = (bf16_t)f2bf(al); oRH[t * 72 + k] = (bf16_t)f2bf(rh); oBE[t * 72 + k] = (bf16_t)f2bf(be); oGA[t * 72 + k] = (bf16_t)f2bf(ga);
          nb[j] = -be; gg[j] = ga;
        }
        bt[0] = pack2(nb[0], nb[1]); bt[1] = pack2(nb[2], nb[3]); gt[0] = pack2(gg[0], gg[1]); gt[1] = pack2(gg[2], gg[3]);
        *(u32x2*)(oBEt + k * 40 + 4 * tq) = bt; *(u32x2*)(oGAt + k * 40 + 4 * tq) = gt;
        if (tq == 7) lamC[k] = lam;
      }
      __syncthreads();
      {
      const int tid = otid(), lane = tid & 63, wave = tid >> 6, r = lane & 31, h = lane >> 5; (void)r; (void)h; (void)lane; (void)wave;
      if (wave < 4) {
        const bf16_t* As = (wave & 1) ? oGA : oBE; const bf16_t* Bs = (wave < 2) ? oAL : oRH;
        f32x16 x;
#pragma unroll
        for (int q = 0; q < 16; ++q) x[q] = 0.f;
#pragma unroll
        for (int s = 0; s < 4; ++s) { const bf16x8 a = *(const bf16x8*)(As + r * 72 + 16 * s + 8 * h); const bf16x8 bb = *(const bf16x8*)(Bs + r * 72 + 16 * s + 8 * h); x = MFMA32(a, bb, x); }
#pragma unroll
        for (int q = 0; q < 16; ++q) { const int i = (q & 3) + 8 * (q >> 2) + 4 * h; const bool keep = (wave < 2) ? (i < r) : (i <= r); x[q] = keep ? x[q] : 0.f; }
        if (wave == 0) {
#pragma unroll
          for (int gq = 0; gq < 4; ++gq) *(float4*)(Bm + r * 36 + 8 * gq + 4 * h) = make_float4(x[4 * gq], x[4 * gq + 1], x[4 * gq + 2], x[4 * gq + 3]);
        } else {
          const float sg = (wave == 2) ? -1.f : 1.f;
#pragma unroll
          for (int s = 0; s < 2; ++s) { u32x4 pk;
#pragma unroll
            for (int j = 0; j < 4; ++j) pk[j] = pack2(sg * x[8 * s + 2 * j], sg * x[8 * s + 2 * j + 1]);
            *(u32x4*)(frag + (((wave - 1) * 2 + s) * 64 + lane) * 16) = pk; }
        }
      }
      }
      __syncthreads();
      f32x16 y0;
#pragma unroll
      for (int q = 0; q < 16; ++q) y0[q] = 0.f;
      const int vloc = 32 * (wave & 1) + r;
      if (wave < 2) {
        f32x16 a0;
#pragma unroll
        for (int q = 0; q < 16; ++q) a0[q] = 0.f;
#pragma unroll
        for (int kb = 0; kb < 2; ++kb)
#pragma unroll
          for (int s = 0; s < 2; ++s) {
            u32x4 pk;
#pragma unroll
            for (int j = 0; j < 4; ++j) pk[j] = kb ? pack2(st1[8 * s + 2 * j], st1[8 * s + 2 * j + 1]) : pack2(st0[8 * s + 2 * j], st0[8 * s + 2 * j + 1]);
            const bf16x8 sf = __builtin_bit_cast(bf16x8, pk);
            const int ko = 32 * kb + 16 * s + 4 * h;
            const u32x4 aa = cat8(*(const u32x2*)(oAL + r * 72 + ko), *(const u32x2*)(oAL + r * 72 + ko + 8));
            const u32x4 ar = cat8(*(const u32x2*)(oRH + r * 72 + ko), *(const u32x2*)(oRH + r * 72 + ko + 8));
            a0 = MFMA32(__builtin_bit_cast(bf16x8, aa), sf, a0);
            y0 = MFMA32(__builtin_bit_cast(bf16x8, ar), sf, y0);
          }
#pragma unroll
        for (int s = 0; s < 2; ++s) {
          const bf16x8 fg = *(const bf16x8*)(frag + ((0 * 2 + s) * 64 + lane) * 16);
          const bf16x8 fpg = *(const bf16x8*)(frag + ((2 * 2 + s) * 64 + lane) * 16);
          const u32x4 ub = cat8(*(const u32x2*)(oUt + vloc * 40 + 16 * s + 4 * h), *(const u32x2*)(oUt + vloc * 40 + 16 * s + 4 * h + 8));
          a0 = MFMA32(fg, __builtin_bit_cast(bf16x8, ub), a0);
          y0 = MFMA32(fpg, __builtin_bit_cast(bf16x8, ub), y0);
        }
#pragma unroll
        for (int q = 0; q < 16; ++q) RHS[((q & 3) + 8 * (q >> 2) + 4 * h) * 64 + vloc] = a0[q];
        float* park = sR + wave * 3072 + lane * 4;
#pragma unroll
        for (int gq = 0; gq < 4; ++gq) {
          *(float4*)(park + gq * 256) = make_float4(st0[4 * gq], st0[4 * gq + 1], st0[4 * gq + 2], st0[4 * gq + 3]);
          *(float4*)(park + 1024 + gq * 256) = make_float4(st1[4 * gq], st1[4 * gq + 1], st1[4 * gq + 2], st1[4 * gq + 3]);
          *(float4*)(park + 2048 + gq * 256) = make_float4(y0[4 * gq], y0[4 * gq + 1], y0[4 * gq + 2], y0[4 * gq + 3]);
        }
      }
      __syncthreads();
      {
      const int tid = otid(), lane = tid & 63, wave = tid >> 6, r = lane & 31, h = lane >> 5; (void)r; (void)h; (void)lane; (void)wave;
      if (wave < 2) {
        float zv[32];
        const __attribute__((address_space(3))) float* Bmo = (const __attribute__((address_space(3))) float*)Bm;
        const __attribute__((address_space(3))) float* RHo = (const __attribute__((address_space(3))) float*)(RHS + vloc);
        asm volatile("" : "+v"(Bmo), "+v"(RHo));
#pragma unroll
        for (int t = 0; t < 32; ++t) zv[t] = 0.f;
        float4 cb[8], nb8[8]; float crhs = RHo[0], nrhs = 0.f;
#pragma unroll
        for (int q = 0; q < 8; ++q) { cb[q] = make_float4(0.f, 0.f, 0.f, 0.f); nb8[q] = make_float4(0.f, 0.f, 0.f, 0.f); }
#pragma unroll
        for (int t = 0; t < 32; ++t) {
          if (t + 1 < 32) {
            nrhs = RHo[(t + 1) * 64];
#pragma unroll
            for (int i4 = 0; i4 < (t + 4) / 4; ++i4) { typedef float f4v __attribute__((ext_vector_type(4))); const f4v q4 = *(const __attribute__((address_space(3))) f4v*)(Bmo + (t + 1) * 36 + 4 * i4); nb8[i4] = make_float4(q4[0], q4[1], q4[2], q4[3]); }
          }
          float a0s = crhs, a1s = 0.f, a2s = 0.f, a3s = 0.f;
#pragma unroll
          for (int i4 = 0; i4 < (t + 3) / 4; ++i4) {
            a0s -= cb[i4].x * zv[4 * i4]; a1s -= cb[i4].y * zv[4 * i4 + 1]; a2s -= cb[i4].z * zv[4 * i4 + 2]; a3s -= cb[i4].w * zv[4 * i4 + 3];
          }
          zv[t] = (a0s + a1s) + (a2s + a3s);
          asm volatile("" : "+v"(zv[t]) :: "memory");
          crhs = nrhs;
#pragma unroll
          for (int i4 = 0; i4 < 8; ++i4) cb[i4] = nb8[i4];
        }
        if (h == 0) {
#pragma unroll
          for (int q = 0; q < 4; ++q) { u32x4 o;
#pragma unroll
            for (int j = 0; j < 4; ++j) o[j] = pack2(zv[8 * q + 2 * j], zv[8 * q + 2 * j + 1]);
            *(u32x4*)(oZt + vloc * 40 + 8 * q) = o; }
        }
      }
      }
      __syncthreads();
      {
      const int tid = otid(), lane = tid & 63, wave = tid >> 6, r = lane & 31, h = lane >> 5; (void)r; (void)h; (void)lane; (void)wave;
      if (wave < 2) {
        { const float* park = sR + wave * 3072 + lane * 4;
#pragma unroll
          for (int gq = 0; gq < 4; ++gq) {
            const float4 a = *(const float4*)(park + gq * 256), bq = *(const float4*)(park + 1024 + gq * 256), cq = *(const float4*)(park + 2048 + gq * 256);
            st0[4 * gq] = a.x; st0[4 * gq + 1] = a.y; st0[4 * gq + 2] = a.z; st0[4 * gq + 3] = a.w;
            st1[4 * gq] = bq.x; st1[4 * gq + 1] = bq.y; st1[4 * gq + 2] = bq.z; st1[4 * gq + 3] = bq.w;
            y0[4 * gq] = cq.x; y0[4 * gq + 1] = cq.y; y0[4 * gq + 2] = cq.z; y0[4 * gq + 3] = cq.w;
          } }
#pragma unroll
        for (int s = 0; s < 2; ++s) {
          const bf16x8 ub = *(const bf16x8*)(oUt + vloc * 40 + 16 * s + 8 * h), zb = *(const bf16x8*)(oZt + vloc * 40 + 16 * s + 8 * h);
          const bf16x8 g0 = *(const bf16x8*)(oGAt + r * 40 + 16 * s + 8 * h), g1 = *(const bf16x8*)(oGAt + (32 + r) * 40 + 16 * s + 8 * h);
          const bf16x8 b0 = *(const bf16x8*)(oBEt + r * 40 + 16 * s + 8 * h), b1 = *(const bf16x8*)(oBEt + (32 + r) * 40 + 16 * s + 8 * h);
          st0 = MFMA32(g0, ub, st0); st0 = MFMA32(b0, zb, st0);
          st1 = MFMA32(g1, ub, st1); st1 = MFMA32(b1, zb, st1);
          const bf16x8 fpb = *(const bf16x8*)(frag + ((1 * 2 + s) * 64 + lane) * 16);
          const u32x4 z8 = cat8(*(const u32x2*)(oZt + vloc * 40 + 16 * s + 4 * h), *(const u32x2*)(oZt + vloc * 40 + 16 * s + 4 * h + 8));
          y0 = MFMA32(fpb, __builtin_bit_cast(bf16x8, z8), y0);
        }
#pragma unroll
        for (int gq = 0; gq < 4; ++gq) {
          const float4 l0 = *(const float4*)(lamC + 8 * gq + 4 * h), l1 = *(const float4*)(lamC + 32 + 8 * gq + 4 * h);
          st0[4 * gq] *= l0.x; st0[4 * gq + 1] *= l0.y; st0[4 * gq + 2] *= l0.z; st0[4 * gq + 3] *= l0.w;
          st1[4 * gq] *= l1.x; st1[4 * gq + 1] *= l1.y; st1[4 * gq + 2] *= l1.z; st1[4 * gq + 3] *= l1.w;
        }
#pragma unroll
        for (int q = 0; q < 16; ++q) {
          const int t = (q & 3) + 8 * (q >> 2) + 4 * h; const int tl = z ? (L - 1 - (sc * 32 + t)) : (sc * 32 + t);
          Yg[((size_t)b * L + tl) * 1024 + head * 64 + vloc] = (bf16_t)f2bf(y0[q]);
        }
      }
      }
      __syncthreads();
    }
#undef SCAN_LOAD
    if (g == 0 && wave < 2) {
#pragma unroll
      for (int gq = 0; gq < 4; ++gq) {
        *(float4*)(p.out + OUT_ST + stbase + 8 * gq + 4 * h) = make_float4(st0[4 * gq], st0[4 * gq + 1], st0[4 * gq + 2], st0[4 * gq + 3]);
        *(float4*)(p.out + OUT_ST + stbase + 32 + 8 * gq + 4 * h) = make_float4(st1[4 * gq], st1[4 * gq + 1], st1[4 * gq + 2], st1[4 * gq + 3]);
      }
    }
    __syncthreads();
  }
}

DI void phase_rwkv_combine(const P& p, int g, int jl) {
  const int T = g ? 16384 : 8192;
  const int tid = otid(); const int lane = tid & 63, wave = tid >> 6;
  bf16_t* slots = (bf16_t*)(p.ws + WS_SLOT);
  const float* bon = (const float*)(p.ws + WS_BON);
  for (int t = blockIdx.x * 8 + wave; t < T; t += gridDim.x * 8) {
    const size_t o = (size_t)t * 1024 + 16 * lane; const int head = lane >> 2;
    float y[16], v[16], gg[16];
#pragma unroll
    for (int q = 0; q < 2; ++q) {
      const u32x4 a = *(const u32x4*)(slots + 5 * SLOT_ELEMS + o + 8 * q), bq = *(const u32x4*)(slots + 0 * SLOT_ELEMS + o + 8 * q);
      const u32x4 vq = *(const u32x4*)(slots + 3 * SLOT_ELEMS + o + 8 * q), gq = *(const u32x4*)(slots + 4 * SLOT_ELEMS + o + 8 * q);
#pragma unroll
      for (int i = 0; i < 4; ++i) { y[8 * q + 2 * i] = bflo(a[i]) + bflo(bq[i]); y[8 * q + 2 * i + 1] = bfhi(a[i]) + bfhi(bq[i]);
        v[8 * q + 2 * i] = bflo(vq[i]); v[8 * q + 2 * i + 1] = bfhi(vq[i]); gg[8 * q + 2 * i] = bflo(gq[i]); gg[8 * q + 2 * i + 1] = bfhi(gq[i]); }
    }
    float s = 0.f;
#pragma unroll
    for (int i = 0; i < 16; ++i) s += y[i];
    const float mean = quad_sum(s) * (1.f / 64.f);
    float vs = 0.f;
#pragma unroll
    for (int i = 0; i < 16; ++i) { const float d = y[i] - mean; vs += d * d; }
    const float rstd = rsqrtf(quad_sum(vs) * (1.f / 64.f) + 64e-5f);
    const float bs = bon[((size_t)t * 16 + head) * 2] + bon[((size_t)t * 16 + head) * 2 + 1];
    const float* gw = p.in[22] + jl * 1024 + 16 * lane; const float* gb = p.in[23] + jl * 1024 + 16 * lane;
    float ov[16];
#pragma unroll
    for (int i = 0; i < 16; ++i) ov[i] = ((y[i] - mean) * rstd * gw[i] + gb[i] + bs * v[i]) * silu(gg[i]);
#pragma unroll
    for (int q = 0; q < 2; ++q) { u32x4 w; w[0] = pack2(ov[8 * q], ov[8 * q + 1]); w[1] = pack2(ov[8 * q + 2], ov[8 * q + 3]); w[2] = pack2(ov[8 * q + 4], ov[8 * q + 5]); w[3] = pack2(ov[8 * q + 6], ov[8 * q + 7]);
      *(u32x4*)(slots + 4 * SLOT_ELEMS + o + 8 * q) = w; }
  }
}

DI void phase_conv(const P& p, int g) {
  const int T = g ? 16384 : 8192, Lmask = g ? 4095 : 255;
  bf16_t* slots = (bf16_t*)(p.ws + WS_SLOT);
  const bf16_t* BG = slots + 2 * SLOT_ELEMS; const bf16_t* CG = slots + 3 * SLOT_ELEMS; const bf16_t* U = slots + 4 * SLOT_ELEMS; const bf16_t* G = slots + 5 * SLOT_ELEMS;
  bf16_t* O = slots;
  for (int e = blockIdx.x * NT + otid(); e < T * 128; e += gridDim.x * NT) {
    const int t = e >> 7, c = (e & 127) * 8; const size_t o = (size_t)t * 1024 + c; const int tl = t & Lmask;
    const u32x4 zz = {0u, 0u, 0u, 0u};
    const u32x4 c1 = *(const u32x4*)(CG + o), u1 = *(const u32x4*)(U + o);
    const u32x4 c0 = tl != 0 ? *(const u32x4*)(CG + o - 1024) : zz, u0 = tl != 0 ? *(const u32x4*)(U + o - 1024) : zz;
    const u32x4 c2 = tl != Lmask ? *(const u32x4*)(CG + o + 1024) : zz, u2 = tl != Lmask ? *(const u32x4*)(U + o + 1024) : zz;
    const u32x4 bg = *(const u32x4*)(BG + o), gg = *(const u32x4*)(G + o);
    const float* cw = p.in[30]; const float* cb = p.in[31];
    u32x4 w;
#pragma unroll
    for (int i = 0; i < 4; ++i) {
      const int ch = c + 2 * i;
      const float lo = bflo(bg[i]) * (cw[ch] * bflo(c0[i]) * bflo(u0[i]) + cw[1024 + ch] * bflo(c1[i]) * bflo(u1[i]) + cw[2048 + ch] * bflo(c2[i]) * bflo(u2[i]) + cb[ch]) * silu(bflo(gg[i]));
      const float hi = bfhi(bg[i]) * (cw[ch + 1] * bfhi(c0[i]) * bfhi(u0[i]) + cw[1024 + ch + 1] * bfhi(c1[i]) * bfhi(u1[i]) + cw[2048 + ch + 1] * bfhi(c2[i]) * bfhi(u2[i]) + cb[ch + 1]) * silu(bfhi(gg[i]));
      w[i] = pack2(lo, hi);
    }
    *(u32x4*)(O + o) = w;
  }
}

DI void phase_attn(const P& p, int g, unsigned char* lds) {
  const int tid = otid(), lane = tid & 63, wave = tid >> 6, r = lane & 31, h = lane >> 5;
  const int L = g ? 4096 : 256, Ltot = g ? 4352 : 256, B = g ? 4 : 32;
  const int nq = L >> 6, ntasks = B * 4 * nq, nkt = Ltot >> 6;
  bf16_t* slots = (bf16_t*)(p.ws + WS_SLOT);
  bf16_t* Q = slots + 2 * SLOT_ELEMS; const bf16_t* G = slots + 3 * SLOT_ELEMS;
  const bf16_t* Kb = slots + 4 * SLOT_ELEMS; const bf16_t* Vt = Kb + SLOT_ELEMS / 2;
  const float SC = 0.125f * 1.4426950408889634f;
  for (int task = blockIdx.x; task < ntasks; task += gridDim.x) {
    const int qt = task % nq, kvh = (task / nq) & 3, b = task / (nq * 4);
    const int head = kvh * 4 + (wave >> 1); const int q0 = qt * 64 + (wave & 1) * 32;
    const size_t tok = (size_t)b * L + q0 + r;
    bf16x8 qf[4];
#pragma unroll
    for (int ds = 0; ds < 4; ++ds) qf[ds] = *(const bf16x8*)(Q + tok * 1024 + head * 64 + ds * 16 + h * 8);
    float m = -1e30f, lsum = 0.f;
    f32x16 O0, O1;
#pragma unroll
    for (int i = 0; i < 16; ++i) { O0[i] = 0.f; O1[i] = 0.f; }
    const int lrow = tid >> 3, lc = (tid & 7) * 8;
    const bf16_t* gK = Kb + ((size_t)b * Ltot + lrow) * 256 + kvh * 64 + lc;
    const bf16_t* gV = Vt + ((size_t)(b * 4 + kvh) * 64 + lrow) * Ltot + lc;
    u32x4 rk = *(const u32x4*)gK, rv = *(const u32x4*)gV;
    *(u32x4*)(lds + lrow * 144 + lc * 2) = rk; *(u32x4*)(lds + 9216 + lrow * 144 + lc * 2) = rv;
    __syncthreads();
    for (int kt = 0; kt < nkt; ++kt) {
      const unsigned char* cur = lds + (kt & 1) * 18432; unsigned char* nxt = lds + ((kt + 1) & 1) * 18432;
      if (kt + 1 < nkt) { rk = *(const u32x4*)(gK + (size_t)(kt + 1) * 64 * 256); rv = *(const u32x4*)(gV + (kt + 1) * 64); }
      f32x16 s0, s1;
#pragma unroll
      for (int i = 0; i < 16; ++i) { s0[i] = 0.f; s1[i] = 0.f; }
#pragma unroll
      for (int ds = 0; ds < 4; ++ds) {
        const bf16x8 a0 = *(const bf16x8*)(cur + r * 144 + (ds * 16 + h * 8) * 2);
        const bf16x8 a1 = *(const bf16x8*)(cur + (32 + r) * 144 + (ds * 16 + h * 8) * 2);
        s0 = MFMA32(a0, qf[ds], s0); s1 = MFMA32(a1, qf[ds], s1);
      }
      float tmax = s0[0];
#pragma unroll
      for (int i = 1; i < 16; ++i) tmax = fmaxf(tmax, s0[i]);
#pragma unroll
      for (int i = 0; i < 16; ++i) tmax = fmaxf(tmax, s1[i]);
      tmax = fmaxf(tmax, __shfl_xor(tmax, 32));
      const float mnew = fmaxf(m, tmax * SC);
      const float alpha = __builtin_amdgcn_exp2f(m - mnew);
      float ps = 0.f;
#pragma unroll
      for (int i = 0; i < 16; ++i) { s0[i] = __builtin_amdgcn_exp2f(s0[i] * SC - mnew); s1[i] = __builtin_amdgcn_exp2f(s1[i] * SC - mnew); ps += s0[i] + s1[i]; }
      lsum = lsum * alpha + ps; m = mnew;
#pragma unroll
      for (int i = 0; i < 16; ++i) { O0[i] *= alpha; O1[i] *= alpha; }
      const unsigned char* vs = cur + 9216;
#pragma unroll
      for (int kb = 0; kb < 2; ++kb)
#pragma unroll
        for (int s = 0; s < 2; ++s) {
          u32x4 pk;
#pragma unroll
          for (int j = 0; j < 4; ++j) pk[j] = kb ? pack2(s1[8 * s + 2 * j], s1[8 * s + 2 * j + 1]) : pack2(s0[8 * s + 2 * j], s0[8 * s + 2 * j + 1]);
          const bf16x8 pf = __builtin_bit_cast(bf16x8, pk);
          const int ko = (32 * kb + 16 * s + 4 * h) * 2;
          { const u32x2 lo = *(const u32x2*)(vs + r * 144 + ko), hi = *(const u32x2*)(vs + r * 144 + ko + 16);
            u32x4 av; av[0] = lo[0]; av[1] = lo[1]; av[2] = hi[0]; av[3] = hi[1];
            O0 = MFMA32(__builtin_bit_cast(bf16x8, av), pf, O0); }
          { const u32x2 lo = *(const u32x2*)(vs + (32 + r) * 144 + ko), hi = *(const u32x2*)(vs + (32 + r) * 144 + ko + 16);
            u32x4 av; av[0] = lo[0]; av[1] = lo[1]; av[2] = hi[0]; av[3] = hi[1];
            O1 = MFMA32(__builtin_bit_cast(bf16x8, av), pf, O1); }
        }
      if (kt + 1 < nkt) { *(u32x4*)(nxt + lrow * 144 + lc * 2) = rk; *(u32x4*)(nxt + 9216 + lrow * 144 + lc * 2) = rv; }
      __syncthreads();
    }
    lsum += __shfl_xor(lsum, 32);
    const float inv = 1.f / lsum;
#pragma unroll
    for (int db = 0; db < 2; ++db)
#pragma unroll
      for (int i4 = 0; i4 < 4; ++i4) {
        const size_t o = tok * 1024 + head * 64 + 32 * db + 8 * i4 + 4 * h;
        const u32x2 gq = *(const u32x2*)(G + o);
        const float v0 = (db ? O1[4 * i4] : O0[4 * i4]) * inv, v1 = (db ? O1[4 * i4 + 1] : O0[4 * i4 + 1]) * inv;
        const float v2 = (db ? O1[4 * i4 + 2] : O0[4 * i4 + 2]) * inv, v3 = (db ? O1[4 * i4 + 3] : O0[4 * i4 + 3]) * inv;
        u32x2 w; w[0] = pack2(v0 * silu(bflo(gq[0])), v1 * silu(bfhi(gq[0]))); w[1] = pack2(v2 * silu(bflo(gq[1])), v3 * silu(bfhi(gq[1])));
        *(u32x2*)(slots + 5 * SLOT_ELEMS + o) = w;
      }
  }
}


#define XB_TMO      128
#define XB_XCNT(j)  (256  + 64 * (j))
#define XB_XSUB(j)  (1280 + 64 * (j))
#define XB_XGEN(j)  (2304 + 64 * (j))
#define XB_TOP      3328
#define XB_TOPGEN   3392
#define XCD_BAR_WORDS 3456
#define XB_SPIN_CAP (1u << 22)
#define LAS __attribute__((address_space(3)))
DI unsigned xb_ld(unsigned* p) { return __hip_atomic_load(p, __ATOMIC_RELAXED, __HIP_MEMORY_SCOPE_AGENT); }
DI unsigned xb_add(unsigned* p, unsigned v) { return __hip_atomic_fetch_add(p, v, __ATOMIC_RELAXED, __HIP_MEMORY_SCOPE_AGENT); }
DI unsigned xb_xcc_id() { return (unsigned)__builtin_amdgcn_s_getreg((3 << 11) | 20) & 0xFu; }
#define XB_SPIN(cond, bar) do { unsigned _sp = 0; while (cond) { __builtin_amdgcn_s_sleep(1); \
    if ((++_sp & 255u) == 0u) { if (xb_ld(&(bar)[XB_TMO])) break; if (_sp > XB_SPIN_CAP) { atomicAdd(&(bar)[XB_TMO], 1u); break; } } } } while (0)
struct XcdBarrier { unsigned* bar; unsigned x; volatile LAS unsigned* st; };
DI XcdBarrier xcd_barrier_post(unsigned* bar, volatile LAS unsigned* st) {
  XcdBarrier b; b.bar = bar; b.x = xb_xcc_id(); b.st = st;
  if (threadIdx.x == 0) (void)xb_add(&bar[XB_XCNT(b.x)], 1u);
  return b;
}
DI void xcd_barrier_complete(unsigned* bar, unsigned x, unsigned& nloc, unsigned& nx) {
  const unsigned G = gridDim.x * gridDim.y * gridDim.z;
  unsigned sum, cnt, mine, sp = 0u;
  for (;;) {
    sum = 0u; cnt = 0u; mine = 0u;
#pragma unroll
    for (unsigned j = 0; j < 16; ++j) { const unsigned c = xb_ld(&bar[XB_XCNT(j)]); sum += c; cnt += (c > 0u) ? 1u : 0u; mine = (j == x) ? c : mine; }
    if (sum == G) break;
    __builtin_amdgcn_s_sleep(1);
    if ((++sp & 255u) == 0u) { if (xb_ld(&bar[XB_TMO])) break; if (sp > XB_SPIN_CAP) { atomicAdd(&bar[XB_TMO], 1u); break; } }
  }
  nloc = mine > 0u ? mine : 1u; nx = cnt > 0u ? cnt : 1u;
}
DI void xcd_barrier(const XcdBarrier& b) {
  asm volatile("s_waitcnt vmcnt(0)" ::: "memory");
  __syncthreads();
  if (threadIdx.x == 0) {
    unsigned* bar = b.bar;
    __builtin_amdgcn_s_waitcnt(0);
    unsigned nloc = b.st[0], nx = b.st[1];
    if (nloc == 0u) { xcd_barrier_complete(bar, b.x, nloc, nx); b.st[0] = nloc; b.st[1] = nx; }
    const unsigned old = xb_add(&bar[XB_XSUB(b.x)], 1u);
    const unsigned gen = old / nloc;
    if (old + 1u == (gen + 1u) * nloc) {
      __builtin_amdgcn_fence(__ATOMIC_RELEASE, "agent");
      asm volatile("s_waitcnt vmcnt(0)" ::: "memory");
      const unsigned og = xb_add(&bar[XB_TOP], 1u);
      const unsigned tg = og / nx;
      if (og + 1u == (tg + 1u) * nx) xb_add(&bar[XB_TOPGEN], 1u);
      else XB_SPIN(xb_ld(&bar[XB_TOPGEN]) == tg, bar);
      __builtin_amdgcn_fence(__ATOMIC_ACQUIRE, "agent");
      xb_add(&bar[XB_XGEN(b.x)], 1u);
      asm volatile("s_waitcnt vmcnt(0)" ::: "memory");
    } else {
      XB_SPIN(xb_ld(&bar[XB_XGEN(b.x)]) == gen, bar);
      __builtin_amdgcn_fence(__ATOMIC_ACQUIRE, "agent");
      asm volatile("s_waitcnt vmcnt(0)" ::: "memory");
    }
  }
  __syncthreads();
}

#define GPTR(T, x) ((T*)(__attribute__((address_space(1))) T*)(x))
__global__ void __launch_bounds__(NT) mega(P p) {
  extern __shared__ __attribute__((aligned(16))) unsigned char lds[];
  cg::grid_group grid = cg::this_grid();
  volatile LAS unsigned* st = (volatile LAS unsigned*)(lds + 135168);
  if (threadIdx.x < 4) st[threadIdx.x] = 0u;
  __syncthreads();
  const XcdBarrier xbar = xcd_barrier_post((unsigned*)(p.ws + WS_BAR), st);
  phase0(p, lds);
  grid.sync();
  const P& p0 = p;
  for (int step = 0; step < 50; ++step) {
    const int g = step / 25, rem = step - g * 25, layer = rem / 5, sub = rem - layer * 5;
    const int kind = layer % 3, jl = layer / 3;
    const int T = g ? 16384 : 8192, Lmask = g ? 4095 : 255;
    int op = -1;
    if (layer == 4) op = (sub == 0) ? 0 : -1;
    else if (sub == 0) op = 0;
    else if (kind == 0) op = sub == 1 ? 1 : (sub == 2 ? 2 : (sub == 3 ? 3 : 4));
    else if (kind == 1) op = sub == 1 ? 5 : (sub == 2 ? 6 : (sub == 3 ? 4 : -1));
    else op = sub == 1 ? 4 : (sub == 2 ? 7 : (sub == 3 ? 4 : -1));
    if (op < 0) continue;
    P p = p0;
    { size_t zo_ = 0; asm volatile("" : "+s"(zo_)); p.ws = p0.ws + zo_; p.out = p0.out + zo_; }
    bf16_t* slots = (bf16_t*)(p.ws + WS_SLOT);
    const bf16_t* W = (const bf16_t*)(p.ws + WS_W);
    if (op == 0) {
      const float* xin = p.in[g]; float* xout = p.out + (g ? OUT_YS : OUT_YP);
      phase_norm(p, g, layer - 1, layer < 4 ? layer : -1, layer <= 1 ? xin : xout, xout, slots + SLOT_ELEMS, slots);
      if (kind == 1 && g == 1 && layer < 4) phase_cache_copy(p);
    } else if (op == 1) {
      for (int rep = 0; rep < opq(REP_GEMM); ++rep) phase_gemm<1, 0>(p, g, slots, W + (size_t)(RW_IN0 + jl * RW_STRIDE) * 1024, T, 4352, p.in[11] + jl * 6144, Lmask, slots + SLOT_ELEMS, 1, lds);
    } else if (op == 2) {
      for (int rep = 0; rep < opq(REP_SCAN); ++rep) phase_scan(p, g, jl, lds);
    } else if (op == 3) {
      phase_rwkv_combine(p, g, jl);
    } else if (op == 4) {
      const bf16_t* A; const bf16_t* Bt; int N; bf16_t* dst;
      if (sub == 1) { A = slots; Bt = W + (size_t)CV_IN * 1024; N = 4096; dst = slots + 2 * SLOT_ELEMS; }
      else {
        N = 1024; dst = slots + SLOT_ELEMS;
        if (kind == 0) { A = slots + 4 * SLOT_ELEMS; Bt = W + (size_t)(RW_OUT0 + jl * RW_STRIDE) * 1024; }
        else if (kind == 1) { A = slots + 5 * SLOT_ELEMS; Bt = W + (size_t)AT_OUT * 1024; }
        else { A = slots; Bt = W + (size_t)CV_OUT * 1024; }
      }
      for (int rep = 0; rep < opq(REP_GEMM); ++rep) phase_gemm<0, 0>(p, g, A, Bt, T, N, nullptr, 0, dst, 0, lds);
    } else if (op == 5) {
      for (int rep = 0; rep < opq(REP_GEMM); ++rep) phase_gemm<0, 1>(p, g, slots, W + (size_t)AT_IN * 1024, T, 2560, nullptr, 0, nullptr, 0, lds);
    } else if (op == 6) {
      for (int rep = 0; rep < opq(REP_ATTN); ++rep) phase_attn(p, g, lds);
    } else {
      phase_conv(p, g);
    }
    if (!(g == 1 && layer == 4)) for (int rep = 0; rep < opq(REP_SYNC); ++rep) xcd_barrier(xbar);
  }
}

extern "C" void kernel_launch(void* const* d_in, const int* in_sizes, int n_in, void* d_out, int out_size, void* d_ws, size_t ws_size, hipStream_t stream) {
  static int grid_blocks = 0;
  if (!grid_blocks) {
    int dev = 0, cus = 0, per_cu = 0;
    hipGetDevice(&dev);
    hipDeviceGetAttribute(&cus, hipDeviceAttributeMultiprocessorCount, dev);
    hipFuncSetAttribute((const void*)mega, hipFuncAttributeMaxDynamicSharedMemorySize, LDS_BYTES);
    hipOccupancyMaxActiveBlocksPerMultiprocessor(&per_cu, (const void*)mega, NT, LDS_BYTES);
    if (per_cu < 1) per_cu = 1;
    if (per_cu > 1) per_cu = 1;
    grid_blocks = cus * per_cu;
    if (ws_size < WS_SLOT + 6 * SLOT_ELEMS * 2) fprintf(stderr, "workspace too small: %zu\n", ws_size);
  }
  (void)hipMemsetAsync((unsigned char*)d_ws + WS_BAR, 0, XCD_BAR_WORDS * sizeof(unsigned), stream);
  P p{};
  for (int i = 0; i < 33; ++i) p.in[i] = (const float*)d_in[i];
  p.out = (float*)d_out; p.ws = (unsigned char*)d_ws;
  void* args[] = {&p};
  hipError_t e = hipLaunchCooperativeKernel((const void*)mega, dim3(grid_blocks), dim3(NT), args, LDS_BYTES, stream);
  if (e != hipSuccess) fprintf(stderr, "cooperative launch failed: %s (grid %d)\n", hipGetErrorString(e), grid_blocks);
}
```

```cpp
#include <hip/hip_runtime.h>
#include <hip/hip_cooperative_groups.h>
#include <cstdio>
namespace cg = cooperative_groups;

typedef unsigned short bf16_t;
using bf16x8 = __attribute__((ext_vector_type(8))) short;
using f32x16 = __attribute__((ext_vector_type(16))) float;
using u32x4 = __attribute__((ext_vector_type(4))) unsigned;
using u32x2 = __attribute__((ext_vector_type(2))) unsigned;

#define NT 512
#ifndef REP_GEMM
#define REP_GEMM 1
#endif
#ifndef REP_SCAN
#define REP_SCAN 1
#endif
#ifndef REP_ATTN
#define REP_ATTN 1
#endif
#ifndef REP_SYNC
#define REP_SYNC 1
#endif
#define DI __device__ __forceinline__
#define MFMA32(a, b, c) __builtin_amdgcn_mfma_f32_32x32x16_bf16((a), (b), (c), 0, 0, 0)

struct P { const float* in[33]; float* out; unsigned char* ws; };

constexpr size_t WS_ADA = 0;
constexpr size_t WS_ROPE = 262144;
constexpr size_t WS_BON = 327680;
constexpr size_t WS_HID = WS_BON + 2097152;
constexpr size_t WS_W = WS_HID + 8388608;
constexpr size_t WS_SLOT = WS_W + 39845888;
constexpr size_t SLOT_ELEMS = (size_t)16384 * 1024;
constexpr int RW_IN0 = 0, RW_OUT0 = 4352, RW_STRIDE = 5376, AT_IN = 10752, AT_OUT = 13312, CV_IN = 14336, CV_OUT = 18432;
constexpr size_t OUT_YP = 0, OUT_YS = 8388608, OUT_ST = 25165824, OUT_CK = 33554432, OUT_CV = 35651584;
constexpr int LDS_BYTES = 135168 + 16;
constexpr size_t WS_BAR = 278528;

typedef __bf16 bf16x2_t __attribute__((ext_vector_type(2)));
typedef float f32x2_t __attribute__((ext_vector_type(2)));
DI unsigned pack2(float a, float b) { f32x2_t v = {a, b}; return __builtin_bit_cast(unsigned, __builtin_convertvector(v, bf16x2_t)); }
DI unsigned f2bf(float x) { return (unsigned)__builtin_bit_cast(unsigned short, (__bf16)x); }
DI float bflo(unsigned u) { return __uint_as_float(u << 16); }
DI float bfhi(unsigned u) { return __uint_as_float(u & 0xffff0000u); }
DI float bf1(bf16_t u) { return __uint_as_float(((unsigned)u) << 16); }

template <int CTRL> DI float dppf(float v) { return __int_as_float(__builtin_amdgcn_update_dpp(0, __float_as_int(v), CTRL, 0xF, 0xF, true)); }
DI float reduce16(float v) { v += dppf<0xB1>(v); v += dppf<0x4E>(v); v += dppf<0x141>(v); v += dppf<0x140>(v); return v; }
DI float wave_sum(float v) { v = reduce16(v); v += __shfl_xor(v, 16); v += __shfl_xor(v, 32); return v; }
DI float quad_sum(float v) { v += dppf<0xB1>(v); v += dppf<0x4E>(v); return v; }
DI float silu(float x) { return x / (1.f + __expf(-x)); }
DI int opq(int v) { asm volatile("" : "+s"(v)); return v; }
DI int otid() { int t = threadIdx.x; asm volatile("" : "+v"(t)); return t; }

DI void conv_tiles(const float* __restrict__ src, int N, bf16_t* __restrict__ dst, float* lds) {
  const int tid = otid();
  const int tilesN = N >> 6, ntiles = 16 * tilesN;
  for (int tile = blockIdx.x; tile < ntiles; tile += gridDim.x) {
    const int kt = tile / tilesN, nt = tile - kt * tilesN, k0 = kt * 64, n0 = nt * 64;
#pragma unroll
    for (int i = 0; i < 8; ++i) { const int k = (tid >> 6) + 8 * i, n = tid & 63; lds[k * 65 + n] = src[(size_t)(k0 + k) * N + n0 + n]; }
    __syncthreads();
    { const int n = tid >> 3, kc = (tid & 7) * 8; u32x4 o;
#pragma unroll
      for (int j = 0; j < 4; ++j) o[j] = pack2(lds[(kc + 2 * j) * 65 + n], lds[(kc + 2 * j + 1) * 65 + n]);
      *(u32x4*)(dst + (size_t)(n0 + n) * 1024 + k0 + kc) = o; }
    __syncthreads();
  }
}

DI void phase0(const P& p, unsigned char* ldsb) {
  float* lds = (float*)ldsb;
  const int tid = otid();
  bf16_t* W = (bf16_t*)(p.ws + WS_W);
#pragma unroll 1
  for (int e = 0; e < opq(22); ++e) {
    const float* src; int N, drow;
    if (e < 18) {
      const int j = e / 9, q = e - j * 9;
      if (q < 4) { src = p.in[12] + (size_t)(j * 4 + q) * 1048576; N = 1024; drow = RW_IN0 + j * RW_STRIDE + q * 1024; }
      else if (q < 6) { src = p.in[14] + (size_t)(j * 2 + q - 4) * 65536; N = 64; drow = RW_IN0 + j * RW_STRIDE + 4096 + (q - 4) * 64; }
      else if (q < 8) { src = p.in[17] + (size_t)(j * 2 + q - 6) * 65536; N = 64; drow = RW_IN0 + j * RW_STRIDE + 4224 + (q - 6) * 64; }
      else { src = p.in[24] + (size_t)j * 1048576; N = 1024; drow = RW_OUT0 + j * RW_STRIDE; }
    } else if (e == 18) { src = p.in[25]; N = 2560; drow = AT_IN; }
    else if (e == 19) { src = p.in[28]; N = 1024; drow = AT_OUT; }
    else if (e == 20) { src = p.in[29]; N = 4096; drow = CV_IN; }
    else { src = p.in[32]; N = 1024; drow = CV_OUT; }
    conv_tiles(src, N, W + (size_t)drow * 1024, lds);
  }
  {
    float* scond = lds;
    float* red = lds + 5120;
    for (int e = tid; e < 5120; e += NT) { const int cnd = e >> 10, k = e & 1023; const float cv = cnd == 0 ? p.in[6][k] : p.in[5][(cnd - 1) * 1024 + k]; scond[e] = silu(cv); }
    __syncthreads();
    float* ada = (float*)(p.ws + WS_ADA);
    for (int task = blockIdx.x; task < 192; task += gridDim.x) {
      const int layer = task / 48, n0 = (task % 48) * 64, c = tid & 63, kg = tid >> 6;
      float a0 = 0.f, a1 = 0.f, a2 = 0.f, a3 = 0.f, a4 = 0.f;
      const float* wp = p.in[9] + ((size_t)layer * 1024 + kg * 128) * 3072 + n0 + c;
#pragma unroll 8
      for (int k = 0; k < 128; ++k) { const float w = wp[(size_t)k * 3072]; const int kk = kg * 128 + k;
        a0 += scond[kk] * w; a1 += scond[1024 + kk] * w; a2 += scond[2048 + kk] * w; a3 += scond[3072 + kk] * w; a4 += scond[4096 + kk] * w; }
      red[(kg * 5 + 0) * 64 + c] = a0; red[(kg * 5 + 1) * 64 + c] = a1; red[(kg * 5 + 2) * 64 + c] = a2; red[(kg * 5 + 3) * 64 + c] = a3; red[(kg * 5 + 4) * 64 + c] = a4;
      __syncthreads();
      if (tid < 320) { const int cnd = tid >> 6; float s = p.in[10][layer * 3072 + n0 + c];
#pragma unroll
        for (int q = 0; q < 8; ++q) s += red[(q * 5 + cnd) * 64 + c];
        ada[(cnd * 4 + layer) * 3072 + n0 + c] = s; }
      __syncthreads();
    }
  }
  if (blockIdx.x == gridDim.x - 1) {
    float* rope = (float*)(p.ws + WS_ROPE);
    for (int e = tid; e < 1024; e += NT) {
      const int pos = e >> 4, f = e & 15;
      double inv = 1.0; for (int q = 0; q < f; ++q) inv *= 0.5623413251903491;
      double ang = (double)pos * inv;
      const double twopi = 6.283185307179586476925286766559;
      double n = __builtin_rint(ang / twopi); double rr = ang - n * twopi;
      double r2 = rr * rr, sn = 0.0, cs = 0.0, ts = rr, tc = 1.0;
      for (int q = 0; q < 16; ++q) { cs += tc; sn += ts; tc = -tc * r2 / (double)((2 * q + 1) * (2 * q + 2)); ts = -ts * r2 / (double)((2 * q + 2) * (2 * q + 3)); }
      rope[e * 2] = (float)cs; rope[e * 2 + 1] = (float)sn;
    }
  }
}

DI void phase_norm(const P& p, int g, int lpost, int lpre, const float* __restrict__ xsrc, float* __restrict__ xdst,
                   const bf16_t* __restrict__ Mb, bf16_t* __restrict__ H) {
  const int T = g ? 16384 : 8192;
  const int tid = otid(); const int lane = tid & 63, wave = tid >> 6;
  const float* ada = (const float*)(p.ws + WS_ADA);
  for (int t = blockIdx.x * 8 + wave; t < T; t += gridDim.x * 8) {
    const int cond = g ? 1 + (t >> 12) : 0;
    float4 x[4];
#pragma unroll
    for (int i = 0; i < 4; ++i) x[i] = *(const float4*)(xsrc + (size_t)t * 1024 + 256 * i + 4 * lane);
    if (lpost >= 0) {
      float m[16]; float ss = 0.f;
#pragma unroll
      for (int i = 0; i < 4; ++i) { const u32x2 u = *(const u32x2*)(Mb + (size_t)t * 1024 + 256 * i + 4 * lane);
        m[4 * i] = bflo(u[0]); m[4 * i + 1] = bfhi(u[0]); m[4 * i + 2] = bflo(u[1]); m[4 * i + 3] = bfhi(u[1]); }
#pragma unroll
      for (int i = 0; i < 16; ++i) ss += m[i] * m[i];
      ss = wave_sum(ss);
      const float rs = rsqrtf(ss * (1.f / 1024.f) + 1e-6f);
      const float* gate = ada + (cond * 4 + lpost) * 3072 + 2048;
      const float* wpo = p.in[8] + lpost * 1024;
#pragma unroll
      for (int i = 0; i < 4; ++i) { const int c = 256 * i + 4 * lane; const float4 gt = *(const float4*)(gate + c); const float4 wv = *(const float4*)(wpo + c);
        x[i].x += gt.x * (m[4 * i] * rs * wv.x); x[i].y += gt.y * (m[4 * i + 1] * rs * wv.y); x[i].z += gt.z * (m[4 * i + 2] * rs * wv.z); x[i].w += gt.w * (m[4 * i + 3] * rs * wv.w);
        *(float4*)(xdst + (size_t)t * 1024 + c) = x[i]; }
    }
    if (lpre >= 0) {
      float ss = 0.f;
#pragma unroll
      for (int i = 0; i < 4; ++i) ss += x[i].x * x[i].x + x[i].y * x[i].y + x[i].z * x[i].z + x[i].w * x[i].w;
      ss = wave_sum(ss);
      const float rs = rsqrtf(ss * (1.f / 1024.f) + 1e-6f);
      const float* sh = ada + (cond * 4 + lpre) * 3072; const float* sc = sh + 1024; const float* wpr = p.in[7] + lpre * 1024;
#pragma unroll
      for (int i = 0; i < 4; ++i) { const int c = 256 * i + 4 * lane; const float4 s4 = *(const float4*)(sh + c); const float4 c4 = *(const float4*)(sc + c); const float4 wv = *(const float4*)(wpr + c);
        u32x2 o; o[0] = pack2(x[i].x * rs * wv.x * (1.f + c4.x) + s4.x, x[i].y * rs * wv.y * (1.f + c4.y) + s4.y);
        o[1] = pack2(x[i].z * rs * wv.z * (1.f + c4.z) + s4.z, x[i].w * rs * wv.w * (1.f + c4.w) + s4.w);
        *(u32x2*)(H + (size_t)t * 1024 + c) = o; }
    }
  }
}

DI void phase_cache_copy(const P& p) {
  bf16_t* Kb = (bf16_t*)(p.ws + WS_SLOT) + 4 * SLOT_ELEMS; bf16_t* Vt = Kb + SLOT_ELEMS / 2;
  for (int e = blockIdx.x * NT + otid(); e < 262144; e += gridDim.x * NT) {
    const int c = e & 255, pp = (e >> 8) & 255, b = e >> 16; const int kvh = c >> 6, d = c & 63;
    Kb[((size_t)b * 4352 + 4096 + pp) * 256 + c] = (bf16_t)f2bf(p.in[3][e]);
    Vt[((size_t)(b * 4 + kvh) * 64 + d) * 4352 + 4096 + pp] = (bf16_t)f2bf(p.in[4][e]);
  }
}

template <int SHIFT> DI void ld_half(const bf16_t* __restrict__ A, int t, int k, int Lmask, u32x4 (&raw)[4]) {
  raw[1] = *(const u32x4*)(A + (size_t)t * 1024 + k);
  raw[2] = *(const u32x4*)(A + (size_t)(t + 1) * 1024 + k);
  if (SHIFT) {
    raw[0] = (u32x4){0u, 0u, 0u, 0u}; raw[3] = (u32x4){0u, 0u, 0u, 0u};
    if ((t & Lmask) != 0) raw[0] = *(const u32x4*)(A + (size_t)(t - 1) * 1024 + k);
    if (((t + 1) & Lmask) != Lmask) raw[3] = *(const u32x4*)(A + (size_t)(t + 2) * 1024 + k);
  }
}
DI u32x4 mix3(const u32x4& c, const u32x4& pz, const u32x4& nz, const float* smu, int k) {
  const float4 m0 = *(const float4*)(smu + k), m1 = *(const float4*)(smu + k + 4);
  const float mu[8] = {m0.x, m0.y, m0.z, m0.w, m1.x, m1.y, m1.z, m1.w};
  u32x4 o;
#pragma unroll
  for (int i = 0; i < 4; ++i) {
    const float h0 = bflo(c[i]), h1 = bfhi(c[i]);
    const float x0 = h0 + (0.5f * (bflo(pz[i]) + bflo(nz[i])) - h0) * mu[2 * i];
    const float x1 = h1 + (0.5f * (bfhi(pz[i]) + bfhi(nz[i])) - h1) * mu[2 * i + 1];
    o[i] = pack2(x0, x1);
  }
  return o;
}
template <int SHIFT> DI void st_half(unsigned char* dst, const u32x4 (&raw)[4], const float* smu, int k) {
  if (!SHIFT) { *(u32x4*)dst = raw[1]; *(u32x4*)(dst + 144) = raw[2]; }
  else { *(u32x4*)dst = mix3(raw[1], raw[0], raw[2], smu, k); *(u32x4*)(dst + 144) = mix3(raw[2], raw[1], raw[3], smu, k); }
}

template <int SHIFT, int EPI>
DI void phase_gemm(const P& p, int g, const bf16_t* __restrict__ A, const bf16_t* __restrict__ Bt, int M, int N,
                   const float* __restrict__ mu, int Lmask, bf16_t* __restrict__ dst, int rw, unsigned char* lds) {
  const int tid = otid(), lane = tid & 63, wave = tid >> 6;
  const int wm = wave >> 1, wn = wave & 1, r = lane & 31, h = lane >> 5;
  const int ntn = N >> 7, ntiles = ntn * (M >> 8);
  float* Cs = (float*)lds;
  float* smu = (float*)(lds + 110592);
  for (int tile = blockIdx.x; tile < ntiles; tile += gridDim.x) {
    const int mt = tile / ntn, nt = tile - mt * ntn; const int m0 = mt * 256, n0 = nt * 128;
    f32x16 acc[2][2];
#pragma unroll
    for (int a = 0; a < 2; ++a)
#pragma unroll
      for (int b = 0; b < 2; ++b)
#pragma unroll
        for (int i = 0; i < 16; ++i) acc[a][b][i] = 0.f;
    if (SHIFT) {
      const float* mup = mu + (nt < 32 ? (nt >> 3) : (nt == 32 ? 4 : 5)) * 1024;
      smu[tid] = mup[tid]; smu[tid + 512] = mup[tid + 512];
      __syncthreads();
    }
    if (!SHIFT) {
      u32x4 s0[6], s1[6];
      const int lrow = tid >> 3, lkc = (tid & 7) * 8;
#define G_LOAD(S, K0)  { _Pragma("unroll") for (int i = 0; i < 4; ++i) S[i] = *(const u32x4*)(A + (size_t)(m0 + lrow + 64 * i) * 1024 + (K0) + lkc); \
                         _Pragma("unroll") for (int i = 0; i < 2; ++i) S[4 + i] = *(const u32x4*)(Bt + (size_t)(n0 + lrow + 64 * i) * 1024 + (K0) + lkc); }
#define G_STORE(S, BUF) { _Pragma("unroll") for (int i = 0; i < 4; ++i) *(u32x4*)((BUF) + (lrow + 64 * i) * 144 + lkc * 2) = S[i]; \
                          _Pragma("unroll") for (int i = 0; i < 2; ++i) *(u32x4*)((BUF) + 36864 + (lrow + 64 * i) * 144 + lkc * 2) = S[4 + i]; }
#define G_COMPUTE(BUF) { _Pragma("unroll") for (int ks = 0; ks < 4; ++ks) { const int ko = (ks * 16 + h * 8) * 2; \
        const bf16x8 a0 = *(const bf16x8*)((BUF) + (wm * 64 + r) * 144 + ko); const bf16x8 a1 = *(const bf16x8*)((BUF) + (wm * 64 + 32 + r) * 144 + ko); \
        const bf16x8 b0 = *(const bf16x8*)((BUF) + 36864 + (wn * 64 + r) * 144 + ko); const bf16x8 b1 = *(const bf16x8*)((BUF) + 36864 + (wn * 64 + 32 + r) * 144 + ko); \
        acc[0][0] = MFMA32(a0, b0, acc[0][0]); acc[0][1] = MFMA32(a0, b1, acc[0][1]); acc[1][0] = MFMA32(a1, b0, acc[1][0]); acc[1][1] = MFMA32(a1, b1, acc[1][1]); } }
      G_LOAD(s0, 0) G_STORE(s0, lds)
      G_LOAD(s0, 64) G_LOAD(s1, 128)
      __syncthreads();
      for (int kt = 0; kt < 16; kt += 2) {
        G_COMPUTE(lds)
        G_STORE(s0, lds + 55296)
        if (kt + 3 < 16) G_LOAD(s0, (kt + 3) * 64)
        __syncthreads();
        G_COMPUTE(lds + 55296)
        if (kt + 2 < 16) G_STORE(s1, lds)
        if (kt + 4 < 16) G_LOAD(s1, (kt + 4) * 64)
        __syncthreads();
      }
#undef G_LOAD
#undef G_STORE
#undef G_COMPUTE
    } else {
    u32x4 raw[4], raw2[4], rb[2];
    const int arow = 4 * (tid >> 3), akc = (tid & 7) * 8;
#pragma unroll
    for (int hf = 0; hf < 2; ++hf) { ld_half<SHIFT>(A, m0 + arow + 2 * hf, akc, Lmask, raw); st_half<SHIFT>(lds + (arow + 2 * hf) * 144 + akc * 2, raw, smu, akc); }
#pragma unroll
    for (int i = 0; i < 2; ++i) { const int id = tid + 512 * i; rb[i] = *(const u32x4*)(Bt + (size_t)(n0 + (id >> 3)) * 1024 + (id & 7) * 8); }
#pragma unroll
    for (int i = 0; i < 2; ++i) { const int id = tid + 512 * i; *(u32x4*)(lds + 36864 + (id >> 3) * 144 + (id & 7) * 16) = rb[i]; }
    __syncthreads();
    for (int kt = 0; kt < 16; ++kt) {
      unsigned char* cur = lds + (kt & 1) * 55296; unsigned char* nxt = lds + ((kt + 1) & 1) * 55296;
      const int k1 = (kt + 1) * 64;
      if (kt < 15) {
        ld_half<SHIFT>(A, m0 + arow, k1 + akc, Lmask, raw);
        ld_half<SHIFT>(A, m0 + arow + 2, k1 + akc, Lmask, raw2);
#pragma unroll
        for (int i = 0; i < 2; ++i) { const int id = tid + 512 * i; rb[i] = *(const u32x4*)(Bt + (size_t)(n0 + (id >> 3)) * 1024 + k1 + (id & 7) * 8); }
      }
#pragma unroll
      for (int ks = 0; ks < 4; ++ks) {
        const int ko = (ks * 16 + h * 8) * 2;
        const bf16x8 a0 = *(const bf16x8*)(cur + (wm * 64 + r) * 144 + ko);
        const bf16x8 a1 = *(const bf16x8*)(cur + (wm * 64 + 32 + r) * 144 + ko);
        const bf16x8 b0 = *(const bf16x8*)(cur + 36864 + (wn * 64 + r) * 144 + ko);
        const bf16x8 b1 = *(const bf16x8*)(cur + 36864 + (wn * 64 + 32 + r) * 144 + ko);
        acc[0][0] = MFMA32(a0, b0, acc[0][0]); acc[0][1] = MFMA32(a0, b1, acc[0][1]);
        acc[1][0] = MFMA32(a1, b0, acc[1][0]); acc[1][1] = MFMA32(a1, b1, acc[1][1]);
      }
      if (kt < 15) {
        st_half<SHIFT>(nxt + arow * 144 + akc * 2, raw, smu, k1 + akc);
        st_half<SHIFT>(nxt + (arow + 2) * 144 + akc * 2, raw2, smu, k1 + akc);
#pragma unroll
        for (int i = 0; i < 2; ++i) { const int id = tid + 512 * i; *(u32x4*)(nxt + 36864 + (id >> 3) * 144 + (id & 7) * 16) = rb[i]; }
      }
      __syncthreads();
    }
    }
#pragma unroll
    for (int mi = 0; mi < 2; ++mi)
#pragma unroll
      for (int ni = 0; ni < 2; ++ni)
#pragma unroll
        for (int i = 0; i < 16; ++i) {
          const int row = wm * 64 + mi * 32 + (i & 3) + 8 * (i >> 2) + 4 * h, col = wn * 64 + ni * 32 + r;
          Cs[row * 132 + col] = acc[mi][ni][i];
        }
    __syncthreads();
    if (EPI == 0) {
#pragma unroll
      for (int i = 0; i < 8; ++i) {
        const int id = tid + 512 * i, row = id >> 4, cc = (id & 15) * 8;
        float4 v0 = *(const float4*)(Cs + row * 132 + cc), v1 = *(const float4*)(Cs + row * 132 + cc + 4);
        if (rw && nt == 32) { v0.x = tanhf(v0.x); v0.y = tanhf(v0.y); v0.z = tanhf(v0.z); v0.w = tanhf(v0.w); v1.x = tanhf(v1.x); v1.y = tanhf(v1.y); v1.z = tanhf(v1.z); v1.w = tanhf(v1.w); }
        u32x4 o; o[0] = pack2(v0.x, v0.y); o[1] = pack2(v0.z, v0.w); o[2] = pack2(v1.x, v1.y); o[3] = pack2(v1.z, v1.w);
        if (rw && nt >= 32) *(u32x4*)((bf16_t*)(p.ws + WS_HID) + (size_t)(m0 + row) * 256 + (nt - 32) * 128 + cc) = o;
        else *(u32x4*)(dst + (size_t)(nt >> 3) * SLOT_ELEMS + (size_t)(m0 + row) * 1024 + (nt & 7) * 128 + cc) = o;
      }
    } else {
      const int row = tid & 255, hh = tid >> 8; const int t = m0 + row;
      float x[64];
#pragma unroll
      for (int q = 0; q < 16; ++q) { const float4 v = *(const float4*)(Cs + row * 132 + hh * 64 + 4 * q); x[4 * q] = v.x; x[4 * q + 1] = v.y; x[4 * q + 2] = v.z; x[4 * q + 3] = v.w; }
      bf16_t* slots = (bf16_t*)(p.ws + WS_SLOT);
      const int L = g ? 4096 : 256, Ltot = g ? 4352 : 256;
      const int b = g ? (t >> 12) : (t >> 8), s = t & (L - 1);
      if (nt < 10) {
        int vz = 0; asm volatile("" : "+v"(vz));
        const float* nw = (nt < 8 ? p.in[26] : p.in[27]) + vz;
        float ss = 0.f;
#pragma unroll
        for (int d = 0; d < 64; ++d) ss += x[d] * x[d];
        const float rs = rsqrtf(ss * (1.f / 64.f) + 1e-6f);
#pragma unroll
        for (int d = 0; d < 64; ++d) x[d] *= rs * nw[d];
        if (g == 0 && nt >= 8) {
          float* ck = p.out + OUT_CK + (size_t)t * 256 + ((nt - 8) * 2 + hh) * 64;
#pragma unroll
          for (int q = 0; q < 16; ++q) *(float4*)(ck + 4 * q) = make_float4(x[4 * q], x[4 * q + 1], x[4 * q + 2], x[4 * q + 3]);
        }
        if (g == 1) {
          const float2* rope = (const float2*)(p.ws + WS_ROPE);
          const int ri = s >> 6, ci = s & 63;
#pragma unroll
          for (int f = 0; f < 16; ++f) {
            const float2 cr = rope[ri * 16 + f]; const float x1 = x[f], x2 = x[16 + f];
            x[f] = x1 * cr.x - x2 * cr.y; x[16 + f] = x2 * cr.x + x1 * cr.y;
            const float2 cc = rope[ci * 16 + f]; const float y1 = x[32 + f], y2 = x[48 + f];
            x[32 + f] = y1 * cc.x - y2 * cc.y; x[48 + f] = y2 * cc.x + y1 * cc.y;
          }
        }
        bf16_t* dq = nt < 8 ? slots + 2 * SLOT_ELEMS + (size_t)t * 1024 + (nt * 2 + hh) * 64
                            : slots + 4 * SLOT_ELEMS + ((size_t)b * Ltot + s) * 256 + ((nt - 8) * 2 + hh) * 64;
#pragma unroll
        for (int q = 0; q < 8; ++q) { u32x4 o; o[0] = pack2(x[8 * q], x[8 * q + 1]); o[1] = pack2(x[8 * q + 2], x[8 * q + 3]); o[2] = pack2(x[8 * q + 4], x[8 * q + 5]); o[3] = pack2(x[8 * q + 6], x[8 * q + 7]); *(u32x4*)(dq + 8 * q) = o; }
      } else if (nt < 12) {
        const int kvh = (nt - 10) * 2 + hh;
        if (g == 0) {
          float* cv = p.out + OUT_CV + (size_t)t * 256 + kvh * 64;
#pragma unroll
          for (int q = 0; q < 16; ++q) *(float4*)(cv + 4 * q) = make_float4(x[4 * q], x[4 * q + 1], x[4 * q + 2], x[4 * q + 3]);
        }
        bf16_t* vt = slots + 4 * SLOT_ELEMS + SLOT_ELEMS / 2 + ((size_t)(b * 4 + kvh) * 64) * Ltot + s;
#pragma unroll
        for (int d = 0; d < 64; ++d) { *vt = (bf16_t)f2bf(x[d]); vt += Ltot; asm volatile("" : "+v"(vt)); }
      } else {
        bf16_t* dg = slots + 3 * SLOT_ELEMS + (size_t)t * 1024 + (nt - 12) * 128 + hh * 64;
#pragma unroll
        for (int q = 0; q < 8; ++q) { u32x4 o; o[0] = pack2(x[8 * q], x[8 * q + 1]); o[1] = pack2(x[8 * q + 2], x[8 * q + 3]); o[2] = pack2(x[8 * q + 4], x[8 * q + 5]); o[3] = pack2(x[8 * q + 6], x[8 * q + 7]); *(u32x4*)(dg + 8 * q) = o; }
      }
    }
    __syncthreads();
  }
}

DI u32x4 cat8(const u32x2 lo, const u32x2 hi) { u32x4 v; v[0] = lo[0]; v[1] = lo[1]; v[2] = hi[0]; v[3] = hi[1]; return v; }
DI void phase_scan(const P& p, int g, int jl, unsigned char* lds) {
  const int tid = otid(), lane = tid & 63, wave = tid >> 6, r = lane & 31, h = lane >> 5;
  const int L = g ? 4096 : 256, B = g ? 4 : 32, nsc = L >> 5;
  float* sR = (float*)lds; float* sW = sR + 2048; float* sKD = sW + 2048; float* sKK = sKD + 2048; float* sKKA = sKK + 2048;
  bf16_t* sHW = (bf16_t*)(lds + 40960); bf16_t* sHA = (bf16_t*)(lds + 45568);
  bf16_t* oAL = (bf16_t*)(lds + 50176); bf16_t* oRH = (bf16_t*)(lds + 54784); bf16_t* oBE = (bf16_t*)(lds + 59392); bf16_t* oGA = (bf16_t*)(lds + 64000);
  bf16_t* oBEt = (bf16_t*)(lds + 68608); bf16_t* oGAt = (bf16_t*)(lds + 73728); bf16_t* oUt = (bf16_t*)(lds + 78848); bf16_t* oZt = (bf16_t*)(lds + 83968);
  float* Bm = (float*)(lds + 89088); float* RHS = (float*)(lds + 93696); float* lamC = (float*)(lds + 101888); float* sP = (float*)(lds + 102144);
  unsigned char* frag = lds + 104192;
  const bf16_t* slots = (const bf16_t*)(p.ws + WS_SLOT);
  const bf16_t* Rg = slots + 1 * SLOT_ELEMS; const bf16_t* Kg = slots + 2 * SLOT_ELEMS; const bf16_t* Vg = slots + 3 * SLOT_ELEMS;
  const bf16_t* hid = (const bf16_t*)(p.ws + WS_HID);
  float* bon = (float*)(p.ws + WS_BON);
  const int ntasks = B * 32;
  for (int task = blockIdx.x; task < ntasks; task += gridDim.x) {
    const int z = task & 1, head = (task >> 1) & 15, b = task >> 5;
    bf16_t* Yg = (bf16_t*)(p.ws + WS_SLOT) + (z ? 0 : 5) * SLOT_ELEMS;
    const int mat = (wave >> 1) & 1, ntt = wave & 1;
    unsigned char* lfr = lds + 110336 + (wave & 3) * 4096;
    if (wave < 4) {
      const float* W2 = (mat ? p.in[18] : p.in[15]) + (size_t)(jl * 2 + z) * 65536 + head * 64 + 32 * ntt + r;
#pragma unroll
      for (int kk = 0; kk < 4; ++kk) { u32x4 pk;
#pragma unroll
        for (int j = 0; j < 4; ++j) pk[j] = pack2(W2[(size_t)(16 * kk + 8 * h + 2 * j) * 1024], W2[(size_t)(16 * kk + 8 * h + 2 * j + 1) * 1024]);
        *(u32x4*)(lfr + (kk * 64 + lane) * 16) = pk; }
    }
    const float bias = (mat ? p.in[16] : p.in[13])[(jl * 2 + z) * 1024 + head * 64 + 32 * ntt + r];
    const float kkc = p.in[19][jl * 1024 + head * 64 + lane], kac = p.in[20][jl * 1024 + head * 64 + lane], rkc = p.in[21][jl * 1024 + head * 64 + lane];
    f32x16 st0, st1;
#pragma unroll
    for (int q = 0; q < 16; ++q) { st0[q] = 0.f; st1[q] = 0.f; }
    const size_t stbase = ((((size_t)(b * 2 + jl) * 2 + z) * 16 + head) * 64 + (32 * (wave & 1) + r)) * 64;
    if (g && wave < 2) {
#pragma unroll
      for (int gq = 0; gq < 4; ++gq) {
        const float4 s0 = *(const float4*)(p.in[2] + stbase + 8 * gq + 4 * h), s1 = *(const float4*)(p.in[2] + stbase + 32 + 8 * gq + 4 * h);
        st0[4 * gq] = s0.x; st0[4 * gq + 1] = s0.y; st0[4 * gq + 2] = s0.z; st0[4 * gq + 3] = s0.w;
        st1[4 * gq] = s1.x; st1[4 * gq + 1] = s1.y; st1[4 * gq + 2] = s1.z; st1[4 * gq + 3] = s1.w;
      }
    }
    u32x4 pre[3];
#define SCAN_LOAD(sc_)                                                                                    \
    _Pragma("unroll") for (int i = 0; i < 3; ++i) {                                                       \
      const int id = tid + 512 * i;                                                                       \
      if (id < 1280) {                                                                                    \
        const int arr = id >> 8, s = (id >> 3) & 31, cc = (id & 7) * 8;                                   \
        const int tl = z ? (L - 1 - ((sc_) * 32 + s)) : ((sc_) * 32 + s);                                 \
        const size_t tok = (size_t)b * L + tl;                                                            \
        if (arr < 3) pre[i] = *(const u32x4*)((arr == 0 ? Rg : (arr == 1 ? Kg : Vg)) + tok * 1024 + head * 64 + cc); \
        else pre[i] = *(const u32x4*)(hid + tok * 256 + (arr - 3) * 128 + z * 64 + cc);                   \
      }                                                                                                   \
    }
    SCAN_LOAD(0)
    for (int sc = 0; sc < nsc; ++sc) {
      {
      const int tid = otid(), lane = tid & 63, wave = tid >> 6, r = lane & 31, h = lane >> 5; (void)r; (void)h; (void)lane; (void)wave;
#pragma unroll
      for (int i = 0; i < 3; ++i) {
        const int id = tid + 512 * i;
        if (id < 1280) {
          const int arr = id >> 8, s = (id >> 3) & 31, cc = (id & 7) * 8;
          const u32x4 u = pre[i];
          if (arr < 2) { float* d = (arr == 0 ? sR : sKD) + s * 64 + cc;
            *(float4*)d = make_float4(bflo(u[0]), bfhi(u[0]), bflo(u[1]), bfhi(u[1])); *(float4*)(d + 4) = make_float4(bflo(u[2]), bfhi(u[2]), bflo(u[3]), bfhi(u[3])); }
          else if (arr == 2) {
#pragma unroll
            for (int j = 0; j < 4; ++j) { oUt[(cc + 2 * j) * 40 + s] = (bf16_t)(u[j] & 0xffffu); oUt[(cc + 2 * j + 1) * 40 + s] = (bf16_t)(u[j] >> 16); }
          } else *(u32x4*)((arr == 3 ? sHW : sHA) + s * 72 + cc) = u;
        }
      }
      }
      __syncthreads();
      if (sc + 1 < nsc) { SCAN_LOAD(sc + 1) }
      {
      const int tid = otid(), lane = tid & 63, wave = tid >> 6, r = lane & 31, h = lane >> 5; (void)r; (void)h; (void)lane; (void)wave;
      {
        f32x16 acc;
#pragma unroll
        for (int i = 0; i < 16; ++i) acc[i] = 0.f;
        const int mat = (wave >> 1) & 1, ntt = wave & 1, hi8 = wave >> 2;
        const bf16_t* sH = mat ? sHA : sHW;
#pragma unroll
        for (int kk = 0; kk < 4; ++kk) { const bf16x8 a = *(const bf16x8*)(sH + r * 72 + 16 * kk + 8 * h); const bf16x8 bw = *(const bf16x8*)(lfr + (kk * 64 + lane) * 16); acc = MFMA32(a, bw, acc); }
#pragma unroll
        for (int i = 0; i < 16; ++i) {
          if ((i >> 3) != hi8) continue;
          const int srow = (i & 3) + 8 * (i >> 2) + 4 * h, c = 32 * ntt + r;
          const float xv = acc[i] + bias;
          const float sg = __builtin_amdgcn_rcpf(1.f + __expf(-xv));
          if (mat == 0) sW[srow * 64 + c] = __expf(-0.60653065971263342f * sg);
          else sKKA[srow * 64 + c] = sg;
        }
      }
      }
      __syncthreads();
      {
      const int tid = otid(), lane = tid & 63, wave = tid >> 6, r = lane & 31, h = lane >> 5; (void)r; (void)h; (void)lane; (void)wave;
#pragma unroll
      for (int i = 0; i < 4; ++i) {
        const int s = wave + 8 * i; const int c = lane;
        const float kraw = sKD[s * 64 + c], a = sKKA[s * 64 + c], rr = sR[s * 64 + c];
        const float pk = kraw * kkc; const float ss = wave_sum(pk * pk);
        const float kk = pk * rsqrtf(fmaxf(ss, 1e-24f));
        const float kd = kraw * (1.f + (a - 1.f) * kac);
        const float bs = wave_sum(rr * kd * rkc);
        sKD[s * 64 + c] = kd; sKK[s * 64 + c] = kk; sKKA[s * 64 + c] = kk * a;
        if (c == 0) { const int tl = z ? (L - 1 - (sc * 32 + s)) : (sc * 32 + s); bon[(((size_t)b * L + tl) * 16 + head) * 2 + z] = bs; }
      }
      }
      __syncthreads();
      {
        const int k = lane, tq = wave;
        float wq[4];
#pragma unroll
        for (int j = 0; j < 4; ++j) wq[j] = sW[(4 * tq + j) * 64 + k];
        sP[tq * 64 + k] = (wq[0] * wq[1]) * (wq[2] * wq[3]);
        __syncthreads();
        float lam = 1.f;
#pragma unroll
        for (int q = 0; q < 7; ++q) { const float pq = sP[q * 64 + k]; lam *= (q < tq) ? pq : 1.f; }
        u32x2 bt, gt; float nb[4], gg[4];
#pragma unroll
        for (int j = 0; j < 4; ++j) {
          const int t = 4 * tq + j;
          const float lamp = lam; lam = lamp * wq[j];
          const float inv = __builtin_amdgcn_rcpf(lam);
          const float al = lamp * sKK[t * 64 + k], be = sKKA[t * 64 + k] * inv, ga = sKD[t * 64 + k] * inv, rh = lam * sR[t * 64 + k];
          oAL[t * 72 + k] = (bf16_t)f2bf(al); oRH[t * 72 + k] = (bf16_t)f2bf(rh); oBE[t * 72 + k] = (bf16_t)f2bf(be); oGA[t * 72 + k] = (bf16_t)f2bf(ga);
          nb[j] = -be; gg[j] = ga;
        }
        bt[0] = pack2(nb[0], nb[1]); bt[1] = pack2(nb[2], nb[3]); gt[0] = pack2(gg[0], gg[1]); gt[1] = pack2(gg[2], gg[3]);
        *(u32x2*)(oBEt + k * 40 + 4 * tq) = bt; *(u32x2*)(oGAt + k * 40 + 4 * tq) = gt;
        if (tq == 7) lamC[k] = lam;
      }
      __syncthreads();
      {
      const int tid = otid(), lane = tid & 63, wave = tid >> 6, r = lane & 31, h = lane >> 5; (void)r; (void)h; (void)lane; (void)wave;
      if (wave < 4) {
        const bf16_t* As = (wave & 1) ? oGA : oBE; const bf16_t* Bs = (wave < 2) ? oAL : oRH;
        f32x16 x;
#pragma unroll
        for (int q = 0; q < 16; ++q) x[q] = 0.f;
#pragma unroll
        for (int s = 0; s < 4; ++s) { const bf16x8 a = *(const bf16x8*)(As + r * 72 + 16 * s + 8 * h); const bf16x8 bb = *(const bf16x8*)(Bs + r * 72 + 16 * s + 8 * h); x = MFMA32(a, bb, x); }
#pragma unroll
        for (int q = 0; q < 16; ++q) { const int i = (q & 3) + 8 * (q >> 2) + 4 * h; const bool keep = (wave < 2) ? (i < r) : (i <= r); x[q] = keep ? x[q] : 0.f; }
        if (wave == 0) {
#pragma unroll
          for (int gq = 0; gq < 4; ++gq) *(float4*)(Bm + r * 36 + 8 * gq + 4 * h) = make_float4(x[4 * gq], x[4 * gq + 1], x[4 * gq + 2], x[4 * gq + 3]);
        } else {
          const float sg = (wave == 2) ? -1.f : 1.f;
#pragma unroll
          for (int s = 0; s < 2; ++s) { u32x4 pk;
#pragma unroll
            for (int j = 0; j < 4; ++j) pk[j] = pack2(sg * x[8 * s + 2 * j], sg * x[8 * s + 2 * j + 1]);
            *(u32x4*)(frag + (((wave - 1) * 2 + s) * 64 + lane) * 16) = pk; }
        }
      }
      }
      __syncthreads();
      f32x16 y0;
#pragma unroll
      for (int q = 0; q < 16; ++q) y0[q] = 0.f;
      const int vloc = 32 * (wave & 1) + r;
      if (wave < 2) {
        f32x16 a0;
#pragma unroll
        for (int q = 0; q < 16; ++q) a0[q] = 0.f;
#pragma unroll
        for (int kb = 0; kb < 2; ++kb)
#pragma unroll
          for (int s = 0; s < 2; ++s) {
            u32x4 pk;
#pragma unroll
            for (int j = 0; j < 4; ++j) pk[j] = kb ? pack2(st1[8 * s + 2 * j], st1[8 * s + 2 * j + 1]) : pack2(st0[8 * s + 2 * j], st0[8 * s + 2 * j + 1]);
            const bf16x8 sf = __builtin_bit_cast(bf16x8, pk);
            const int ko = 32 * kb + 16 * s + 4 * h;
            const u32x4 aa = cat8(*(const u32x2*)(oAL + r * 72 + ko), *(const u32x2*)(oAL + r * 72 + ko + 8));
            const u32x4 ar = cat8(*(const u32x2*)(oRH + r * 72 + ko), *(const u32x2*)(oRH + r * 72 + ko + 8));
            a0 = MFMA32(__builtin_bit_cast(bf16x8, aa), sf, a0);
            y0 = MFMA32(__builtin_bit_cast(bf16x8, ar), sf, y0);
          }
#pragma unroll
        for (int s = 0; s < 2; ++s) {
          const bf16x8 fg = *(const bf16x8*)(frag + ((0 * 2 + s) * 64 + lane) * 16);
          const bf16x8 fpg = *(const bf16x8*)(frag + ((2 * 2 + s) * 64 + lane) * 16);
          const u32x4 ub = cat8(*(const u32x2*)(oUt + vloc * 40 + 16 * s + 4 * h), *(const u32x2*)(oUt + vloc * 40 + 16 * s + 4 * h + 8));
          a0 = MFMA32(fg, __builtin_bit_cast(bf16x8, ub), a0);
          y0 = MFMA32(fpg, __builtin_bit_cast(bf16x8, ub), y0);
        }
#pragma unroll
        for (int q = 0; q < 16; ++q) RHS[((q & 3) + 8 * (q >> 2) + 4 * h) * 64 + vloc] = a0[q];
        float* park = sR + wave * 3072 + lane * 4;
#pragma unroll
        for (int gq = 0; gq < 4; ++gq) {
          *(float4*)(park + gq * 256) = make_float4(st0[4 * gq], st0[4 * gq + 1], st0[4 * gq + 2], st0[4 * gq + 3]);
          *(float4*)(park + 1024 + gq * 256) = make_float4(st1[4 * gq], st1[4 * gq + 1], st1[4 * gq + 2], st1[4 * gq + 3]);
          *(float4*)(park + 2048 + gq * 256) = make_float4(y0[4 * gq], y0[4 * gq + 1], y0[4 * gq + 2], y0[4 * gq + 3]);
        }
      }
      __syncthreads();
      {
      const int tid = otid(), lane = tid & 63, wave = tid >> 6, r = lane & 31, h = lane >> 5; (void)r; (void)h; (void)lane; (void)wave;
      if (wave < 2) {
        float zv[32];
        const __attribute__((address_space(3))) float* Bmo = (const __attribute__((address_space(3))) float*)Bm;
        const __attribute__((address_space(3))) float* RHo = (const __attribute__((address_space(3))) float*)(RHS + vloc);
        asm volatile("" : "+v"(Bmo), "+v"(RHo));
#pragma unroll
        for (int t = 0; t < 32; ++t) zv[t] = 0.f;
        float4 cb[8], nb8[8]; float crhs = RHo[0], nrhs = 0.f;
#pragma unroll
        for (int q = 0; q < 8; ++q) { cb[q] = make_float4(0.f, 0.f, 0.f, 0.f); nb8[q] = make_float4(0.f, 0.f, 0.f, 0.f); }
#pragma unroll
        for (int t = 0; t < 32; ++t) {
          if (t + 1 < 32) {
            nrhs = RHo[(t + 1) * 64];
#pragma unroll
            for (int i4 = 0; i4 < (t + 4) / 4; ++i4) { typedef float f4v __attribute__((ext_vector_type(4))); const f4v q4 = *(const __attribute__((address_space(3))) f4v*)(Bmo + (t + 1) * 36 + 4 * i4); nb8[i4] = make_float4(q4[0], q4[1], q4[2], q4[3]); }
          }
          float a0s = crhs, a1s = 0.f, a2s = 0.f, a3s = 0.f;
#pragma unroll
          for (int i4 = 0; i4 < (t + 3) / 4; ++i4) {
            a0s -= cb[i4].x * zv[4 * i4]; a1s -= cb[i4].y * zv[4 * i4 + 1]; a2s -= cb[i4].z * zv[4 * i4 + 2]; a3s -= cb[i4].w * zv[4 * i4 + 3];
          }
          zv[t] = (a0s + a1s) + (a2s + a3s);
          asm volatile("" : "+v"(zv[t]) :: "memory");
          crhs = nrhs;
#pragma unroll
          for (int i4 = 0; i4 < 8; ++i4) cb[i4] = nb8[i4];
        }
        if (h == 0) {
#pragma unroll
          for (int q = 0; q < 4; ++q) { u32x4 o;
#pragma unroll
            for (int j = 0; j < 4; ++j) o[j] = pack2(zv[8 * q + 2 * j], zv[8 * q + 2 * j + 1]);
            *(u32x4*)(oZt + vloc * 40 + 8 * q) = o; }
        }
      }
      }
      __syncthreads();
      {
      const int tid = otid(), lane = tid & 63, wave = tid >> 6, r = lane & 31, h = lane >> 5; (void)r; (void)h; (void)lane; (void)wave;
      if (wave < 2) {
        { const float* park = sR + wave * 3072 + lane * 4;
#pragma unroll
          for (int gq = 0; gq < 4; ++gq) {
            const float4 a = *(const float4*)(park + gq * 256), bq = *(const float4*)(park + 1024 + gq * 256), cq = *(const float4*)(park + 2048 + gq * 256);
            st0[4 * gq] = a.x; st0[4 * gq + 1] = a.y; st0[4 * gq + 2] = a.z; st0[4 * gq + 3] = a.w;
            st1[4 * gq] = bq.x; st1[4 * gq + 1] = bq.y; st1[4 * gq + 2] = bq.z; st1[4 * gq + 3] = bq.w;
            y0[4 * gq] = cq.x; y0[4 * gq + 1] = cq.y; y0[4 * gq + 2] = cq.z; y0[4 * gq + 3] = cq.w;
          } }
#pragma unroll
        for (int s = 0; s < 2; ++s) {
          const bf16x8 ub = *(const bf16x8*)(oUt + vloc * 40 + 16 * s + 8 * h), zb = *(const bf16x8*)(oZt + vloc * 40 + 16 * s + 8 * h);
          const bf16x8 g0 = *(const bf16x8*)(oGAt + r * 40 + 16 * s + 8 * h), g1 = *(const bf16x8*)(oGAt + (32 + r) * 40 + 16 * s + 8 * h);
          const bf16x8 b0 = *(const bf16x8*)(oBEt + r * 40 + 16 * s + 8 * h), b1 = *(const bf16x8*)(oBEt + (32 + r) * 40 + 16 * s + 8 * h);
          st0 = MFMA32(g0, ub, st0); st0 = MFMA32(b0, zb, st0);
          st1 = MFMA32(g1, ub, st1); st1 = MFMA32(b1, zb, st1);
          const bf16x8 fpb = *(const bf16x8*)(frag + ((1 * 2 + s) * 64 + lane) * 16);
          const u32x4 z8 = cat8(*(const u32x2*)(oZt + vloc * 40 + 16 * s + 4 * h), *(const u32x2*)(oZt + vloc * 40 + 16 * s + 4 * h + 8));
          y0 = MFMA32(fpb, __builtin_bit_cast(bf16x8, z8), y0);
        }
#pragma unroll
        for (int gq = 0; gq < 4; ++gq) {
          const float4 l0 = *(const float4*)(lamC + 8 * gq + 4 * h), l1 = *(const float4*)(lamC + 32 + 8 * gq + 4 * h);
          st0[4 * gq] *= l0.x; st0[4 * gq + 1] *= l0.y; st0[4 * gq + 2] *= l0.z; st0[4 * gq + 3] *= l0.w;
          st1[4 * gq] *= l1.x; st1[4 * gq + 1] *= l1.y; st1[4 * gq + 2] *= l1.z; st1[4 * gq + 3] *= l1.w;
        }
#pragma unroll
        for (int q = 0; q < 16; ++q) {
          const int t = (q & 3) + 8 * (q >> 2) + 4 * h; const int tl = z ? (L - 1 - (sc * 32 + t)) : (sc * 32 + t);
          Yg[((size_t)b * L + tl) * 1024 + head * 64 + vloc] = (bf16_t)f2bf(y0[q]);
        }
      }
      }
      __syncthreads();
    }
#undef SCAN_LOAD
    if (g == 0 && wave < 2) {
#pragma unroll
      for (int gq = 0; gq < 4; ++gq) {
        *(float4*)(p.out + OUT_ST + stbase + 8 * gq + 4 * h) = make_float4(st0[4 * gq], st0[4 * gq + 1], st0[4 * gq + 2], st0[4 * gq + 3]);
        *(float4*)(p.out + OUT_ST + stbase + 32 + 8 * gq + 4 * h) = make_float4(st1[4 * gq], st1[4 * gq + 1], st1[4 * gq + 2], st1[4 * gq + 3]);
      }
    }
    __syncthreads();
  }
}

DI void phase_rwkv_combine(const P& p, int g, int jl) {
  const int T = g ? 16384 : 8192;
  const int tid = otid(); const int lane = tid & 63, wave = tid >> 6;
  bf16_t* slots = (bf16_t*)(p.ws + WS_SLOT);
  const float* bon = (const float*)(p.ws + WS_BON);
  for (int t = blockIdx.x * 8 + wave; t < T; t += gridDim.x * 8) {
    const size_t o = (size_t)t * 1024 + 16 * lane; const int head = lane >> 2;
    float y[16], v[16], gg[16];
#pragma unroll
    for (int q = 0; q < 2; ++q) {
      const u32x4 a = *(const u32x4*)(slots + 5 * SLOT_ELEMS + o + 8 * q), bq = *(const u32x4*)(slots + 0 * SLOT_ELEMS + o + 8 * q);
      const u32x4 vq = *(const u32x4*)(slots + 3 * SLOT_ELEMS + o + 8 * q), gq = *(const u32x4*)(slots + 4 * SLOT_ELEMS + o + 8 * q);
#pragma unroll
      for (int i = 0; i < 4; ++i) { y[8 * q + 2 * i] = bflo(a[i]) + bflo(bq[i]); y[8 * q + 2 * i + 1] = bfhi(a[i]) + bfhi(bq[i]);
        v[8 * q + 2 * i] = bflo(vq[i]); v[8 * q + 2 * i + 1] = bfhi(vq[i]); gg[8 * q + 2 * i] = bflo(gq[i]); gg[8 * q + 2 * i + 1] = bfhi(gq[i]); }
    }
    float s = 0.f;
#pragma unroll
    for (int i = 0; i < 16; ++i) s += y[i];
    const float mean = quad_sum(s) * (1.f / 64.f);
    float vs = 0.f;
#pragma unroll
    for (int i = 0; i < 16; ++i) { const float d = y[i] - mean; vs += d * d; }
    const float rstd = rsqrtf(quad_sum(vs) * (1.f / 64.f) + 64e-5f);
    const float bs = bon[((size_t)t * 16 + head) * 2] + bon[((size_t)t * 16 + head) * 2 + 1];
    const float* gw = p.in[22] + jl * 1024 + 16 * lane; const float* gb = p.in[23] + jl * 1024 + 16 * lane;
    float ov[16];
#pragma unroll
    for (int i = 0; i < 16; ++i) ov[i] = ((y[i] - mean) * rstd * gw[i] + gb[i] + bs * v[i]) * silu(gg[i]);
#pragma unroll
    for (int q = 0; q < 2; ++q) { u32x4 w; w[0] = pack2(ov[8 * q], ov[8 * q + 1]); w[1] = pack2(ov[8 * q + 2], ov[8 * q + 3]); w[2] = pack2(ov[8 * q + 4], ov[8 * q + 5]); w[3] = pack2(ov[8 * q + 6], ov[8 * q + 7]);
      *(u32x4*)(slots + 4 * SLOT_ELEMS + o + 8 * q) = w; }
  }
}

DI void phase_conv(const P& p, int g) {
  const int T = g ? 16384 : 8192, Lmask = g ? 4095 : 255;
  bf16_t* slots = (bf16_t*)(p.ws + WS_SLOT);
  const bf16_t* BG = slots + 2 * SLOT_ELEMS; const bf16_t* CG = slots + 3 * SLOT_ELEMS; const bf16_t* U = slots + 4 * SLOT_ELEMS; const bf16_t* G = slots + 5 * SLOT_ELEMS;
  bf16_t* O = slots;
  for (int e = blockIdx.x * NT + otid(); e < T * 128; e += gridDim.x * NT) {
    const int t = e >> 7, c = (e & 127) * 8; const size_t o = (size_t)t * 1024 + c; const int tl = t & Lmask;
    const u32x4 zz = {0u, 0u, 0u, 0u};
    const u32x4 c1 = *(const u32x4*)(CG + o), u1 = *(const u32x4*)(U + o);
    const u32x4 c0 = tl != 0 ? *(const u32x4*)(CG + o - 1024) : zz, u0 = tl != 0 ? *(const u32x4*)(U + o - 1024) : zz;
    const u32x4 c2 = tl != Lmask ? *(const u32x4*)(CG + o + 1024) : zz, u2 = tl != Lmask ? *(const u32x4*)(U + o + 1024) : zz;
    const u32x4 bg = *(const u32x4*)(BG + o), gg = *(const u32x4*)(G + o);
    const float* cw = p.in[30]; const float* cb = p.in[31];
    u32x4 w;
#pragma unroll
    for (int i = 0; i < 4; ++i) {
      const int ch = c + 2 * i;
      const float lo = bflo(bg[i]) * (cw[ch] * bflo(c0[i]) * bflo(u0[i]) + cw[1024 + ch] * bflo(c1[i]) * bflo(u1[i]) + cw[2048 + ch] * bflo(c2[i]) * bflo(u2[i]) + cb[ch]) * silu(bflo(gg[i]));
      const float hi = bfhi(bg[i]) * (cw[ch + 1] * bfhi(c0[i]) * bfhi(u0[i]) + cw[1024 + ch + 1] * bfhi(c1[i]) * bfhi(u1[i]) + cw[2048 + ch + 1] * bfhi(c2[i]) * bfhi(u2[i]) + cb[ch + 1]) * silu(bfhi(gg[i]));
      w[i] = pack2(lo, hi);
    }
    *(u32x4*)(O + o) = w;
  }
}

DI void phase_attn(const P& p, int g, unsigned char* lds) {
  const int tid = otid(), lane = tid & 63, wave = tid >> 6, r = lane & 31, h = lane >> 5;
  const int L = g ? 4096 : 256, Ltot = g ? 4352 : 256, B = g ? 4 : 32;
  const int nq = L >> 6, ntasks = B * 4 * nq, nkt = Ltot >> 6;
  bf16_t* slots = (bf16_t*)(p.ws + WS_SLOT);
  bf16_t* Q = slots + 2 * SLOT_ELEMS; const bf16_t* G = slots + 3 * SLOT_ELEMS;
  const bf16_t* Kb = slots + 4 * SLOT_ELEMS; const bf16_t* Vt = Kb + SLOT_ELEMS / 2;
  const float SC = 0.125f * 1.4426950408889634f;
  for (int task = blockIdx.x; task < ntasks; task += gridDim.x) {
    const int qt = task % nq, kvh = (task / nq) & 3, b = task / (nq * 4);
    const int head = kvh * 4 + (wave >> 1); const int q0 = qt * 64 + (wave & 1) * 32;
    const size_t tok = (size_t)b * L + q0 + r;
    bf16x8 qf[4];
#pragma unroll
    for (int ds = 0; ds < 4; ++ds) qf[ds] = *(const bf16x8*)(Q + tok * 1024 + head * 64 + ds * 16 + h * 8);
    float m = -1e30f, lsum = 0.f;
    f32x16 O0, O1;
#pragma unroll
    for (int i = 0; i < 16; ++i) { O0[i] = 0.f; O1[i] = 0.f; }
    const int lrow = tid >> 3, lc = (tid & 7) * 8;
    const bf16_t* gK = Kb + ((size_t)b * Ltot + lrow) * 256 + kvh * 64 + lc;
    const bf16_t* gV = Vt + ((size_t)(b * 4 + kvh) * 64 + lrow) * Ltot + lc;
    u32x4 rk = *(const u32x4*)gK, rv = *(const u32x4*)gV;
    *(u32x4*)(lds + lrow * 144 + lc * 2) = rk; *(u32x4*)(lds + 9216 + lrow * 144 + lc * 2) = rv;
    __syncthreads();
    for (int kt = 0; kt < nkt; ++kt) {
      const unsigned char* cur = lds + (kt & 1) * 18432; unsigned char* nxt = lds + ((kt + 1) & 1) * 18432;
      if (kt + 1 < nkt) { rk = *(const u32x4*)(gK + (size_t)(kt + 1) * 64 * 256); rv = *(const u32x4*)(gV + (kt + 1) * 64); }
      f32x16 s0, s1;
#pragma unroll
      for (int i = 0; i < 16; ++i) { s0[i] = 0.f; s1[i] = 0.f; }
#pragma unroll
      for (int ds = 0; ds < 4; ++ds) {
        const bf16x8 a0 = *(const bf16x8*)(cur + r * 144 + (ds * 16 + h * 8) * 2);
        const bf16x8 a1 = *(const bf16x8*)(cur + (32 + r) * 144 + (ds * 16 + h * 8) * 2);
        s0 = MFMA32(a0, qf[ds], s0); s1 = MFMA32(a1, qf[ds], s1);
      }
      float tmax = s0[0];
#pragma unroll
      for (int i = 1; i < 16; ++i) tmax = fmaxf(tmax, s0[i]);
#pragma unroll
      for (int i = 0; i < 16; ++i) tmax = fmaxf(tmax, s1[i]);
      tmax = fmaxf(tmax, __shfl_xor(tmax, 32));
      const float mnew = fmaxf(m, tmax * SC);
      const float alpha = __builtin_amdgcn_exp2f(m - mnew);
      float ps = 0.f;
#pragma unroll
      for (int i = 0; i < 16; ++i) { s0[i] = __builtin_amdgcn_exp2f(s0[i] * SC - mnew); s1[i] = __builtin_amdgcn_exp2f(s1[i] * SC - mnew); ps += s0[i] + s1[i]; }
      lsum = lsum * alpha + ps; m = mnew;
#pragma unroll
      for (int i = 0; i < 16; ++i) { O0[i] *= alpha; O1[i] *= alpha; }
      const unsigned char* vs = cur + 9216;
#pragma unroll
      for (int kb = 0; kb < 2; ++kb)
#pragma unroll
        for (int s = 0; s < 2; ++s) {
          u32x4 pk;
#pragma unroll
          for (int j = 0; j < 4; ++j) pk[j] = kb ? pack2(s1[8 * s + 2 * j], s1[8 * s + 2 * j + 1]) : pack2(s0[8 * s + 2 * j], s0[8 * s + 2 * j + 1]);
          const bf16x8 pf = __builtin_bit_cast(bf16x8, pk);
          const int ko = (32 * kb + 16 * s + 4 * h) * 2;
          { const u32x2 lo = *(const u32x2*)(vs + r * 144 + ko), hi = *(const u32x2*)(vs + r * 144 + ko + 16);
            u32x4 av; av[0] = lo[0]; av[1] = lo[1]; av[2] = hi[0]; av[3] = hi[1];
            O0 = MFMA32(__builtin_bit_cast(bf16x8, av), pf, O0); }
          { const u32x2 lo = *(const u32x2*)(vs + (32 + r) * 144 + ko), hi = *(const u32x2*)(vs + (32 + r) * 144 + ko + 16);
            u32x4 av; av[0] = lo[0]; av[1] = lo[1]; av[2] = hi[0]; av[3] = hi[1];
            O1 = MFMA32(__builtin_bit_cast(bf16x8, av), pf, O1); }
        }
      if (kt + 1 < nkt) { *(u32x4*)(nxt + lrow * 144 + lc * 2) = rk; *(u32x4*)(nxt + 9216 + lrow * 144 + lc * 2) = rv; }
      __syncthreads();
    }
    lsum += __shfl_xor(lsum, 32);
    const float inv = 1.f / lsum;
#pragma unroll
    for (int db = 0; db < 2; ++db)
#pragma unroll
      for (int i4 = 0; i4 < 4; ++i4) {
        const size_t o = tok * 1024 + head * 64 + 32 * db + 8 * i4 + 4 * h;
        const u32x2 gq = *(const u32x2*)(G + o);
        const float v0 = (db ? O1[4 * i4] : O0[4 * i4]) * inv, v1 = (db ? O1[4 * i4 + 1] : O0[4 * i4 + 1]) * inv;
        const float v2 = (db ? O1[4 * i4 + 2] : O0[4 * i4 + 2]) * inv, v3 = (db ? O1[4 * i4 + 3] : O0[4 * i4 + 3]) * inv;
        u32x2 w; w[0] = pack2(v0 * silu(bflo(gq[0])), v1 * silu(bfhi(gq[0]))); w[1] = pack2(v2 * silu(bflo(gq[1])), v3 * silu(bfhi(gq[1])));
        *(u32x2*)(slots + 5 * SLOT_ELEMS + o) = w;
      }
  }
}


#define XB_TMO      128
#define XB_XCNT(j)  (256  + 64 * (j))
#define XB_XSUB(j)  (1280 + 64 * (j))
#define XB_XGEN(j)  (2304 + 64 * (j))
#define XB_TOP      3328
#define XB_TOPGEN   3392
#define XCD_BAR_WORDS 3456
#define XB_SPIN_CAP (1u << 22)
#define LAS __attribute__((address_space(3)))
DI unsigned xb_ld(unsigned* p) { return __hip_atomic_load(p, __ATOMIC_RELAXED, __HIP_MEMORY_SCOPE_AGENT); }
DI unsigned xb_add(unsigned* p, unsigned v) { return __hip_atomic_fetch_add(p, v, __ATOMIC_RELAXED, __HIP_MEMORY_SCOPE_AGENT); }
DI unsigned xb_xcc_id() { return (unsigned)__builtin_amdgcn_s_getreg((3 << 11) | 20) & 0xFu; }
#define XB_SPIN(cond, bar) do { unsigned _sp = 0; while (cond) { __builtin_amdgcn_s_sleep(1); \
    if ((++_sp & 255u) == 0u) { if (xb_ld(&(bar)[XB_TMO])) break; if (_sp > XB_SPIN_CAP) { atomicAdd(&(bar)[XB_TMO], 1u); break; } } } } while (0)
struct XcdBarrier { unsigned* bar; unsigned x; volatile LAS unsigned* st; };
DI XcdBarrier xcd_barrier_post(unsigned* bar, volatile LAS unsigned* st) {
  XcdBarrier b; b.bar = bar; b.x = xb_xcc_id(); b.st = st;
  if (threadIdx.x == 0) (void)xb_add(&bar[XB_XCNT(b.x)], 1u);
  return b;
}
DI void xcd_barrier_complete(unsigned* bar, unsigned x, unsigned& nloc, unsigned& nx) {
  const unsigned G = gridDim.x * gridDim.y * gridDim.z;
  unsigned sum, cnt, mine, sp = 0u;
  for (;;) {
    sum = 0u; cnt = 0u; mine = 0u;
#pragma unroll
    for (unsigned j = 0; j < 16; ++j) { const unsigned c = xb_ld(&bar[XB_XCNT(j)]); sum += c; cnt += (c > 0u) ? 1u : 0u; mine = (j == x) ? c : mine; }
    if (sum == G) break;
    __builtin_amdgcn_s_sleep(1);
    if ((++sp & 255u) == 0u) { if (xb_ld(&bar[XB_TMO])) break; if (sp > XB_SPIN_CAP) { atomicAdd(&bar[XB_TMO], 1u); break; } }
  }
  nloc = mine > 0u ? mine : 1u; nx = cnt > 0u ? cnt : 1u;
}
DI void xcd_barrier(const XcdBarrier& b) {
  asm volatile("s_waitcnt vmcnt(0)" ::: "memory");
  __syncthreads();
  if (threadIdx.x == 0) {
    unsigned* bar = b.bar;
    __builtin_amdgcn_s_waitcnt(0);
    unsigned nloc = b.st[0], nx = b.st[1];
    if (nloc == 0u) { xcd_barrier_complete(bar, b.x, nloc, nx); b.st[0] = nloc; b.st[1] = nx; }
    const unsigned old = xb_add(&bar[XB_XSUB(b.x)], 1u);
    const unsigned gen = old / nloc;
    if (old + 1u == (gen + 1u) * nloc) {
      __builtin_amdgcn_fence(__ATOMIC_RELEASE, "agent");
      asm volatile("s_waitcnt vmcnt(0)" ::: "memory");
      const unsigned og = xb_add(&bar[XB_TOP], 1u);
      const unsigned tg = og / nx;
      if (og + 1u == (tg + 1u) * nx) xb_add(&bar[XB_TOPGEN], 1u);
      else XB_SPIN(xb_ld(&bar[XB_TOPGEN]) == tg, bar);
      __builtin_amdgcn_fence(__ATOMIC_ACQUIRE, "agent");
      xb_add(&bar[XB_XGEN(b.x)], 1u);
      asm volatile("s_waitcnt vmcnt(0)" ::: "memory");
    } else {
      XB_SPIN(xb_ld(&bar[XB_XGEN(b.x)]) == gen, bar);
      __builtin_amdgcn_fence(__ATOMIC_ACQUIRE, "agent");
      asm volatile("s_waitcnt vmcnt(0)" ::: "memory");
    }
  }
  __syncthreads();
}

#define GPTR(T, x) ((T*)(__attribute__((address_space(1))) T*)(x))
__global__ void __launch_bounds__(NT) mega(P p) {
  extern __shared__ __attribute__((aligned(16))) unsigned char lds[];
  cg::grid_group grid = cg::this_grid();
  volatile LAS unsigned* st = (volatile LAS unsigned*)(lds + 135168);
  if (threadIdx.x < 4) st[threadIdx.x] = 0u;
  __syncthreads();
  const XcdBarrier xbar = xcd_barrier_post((unsigned*)(p.ws + WS_BAR), st);
  phase0(p, lds);
  grid.sync();
  const P& p0 = p;
  for (int step = 0; step < 50; ++step) {
    const int g = step / 25, rem = step - g * 25, layer = rem / 5, sub = rem - layer * 5;
    const int kind = layer % 3, jl = layer / 3;
    const int T = g ? 16384 : 8192, Lmask = g ? 4095 : 255;
    int op = -1;
    if (layer == 4) op = (sub == 0) ? 0 : -1;
    else if (sub == 0) op = 0;
    else if (kind == 0) op = sub == 1 ? 1 : (sub == 2 ? 2 : (sub == 3 ? 3 : 4));
    else if (kind == 1) op = sub == 1 ? 5 : (sub == 2 ? 6 : (sub == 3 ? 4 : -1));
    else op = sub == 1 ? 4 : (sub == 2 ? 7 : (sub == 3 ? 4 : -1));
    if (op < 0) continue;
    P p = p0;
    { size_t zo_ = 0; asm volatile("" : "+s"(zo_)); p.ws = p0.ws + zo_; p.out = p0.out + zo_; }
    bf16_t* slots = (bf16_t*)(p.ws + WS_SLOT);
    const bf16_t* W = (const bf16_t*)(p.ws + WS_W);
    if (op == 0) {
      const float* xin = p.in[g]; float* xout = p.out + (g ? OUT_YS : OUT_YP);
      phase_norm(p, g, layer - 1, layer < 4 ? layer : -1, layer <= 1 ? xin : xout, xout, slots + SLOT_ELEMS, slots);
      if (kind == 1 && g == 1 && layer < 4) phase_cache_copy(p);
    } else if (op == 1) {
      for (int rep = 0; rep < opq(REP_GEMM); ++rep) phase_gemm<1, 0>(p, g, slots, W + (size_t)(RW_IN0 + jl * RW_STRIDE) * 1024, T, 4352, p.in[11] + jl * 6144, Lmask, slots + SLOT_ELEMS, 1, lds);
    } else if (op == 2) {
      for (int rep = 0; rep < opq(REP_SCAN); ++rep) phase_scan(p, g, jl, lds);
    } else if (op == 3) {
      phase_rwkv_combine(p, g, jl);
    } else if (op == 4) {
      const bf16_t* A; const bf16_t* Bt; int N; bf16_t* dst;
      if (sub == 1) { A = slots; Bt = W + (size_t)CV_IN * 1024; N = 4096; dst = slots + 2 * SLOT_ELEMS; }
      else {
        N = 1024; dst = slots + SLOT_ELEMS;
        if (kind == 0) { A = slots + 4 * SLOT_ELEMS; Bt = W + (size_t)(RW_OUT0 + jl * RW_STRIDE) * 1024; }
        else if (kind == 1) { A = slots + 5 * SLOT_ELEMS; Bt = W + (size_t)AT_OUT * 1024; }
        else { A = slots; Bt = W + (size_t)CV_OUT * 1024; }
      }
      for (int rep = 0; rep < opq(REP_GEMM); ++rep) phase_gemm<0, 0>(p, g, A, Bt, T, N, nullptr, 0, dst, 0, lds);
    } else if (op == 5) {
      for (int rep = 0; rep < opq(REP_GEMM); ++rep) phase_gemm<0, 1>(p, g, slots, W + (size_t)AT_IN * 1024, T, 2560, nullptr, 0, nullptr, 0, lds);
    } else if (op == 6) {
      for (int rep = 0; rep < opq(REP_ATTN); ++rep) phase_attn(p, g, lds);
    } else {
      phase_conv(p, g);
    }
    if (!(g == 1 && layer == 4)) for (int rep = 0; rep < opq(REP_SYNC); ++rep) xcd_barrier(xbar);
  }
}

extern "C" void kernel_launch(void* const* d_in, const int* in_sizes, int n_in, void* d_out, int out_size, void* d_ws, size_t ws_size, hipStream_t stream) {
  static int grid_blocks = 0;
  if (!grid_blocks) {
    int dev = 0, cus = 0, per_cu = 0;
    hipGetDevice(&dev);
    hipDeviceGetAttribute(&cus, hipDeviceAttributeMultiprocessorCount, dev);
    hipFuncSetAttribute((const void*)mega, hipFuncAttributeMaxDynamicSharedMemorySize, LDS_BYTES);
    hipOccupancyMaxActiveBlocksPerMultiprocessor(&per_cu, (const void*)mega, NT, LDS_BYTES);
    if (per_cu < 1) per_cu = 1;
    if (per_cu > 1) per_cu = 1;
    grid_blocks = cus * per_cu;
    if (ws_size < WS_SLOT + 6 * SLOT_ELEMS * 2) fprintf(stderr, "workspace too small: %zu\n", ws_size);
  }
  (void)hipMemsetAsync((unsigned char*)d_ws + WS_BAR, 0, XCD_BAR_WORDS * sizeof(unsigned), stream);
  P p{};
  for (int i = 0; i < 33; ++i) p.in[i] = (const float*)d_in[i];
  p.out = (float*)d_out; p.ws = (unsigned char*)d_ws;
  void* args[] = {&p};
  hipError_t e = hipLaunchCooperativeKernel((const void*)mega, dim3(grid_blocks), dim3(NT), args, LDS_BYTES, stream);
  if (e != hipSuccess) fprintf(stderr, "cooperative launch failed: %s (grid %d)\n", hipGetErrorString(e), grid_blocks);
}
```

```cpp
#include <hip/hip_runtime.h>
#include <hip/hip_cooperative_groups.h>
#include <cstdio>
namespace cg = cooperative_groups;

typedef unsigned short bf16_t;
using bf16x8 = __attribute__((ext_vector_type(8))) short;
using f32x16 = __attribute__((ext_vector_type(16))) float;
using u32x4 = __attribute__((ext_vector_type(4))) unsigned;
using u32x2 = __attribute__((ext_vector_type(2))) unsigned;

#define NT 512
#ifndef REP_GEMM
#define REP_GEMM 1
#endif
#ifndef REP_SCAN
#define REP_SCAN 1
#endif
#ifndef REP_ATTN
#define REP_ATTN 1
#endif
#ifndef REP_SYNC
#define REP_SYNC 1
#endif
#define DI __device__ __forceinline__
#define MFMA32(a, b, c) __builtin_amdgcn_mfma_f32_32x32x16_bf16((a), (b), (c), 0, 0, 0)

struct P { const float* in[33]; float* out; unsigned char* ws; };

constexpr size_t WS_ADA = 0;
constexpr size_t WS_ROPE = 262144;
constexpr size_t WS_BON = 327680;
constexpr size_t WS_HID = WS_BON + 2097152;
constexpr size_t WS_W = WS_HID + 8388608;
constexpr size_t WS_SLOT = WS_W + 39845888;
constexpr size_t SLOT_ELEMS = (size_t)16384 * 1024;
constexpr int RW_IN0 = 0, RW_OUT0 = 4352, RW_STRIDE = 5376, AT_IN = 10752, AT_OUT = 13312, CV_IN = 14336, CV_OUT = 18432;
constexpr size_t OUT_YP = 0, OUT_YS = 8388608, OUT_ST = 25165824, OUT_CK = 33554432, OUT_CV = 35651584;
constexpr int LDS_BYTES = 156416 + 16;
constexpr size_t WS_BAR = 278528;

typedef __bf16 bf16x2_t __attribute__((ext_vector_type(2)));
typedef float f32x2_t __attribute__((ext_vector_type(2)));
DI unsigned pack2(float a, float b) { f32x2_t v = {a, b}; return __builtin_bit_cast(unsigned, __builtin_convertvector(v, bf16x2_t)); }
DI unsigned f2bf(float x) { return (unsigned)__builtin_bit_cast(unsigned short, (__bf16)x); }
DI float bflo(unsigned u) { return __uint_as_float(u << 16); }
DI float bfhi(unsigned u) { return __uint_as_float(u & 0xffff0000u); }
DI float bf1(bf16_t u) { return __uint_as_float(((unsigned)u) << 16); }

template <int CTRL> DI float dppf(float v) { return __int_as_float(__builtin_amdgcn_update_dpp(0, __float_as_int(v), CTRL, 0xF, 0xF, true)); }
DI float reduce16(float v) { v += dppf<0xB1>(v); v += dppf<0x4E>(v); v += dppf<0x141>(v); v += dppf<0x140>(v); return v; }
DI float rdl(float v, int l) { return __int_as_float(__builtin_amdgcn_readlane(__float_as_int(v), l)); }
DI float wave_sum(float v) { v = reduce16(v); return (rdl(v, 0) + rdl(v, 16)) + (rdl(v, 32) + rdl(v, 48)); }
DI float quad_sum(float v) { v += dppf<0xB1>(v); v += dppf<0x4E>(v); return v; }
DI float silu(float x) { return x / (1.f + __expf(-x)); }
DI int opq(int v) { asm volatile("" : "+s"(v)); return v; }
DI int otid() { int t = threadIdx.x; asm volatile("" : "+v"(t)); return t; }

DI void conv_tiles(const float* __restrict__ src, int N, bf16_t* __restrict__ dst, float* lds) {
  const int tid = otid();
  const int tilesN = N >> 6, ntiles = 16 * tilesN;
  for (int tile = blockIdx.x; tile < ntiles; tile += gridDim.x) {
    const int kt = tile / tilesN, nt = tile - kt * tilesN, k0 = kt * 64, n0 = nt * 64;
#pragma unroll
    for (int i = 0; i < 8; ++i) { const int k = (tid >> 6) + 8 * i, n = tid & 63; lds[k * 65 + n] = src[(size_t)(k0 + k) * N + n0 + n]; }
    __syncthreads();
    { const int n = tid >> 3, kc = (tid & 7) * 8; u32x4 o;
#pragma unroll
      for (int j = 0; j < 4; ++j) o[j] = pack2(lds[(kc + 2 * j) * 65 + n], lds[(kc + 2 * j + 1) * 65 + n]);
      *(u32x4*)(dst + (size_t)(n0 + n) * 1024 + k0 + kc) = o; }
    __syncthreads();
  }
}

DI void phase0(const P& p, unsigned char* ldsb) {
  float* lds = (float*)ldsb;
  const int tid = otid();
  bf16_t* W = (bf16_t*)(p.ws + WS_W);
#pragma unroll 1
  for (int e = 0; e < opq(22); ++e) {
    const float* src; int N, drow;
    if (e < 18) {
      const int j = e / 9, q = e - j * 9;
      if (q < 4) { src = p.in[12] + (size_t)(j * 4 + q) * 1048576; N = 1024; drow = RW_IN0 + j * RW_STRIDE + q * 1024; }
      else if (q < 6) { src = p.in[14] + (size_t)(j * 2 + q - 4) * 65536; N = 64; drow = RW_IN0 + j * RW_STRIDE + 4096 + (q - 4) * 64; }
      else if (q < 8) { src = p.in[17] + (size_t)(j * 2 + q - 6) * 65536; N = 64; drow = RW_IN0 + j * RW_STRIDE + 4224 + (q - 6) * 64; }
      else { src = p.in[24] + (size_t)j * 1048576; N = 1024; drow = RW_OUT0 + j * RW_STRIDE; }
    } else if (e == 18) { src = p.in[25]; N = 2560; drow = AT_IN; }
    else if (e == 19) { src = p.in[28]; N = 1024; drow = AT_OUT; }
    else if (e == 20) { src = p.in[29]; N = 4096; drow = CV_IN; }
    else { src = p.in[32]; N = 1024; drow = CV_OUT; }
    conv_tiles(src, N, W + (size_t)drow * 1024, lds);
  }
  {
    float* scond = lds;
    float* red = lds + 5120;
    for (int e = tid; e < 5120; e += NT) { const int cnd = e >> 10, k = e & 1023; const float cv = cnd == 0 ? p.in[6][k] : p.in[5][(cnd - 1) * 1024 + k]; scond[e] = silu(cv); }
    __syncthreads();
    float* ada = (float*)(p.ws + WS_ADA);
    for (int task = blockIdx.x; task < 192; task += gridDim.x) {
      const int layer = task / 48, n0 = (task % 48) * 64, c = tid & 63, kg = tid >> 6;
      float a0 = 0.f, a1 = 0.f, a2 = 0.f, a3 = 0.f, a4 = 0.f;
      const float* wp = p.in[9] + ((size_t)layer * 1024 + kg * 128) * 3072 + n0 + c;
#pragma unroll 8
      for (int k = 0; k < 128; ++k) { const float w = wp[(size_t)k * 3072]; const int kk = kg * 128 + k;
        a0 += scond[kk] * w; a1 += scond[1024 + kk] * w; a2 += scond[2048 + kk] * w; a3 += scond[3072 + kk] * w; a4 += scond[4096 + kk] * w; }
      red[(kg * 5 + 0) * 64 + c] = a0; red[(kg * 5 + 1) * 64 + c] = a1; red[(kg * 5 + 2) * 64 + c] = a2; red[(kg * 5 + 3) * 64 + c] = a3; red[(kg * 5 + 4) * 64 + c] = a4;
      __syncthreads();
      if (tid < 320) { const int cnd = tid >> 6; float s = p.in[10][layer * 3072 + n0 + c];
#pragma unroll
        for (int q = 0; q < 8; ++q) s += red[(q * 5 + cnd) * 64 + c];
        ada[(cnd * 4 + layer) * 3072 + n0 + c] = s; }
      __syncthreads();
    }
  }
  if (blockIdx.x == gridDim.x - 1) {
    float* rope = (float*)(p.ws + WS_ROPE);
    for (int e = tid; e < 1024; e += NT) {
      const int pos = e >> 4, f = e & 15;
      double inv = 1.0; for (int q = 0; q < f; ++q) inv *= 0.5623413251903491;
      double ang = (double)pos * inv;
      const double twopi = 6.283185307179586476925286766559;
      double n = __builtin_rint(ang / twopi); double rr = ang - n * twopi;
      double r2 = rr * rr, sn = 0.0, cs = 0.0, ts = rr, tc = 1.0;
      for (int q = 0; q < 16; ++q) { cs += tc; sn += ts; tc = -tc * r2 / (double)((2 * q + 1) * (2 * q + 2)); ts = -ts * r2 / (double)((2 * q + 2) * (2 * q + 3)); }
      rope[e * 2] = (float)cs; rope[e * 2 + 1] = (float)sn;
    }
  }
}

DI void phase_norm(const P& p, int g, int lpost, int lpre, const float* __restrict__ xsrc, float* __restrict__ xdst,
                   const bf16_t* __restrict__ Mb, bf16_t* __restrict__ H) {
  const int T = g ? 16384 : 8192;
  const int tid = otid(); const int lane = tid & 63, wave = tid >> 6;
  const float* ada = (const float*)(p.ws + WS_ADA);
  for (int t = blockIdx.x * 8 + wave; t < T; t += gridDim.x * 8) {
    const int cond = g ? 1 + (t >> 12) : 0;
    float4 x[4];
#pragma unroll
    for (int i = 0; i < 4; ++i) x[i] = *(const float4*)(xsrc + (size_t)t * 1024 + 256 * i + 4 * lane);
    if (lpost >= 0) {
      float m[16]; float ss = 0.f;
#pragma unroll
      for (int i = 0; i < 4; ++i) { const u32x2 u = *(const u32x2*)(Mb + (size_t)t * 1024 + 256 * i + 4 * lane);
        m[4 * i] = bflo(u[0]); m[4 * i + 1] = bfhi(u[0]); m[4 * i + 2] = bflo(u[1]); m[4 * i + 3] = bfhi(u[1]); }
#pragma unroll
      for (int i = 0; i < 16; ++i) ss += m[i] * m[i];
      ss = wave_sum(ss);
      const float rs = rsqrtf(ss * (1.f / 1024.f) + 1e-6f);
      const float* gate = ada + (cond * 4 + lpost) * 3072 + 2048;
      const float* wpo = p.in[8] + lpost * 1024;
#pragma unroll
      for (int i = 0; i < 4; ++i) { const int c = 256 * i + 4 * lane; const float4 gt = *(const float4*)(gate + c); const float4 wv = *(const float4*)(wpo + c);
        x[i].x += gt.x * (m[4 * i] * rs * wv.x); x[i].y += gt.y * (m[4 * i + 1] * rs * wv.y); x[i].z += gt.z * (m[4 * i + 2] * rs * wv.z); x[i].w += gt.w * (m[4 * i + 3] * rs * wv.w);
        *(float4*)(xdst + (size_t)t * 1024 + c) = x[i]; }
    }
    if (lpre >= 0) {
      float ss = 0.f;
#pragma unroll
      for (int i = 0; i < 4; ++i) ss += x[i].x * x[i].x + x[i].y * x[i].y + x[i].z * x[i].z + x[i].w * x[i].w;
      ss = wave_sum(ss);
      const float rs = rsqrtf(ss * (1.f / 1024.f) + 1e-6f);
      const float* sh = ada + (cond * 4 + lpre) * 3072; const float* sc = sh + 1024; const float* wpr = p.in[7] + lpre * 1024;
#pragma unroll
      for (int i = 0; i < 4; ++i) { const int c = 256 * i + 4 * lane; const float4 s4 = *(const float4*)(sh + c); const float4 c4 = *(const float4*)(sc + c); const float4 wv = *(const float4*)(wpr + c);
        u32x2 o; o[0] = pack2(x[i].x * rs * wv.x * (1.f + c4.x) + s4.x, x[i].y * rs * wv.y * (1.f + c4.y) + s4.y);
        o[1] = pack2(x[i].z * rs * wv.z * (1.f + c4.z) + s4.z, x[i].w * rs * wv.w * (1.f + c4.w) + s4.w);
        *(u32x2*)(H + (size_t)t * 1024 + c) = o; }
    }
  }
}

DI void phase_cache_copy(const P& p) {
  bf16_t* Kb = (bf16_t*)(p.ws + WS_SLOT) + 4 * SLOT_ELEMS; bf16_t* Vt = Kb + SLOT_ELEMS / 2;
  for (int e = blockIdx.x * NT + otid(); e < 262144; e += gridDim.x * NT) {
    const int c = e & 255, pp = (e >> 8) & 255, b = e >> 16; const int kvh = c >> 6, d = c & 63;
    Kb[((size_t)b * 4352 + 4096 + pp) * 256 + c] = (bf16_t)f2bf(p.in[3][e]);
    Vt[((size_t)(b * 4 + kvh) * 64 + d) * 4352 + 4096 + pp] = (bf16_t)f2bf(p.in[4][e]);
  }
}

template <int SHIFT> DI void ld_half(const bf16_t* __restrict__ A, int t, int k, int Lmask, u32x4 (&raw)[4]) {
  raw[1] = *(const u32x4*)(A + (size_t)t * 1024 + k);
  raw[2] = *(const u32x4*)(A + (size_t)(t + 1) * 1024 + k);
  if (SHIFT) {
    raw[0] = (u32x4){0u, 0u, 0u, 0u}; raw[3] = (u32x4){0u, 0u, 0u, 0u};
    if ((t & Lmask) != 0) raw[0] = *(const u32x4*)(A + (size_t)(t - 1) * 1024 + k);
    if (((t + 1) & Lmask) != Lmask) raw[3] = *(const u32x4*)(A + (size_t)(t + 2) * 1024 + k);
  }
}
DI u32x4 mix3(const u32x4& c, const u32x4& pz, const u32x4& nz, const float* smu, int k) {
  const float4 m0 = *(const float4*)(smu + k), m1 = *(const float4*)(smu + k + 4);
  const float mu[8] = {m0.x, m0.y, m0.z, m0.w, m1.x, m1.y, m1.z, m1.w};
  u32x4 o;
#pragma unroll
  for (int i = 0; i < 4; ++i) {
    const float h0 = bflo(c[i]), h1 = bfhi(c[i]);
    const float x0 = h0 + (0.5f * (bflo(pz[i]) + bflo(nz[i])) - h0) * mu[2 * i];
    const float x1 = h1 + (0.5f * (bfhi(pz[i]) + bfhi(nz[i])) - h1) * mu[2 * i + 1];
    o[i] = pack2(x0, x1);
  }
  return o;
}
template <int SHIFT> DI void st_half(unsigned char* dst, const u32x4 (&raw)[4], const float* smu, int k) {
  if (!SHIFT) { *(u32x4*)dst = raw[1]; *(u32x4*)(dst + 144) = raw[2]; }
  else { *(u32x4*)dst = mix3(raw[1], raw[0], raw[2], smu, k); *(u32x4*)(dst + 144) = mix3(raw[2], raw[1], raw[3], smu, k); }
}

template <int SHIFT, int EPI>
DI void phase_gemm(const P& p, int g, const bf16_t* __restrict__ A, const bf16_t* __restrict__ Bt, int M, int N,
                   const float* __restrict__ mu, int Lmask, bf16_t* __restrict__ dst, int rw, unsigned char* lds) {
  const int tid = otid(), lane = tid & 63, wave = tid >> 6;
  const int wm = wave >> 1, wn = wave & 1, r = lane & 31, h = lane >> 5;
  const int ntn = N >> 7, ntiles = ntn * (M >> 8);
  float* Cs = (float*)lds;
  float* smu = (float*)(lds + 110592);
  for (int tile = blockIdx.x; tile < ntiles; tile += gridDim.x) {
    const int mt = tile / ntn, nt = tile - mt * ntn; const int m0 = mt * 256, n0 = nt * 128;
    f32x16 acc[2][2];
#pragma unroll
    for (int a = 0; a < 2; ++a)
#pragma unroll
      for (int b = 0; b < 2; ++b)
#pragma unroll
        for (int i = 0; i < 16; ++i) acc[a][b][i] = 0.f;
    if (SHIFT) {
      const float* mup = mu + (nt < 32 ? (nt >> 3) : (nt == 32 ? 4 : 5)) * 1024;
      smu[tid] = mup[tid]; smu[tid + 512] = mup[tid + 512];
      __syncthreads();
    }
    if (!SHIFT) {
      u32x4 s0[6], s1[6];
      const int lrow = tid >> 3, lkc = (tid & 7) * 8;
#define G_LOAD(S, K0)  { _Pragma("unroll") for (int i = 0; i < 4; ++i) S[i] = *(const u32x4*)(A + (size_t)(m0 + lrow + 64 * i) * 1024 + (K0) + lkc); \
                         _Pragma("unroll") for (int i = 0; i < 2; ++i) S[4 + i] = *(const u32x4*)(Bt + (size_t)(n0 + lrow + 64 * i) * 1024 + (K0) + lkc); }
#define G_STORE(S, BUF) { _Pragma("unroll") for (int i = 0; i < 4; ++i) *(u32x4*)((BUF) + (lrow + 64 * i) * 144 + lkc * 2) = S[i]; \
                          _Pragma("unroll") for (int i = 0; i < 2; ++i) *(u32x4*)((BUF) + 36864 + (lrow + 64 * i) * 144 + lkc * 2) = S[4 + i]; }
#define G_COMPUTE(BUF) { _Pragma("unroll") for (int ks = 0; ks < 4; ++ks) { const int ko = (ks * 16 + h * 8) * 2; \
        const bf16x8 a0 = *(const bf16x8*)((BUF) + (wm * 64 + r) * 144 + ko); const bf16x8 a1 = *(const bf16x8*)((BUF) + (wm * 64 + 32 + r) * 144 + ko); \
        const bf16x8 b0 = *(const bf16x8*)((BUF) + 36864 + (wn * 64 + r) * 144 + ko); const bf16x8 b1 = *(const bf16x8*)((BUF) + 36864 + (wn * 64 + 32 + r) * 144 + ko); \
        acc[0][0] = MFMA32(a0, b0, acc[0][0]); acc[0][1] = MFMA32(a0, b1, acc[0][1]); acc[1][0] = MFMA32(a1, b0, acc[1][0]); acc[1][1] = MFMA32(a1, b1, acc[1][1]); } }
      G_LOAD(s0, 0) G_STORE(s0, lds)
      G_LOAD(s0, 64) G_LOAD(s1, 128)
      __syncthreads();
      for (int kt = 0; kt < 16; kt += 2) {
        G_COMPUTE(lds)
        G_STORE(s0, lds + 55296)
        if (kt + 3 < 16) G_LOAD(s0, (kt + 3) * 64)
        __syncthreads();
        G_COMPUTE(lds + 55296)
        if (kt + 2 < 16) G_STORE(s1, lds)
        if (kt + 4 < 16) G_LOAD(s1, (kt + 4) * 64)
        __syncthreads();
      }
#undef G_LOAD
#undef G_STORE
#undef G_COMPUTE
    } else {
    u32x4 raw[4], raw2[4], rb[2];
    const int arow = 4 * (tid >> 3), akc = (tid & 7) * 8;
#pragma unroll
    for (int hf = 0; hf < 2; ++hf) { ld_half<SHIFT>(A, m0 + arow + 2 * hf, akc, Lmask, raw); st_half<SHIFT>(lds + (arow + 2 * hf) * 144 + akc * 2, raw, smu, akc); }
#pragma unroll
    for (int i = 0; i < 2; ++i) { const int id = tid + 512 * i; rb[i] = *(const u32x4*)(Bt + (size_t)(n0 + (id >> 3)) * 1024 + (id & 7) * 8); }
#pragma unroll
    for (int i = 0; i < 2; ++i) { const int id = tid + 512 * i; *(u32x4*)(lds + 36864 + (id >> 3) * 144 + (id & 7) * 16) = rb[i]; }
    __syncthreads();
    for (int kt = 0; kt < 16; ++kt) {
      unsigned char* cur = lds + (kt & 1) * 55296; unsigned char* nxt = lds + ((kt + 1) & 1) * 55296;
      const int k1 = (kt + 1) * 64;
      if (kt < 15) {
        ld_half<SHIFT>(A, m0 + arow, k1 + akc, Lmask, raw);
        ld_half<SHIFT>(A, m0 + arow + 2, k1 + akc, Lmask, raw2);
#pragma unroll
        for (int i = 0; i < 2; ++i) { const int id = tid + 512 * i; rb[i] = *(const u32x4*)(Bt + (size_t)(n0 + (id >> 3)) * 1024 + k1 + (id & 7) * 8); }
      }
#pragma unroll
      for (int ks = 0; ks < 4; ++ks) {
        const int ko = (ks * 16 + h * 8) * 2;
        const bf16x8 a0 = *(const bf16x8*)(cur + (wm * 64 + r) * 144 + ko);
        const bf16x8 a1 = *(const bf16x8*)(cur + (wm * 64 + 32 + r) * 144 + ko);
        const bf16x8 b0 = *(const bf16x8*)(cur + 36864 + (wn * 64 + r) * 144 + ko);
        const bf16x8 b1 = *(const bf16x8*)(cur + 36864 + (wn * 64 + 32 + r) * 144 + ko);
        acc[0][0] = MFMA32(a0, b0, acc[0][0]); acc[0][1] = MFMA32(a0, b1, acc[0][1]);
        acc[1][0] = MFMA32(a1, b0, acc[1][0]); acc[1][1] = MFMA32(a1, b1, acc[1][1]);
      }
      if (kt < 15) {
        st_half<SHIFT>(nxt + arow * 144 + akc * 2, raw, smu, k1 + akc);
        st_half<SHIFT>(nxt + (arow + 2) * 144 + akc * 2, raw2, smu, k1 + akc);
#pragma unroll
        for (int i = 0; i < 2; ++i) { const int id = tid + 512 * i; *(u32x4*)(nxt + 36864 + (id >> 3) * 144 + (id & 7) * 16) = rb[i]; }
      }
      __syncthreads();
    }
    }
#pragma unroll
    for (int mi = 0; mi < 2; ++mi)
#pragma unroll
      for (int ni = 0; ni < 2; ++ni)
#pragma unroll
        for (int i = 0; i < 16; ++i) {
          const int row = wm * 64 + mi * 32 + (i & 3) + 8 * (i >> 2) + 4 * h, col = wn * 64 + ni * 32 + r;
          Cs[row * 132 + col] = acc[mi][ni][i];
        }
    __syncthreads();
    if (EPI == 0) {
#pragma unroll
      for (int i = 0; i < 8; ++i) {
        const int id = tid + 512 * i, row = id >> 4, cc = (id & 15) * 8;
        float4 v0 = *(const float4*)(Cs + row * 132 + cc), v1 = *(const float4*)(Cs + row * 132 + cc + 4);
        if (rw && nt == 32) { v0.x = tanhf(v0.x); v0.y = tanhf(v0.y); v0.z = tanhf(v0.z); v0.w = tanhf(v0.w); v1.x = tanhf(v1.x); v1.y = tanhf(v1.y); v1.z = tanhf(v1.z); v1.w = tanhf(v1.w); }
        u32x4 o; o[0] = pack2(v0.x, v0.y); o[1] = pack2(v0.z, v0.w); o[2] = pack2(v1.x, v1.y); o[3] = pack2(v1.z, v1.w);
        if (rw && nt >= 32) *(u32x4*)((bf16_t*)(p.ws + WS_HID) + (size_t)(m0 + row) * 256 + (nt - 32) * 128 + cc) = o;
        else *(u32x4*)(dst + (size_t)(nt >> 3) * SLOT_ELEMS + (size_t)(m0 + row) * 1024 + (nt & 7) * 128 + cc) = o;
      }
    } else {
      const int row = tid & 255, hh = tid >> 8; const int t = m0 + row;
      float x[64];
#pragma unroll
      for (int q = 0; q < 16; ++q) { const float4 v = *(const float4*)(Cs + row * 132 + hh * 64 + 4 * q); x[4 * q] = v.x; x[4 * q + 1] = v.y; x[4 * q + 2] = v.z; x[4 * q + 3] = v.w; }
      bf16_t* slots = (bf16_t*)(p.ws + WS_SLOT);
      const int L = g ? 4096 : 256, Ltot = g ? 4352 : 256;
      const int b = g ? (t >> 12) : (t >> 8), s = t & (L - 1);
      if (nt < 10) {
        int vz = 0; asm volatile("" : "+v"(vz));
        const float* nw = (nt < 8 ? p.in[26] : p.in[27]) + vz;
        float ss = 0.f;
#pragma unroll
        for (int d = 0; d < 64; ++d) ss += x[d] * x[d];
        const float rs = rsqrtf(ss * (1.f / 64.f) + 1e-6f);
#pragma unroll
        for (int d = 0; d < 64; ++d) x[d] *= rs * nw[d];
        if (g == 0 && nt >= 8) {
          float* ck = p.out + OUT_CK + (size_t)t * 256 + ((nt - 8) * 2 + hh) * 64;
#pragma unroll
          for (int q = 0; q < 16; ++q) *(float4*)(ck + 4 * q) = make_float4(x[4 * q], x[4 * q + 1], x[4 * q + 2], x[4 * q + 3]);
        }
        if (g == 1) {
          const float2* rope = (const float2*)(p.ws + WS_ROPE);
          const int ri = s >> 6, ci = s & 63;
#pragma unroll
          for (int f = 0; f < 16; ++f) {
            const float2 cr = rope[ri * 16 + f]; const float x1 = x[f], x2 = x[16 + f];
            x[f] = x1 * cr.x - x2 * cr.y; x[16 + f] = x2 * cr.x + x1 * cr.y;
            const float2 cc = rope[ci * 16 + f]; const float y1 = x[32 + f], y2 = x[48 + f];
            x[32 + f] = y1 * cc.x - y2 * cc.y; x[48 + f] = y2 * cc.x + y1 * cc.y;
          }
        }
        bf16_t* dq = nt < 8 ? slots + 2 * SLOT_ELEMS + (size_t)t * 1024 + (nt * 2 + hh) * 64
                            : slots + 4 * SLOT_ELEMS + ((size_t)b * Ltot + s) * 256 + ((nt - 8) * 2 + hh) * 64;
#pragma unroll
        for (int q = 0; q < 8; ++q) { u32x4 o; o[0] = pack2(x[8 * q], x[8 * q + 1]); o[1] = pack2(x[8 * q + 2], x[8 * q + 3]); o[2] = pack2(x[8 * q + 4], x[8 * q + 5]); o[3] = pack2(x[8 * q + 6], x[8 * q + 7]); *(u32x4*)(dq + 8 * q) = o; }
      } else if (nt < 12) {
        const int kvh = (nt - 10) * 2 + hh;
        if (g == 0) {
          float* cv = p.out + OUT_CV + (size_t)t * 256 + kvh * 64;
#pragma unroll
          for (int q = 0; q < 16; ++q) *(float4*)(cv + 4 * q) = make_float4(x[4 * q], x[4 * q + 1], x[4 * q + 2], x[4 * q + 3]);
        }
        bf16_t* vt = slots + 4 * SLOT_ELEMS + SLOT_ELEMS / 2 + ((size_t)(b * 4 + kvh) * 64) * Ltot + s;
#pragma unroll
        for (int d = 0; d < 64; ++d) { *vt = (bf16_t)f2bf(x[d]); vt += Ltot; asm volatile("" : "+v"(vt)); }
      } else {
        bf16_t* dg = slots + 3 * SLOT_ELEMS + (size_t)t * 1024 + (nt - 12) * 128 + hh * 64;
#pragma unroll
        for (int q = 0; q < 8; ++q) { u32x4 o; o[0] = pack2(x[8 * q], x[8 * q + 1]); o[1] = pack2(x[8 * q + 2], x[8 * q + 3]); o[2] = pack2(x[8 * q + 4], x[8 * q + 5]); o[3] = pack2(x[8 * q + 6], x[8 * q + 7]); *(u32x4*)(dg + 8 * q) = o; }
      }
    }
    __syncthreads();
  }
}

DI u32x4 cat8(const u32x2 lo, const u32x2 hi) { u32x4 v; v[0] = lo[0]; v[1] = lo[1]; v[2] = hi[0]; v[3] = hi[1]; return v; }
DI void phase_scan(const P& p, int g, int jl, unsigned char* lds) {
  const int tid = otid(), lane = tid & 63, wave = tid >> 6, r = lane & 31, h = lane >> 5;
  const int L = g ? 4096 : 256, B = g ? 4 : 32, nsc = L >> 5;
  float* sR = (float*)lds; float* sW = sR + 2048; float* sKD = sW + 2048; float* sKK = sKD + 2048; float* sKKA = sKK + 2048;
  bf16_t* sHW = (bf16_t*)(lds + 40960); bf16_t* sHA = (bf16_t*)(lds + 45568);
  bf16_t* oAL = (bf16_t*)(lds + 50176); bf16_t* oRH = (bf16_t*)(lds + 54784); bf16_t* oBE = (bf16_t*)(lds + 59392); bf16_t* oGA = (bf16_t*)(lds + 64000);
  bf16_t* oBEt = (bf16_t*)(lds + 68608); bf16_t* oGAt = (bf16_t*)(lds + 73728); bf16_t* oUt = (bf16_t*)(lds + 78848); bf16_t* oZt = (bf16_t*)(lds + 83968);
  float* Bm = (float*)(lds + 89088); float* RHS = (float*)(lds + 93696); float* lamC = (float*)(lds + 101888); float* sP = (float*)(lds + 102144);
  unsigned char* frag = lds + 104192;
  const bf16_t* slots = (const bf16_t*)(p.ws + WS_SLOT);
  const bf16_t* Rg = slots + 1 * SLOT_ELEMS; const bf16_t* Kg = slots + 2 * SLOT_ELEMS; const bf16_t* Vg = slots + 3 * SLOT_ELEMS;
  const bf16_t* hid = (const bf16_t*)(p.ws + WS_HID);
  float* bon = (float*)(p.ws + WS_BON);
  const int ntasks = B * 32;
  for (int task = blockIdx.x; task < ntasks; task += gridDim.x) {
    const int z = task & 1, head = (task >> 1) & 15, b = task >> 5;
    bf16_t* Yg = (bf16_t*)(p.ws + WS_SLOT) + (z ? 0 : 5) * SLOT_ELEMS;
    const int mat = (wave >> 1) & 1, ntt = wave & 1;
    unsigned char* lfr = lds + 110336 + (wave & 3) * 4096;
    if (wave >= 4) {
      const float* W2 = (mat ? p.in[18] : p.in[15]) + (size_t)(jl * 2 + z) * 65536 + head * 64 + 32 * ntt + r;
#pragma unroll
      for (int kk = 0; kk < 4; ++kk) { u32x4 pk;
#pragma unroll
        for (int j = 0; j < 4; ++j) pk[j] = pack2(W2[(size_t)(16 * kk + 8 * h + 2 * j) * 1024], W2[(size_t)(16 * kk + 8 * h + 2 * j + 1) * 1024]);
        *(u32x4*)(lfr + (kk * 64 + lane) * 16) = pk; }
    }
    const float bias = (mat ? p.in[16] : p.in[13])[(jl * 2 + z) * 1024 + head * 64 + 32 * ntt + r];
    const float kkc = p.in[19][jl * 1024 + head * 64 + lane], kac = p.in[20][jl * 1024 + head * 64 + lane], rkc = p.in[21][jl * 1024 + head * 64 + lane];
    f32x16 st0, st1;
#pragma unroll
    for (int q = 0; q < 16; ++q) { st0[q] = 0.f; st1[q] = 0.f; }
    const size_t stbase = ((((size_t)(b * 2 + jl) * 2 + z) * 16 + head) * 64 + (32 * (wave & 1) + r)) * 64;
    if (g && wave < 2) {
#pragma unroll
      for (int gq = 0; gq < 4; ++gq) {
        const float4 s0 = *(const float4*)(p.in[2] + stbase + 8 * gq + 4 * h), s1 = *(const float4*)(p.in[2] + stbase + 32 + 8 * gq + 4 * h);
        st0[4 * gq] = s0.x; st0[4 * gq + 1] = s0.y; st0[4 * gq + 2] = s0.z; st0[4 * gq + 3] = s0.w;
        st1[4 * gq] = s1.x; st1[4 * gq + 1] = s1.y; st1[4 * gq + 2] = s1.z; st1[4 * gq + 3] = s1.w;
      }
    }
    u32x4 pre[5];
    const int ht = tid - 256;
#define SCAN_LOAD(sc_)                                                                                    \
    { const int ht2 = otid() - 256;                                                                       \
    _Pragma("unroll") for (int i = 0; i < 5; ++i) {                                                       \
      const int id = ht2 + 256 * i;                                                                       \
      const int arr = id >> 8, s = (id >> 3) & 31, cc = (id & 7) * 8;                                     \
      const int tl = z ? (L - 1 - ((sc_) * 32 + s)) : ((sc_) * 32 + s);                                   \
      const size_t tok = (size_t)b * L + tl;                                                              \
      if (arr < 3) pre[i] = *(const u32x4*)((arr == 0 ? Rg : (arr == 1 ? Kg : Vg)) + tok * 1024 + head * 64 + cc); \
      else pre[i] = *(const u32x4*)(hid + tok * 256 + (arr - 3) * 128 + z * 64 + cc);                     \
    } }
#define SOLVE_ROWS(T0, T1)                                                                                \
    _Pragma("unroll") for (int t = (T0); t < (T1); ++t) {                                                 \
      if (t + 1 < 32) {                                                                                   \
        nrhs = RHo[(t + 1) * 64];                                                                         \
        _Pragma("unroll") for (int i4 = 0; i4 < (t + 4) / 4; ++i4) { const f4v q4 = *(const __attribute__((address_space(3))) f4v*)(Bmo + (t + 1) * 36 + 4 * i4); nb8[i4] = make_float4(q4[0], q4[1], q4[2], q4[3]); } \
      }                                                                                                   \
      float a0s = crhs, a1s = 0.f, a2s = 0.f, a3s = 0.f;                                                  \
      _Pragma("unroll") for (int i4 = 0; i4 < (t + 3) / 4; ++i4) {                                        \
        a0s -= cb[i4].x * zv[4 * i4]; a1s -= cb[i4].y * zv[4 * i4 + 1]; a2s -= cb[i4].z * zv[4 * i4 + 2]; a3s -= cb[i4].w * zv[4 * i4 + 3]; } \
      zv[t] = (a0s + a1s) + (a2s + a3s);                                                                  \
      asm volatile("" : "+v"(zv[t]) :: "memory");                                                         \
      crhs = nrhs;                                                                                        \
      _Pragma("unroll") for (int i4 = 0; i4 < 8; ++i4) cb[i4] = nb8[i4];                                  \
    }
    typedef float f4v __attribute__((ext_vector_type(4)));
    if (wave >= 4) { SCAN_LOAD(0) }
    for (int sc = -1; sc < nsc; ++sc) {
      const bool st_on = sc >= 0, hl_on = sc + 1 < nsc;
      bf16_t* oUc = (bf16_t*)(lds + ((sc & 1) ? 126720 : 78848));
      bf16_t* oUn = (bf16_t*)(lds + ((sc & 1) ? 78848 : 126720));
      f32x16 y0;
      const int vloc = 32 * (wave & 1) + r;
      if (st_on) {
      {
        const int k = lane, tq = wave;
        float wq[4];
#pragma unroll
        for (int j = 0; j < 4; ++j) wq[j] = sW[(4 * tq + j) * 64 + k];
        sP[tq * 64 + k] = (wq[0] * wq[1]) * (wq[2] * wq[3]);
        __syncthreads();
        float lam = 1.f;
#pragma unroll
        for (int q = 0; q < 7; ++q) { const float pq = sP[q * 64 + k]; lam *= (q < tq) ? pq : 1.f; }
        u32x2 bt, gt; float nb[4], gg[4];
#pragma unroll
        for (int j = 0; j < 4; ++j) {
          const int t = 4 * tq + j;
          const float lamp = lam; lam = lamp * wq[j];
          const float inv = __builtin_amdgcn_rcpf(lam);
          const float al = lamp * sKK[t * 64 + k], be = sKKA[t * 64 + k] * inv, ga = sKD[t * 64 + k] * inv, rh = lam * sR[t * 64 + k];
          oAL[t * 72 + k] = (bf16_t)f2bf(al); oRH[t * 72 + k] = (bf16_t)f2bf(rh); oBE[t * 72 + k] = (bf16_t)f2bf(be); oGA[t * 72 + k] = (bf16_t)f2bf(ga);
          nb[j] = -be; gg[j] = ga;
        }
        bt[0] = pack2(nb[0], nb[1]); bt[1] = pack2(nb[2], nb[3]); gt[0] = pack2(gg[0], gg[1]); gt[1] = pack2(gg[2], gg[3]);
        *(u32x2*)(oBEt + k * 40 + 4 * tq) = bt; *(u32x2*)(oGAt + k * 40 + 4 * tq) = gt;
        if (tq == 7) lamC[k] = lam;
      }
      __syncthreads();
      {
      const int tid = otid(), lane = tid & 63, wave = tid >> 6, r = lane & 31, h = lane >> 5; (void)r; (void)h; (void)lane; (void)wave;
      if (wave < 4) {
        const bf16_t* As = (wave & 1) ? oGA : oBE; const bf16_t* Bs = (wave < 2) ? oAL : oRH;
        f32x16 x;
#pragma unroll
        for (int q = 0; q < 16; ++q) x[q] = 0.f;
#pragma unroll
        for (int s = 0; s < 4; ++s) { const bf16x8 a = *(const bf16x8*)(As + r * 72 + 16 * s + 8 * h); const bf16x8 bb = *(const bf16x8*)(Bs + r * 72 + 16 * s + 8 * h); x = MFMA32(a, bb, x); }
#pragma unroll
        for (int q = 0; q < 16; ++q) { const int i = (q & 3) + 8 * (q >> 2) + 4 * h; const bool keep = (wave < 2) ? (i < r) : (i <= r); x[q] = keep ? x[q] : 0.f; }
        if (wave == 0) {
#pragma unroll
          for (int gq = 0; gq < 4; ++gq) *(float4*)(Bm + r * 36 + 8 * gq + 4 * h) = make_float4(x[4 * gq], x[4 * gq + 1], x[4 * gq + 2], x[4 * gq + 3]);
        } else {
          const float sg = (wave == 2) ? -1.f : 1.f;
#pragma unroll
          for (int s = 0; s < 2; ++s) { u32x4 pk;
#pragma unroll
            for (int j = 0; j < 4; ++j) pk[j] = pack2(sg * x[8 * s + 2 * j], sg * x[8 * s + 2 * j + 1]);
            *(u32x4*)(frag + (((wave - 1) * 2 + s) * 64 + lane) * 16) = pk; }
        }
      }
      }
      __syncthreads();
      if (wave < 2) {
        f32x16 a0;
#pragma unroll
        for (int q = 0; q < 16; ++q) { a0[q] = 0.f; y0[q] = 0.f; }
#pragma unroll
        for (int kb = 0; kb < 2; ++kb)
#pragma unroll
          for (int s = 0; s < 2; ++s) {
            u32x4 pk;
#pragma unroll
            for (int j = 0; j < 4; ++j) pk[j] = kb ? pack2(st1[8 * s + 2 * j], st1[8 * s + 2 * j + 1]) : pack2(st0[8 * s + 2 * j], st0[8 * s + 2 * j + 1]);
            const bf16x8 sf = __builtin_bit_cast(bf16x8, pk);
            const int ko = 32 * kb + 16 * s + 4 * h;
            const u32x4 aa = cat8(*(const u32x2*)(oAL + r * 72 + ko), *(const u32x2*)(oAL + r * 72 + ko + 8));
            const u32x4 ar = cat8(*(const u32x2*)(oRH + r * 72 + ko), *(const u32x2*)(oRH + r * 72 + ko + 8));
            a0 = MFMA32(__builtin_bit_cast(bf16x8, aa), sf, a0);
            y0 = MFMA32(__builtin_bit_cast(bf16x8, ar), sf, y0);
          }
#pragma unroll
        for (int s = 0; s < 2; ++s) {
          const bf16x8 fg = *(const bf16x8*)(frag + ((0 * 2 + s) * 64 + lane) * 16);
          const bf16x8 fpg = *(const bf16x8*)(frag + ((2 * 2 + s) * 64 + lane) * 16);
          const u32x4 ub = cat8(*(const u32x2*)(oUc + vloc * 40 + 16 * s + 4 * h), *(const u32x2*)(oUc + vloc * 40 + 16 * s + 4 * h + 8));
          a0 = MFMA32(fg, __builtin_bit_cast(bf16x8, ub), a0);
          y0 = MFMA32(fpg, __builtin_bit_cast(bf16x8, ub), y0);
        }
#pragma unroll
        for (int q = 0; q < 16; ++q) RHS[((q & 3) + 8 * (q >> 2) + 4 * h) * 64 + vloc] = a0[q];
        float* park = (float*)(lds + 131840) + wave * 3072 + lane * 4;
#pragma unroll
        for (int gq = 0; gq < 4; ++gq) {
          *(float4*)(park + gq * 256) = make_float4(st0[4 * gq], st0[4 * gq + 1], st0[4 * gq + 2], st0[4 * gq + 3]);
          *(float4*)(park + 1024 + gq * 256) = make_float4(st1[4 * gq], st1[4 * gq + 1], st1[4 * gq + 2], st1[4 * gq + 3]);
          *(float4*)(park + 2048 + gq * 256) = make_float4(y0[4 * gq], y0[4 * gq + 1], y0[4 * gq + 2], y0[4 * gq + 3]);
        }
      }
      }
      float zv[32]; float4 cb[8], nb8[8]; float crhs = 0.f, nrhs = 0.f;
#pragma unroll
      for (int t = 0; t < 32; ++t) zv[t] = 0.f;
#pragma unroll
      for (int q = 0; q < 8; ++q) { cb[q] = make_float4(0.f, 0.f, 0.f, 0.f); nb8[q] = make_float4(0.f, 0.f, 0.f, 0.f); }
      const __attribute__((address_space(3))) float* Bmo = (const __attribute__((address_space(3))) float*)(unsigned)(unsigned long long)Bm;
      const __attribute__((address_space(3))) float* RHo = (const __attribute__((address_space(3))) float*)(unsigned)(unsigned long long)(RHS + vloc);
      asm volatile("" : "+v"(Bmo), "+v"(RHo));
      if (wave < 2 && st_on) crhs = RHo[0];
      if (wave < 2) { if (st_on) { SOLVE_ROWS(0, 10) } }
      else if (wave >= 4 && hl_on) {
#pragma unroll
        for (int i = 0; i < 5; ++i) {
          const int id = ht + 256 * i; const int arr = id >> 8, s = (id >> 3) & 31, cc = (id & 7) * 8;
          const u32x4 u = pre[i];
          if (arr < 2) { float* d = (arr == 0 ? sR : sKD) + s * 64 + cc;
            *(float4*)d = make_float4(bflo(u[0]), bfhi(u[0]), bflo(u[1]), bfhi(u[1])); *(float4*)(d + 4) = make_float4(bflo(u[2]), bfhi(u[2]), bflo(u[3]), bfhi(u[3])); }
          else if (arr == 2) {
#pragma unroll
            for (int j = 0; j < 4; ++j) { oUn[(cc + 2 * j) * 40 + s] = (bf16_t)(u[j] & 0xffffu); oUn[(cc + 2 * j + 1) * 40 + s] = (bf16_t)(u[j] >> 16); }
          } else *(u32x4*)((arr == 3 ? sHW : sHA) + s * 72 + cc) = u;
        }
        if (sc + 2 < nsc) { SCAN_LOAD(sc + 2) }
      }
      __syncthreads();
      if (wave < 2) { if (st_on) { SOLVE_ROWS(10, 21) } }
      else if (wave >= 4 && hl_on) {
        f32x16 acc;
#pragma unroll
        for (int i = 0; i < 16; ++i) acc[i] = 0.f;
        const bf16_t* sH = mat ? sHA : sHW;
#pragma unroll
        for (int kk = 0; kk < 4; ++kk) { const bf16x8 a = *(const bf16x8*)(sH + r * 72 + 16 * kk + 8 * h); const bf16x8 bw = *(const bf16x8*)(lfr + (kk * 64 + lane) * 16); acc = MFMA32(a, bw, acc); }
#pragma unroll
        for (int i = 0; i < 16; ++i) {
          const int srow = (i & 3) + 8 * (i >> 2) + 4 * h, c = 32 * ntt + r;
          const float xv = acc[i] + bias;
          const float sg = __builtin_amdgcn_rcpf(1.f + __expf(-xv));
          if (mat == 0) sW[srow * 64 + c] = __expf(-0.60653065971263342f * sg);
          else sKKA[srow * 64 + c] = sg;
        }
      }
      __syncthreads();
      if (wave < 2) { if (st_on) {
        SOLVE_ROWS(21, 32)
        if (h == 0) {
#pragma unroll
          for (int q = 0; q < 4; ++q) { u32x4 o;
#pragma unroll
            for (int j = 0; j < 4; ++j) o[j] = pack2(zv[8 * q + 2 * j], zv[8 * q + 2 * j + 1]);
            *(u32x4*)(oZt + vloc * 40 + 8 * q) = o; }
        } } }
      else if (wave >= 4 && hl_on) {
#pragma unroll
        for (int i = 0; i < 8; ++i) {
          const int s = (wave - 4) + 4 * i; const int c = lane;
          const float kraw = sKD[s * 64 + c], a = sKKA[s * 64 + c], rr = sR[s * 64 + c];
          const float pk = kraw * kkc; const float ss = wave_sum(pk * pk);
          const float kk = pk * rsqrtf(fmaxf(ss, 1e-24f));
          const float kd = kraw * (1.f + (a - 1.f) * kac);
          const float bs = wave_sum(rr * kd * rkc);
          sKD[s * 64 + c] = kd; sKK[s * 64 + c] = kk; sKKA[s * 64 + c] = kk * a;
          if (c == 0) { const int tl = z ? (L - 1 - ((sc + 1) * 32 + s)) : ((sc + 1) * 32 + s); bon[(((size_t)b * L + tl) * 16 + head) * 2 + z] = bs; }
        }
      }
      __syncthreads();
      if (st_on) {
      {
      const int tid = otid(), lane = tid & 63, wave = tid >> 6, r = lane & 31, h = lane >> 5; (void)r; (void)h; (void)lane; (void)wave;
      if (wave < 2) {
        { const float* park = (const float*)(lds + 131840) + wave * 3072 + lane * 4;
#pragma unroll
          for (int gq = 0; gq < 4; ++gq) {
            const float4 a = *(const float4*)(park + gq * 256), bq = *(const float4*)(park + 1024 + gq * 256), cq = *(const float4*)(park + 2048 + gq * 256);
            st0[4 * gq] = a.x; st0[4 * gq + 1] = a.y; st0[4 * gq + 2] = a.z; st0[4 * gq + 3] = a.w;
            st1[4 * gq] = bq.x; st1[4 * gq + 1] = bq.y; st1[4 * gq + 2] = bq.z; st1[4 * gq + 3] = bq.w;
            y0[4 * gq] = cq.x; y0[4 * gq + 1] = cq.y; y0[4 * gq + 2] = cq.z; y0[4 * gq + 3] = cq.w;
          } }
#pragma unroll
        for (int s = 0; s < 2; ++s) {
          const bf16x8 ub = *(const bf16x8*)(oUc + vloc * 40 + 16 * s + 8 * h), zb = *(const bf16x8*)(oZt + vloc * 40 + 16 * s + 8 * h);
          const bf16x8 g0 = *(const bf16x8*)(oGAt + r * 40 + 16 * s + 8 * h), g1 = *(const bf16x8*)(oGAt + (32 + r) * 40 + 16 * s + 8 * h);
          const bf16x8 b0 = *(const bf16x8*)(oBEt + r * 40 + 16 * s + 8 * h), b1 = *(const bf16x8*)(oBEt + (32 + r) * 40 + 16 * s + 8 * h);
          st0 = MFMA32(g0, ub, st0); st0 = MFMA32(b0, zb, st0);
          st1 = MFMA32(g1, ub, st1); st1 = MFMA32(b1, zb, st1);
          const bf16x8 fpb = *(const bf16x8*)(frag + ((1 * 2 + s) * 64 + lane) * 16);
          const u32x4 z8 = cat8(*(const u32x2*)(oZt + vloc * 40 + 16 * s + 4 * h), *(const u32x2*)(oZt + vloc * 40 + 16 * s + 4 * h + 8));
          y0 = MFMA32(fpb, __builtin_bit_cast(bf16x8, z8), y0);
        }
#pragma unroll
        for (int gq = 0; gq < 4; ++gq) {
          const float4 l0 = *(const float4*)(lamC + 8 * gq + 4 * h), l1 = *(const float4*)(lamC + 32 + 8 * gq + 4 * h);
          st0[4 * gq] *= l0.x; st0[4 * gq + 1] *= l0.y; st0[4 * gq + 2] *= l0.z; st0[4 * gq + 3] *= l0.w;
          st1[4 * gq] *= l1.x; st1[4 * gq + 1] *= l1.y; st1[4 * gq + 2] *= l1.z; st1[4 * gq + 3] *= l1.w;
        }
#pragma unroll
        for (int q = 0; q < 16; ++q) {
          const int t = (q & 3) + 8 * (q >> 2) + 4 * h; const int tl = z ? (L - 1 - (sc * 32 + t)) : (sc * 32 + t);
          Yg[((size_t)b * L + tl) * 1024 + head * 64 + vloc] = (bf16_t)f2bf(y0[q]);
        }
      }
      }
      __syncthreads();
      }
    }
#undef SOLVE_ROWS
#undef SCAN_LOAD
    if (g == 0 && wave < 2) {
#pragma unroll
      for (int gq = 0; gq < 4; ++gq) {
        *(float4*)(p.out + OUT_ST + stbase + 8 * gq + 4 * h) = make_float4(st0[4 * gq], st0[4 * gq + 1], st0[4 * gq + 2], st0[4 * gq + 3]);
        *(float4*)(p.out + OUT_ST + stbase + 32 + 8 * gq + 4 * h) = make_float4(st1[4 * gq], st1[4 * gq + 1], st1[4 * gq + 2], st1[4 * gq + 3]);
      }
    }
    __syncthreads();
  }
}

DI void phase_rwkv_combine(const P& p, int g, int jl) {
  const int T = g ? 16384 : 8192;
  const int tid = otid(); const int lane = tid & 63, wave = tid >> 6;
  bf16_t* slots = (bf16_t*)(p.ws + WS_SLOT);
  const float* bon = (const float*)(p.ws + WS_BON);
  for (int t = blockIdx.x * 8 + wave; t < T; t += gridDim.x * 8) {
    const size_t o = (size_t)t * 1024 + 16 * lane; const int head = lane >> 2;
    float y[16], v[16], gg[16];
#pragma unroll
    for (int q = 0; q < 2; ++q) {
      const u32x4 a = *(const u32x4*)(slots + 5 * SLOT_ELEMS + o + 8 * q), bq = *(const u32x4*)(slots + 0 * SLOT_ELEMS + o + 8 * q);
      const u32x4 vq = *(const u32x4*)(slots + 3 * SLOT_ELEMS + o + 8 * q), gq = *(const u32x4*)(slots + 4 * SLOT_ELEMS + o + 8 * q);
#pragma unroll
      for (int i = 0; i < 4; ++i) { y[8 * q + 2 * i] = bflo(a[i]) + bflo(bq[i]); y[8 * q + 2 * i + 1] = bfhi(a[i]) + bfhi(bq[i]);
        v[8 * q + 2 * i] = bflo(vq[i]); v[8 * q + 2 * i + 1] = bfhi(vq[i]); gg[8 * q + 2 * i] = bflo(gq[i]); gg[8 * q + 2 * i + 1] = bfhi(gq[i]); }
    }
    float s = 0.f;
#pragma unroll
    for (int i = 0; i < 16; ++i) s += y[i];
    const float mean = quad_sum(s) * (1.f / 64.f);
    float vs = 0.f;
#pragma unroll
    for (int i = 0; i < 16; ++i) { const float d = y[i] - mean; vs += d * d; }
    const float rstd = rsqrtf(quad_sum(vs) * (1.f / 64.f) + 64e-5f);
    const float bs = bon[((size_t)t * 16 + head) * 2] + bon[((size_t)t * 16 + head) * 2 + 1];
    const float* gw = p.in[22] + jl * 1024 + 16 * lane; const float* gb = p.in[23] + jl * 1024 + 16 * lane;
    float ov[16];
#pragma unroll
    for (int i = 0; i < 16; ++i) ov[i] = ((y[i] - mean) * rstd * gw[i] + gb[i] + bs * v[i]) * silu(gg[i]);
#pragma unroll
    for (int q = 0; q < 2; ++q) { u32x4 w; w[0] = pack2(ov[8 * q], ov[8 * q + 1]); w[1] = pack2(ov[8 * q + 2], ov[8 * q + 3]); w[2] = pack2(ov[8 * q + 4], ov[8 * q + 5]); w[3] = pack2(ov[8 * q + 6], ov[8 * q + 7]);
      *(u32x4*)(slots + 4 * SLOT_ELEMS + o + 8 * q) = w; }
  }
}

DI void phase_conv(const P& p, int g) {
  const int T = g ? 16384 : 8192, Lmask = g ? 4095 : 255;
  bf16_t* slots = (bf16_t*)(p.ws + WS_SLOT);
  const bf16_t* BG = slots + 2 * SLOT_ELEMS; const bf16_t* CG = slots + 3 * SLOT_ELEMS; const bf16_t* U = slots + 4 * SLOT_ELEMS; const bf16_t* G = slots + 5 * SLOT_ELEMS;
  bf16_t* O = slots;
  for (int e = blockIdx.x * NT + otid(); e < T * 128; e += gridDim.x * NT) {
    const int t = e >> 7, c = (e & 127) * 8; const size_t o = (size_t)t * 1024 + c; const int tl = t & Lmask;
    const u32x4 zz = {0u, 0u, 0u, 0u};
    const u32x4 c1 = *(const u32x4*)(CG + o), u1 = *(const u32x4*)(U + o);
    const u32x4 c0 = tl != 0 ? *(const u32x4*)(CG + o - 1024) : zz, u0 = tl != 0 ? *(const u32x4*)(U + o - 1024) : zz;
    const u32x4 c2 = tl != Lmask ? *(const u32x4*)(CG + o + 1024) : zz, u2 = tl != Lmask ? *(const u32x4*)(U + o + 1024) : zz;
    const u32x4 bg = *(const u32x4*)(BG + o), gg = *(const u32x4*)(G + o);
    const float* cw = p.in[30]; const float* cb = p.in[31];
    u32x4 w;
#pragma unroll
    for (int i = 0; i < 4; ++i) {
      const int ch = c + 2 * i;
      const float lo = bflo(bg[i]) * (cw[ch] * bflo(c0[i]) * bflo(u0[i]) + cw[1024 + ch] * bflo(c1[i]) * bflo(u1[i]) + cw[2048 + ch] * bflo(c2[i]) * bflo(u2[i]) + cb[ch]) * silu(bflo(gg[i]));
      const float hi = bfhi(bg[i]) * (cw[ch + 1] * bfhi(c0[i]) * bfhi(u0[i]) + cw[1024 + ch + 1] * bfhi(c1[i]) * bfhi(u1[i]) + cw[2048 + ch + 1] * bfhi(c2[i]) * bfhi(u2[i]) + cb[ch + 1]) * silu(bfhi(gg[i]));
      w[i] = pack2(lo, hi);
    }
    *(u32x4*)(O + o) = w;
  }
}

DI void phase_attn(const P& p, int g, unsigned char* lds) {
  const int tid = otid(), lane = tid & 63, wave = tid >> 6, r = lane & 31, h = lane >> 5;
  const int L = g ? 4096 : 256, Ltot = g ? 4352 : 256, B = g ? 4 : 32;
  const int nq = L >> 6, ntasks = B * 4 * nq, nkt = Ltot >> 6;
  bf16_t* slots = (bf16_t*)(p.ws + WS_SLOT);
  bf16_t* Q = slots + 2 * SLOT_ELEMS; const bf16_t* G = slots + 3 * SLOT_ELEMS;
  const bf16_t* Kb = slots + 4 * SLOT_ELEMS; const bf16_t* Vt = Kb + SLOT_ELEMS / 2;
  const float SC = 0.125f * 1.4426950408889634f;
  for (int task = blockIdx.x; task < ntasks; task += gridDim.x) {
    const int qt = task % nq, kvh = (task / nq) & 3, b = task / (nq * 4);
    const int head = kvh * 4 + (wave >> 1); const int q0 = qt * 64 + (wave & 1) * 32;
    const size_t tok = (size_t)b * L + q0 + r;
    bf16x8 qf[4];
#pragma unroll
    for (int ds = 0; ds < 4; ++ds) qf[ds] = *(const bf16x8*)(Q + tok * 1024 + head * 64 + ds * 16 + h * 8);
    float m = -1e30f, lsum = 0.f;
    f32x16 O0, O1;
#pragma unroll
    for (int i = 0; i < 16; ++i) { O0[i] = 0.f; O1[i] = 0.f; }
    const int lrow = tid >> 3, lc = (tid & 7) * 8;
    const bf16_t* gK = Kb + ((size_t)b * Ltot + lrow) * 256 + kvh * 64 + lc;
    const bf16_t* gV = Vt + ((size_t)(b * 4 + kvh) * 64 + lrow) * Ltot + lc;
    u32x4 rk = *(const u32x4*)gK, rv = *(const u32x4*)gV;
    *(u32x4*)(lds + lrow * 144 + lc * 2) = rk; *(u32x4*)(lds + 9216 + lrow * 144 + lc * 2) = rv;
    __syncthreads();
    for (int kt = 0; kt < nkt; ++kt) {
      const unsigned char* cur = lds + (kt & 1) * 18432; unsigned char* nxt = lds + ((kt + 1) & 1) * 18432;
      if (kt + 1 < nkt) { rk = *(const u32x4*)(gK + (size_t)(kt + 1) * 64 * 256); rv = *(const u32x4*)(gV + (kt + 1) * 64); }
      f32x16 s0, s1;
#pragma unroll
      for (int i = 0; i < 16; ++i) { s0[i] = 0.f; s1[i] = 0.f; }
#pragma unroll
      for (int ds = 0; ds < 4; ++ds) {
        const bf16x8 a0 = *(const bf16x8*)(cur + r * 144 + (ds * 16 + h * 8) * 2);
        const bf16x8 a1 = *(const bf16x8*)(cur + (32 + r) * 144 + (ds * 16 + h * 8) * 2);
        s0 = MFMA32(a0, qf[ds], s0); s1 = MFMA32(a1, qf[ds], s1);
      }
      float tmax = s0[0];
#pragma unroll
      for (int i = 1; i < 16; ++i) tmax = fmaxf(tmax, s0[i]);
#pragma unroll
      for (int i = 0; i < 16; ++i) tmax = fmaxf(tmax, s1[i]);
      tmax = fmaxf(tmax, __shfl_xor(tmax, 32));
      const float mnew = fmaxf(m, tmax * SC);
      const float alpha = __builtin_amdgcn_exp2f(m - mnew);
      float ps = 0.f;
#pragma unroll
      for (int i = 0; i < 16; ++i) { s0[i] = __builtin_amdgcn_exp2f(s0[i] * SC - mnew); s1[i] = __builtin_amdgcn_exp2f(s1[i] * SC - mnew); ps += s0[i] + s1[i]; }
      lsum = lsum * alpha + ps; m = mnew;
#pragma unroll
      for (int i = 0; i < 16; ++i) { O0[i] *= alpha; O1[i] *= alpha; }
      const unsigned char* vs = cur + 9216;
#pragma unroll
      for (int kb = 0; kb < 2; ++kb)
#pragma unroll
        for (int s = 0; s < 2; ++s) {
          u32x4 pk;
#pragma unroll
          for (int j = 0; j < 4; ++j) pk[j] = kb ? pack2(s1[8 * s + 2 * j], s1[8 * s + 2 * j + 1]) : pack2(s0[8 * s + 2 * j], s0[8 * s + 2 * j + 1]);
          const bf16x8 pf = __builtin_bit_cast(bf16x8, pk);
          const int ko = (32 * kb + 16 * s + 4 * h) * 2;
          { const u32x2 lo = *(const u32x2*)(vs + r * 144 + ko), hi = *(const u32x2*)(vs + r * 144 + ko + 16);
            u32x4 av; av[0] = lo[0]; av[1] = lo[1]; av[2] = hi[0]; av[3] = hi[1];
            O0 = MFMA32(__builtin_bit_cast(bf16x8, av), pf, O0); }
          { const u32x2 lo = *(const u32x2*)(vs + (32 + r) * 144 + ko), hi = *(const u32x2*)(vs + (32 + r) * 144 + ko + 16);
            u32x4 av; av[0] = lo[0]; av[1] = lo[1]; av[2] = hi[0]; av[3] = hi[1];
            O1 = MFMA32(__builtin_bit_cast(bf16x8, av), pf, O1); }
        }
      if (kt + 1 < nkt) { *(u32x4*)(nxt + lrow * 144 + lc * 2) = rk; *(u32x4*)(nxt + 9216 + lrow * 144 + lc * 2) = rv; }
      __syncthreads();
    }
    lsum += __shfl_xor(lsum, 32);
    const float inv = 1.f / lsum;
#pragma unroll
    for (int db = 0; db < 2; ++db)
#pragma unroll
      for (int i4 = 0; i4 < 4; ++i4) {
        const size_t o = tok * 1024 + head * 64 + 32 * db + 8 * i4 + 4 * h;
        const u32x2 gq = *(const u32x2*)(G + o);
        const float v0 = (db ? O1[4 * i4] : O0[4 * i4]) * inv, v1 = (db ? O1[4 * i4 + 1] : O0[4 * i4 + 1]) * inv;
        const float v2 = (db ? O1[4 * i4 + 2] : O0[4 * i4 + 2]) * inv, v3 = (db ? O1[4 * i4 + 3] : O0[4 * i4 + 3]) * inv;
        u32x2 w; w[0] = pack2(v0 * silu(bflo(gq[0])), v1 * silu(bfhi(gq[0]))); w[1] = pack2(v2 * silu(bflo(gq[1])), v3 * silu(bfhi(gq[1])));
        *(u32x2*)(slots + 5 * SLOT_ELEMS + o) = w;
      }
  }
}


#define XB_TMO      128
#define XB_XCNT(j)  (256  + 64 * (j))
#define XB_XSUB(j)  (1280 + 64 * (j))
#define XB_XGEN(j)  (2304 + 64 * (j))
#define XB_TOP      3328
#define XB_TOPGEN   3392
#define XCD_BAR_WORDS 3456
#define XB_SPIN_CAP (1u << 22)
#define LAS __attribute__((address_space(3)))
DI unsigned xb_ld(unsigned* p) { return __hip_atomic_load(p, __ATOMIC_RELAXED, __HIP_MEMORY_SCOPE_AGENT); }
DI unsigned xb_add(unsigned* p, unsigned v) { return __hip_atomic_fetch_add(p, v, __ATOMIC_RELAXED, __HIP_MEMORY_SCOPE_AGENT); }
DI unsigned xb_xcc_id() { return (unsigned)__builtin_amdgcn_s_getreg((3 << 11) | 20) & 0xFu; }
#define XB_SPIN(cond, bar) do { unsigned _sp = 0; while (cond) { __builtin_amdgcn_s_sleep(1); \
    if ((++_sp & 255u) == 0u) { if (xb_ld(&(bar)[XB_TMO])) break; if (_sp > XB_SPIN_CAP) { atomicAdd(&(bar)[XB_TMO], 1u); break; } } } } while (0)
struct XcdBarrier { unsigned* bar; unsigned x; volatile LAS unsigned* st; };
DI XcdBarrier xcd_barrier_post(unsigned* bar, volatile LAS unsigned* st) {
  XcdBarrier b; b.bar = bar; b.x = xb_xcc_id(); b.st = st;
  if (threadIdx.x == 0) (void)xb_add(&bar[XB_XCNT(b.x)], 1u);
  return b;
}
DI void xcd_barrier_complete(unsigned* bar, unsigned x, unsigned& nloc, unsigned& nx) {
  const unsigned G = gridDim.x * gridDim.y * gridDim.z;
  unsigned sum, cnt, mine, sp = 0u;
  for (;;) {
    sum = 0u; cnt = 0u; mine = 0u;
#pragma unroll
    for (unsigned j = 0; j < 16; ++j) { const unsigned c = xb_ld(&bar[XB_XCNT(j)]); sum += c; cnt += (c > 0u) ? 1u : 0u; mine = (j == x) ? c : mine; }
    if (sum == G) break;
    __builtin_amdgcn_s_sleep(1);
    if ((++sp & 255u) == 0u) { if (xb_ld(&bar[XB_TMO])) break; if (sp > XB_SPIN_CAP) { atomicAdd(&bar[XB_TMO], 1u); break; } }
  }
  nloc = mine > 0u ? mine : 1u; nx = cnt > 0u ? cnt : 1u;
}
DI void xcd_barrier(const XcdBarrier& b) {
  asm volatile("s_waitcnt vmcnt(0)" ::: "memory");
  __syncthreads();
  if (threadIdx.x == 0) {
    unsigned* bar = b.bar;
    __builtin_amdgcn_s_waitcnt(0);
    unsigned nloc = b.st[0], nx = b.st[1];
    if (nloc == 0u) { xcd_barrier_complete(bar, b.x, nloc, nx); b.st[0] = nloc; b.st[1] = nx; }
    const unsigned old = xb_add(&bar[XB_XSUB(b.x)], 1u);
    const unsigned gen = old / nloc;
    if (old + 1u == (gen + 1u) * nloc) {
      __builtin_amdgcn_fence(__ATOMIC_RELEASE, "agent");
      asm volatile("s_waitcnt vmcnt(0)" ::: "memory");
      const unsigned og = xb_add(&bar[XB_TOP], 1u);
      const unsigned tg = og / nx;
      if (og + 1u == (tg + 1u) * nx) xb_add(&bar[XB_TOPGEN], 1u);
      else XB_SPIN(xb_ld(&bar[XB_TOPGEN]) == tg, bar);
      __builtin_amdgcn_fence(__ATOMIC_ACQUIRE, "agent");
      xb_add(&bar[XB_XGEN(b.x)], 1u);
      asm volatile("s_waitcnt vmcnt(0)" ::: "memory");
    } else {
      XB_SPIN(xb_ld(&bar[XB_XGEN(b.x)]) == gen, bar);
      __builtin_amdgcn_fence(__ATOMIC_ACQUIRE, "agent");
      asm volatile("s_waitcnt vmcnt(0)" ::: "memory");
    }
  }
  __syncthreads();
}

#define GPTR(T, x) ((T*)(__attribute__((address_space(1))) T*)(x))
__global__ void __launch_bounds__(NT) mega(P p) {
  extern __shared__ __attribute__((aligned(16))) unsigned char lds[];
  cg::grid_group grid = cg::this_grid();
  volatile LAS unsigned* st = (volatile LAS unsigned*)(lds + LDS_BYTES - 16);
  if (threadIdx.x < 4) st[threadIdx.x] = 0u;
  __syncthreads();
  const XcdBarrier xbar = xcd_barrier_post((unsigned*)(p.ws + WS_BAR), st);
  phase0(p, lds);
  grid.sync();
  const P& p0 = p;
  for (int step = 0; step < 50; ++step) {
    const int g = step / 25, rem = step - g * 25, layer = rem / 5, sub = rem - layer * 5;
    const int kind = layer % 3, jl = layer / 3;
    const int T = g ? 16384 : 8192, Lmask = g ? 4095 : 255;
    int op = -1;
    if (layer == 4) op = (sub == 0) ? 0 : -1;
    else if (sub == 0) op = 0;
    else if (kind == 0) op = sub == 1 ? 1 : (sub == 2 ? 2 : (sub == 3 ? 3 : 4));
    else if (kind == 1) op = sub == 1 ? 5 : (sub == 2 ? 6 : (sub == 3 ? 4 : -1));
    else op = sub == 1 ? 4 : (sub == 2 ? 7 : (sub == 3 ? 4 : -1));
    if (op < 0) continue;
    P p = p0;
    { size_t zo_ = 0; asm volatile("" : "+s"(zo_)); p.ws = p0.ws + zo_; p.out = p0.out + zo_; }
    bf16_t* slots = (bf16_t*)(p.ws + WS_SLOT);
    const bf16_t* W = (const bf16_t*)(p.ws + WS_W);
    if (op == 0) {
      const float* xin = p.in[g]; float* xout = p.out + (g ? OUT_YS : OUT_YP);
      phase_norm(p, g, layer - 1, layer < 4 ? layer : -1, layer <= 1 ? xin : xout, xout, slots + SLOT_ELEMS, slots);
      if (kind == 1 && g == 1 && layer < 4) phase_cache_copy(p);
    } else if (op == 1) {
      for (int rep = 0; rep < opq(REP_GEMM); ++rep) phase_gemm<1, 0>(p, g, slots, W + (size_t)(RW_IN0 + jl * RW_STRIDE) * 1024, T, 4352, p.in[11] + jl * 6144, Lmask, slots + SLOT_ELEMS, 1, lds);
    } else if (op == 2) {
      for (int rep = 0; rep < opq(REP_SCAN); ++rep) phase_scan(p, g, jl, lds);
    } else if (op == 3) {
      phase_rwkv_combine(p, g, jl);
    } else if (op == 4) {
      const bf16_t* A; const bf16_t* Bt; int N; bf16_t* dst;
      if (sub == 1) { A = slots; Bt = W + (size_t)CV_IN * 1024; N = 4096; dst = slots + 2 * SLOT_ELEMS; }
      else {
        N = 1024; dst = slots + SLOT_ELEMS;
        if (kind == 0) { A = slots + 4 * SLOT_ELEMS; Bt = W + (size_t)(RW_OUT0 + jl * RW_STRIDE) * 1024; }
        else if (kind == 1) { A = slots + 5 * SLOT_ELEMS; Bt = W + (size_t)AT_OUT * 1024; }
        else { A = slots; Bt = W + (size_t)CV_OUT * 1024; }
      }
      for (int rep = 0; rep < opq(REP_GEMM); ++rep) phase_gemm<0, 0>(p, g, A, Bt, T, N, nullptr, 0, dst, 0, lds);
    } else if (op == 5) {
      for (int rep = 0; rep < opq(REP_GEMM); ++rep) phase_gemm<0, 1>(p, g, slots, W + (size_t)AT_IN * 1024, T, 2560, nullptr, 0, nullptr, 0, lds);
    } else if (op == 6) {
      for (int rep = 0; rep < opq(REP_ATTN); ++rep) phase_attn(p, g, lds);
    } else {
      phase_conv(p, g);
    }
    if (!(g == 1 && layer == 4)) for (int rep = 0; rep < opq(REP_SYNC); ++rep) xcd_barrier(xbar);
  }
}

extern "C" void kernel_launch(void* const* d_in, const int* in_sizes, int n_in, void* d_out, int out_size, void* d_ws, size_t ws_size, hipStream_t stream) {
  static int grid_blocks = 0;
  if (!grid_blocks) {
    int dev = 0, cus = 0, per_cu = 0;
    hipGetDevice(&dev);
    hipDeviceGetAttribute(&cus, hipDeviceAttributeMultiprocessorCount, dev);
    hipFuncSetAttribute((const void*)mega, hipFuncAttributeMaxDynamicSharedMemorySize, LDS_BYTES);
    hipOccupancyMaxActiveBlocksPerMultiprocessor(&per_cu, (const void*)mega, NT, LDS_BYTES);
    if (per_cu < 1) per_cu = 1;
    if (per_cu > 1) per_cu = 1;
    grid_blocks = cus * per_cu;
    if (ws_size < WS_SLOT + 6 * SLOT_ELEMS * 2) fprintf(stderr, "workspace too small: %zu\n", ws_size);
  }
  (void)hipMemsetAsync((unsigned char*)d_ws + WS_BAR, 0, XCD_BAR_WORDS * sizeof(unsigned), stream);
  P p{};
  for (int i = 0; i < 33; ++i) p.in[i] = (const float*)d_in[i];
  p.out = (float*)d_out; p.ws = (unsigned char*)d_ws;
  void* args[] = {&p};
  hipError_t e = hipLaunchCooperativeKernel((const void*)mega, dim3(grid_blocks), dim3(NT), args, LDS_BYTES, stream);
  if (e != hipSuccess) fprintf(stderr, "cooperative launch failed: %s (grid %d)\n", hipGetErrorString(e), grid_blocks);
}
```

```cpp
#include <hip/hip_runtime.h>
#include <hip/hip_cooperative_groups.h>
#include <cstdio>
namespace cg = cooperative_groups;

typedef unsigned short bf16_t;
using bf16x8 = __attribute__((ext_vector_type(8))) short;
using f32x16 = __attribute__((ext_vector_type(16))) float;
using u32x4 = __attribute__((ext_vector_type(4))) unsigned;
using u32x2 = __attribute__((ext_vector_type(2))) unsigned;

#define NT 512
#ifndef REP_GEMM
#define REP_GEMM 1
#endif
#ifndef REP_SCAN
#define REP_SCAN 1
#endif
#ifndef REP_ATTN
#define REP_ATTN 1
#endif
#ifndef REP_SYNC
#define REP_SYNC 1
#endif
#define DI __device__ __forceinline__
#define MFMA32(a, b, c) __builtin_amdgcn_mfma_f32_32x32x16_bf16((a), (b), (c), 0, 0, 0)

struct P { const float* in[33]; float* out; unsigned char* ws; };

constexpr size_t WS_ADA = 0;
constexpr size_t WS_ROPE = 262144;
constexpr size_t WS_BON = 327680;
constexpr size_t WS_HID = WS_BON + 2097152;
constexpr size_t WS_W = WS_HID + 8388608;
constexpr size_t WS_SLOT = WS_W + 39845888;
constexpr size_t SLOT_ELEMS = (size_t)16384 * 1024;
constexpr int RW_IN0 = 0, RW_OUT0 = 4352, RW_STRIDE = 5376, AT_IN = 10752, AT_OUT = 13312, CV_IN = 14336, CV_OUT = 18432;
constexpr size_t OUT_YP = 0, OUT_YS = 8388608, OUT_ST = 25165824, OUT_CK = 33554432, OUT_CV = 35651584;
constexpr int LDS_BYTES = 156416 + 16;
constexpr size_t WS_BAR = 278528;

typedef __bf16 bf16x2_t __attribute__((ext_vector_type(2)));
typedef float f32x2_t __attribute__((ext_vector_type(2)));
DI unsigned pack2(float a, float b) { f32x2_t v = {a, b}; return __builtin_bit_cast(unsigned, __builtin_convertvector(v, bf16x2_t)); }
DI unsigned f2bf(float x) { return (unsigned)__builtin_bit_cast(unsigned short, (__bf16)x); }
DI float bflo(unsigned u) { return __uint_as_float(u << 16); }
DI float bfhi(unsigned u) { return __uint_as_float(u & 0xffff0000u); }
DI float bf1(bf16_t u) { return __uint_as_float(((unsigned)u) << 16); }

template <int CTRL> DI float dppf(float v) { return __int_as_float(__builtin_amdgcn_update_dpp(0, __float_as_int(v), CTRL, 0xF, 0xF, true)); }
DI float reduce16(float v) { v += dppf<0xB1>(v); v += dppf<0x4E>(v); v += dppf<0x141>(v); v += dppf<0x140>(v); return v; }
DI float rdl(float v, int l) { return __int_as_float(__builtin_amdgcn_readlane(__float_as_int(v), l)); }
DI float wave_sum(float v) { v = reduce16(v); return (rdl(v, 0) + rdl(v, 16)) + (rdl(v, 32) + rdl(v, 48)); }
DI float quad_sum(float v) { v += dppf<0xB1>(v); v += dppf<0x4E>(v); return v; }
DI float silu(float x) { return x / (1.f + __expf(-x)); }
DI int opq(int v) { asm volatile("" : "+s"(v)); return v; }
DI int otid() { int t = threadIdx.x; asm volatile("" : "+v"(t)); return t; }

DI void conv_tiles(const float* __restrict__ src, int N, bf16_t* __restrict__ dst, float* lds) {
  const int tid = otid();
  const int tilesN = N >> 6, ntiles = 16 * tilesN;
  for (int tile = blockIdx.x; tile < ntiles; tile += gridDim.x) {
    const int kt = tile / tilesN, nt = tile - kt * tilesN, k0 = kt * 64, n0 = nt * 64;
#pragma unroll
    for (int i = 0; i < 8; ++i) { const int k = (tid >> 6) + 8 * i, n = tid & 63; lds[k * 65 + n] = src[(size_t)(k0 + k) * N + n0 + n]; }
    __syncthreads();
    { const int n = tid >> 3, kc = (tid & 7) * 8; u32x4 o;
#pragma unroll
      for (int j = 0; j < 4; ++j) o[j] = pack2(lds[(kc + 2 * j) * 65 + n], lds[(kc + 2 * j + 1) * 65 + n]);
      *(u32x4*)(dst + (size_t)(n0 + n) * 1024 + k0 + kc) = o; }
    __syncthreads();
  }
}

DI void phase0(const P& p, unsigned char* ldsb) {
  float* lds = (float*)ldsb;
  const int tid = otid();
  bf16_t* W = (bf16_t*)(p.ws + WS_W);
#pragma unroll 1
  for (int e = 0; e < opq(22); ++e) {
    const float* src; int N, drow;
    if (e < 18) {
      const int j = e / 9, q = e - j * 9;
      if (q < 4) { src = p.in[12] + (size_t)(j * 4 + q) * 1048576; N = 1024; drow = RW_IN0 + j * RW_STRIDE + q * 1024; }
      else if (q < 6) { src = p.in[14] + (size_t)(j * 2 + q - 4) * 65536; N = 64; drow = RW_IN0 + j * RW_STRIDE + 4096 + (q - 4) * 64; }
      else if (q < 8) { src = p.in[17] + (size_t)(j * 2 + q - 6) * 65536; N = 64; drow = RW_IN0 + j * RW_STRIDE + 4224 + (q - 6) * 64; }
      else { src = p.in[24] + (size_t)j * 1048576; N = 1024; drow = RW_OUT0 + j * RW_STRIDE; }
    } else if (e == 18) { src = p.in[25]; N = 2560; drow = AT_IN; }
    else if (e == 19) { src = p.in[28]; N = 1024; drow = AT_OUT; }
    else if (e == 20) { src = p.in[29]; N = 4096; drow = CV_IN; }
    else { src = p.in[32]; N = 1024; drow = CV_OUT; }
    conv_tiles(src, N, W + (size_t)drow * 1024, lds);
  }
  {
    float* scond = lds;
    float* red = lds + 5120;
    for (int e = tid; e < 5120; e += NT) { const int cnd = e >> 10, k = e & 1023; const float cv = cnd == 0 ? p.in[6][k] : p.in[5][(cnd - 1) * 1024 + k]; scond[e] = silu(cv); }
    __syncthreads();
    float* ada = (float*)(p.ws + WS_ADA);
    for (int task = blockIdx.x; task < 192; task += gridDim.x) {
      const int layer = task / 48, n0 = (task % 48) * 64, c = tid & 63, kg = tid >> 6;
      float a0 = 0.f, a1 = 0.f, a2 = 0.f, a3 = 0.f, a4 = 0.f;
      const float* wp = p.in[9] + ((size_t)layer * 1024 + kg * 128) * 3072 + n0 + c;
#pragma unroll 8
      for (int k = 0; k < 128; ++k) { const float w = wp[(size_t)k * 3072]; const int kk = kg * 128 + k;
        a0 += scond[kk] * w; a1 += scond[1024 + kk] * w; a2 += scond[2048 + kk] * w; a3 += scond[3072 + kk] * w; a4 += scond[4096 + kk] * w; }
      red[(kg * 5 + 0) * 64 + c] = a0; red[(kg * 5 + 1) * 64 + c] = a1; red[(kg * 5 + 2) * 64 + c] = a2; red[(kg * 5 + 3) * 64 + c] = a3; red[(kg * 5 + 4) * 64 + c] = a4;
      __syncthreads();
      if (tid < 320) { const int cnd = tid >> 6; float s = p.in[10][layer * 3072 + n0 + c];
#pragma unroll
        for (int q = 0; q < 8; ++q) s += red[(q * 5 + cnd) * 64 + c];
        ada[(cnd * 4 + layer) * 3072 + n0 + c] = s; }
      __syncthreads();
    }
  }
  if (blockIdx.x == gridDim.x - 1) {
    float* rope = (float*)(p.ws + WS_ROPE);
    for (int e = tid; e < 1024; e += NT) {
      const int pos = e >> 4, f = e & 15;
      double inv = 1.0; for (int q = 0; q < f; ++q) inv *= 0.5623413251903491;
      double ang = (double)pos * inv;
      const double twopi = 6.283185307179586476925286766559;
      double n = __builtin_rint(ang / twopi); double rr = ang - n * twopi;
      double r2 = rr * rr, sn = 0.0, cs = 0.0, ts = rr, tc = 1.0;
      for (int q = 0; q < 16; ++q) { cs += tc; sn += ts; tc = -tc * r2 / (double)((2 * q + 1) * (2 * q + 2)); ts = -ts * r2 / (double)((2 * q + 2) * (2 * q + 3)); }
      rope[e * 2] = (float)cs; rope[e * 2 + 1] = (float)sn;
    }
  }
}

DI void phase_norm(const P& p, int g, int lpost, int lpre, const float* __restrict__ xsrc, float* __restrict__ xdst,
                   const bf16_t* __restrict__ Mb, bf16_t* __restrict__ H) {
  const int T = g ? 16384 : 8192;
  const int tid = otid(); const int lane = tid & 63, wave = tid >> 6;
  const float* ada = (const float*)(p.ws + WS_ADA);
  for (int t = blockIdx.x * 8 + wave; t < T; t += gridDim.x * 8) {
    const int cond = g ? 1 + (t >> 12) : 0;
    float4 x[4];
#pragma unroll
    for (int i = 0; i < 4; ++i) x[i] = *(const float4*)(xsrc + (size_t)t * 1024 + 256 * i + 4 * lane);
    if (lpost >= 0) {
      float m[16]; float ss = 0.f;
#pragma unroll
      for (int i = 0; i < 4; ++i) { const u32x2 u = *(const u32x2*)(Mb + (size_t)t * 1024 + 256 * i + 4 * lane);
        m[4 * i] = bflo(u[0]); m[4 * i + 1] = bfhi(u[0]); m[4 * i + 2] = bflo(u[1]); m[4 * i + 3] = bfhi(u[1]); }
#pragma unroll
      for (int i = 0; i < 16; ++i) ss += m[i] * m[i];
      ss = wave_sum(ss);
      const float rs = rsqrtf(ss * (1.f / 1024.f) + 1e-6f);
      const float* gate = ada + (cond * 4 + lpost) * 3072 + 2048;
      const float* wpo = p.in[8] + lpost * 1024;
#pragma unroll
      for (int i = 0; i < 4; ++i) { const int c = 256 * i + 4 * lane; const float4 gt = *(const float4*)(gate + c); const float4 wv = *(const float4*)(wpo + c);
        x[i].x += gt.x * (m[4 * i] * rs * wv.x); x[i].y += gt.y * (m[4 * i + 1] * rs * wv.y); x[i].z += gt.z * (m[4 * i + 2] * rs * wv.z); x[i].w += gt.w * (m[4 * i + 3] * rs * wv.w);
        *(float4*)(xdst + (size_t)t * 1024 + c) = x[i]; }
    }
    if (lpre >= 0) {
      float ss = 0.f;
#pragma unroll
      for (int i = 0; i < 4; ++i) ss += x[i].x * x[i].x + x[i].y * x[i].y + x[i].z * x[i].z + x[i].w * x[i].w;
      ss = wave_sum(ss);
      const float rs = rsqrtf(ss * (1.f / 1024.f) + 1e-6f);
      const float* sh = ada + (cond * 4 + lpre) * 3072; const float* sc = sh + 1024; const float* wpr = p.in[7] + lpre * 1024;
#pragma unroll
      for (int i = 0; i < 4; ++i) { const int c = 256 * i + 4 * lane; const float4 s4 = *(const float4*)(sh + c); const float4 c4 = *(const float4*)(sc + c); const float4 wv = *(const float4*)(wpr + c);
        u32x2 o; o[0] = pack2(x[i].x * rs * wv.x * (1.f + c4.x) + s4.x, x[i].y * rs * wv.y * (1.f + c4.y) + s4.y);
        o[1] = pack2(x[i].z * rs * wv.z * (1.f + c4.z) + s4.z, x[i].w * rs * wv.w * (1.f + c4.w) + s4.w);
        *(u32x2*)(H + (size_t)t * 1024 + c) = o; }
    }
  }
}

DI void phase_cache_copy(const P& p) {
  bf16_t* Kb = (bf16_t*)(p.ws + WS_SLOT) + 4 * SLOT_ELEMS; bf16_t* Vt = Kb + SLOT_ELEMS / 2;
  for (int e = blockIdx.x * NT + otid(); e < 262144; e += gridDim.x * NT) {
    const int c = e & 255, pp = (e >> 8) & 255, b = e >> 16; const int kvh = c >> 6, d = c & 63;
    Kb[((size_t)b * 4352 + 4096 + pp) * 256 + c] = (bf16_t)f2bf(p.in[3][e]);
    Vt[((size_t)(b * 4 + kvh) * 64 + d) * 4352 + 4096 + pp] = (bf16_t)f2bf(p.in[4][e]);
  }
}

template <int SHIFT> DI void ld_half(const bf16_t* __restrict__ A, int t, int k, int Lmask, u32x4 (&raw)[4]) {
  raw[1] = *(const u32x4*)(A + (size_t)t * 1024 + k);
  raw[2] = *(const u32x4*)(A + (size_t)(t + 1) * 1024 + k);
  if (SHIFT) {
    raw[0] = (u32x4){0u, 0u, 0u, 0u}; raw[3] = (u32x4){0u, 0u, 0u, 0u};
    if ((t & Lmask) != 0) raw[0] = *(const u32x4*)(A + (size_t)(t - 1) * 1024 + k);
    if (((t + 1) & Lmask) != Lmask) raw[3] = *(const u32x4*)(A + (size_t)(t + 2) * 1024 + k);
  }
}
DI u32x4 mix3(const u32x4& c, const u32x4& pz, const u32x4& nz, const float* smu, int k) {
  const float4 m0 = *(const float4*)(smu + k), m1 = *(const float4*)(smu + k + 4);
  const float mu[8] = {m0.x, m0.y, m0.z, m0.w, m1.x, m1.y, m1.z, m1.w};
  u32x4 o;
#pragma unroll
  for (int i = 0; i < 4; ++i) {
    const float h0 = bflo(c[i]), h1 = bfhi(c[i]);
    const float x0 = h0 + (0.5f * (bflo(pz[i]) + bflo(nz[i])) - h0) * mu[2 * i];
    const float x1 = h1 + (0.5f * (bfhi(pz[i]) + bfhi(nz[i])) - h1) * mu[2 * i + 1];
    o[i] = pack2(x0, x1);
  }
  return o;
}
DI int swz(int row, int c) { return row * 128 + ((c ^ ((row >> 1) & 7)) << 4); }
template <int SHIFT> DI void st_half(unsigned char* base, int row, int c, const u32x4 (&raw)[4], const float* smu, int k) {
  if (!SHIFT) { *(u32x4*)(base + swz(row, c)) = raw[1]; *(u32x4*)(base + swz(row + 1, c)) = raw[2]; }
  else { *(u32x4*)(base + swz(row, c)) = mix3(raw[1], raw[0], raw[2], smu, k); *(u32x4*)(base + swz(row + 1, c)) = mix3(raw[2], raw[1], raw[3], smu, k); }
}

template <int SHIFT, int EPI>
DI void phase_gemm(const P& p, int g, const bf16_t* __restrict__ A, const bf16_t* __restrict__ Bt, int M, int N,
                   const float* __restrict__ mu, int Lmask, bf16_t* __restrict__ dst, int rw, unsigned char* lds) {
  const int tid = otid(), lane = tid & 63, wave = tid >> 6;
  const int wm = wave >> 1, wn = wave & 1, r = lane & 31, h = lane >> 5;
  const int ntn = N >> 7, ntiles = ntn * (M >> 8);
  float* Cs = (float*)lds;
  float* smu = (float*)(lds + 110592);
  for (int tile = blockIdx.x; tile < ntiles; tile += gridDim.x) {
    const int mt = tile / ntn, nt = tile - mt * ntn; const int m0 = mt * 256, n0 = nt * 128;
    f32x16 acc[2][2];
#pragma unroll
    for (int a = 0; a < 2; ++a)
#pragma unroll
      for (int b = 0; b < 2; ++b)
#pragma unroll
        for (int i = 0; i < 16; ++i) acc[a][b][i] = 0.f;
    if (SHIFT) {
      const float* mup = mu + (nt < 32 ? (nt >> 3) : (nt == 32 ? 4 : 5)) * 1024;
      smu[tid] = mup[tid]; smu[tid + 512] = mup[tid + 512];
      __syncthreads();
    }
    if (!SHIFT) {
      u32x4 s0[6], s1[6];
      const int lrow = tid >> 3, lkc = (tid & 7) * 8;
#define G_LOAD(S, K0)  { _Pragma("unroll") for (int i = 0; i < 4; ++i) S[i] = *(const u32x4*)(A + (size_t)(m0 + lrow + 64 * i) * 1024 + (K0) + lkc); \
                         _Pragma("unroll") for (int i = 0; i < 2; ++i) S[4 + i] = *(const u32x4*)(Bt + (size_t)(n0 + lrow + 64 * i) * 1024 + (K0) + lkc); }
#define G_STORE(S, BUF) { _Pragma("unroll") for (int i = 0; i < 4; ++i) *(u32x4*)((BUF) + swz(lrow + 64 * i, tid & 7)) = S[i]; \
                          _Pragma("unroll") for (int i = 0; i < 2; ++i) *(u32x4*)((BUF) + 32768 + swz(lrow + 64 * i, tid & 7)) = S[4 + i]; }
#define G_COMPUTE(BUF) { _Pragma("unroll") for (int ks = 0; ks < 4; ++ks) { const int kc_ = ks * 2 + h; \
        const bf16x8 a0 = *(const bf16x8*)((BUF) + swz(wm * 64 + r, kc_)); const bf16x8 a1 = *(const bf16x8*)((BUF) + swz(wm * 64 + 32 + r, kc_)); \
        const bf16x8 b0 = *(const bf16x8*)((BUF) + 32768 + swz(wn * 64 + r, kc_)); const bf16x8 b1 = *(const bf16x8*)((BUF) + 32768 + swz(wn * 64 + 32 + r, kc_)); \
        acc[0][0] = MFMA32(a0, b0, acc[0][0]); acc[0][1] = MFMA32(a0, b1, acc[0][1]); acc[1][0] = MFMA32(a1, b0, acc[1][0]); acc[1][1] = MFMA32(a1, b1, acc[1][1]); } }
      G_LOAD(s0, 0) G_STORE(s0, lds)
      G_LOAD(s0, 64) G_LOAD(s1, 128)
      __syncthreads();
      for (int kt = 0; kt < 16; kt += 2) {
        G_COMPUTE(lds)
        G_STORE(s0, lds + 49152)
        if (kt + 3 < 16) G_LOAD(s0, (kt + 3) * 64)
        __syncthreads();
        G_COMPUTE(lds + 49152)
        if (kt + 2 < 16) G_STORE(s1, lds)
        if (kt + 4 < 16) G_LOAD(s1, (kt + 4) * 64)
        __syncthreads();
      }
#undef G_LOAD
#undef G_STORE
#undef G_COMPUTE
    } else {
    u32x4 raw[4], raw2[4], rb[2];
    const int arow = 4 * (tid >> 3), akc = (tid & 7) * 8;
#pragma unroll
    for (int hf = 0; hf < 2; ++hf) { ld_half<SHIFT>(A, m0 + arow + 2 * hf, akc, Lmask, raw); st_half<SHIFT>(lds, arow + 2 * hf, tid & 7, raw, smu, akc); }
#pragma unroll
    for (int i = 0; i < 2; ++i) { const int id = tid + 512 * i; rb[i] = *(const u32x4*)(Bt + (size_t)(n0 + (id >> 3)) * 1024 + (id & 7) * 8); }
#pragma unroll
    for (int i = 0; i < 2; ++i) { const int id = tid + 512 * i; *(u32x4*)(lds + 32768 + swz(id >> 3, id & 7)) = rb[i]; }
    __syncthreads();
    for (int kt = 0; kt < 16; ++kt) {
      unsigned char* cur = lds + (kt & 1) * 49152; unsigned char* nxt = lds + ((kt + 1) & 1) * 49152;
      const int k1 = (kt + 1) * 64;
      if (kt < 15) {
        ld_half<SHIFT>(A, m0 + arow, k1 + akc, Lmask, raw);
        ld_half<SHIFT>(A, m0 + arow + 2, k1 + akc, Lmask, raw2);
#pragma unroll
        for (int i = 0; i < 2; ++i) { const int id = tid + 512 * i; rb[i] = *(const u32x4*)(Bt + (size_t)(n0 + (id >> 3)) * 1024 + k1 + (id & 7) * 8); }
      }
#pragma unroll
      for (int ks = 0; ks < 4; ++ks) {
        const int kc_ = ks * 2 + h;
        const bf16x8 a0 = *(const bf16x8*)(cur + swz(wm * 64 + r, kc_));
        const bf16x8 a1 = *(const bf16x8*)(cur + swz(wm * 64 + 32 + r, kc_));
        const bf16x8 b0 = *(const bf16x8*)(cur + 32768 + swz(wn * 64 + r, kc_));
        const bf16x8 b1 = *(const bf16x8*)(cur + 32768 + swz(wn * 64 + 32 + r, kc_));
        acc[0][0] = MFMA32(a0, b0, acc[0][0]); acc[0][1] = MFMA32(a0, b1, acc[0][1]);
        acc[1][0] = MFMA32(a1, b0, acc[1][0]); acc[1][1] = MFMA32(a1, b1, acc[1][1]);
      }
      if (kt < 15) {
        st_half<SHIFT>(nxt, arow, tid & 7, raw, smu, k1 + akc);
        st_half<SHIFT>(nxt, arow + 2, tid & 7, raw2, smu, k1 + akc);
#pragma unroll
        for (int i = 0; i < 2; ++i) { const int id = tid + 512 * i; *(u32x4*)(nxt + 32768 + swz(id >> 3, id & 7)) = rb[i]; }
      }
      __syncthreads();
    }
    }
#pragma unroll
    for (int mi = 0; mi < 2; ++mi)
#pragma unroll
      for (int ni = 0; ni < 2; ++ni)
#pragma unroll
        for (int i = 0; i < 16; ++i) {
          const int row = wm * 64 + mi * 32 + (i & 3) + 8 * (i >> 2) + 4 * h, col = wn * 64 + ni * 32 + r;
          Cs[row * 132 + col] = acc[mi][ni][i];
        }
    __syncthreads();
    if (EPI == 0) {
#pragma unroll
      for (int i = 0; i < 8; ++i) {
        const int id = tid + 512 * i, row = id >> 4, cc = (id & 15) * 8;
        float4 v0 = *(const float4*)(Cs + row * 132 + cc), v1 = *(const float4*)(Cs + row * 132 + cc + 4);
        if (rw && nt == 32) { v0.x = tanhf(v0.x); v0.y = tanhf(v0.y); v0.z = tanhf(v0.z); v0.w = tanhf(v0.w); v1.x = tanhf(v1.x); v1.y = tanhf(v1.y); v1.z = tanhf(v1.z); v1.w = tanhf(v1.w); }
        u32x4 o; o[0] = pack2(v0.x, v0.y); o[1] = pack2(v0.z, v0.w); o[2] = pack2(v1.x, v1.y); o[3] = pack2(v1.z, v1.w);
        if (rw && nt >= 32) *(u32x4*)((bf16_t*)(p.ws + WS_HID) + (size_t)(m0 + row) * 256 + (nt - 32) * 128 + cc) = o;
        else *(u32x4*)(dst + (size_t)(nt >> 3) * SLOT_ELEMS + (size_t)(m0 + row) * 1024 + (nt & 7) * 128 + cc) = o;
      }
    } else {
      const int row = tid & 255, hh = tid >> 8; const int t = m0 + row;
      float x[64];
#pragma unroll
      for (int q = 0; q < 16; ++q) { const float4 v = *(const float4*)(Cs + row * 132 + hh * 64 + 4 * q); x[4 * q] = v.x; x[4 * q + 1] = v.y; x[4 * q + 2] = v.z; x[4 * q + 3] = v.w; }
      bf16_t* slots = (bf16_t*)(p.ws + WS_SLOT);
      const int L = g ? 4096 : 256, Ltot = g ? 4352 : 256;
      const int b = g ? (t >> 12) : (t >> 8), s = t & (L - 1);
      if (nt < 10) {
        int vz = 0; asm volatile("" : "+v"(vz));
        const float* nw = (nt < 8 ? p.in[26] : p.in[27]) + vz;
        float ss = 0.f;
#pragma unroll
        for (int d = 0; d < 64; ++d) ss += x[d] * x[d];
        const float rs = rsqrtf(ss * (1.f / 64.f) + 1e-6f);
#pragma unroll
        for (int d = 0; d < 64; ++d) x[d] *= rs * nw[d];
        if (g == 0 && nt >= 8) {
          float* ck = p.out + OUT_CK + (size_t)t * 256 + ((nt - 8) * 2 + hh) * 64;
#pragma unroll
          for (int q = 0; q < 16; ++q) *(float4*)(ck + 4 * q) = make_float4(x[4 * q], x[4 * q + 1], x[4 * q + 2], x[4 * q + 3]);
        }
        if (g == 1) {
          const float2* rope = (const float2*)(p.ws + WS_ROPE);
          const int ri = s >> 6, ci = s & 63;
#pragma unroll
          for (int f = 0; f < 16; ++f) {
            const float2 cr = rope[ri * 16 + f]; const float x1 = x[f], x2 = x[16 + f];
            x[f] = x1 * cr.x - x2 * cr.y; x[16 + f] = x2 * cr.x + x1 * cr.y;
            const float2 cc = rope[ci * 16 + f]; const float y1 = x[32 + f], y2 = x[48 + f];
            x[32 + f] = y1 * cc.x - y2 * cc.y; x[48 + f] = y2 * cc.x + y1 * cc.y;
          }
        }
        bf16_t* dq = nt < 8 ? slots + 2 * SLOT_ELEMS + (size_t)t * 1024 + (nt * 2 + hh) * 64
                            : slots + 4 * SLOT_ELEMS + ((size_t)b * Ltot + s) * 256 + ((nt - 8) * 2 + hh) * 64;
#pragma unroll
        for (int q = 0; q < 8; ++q) { u32x4 o; o[0] = pack2(x[8 * q], x[8 * q + 1]); o[1] = pack2(x[8 * q + 2], x[8 * q + 3]); o[2] = pack2(x[8 * q + 4], x[8 * q + 5]); o[3] = pack2(x[8 * q + 6], x[8 * q + 7]); *(u32x4*)(dq + 8 * q) = o; }
      } else if (nt < 12) {
        const int kvh = (nt - 10) * 2 + hh;
        if (g == 0) {
          float* cv = p.out + OUT_CV + (size_t)t * 256 + kvh * 64;
#pragma unroll
          for (int q = 0; q < 16; ++q) *(float4*)(cv + 4 * q) = make_float4(x[4 * q], x[4 * q + 1], x[4 * q + 2], x[4 * q + 3]);
        }
        bf16_t* vt = slots + 4 * SLOT_ELEMS + SLOT_ELEMS / 2 + ((size_t)(b * 4 + kvh) * 64) * Ltot + s;
        { size_t vo = 0;
#pragma unroll
        for (int d = 0; d < 64; ++d) { vt[vo] = (bf16_t)f2bf(x[d]); vo += Ltot; asm volatile("" : "+v"(vo)); } }
      } else {
        bf16_t* dg = slots + 3 * SLOT_ELEMS + (size_t)t * 1024 + (nt - 12) * 128 + hh * 64;
#pragma unroll
        for (int q = 0; q < 8; ++q) { u32x4 o; o[0] = pack2(x[8 * q], x[8 * q + 1]); o[1] = pack2(x[8 * q + 2], x[8 * q + 3]); o[2] = pack2(x[8 * q + 4], x[8 * q + 5]); o[3] = pack2(x[8 * q + 6], x[8 * q + 7]); *(u32x4*)(dg + 8 * q) = o; }
      }
    }
    __syncthreads();
  }
}

DI u32x4 cat8(const u32x2 lo, const u32x2 hi) { u32x4 v; v[0] = lo[0]; v[1] = lo[1]; v[2] = hi[0]; v[3] = hi[1]; return v; }
DI void phase_scan(const P& p, int g, int jl, unsigned char* lds) {
  const int tid = otid(), lane = tid & 63, wave = tid >> 6, r = lane & 31, h = lane >> 5;
  const int L = g ? 4096 : 256, B = g ? 4 : 32, nsc = L >> 5;
  float* sR = (float*)lds; float* sW = sR + 2048; float* sKD = sW + 2048; float* sKK = sKD + 2048; float* sKKA = sKK + 2048;
  bf16_t* sHW = (bf16_t*)(lds + 40960); bf16_t* sHA = (bf16_t*)(lds + 45568);
  bf16_t* oAL = (bf16_t*)(lds + 50176); bf16_t* oRH = (bf16_t*)(lds + 54784); bf16_t* oBE = (bf16_t*)(lds + 59392); bf16_t* oGA = (bf16_t*)(lds + 64000);
  bf16_t* oBEt = (bf16_t*)(lds + 68608); bf16_t* oGAt = (bf16_t*)(lds + 73728); bf16_t* oUt = (bf16_t*)(lds + 78848); bf16_t* oZt = (bf16_t*)(lds + 83968);
  float* Bm = (float*)(lds + 89088); float* RHS = (float*)(lds + 93696); float* lamC = (float*)(lds + 101888); float* sP = (float*)(lds + 102144);
  unsigned char* frag = lds + 104192;
  const bf16_t* slots = (const bf16_t*)(p.ws + WS_SLOT);
  const bf16_t* Rg = slots + 1 * SLOT_ELEMS; const bf16_t* Kg = slots + 2 * SLOT_ELEMS; const bf16_t* Vg = slots + 3 * SLOT_ELEMS;
  const bf16_t* hid = (const bf16_t*)(p.ws + WS_HID);
  float* bon = (float*)(p.ws + WS_BON);
  const int ntasks = B * 32;
  for (int task = blockIdx.x; task < ntasks; task += gridDim.x) {
    const int z = task & 1, head = (task >> 1) & 15, b = task >> 5;
    bf16_t* Yg = (bf16_t*)(p.ws + WS_SLOT) + (z ? 0 : 5) * SLOT_ELEMS;
    const int mat = (wave >> 1) & 1, ntt = wave & 1;
    unsigned char* lfr = lds + 110336 + (wave & 3) * 4096;
    if (wave >= 4) {
      const float* W2 = (mat ? p.in[18] : p.in[15]) + (size_t)(jl * 2 + z) * 65536 + head * 64 + 32 * ntt + r;
#pragma unroll
      for (int kk = 0; kk < 4; ++kk) { u32x4 pk;
#pragma unroll
        for (int j = 0; j < 4; ++j) pk[j] = pack2(W2[(size_t)(16 * kk + 8 * h + 2 * j) * 1024], W2[(size_t)(16 * kk + 8 * h + 2 * j + 1) * 1024]);
        *(u32x4*)(lfr + (kk * 64 + lane) * 16) = pk; }
    }
    const float bias = (mat ? p.in[16] : p.in[13])[(jl * 2 + z) * 1024 + head * 64 + 32 * ntt + r];
    const float kkc = p.in[19][jl * 1024 + head * 64 + lane], kac = p.in[20][jl * 1024 + head * 64 + lane], rkc = p.in[21][jl * 1024 + head * 64 + lane];
    f32x16 st0, st1;
#pragma unroll
    for (int q = 0; q < 16; ++q) { st0[q] = 0.f; st1[q] = 0.f; }
    const size_t stbase = ((((size_t)(b * 2 + jl) * 2 + z) * 16 + head) * 64 + (32 * (wave & 1) + r)) * 64;
    if (g && wave < 2) {
#pragma unroll
      for (int gq = 0; gq < 4; ++gq) {
        const float4 s0 = *(const float4*)(p.in[2] + stbase + 8 * gq + 4 * h), s1 = *(const float4*)(p.in[2] + stbase + 32 + 8 * gq + 4 * h);
        st0[4 * gq] = s0.x; st0[4 * gq + 1] = s0.y; st0[4 * gq + 2] = s0.z; st0[4 * gq + 3] = s0.w;
        st1[4 * gq] = s1.x; st1[4 * gq + 1] = s1.y; st1[4 * gq + 2] = s1.z; st1[4 * gq + 3] = s1.w;
      }
    }
    u32x4 pre[5];
    const int ht = tid - 256;
#define SCAN_LOAD(sc_)                                                                                    \
    { const int ht2 = otid() - 256;                                                                       \
    _Pragma("unroll") for (int i = 0; i < 5; ++i) {                                                       \
      const int id = ht2 + 256 * i;                                                                       \
      const int arr = id >> 8, s = (id >> 3) & 31, cc = (id & 7) * 8;                                     \
      const int tl = z ? (L - 1 - ((sc_) * 32 + s)) : ((sc_) * 32 + s);                                   \
      const size_t tok = (size_t)b * L + tl;                                                              \
      if (arr < 3) pre[i] = *(const u32x4*)((arr == 0 ? Rg : (arr == 1 ? Kg : Vg)) + tok * 1024 + head * 64 + cc); \
      else pre[i] = *(const u32x4*)(hid + tok * 256 + (arr - 3) * 128 + z * 64 + cc);                     \
    } }
#define SOLVE_ROWS(T0, T1)                                                                                \
    _Pragma("unroll") for (int t = (T0); t < (T1); ++t) {                                                 \
      if (t + 1 < 32) {                                                                                   \
        nrhs = RHo[(t + 1) * 64];                                                                         \
        _Pragma("unroll") for (int i4 = 0; i4 < (t + 4) / 4; ++i4) { const f4v q4 = *(const __attribute__((address_space(3))) f4v*)(Bmo + (t + 1) * 36 + 4 * i4); nb8[i4] = make_float4(q4[0], q4[1], q4[2], q4[3]); } \
      }                                                                                                   \
      float a0s = crhs, a1s = 0.f, a2s = 0.f, a3s = 0.f;                                                  \
      _Pragma("unroll") for (int i4 = 0; i4 < (t + 3) / 4; ++i4) {                                        \
        a0s -= cb[i4].x * zv[4 * i4]; a1s -= cb[i4].y * zv[4 * i4 + 1]; a2s -= cb[i4].z * zv[4 * i4 + 2]; a3s -= cb[i4].w * zv[4 * i4 + 3]; } \
      zv[t] = (a0s + a1s) + (a2s + a3s);                                                                  \
      asm volatile("" : "+v"(zv[t]) :: "memory");                                                         \
      crhs = nrhs;                                                                                        \
      _Pragma("unroll") for (int i4 = 0; i4 < 8; ++i4) cb[i4] = nb8[i4];                                  \
    }
    typedef float f4v __attribute__((ext_vector_type(4)));
    if (wave >= 4) { SCAN_LOAD(0) }
    for (int sc = -1; sc < nsc; ++sc) {
      const bool st_on = sc >= 0, hl_on = sc + 1 < nsc;
      bf16_t* oUc = (bf16_t*)(lds + ((sc & 1) ? 126720 : 78848));
      bf16_t* oUn = (bf16_t*)(lds + ((sc & 1) ? 78848 : 126720));
      f32x16 y0;
      const int vloc = 32 * (wave & 1) + r;
      if (st_on) {
      {
        const int k = lane, tq = wave;
        float wq[4];
#pragma unroll
        for (int j = 0; j < 4; ++j) wq[j] = sW[(4 * tq + j) * 64 + k];
        sP[tq * 64 + k] = (wq[0] * wq[1]) * (wq[2] * wq[3]);
        __syncthreads();
        float lam = 1.f;
#pragma unroll
        for (int q = 0; q < 7; ++q) { const float pq = sP[q * 64 + k]; lam *= (q < tq) ? pq : 1.f; }
        u32x2 bt, gt; float nb[4], gg[4];
#pragma unroll
        for (int j = 0; j < 4; ++j) {
          const int t = 4 * tq + j;
          const float lamp = lam; lam = lamp * wq[j];
          const float inv = __builtin_amdgcn_rcpf(lam);
          const float al = lamp * sKK[t * 64 + k], be = sKKA[t * 64 + k] * inv, ga = sKD[t * 64 + k] * inv, rh = lam * sR[t * 64 + k];
          oAL[t * 72 + k] = (bf16_t)f2bf(al); oRH[t * 72 + k] = (bf16_t)f2bf(rh); oBE[t * 72 + k] = (bf16_t)f2bf(be); oGA[t * 72 + k] = (bf16_t)f2bf(ga);
          nb[j] = -be; gg[j] = ga;
        }
        bt[0] = pack2(nb[0], nb[1]); bt[1] = pack2(nb[2], nb[3]); gt[0] = pack2(gg[0], gg[1]); gt[1] = pack2(gg[2], gg[3]);
        *(u32x2*)(oBEt + k * 40 + 4 * tq) = bt; *(u32x2*)(oGAt + k * 40 + 4 * tq) = gt;
        if (tq == 7) lamC[k] = lam;
      }
      __syncthreads();
      {
      const int tid = otid(), lane = tid & 63, wave = tid >> 6, r = lane & 31, h = lane >> 5; (void)r; (void)h; (void)lane; (void)wave;
      if (wave < 4) {
        const bf16_t* As = (wave & 1) ? oGA : oBE; const bf16_t* Bs = (wave < 2) ? oAL : oRH;
        f32x16 x;
#pragma unroll
        for (int q = 0; q < 16; ++q) x[q] = 0.f;
#pragma unroll
        for (int s = 0; s < 4; ++s) { const bf16x8 a = *(const bf16x8*)(As + r * 72 + 16 * s + 8 * h); const bf16x8 bb = *(const bf16x8*)(Bs + r * 72 + 16 * s + 8 * h); x = MFMA32(a, bb, x); }
#pragma unroll
        for (int q = 0; q < 16; ++q) { const int i = (q & 3) + 8 * (q >> 2) + 4 * h; const bool keep = (wave < 2) ? (i < r) : (i <= r); x[q] = keep ? x[q] : 0.f; }
        if (wave == 0) {
#pragma unroll
          for (int gq = 0; gq < 4; ++gq) *(float4*)(Bm + r * 36 + 8 * gq + 4 * h) = make_float4(x[4 * gq], x[4 * gq + 1], x[4 * gq + 2], x[4 * gq + 3]);
        } else {
          const float sg = (wave == 2) ? -1.f : 1.f;
#pragma unroll
          for (int s = 0; s < 2; ++s) { u32x4 pk;
#pragma unroll
            for (int j = 0; j < 4; ++j) pk[j] = pack2(sg * x[8 * s + 2 * j], sg * x[8 * s + 2 * j + 1]);
            *(u32x4*)(frag + (((wave - 1) * 2 + s) * 64 + lane) * 16) = pk; }
        }
      }
      }
      __syncthreads();
      if (wave < 2) {
        f32x16 a0;
#pragma unroll
        for (int q = 0; q < 16; ++q) { a0[q] = 0.f; y0[q] = 0.f; }
#pragma unroll
        for (int kb = 0; kb < 2; ++kb)
#pragma unroll
          for (int s = 0; s < 2; ++s) {
            u32x4 pk;
#pragma unroll
            for (int j = 0; j < 4; ++j) pk[j] = kb ? pack2(st1[8 * s + 2 * j], st1[8 * s + 2 * j + 1]) : pack2(st0[8 * s + 2 * j], st0[8 * s + 2 * j + 1]);
            const bf16x8 sf = __builtin_bit_cast(bf16x8, pk);
            const int ko = 32 * kb + 16 * s + 4 * h;
            const u32x4 aa = cat8(*(const u32x2*)(oAL + r * 72 + ko), *(const u32x2*)(oAL + r * 72 + ko + 8));
            const u32x4 ar = cat8(*(const u32x2*)(oRH + r * 72 + ko), *(const u32x2*)(oRH + r * 72 + ko + 8));
            a0 = MFMA32(__builtin_bit_cast(bf16x8, aa), sf, a0);
            y0 = MFMA32(__builtin_bit_cast(bf16x8, ar), sf, y0);
          }
#pragma unroll
        for (int s = 0; s < 2; ++s) {
          const bf16x8 fg = *(const bf16x8*)(frag + ((0 * 2 + s) * 64 + lane) * 16);
          const bf16x8 fpg = *(const bf16x8*)(frag + ((2 * 2 + s) * 64 + lane) * 16);
          const u32x4 ub = cat8(*(const u32x2*)(oUc + vloc * 40 + 16 * s + 4 * h), *(const u32x2*)(oUc + vloc * 40 + 16 * s + 4 * h + 8));
          a0 = MFMA32(fg, __builtin_bit_cast(bf16x8, ub), a0);
          y0 = MFMA32(fpg, __builtin_bit_cast(bf16x8, ub), y0);
        }
#pragma unroll
        for (int q = 0; q < 16; ++q) RHS[((q & 3) + 8 * (q >> 2) + 4 * h) * 64 + vloc] = a0[q];
        float* park = (float*)(lds + 131840) + wave * 3072 + lane * 4;
#pragma unroll
        for (int gq = 0; gq < 4; ++gq) {
          *(float4*)(park + gq * 256) = make_float4(st0[4 * gq], st0[4 * gq + 1], st0[4 * gq + 2], st0[4 * gq + 3]);
          *(float4*)(park + 1024 + gq * 256) = make_float4(st1[4 * gq], st1[4 * gq + 1], st1[4 * gq + 2], st1[4 * gq + 3]);
          *(float4*)(park + 2048 + gq * 256) = make_float4(y0[4 * gq], y0[4 * gq + 1], y0[4 * gq + 2], y0[4 * gq + 3]);
        }
      }
      }
      float zv[32]; float4 cb[8], nb8[8]; float crhs = 0.f, nrhs = 0.f;
#pragma unroll
      for (int t = 0; t < 32; ++t) zv[t] = 0.f;
#pragma unroll
      for (int q = 0; q < 8; ++q) { cb[q] = make_float4(0.f, 0.f, 0.f, 0.f); nb8[q] = make_float4(0.f, 0.f, 0.f, 0.f); }
      const __attribute__((address_space(3))) float* Bmo = (const __attribute__((address_space(3))) float*)(unsigned)(unsigned long long)Bm;
      const __attribute__((address_space(3))) float* RHo = (const __attribute__((address_space(3))) float*)(unsigned)(unsigned long long)(RHS + vloc);
      asm volatile("" : "+v"(Bmo), "+v"(RHo));
      if (wave < 2 && st_on) crhs = RHo[0];
      if (wave < 2) { if (st_on) { SOLVE_ROWS(0, 10) } }
      else if (wave >= 4 && hl_on) {
#pragma unroll
        for (int i = 0; i < 5; ++i) {
          const int id = ht + 256 * i; const int arr = id >> 8, s = (id >> 3) & 31, cc = (id & 7) * 8;
          const u32x4 u = pre[i];
          if (arr < 2) { float* d = (arr == 0 ? sR : sKD) + s * 64 + cc;
            *(float4*)d = make_float4(bflo(u[0]), bfhi(u[0]), bflo(u[1]), bfhi(u[1])); *(float4*)(d + 4) = make_float4(bflo(u[2]), bfhi(u[2]), bflo(u[3]), bfhi(u[3])); }
          else if (arr == 2) {
#pragma unroll
            for (int j = 0; j < 4; ++j) { oUn[(cc + 2 * j) * 40 + s] = (bf16_t)(u[j] & 0xffffu); oUn[(cc + 2 * j + 1) * 40 + s] = (bf16_t)(u[j] >> 16); }
          } else *(u32x4*)((arr == 3 ? sHW : sHA) + s * 72 + cc) = u;
        }
        if (sc + 2 < nsc) { SCAN_LOAD(sc + 2) }
      }
      __syncthreads();
      if (wave < 2) { if (st_on) { SOLVE_ROWS(10, 21) } }
      else if (wave >= 4 && hl_on) {
        f32x16 acc;
#pragma unroll
        for (int i = 0; i < 16; ++i) acc[i] = 0.f;
        const bf16_t* sH = mat ? sHA : sHW;
#pragma unroll
        for (int kk = 0; kk < 4; ++kk) { const bf16x8 a = *(const bf16x8*)(sH + r * 72 + 16 * kk + 8 * h); const bf16x8 bw = *(const bf16x8*)(lfr + (kk * 64 + lane) * 16); acc = MFMA32(a, bw, acc); }
#pragma unroll
        for (int i = 0; i < 16; ++i) {
          const int srow = (i & 3) + 8 * (i >> 2) + 4 * h, c = 32 * ntt + r;
          const float xv = acc[i] + bias;
          const float sg = __builtin_amdgcn_rcpf(1.f + __expf(-xv));
          if (mat == 0) sW[srow * 64 + c] = __expf(-0.60653065971263342f * sg);
          else sKKA[srow * 64 + c] = sg;
        }
      }
      __syncthreads();
      if (wave < 2) { if (st_on) {
        SOLVE_ROWS(21, 32)
        if (h == 0) {
#pragma unroll
          for (int q = 0; q < 4; ++q) { u32x4 o;
#pragma unroll
            for (int j = 0; j < 4; ++j) o[j] = pack2(zv[8 * q + 2 * j], zv[8 * q + 2 * j + 1]);
            *(u32x4*)(oZt + vloc * 40 + 8 * q) = o; }
        } } }
      else if (wave >= 4 && hl_on) {
#pragma unroll
        for (int i = 0; i < 8; ++i) {
          const int s = (wave - 4) + 4 * i; const int c = lane;
          const float kraw = sKD[s * 64 + c], a = sKKA[s * 64 + c], rr = sR[s * 64 + c];
          const float pk = kraw * kkc; const float ss = wave_sum(pk * pk);
          const float kk = pk * rsqrtf(fmaxf(ss, 1e-24f));
          const float kd = kraw * (1.f + (a - 1.f) * kac);
          const float bs = wave_sum(rr * kd * rkc);
          sKD[s * 64 + c] = kd; sKK[s * 64 + c] = kk; sKKA[s * 64 + c] = kk * a;
          if (c == 0) { const int tl = z ? (L - 1 - ((sc + 1) * 32 + s)) : ((sc + 1) * 32 + s); bon[(((size_t)b * L + tl) * 16 + head) * 2 + z] = bs; }
        }
      }
      __syncthreads();
      if (st_on) {
      {
      const int tid = otid(), lane = tid & 63, wave = tid >> 6, r = lane & 31, h = lane >> 5; (void)r; (void)h; (void)lane; (void)wave;
      if (wave < 2) {
        { const float* park = (const float*)(lds + 131840) + wave * 3072 + lane * 4;
#pragma unroll
          for (int gq = 0; gq < 4; ++gq) {
            const float4 a = *(const float4*)(park + gq * 256), bq = *(const float4*)(park + 1024 + gq * 256), cq = *(const float4*)(park + 2048 + gq * 256);
            st0[4 * gq] = a.x; st0[4 * gq + 1] = a.y; st0[4 * gq + 2] = a.z; st0[4 * gq + 3] = a.w;
            st1[4 * gq] = bq.x; st1[4 * gq + 1] = bq.y; st1[4 * gq + 2] = bq.z; st1[4 * gq + 3] = bq.w;
            y0[4 * gq] = cq.x; y0[4 * gq + 1] = cq.y; y0[4 * gq + 2] = cq.z; y0[4 * gq + 3] = cq.w;
          } }
#pragma unroll
        for (int s = 0; s < 2; ++s) {
          const bf16x8 ub = *(const bf16x8*)(oUc + vloc * 40 + 16 * s + 8 * h), zb = *(const bf16x8*)(oZt + vloc * 40 + 16 * s + 8 * h);
          const bf16x8 g0 = *(const bf16x8*)(oGAt + r * 40 + 16 * s + 8 * h), g1 = *(const bf16x8*)(oGAt + (32 + r) * 40 + 16 * s + 8 * h);
          const bf16x8 b0 = *(const bf16x8*)(oBEt + r * 40 + 16 * s + 8 * h), b1 = *(const bf16x8*)(oBEt + (32 + r) * 40 + 16 * s + 8 * h);
          st0 = MFMA32(g0, ub, st0); st0 = MFMA32(b0, zb, st0);
          st1 = MFMA32(g1, ub, st1); st1 = MFMA32(b1, zb, st1);
          const bf16x8 fpb = *(const bf16x8*)(frag + ((1 * 2 + s) * 64 + lane) * 16);
          const u32x4 z8 = cat8(*(const u32x2*)(oZt + vloc * 40 + 16 * s + 4 * h), *(const u32x2*)(oZt + vloc * 40 + 16 * s + 4 * h + 8));
          y0 = MFMA32(fpb, __builtin_bit_cast(bf16x8, z8), y0);
        }
#pragma unroll
        for (int gq = 0; gq < 4; ++gq) {
          const float4 l0 = *(const float4*)(lamC + 8 * gq + 4 * h), l1 = *(const float4*)(lamC + 32 + 8 * gq + 4 * h);
          st0[4 * gq] *= l0.x; st0[4 * gq + 1] *= l0.y; st0[4 * gq + 2] *= l0.z; st0[4 * gq + 3] *= l0.w;
          st1[4 * gq] *= l1.x; st1[4 * gq + 1] *= l1.y; st1[4 * gq + 2] *= l1.z; st1[4 * gq + 3] *= l1.w;
        }
#pragma unroll
        for (int q = 0; q < 16; ++q) {
          const int t = (q & 3) + 8 * (q >> 2) + 4 * h; const int tl = z ? (L - 1 - (sc * 32 + t)) : (sc * 32 + t);
          Yg[((size_t)b * L + tl) * 1024 + head * 64 + vloc] = (bf16_t)f2bf(y0[q]);
        }
      }
      }
      __syncthreads();
      }
    }
#undef SOLVE_ROWS
#undef SCAN_LOAD
    if (g == 0 && wave < 2) {
#pragma unroll
      for (int gq = 0; gq < 4; ++gq) {
        *(float4*)(p.out + OUT_ST + stbase + 8 * gq + 4 * h) = make_float4(st0[4 * gq], st0[4 * gq + 1], st0[4 * gq + 2], st0[4 * gq + 3]);
        *(float4*)(p.out + OUT_ST + stbase + 32 + 8 * gq + 4 * h) = make_float4(st1[4 * gq], st1[4 * gq + 1], st1[4 * gq + 2], st1[4 * gq + 3]);
      }
    }
    __syncthreads();
  }
}

DI void phase_rwkv_combine(const P& p, int g, int jl) {
  const int T = g ? 16384 : 8192;
  const int tid = otid(); const int lane = tid & 63, wave = tid >> 6;
  bf16_t* slots = (bf16_t*)(p.ws + WS_SLOT);
  const float* bon = (const float*)(p.ws + WS_BON);
  for (int t = blockIdx.x * 8 + wave; t < T; t += gridDim.x * 8) {
    const size_t o = (size_t)t * 1024 + 16 * lane; const int head = lane >> 2;
    float y[16], v[16], gg[16];
#pragma unroll
    for (int q = 0; q < 2; ++q) {
      const u32x4 a = *(const u32x4*)(slots + 5 * SLOT_ELEMS + o + 8 * q), bq = *(const u32x4*)(slots + 0 * SLOT_ELEMS + o + 8 * q);
      const u32x4 vq = *(const u32x4*)(slots + 3 * SLOT_ELEMS + o + 8 * q), gq = *(const u32x4*)(slots + 4 * SLOT_ELEMS + o + 8 * q);
#pragma unroll
      for (int i = 0; i < 4; ++i) { y[8 * q + 2 * i] = bflo(a[i]) + bflo(bq[i]); y[8 * q + 2 * i + 1] = bfhi(a[i]) + bfhi(bq[i]);
        v[8 * q + 2 * i] = bflo(vq[i]); v[8 * q + 2 * i + 1] = bfhi(vq[i]); gg[8 * q + 2 * i] = bflo(gq[i]); gg[8 * q + 2 * i + 1] = bfhi(gq[i]); }
    }
    float s = 0.f;
#pragma unroll
    for (int i = 0; i < 16; ++i) s += y[i];
    const float mean = quad_sum(s) * (1.f / 64.f);
    float vs = 0.f;
#pragma unroll
    for (int i = 0; i < 16; ++i) { const float d = y[i] - mean; vs += d * d; }
    const float rstd = rsqrtf(quad_sum(vs) * (1.f / 64.f) + 64e-5f);
    const float bs = bon[((size_t)t * 16 + head) * 2] + bon[((size_t)t * 16 + head) * 2 + 1];
    const float* gw = p.in[22] + jl * 1024 + 16 * lane; const float* gb = p.in[23] + jl * 1024 + 16 * lane;
    float ov[16];
#pragma unroll
    for (int i = 0; i < 16; ++i) ov[i] = ((y[i] - mean) * rstd * gw[i] + gb[i] + bs * v[i]) * silu(gg[i]);
#pragma unroll
    for (int q = 0; q < 2; ++q) { u32x4 w; w[0] = pack2(ov[8 * q], ov[8 * q + 1]); w[1] = pack2(ov[8 * q + 2], ov[8 * q + 3]); w[2] = pack2(ov[8 * q + 4], ov[8 * q + 5]); w[3] = pack2(ov[8 * q + 6], ov[8 * q + 7]);
      *(u32x4*)(slots + 4 * SLOT_ELEMS + o + 8 * q) = w; }
  }
}

DI void phase_conv(const P& p, int g) {
  const int T = g ? 16384 : 8192, Lmask = g ? 4095 : 255;
  bf16_t* slots = (bf16_t*)(p.ws + WS_SLOT);
  const bf16_t* BG = slots + 2 * SLOT_ELEMS; const bf16_t* CG = slots + 3 * SLOT_ELEMS; const bf16_t* U = slots + 4 * SLOT_ELEMS; const bf16_t* G = slots + 5 * SLOT_ELEMS;
  bf16_t* O = slots;
  for (int e = blockIdx.x * NT + otid(); e < T * 128; e += gridDim.x * NT) {
    const int t = e >> 7, c = (e & 127) * 8; const size_t o = (size_t)t * 1024 + c; const int tl = t & Lmask;
    const u32x4 zz = {0u, 0u, 0u, 0u};
    const u32x4 c1 = *(const u32x4*)(CG + o), u1 = *(const u32x4*)(U + o);
    const u32x4 c0 = tl != 0 ? *(const u32x4*)(CG + o - 1024) : zz, u0 = tl != 0 ? *(const u32x4*)(U + o - 1024) : zz;
    const u32x4 c2 = tl != Lmask ? *(const u32x4*)(CG + o + 1024) : zz, u2 = tl != Lmask ? *(const u32x4*)(U + o + 1024) : zz;
    const u32x4 bg = *(const u32x4*)(BG + o), gg = *(const u32x4*)(G + o);
    const float* cw = p.in[30]; const float* cb = p.in[31];
    u32x4 w;
#pragma unroll
    for (int i = 0; i < 4; ++i) {
      const int ch = c + 2 * i;
      const float lo = bflo(bg[i]) * (cw[ch] * bflo(c0[i]) * bflo(u0[i]) + cw[1024 + ch] * bflo(c1[i]) * bflo(u1[i]) + cw[2048 + ch] * bflo(c2[i]) * bflo(u2[i]) + cb[ch]) * silu(bflo(gg[i]));
      const float hi = bfhi(bg[i]) * (cw[ch + 1] * bfhi(c0[i]) * bfhi(u0[i]) + cw[1024 + ch + 1] * bfhi(c1[i]) * bfhi(u1[i]) + cw[2048 + ch + 1] * bfhi(c2[i]) * bfhi(u2[i]) + cb[ch + 1]) * silu(bfhi(gg[i]));
      w[i] = pack2(lo, hi);
    }
    *(u32x4*)(O + o) = w;
  }
}

DI void phase_attn(const P& p, int g, unsigned char* lds) {
  const int tid = otid(), lane = tid & 63, wave = tid >> 6, r = lane & 31, h = lane >> 5;
  const int L = g ? 4096 : 256, Ltot = g ? 4352 : 256, B = g ? 4 : 32;
  const int nq = L >> 6, ntasks = B * 4 * nq, nkt = Ltot >> 6;
  bf16_t* slots = (bf16_t*)(p.ws + WS_SLOT);
  bf16_t* Q = slots + 2 * SLOT_ELEMS; const bf16_t* G = slots + 3 * SLOT_ELEMS;
  const bf16_t* Kb = slots + 4 * SLOT_ELEMS; const bf16_t* Vt = Kb + SLOT_ELEMS / 2;
  const float SC = 0.125f * 1.4426950408889634f;
  for (int task = blockIdx.x; task < ntasks; task += gridDim.x) {
    const int qt = task % nq, kvh = (task / nq) & 3, b = task / (nq * 4);
    const int head = kvh * 4 + (wave >> 1); const int q0 = qt * 64 + (wave & 1) * 32;
    const size_t tok = (size_t)b * L + q0 + r;
    bf16x8 qf[4];
#pragma unroll
    for (int ds = 0; ds < 4; ++ds) qf[ds] = *(const bf16x8*)(Q + tok * 1024 + head * 64 + ds * 16 + h * 8);
    float m = -1e30f, lsum = 0.f;
    f32x16 O0, O1;
#pragma unroll
    for (int i = 0; i < 16; ++i) { O0[i] = 0.f; O1[i] = 0.f; }
    const int lrow = tid >> 3, lc = (tid & 7) * 8;
    const bf16_t* gK = Kb + ((size_t)b * Ltot + lrow) * 256 + kvh * 64 + lc;
    const bf16_t* gV = Vt + ((size_t)(b * 4 + kvh) * 64 + lrow) * Ltot + lc;
    u32x4 rk = *(const u32x4*)gK, rv = *(const u32x4*)gV;
    *(u32x4*)(lds + lrow * 144 + lc * 2) = rk; *(u32x4*)(lds + 9216 + lrow * 144 + lc * 2) = rv;
    __syncthreads();
    for (int kt = 0; kt < nkt; ++kt) {
      const unsigned char* cur = lds + (kt & 1) * 18432; unsigned char* nxt = lds + ((kt + 1) & 1) * 18432;
      if (kt + 1 < nkt) { rk = *(const u32x4*)(gK + (size_t)(kt + 1) * 64 * 256); rv = *(const u32x4*)(gV + (kt + 1) * 64); }
      f32x16 s0, s1;
#pragma unroll
      for (int i = 0; i < 16; ++i) { s0[i] = 0.f; s1[i] = 0.f; }
#pragma unroll
      for (int ds = 0; ds < 4; ++ds) {
        const bf16x8 a0 = *(const bf16x8*)(cur + r * 144 + (ds * 16 + h * 8) * 2);
        const bf16x8 a1 = *(const bf16x8*)(cur + (32 + r) * 144 + (ds * 16 + h * 8) * 2);
        s0 = MFMA32(a0, qf[ds], s0); s1 = MFMA32(a1, qf[ds], s1);
      }
      float tmax = s0[0];
#pragma unroll
      for (int i = 1; i < 16; ++i) tmax = fmaxf(tmax, s0[i]);
#pragma unroll
      for (int i = 0; i < 16; ++i) tmax = fmaxf(tmax, s1[i]);
      tmax = fmaxf(tmax, __shfl_xor(tmax, 32));
      const float mnew = fmaxf(m, tmax * SC);
      const float alpha = __builtin_amdgcn_exp2f(m - mnew);
      float ps = 0.f;
#pragma unroll
      for (int i = 0; i < 16; ++i) { s0[i] = __builtin_amdgcn_exp2f(s0[i] * SC - mnew); s1[i] = __builtin_amdgcn_exp2f(s1[i] * SC - mnew); ps += s0[i] + s1[i]; }
      lsum = lsum * alpha + ps; m = mnew;
#pragma unroll
      for (int i = 0; i < 16; ++i) { O0[i] *= alpha; O1[i] *= alpha; }
      const unsigned char* vs = cur + 9216;
#pragma unroll
      for (int kb = 0; kb < 2; ++kb)
#pragma unroll
        for (int s = 0; s < 2; ++s) {
          u32x4 pk;
#pragma unroll
          for (int j = 0; j < 4; ++j) pk[j] = kb ? pack2(s1[8 * s + 2 * j], s1[8 * s + 2 * j + 1]) : pack2(s0[8 * s + 2 * j], s0[8 * s + 2 * j + 1]);
          const bf16x8 pf = __builtin_bit_cast(bf16x8, pk);
          const int ko = (32 * kb + 16 * s + 4 * h) * 2;
          { const u32x2 lo = *(const u32x2*)(vs + r * 144 + ko), hi = *(const u32x2*)(vs + r * 144 + ko + 16);
            u32x4 av; av[0] = lo[0]; av[1] = lo[1]; av[2] = hi[0]; av[3] = hi[1];
            O0 = MFMA32(__builtin_bit_cast(bf16x8, av), pf, O0); }
          { const u32x2 lo = *(const u32x2*)(vs + (32 + r) * 144 + ko), hi = *(const u32x2*)(vs + (32 + r) * 144 + ko + 16);
            u32x4 av; av[0] = lo[0]; av[1] = lo[1]; av[2] = hi[0]; av[3] = hi[1];
            O1 = MFMA32(__builtin_bit_cast(bf16x8, av), pf, O1); }
        }
      if (kt + 1 < nkt) { *(u32x4*)(nxt + lrow * 144 + lc * 2) = rk; *(u32x4*)(nxt + 9216 + lrow * 144 + lc * 2) = rv; }
      __syncthreads();
    }
    lsum += __shfl_xor(lsum, 32);
    const float inv = 1.f / lsum;
#pragma unroll
    for (int db = 0; db < 2; ++db)
#pragma unroll
      for (int i4 = 0; i4 < 4; ++i4) {
        const size_t o = tok * 1024 + head * 64 + 32 * db + 8 * i4 + 4 * h;
        const u32x2 gq = *(const u32x2*)(G + o);
        const float v0 = (db ? O1[4 * i4] : O0[4 * i4]) * inv, v1 = (db ? O1[4 * i4 + 1] : O0[4 * i4 + 1]) * inv;
        const float v2 = (db ? O1[4 * i4 + 2] : O0[4 * i4 + 2]) * inv, v3 = (db ? O1[4 * i4 + 3] : O0[4 * i4 + 3]) * inv;
        u32x2 w; w[0] = pack2(v0 * silu(bflo(gq[0])), v1 * silu(bfhi(gq[0]))); w[1] = pack2(v2 * silu(bflo(gq[1])), v3 * silu(bfhi(gq[1])));
        *(u32x2*)(slots + 5 * SLOT_ELEMS + o) = w;
      }
  }
}


#define XB_TMO      128
#define XB_XCNT(j)  (256  + 64 * (j))
#define XB_XSUB(j)  (1280 + 64 * (j))
#define XB_XGEN(j)  (2304 + 64 * (j))
#define XB_TOP      3328
#define XB_TOPGEN   3392
#define XCD_BAR_WORDS 3456
#define XB_SPIN_CAP (1u << 22)
#define LAS __attribute__((address_space(3)))
DI unsigned xb_ld(unsigned* p) { return __hip_atomic_load(p, __ATOMIC_RELAXED, __HIP_MEMORY_SCOPE_AGENT); }
DI unsigned xb_add(unsigned* p, unsigned v) { return __hip_atomic_fetch_add(p, v, __ATOMIC_RELAXED, __HIP_MEMORY_SCOPE_AGENT); }
DI unsigned xb_xcc_id() { return (unsigned)__builtin_amdgcn_s_getreg((3 << 11) | 20) & 0xFu; }
#define XB_SPIN(cond, bar) do { unsigned _sp = 0; while (cond) { __builtin_amdgcn_s_sleep(1); \
    if ((++_sp & 255u) == 0u) { if (xb_ld(&(bar)[XB_TMO])) break; if (_sp > XB_SPIN_CAP) { atomicAdd(&(bar)[XB_TMO], 1u); break; } } } } while (0)
struct XcdBarrier { unsigned* bar; unsigned x; volatile LAS unsigned* st; };
DI XcdBarrier xcd_barrier_post(unsigned* bar, volatile LAS unsigned* st) {
  XcdBarrier b; b.bar = bar; b.x = xb_xcc_id(); b.st = st;
  if (threadIdx.x == 0) (void)xb_add(&bar[XB_XCNT(b.x)], 1u);
  return b;
}
DI void xcd_barrier_complete(unsigned* bar, unsigned x, unsigned& nloc, unsigned& nx) {
  const unsigned G = gridDim.x * gridDim.y * gridDim.z;
  unsigned sum, cnt, mine, sp = 0u;
  for (;;) {
    sum = 0u; cnt = 0u; mine = 0u;
#pragma unroll
    for (unsigned j = 0; j < 16; ++j) { const unsigned c = xb_ld(&bar[XB_XCNT(j)]); sum += c; cnt += (c > 0u) ? 1u : 0u; mine = (j == x) ? c : mine; }
    if (sum == G) break;
    __builtin_amdgcn_s_sleep(1);
    if ((++sp & 255u) == 0u) { if (xb_ld(&bar[XB_TMO])) break; if (sp > XB_SPIN_CAP) { atomicAdd(&bar[XB_TMO], 1u); break; } }
  }
  nloc = mine > 0u ? mine : 1u; nx = cnt > 0u ? cnt : 1u;
}
DI void xcd_barrier(const XcdBarrier& b) {
  asm volatile("s_waitcnt vmcnt(0)" ::: "memory");
  __syncthreads();
  if (threadIdx.x == 0) {
    unsigned* bar = b.bar;
    __builtin_amdgcn_s_waitcnt(0);
    unsigned nloc = b.st[0], nx = b.st[1];
    if (nloc == 0u) { xcd_barrier_complete(bar, b.x, nloc, nx); b.st[0] = nloc; b.st[1] = nx; }
    const unsigned old = xb_add(&bar[XB_XSUB(b.x)], 1u);
    const unsigned gen = old / nloc;
    if (old + 1u == (gen + 1u) * nloc) {
      __builtin_amdgcn_fence(__ATOMIC_RELEASE, "agent");
      asm volatile("s_waitcnt vmcnt(0)" ::: "memory");
      const unsigned og = xb_add(&bar[XB_TOP], 1u);
      const unsigned tg = og / nx;
      if (og + 1u == (tg + 1u) * nx) xb_add(&bar[XB_TOPGEN], 1u);
      else XB_SPIN(xb_ld(&bar[XB_TOPGEN]) == tg, bar);
      __builtin_amdgcn_fence(__ATOMIC_ACQUIRE, "agent");
      xb_add(&bar[XB_XGEN(b.x)], 1u);
      asm volatile("s_waitcnt vmcnt(0)" ::: "memory");
    } else {
      XB_SPIN(xb_ld(&bar[XB_XGEN(b.x)]) == gen, bar);
      __builtin_amdgcn_fence(__ATOMIC_ACQUIRE, "agent");
      asm volatile("s_waitcnt vmcnt(0)" ::: "memory");
    }
  }
  __syncthreads();
}

#define GPTR(T, x) ((T*)(__attribute__((address_space(1))) T*)(x))
__global__ void __launch_bounds__(NT) mega(P p) {
  extern __shared__ __attribute__((aligned(16))) unsigned char lds[];
  cg::grid_group grid = cg::this_grid();
  volatile LAS unsigned* st = (volatile LAS unsigned*)(lds + LDS_BYTES - 16);
  if (threadIdx.x < 4) st[threadIdx.x] = 0u;
  __syncthreads();
  const XcdBarrier xbar = xcd_barrier_post((unsigned*)(p.ws + WS_BAR), st);
  phase0(p, lds);
  grid.sync();
  const P& p0 = p;
  for (int step = 0; step < 50; ++step) {
    const int g = step / 25, rem = step - g * 25, layer = rem / 5, sub = rem - layer * 5;
    const int kind = layer % 3, jl = layer / 3;
    const int T = g ? 16384 : 8192, Lmask = g ? 4095 : 255;
    int op = -1;
    if (layer == 4) op = (sub == 0) ? 0 : -1;
    else if (sub == 0) op = 0;
    else if (kind == 0) op = sub == 1 ? 1 : (sub == 2 ? 2 : (sub == 3 ? 3 : 4));
    else if (kind == 1) op = sub == 1 ? 5 : (sub == 2 ? 6 : (sub == 3 ? 4 : -1));
    else op = sub == 1 ? 4 : (sub == 2 ? 7 : (sub == 3 ? 4 : -1));
    if (op < 0) continue;
    P p = p0;
    { size_t zo_ = 0; asm volatile("" : "+s"(zo_)); p.ws = p0.ws + zo_; p.out = p0.out + zo_; }
    bf16_t* slots = (bf16_t*)(p.ws + WS_SLOT);
    const bf16_t* W = (const bf16_t*)(p.ws + WS_W);
    if (op == 0) {
      const float* xin = p.in[g]; float* xout = p.out + (g ? OUT_YS : OUT_YP);
      phase_norm(p, g, layer - 1, layer < 4 ? layer : -1, layer <= 1 ? xin : xout, xout, slots + SLOT_ELEMS, slots);
      if (kind == 1 && g == 1 && layer < 4) phase_cache_copy(p);
    } else if (op == 1) {
      for (int rep = 0; rep < opq(REP_GEMM); ++rep) phase_gemm<1, 0>(p, g, slots, W + (size_t)(RW_IN0 + jl * RW_STRIDE) * 1024, T, 4352, p.in[11] + jl * 6144, Lmask, slots + SLOT_ELEMS, 1, lds);
    } else if (op == 2) {
      for (int rep = 0; rep < opq(REP_SCAN); ++rep) phase_scan(p, g, jl, lds);
    } else if (op == 3) {
      phase_rwkv_combine(p, g, jl);
    } else if (op == 4) {
      const bf16_t* A; const bf16_t* Bt; int N; bf16_t* dst;
      if (sub == 1) { A = slots; Bt = W + (size_t)CV_IN * 1024; N = 4096; dst = slots + 2 * SLOT_ELEMS; }
      else {
        N = 1024; dst = slots + SLOT_ELEMS;
        if (kind == 0) { A = slots + 4 * SLOT_ELEMS; Bt = W + (size_t)(RW_OUT0 + jl * RW_STRIDE) * 1024; }
        else if (kind == 1) { A = slots + 5 * SLOT_ELEMS; Bt = W + (size_t)AT_OUT * 1024; }
        else { A = slots; Bt = W + (size_t)CV_OUT * 1024; }
      }
      for (int rep = 0; rep < opq(REP_GEMM); ++rep) phase_gemm<0, 0>(p, g, A, Bt, T, N, nullptr, 0, dst, 0, lds);
    } else if (op == 5) {
      for (int rep = 0; rep < opq(REP_GEMM); ++rep) phase_gemm<0, 1>(p, g, slots, W + (size_t)AT_IN * 1024, T, 2560, nullptr, 0, nullptr, 0, lds);
    } else if (op == 6) {
      for (int rep = 0; rep < opq(REP_ATTN); ++rep) phase_attn(p, g, lds);
    } else {
      phase_conv(p, g);
    }
    if (!(g == 1 && layer == 4)) for (int rep = 0; rep < opq(REP_SYNC); ++rep) xcd_barrier(xbar);
  }
}

extern "C" void kernel_launch(void* const* d_in, const int* in_sizes, int n_in, void* d_out, int out_size, void* d_ws, size_t ws_size, hipStream_t stream) {
  static int grid_blocks = 0;
  if (!grid_blocks) {
    int dev = 0, cus = 0, per_cu = 0;
    hipGetDevice(&dev);
    hipDeviceGetAttribute(&cus, hipDeviceAttributeMultiprocessorCount, dev);
    hipFuncSetAttribute((const void*)mega, hipFuncAttributeMaxDynamicSharedMemorySize, LDS_BYTES);
    hipOccupancyMaxActiveBlocksPerMultiprocessor(&per_cu, (const void*)mega, NT, LDS_BYTES);
    if (per_cu < 1) per_cu = 1;
    if (per_cu > 1) per_cu = 1;
    grid_blocks = cus * per_cu;
    if (ws_size < WS_SLOT + 6 * SLOT_ELEMS * 2) fprintf(stderr, "workspace too small: %zu\n", ws_size);
  }
  (void)hipMemsetAsync((unsigned char*)d_ws + WS_BAR, 0, XCD_BAR_WORDS * sizeof(unsigned), stream);
  P p{};
  for (int i = 0; i < 33; ++i) p.in[i] = (const float*)d_in[i];
  p.out = (float*)d_out; p.ws = (unsigned char*)d_ws;
  void* args[] = {&p};
  hipError_t e = hipLaunchCooperativeKernel((const void*)mega, dim3(grid_blocks), dim3(NT), args, LDS_BYTES, stream);
  if (e != hipSuccess) fprintf(stderr, "cooperative launch failed: %s (grid %d)\n", hipGetErrorString(e), grid_blocks);
}
```

```cpp
#include <hip/hip_runtime.h>
#include <hip/hip_cooperative_groups.h>
#include <cstdio>
namespace cg = cooperative_groups;

typedef unsigned short bf16_t;
using bf16x8 = __attribute__((ext_vector_type(8))) short;
using f32x16 = __attribute__((ext_vector_type(16))) float;
using u32x4 = __attribute__((ext_vector_type(4))) unsigned;
using u32x2 = __attribute__((ext_vector_type(2))) unsigned;

#define NT 512
#ifndef REP_GEMM
#define REP_GEMM 1
#endif
#ifndef REP_SCAN
#define REP_SCAN 1
#endif
#ifndef REP_ATTN
#define REP_ATTN 1
#endif
#ifndef REP_SYNC
#define REP_SYNC 1
#endif
#define DI __device__ __forceinline__
#define MFMA32(a, b, c) __builtin_amdgcn_mfma_f32_32x32x16_bf16((a), (b), (c), 0, 0, 0)

struct P { const float* in[33]; float* out; unsigned char* ws; };

constexpr size_t WS_ADA = 0;
constexpr size_t WS_ROPE = 262144;
constexpr size_t WS_BON = 327680;
constexpr size_t WS_HID = WS_BON + 2097152;
constexpr size_t WS_W = WS_HID + 8388608;
constexpr size_t WS_SLOT = WS_W + 39845888;
constexpr size_t SLOT_ELEMS = (size_t)16384 * 1024;
constexpr int RW_IN0 = 0, RW_OUT0 = 4352, RW_STRIDE = 5376, AT_IN = 10752, AT_OUT = 13312, CV_IN = 14336, CV_OUT = 18432;
constexpr size_t OUT_YP = 0, OUT_YS = 8388608, OUT_ST = 25165824, OUT_CK = 33554432, OUT_CV = 35651584;
constexpr int LDS_BYTES = 156416 + 16;
constexpr size_t WS_BAR = 278528;

typedef __bf16 bf16x2_t __attribute__((ext_vector_type(2)));
typedef float f32x2_t __attribute__((ext_vector_type(2)));
DI unsigned pack2(float a, float b) { f32x2_t v = {a, b}; return __builtin_bit_cast(unsigned, __builtin_convertvector(v, bf16x2_t)); }
DI unsigned f2bf(float x) { return (unsigned)__builtin_bit_cast(unsigned short, (__bf16)x); }
DI float bflo(unsigned u) { return __uint_as_float(u << 16); }
DI float bfhi(unsigned u) { return __uint_as_float(u & 0xffff0000u); }
DI float bf1(bf16_t u) { return __uint_as_float(((unsigned)u) << 16); }

template <int CTRL> DI float dppf(float v) { return __int_as_float(__builtin_amdgcn_update_dpp(0, __float_as_int(v), CTRL, 0xF, 0xF, true)); }
DI float reduce16(float v) { v += dppf<0xB1>(v); v += dppf<0x4E>(v); v += dppf<0x141>(v); v += dppf<0x140>(v); return v; }
DI float rdl(float v, int l) { return __int_as_float(__builtin_amdgcn_readlane(__float_as_int(v), l)); }
DI float wave_sum(float v) { v = reduce16(v); return (rdl(v, 0) + rdl(v, 16)) + (rdl(v, 32) + rdl(v, 48)); }
DI float xhalf_max(float x) { const auto r2 = __builtin_amdgcn_permlane32_swap(__float_as_uint(x), __float_as_uint(x), false, false); return fmaxf(__uint_as_float(r2[0]), __uint_as_float(r2[1])); }
DI float xhalf_sum(float x) { const auto r2 = __builtin_amdgcn_permlane32_swap(__float_as_uint(x), __float_as_uint(x), false, false); return __uint_as_float(r2[0]) + __uint_as_float(r2[1]); }
DI float quad_sum(float v) { v += dppf<0xB1>(v); v += dppf<0x4E>(v); return v; }
DI float silu(float x) { return x / (1.f + __expf(-x)); }
DI int opq(int v) { asm volatile("" : "+s"(v)); return v; }
DI int otid() { int t = threadIdx.x; asm volatile("" : "+v"(t)); return t; }

DI void conv_tiles(const float* __restrict__ src, int N, bf16_t* __restrict__ dst, float* lds) {
  const int tid = otid();
  const int tilesN = N >> 6, ntiles = 16 * tilesN;
  for (int tile = blockIdx.x; tile < ntiles; tile += gridDim.x) {
    const int kt = tile / tilesN, nt = tile - kt * tilesN, k0 = kt * 64, n0 = nt * 64;
#pragma unroll
    for (int i = 0; i < 8; ++i) { const int k = (tid >> 6) + 8 * i, n = tid & 63; lds[k * 65 + n] = src[(size_t)(k0 + k) * N + n0 + n]; }
    __syncthreads();
    { const int n = tid >> 3, kc = (tid & 7) * 8; u32x4 o;
#pragma unroll
      for (int j = 0; j < 4; ++j) o[j] = pack2(lds[(kc + 2 * j) * 65 + n], lds[(kc + 2 * j + 1) * 65 + n]);
      *(u32x4*)(dst + (size_t)(n0 + n) * 1024 + k0 + kc) = o; }
    __syncthreads();
  }
}

DI void phase0(const P& p, unsigned char* ldsb) {
  float* lds = (float*)ldsb;
  const int tid = otid();
  bf16_t* W = (bf16_t*)(p.ws + WS_W);
#pragma unroll 1
  for (int e = 0; e < opq(22); ++e) {
    const float* src; int N, drow;
    if (e < 18) {
      const int j = e / 9, q = e - j * 9;
      if (q < 4) { src = p.in[12] + (size_t)(j * 4 + q) * 1048576; N = 1024; drow = RW_IN0 + j * RW_STRIDE + q * 1024; }
      else if (q < 6) { src = p.in[14] + (size_t)(j * 2 + q - 4) * 65536; N = 64; drow = RW_IN0 + j * RW_STRIDE + 4096 + (q - 4) * 64; }
      else if (q < 8) { src = p.in[17] + (size_t)(j * 2 + q - 6) * 65536; N = 64; drow = RW_IN0 + j * RW_STRIDE + 4224 + (q - 6) * 64; }
      else { src = p.in[24] + (size_t)j * 1048576; N = 1024; drow = RW_OUT0 + j * RW_STRIDE; }
    } else if (e == 18) { src = p.in[25]; N = 2560; drow = AT_IN; }
    else if (e == 19) { src = p.in[28]; N = 1024; drow = AT_OUT; }
    else if (e == 20) { src = p.in[29]; N = 4096; drow = CV_IN; }
    else { src = p.in[32]; N = 1024; drow = CV_OUT; }
    conv_tiles(src, N, W + (size_t)drow * 1024, lds);
  }
  {
    float* scond = lds;
    float* red = lds + 5120;
    for (int e = tid; e < 5120; e += NT) { const int cnd = e >> 10, k = e & 1023; const float cv = cnd == 0 ? p.in[6][k] : p.in[5][(cnd - 1) * 1024 + k]; scond[e] = silu(cv); }
    __syncthreads();
    float* ada = (float*)(p.ws + WS_ADA);
    for (int task = blockIdx.x; task < 192; task += gridDim.x) {
      const int layer = task / 48, n0 = (task % 48) * 64, c = tid & 63, kg = tid >> 6;
      float a0 = 0.f, a1 = 0.f, a2 = 0.f, a3 = 0.f, a4 = 0.f;
      const float* wp = p.in[9] + ((size_t)layer * 1024 + kg * 128) * 3072 + n0 + c;
#pragma unroll 8
      for (int k = 0; k < 128; ++k) { const float w = wp[(size_t)k * 3072]; const int kk = kg * 128 + k;
        a0 += scond[kk] * w; a1 += scond[1024 + kk] * w; a2 += scond[2048 + kk] * w; a3 += scond[3072 + kk] * w; a4 += scond[4096 + kk] * w; }
      red[(kg * 5 + 0) * 64 + c] = a0; red[(kg * 5 + 1) * 64 + c] = a1; red[(kg * 5 + 2) * 64 + c] = a2; red[(kg * 5 + 3) * 64 + c] = a3; red[(kg * 5 + 4) * 64 + c] = a4;
      __syncthreads();
      if (tid < 320) { const int cnd = tid >> 6; float s = p.in[10][layer * 3072 + n0 + c];
#pragma unroll
        for (int q = 0; q < 8; ++q) s += red[(q * 5 + cnd) * 64 + c];
        ada[(cnd * 4 + layer) * 3072 + n0 + c] = s; }
      __syncthreads();
    }
  }
  if (blockIdx.x == gridDim.x - 1) {
    float* rope = (float*)(p.ws + WS_ROPE);
    for (int e = tid; e < 1024; e += NT) {
      const int pos = e >> 4, f = e & 15;
      double inv = 1.0; for (int q = 0; q < f; ++q) inv *= 0.5623413251903491;
      double ang = (double)pos * inv;
      const double twopi = 6.283185307179586476925286766559;
      double n = __builtin_rint(ang / twopi); double rr = ang - n * twopi;
      double r2 = rr * rr, sn = 0.0, cs = 0.0, ts = rr, tc = 1.0;
      for (int q = 0; q < 16; ++q) { cs += tc; sn += ts; tc = -tc * r2 / (double)((2 * q + 1) * (2 * q + 2)); ts = -ts * r2 / (double)((2 * q + 2) * (2 * q + 3)); }
      rope[e * 2] = (float)cs; rope[e * 2 + 1] = (float)sn;
    }
  }
}

DI void phase_norm(const P& p, int g, int lpost, int lpre, const float* __restrict__ xsrc, float* __restrict__ xdst,
                   const bf16_t* __restrict__ Mb, bf16_t* __restrict__ H) {
  const int T = g ? 16384 : 8192;
  const int tid = otid(); const int lane = tid & 63, wave = tid >> 6;
  const float* ada = (const float*)(p.ws + WS_ADA);
  float4 xn[4]; u32x2 mn[4];
  const int t0 = blockIdx.x * 8 + wave, tstep = gridDim.x * 8;
#pragma unroll
  for (int i = 0; i < 4; ++i) { xn[i] = make_float4(0.f, 0.f, 0.f, 0.f); mn[i] = (u32x2){0u, 0u}; }
  if (t0 < T) {
#pragma unroll
    for (int i = 0; i < 4; ++i) { xn[i] = *(const float4*)(xsrc + (size_t)t0 * 1024 + 256 * i + 4 * lane); if (lpost >= 0) mn[i] = *(const u32x2*)(Mb + (size_t)t0 * 1024 + 256 * i + 4 * lane); }
  }
  for (int t = t0; t < T; t += tstep) {
    const int cond = g ? 1 + (t >> 12) : 0;
    float4 x[4]; u32x2 mr[4];
#pragma unroll
    for (int i = 0; i < 4; ++i) { x[i] = xn[i]; mr[i] = mn[i]; }
    if (t + tstep < T) {
#pragma unroll
      for (int i = 0; i < 4; ++i) { xn[i] = *(const float4*)(xsrc + (size_t)(t + tstep) * 1024 + 256 * i + 4 * lane); if (lpost >= 0) mn[i] = *(const u32x2*)(Mb + (size_t)(t + tstep) * 1024 + 256 * i + 4 * lane); }
    }
    if (lpost >= 0) {
      float m[16]; float ss = 0.f;
#pragma unroll
      for (int i = 0; i < 4; ++i) { const u32x2 u = mr[i];
        m[4 * i] = bflo(u[0]); m[4 * i + 1] = bfhi(u[0]); m[4 * i + 2] = bflo(u[1]); m[4 * i + 3] = bfhi(u[1]); }
#pragma unroll
      for (int i = 0; i < 16; ++i) ss += m[i] * m[i];
      ss = wave_sum(ss);
      const float rs = rsqrtf(ss * (1.f / 1024.f) + 1e-6f);
      const float* gate = ada + (cond * 4 + lpost) * 3072 + 2048;
      const float* wpo = p.in[8] + lpost * 1024;
#pragma unroll
      for (int i = 0; i < 4; ++i) { const int c = 256 * i + 4 * lane; const float4 gt = *(const float4*)(gate + c); const float4 wv = *(const float4*)(wpo + c);
        x[i].x += gt.x * (m[4 * i] * rs * wv.x); x[i].y += gt.y * (m[4 * i + 1] * rs * wv.y); x[i].z += gt.z * (m[4 * i + 2] * rs * wv.z); x[i].w += gt.w * (m[4 * i + 3] * rs * wv.w);
        *(float4*)(xdst + (size_t)t * 1024 + c) = x[i]; }
    }
    if (lpre >= 0) {
      float ss = 0.f;
#pragma unroll
      for (int i = 0; i < 4; ++i) ss += x[i].x * x[i].x + x[i].y * x[i].y + x[i].z * x[i].z + x[i].w * x[i].w;
      ss = wave_sum(ss);
      const float rs = rsqrtf(ss * (1.f / 1024.f) + 1e-6f);
      const float* sh = ada + (cond * 4 + lpre) * 3072; const float* sc = sh + 1024; const float* wpr = p.in[7] + lpre * 1024;
#pragma unroll
      for (int i = 0; i < 4; ++i) { const int c = 256 * i + 4 * lane; const float4 s4 = *(const float4*)(sh + c); const float4 c4 = *(const float4*)(sc + c); const float4 wv = *(const float4*)(wpr + c);
        u32x2 o; o[0] = pack2(x[i].x * rs * wv.x * (1.f + c4.x) + s4.x, x[i].y * rs * wv.y * (1.f + c4.y) + s4.y);
        o[1] = pack2(x[i].z * rs * wv.z * (1.f + c4.z) + s4.z, x[i].w * rs * wv.w * (1.f + c4.w) + s4.w);
        *(u32x2*)(H + (size_t)t * 1024 + c) = o; }
    }
  }
}

DI void phase_cache_copy(const P& p) {
  bf16_t* Kb = (bf16_t*)(p.ws + WS_SLOT) + 4 * SLOT_ELEMS; bf16_t* Vt = Kb + SLOT_ELEMS / 2;
  for (int e = blockIdx.x * NT + otid(); e < 262144; e += gridDim.x * NT) {
    const int c = e & 255, pp = (e >> 8) & 255, b = e >> 16; const int kvh = c >> 6, d = c & 63;
    Kb[((size_t)b * 4352 + 4096 + pp) * 256 + c] = (bf16_t)f2bf(p.in[3][e]);
    Vt[((size_t)(b * 4 + kvh) * 64 + d) * 4352 + 4096 + pp] = (bf16_t)f2bf(p.in[4][e]);
  }
}

template <int SHIFT> DI void ld_half(const bf16_t* __restrict__ A, int t, int k, int Lmask, u32x4 (&raw)[4]) {
  raw[1] = *(const u32x4*)(A + (size_t)t * 1024 + k);
  raw[2] = *(const u32x4*)(A + (size_t)(t + 1) * 1024 + k);
  if (SHIFT) {
    raw[0] = (u32x4){0u, 0u, 0u, 0u}; raw[3] = (u32x4){0u, 0u, 0u, 0u};
    if ((t & Lmask) != 0) raw[0] = *(const u32x4*)(A + (size_t)(t - 1) * 1024 + k);
    if (((t + 1) & Lmask) != Lmask) raw[3] = *(const u32x4*)(A + (size_t)(t + 2) * 1024 + k);
  }
}
DI u32x4 mix3(const u32x4& c, const u32x4& pz, const u32x4& nz, const float* smu, int k) {
  const float4 m0 = *(const float4*)(smu + k), m1 = *(const float4*)(smu + k + 4);
  const float mu[8] = {m0.x, m0.y, m0.z, m0.w, m1.x, m1.y, m1.z, m1.w};
  u32x4 o;
#pragma unroll
  for (int i = 0; i < 4; ++i) {
    const float h0 = bflo(c[i]), h1 = bfhi(c[i]);
    const float x0 = h0 + (0.5f * (bflo(pz[i]) + bflo(nz[i])) - h0) * mu[2 * i];
    const float x1 = h1 + (0.5f * (bfhi(pz[i]) + bfhi(nz[i])) - h1) * mu[2 * i + 1];
    o[i] = pack2(x0, x1);
  }
  return o;
}
DI int swz(int row, int c) { return row * 128 + ((c ^ ((row >> 1) & 7)) << 4); }
template <int SHIFT> DI void st_half(unsigned char* base, int row, int c, const u32x4 (&raw)[4], const float* smu, int k) {
  if (!SHIFT) { *(u32x4*)(base + swz(row, c)) = raw[1]; *(u32x4*)(base + swz(row + 1, c)) = raw[2]; }
  else { *(u32x4*)(base + swz(row, c)) = mix3(raw[1], raw[0], raw[2], smu, k); *(u32x4*)(base + swz(row + 1, c)) = mix3(raw[2], raw[1], raw[3], smu, k); }
}

template <int SHIFT, int EPI>
DI void phase_gemm(const P& p, int g, const bf16_t* __restrict__ A, const bf16_t* __restrict__ Bt, int M, int N,
                   const float* __restrict__ mu, int Lmask, bf16_t* __restrict__ dst, int rw, unsigned char* lds) {
  const int tid = otid(), lane = tid & 63, wave = tid >> 6;
  const int wm = wave >> 1, wn = wave & 1, r = lane & 31, h = lane >> 5;
  const int ntn = N >> 7, ntiles = ntn * (M >> 8);
  float* Cs = (float*)lds;
  float* smu = (float*)(lds + 110592);
  for (int tile = blockIdx.x; tile < ntiles; tile += gridDim.x) {
    const int mt = tile / ntn, nt = tile - mt * ntn; const int m0 = mt * 256, n0 = nt * 128;
    f32x16 acc[2][2];
#pragma unroll
    for (int a = 0; a < 2; ++a)
#pragma unroll
      for (int b = 0; b < 2; ++b)
#pragma unroll
        for (int i = 0; i < 16; ++i) acc[a][b][i] = 0.f;
    if (SHIFT) {
      const float* mup = mu + (nt < 32 ? (nt >> 3) : (nt == 32 ? 4 : 5)) * 1024;
      smu[tid] = mup[tid]; smu[tid + 512] = mup[tid + 512];
      __syncthreads();
    }
    if (!SHIFT) {
      u32x4 s0[6], s1[6];
      const int lrow = tid >> 3, lkc = (tid & 7) * 8;
#define G_LOAD(S, K0)  { _Pragma("unroll") for (int i = 0; i < 4; ++i) S[i] = *(const u32x4*)(A + (size_t)(m0 + lrow + 64 * i) * 1024 + (K0) + lkc); \
                         _Pragma("unroll") for (int i = 0; i < 2; ++i) S[4 + i] = *(const u32x4*)(Bt + (size_t)(n0 + lrow + 64 * i) * 1024 + (K0) + lkc); }
#define G_STORE(S, BUF) { _Pragma("unroll") for (int i = 0; i < 4; ++i) *(u32x4*)((BUF) + swz(lrow + 64 * i, tid & 7)) = S[i]; \
                          _Pragma("unroll") for (int i = 0; i < 2; ++i) *(u32x4*)((BUF) + 32768 + swz(lrow + 64 * i, tid & 7)) = S[4 + i]; }
#define G_COMPUTE(BUF) { _Pragma("unroll") for (int ks = 0; ks < 4; ++ks) { const int kc_ = ks * 2 + h; \
        const bf16x8 a0 = *(const bf16x8*)((BUF) + swz(wm * 64 + r, kc_)); const bf16x8 a1 = *(const bf16x8*)((BUF) + swz(wm * 64 + 32 + r, kc_)); \
        const bf16x8 b0 = *(const bf16x8*)((BUF) + 32768 + swz(wn * 64 + r, kc_)); const bf16x8 b1 = *(const bf16x8*)((BUF) + 32768 + swz(wn * 64 + 32 + r, kc_)); \
        acc[0][0] = MFMA32(a0, b0, acc[0][0]); acc[0][1] = MFMA32(a0, b1, acc[0][1]); acc[1][0] = MFMA32(a1, b0, acc[1][0]); acc[1][1] = MFMA32(a1, b1, acc[1][1]); } }
      G_LOAD(s0, 0) G_STORE(s0, lds)
      G_LOAD(s0, 64) G_LOAD(s1, 128)
      __syncthreads();
      for (int kt = 0; kt < 16; kt += 2) {
        G_COMPUTE(lds)
        G_STORE(s0, lds + 49152)
        if (kt + 3 < 16) G_LOAD(s0, (kt + 3) * 64)
        __syncthreads();
        G_COMPUTE(lds + 49152)
        if (kt + 2 < 16) G_STORE(s1, lds)
        if (kt + 4 < 16) G_LOAD(s1, (kt + 4) * 64)
        __syncthreads();
      }
#undef G_LOAD
#undef G_STORE
#undef G_COMPUTE
    } else {
    u32x4 raw[4], raw2[4], rb[2];
    const int arow = 4 * (tid >> 3), akc = (tid & 7) * 8;
#pragma unroll
    for (int hf = 0; hf < 2; ++hf) { ld_half<SHIFT>(A, m0 + arow + 2 * hf, akc, Lmask, raw); st_half<SHIFT>(lds, arow + 2 * hf, tid & 7, raw, smu, akc); }
#pragma unroll
    for (int i = 0; i < 2; ++i) { const int id = tid + 512 * i; rb[i] = *(const u32x4*)(Bt + (size_t)(n0 + (id >> 3)) * 1024 + (id & 7) * 8); }
#pragma unroll
    for (int i = 0; i < 2; ++i) { const int id = tid + 512 * i; *(u32x4*)(lds + 32768 + swz(id >> 3, id & 7)) = rb[i]; }
    __syncthreads();
    for (int kt = 0; kt < 16; ++kt) {
      unsigned char* cur = lds + (kt & 1) * 49152; unsigned char* nxt = lds + ((kt + 1) & 1) * 49152;
      const int k1 = (kt + 1) * 64;
      if (kt < 15) {
        ld_half<SHIFT>(A, m0 + arow, k1 + akc, Lmask, raw);
        ld_half<SHIFT>(A, m0 + arow + 2, k1 + akc, Lmask, raw2);
#pragma unroll
        for (int i = 0; i < 2; ++i) { const int id = tid + 512 * i; rb[i] = *(const u32x4*)(Bt + (size_t)(n0 + (id >> 3)) * 1024 + k1 + (id & 7) * 8); }
      }
#pragma unroll
      for (int ks = 0; ks < 4; ++ks) {
        const int kc_ = ks * 2 + h;
        const bf16x8 a0 = *(const bf16x8*)(cur + swz(wm * 64 + r, kc_));
        const bf16x8 a1 = *(const bf16x8*)(cur + swz(wm * 64 + 32 + r, kc_));
        const bf16x8 b0 = *(const bf16x8*)(cur + 32768 + swz(wn * 64 + r, kc_));
        const bf16x8 b1 = *(const bf16x8*)(cur + 32768 + swz(wn * 64 + 32 + r, kc_));
        acc[0][0] = MFMA32(a0, b0, acc[0][0]); acc[0][1] = MFMA32(a0, b1, acc[0][1]);
        acc[1][0] = MFMA32(a1, b0, acc[1][0]); acc[1][1] = MFMA32(a1, b1, acc[1][1]);
      }
      if (kt < 15) {
        st_half<SHIFT>(nxt, arow, tid & 7, raw, smu, k1 + akc);
        st_half<SHIFT>(nxt, arow + 2, tid & 7, raw2, smu, k1 + akc);
#pragma unroll
        for (int i = 0; i < 2; ++i) { const int id = tid + 512 * i; *(u32x4*)(nxt + 32768 + swz(id >> 3, id & 7)) = rb[i]; }
      }
      __syncthreads();
    }
    }
#pragma unroll
    for (int mi = 0; mi < 2; ++mi)
#pragma unroll
      for (int ni = 0; ni < 2; ++ni)
#pragma unroll
        for (int i = 0; i < 16; ++i) {
          const int row = wm * 64 + mi * 32 + (i & 3) + 8 * (i >> 2) + 4 * h, col = wn * 64 + ni * 32 + r;
          Cs[row * 132 + col] = acc[mi][ni][i];
        }
    __syncthreads();
    if (EPI == 0) {
#pragma unroll
      for (int i = 0; i < 8; ++i) {
        const int id = tid + 512 * i, row = id >> 4, cc = (id & 15) * 8;
        float4 v0 = *(const float4*)(Cs + row * 132 + cc), v1 = *(const float4*)(Cs + row * 132 + cc + 4);
        if (rw && nt == 32) { v0.x = tanhf(v0.x); v0.y = tanhf(v0.y); v0.z = tanhf(v0.z); v0.w = tanhf(v0.w); v1.x = tanhf(v1.x); v1.y = tanhf(v1.y); v1.z = tanhf(v1.z); v1.w = tanhf(v1.w); }
        u32x4 o; o[0] = pack2(v0.x, v0.y); o[1] = pack2(v0.z, v0.w); o[2] = pack2(v1.x, v1.y); o[3] = pack2(v1.z, v1.w);
        if (rw && nt >= 32) *(u32x4*)((bf16_t*)(p.ws + WS_HID) + (size_t)(m0 + row) * 256 + (nt - 32) * 128 + cc) = o;
        else *(u32x4*)(dst + (size_t)(nt >> 3) * SLOT_ELEMS + (size_t)(m0 + row) * 1024 + (nt & 7) * 128 + cc) = o;
      }
    } else {
      const int row = tid & 255, hh = tid >> 8; const int t = m0 + row;
      float x[64];
#pragma unroll
      for (int q = 0; q < 16; ++q) { const float4 v = *(const float4*)(Cs + row * 132 + hh * 64 + 4 * q); x[4 * q] = v.x; x[4 * q + 1] = v.y; x[4 * q + 2] = v.z; x[4 * q + 3] = v.w; }
      bf16_t* slots = (bf16_t*)(p.ws + WS_SLOT);
      const int L = g ? 4096 : 256, Ltot = g ? 4352 : 256;
      const int b = g ? (t >> 12) : (t >> 8), s = t & (L - 1);
      if (nt < 10) {
        int vz = 0; asm volatile("" : "+v"(vz));
        const float* nw = (nt < 8 ? p.in[26] : p.in[27]) + vz;
        float ss = 0.f;
#pragma unroll
        for (int d = 0; d < 64; ++d) ss += x[d] * x[d];
        const float rs = rsqrtf(ss * (1.f / 64.f) + 1e-6f);
#pragma unroll
        for (int d = 0; d < 64; ++d) x[d] *= rs * nw[d];
        if (g == 0 && nt >= 8) {
          float* ck = p.out + OUT_CK + (size_t)t * 256 + ((nt - 8) * 2 + hh) * 64;
#pragma unroll
          for (int q = 0; q < 16; ++q) *(float4*)(ck + 4 * q) = make_float4(x[4 * q], x[4 * q + 1], x[4 * q + 2], x[4 * q + 3]);
        }
        if (g == 1) {
          const float2* rope = (const float2*)(p.ws + WS_ROPE);
          const int ri = s >> 6, ci = s & 63;
#pragma unroll
          for (int f = 0; f < 16; ++f) {
            const float2 cr = rope[ri * 16 + f]; const float x1 = x[f], x2 = x[16 + f];
            x[f] = x1 * cr.x - x2 * cr.y; x[16 + f] = x2 * cr.x + x1 * cr.y;
            const float2 cc = rope[ci * 16 + f]; const float y1 = x[32 + f], y2 = x[48 + f];
            x[32 + f] = y1 * cc.x - y2 * cc.y; x[48 + f] = y2 * cc.x + y1 * cc.y;
          }
        }
        bf16_t* dq = nt < 8 ? slots + 2 * SLOT_ELEMS + (size_t)t * 1024 + (nt * 2 + hh) * 64
                            : slots + 4 * SLOT_ELEMS + ((size_t)b * Ltot + s) * 256 + ((nt - 8) * 2 + hh) * 64;
#pragma unroll
        for (int q = 0; q < 8; ++q) { u32x4 o; o[0] = pack2(x[8 * q], x[8 * q + 1]); o[1] = pack2(x[8 * q + 2], x[8 * q + 3]); o[2] = pack2(x[8 * q + 4], x[8 * q + 5]); o[3] = pack2(x[8 * q + 6], x[8 * q + 7]); *(u32x4*)(dq + 8 * q) = o; }
      } else if (nt < 12) {
        const int kvh = (nt - 10) * 2 + hh;
        if (g == 0) {
          float* cv = p.out + OUT_CV + (size_t)t * 256 + kvh * 64;
#pragma unroll
          for (int q = 0; q < 16; ++q) *(float4*)(cv + 4 * q) = make_float4(x[4 * q], x[4 * q + 1], x[4 * q + 2], x[4 * q + 3]);
        }
        bf16_t* vt = slots + 4 * SLOT_ELEMS + SLOT_ELEMS / 2 + ((size_t)(b * 4 + kvh) * 64) * Ltot + s;
        { size_t vo = 0;
#pragma unroll
        for (int d = 0; d < 64; ++d) { vt[vo] = (bf16_t)f2bf(x[d]); vo += Ltot; asm volatile("" : "+v"(vo)); } }
      } else {
        bf16_t* dg = slots + 3 * SLOT_ELEMS + (size_t)t * 1024 + (nt - 12) * 128 + hh * 64;
#pragma unroll
        for (int q = 0; q < 8; ++q) { u32x4 o; o[0] = pack2(x[8 * q], x[8 * q + 1]); o[1] = pack2(x[8 * q + 2], x[8 * q + 3]); o[2] = pack2(x[8 * q + 4], x[8 * q + 5]); o[3] = pack2(x[8 * q + 6], x[8 * q + 7]); *(u32x4*)(dg + 8 * q) = o; }
      }
    }
    __syncthreads();
  }
}

DI u32x4 cat8(const u32x2 lo, const u32x2 hi) { u32x4 v; v[0] = lo[0]; v[1] = lo[1]; v[2] = hi[0]; v[3] = hi[1]; return v; }
DI void phase_scan(const P& p, int g, int jl, unsigned char* lds) {
  const int tid = otid(), lane = tid & 63, wave = tid >> 6, r = lane & 31, h = lane >> 5;
  const int L = g ? 4096 : 256, B = g ? 4 : 32, nsc = L >> 5;
  float* sR = (float*)lds; float* sW = sR + 2048; float* sKD = sW + 2048; float* sKK = sKD + 2048; float* sKKA = sKK + 2048;
  bf16_t* sHW = (bf16_t*)(lds + 40960); bf16_t* sHA = (bf16_t*)(lds + 45568);
  bf16_t* oAL = (bf16_t*)(lds + 50176); bf16_t* oRH = (bf16_t*)(lds + 54784); bf16_t* oBE = (bf16_t*)(lds + 59392); bf16_t* oGA = (bf16_t*)(lds + 64000);
  bf16_t* oBEt = (bf16_t*)(lds + 68608); bf16_t* oGAt = (bf16_t*)(lds + 73728); bf16_t* oUt = (bf16_t*)(lds + 78848); bf16_t* oZt = (bf16_t*)(lds + 83968);
  float* Bm = (float*)(lds + 89088); float* RHS = (float*)(lds + 93696); float* lamC = (float*)(lds + 101888); float* sP = (float*)(lds + 102144);
  unsigned char* frag = lds + 104192;
  const bf16_t* slots = (const bf16_t*)(p.ws + WS_SLOT);
  const bf16_t* Rg = slots + 1 * SLOT_ELEMS; const bf16_t* Kg = slots + 2 * SLOT_ELEMS; const bf16_t* Vg = slots + 3 * SLOT_ELEMS;
  const bf16_t* hid = (const bf16_t*)(p.ws + WS_HID);
  float* bon = (float*)(p.ws + WS_BON);
  const int ntasks = B * 32;
  for (int task = blockIdx.x; task < ntasks; task += gridDim.x) {
    const int z = task & 1, head = (task >> 1) & 15, b = task >> 5;
    bf16_t* Yg = (bf16_t*)(p.ws + WS_SLOT) + (z ? 0 : 5) * SLOT_ELEMS;
    const int mat = (wave >> 1) & 1, ntt = wave & 1;
    unsigned char* lfr = lds + 110336 + (wave & 3) * 4096;
    if (wave >= 4) {
      const float* W2 = (mat ? p.in[18] : p.in[15]) + (size_t)(jl * 2 + z) * 65536 + head * 64 + 32 * ntt + r;
#pragma unroll
      for (int kk = 0; kk < 4; ++kk) { u32x4 pk;
#pragma unroll
        for (int j = 0; j < 4; ++j) pk[j] = pack2(W2[(size_t)(16 * kk + 8 * h + 2 * j) * 1024], W2[(size_t)(16 * kk + 8 * h + 2 * j + 1) * 1024]);
        *(u32x4*)(lfr + (kk * 64 + lane) * 16) = pk; }
    }
    const float bias = (mat ? p.in[16] : p.in[13])[(jl * 2 + z) * 1024 + head * 64 + 32 * ntt + r];
    const float kkc = p.in[19][jl * 1024 + head * 64 + lane], kac = p.in[20][jl * 1024 + head * 64 + lane], rkc = p.in[21][jl * 1024 + head * 64 + lane];
    f32x16 st0, st1;
#pragma unroll
    for (int q = 0; q < 16; ++q) { st0[q] = 0.f; st1[q] = 0.f; }
    const size_t stbase = ((((size_t)(b * 2 + jl) * 2 + z) * 16 + head) * 64 + (32 * (wave & 1) + r)) * 64;
    if (g && wave < 2) {
#pragma unroll
      for (int gq = 0; gq < 4; ++gq) {
        const float4 s0 = *(const float4*)(p.in[2] + stbase + 8 * gq + 4 * h), s1 = *(const float4*)(p.in[2] + stbase + 32 + 8 * gq + 4 * h);
        st0[4 * gq] = s0.x; st0[4 * gq + 1] = s0.y; st0[4 * gq + 2] = s0.z; st0[4 * gq + 3] = s0.w;
        st1[4 * gq] = s1.x; st1[4 * gq + 1] = s1.y; st1[4 * gq + 2] = s1.z; st1[4 * gq + 3] = s1.w;
      }
    }
    u32x4 pre[5];
    const int ht = tid - 256;
#define SCAN_LOAD(sc_)                                                                                    \
    { const int ht2 = otid() - 256;                                                                       \
    _Pragma("unroll") for (int i = 0; i < 5; ++i) {                                                       \
      const int id = ht2 + 256 * i;                                                                       \
      const int arr = id >> 8, s = (id >> 3) & 31, cc = (id & 7) * 8;                                     \
      const int tl = z ? (L - 1 - ((sc_) * 32 + s)) : ((sc_) * 32 + s);                                   \
      const size_t tok = (size_t)b * L + tl;                                                              \
      if (arr < 3) pre[i] = *(const u32x4*)((arr == 0 ? Rg : (arr == 1 ? Kg : Vg)) + tok * 1024 + head * 64 + cc); \
      else pre[i] = *(const u32x4*)(hid + tok * 256 + (arr - 3) * 128 + z * 64 + cc);                     \
    } }
#define SOLVE_ROWS(T0, T1)                                                                                \
    _Pragma("unroll") for (int t = (T0); t < (T1); ++t) {                                                 \
      if (t + 1 < 32) {                                                                                   \
        nrhs = RHo[(t + 1) * 64];                                                                         \
        _Pragma("unroll") for (int i4 = 0; i4 < (t + 4) / 4; ++i4) { const f4v q4 = *(const __attribute__((address_space(3))) f4v*)(Bmo + (t + 1) * 36 + 4 * i4); nb8[i4] = make_float4(q4[0], q4[1], q4[2], q4[3]); } \
      }                                                                                                   \
      float a0s = crhs, a1s = 0.f, a2s = 0.f, a3s = 0.f;                                                  \
      _Pragma("unroll") for (int i4 = 0; i4 < (t + 3) / 4; ++i4) {                                        \
        a0s -= cb[i4].x * zv[4 * i4]; a1s -= cb[i4].y * zv[4 * i4 + 1]; a2s -= cb[i4].z * zv[4 * i4 + 2]; a3s -= cb[i4].w * zv[4 * i4 + 3]; } \
      zv[t] = (a0s + a1s) + (a2s + a3s);                                                                  \
      asm volatile("" : "+v"(zv[t]) :: "memory");                                                         \
      crhs = nrhs;                                                                                        \
      _Pragma("unroll") for (int i4 = 0; i4 < 8; ++i4) cb[i4] = nb8[i4];                                  \
    }
    typedef float f4v __attribute__((ext_vector_type(4)));
    if (wave >= 4) { SCAN_LOAD(0) }
    for (int sc = -1; sc < nsc; ++sc) {
      const bool st_on = sc >= 0, hl_on = sc + 1 < nsc;
      bf16_t* oUc = (bf16_t*)(lds + ((sc & 1) ? 126720 : 78848));
      bf16_t* oUn = (bf16_t*)(lds + ((sc & 1) ? 78848 : 126720));
      f32x16 y0;
      const int vloc = 32 * (wave & 1) + r;
      if (st_on) {
      {
        const int k = lane, tq = wave;
        float wq[4];
#pragma unroll
        for (int j = 0; j < 4; ++j) wq[j] = sW[(4 * tq + j) * 64 + k];
        sP[tq * 64 + k] = (wq[0] * wq[1]) * (wq[2] * wq[3]);
        __syncthreads();
        float lam = 1.f;
#pragma unroll
        for (int q = 0; q < 7; ++q) { const float pq = sP[q * 64 + k]; lam *= (q < tq) ? pq : 1.f; }
        u32x2 bt, gt; float nb[4], gg[4];
#pragma unroll
        for (int j = 0; j < 4; ++j) {
          const int t = 4 * tq + j;
          const float lamp = lam; lam = lamp * wq[j];
          const float inv = __builtin_amdgcn_rcpf(lam);
          const float al = lamp * sKK[t * 64 + k], be = sKKA[t * 64 + k] * inv, ga = sKD[t * 64 + k] * inv, rh = lam * sR[t * 64 + k];
          oAL[t * 72 + k] = (bf16_t)f2bf(al); oRH[t * 72 + k] = (bf16_t)f2bf(rh); oBE[t * 72 + k] = (bf16_t)f2bf(be); oGA[t * 72 + k] = (bf16_t)f2bf(ga);
          nb[j] = -be; gg[j] = ga;
        }
        bt[0] = pack2(nb[0], nb[1]); bt[1] = pack2(nb[2], nb[3]); gt[0] = pack2(gg[0], gg[1]); gt[1] = pack2(gg[2], gg[3]);
        *(u32x2*)(oBEt + k * 40 + 4 * tq) = bt; *(u32x2*)(oGAt + k * 40 + 4 * tq) = gt;
        if (tq == 7) lamC[k] = lam;
      }
      __syncthreads();
      {
      const int tid = otid(), lane = tid & 63, wave = tid >> 6, r = lane & 31, h = lane >> 5; (void)r; (void)h; (void)lane; (void)wave;
      if (wave < 4) {
        const bf16_t* As = (wave & 1) ? oGA : oBE; const bf16_t* Bs = (wave < 2) ? oAL : oRH;
        f32x16 x;
#pragma unroll
        for (int q = 0; q < 16; ++q) x[q] = 0.f;
#pragma unroll
        for (int s = 0; s < 4; ++s) { const bf16x8 a = *(const bf16x8*)(As + r * 72 + 16 * s + 8 * h); const bf16x8 bb = *(const bf16x8*)(Bs + r * 72 + 16 * s + 8 * h); x = MFMA32(a, bb, x); }
#pragma unroll
        for (int q = 0; q < 16; ++q) { const int i = (q & 3) + 8 * (q >> 2) + 4 * h; const bool keep = (wave < 2) ? (i < r) : (i <= r); x[q] = keep ? x[q] : 0.f; }
        if (wave == 0) {
#pragma unroll
          for (int gq = 0; gq < 4; ++gq) *(float4*)(Bm + r * 36 + 8 * gq + 4 * h) = make_float4(x[4 * gq], x[4 * gq + 1], x[4 * gq + 2], x[4 * gq + 3]);
        } else {
          const float sg = (wave == 2) ? -1.f : 1.f;
#pragma unroll
          for (int s = 0; s < 2; ++s) { u32x4 pk;
#pragma unroll
            for (int j = 0; j < 4; ++j) pk[j] = pack2(sg * x[8 * s + 2 * j], sg * x[8 * s + 2 * j + 1]);
            *(u32x4*)(frag + (((wave - 1) * 2 + s) * 64 + lane) * 16) = pk; }
        }
      }
      }
      __syncthreads();
      if (wave < 2) {
        f32x16 a0;
#pragma unroll
        for (int q = 0; q < 16; ++q) { a0[q] = 0.f; y0[q] = 0.f; }
#pragma unroll
        for (int kb = 0; kb < 2; ++kb)
#pragma unroll
          for (int s = 0; s < 2; ++s) {
            u32x4 pk;
#pragma unroll
            for (int j = 0; j < 4; ++j) pk[j] = kb ? pack2(st1[8 * s + 2 * j], st1[8 * s + 2 * j + 1]) : pack2(st0[8 * s + 2 * j], st0[8 * s + 2 * j + 1]);
            const bf16x8 sf = __builtin_bit_cast(bf16x8, pk);
            const int ko = 32 * kb + 16 * s + 4 * h;
            const u32x4 aa = cat8(*(const u32x2*)(oAL + r * 72 + ko), *(const u32x2*)(oAL + r * 72 + ko + 8));
            const u32x4 ar = cat8(*(const u32x2*)(oRH + r * 72 + ko), *(const u32x2*)(oRH + r * 72 + ko + 8));
            a0 = MFMA32(__builtin_bit_cast(bf16x8, aa), sf, a0);
            y0 = MFMA32(__builtin_bit_cast(bf16x8, ar), sf, y0);
          }
#pragma unroll
        for (int s = 0; s < 2; ++s) {
          const bf16x8 fg = *(const bf16x8*)(frag + ((0 * 2 + s) * 64 + lane) * 16);
          const bf16x8 fpg = *(const bf16x8*)(frag + ((2 * 2 + s) * 64 + lane) * 16);
          const u32x4 ub = cat8(*(const u32x2*)(oUc + vloc * 40 + 16 * s + 4 * h), *(const u32x2*)(oUc + vloc * 40 + 16 * s + 4 * h + 8));
          a0 = MFMA32(fg, __builtin_bit_cast(bf16x8, ub), a0);
          y0 = MFMA32(fpg, __builtin_bit_cast(bf16x8, ub), y0);
        }
#pragma unroll
        for (int q = 0; q < 16; ++q) RHS[((q & 3) + 8 * (q >> 2) + 4 * h) * 64 + vloc] = a0[q];
        float* park = (float*)(lds + 131840) + wave * 3072 + lane * 4;
#pragma unroll
        for (int gq = 0; gq < 4; ++gq) {
          *(float4*)(park + gq * 256) = make_float4(st0[4 * gq], st0[4 * gq + 1], st0[4 * gq + 2], st0[4 * gq + 3]);
          *(float4*)(park + 1024 + gq * 256) = make_float4(st1[4 * gq], st1[4 * gq + 1], st1[4 * gq + 2], st1[4 * gq + 3]);
          *(float4*)(park + 2048 + gq * 256) = make_float4(y0[4 * gq], y0[4 * gq + 1], y0[4 * gq + 2], y0[4 * gq + 3]);
        }
      }
      }
      float zv[32]; float4 cb[8], nb8[8]; float crhs = 0.f, nrhs = 0.f;
#pragma unroll
      for (int t = 0; t < 32; ++t) zv[t] = 0.f;
#pragma unroll
      for (int q = 0; q < 8; ++q) { cb[q] = make_float4(0.f, 0.f, 0.f, 0.f); nb8[q] = make_float4(0.f, 0.f, 0.f, 0.f); }
      const __attribute__((address_space(3))) float* Bmo = (const __attribute__((address_space(3))) float*)(unsigned)(unsigned long long)Bm;
      const __attribute__((address_space(3))) float* RHo = (const __attribute__((address_space(3))) float*)(unsigned)(unsigned long long)(RHS + vloc);
      asm volatile("" : "+v"(Bmo), "+v"(RHo));
      if (wave < 2 && st_on) crhs = RHo[0];
      if (wave < 2) { if (st_on) { SOLVE_ROWS(0, 10) } }
      else if (wave >= 4 && hl_on) {
#pragma unroll
        for (int i = 0; i < 5; ++i) {
          const int id = ht + 256 * i; const int arr = id >> 8, s = (id >> 3) & 31, cc = (id & 7) * 8;
          const u32x4 u = pre[i];
          if (arr < 2) { float* d = (arr == 0 ? sR : sKD) + s * 64 + cc;
            *(float4*)d = make_float4(bflo(u[0]), bfhi(u[0]), bflo(u[1]), bfhi(u[1])); *(float4*)(d + 4) = make_float4(bflo(u[2]), bfhi(u[2]), bflo(u[3]), bfhi(u[3])); }
          else if (arr == 2) {
#pragma unroll
            for (int j = 0; j < 4; ++j) { oUn[(cc + 2 * j) * 40 + s] = (bf16_t)(u[j] & 0xffffu); oUn[(cc + 2 * j + 1) * 40 + s] = (bf16_t)(u[j] >> 16); }
          } else *(u32x4*)((arr == 3 ? sHW : sHA) + s * 72 + cc) = u;
        }
        if (sc + 2 < nsc) { SCAN_LOAD(sc + 2) }
      }
      __syncthreads();
      if (wave < 2) { if (st_on) { SOLVE_ROWS(10, 21) } }
      else if (wave >= 4 && hl_on) {
        f32x16 acc;
#pragma unroll
        for (int i = 0; i < 16; ++i) acc[i] = 0.f;
        const bf16_t* sH = mat ? sHA : sHW;
#pragma unroll
        for (int kk = 0; kk < 4; ++kk) { const bf16x8 a = *(const bf16x8*)(sH + r * 72 + 16 * kk + 8 * h); const bf16x8 bw = *(const bf16x8*)(lfr + (kk * 64 + lane) * 16); acc = MFMA32(a, bw, acc); }
#pragma unroll
        for (int i = 0; i < 16; ++i) {
          const int srow = (i & 3) + 8 * (i >> 2) + 4 * h, c = 32 * ntt + r;
          const float xv = acc[i] + bias;
          const float sg = __builtin_amdgcn_rcpf(1.f + __expf(-xv));
          if (mat == 0) sW[srow * 64 + c] = __expf(-0.60653065971263342f * sg);
          else sKKA[srow * 64 + c] = sg;
        }
      }
      __syncthreads();
      if (wave < 2) { if (st_on) {
        SOLVE_ROWS(21, 32)
        if (h == 0) {
#pragma unroll
          for (int q = 0; q < 4; ++q) { u32x4 o;
#pragma unroll
            for (int j = 0; j < 4; ++j) o[j] = pack2(zv[8 * q + 2 * j], zv[8 * q + 2 * j + 1]);
            *(u32x4*)(oZt + vloc * 40 + 8 * q) = o; }
        } } }
      else if (wave >= 4 && hl_on) {
#pragma unroll
        for (int i = 0; i < 8; ++i) {
          const int s = (wave - 4) + 4 * i; const int c = lane;
          const float kraw = sKD[s * 64 + c], a = sKKA[s * 64 + c], rr = sR[s * 64 + c];
          const float pk = kraw * kkc; const float ss = wave_sum(pk * pk);
          const float kk = pk * rsqrtf(fmaxf(ss, 1e-24f));
          const float kd = kraw * (1.f + (a - 1.f) * kac);
          const float bs = wave_sum(rr * kd * rkc);
          sKD[s * 64 + c] = kd; sKK[s * 64 + c] = kk; sKKA[s * 64 + c] = kk * a;
          if (c == 0) { const int tl = z ? (L - 1 - ((sc + 1) * 32 + s)) : ((sc + 1) * 32 + s); bon[(((size_t)b * L + tl) * 16 + head) * 2 + z] = bs; }
        }
      }
      __syncthreads();
      if (st_on) {
      {
      const int tid = otid(), lane = tid & 63, wave = tid >> 6, r = lane & 31, h = lane >> 5; (void)r; (void)h; (void)lane; (void)wave;
      if (wave < 2) {
        { const float* park = (const float*)(lds + 131840) + wave * 3072 + lane * 4;
#pragma unroll
          for (int gq = 0; gq < 4; ++gq) {
            const float4 a = *(const float4*)(park + gq * 256), bq = *(const float4*)(park + 1024 + gq * 256), cq = *(const float4*)(park + 2048 + gq * 256);
            st0[4 * gq] = a.x; st0[4 * gq + 1] = a.y; st0[4 * gq + 2] = a.z; st0[4 * gq + 3] = a.w;
            st1[4 * gq] = bq.x; st1[4 * gq + 1] = bq.y; st1[4 * gq + 2] = bq.z; st1[4 * gq + 3] = bq.w;
            y0[4 * gq] = cq.x; y0[4 * gq + 1] = cq.y; y0[4 * gq + 2] = cq.z; y0[4 * gq + 3] = cq.w;
          } }
#pragma unroll
        for (int s = 0; s < 2; ++s) {
          const bf16x8 ub = *(const bf16x8*)(oUc + vloc * 40 + 16 * s + 8 * h), zb = *(const bf16x8*)(oZt + vloc * 40 + 16 * s + 8 * h);
          const bf16x8 g0 = *(const bf16x8*)(oGAt + r * 40 + 16 * s + 8 * h), g1 = *(const bf16x8*)(oGAt + (32 + r) * 40 + 16 * s + 8 * h);
          const bf16x8 b0 = *(const bf16x8*)(oBEt + r * 40 + 16 * s + 8 * h), b1 = *(const bf16x8*)(oBEt + (32 + r) * 40 + 16 * s + 8 * h);
          st0 = MFMA32(g0, ub, st0); st0 = MFMA32(b0, zb, st0);
          st1 = MFMA32(g1, ub, st1); st1 = MFMA32(b1, zb, st1);
          const bf16x8 fpb = *(const bf16x8*)(frag + ((1 * 2 + s) * 64 + lane) * 16);
          const u32x4 z8 = cat8(*(const u32x2*)(oZt + vloc * 40 + 16 * s + 4 * h), *(const u32x2*)(oZt + vloc * 40 + 16 * s + 4 * h + 8));
          y0 = MFMA32(fpb, __builtin_bit_cast(bf16x8, z8), y0);
        }
#pragma unroll
        for (int gq = 0; gq < 4; ++gq) {
          const float4 l0 = *(const float4*)(lamC + 8 * gq + 4 * h), l1 = *(const float4*)(lamC + 32 + 8 * gq + 4 * h);
          st0[4 * gq] *= l0.x; st0[4 * gq + 1] *= l0.y; st0[4 * gq + 2] *= l0.z; st0[4 * gq + 3] *= l0.w;
          st1[4 * gq] *= l1.x; st1[4 * gq + 1] *= l1.y; st1[4 * gq + 2] *= l1.z; st1[4 * gq + 3] *= l1.w;
        }
#pragma unroll
        for (int q = 0; q < 16; ++q) {
          const int t = (q & 3) + 8 * (q >> 2) + 4 * h; const int tl = z ? (L - 1 - (sc * 32 + t)) : (sc * 32 + t);
          Yg[((size_t)b * L + tl) * 1024 + head * 64 + vloc] = (bf16_t)f2bf(y0[q]);
        }
      }
      }
      __syncthreads();
      }
    }
#undef SOLVE_ROWS
#undef SCAN_LOAD
    if (g == 0 && wave < 2) {
#pragma unroll
      for (int gq = 0; gq < 4; ++gq) {
        *(float4*)(p.out + OUT_ST + stbase + 8 * gq + 4 * h) = make_float4(st0[4 * gq], st0[4 * gq + 1], st0[4 * gq + 2], st0[4 * gq + 3]);
        *(float4*)(p.out + OUT_ST + stbase + 32 + 8 * gq + 4 * h) = make_float4(st1[4 * gq], st1[4 * gq + 1], st1[4 * gq + 2], st1[4 * gq + 3]);
      }
    }
    __syncthreads();
  }
}

DI void phase_rwkv_combine(const P& p, int g, int jl) {
  const int T = g ? 16384 : 8192;
  const int tid = otid(); const int lane = tid & 63, wave = tid >> 6;
  bf16_t* slots = (bf16_t*)(p.ws + WS_SLOT);
  const float* bon = (const float*)(p.ws + WS_BON);
  for (int t = blockIdx.x * 8 + wave; t < T; t += gridDim.x * 8) {
    const size_t o = (size_t)t * 1024 + 16 * lane; const int head = lane >> 2;
    float y[16], v[16], gg[16];
#pragma unroll
    for (int q = 0; q < 2; ++q) {
      const u32x4 a = *(const u32x4*)(slots + 5 * SLOT_ELEMS + o + 8 * q), bq = *(const u32x4*)(slots + 0 * SLOT_ELEMS + o + 8 * q);
      const u32x4 vq = *(const u32x4*)(slots + 3 * SLOT_ELEMS + o + 8 * q), gq = *(const u32x4*)(slots + 4 * SLOT_ELEMS + o + 8 * q);
#pragma unroll
      for (int i = 0; i < 4; ++i) { y[8 * q + 2 * i] = bflo(a[i]) + bflo(bq[i]); y[8 * q + 2 * i + 1] = bfhi(a[i]) + bfhi(bq[i]);
        v[8 * q + 2 * i] = bflo(vq[i]); v[8 * q + 2 * i + 1] = bfhi(vq[i]); gg[8 * q + 2 * i] = bflo(gq[i]); gg[8 * q + 2 * i + 1] = bfhi(gq[i]); }
    }
    float s = 0.f;
#pragma unroll
    for (int i = 0; i < 16; ++i) s += y[i];
    const float mean = quad_sum(s) * (1.f / 64.f);
    float vs = 0.f;
#pragma unroll
    for (int i = 0; i < 16; ++i) { const float d = y[i] - mean; vs += d * d; }
    const float rstd = rsqrtf(quad_sum(vs) * (1.f / 64.f) + 64e-5f);
    const float bs = bon[((size_t)t * 16 + head) * 2] + bon[((size_t)t * 16 + head) * 2 + 1];
    const float* gw = p.in[22] + jl * 1024 + 16 * lane; const float* gb = p.in[23] + jl * 1024 + 16 * lane;
    float ov[16];
#pragma unroll
    for (int i = 0; i < 16; ++i) ov[i] = ((y[i] - mean) * rstd * gw[i] + gb[i] + bs * v[i]) * silu(gg[i]);
#pragma unroll
    for (int q = 0; q < 2; ++q) { u32x4 w; w[0] = pack2(ov[8 * q], ov[8 * q + 1]); w[1] = pack2(ov[8 * q + 2], ov[8 * q + 3]); w[2] = pack2(ov[8 * q + 4], ov[8 * q + 5]); w[3] = pack2(ov[8 * q + 6], ov[8 * q + 7]);
      *(u32x4*)(slots + 4 * SLOT_ELEMS + o + 8 * q) = w; }
  }
}

DI void phase_conv(const P& p, int g) {
  const int T = g ? 16384 : 8192, Lmask = g ? 4095 : 255;
  bf16_t* slots = (bf16_t*)(p.ws + WS_SLOT);
  const bf16_t* BG = slots + 2 * SLOT_ELEMS; const bf16_t* CG = slots + 3 * SLOT_ELEMS; const bf16_t* U = slots + 4 * SLOT_ELEMS; const bf16_t* G = slots + 5 * SLOT_ELEMS;
  bf16_t* O = slots;
  for (int e = blockIdx.x * NT + otid(); e < T * 128; e += gridDim.x * NT) {
    const int t = e >> 7, c = (e & 127) * 8; const size_t o = (size_t)t * 1024 + c; const int tl = t & Lmask;
    const u32x4 zz = {0u, 0u, 0u, 0u};
    const u32x4 c1 = *(const u32x4*)(CG + o), u1 = *(const u32x4*)(U + o);
    const u32x4 c0 = tl != 0 ? *(const u32x4*)(CG + o - 1024) : zz, u0 = tl != 0 ? *(const u32x4*)(U + o - 1024) : zz;
    const u32x4 c2 = tl != Lmask ? *(const u32x4*)(CG + o + 1024) : zz, u2 = tl != Lmask ? *(const u32x4*)(U + o + 1024) : zz;
    const u32x4 bg = *(const u32x4*)(BG + o), gg = *(const u32x4*)(G + o);
    const float* cw = p.in[30]; const float* cb = p.in[31];
    u32x4 w;
#pragma unroll
    for (int i = 0; i < 4; ++i) {
      const int ch = c + 2 * i;
      const float lo = bflo(bg[i]) * (cw[ch] * bflo(c0[i]) * bflo(u0[i]) + cw[1024 + ch] * bflo(c1[i]) * bflo(u1[i]) + cw[2048 + ch] * bflo(c2[i]) * bflo(u2[i]) + cb[ch]) * silu(bflo(gg[i]));
      const float hi = bfhi(bg[i]) * (cw[ch + 1] * bfhi(c0[i]) * bfhi(u0[i]) + cw[1024 + ch + 1] * bfhi(c1[i]) * bfhi(u1[i]) + cw[2048 + ch + 1] * bfhi(c2[i]) * bfhi(u2[i]) + cb[ch + 1]) * silu(bfhi(gg[i]));
      w[i] = pack2(lo, hi);
    }
    *(u32x4*)(O + o) = w;
  }
}

DI void phase_attn(const P& p, int g, unsigned char* lds) {
  const int tid = otid(), lane = tid & 63, wave = tid >> 6, r = lane & 31, h = lane >> 5;
  const int L = g ? 4096 : 256, Ltot = g ? 4352 : 256, B = g ? 4 : 32;
  const int nq = L >> 6, ntasks = B * 4 * nq, nkt = Ltot >> 6;
  bf16_t* slots = (bf16_t*)(p.ws + WS_SLOT);
  bf16_t* Q = slots + 2 * SLOT_ELEMS; const bf16_t* G = slots + 3 * SLOT_ELEMS;
  const bf16_t* Kb = slots + 4 * SLOT_ELEMS; const bf16_t* Vt = Kb + SLOT_ELEMS / 2;
  const float SC = 0.125f * 1.4426950408889634f;
  for (int task = blockIdx.x; task < ntasks; task += gridDim.x) {
    const int qt = task % nq, kvh = (task / nq) & 3, b = task / (nq * 4);
    const int head = kvh * 4 + (wave >> 1); const int q0 = qt * 64 + (wave & 1) * 32;
    const size_t tok = (size_t)b * L + q0 + r;
    bf16x8 qf[4];
#pragma unroll
    for (int ds = 0; ds < 4; ++ds) qf[ds] = *(const bf16x8*)(Q + tok * 1024 + head * 64 + ds * 16 + h * 8);
    float m = -1e30f, lsum = 0.f;
    f32x16 O0, O1;
#pragma unroll
    for (int i = 0; i < 16; ++i) { O0[i] = 0.f; O1[i] = 0.f; }
    const int lrow = tid >> 3, lc = (tid & 7) * 8;
    const bf16_t* gK = Kb + ((size_t)b * Ltot + lrow) * 256 + kvh * 64 + lc;
    const bf16_t* gV = Vt + ((size_t)(b * 4 + kvh) * 64 + lrow) * Ltot + lc;
    u32x4 rk = *(const u32x4*)gK, rv = *(const u32x4*)gV;
    *(u32x4*)(lds + lrow * 144 + lc * 2) = rk; *(u32x4*)(lds + 9216 + lrow * 144 + lc * 2) = rv;
    __syncthreads();
    for (int kt = 0; kt < nkt; ++kt) {
      const unsigned char* cur = lds + (kt & 1) * 18432; unsigned char* nxt = lds + ((kt + 1) & 1) * 18432;
      if (kt + 1 < nkt) { rk = *(const u32x4*)(gK + (size_t)(kt + 1) * 64 * 256); rv = *(const u32x4*)(gV + (kt + 1) * 64); }
      f32x16 s0, s1;
#pragma unroll
      for (int i = 0; i < 16; ++i) { s0[i] = 0.f; s1[i] = 0.f; }
#pragma unroll
      for (int ds = 0; ds < 4; ++ds) {
        const bf16x8 a0 = *(const bf16x8*)(cur + r * 144 + (ds * 16 + h * 8) * 2);
        const bf16x8 a1 = *(const bf16x8*)(cur + (32 + r) * 144 + (ds * 16 + h * 8) * 2);
        s0 = MFMA32(a0, qf[ds], s0); s1 = MFMA32(a1, qf[ds], s1);
      }
      float tmax = s0[0];
#pragma unroll
      for (int i = 1; i < 16; ++i) tmax = fmaxf(tmax, s0[i]);
#pragma unroll
      for (int i = 0; i < 16; ++i) tmax = fmaxf(tmax, s1[i]);
      tmax = xhalf_max(tmax);
      const float mnew = fmaxf(m, tmax * SC);
      const float alpha = __builtin_amdgcn_exp2f(m - mnew);
      float ps = 0.f;
#pragma unroll
      for (int i = 0; i < 16; ++i) { s0[i] = __builtin_amdgcn_exp2f(s0[i] * SC - mnew); s1[i] = __builtin_amdgcn_exp2f(s1[i] * SC - mnew); ps += s0[i] + s1[i]; }
      lsum = lsum * alpha + ps; m = mnew;
#pragma unroll
      for (int i = 0; i < 16; ++i) { O0[i] *= alpha; O1[i] *= alpha; }
      const unsigned char* vs = cur + 9216;
#pragma unroll
      for (int kb = 0; kb < 2; ++kb)
#pragma unroll
        for (int s = 0; s < 2; ++s) {
          u32x4 pk;
#pragma unroll
          for (int j = 0; j < 4; ++j) pk[j] = kb ? pack2(s1[8 * s + 2 * j], s1[8 * s + 2 * j + 1]) : pack2(s0[8 * s + 2 * j], s0[8 * s + 2 * j + 1]);
          const bf16x8 pf = __builtin_bit_cast(bf16x8, pk);
          const int ko = (32 * kb + 16 * s + 4 * h) * 2;
          { const u32x2 lo = *(const u32x2*)(vs + r * 144 + ko), hi = *(const u32x2*)(vs + r * 144 + ko + 16);
            u32x4 av; av[0] = lo[0]; av[1] = lo[1]; av[2] = hi[0]; av[3] = hi[1];
            O0 = MFMA32(__builtin_bit_cast(bf16x8, av), pf, O0); }
          { const u32x2 lo = *(const u32x2*)(vs + (32 + r) * 144 + ko), hi = *(const u32x2*)(vs + (32 + r) * 144 + ko + 16);
            u32x4 av; av[0] = lo[0]; av[1] = lo[1]; av[2] = hi[0]; av[3] = hi[1];
            O1 = MFMA32(__builtin_bit_cast(bf16x8, av), pf, O1); }
        }
      if (kt + 1 < nkt) { *(u32x4*)(nxt + lrow * 144 + lc * 2) = rk; *(u32x4*)(nxt + 9216 + lrow * 144 + lc * 2) = rv; }
      __syncthreads();
    }
    lsum = xhalf_sum(lsum);
    const float inv = 1.f / lsum;
#pragma unroll
    for (int db = 0; db < 2; ++db)
#pragma unroll
      for (int i4 = 0; i4 < 4; ++i4) {
        const size_t o = tok * 1024 + head * 64 + 32 * db + 8 * i4 + 4 * h;
        const u32x2 gq = *(const u32x2*)(G + o);
        const float v0 = (db ? O1[4 * i4] : O0[4 * i4]) * inv, v1 = (db ? O1[4 * i4 + 1] : O0[4 * i4 + 1]) * inv;
        const float v2 = (db ? O1[4 * i4 + 2] : O0[4 * i4 + 2]) * inv, v3 = (db ? O1[4 * i4 + 3] : O0[4 * i4 + 3]) * inv;
        u32x2 w; w[0] = pack2(v0 * silu(bflo(gq[0])), v1 * silu(bfhi(gq[0]))); w[1] = pack2(v2 * silu(bflo(gq[1])), v3 * silu(bfhi(gq[1])));
        *(u32x2*)(slots + 5 * SLOT_ELEMS + o) = w;
      }
  }
}


#define XB_TMO      128
#define XB_XCNT(j)  (256  + 64 * (j))
#define XB_XSUB(j)  (1280 + 64 * (j))
#define XB_XGEN(j)  (2304 + 64 * (j))
#define XB_TOP      3328
#define XB_TOPGEN   3392
#define XCD_BAR_WORDS 3456
#define XB_SPIN_CAP (1u << 22)
#define LAS __attribute__((address_space(3)))
DI unsigned xb_ld(unsigned* p) { return __hip_atomic_load(p, __ATOMIC_RELAXED, __HIP_MEMORY_SCOPE_AGENT); }
DI unsigned xb_add(unsigned* p, unsigned v) { return __hip_atomic_fetch_add(p, v, __ATOMIC_RELAXED, __HIP_MEMORY_SCOPE_AGENT); }
DI unsigned xb_xcc_id() { return (unsigned)__builtin_amdgcn_s_getreg((3 << 11) | 20) & 0xFu; }
#define XB_SPIN(cond, bar) do { unsigned _sp = 0; while (cond) { __builtin_amdgcn_s_sleep(1); \
    if ((++_sp & 255u) == 0u) { if (xb_ld(&(bar)[XB_TMO])) break; if (_sp > XB_SPIN_CAP) { atomicAdd(&(bar)[XB_TMO], 1u); break; } } } } while (0)
struct XcdBarrier { unsigned* bar; unsigned x; volatile LAS unsigned* st; };
DI XcdBarrier xcd_barrier_post(unsigned* bar, volatile LAS unsigned* st) {
  XcdBarrier b; b.bar = bar; b.x = xb_xcc_id(); b.st = st;
  if (threadIdx.x == 0) (void)xb_add(&bar[XB_XCNT(b.x)], 1u);
  return b;
}
DI void xcd_barrier_complete(unsigned* bar, unsigned x, unsigned& nloc, unsigned& nx) {
  const unsigned G = gridDim.x * gridDim.y * gridDim.z;
  unsigned sum, cnt, mine, sp = 0u;
  for (;;) {
    sum = 0u; cnt = 0u; mine = 0u;
#pragma unroll
    for (unsigned j = 0; j < 16; ++j) { const unsigned c = xb_ld(&bar[XB_XCNT(j)]); sum += c; cnt += (c > 0u) ? 1u : 0u; mine = (j == x) ? c : mine; }
    if (sum == G) break;
    __builtin_amdgcn_s_sleep(1);
    if ((++sp & 255u) == 0u) { if (xb_ld(&bar[XB_TMO])) break; if (sp > XB_SPIN_CAP) { atomicAdd(&bar[XB_TMO], 1u); break; } }
  }
  nloc = mine > 0u ? mine : 1u; nx = cnt > 0u ? cnt : 1u;
}
DI void xcd_barrier(const XcdBarrier& b) {
  asm volatile("s_waitcnt vmcnt(0)" ::: "memory");
  __syncthreads();
  if (threadIdx.x == 0) {
    unsigned* bar = b.bar;
    __builtin_amdgcn_s_waitcnt(0);
    unsigned nloc = b.st[0], nx = b.st[1];
    if (nloc == 0u) { xcd_barrier_complete(bar, b.x, nloc, nx); b.st[0] = nloc; b.st[1] = nx; }
    const unsigned old = xb_add(&bar[XB_XSUB(b.x)], 1u);
    const unsigned gen = old / nloc;
    if (old + 1u == (gen + 1u) * nloc) {
      __builtin_amdgcn_fence(__ATOMIC_RELEASE, "agent");
      asm volatile("s_waitcnt vmcnt(0)" ::: "memory");
      const unsigned og = xb_add(&bar[XB_TOP], 1u);
      const unsigned tg = og / nx;
      if (og + 1u == (tg + 1u) * nx) xb_add(&bar[XB_TOPGEN], 1u);
      else XB_SPIN(xb_ld(&bar[XB_TOPGEN]) == tg, bar);
      __builtin_amdgcn_fence(__ATOMIC_ACQUIRE, "agent");
      xb_add(&bar[XB_XGEN(b.x)], 1u);
      asm volatile("s_waitcnt vmcnt(0)" ::: "memory");
    } else {
      XB_SPIN(xb_ld(&bar[XB_XGEN(b.x)]) == gen, bar);
      __builtin_amdgcn_fence(__ATOMIC_ACQUIRE, "agent");
      asm volatile("s_waitcnt vmcnt(0)" ::: "memory");
    }
  }
  __syncthreads();
}

#define GPTR(T, x) ((T*)(__attribute__((address_space(1))) T*)(x))
__global__ void __launch_bounds__(NT) mega(P p) {
  extern __shared__ __attribute__((aligned(16))) unsigned char lds[];
  cg::grid_group grid = cg::this_grid();
  volatile LAS unsigned* st = (volatile LAS unsigned*)(lds + LDS_BYTES - 16);
  if (threadIdx.x < 4) st[threadIdx.x] = 0u;
  __syncthreads();
  const XcdBarrier xbar = xcd_barrier_post((unsigned*)(p.ws + WS_BAR), st);
  phase0(p, lds);
  grid.sync();
  const P& p0 = p;
  for (int step = 0; step < 50; ++step) {
    const int g = step / 25, rem = step - g * 25, layer = rem / 5, sub = rem - layer * 5;
    const int kind = layer % 3, jl = layer / 3;
    const int T = g ? 16384 : 8192, Lmask = g ? 4095 : 255;
    int op = -1;
    if (layer == 4) op = (sub == 0) ? 0 : -1;
    else if (sub == 0) op = 0;
    else if (kind == 0) op = sub == 1 ? 1 : (sub == 2 ? 2 : (sub == 3 ? 3 : 4));
    else if (kind == 1) op = sub == 1 ? 5 : (sub == 2 ? 6 : (sub == 3 ? 4 : -1));
    else op = sub == 1 ? 4 : (sub == 2 ? 7 : (sub == 3 ? 4 : -1));
    if (op < 0) continue;
    P p = p0;
    { size_t zo_ = 0; asm volatile("" : "+s"(zo_)); p.ws = p0.ws + zo_; p.out = p0.out + zo_; }
    bf16_t* slots = (bf16_t*)(p.ws + WS_SLOT);
    const bf16_t* W = (const bf16_t*)(p.ws + WS_W);
    if (op == 0) {
      const float* xin = p.in[g]; float* xout = p.out + (g ? OUT_YS : OUT_YP);
      phase_norm(p, g, layer - 1, layer < 4 ? layer : -1, layer <= 1 ? xin : xout, xout, slots + SLOT_ELEMS, slots);
      if (kind == 1 && g == 1 && layer < 4) phase_cache_copy(p);
    } else if (op == 1) {
      for (int rep = 0; rep < opq(REP_GEMM); ++rep) phase_gemm<1, 0>(p, g, slots, W + (size_t)(RW_IN0 + jl * RW_STRIDE) * 1024, T, 4352, p.in[11] + jl * 6144, Lmask, slots + SLOT_ELEMS, 1, lds);
    } else if (op == 2) {
      for (int rep = 0; rep < opq(REP_SCAN); ++rep) phase_scan(p, g, jl, lds);
    } else if (op == 3) {
      phase_rwkv_combine(p, g, jl);
    } else if (op == 4) {
      const bf16_t* A; const bf16_t* Bt; int N; bf16_t* dst;
      if (sub == 1) { A = slots; Bt = W + (size_t)CV_IN * 1024; N = 4096; dst = slots + 2 * SLOT_ELEMS; }
      else {
        N = 1024; dst = slots + SLOT_ELEMS;
        if (kind == 0) { A = slots + 4 * SLOT_ELEMS; Bt = W + (size_t)(RW_OUT0 + jl * RW_STRIDE) * 1024; }
        else if (kind == 1) { A = slots + 5 * SLOT_ELEMS; Bt = W + (size_t)AT_OUT * 1024; }
        else { A = slots; Bt = W + (size_t)CV_OUT * 1024; }
      }
      for (int rep = 0; rep < opq(REP_GEMM); ++rep) phase_gemm<0, 0>(p, g, A, Bt, T, N, nullptr, 0, dst, 0, lds);
    } else if (op == 5) {
      for (int rep = 0; rep < opq(REP_GEMM); ++rep) phase_gemm<0, 1>(p, g, slots, W + (size_t)AT_IN * 1024, T, 2560, nullptr, 0, nullptr, 0, lds);
    } else if (op == 6) {
      for (int rep = 0; rep < opq(REP_ATTN); ++rep) phase_attn(p, g, lds);
    } else {
      phase_conv(p, g);
    }
    if (!(g == 1 && layer == 4)) for (int rep = 0; rep < opq(REP_SYNC); ++rep) xcd_barrier(xbar);
  }
}

extern "C" void kernel_launch(void* const* d_in, const int* in_sizes, int n_in, void* d_out, int out_size, void* d_ws, size_t ws_size, hipStream_t stream) {
  static int grid_blocks = 0;
  if (!grid_blocks) {
    int dev = 0, cus = 0, per_cu = 0;
    hipGetDevice(&dev);
    hipDeviceGetAttribute(&cus, hipDeviceAttributeMultiprocessorCount, dev);
    hipFuncSetAttribute((const void*)mega, hipFuncAttributeMaxDynamicSharedMemorySize, LDS_BYTES);
    hipOccupancyMaxActiveBlocksPerMultiprocessor(&per_cu, (const void*)mega, NT, LDS_BYTES);
    if (per_cu < 1) per_cu = 1;
    if (per_cu > 1) per_cu = 1;
    grid_blocks = cus * per_cu;
    if (ws_size < WS_SLOT + 6 * SLOT_ELEMS * 2) fprintf(stderr, "workspace too small: %zu\n", ws_size);
  }
  (void)hipMemsetAsync((unsigned char*)d_ws + WS_BAR, 0, XCD_BAR_WORDS * sizeof(unsigned), stream);
  P p{};
  for (int i = 0; i < 33; ++i) p.in[i] = (const float*)d_in[i];
  p.out = (float*)d_out; p.ws = (unsigned char*)d_ws;
  void* args[] = {&p};
  hipError_t e = hipLaunchCooperativeKernel((const void*)mega, dim3(grid_blocks), dim3(NT), args, LDS_BYTES, stream);
  if (e != hipSuccess) fprintf(stderr, "cooperative launch failed: %s (grid %d)\n", hipGetErrorString(e), grid_blocks);
}
```

```cpp
#include <hip/hip_runtime.h>
#include <hip/hip_cooperative_groups.h>
#include <cstdio>
namespace cg = cooperative_groups;

typedef unsigned short bf16_t;
using bf16x8 = __attribute__((ext_vector_type(8))) short;
using f32x16 = __attribute__((ext_vector_type(16))) float;
using u32x4 = __attribute__((ext_vector_type(4))) unsigned;
using u32x2 = __attribute__((ext_vector_type(2))) unsigned;

#define NT 512
#ifndef REP_GEMM
#define REP_GEMM 1
#endif
#ifndef REP_SCAN
#define REP_SCAN 1
#endif
#ifndef REP_ATTN
#define REP_ATTN 1
#endif
#ifndef REP_SYNC
#define REP_SYNC 1
#endif
#define DI __device__ __forceinline__
#define MFMA32(a, b, c) __builtin_amdgcn_mfma_f32_32x32x16_bf16((a), (b), (c), 0, 0, 0)

struct P { const float* in[33]; float* out; unsigned char* ws; };

constexpr size_t WS_ADA = 0;
constexpr size_t WS_ROPE = 262144;
constexpr size_t WS_BON = 327680;
constexpr size_t WS_HID = WS_BON + 2097152;
constexpr size_t WS_W = WS_HID + 8388608;
constexpr size_t WS_SLOT = WS_W + 39845888;
constexpr size_t SLOT_ELEMS = (size_t)16384 * 1024;
constexpr int RW_IN0 = 0, RW_OUT0 = 4352, RW_STRIDE = 5376, AT_IN = 10752, AT_OUT = 13312, CV_IN = 14336, CV_OUT = 18432;
constexpr size_t OUT_YP = 0, OUT_YS = 8388608, OUT_ST = 25165824, OUT_CK = 33554432, OUT_CV = 35651584;
constexpr int LDS_BYTES = 156416 + 16;
constexpr size_t WS_BAR = 278528;

typedef __bf16 bf16x2_t __attribute__((ext_vector_type(2)));
typedef float f32x2_t __attribute__((ext_vector_type(2)));
DI unsigned pack2(float a, float b) { f32x2_t v = {a, b}; return __builtin_bit_cast(unsigned, __builtin_convertvector(v, bf16x2_t)); }
DI unsigned f2bf(float x) { return (unsigned)__builtin_bit_cast(unsigned short, (__bf16)x); }
DI float bflo(unsigned u) { return __uint_as_float(u << 16); }
DI float bfhi(unsigned u) { return __uint_as_float(u & 0xffff0000u); }
DI float bf1(bf16_t u) { return __uint_as_float(((unsigned)u) << 16); }

template <int CTRL> DI float dppf(float v) { return __int_as_float(__builtin_amdgcn_update_dpp(0, __float_as_int(v), CTRL, 0xF, 0xF, true)); }
DI float reduce16(float v) { v += dppf<0xB1>(v); v += dppf<0x4E>(v); v += dppf<0x141>(v); v += dppf<0x140>(v); return v; }
DI float rdl(float v, int l) { return __int_as_float(__builtin_amdgcn_readlane(__float_as_int(v), l)); }
DI float wave_sum(float v) { v = reduce16(v); return (rdl(v, 0) + rdl(v, 16)) + (rdl(v, 32) + rdl(v, 48)); }
DI float xhalf_max(float x) { const auto r2 = __builtin_amdgcn_permlane32_swap(__float_as_uint(x), __float_as_uint(x), false, false); return fmaxf(__uint_as_float(r2[0]), __uint_as_float(r2[1])); }
DI float xhalf_sum(float x) { const auto r2 = __builtin_amdgcn_permlane32_swap(__float_as_uint(x), __float_as_uint(x), false, false); return __uint_as_float(r2[0]) + __uint_as_float(r2[1]); }
DI float quad_sum(float v) { v += dppf<0xB1>(v); v += dppf<0x4E>(v); return v; }
DI float silu(float x) { return x / (1.f + __expf(-x)); }
DI int opq(int v) { asm volatile("" : "+s"(v)); return v; }
DI int otid() { int t = threadIdx.x; asm volatile("" : "+v"(t)); return t; }

DI void conv_tiles(const float* __restrict__ src, int N, bf16_t* __restrict__ dst, float* lds) {
  const int tid = otid();
  const int tilesN = N >> 6, ntiles = 16 * tilesN;
  for (int tile = blockIdx.x; tile < ntiles; tile += gridDim.x) {
    const int kt = tile / tilesN, nt = tile - kt * tilesN, k0 = kt * 64, n0 = nt * 64;
#pragma unroll
    for (int i = 0; i < 8; ++i) { const int k = (tid >> 6) + 8 * i, n = tid & 63; lds[k * 65 + n] = src[(size_t)(k0 + k) * N + n0 + n]; }
    __syncthreads();
    { const int n = tid >> 3, kc = (tid & 7) * 8; u32x4 o;
#pragma unroll
      for (int j = 0; j < 4; ++j) o[j] = pack2(lds[(kc + 2 * j) * 65 + n], lds[(kc + 2 * j + 1) * 65 + n]);
      *(u32x4*)(dst + (size_t)(n0 + n) * 1024 + k0 + kc) = o; }
    __syncthreads();
  }
}

DI void phase0(const P& p, unsigned char* ldsb) {
  float* lds = (float*)ldsb;
  const int tid = otid();
  bf16_t* W = (bf16_t*)(p.ws + WS_W);
#pragma unroll 1
  for (int e = 0; e < opq(22); ++e) {
    const float* src; int N, drow;
    if (e < 18) {
      const int j = e / 9, q = e - j * 9;
      if (q < 4) { src = p.in[12] + (size_t)(j * 4 + q) * 1048576; N = 1024; drow = RW_IN0 + j * RW_STRIDE + q * 1024; }
      else if (q < 6) { src = p.in[14] + (size_t)(j * 2 + q - 4) * 65536; N = 64; drow = RW_IN0 + j * RW_STRIDE + 4096 + (q - 4) * 64; }
      else if (q < 8) { src = p.in[17] + (size_t)(j * 2 + q - 6) * 65536; N = 64; drow = RW_IN0 + j * RW_STRIDE + 4224 + (q - 6) * 64; }
      else { src = p.in[24] + (size_t)j * 1048576; N = 1024; drow = RW_OUT0 + j * RW_STRIDE; }
    } else if (e == 18) { src = p.in[25]; N = 2560; drow = AT_IN; }
    else if (e == 19) { src = p.in[28]; N = 1024; drow = AT_OUT; }
    else if (e == 20) { src = p.in[29]; N = 4096; drow = CV_IN; }
    else { src = p.in[32]; N = 1024; drow = CV_OUT; }
    conv_tiles(src, N, W + (size_t)drow * 1024, lds);
  }
  {
    float* scond = lds;
    float* red = lds + 5120;
    for (int e = tid; e < 5120; e += NT) { const int cnd = e >> 10, k = e & 1023; const float cv = cnd == 0 ? p.in[6][k] : p.in[5][(cnd - 1) * 1024 + k]; scond[e] = silu(cv); }
    __syncthreads();
    float* ada = (float*)(p.ws + WS_ADA);
    for (int task = blockIdx.x; task < 192; task += gridDim.x) {
      const int layer = task / 48, n0 = (task % 48) * 64, c = tid & 63, kg = tid >> 6;
      float a0 = 0.f, a1 = 0.f, a2 = 0.f, a3 = 0.f, a4 = 0.f;
      const float* wp = p.in[9] + ((size_t)layer * 1024 + kg * 128) * 3072 + n0 + c;
#pragma unroll 8
      for (int k = 0; k < 128; ++k) { const float w = wp[(size_t)k * 3072]; const int kk = kg * 128 + k;
        a0 += scond[kk] * w; a1 += scond[1024 + kk] * w; a2 += scond[2048 + kk] * w; a3 += scond[3072 + kk] * w; a4 += scond[4096 + kk] * w; }
      red[(kg * 5 + 0) * 64 + c] = a0; red[(kg * 5 + 1) * 64 + c] = a1; red[(kg * 5 + 2) * 64 + c] = a2; red[(kg * 5 + 3) * 64 + c] = a3; red[(kg * 5 + 4) * 64 + c] = a4;
      __syncthreads();
      if (tid < 320) { const int cnd = tid >> 6; float s = p.in[10][layer * 3072 + n0 + c];
#pragma unroll
        for (int q = 0; q < 8; ++q) s += red[(q * 5 + cnd) * 64 + c];
        ada[(cnd * 4 + layer) * 3072 + n0 + c] = s; }
      __syncthreads();
    }
  }
  if (blockIdx.x == gridDim.x - 1) {
    float* rope = (float*)(p.ws + WS_ROPE);
    for (int e = tid; e < 1024; e += NT) {
      const int pos = e >> 4, f = e & 15;
      double inv = 1.0; for (int q = 0; q < f; ++q) inv *= 0.5623413251903491;
      double ang = (double)pos * inv;
      const double twopi = 6.283185307179586476925286766559;
      double n = __builtin_rint(ang / twopi); double rr = ang - n * twopi;
      double r2 = rr * rr, sn = 0.0, cs = 0.0, ts = rr, tc = 1.0;
      for (int q = 0; q < 16; ++q) { cs += tc; sn += ts; tc = -tc * r2 / (double)((2 * q + 1) * (2 * q + 2)); ts = -ts * r2 / (double)((2 * q + 2) * (2 * q + 3)); }
      rope[e * 2] = (float)cs; rope[e * 2 + 1] = (float)sn;
    }
  }
}

DI void phase_norm(const P& p, int g, int lpost, int lpre, const float* __restrict__ xsrc, float* __restrict__ xdst,
                   const bf16_t* __restrict__ Mb, bf16_t* __restrict__ H) {
  const int T = g ? 16384 : 8192;
  const int tid = otid(); const int lane = tid & 63, wave = tid >> 6;
  const float* ada = (const float*)(p.ws + WS_ADA);
  float4 xn[4]; u32x2 mn[4];
  const int t0 = blockIdx.x * 8 + wave, tstep = gridDim.x * 8;
#pragma unroll
  for (int i = 0; i < 4; ++i) { xn[i] = make_float4(0.f, 0.f, 0.f, 0.f); mn[i] = (u32x2){0u, 0u}; }
  if (t0 < T) {
#pragma unroll
    for (int i = 0; i < 4; ++i) { xn[i] = *(const float4*)(xsrc + (size_t)t0 * 1024 + 256 * i + 4 * lane); if (lpost >= 0) mn[i] = *(const u32x2*)(Mb + (size_t)t0 * 1024 + 256 * i + 4 * lane); }
  }
  for (int t = t0; t < T; t += tstep) {
    const int cond = g ? 1 + (t >> 12) : 0;
    float4 x[4]; u32x2 mr[4];
#pragma unroll
    for (int i = 0; i < 4; ++i) { x[i] = xn[i]; mr[i] = mn[i]; }
    if (t + tstep < T) {
#pragma unroll
      for (int i = 0; i < 4; ++i) { xn[i] = *(const float4*)(xsrc + (size_t)(t + tstep) * 1024 + 256 * i + 4 * lane); if (lpost >= 0) mn[i] = *(const u32x2*)(Mb + (size_t)(t + tstep) * 1024 + 256 * i + 4 * lane); }
    }
    if (lpost >= 0) {
      float m[16]; float ss = 0.f;
#pragma unroll
      for (int i = 0; i < 4; ++i) { const u32x2 u = mr[i];
        m[4 * i] = bflo(u[0]); m[4 * i + 1] = bfhi(u[0]); m[4 * i + 2] = bflo(u[1]); m[4 * i + 3] = bfhi(u[1]); }
#pragma unroll
      for (int i = 0; i < 16; ++i) ss += m[i] * m[i];
      ss = wave_sum(ss);
      const float rs = rsqrtf(ss * (1.f / 1024.f) + 1e-6f);
      const float* gate = ada + (cond * 4 + lpost) * 3072 + 2048;
      const float* wpo = p.in[8] + lpost * 1024;
#pragma unroll
      for (int i = 0; i < 4; ++i) { const int c = 256 * i + 4 * lane; const float4 gt = *(const float4*)(gate + c); const float4 wv = *(const float4*)(wpo + c);
        x[i].x += gt.x * (m[4 * i] * rs * wv.x); x[i].y += gt.y * (m[4 * i + 1] * rs * wv.y); x[i].z += gt.z * (m[4 * i + 2] * rs * wv.z); x[i].w += gt.w * (m[4 * i + 3] * rs * wv.w);
        *(float4*)(xdst + (size_t)t * 1024 + c) = x[i]; }
    }
    if (lpre >= 0) {
      float ss = 0.f;
#pragma unroll
      for (int i = 0; i < 4; ++i) ss += x[i].x * x[i].x + x[i].y * x[i].y + x[i].z * x[i].z + x[i].w * x[i].w;
      ss = wave_sum(ss);
      const float rs = rsqrtf(ss * (1.f / 1024.f) + 1e-6f);
      const float* sh = ada + (cond * 4 + lpre) * 3072; const float* sc = sh + 1024; const float* wpr = p.in[7] + lpre * 1024;
#pragma unroll
      for (int i = 0; i < 4; ++i) { const int c = 256 * i + 4 * lane; const float4 s4 = *(const float4*)(sh + c); const float4 c4 = *(const float4*)(sc + c); const float4 wv = *(const float4*)(wpr + c);
        u32x2 o; o[0] = pack2(x[i].x * rs * wv.x * (1.f + c4.x) + s4.x, x[i].y * rs * wv.y * (1.f + c4.y) + s4.y);
        o[1] = pack2(x[i].z * rs * wv.z * (1.f + c4.z) + s4.z, x[i].w * rs * wv.w * (1.f + c4.w) + s4.w);
        *(u32x2*)(H + (size_t)t * 1024 + c) = o; }
    }
  }
}

DI void phase_cache_copy(const P& p) {
  bf16_t* Kb = (bf16_t*)(p.ws + WS_SLOT) + 4 * SLOT_ELEMS; bf16_t* Vt = Kb + SLOT_ELEMS / 2;
  for (int e = blockIdx.x * NT + otid(); e < 262144; e += gridDim.x * NT) {
    const int c = e & 255, pp = (e >> 8) & 255, b = e >> 16; const int kvh = c >> 6, d = c & 63;
    Kb[((size_t)b * 4352 + 4096 + pp) * 256 + c] = (bf16_t)f2bf(p.in[3][e]);
    Vt[((size_t)(b * 4 + kvh) * 64 + d) * 4352 + 4096 + pp] = (bf16_t)f2bf(p.in[4][e]);
  }
}

template <int SHIFT> DI void ld_half(const bf16_t* __restrict__ A, int t, int k, int Lmask, u32x4 (&raw)[4]) {
  raw[1] = *(const u32x4*)(A + (size_t)t * 1024 + k);
  raw[2] = *(const u32x4*)(A + (size_t)(t + 1) * 1024 + k);
  if (SHIFT) {
    raw[0] = (u32x4){0u, 0u, 0u, 0u}; raw[3] = (u32x4){0u, 0u, 0u, 0u};
    if ((t & Lmask) != 0) raw[0] = *(const u32x4*)(A + (size_t)(t - 1) * 1024 + k);
    if (((t + 1) & Lmask) != Lmask) raw[3] = *(const u32x4*)(A + (size_t)(t + 2) * 1024 + k);
  }
}
DI u32x4 mix3(const u32x4& c, const u32x4& pz, const u32x4& nz, const float* smu, int k) {
  const float4 m0 = *(const float4*)(smu + k), m1 = *(const float4*)(smu + k + 4);
  const float mu[8] = {m0.x, m0.y, m0.z, m0.w, m1.x, m1.y, m1.z, m1.w};
  u32x4 o;
#pragma unroll
  for (int i = 0; i < 4; ++i) {
    const float h0 = bflo(c[i]), h1 = bfhi(c[i]);
    const float x0 = h0 + (0.5f * (bflo(pz[i]) + bflo(nz[i])) - h0) * mu[2 * i];
    const float x1 = h1 + (0.5f * (bfhi(pz[i]) + bfhi(nz[i])) - h1) * mu[2 * i + 1];
    o[i] = pack2(x0, x1);
  }
  return o;
}
DI int swz(int row, int c) { return row * 128 + ((c ^ ((row >> 1) & 7)) << 4); }
template <int SHIFT> DI void st_half(unsigned char* base, int row, int c, const u32x4 (&raw)[4], const float* smu, int k) {
  if (!SHIFT) { *(u32x4*)(base + swz(row, c)) = raw[1]; *(u32x4*)(base + swz(row + 1, c)) = raw[2]; }
  else { *(u32x4*)(base + swz(row, c)) = mix3(raw[1], raw[0], raw[2], smu, k); *(u32x4*)(base + swz(row + 1, c)) = mix3(raw[2], raw[1], raw[3], smu, k); }
}

template <int SHIFT, int EPI>
DI void phase_gemm(const P& p, int g, const bf16_t* __restrict__ A, const bf16_t* __restrict__ Bt, int M, int N,
                   const float* __restrict__ mu, int Lmask, bf16_t* __restrict__ dst, int rw, unsigned char* lds) {
  const int tid = otid(), lane = tid & 63, wave = tid >> 6;
  const int wm = wave >> 1, wn = wave & 1, r = lane & 31, h = lane >> 5;
  const int ntn = N >> 7, ntiles = ntn * (M >> 8);
  float* Cs = (float*)lds;
  float* smu = (float*)(lds + 110592);
  for (int tile = blockIdx.x; tile < ntiles; tile += gridDim.x) {
    const int mt = tile / ntn, nt = tile - mt * ntn; const int m0 = mt * 256, n0 = nt * 128;
    f32x16 acc[2][2];
#pragma unroll
    for (int a = 0; a < 2; ++a)
#pragma unroll
      for (int b = 0; b < 2; ++b)
#pragma unroll
        for (int i = 0; i < 16; ++i) acc[a][b][i] = 0.f;
    if (SHIFT) {
      const float* mup = mu + (nt < 32 ? (nt >> 3) : (nt == 32 ? 4 : 5)) * 1024;
      smu[tid] = mup[tid]; smu[tid + 512] = mup[tid + 512];
      __syncthreads();
    }
    if (!SHIFT) {
      u32x4 s0[6], s1[6];
      const int lrow = tid >> 3, lkc = (tid & 7) * 8;
#define G_LOAD(S, K0)  { _Pragma("unroll") for (int i = 0; i < 4; ++i) S[i] = *(const u32x4*)(A + (size_t)(m0 + lrow + 64 * i) * 1024 + (K0) + lkc); \
                         _Pragma("unroll") for (int i = 0; i < 2; ++i) S[4 + i] = *(const u32x4*)(Bt + (size_t)(n0 + lrow + 64 * i) * 1024 + (K0) + lkc); }
#define G_STORE(S, BUF) { _Pragma("unroll") for (int i = 0; i < 4; ++i) *(u32x4*)((BUF) + swz(lrow + 64 * i, tid & 7)) = S[i]; \
                          _Pragma("unroll") for (int i = 0; i < 2; ++i) *(u32x4*)((BUF) + 32768 + swz(lrow + 64 * i, tid & 7)) = S[4 + i]; }
#define G_COMPUTE(BUF) { _Pragma("unroll") for (int ks = 0; ks < 4; ++ks) { const int kc_ = ks * 2 + h; \
        const bf16x8 a0 = *(const bf16x8*)((BUF) + swz(wm * 64 + r, kc_)); const bf16x8 a1 = *(const bf16x8*)((BUF) + swz(wm * 64 + 32 + r, kc_)); \
        const bf16x8 b0 = *(const bf16x8*)((BUF) + 32768 + swz(wn * 64 + r, kc_)); const bf16x8 b1 = *(const bf16x8*)((BUF) + 32768 + swz(wn * 64 + 32 + r, kc_)); \
        acc[0][0] = MFMA32(a0, b0, acc[0][0]); acc[0][1] = MFMA32(a0, b1, acc[0][1]); acc[1][0] = MFMA32(a1, b0, acc[1][0]); acc[1][1] = MFMA32(a1, b1, acc[1][1]); } }
      G_LOAD(s0, 0) G_STORE(s0, lds)
      G_LOAD(s0, 64) G_LOAD(s1, 128)
      __syncthreads();
      for (int kt = 0; kt < 16; kt += 2) {
        G_COMPUTE(lds)
        G_STORE(s0, lds + 49152)
        if (kt + 3 < 16) G_LOAD(s0, (kt + 3) * 64)
        __syncthreads();
        G_COMPUTE(lds + 49152)
        if (kt + 2 < 16) G_STORE(s1, lds)
        if (kt + 4 < 16) G_LOAD(s1, (kt + 4) * 64)
        __syncthreads();
      }
#undef G_LOAD
#undef G_STORE
#undef G_COMPUTE
    } else {
    u32x4 raw[4], raw2[4], rb[2];
    const int arow = 4 * (tid >> 3), akc = (tid & 7) * 8;
#pragma unroll
    for (int hf = 0; hf < 2; ++hf) { ld_half<SHIFT>(A, m0 + arow + 2 * hf, akc, Lmask, raw); st_half<SHIFT>(lds, arow + 2 * hf, tid & 7, raw, smu, akc); }
#pragma unroll
    for (int i = 0; i < 2; ++i) { const int id = tid + 512 * i; rb[i] = *(const u32x4*)(Bt + (size_t)(n0 + (id >> 3)) * 1024 + (id & 7) * 8); }
#pragma unroll
    for (int i = 0; i < 2; ++i) { const int id = tid + 512 * i; *(u32x4*)(lds + 32768 + swz(id >> 3, id & 7)) = rb[i]; }
    __syncthreads();
    for (int kt = 0; kt < 16; ++kt) {
      unsigned char* cur = lds + (kt & 1) * 49152; unsigned char* nxt = lds + ((kt + 1) & 1) * 49152;
      const int k1 = (kt + 1) * 64;
      if (kt < 15) {
        ld_half<SHIFT>(A, m0 + arow, k1 + akc, Lmask, raw);
        ld_half<SHIFT>(A, m0 + arow + 2, k1 + akc, Lmask, raw2);
#pragma unroll
        for (int i = 0; i < 2; ++i) { const int id = tid + 512 * i; rb[i] = *(const u32x4*)(Bt + (size_t)(n0 + (id >> 3)) * 1024 + k1 + (id & 7) * 8); }
      }
#pragma unroll
      for (int ks = 0; ks < 4; ++ks) {
        const int kc_ = ks * 2 + h;
        const bf16x8 a0 = *(const bf16x8*)(cur + swz(wm * 64 + r, kc_));
        const bf16x8 a1 = *(const bf16x8*)(cur + swz(wm * 64 + 32 + r, kc_));
        const bf16x8 b0 = *(const bf16x8*)(cur + 32768 + swz(wn * 64 + r, kc_));
        const bf16x8 b1 = *(const bf16x8*)(cur + 32768 + swz(wn * 64 + 32 + r, kc_));
        acc[0][0] = MFMA32(a0, b0, acc[0][0]); acc[0][1] = MFMA32(a0, b1, acc[0][1]);
        acc[1][0] = MFMA32(a1, b0, acc[1][0]); acc[1][1] = MFMA32(a1, b1, acc[1][1]);
      }
      if (kt < 15) {
        st_half<SHIFT>(nxt, arow, tid & 7, raw, smu, k1 + akc);
        st_half<SHIFT>(nxt, arow + 2, tid & 7, raw2, smu, k1 + akc);
#pragma unroll
        for (int i = 0; i < 2; ++i) { const int id = tid + 512 * i; *(u32x4*)(nxt + 32768 + swz(id >> 3, id & 7)) = rb[i]; }
      }
      __syncthreads();
    }
    }
#pragma unroll
    for (int mi = 0; mi < 2; ++mi)
#pragma unroll
      for (int ni = 0; ni < 2; ++ni)
#pragma unroll
        for (int i = 0; i < 16; ++i) {
          const int row = wm * 64 + mi * 32 + (i & 3) + 8 * (i >> 2) + 4 * h, col = wn * 64 + ni * 32 + r;
          Cs[row * 132 + col] = acc[mi][ni][i];
        }
    __syncthreads();
    if (EPI == 0) {
#pragma unroll
      for (int i = 0; i < 8; ++i) {
        const int id = tid + 512 * i, row = id >> 4, cc = (id & 15) * 8;
        float4 v0 = *(const float4*)(Cs + row * 132 + cc), v1 = *(const float4*)(Cs + row * 132 + cc + 4);
        if (rw && nt == 32) { v0.x = tanhf(v0.x); v0.y = tanhf(v0.y); v0.z = tanhf(v0.z); v0.w = tanhf(v0.w); v1.x = tanhf(v1.x); v1.y = tanhf(v1.y); v1.z = tanhf(v1.z); v1.w = tanhf(v1.w); }
        u32x4 o; o[0] = pack2(v0.x, v0.y); o[1] = pack2(v0.z, v0.w); o[2] = pack2(v1.x, v1.y); o[3] = pack2(v1.z, v1.w);
        if (rw && nt >= 32) *(u32x4*)((bf16_t*)(p.ws + WS_HID) + (size_t)(m0 + row) * 256 + (nt - 32) * 128 + cc) = o;
        else *(u32x4*)(dst + (size_t)(nt >> 3) * SLOT_ELEMS + (size_t)(m0 + row) * 1024 + (nt & 7) * 128 + cc) = o;
      }
    } else {
      const int row = tid & 255, hh = tid >> 8; const int t = m0 + row;
      float x[64];
#pragma unroll
      for (int q = 0; q < 16; ++q) { const float4 v = *(const float4*)(Cs + row * 132 + hh * 64 + 4 * q); x[4 * q] = v.x; x[4 * q + 1] = v.y; x[4 * q + 2] = v.z; x[4 * q + 3] = v.w; }
      bf16_t* slots = (bf16_t*)(p.ws + WS_SLOT);
      const int L = g ? 4096 : 256, Ltot = g ? 4352 : 256;
      const int b = g ? (t >> 12) : (t >> 8), s = t & (L - 1);
      if (nt < 10) {
        int vz = 0; asm volatile("" : "+v"(vz));
        const float* nw = (nt < 8 ? p.in[26] : p.in[27]) + vz;
        float ss = 0.f;
#pragma unroll
        for (int d = 0; d < 64; ++d) ss += x[d] * x[d];
        const float rs = rsqrtf(ss * (1.f / 64.f) + 1e-6f);
#pragma unroll
        for (int d = 0; d < 64; ++d) x[d] *= rs * nw[d];
        if (g == 0 && nt >= 8) {
          float* ck = p.out + OUT_CK + (size_t)t * 256 + ((nt - 8) * 2 + hh) * 64;
#pragma unroll
          for (int q = 0; q < 16; ++q) *(float4*)(ck + 4 * q) = make_float4(x[4 * q], x[4 * q + 1], x[4 * q + 2], x[4 * q + 3]);
        }
        if (g == 1) {
          const float2* rope = (const float2*)(p.ws + WS_ROPE);
          const int ri = s >> 6, ci = s & 63;
#pragma unroll
          for (int f = 0; f < 16; ++f) {
            const float2 cr = rope[ri * 16 + f]; const float x1 = x[f], x2 = x[16 + f];
            x[f] = x1 * cr.x - x2 * cr.y; x[16 + f] = x2 * cr.x + x1 * cr.y;
            const float2 cc = rope[ci * 16 + f]; const float y1 = x[32 + f], y2 = x[48 + f];
            x[32 + f] = y1 * cc.x - y2 * cc.y; x[48 + f] = y2 * cc.x + y1 * cc.y;
          }
        }
        bf16_t* dq = nt < 8 ? slots + 2 * SLOT_ELEMS + (size_t)t * 1024 + (nt * 2 + hh) * 64
                            : slots + 4 * SLOT_ELEMS + ((size_t)b * Ltot + s) * 256 + ((nt - 8) * 2 + hh) * 64;
#pragma unroll
        for (int q = 0; q < 8; ++q) { u32x4 o; o[0] = pack2(x[8 * q], x[8 * q + 1]); o[1] = pack2(x[8 * q + 2], x[8 * q + 3]); o[2] = pack2(x[8 * q + 4], x[8 * q + 5]); o[3] = pack2(x[8 * q + 6], x[8 * q + 7]); *(u32x4*)(dq + 8 * q) = o; }
      } else if (nt < 12) {
        const int kvh = (nt - 10) * 2 + hh;
        if (g == 0) {
          float* cv = p.out + OUT_CV + (size_t)t * 256 + kvh * 64;
#pragma unroll
          for (int q = 0; q < 16; ++q) *(float4*)(cv + 4 * q) = make_float4(x[4 * q], x[4 * q + 1], x[4 * q + 2], x[4 * q + 3]);
        }
        bf16_t* vt = slots + 4 * SLOT_ELEMS + SLOT_ELEMS / 2 + ((size_t)(b * 4 + kvh) * 64) * Ltot + s;
        { size_t vo = 0;
#pragma unroll
        for (int d = 0; d < 64; ++d) { vt[vo] = (bf16_t)f2bf(x[d]); vo += Ltot; asm volatile("" : "+v"(vo)); } }
      } else {
        bf16_t* dg = slots + 3 * SLOT_ELEMS + (size_t)t * 1024 + (nt - 12) * 128 + hh * 64;
#pragma unroll
        for (int q = 0; q < 8; ++q) { u32x4 o; o[0] = pack2(x[8 * q], x[8 * q + 1]); o[1] = pack2(x[8 * q + 2], x[8 * q + 3]); o[2] = pack2(x[8 * q + 4], x[8 * q + 5]); o[3] = pack2(x[8 * q + 6], x[8 * q + 7]); *(u32x4*)(dg + 8 * q) = o; }
      }
    }
    __syncthreads();
  }
}

DI u32x4 cat8(const u32x2 lo, const u32x2 hi) { u32x4 v; v[0] = lo[0]; v[1] = lo[1]; v[2] = hi[0]; v[3] = hi[1]; return v; }
DI void phase_scan(const P& p, int g, int jl, unsigned char* lds) {
  const int tid = otid(), lane = tid & 63, wave = tid >> 6, r = lane & 31, h = lane >> 5;
  const int L = g ? 4096 : 256, B = g ? 4 : 32, nsc = L >> 5;
  float* sR = (float*)lds; float* sW = sR + 2048; float* sKD = sW + 2048; float* sKK = sKD + 2048; float* sKKA = sKK + 2048;
  bf16_t* sHW = (bf16_t*)(lds + 40960); bf16_t* sHA = (bf16_t*)(lds + 45568);
  bf16_t* oAL = (bf16_t*)(lds + 50176); bf16_t* oRH = (bf16_t*)(lds + 54784); bf16_t* oBE = (bf16_t*)(lds + 59392); bf16_t* oGA = (bf16_t*)(lds + 64000);
  bf16_t* oBEt = (bf16_t*)(lds + 68608); bf16_t* oGAt = (bf16_t*)(lds + 73728); bf16_t* oUt = (bf16_t*)(lds + 78848); bf16_t* oZt = (bf16_t*)(lds + 83968);
  float* Bm = (float*)(lds + 89088); float* RHS = (float*)(lds + 93696); float* lamC = (float*)(lds + 101888); float* sP = (float*)(lds + 102144);
  unsigned char* frag = lds + 104192;
  const bf16_t* slots = (const bf16_t*)(p.ws + WS_SLOT);
  const bf16_t* Rg = slots + 1 * SLOT_ELEMS; const bf16_t* Kg = slots + 2 * SLOT_ELEMS; const bf16_t* Vg = slots + 3 * SLOT_ELEMS;
  const bf16_t* hid = (const bf16_t*)(p.ws + WS_HID);
  float* bon = (float*)(p.ws + WS_BON);
  const int ntasks = B * 32;
  for (int task = blockIdx.x; task < ntasks; task += gridDim.x) {
    const int z = task & 1, head = (task >> 1) & 15, b = task >> 5;
    bf16_t* Yg = (bf16_t*)(p.ws + WS_SLOT) + (z ? 0 : 5) * SLOT_ELEMS;
    const int mat = (wave >> 1) & 1, ntt = wave & 1;
    unsigned char* lfr = lds + 110336 + (wave & 3) * 4096;
    if (wave >= 4) {
      const float* W2 = (mat ? p.in[18] : p.in[15]) + (size_t)(jl * 2 + z) * 65536 + head * 64 + 32 * ntt + r;
#pragma unroll
      for (int kk = 0; kk < 4; ++kk) { u32x4 pk;
#pragma unroll
        for (int j = 0; j < 4; ++j) pk[j] = pack2(W2[(size_t)(16 * kk + 8 * h + 2 * j) * 1024], W2[(size_t)(16 * kk + 8 * h + 2 * j + 1) * 1024]);
        *(u32x4*)(lfr + (kk * 64 + lane) * 16) = pk; }
    }
    const float bias = (mat ? p.in[16] : p.in[13])[(jl * 2 + z) * 1024 + head * 64 + 32 * ntt + r];
    const float kkc = p.in[19][jl * 1024 + head * 64 + lane], kac = p.in[20][jl * 1024 + head * 64 + lane], rkc = p.in[21][jl * 1024 + head * 64 + lane];
    f32x16 st0, st1;
#pragma unroll
    for (int q = 0; q < 16; ++q) { st0[q] = 0.f; st1[q] = 0.f; }
    const size_t stbase = ((((size_t)(b * 2 + jl) * 2 + z) * 16 + head) * 64 + (32 * (wave & 1) + r)) * 64;
    if (g && wave < 2) {
#pragma unroll
      for (int gq = 0; gq < 4; ++gq) {
        const float4 s0 = *(const float4*)(p.in[2] + stbase + 8 * gq + 4 * h), s1 = *(const float4*)(p.in[2] + stbase + 32 + 8 * gq + 4 * h);
        st0[4 * gq] = s0.x; st0[4 * gq + 1] = s0.y; st0[4 * gq + 2] = s0.z; st0[4 * gq + 3] = s0.w;
        st1[4 * gq] = s1.x; st1[4 * gq + 1] = s1.y; st1[4 * gq + 2] = s1.z; st1[4 * gq + 3] = s1.w;
      }
    }
    u32x4 pre[5];
    const int ht = tid - 256;
#define SCAN_LOAD(sc_)                                                                                    \
    { const int ht2 = otid() - 256;                                                                       \
    _Pragma("unroll") for (int i = 0; i < 5; ++i) {                                                       \
      const int id = ht2 + 256 * i;                                                                       \
      const int arr = id >> 8, s = (id >> 3) & 31, cc = (id & 7) * 8;                                     \
      const int tl = z ? (L - 1 - ((sc_) * 32 + s)) : ((sc_) * 32 + s);                                   \
      const size_t tok = (size_t)b * L + tl;                                                              \
      if (arr < 3) pre[i] = *(const u32x4*)((arr == 0 ? Rg : (arr == 1 ? Kg : Vg)) + tok * 1024 + head * 64 + cc); \
      else pre[i] = *(const u32x4*)(hid + tok * 256 + (arr - 3) * 128 + z * 64 + cc);                     \
    } }
#define NQ(t_) ((((t_) + 3) / 4 + 1) / 2)
#define SOLVE_ROWS(T0, T1)                                                                                \
    _Pragma("unroll") for (int t = (T0); t < (T1); ++t) {                                                 \
      if (t + 2 < 32) {                                                                                   \
        n2rhs = RHo[(t + 2) * 64];                                                                        \
        _Pragma("unroll") for (int q = 0; q < NQ(t + 2); ++q) { const f4v q4 = *(const __attribute__((address_space(3))) f4v*)(Bmo + (t + 2) * 36 + 8 * q); nc8[q] = make_float4(q4[0], q4[1], q4[2], q4[3]); } \
      }                                                                                                   \
      float a0s = crhs * mh, a1s = 0.f;                                                                   \
      _Pragma("unroll") for (int q = 0; q < NQ(t); ++q) {                                                 \
        a0s -= cb[q].x * zv[4 * q]; a1s -= cb[q].y * zv[4 * q + 1]; a0s -= cb[q].z * zv[4 * q + 2]; a1s -= cb[q].w * zv[4 * q + 3]; } \
      float zt = xhalf_sum(a0s + a1s);                                                                    \
      asm volatile("" : "+v"(zt) :: "memory");                                                            \
      zv[4 * (t >> 3) + (t & 3)] = ((((t >> 2) & 1) == h)) ? zt : zv[4 * (t >> 3) + (t & 3)];             \
      crhs = nrhs; nrhs = n2rhs;                                                                          \
      _Pragma("unroll") for (int q = 0; q < 4; ++q) { cb[q] = nb8[q]; nb8[q] = nc8[q]; }                  \
    }
    typedef float f4v __attribute__((ext_vector_type(4)));
    if (wave >= 4) { SCAN_LOAD(0) }
    for (int sc = -1; sc < nsc; ++sc) {
      const bool st_on = sc >= 0, hl_on = sc + 1 < nsc;
      bf16_t* oUc = (bf16_t*)(lds + ((sc & 1) ? 126720 : 78848));
      bf16_t* oUn = (bf16_t*)(lds + ((sc & 1) ? 78848 : 126720));
      f32x16 y0;
      const int vloc = 32 * (wave & 1) + r;
      if (st_on) {
      {
        const int k = lane, tq = wave;
        float wq[4];
#pragma unroll
        for (int j = 0; j < 4; ++j) wq[j] = sW[(4 * tq + j) * 64 + k];
        sP[tq * 64 + k] = (wq[0] * wq[1]) * (wq[2] * wq[3]);
        __syncthreads();
        float lam = 1.f;
#pragma unroll
        for (int q = 0; q < 7; ++q) { const float pq = sP[q * 64 + k]; lam *= (q < tq) ? pq : 1.f; }
        u32x2 bt, gt; float nb[4], gg[4];
#pragma unroll
        for (int j = 0; j < 4; ++j) {
          const int t = 4 * tq + j;
          const float lamp = lam; lam = lamp * wq[j];
          const float inv = __builtin_amdgcn_rcpf(lam);
          const float al = lamp * sKK[t * 64 + k], be = sKKA[t * 64 + k] * inv, ga = sKD[t * 64 + k] * inv, rh = lam * sR[t * 64 + k];
          oAL[t * 72 + k] = (bf16_t)f2bf(al); oRH[t * 72 + k] = (bf16_t)f2bf(rh); oBE[t * 72 + k] = (bf16_t)f2bf(be); oGA[t * 72 + k] = (bf16_t)f2bf(ga);
          nb[j] = -be; gg[j] = ga;
        }
        bt[0] = pack2(nb[0], nb[1]); bt[1] = pack2(nb[2], nb[3]); gt[0] = pack2(gg[0], gg[1]); gt[1] = pack2(gg[2], gg[3]);
        *(u32x2*)(oBEt + k * 40 + 4 * tq) = bt; *(u32x2*)(oGAt + k * 40 + 4 * tq) = gt;
        if (tq == 7) lamC[k] = lam;
      }
      __syncthreads();
      {
      const int tid = otid(), lane = tid & 63, wave = tid >> 6, r = lane & 31, h = lane >> 5; (void)r; (void)h; (void)lane; (void)wave;
      if (wave < 4) {
        const bf16_t* As = (wave & 1) ? oGA : oBE; const bf16_t* Bs = (wave < 2) ? oAL : oRH;
        f32x16 x;
#pragma unroll
        for (int q = 0; q < 16; ++q) x[q] = 0.f;
#pragma unroll
        for (int s = 0; s < 4; ++s) { const bf16x8 a = *(const bf16x8*)(As + r * 72 + 16 * s + 8 * h); const bf16x8 bb = *(const bf16x8*)(Bs + r * 72 + 16 * s + 8 * h); x = MFMA32(a, bb, x); }
#pragma unroll
        for (int q = 0; q < 16; ++q) { const int i = (q & 3) + 8 * (q >> 2) + 4 * h; const bool keep = (wave < 2) ? (i < r) : (i <= r); x[q] = keep ? x[q] : 0.f; }
        if (wave == 0) {
#pragma unroll
          for (int gq = 0; gq < 4; ++gq) *(float4*)(Bm + r * 36 + 8 * gq + 4 * h) = make_float4(x[4 * gq], x[4 * gq + 1], x[4 * gq + 2], x[4 * gq + 3]);
        } else {
          const float sg = (wave == 2) ? -1.f : 1.f;
#pragma unroll
          for (int s = 0; s < 2; ++s) { u32x4 pk;
#pragma unroll
            for (int j = 0; j < 4; ++j) pk[j] = pack2(sg * x[8 * s + 2 * j], sg * x[8 * s + 2 * j + 1]);
            *(u32x4*)(frag + (((wave - 1) * 2 + s) * 64 + lane) * 16) = pk; }
        }
      }
      }
      __syncthreads();
      if (wave < 2) {
        f32x16 a0;
#pragma unroll
        for (int q = 0; q < 16; ++q) { a0[q] = 0.f; y0[q] = 0.f; }
#pragma unroll
        for (int kb = 0; kb < 2; ++kb)
#pragma unroll
          for (int s = 0; s < 2; ++s) {
            u32x4 pk;
#pragma unroll
            for (int j = 0; j < 4; ++j) pk[j] = kb ? pack2(st1[8 * s + 2 * j], st1[8 * s + 2 * j + 1]) : pack2(st0[8 * s + 2 * j], st0[8 * s + 2 * j + 1]);
            const bf16x8 sf = __builtin_bit_cast(bf16x8, pk);
            const int ko = 32 * kb + 16 * s + 4 * h;
            const u32x4 aa = cat8(*(const u32x2*)(oAL + r * 72 + ko), *(const u32x2*)(oAL + r * 72 + ko + 8));
            const u32x4 ar = cat8(*(const u32x2*)(oRH + r * 72 + ko), *(const u32x2*)(oRH + r * 72 + ko + 8));
            a0 = MFMA32(__builtin_bit_cast(bf16x8, aa), sf, a0);
            y0 = MFMA32(__builtin_bit_cast(bf16x8, ar), sf, y0);
          }
#pragma unroll
        for (int s = 0; s < 2; ++s) {
          const bf16x8 fg = *(const bf16x8*)(frag + ((0 * 2 + s) * 64 + lane) * 16);
          const bf16x8 fpg = *(const bf16x8*)(frag + ((2 * 2 + s) * 64 + lane) * 16);
          const u32x4 ub = cat8(*(const u32x2*)(oUc + vloc * 40 + 16 * s + 4 * h), *(const u32x2*)(oUc + vloc * 40 + 16 * s + 4 * h + 8));
          a0 = MFMA32(fg, __builtin_bit_cast(bf16x8, ub), a0);
          y0 = MFMA32(fpg, __builtin_bit_cast(bf16x8, ub), y0);
        }
#pragma unroll
        for (int q = 0; q < 16; ++q) RHS[((q & 3) + 8 * (q >> 2) + 4 * h) * 64 + vloc] = a0[q];
        float* park = (float*)(lds + 131840) + wave * 3072 + lane * 4;
#pragma unroll
        for (int gq = 0; gq < 4; ++gq) {
          *(float4*)(park + gq * 256) = make_float4(st0[4 * gq], st0[4 * gq + 1], st0[4 * gq + 2], st0[4 * gq + 3]);
          *(float4*)(park + 1024 + gq * 256) = make_float4(st1[4 * gq], st1[4 * gq + 1], st1[4 * gq + 2], st1[4 * gq + 3]);
          *(float4*)(park + 2048 + gq * 256) = make_float4(y0[4 * gq], y0[4 * gq + 1], y0[4 * gq + 2], y0[4 * gq + 3]);
        }
      }
      }
      float zv[16]; float4 cb[4], nb8[4], nc8[4]; float crhs = 0.f, nrhs = 0.f, n2rhs = 0.f;
      const float mh = h ? 0.f : 1.f;
#pragma unroll
      for (int t = 0; t < 16; ++t) zv[t] = 0.f;
#pragma unroll
      for (int q = 0; q < 4; ++q) { cb[q] = make_float4(0.f, 0.f, 0.f, 0.f); nb8[q] = make_float4(0.f, 0.f, 0.f, 0.f); nc8[q] = make_float4(0.f, 0.f, 0.f, 0.f); }
      const __attribute__((address_space(3))) float* Bmo = (const __attribute__((address_space(3))) float*)(unsigned)(unsigned long long)(Bm + 4 * h);
      const __attribute__((address_space(3))) float* RHo = (const __attribute__((address_space(3))) float*)(unsigned)(unsigned long long)(RHS + vloc);
      asm volatile("" : "+v"(Bmo), "+v"(RHo));
      if (wave < 2 && st_on) { crhs = RHo[0]; nrhs = RHo[64]; const f4v q4 = *(const __attribute__((address_space(3))) f4v*)(Bmo + 36); nb8[0] = make_float4(q4[0], q4[1], q4[2], q4[3]); }
      if (wave < 2) { if (st_on) { SOLVE_ROWS(0, 6) } }
      else if (wave >= 4 && hl_on) {
#pragma unroll
        for (int i = 0; i < 5; ++i) {
          const int id = ht + 256 * i; const int arr = id >> 8, s = (id >> 3) & 31, cc = (id & 7) * 8;
          const u32x4 u = pre[i];
          if (arr < 2) { float* d = (arr == 0 ? sR : sKD) + s * 64 + cc;
            *(float4*)d = make_float4(bflo(u[0]), bfhi(u[0]), bflo(u[1]), bfhi(u[1])); *(float4*)(d + 4) = make_float4(bflo(u[2]), bfhi(u[2]), bflo(u[3]), bfhi(u[3])); }
          else if (arr == 2) {
#pragma unroll
            for (int j = 0; j < 4; ++j) { oUn[(cc + 2 * j) * 40 + s] = (bf16_t)(u[j] & 0xffffu); oUn[(cc + 2 * j + 1) * 40 + s] = (bf16_t)(u[j] >> 16); }
          } else *(u32x4*)((arr == 3 ? sHW : sHA) + s * 72 + cc) = u;
        }
        if (sc + 2 < nsc) { SCAN_LOAD(sc + 2) }
      }
      __syncthreads();
      if (wave < 2) { if (st_on) { SOLVE_ROWS(6, 24) } }
      else if (wave >= 4 && hl_on) {
        f32x16 acc;
#pragma unroll
        for (int i = 0; i < 16; ++i) acc[i] = 0.f;
        const bf16_t* sH = mat ? sHA : sHW;
#pragma unroll
        for (int kk = 0; kk < 4; ++kk) { const bf16x8 a = *(const bf16x8*)(sH + r * 72 + 16 * kk + 8 * h); const bf16x8 bw = *(const bf16x8*)(lfr + (kk * 64 + lane) * 16); acc = MFMA32(a, bw, acc); }
#pragma unroll
        for (int i = 0; i < 16; ++i) {
          const int srow = (i & 3) + 8 * (i >> 2) + 4 * h, c = 32 * ntt + r;
          const float xv = acc[i] + bias;
          const float sg = __builtin_amdgcn_rcpf(1.f + __expf(-xv));
          if (mat == 0) sW[srow * 64 + c] = __expf(-0.60653065971263342f * sg);
          else sKKA[srow * 64 + c] = sg;
        }
      }
      __syncthreads();
      if (wave < 2) { if (st_on) {
        SOLVE_ROWS(24, 32)
#pragma unroll
        for (int q = 0; q < 4; ++q) { u32x2 o; o[0] = pack2(zv[4 * q], zv[4 * q + 1]); o[1] = pack2(zv[4 * q + 2], zv[4 * q + 3]);
          *(u32x2*)(oZt + vloc * 40 + 4 * (2 * q + h)) = o; }
        } }
      else if (wave >= 4 && hl_on) {
#pragma unroll
        for (int i = 0; i < 8; ++i) {
          const int s = (wave - 4) + 4 * i; const int c = lane;
          const float kraw = sKD[s * 64 + c], a = sKKA[s * 64 + c], rr = sR[s * 64 + c];
          const float pk = kraw * kkc; const float ss = wave_sum(pk * pk);
          const float kk = pk * rsqrtf(fmaxf(ss, 1e-24f));
          const float kd = kraw * (1.f + (a - 1.f) * kac);
          const float bs = wave_sum(rr * kd * rkc);
          sKD[s * 64 + c] = kd; sKK[s * 64 + c] = kk; sKKA[s * 64 + c] = kk * a;
          if (c == 0) { const int tl = z ? (L - 1 - ((sc + 1) * 32 + s)) : ((sc + 1) * 32 + s); bon[(((size_t)b * L + tl) * 16 + head) * 2 + z] = bs; }
        }
      }
      __syncthreads();
      if (st_on) {
      {
      const int tid = otid(), lane = tid & 63, wave = tid >> 6, r = lane & 31, h = lane >> 5; (void)r; (void)h; (void)lane; (void)wave;
      if (wave < 2) {
        { const float* park = (const float*)(lds + 131840) + wave * 3072 + lane * 4;
#pragma unroll
          for (int gq = 0; gq < 4; ++gq) {
            const float4 a = *(const float4*)(park + gq * 256), bq = *(const float4*)(park + 1024 + gq * 256), cq = *(const float4*)(park + 2048 + gq * 256);
            st0[4 * gq] = a.x; st0[4 * gq + 1] = a.y; st0[4 * gq + 2] = a.z; st0[4 * gq + 3] = a.w;
            st1[4 * gq] = bq.x; st1[4 * gq + 1] = bq.y; st1[4 * gq + 2] = bq.z; st1[4 * gq + 3] = bq.w;
            y0[4 * gq] = cq.x; y0[4 * gq + 1] = cq.y; y0[4 * gq + 2] = cq.z; y0[4 * gq + 3] = cq.w;
          } }
#pragma unroll
        for (int s = 0; s < 2; ++s) {
          const bf16x8 ub = *(const bf16x8*)(oUc + vloc * 40 + 16 * s + 8 * h), zb = *(const bf16x8*)(oZt + vloc * 40 + 16 * s + 8 * h);
          const bf16x8 g0 = *(const bf16x8*)(oGAt + r * 40 + 16 * s + 8 * h), g1 = *(const bf16x8*)(oGAt + (32 + r) * 40 + 16 * s + 8 * h);
          const bf16x8 b0 = *(const bf16x8*)(oBEt + r * 40 + 16 * s + 8 * h), b1 = *(const bf16x8*)(oBEt + (32 + r) * 40 + 16 * s + 8 * h);
          st0 = MFMA32(g0, ub, st0); st0 = MFMA32(b0, zb, st0);
          st1 = MFMA32(g1, ub, st1); st1 = MFMA32(b1, zb, st1);
          const bf16x8 fpb = *(const bf16x8*)(frag + ((1 * 2 + s) * 64 + lane) * 16);
          const u32x4 z8 = cat8(*(const u32x2*)(oZt + vloc * 40 + 16 * s + 4 * h), *(const u32x2*)(oZt + vloc * 40 + 16 * s + 4 * h + 8));
          y0 = MFMA32(fpb, __builtin_bit_cast(bf16x8, z8), y0);
        }
#pragma unroll
        for (int gq = 0; gq < 4; ++gq) {
          const float4 l0 = *(const float4*)(lamC + 8 * gq + 4 * h), l1 = *(const float4*)(lamC + 32 + 8 * gq + 4 * h);
          st0[4 * gq] *= l0.x; st0[4 * gq + 1] *= l0.y; st0[4 * gq + 2] *= l0.z; st0[4 * gq + 3] *= l0.w;
          st1[4 * gq] *= l1.x; st1[4 * gq + 1] *= l1.y; st1[4 * gq + 2] *= l1.z; st1[4 * gq + 3] *= l1.w;
        }
#pragma unroll
        for (int q = 0; q < 16; ++q) {
          const int t = (q & 3) + 8 * (q >> 2) + 4 * h; const int tl = z ? (L - 1 - (sc * 32 + t)) : (sc * 32 + t);
          Yg[((size_t)b * L + tl) * 1024 + head * 64 + vloc] = (bf16_t)f2bf(y0[q]);
        }
      }
      }
      __syncthreads();
      }
    }
#undef SOLVE_ROWS
#undef SCAN_LOAD
    if (g == 0 && wave < 2) {
#pragma unroll
      for (int gq = 0; gq < 4; ++gq) {
        *(float4*)(p.out + OUT_ST + stbase + 8 * gq + 4 * h) = make_float4(st0[4 * gq], st0[4 * gq + 1], st0[4 * gq + 2], st0[4 * gq + 3]);
        *(float4*)(p.out + OUT_ST + stbase + 32 + 8 * gq + 4 * h) = make_float4(st1[4 * gq], st1[4 * gq + 1], st1[4 * gq + 2], st1[4 * gq + 3]);
      }
    }
    __syncthreads();
  }
}

DI void phase_rwkv_combine(const P& p, int g, int jl) {
  const int T = g ? 16384 : 8192;
  const int tid = otid(); const int lane = tid & 63, wave = tid >> 6;
  bf16_t* slots = (bf16_t*)(p.ws + WS_SLOT);
  const float* bon = (const float*)(p.ws + WS_BON);
  for (int t = blockIdx.x * 8 + wave; t < T; t += gridDim.x * 8) {
    const size_t o = (size_t)t * 1024 + 16 * lane; const int head = lane >> 2;
    float y[16], v[16], gg[16];
#pragma unroll
    for (int q = 0; q < 2; ++q) {
      const u32x4 a = *(const u32x4*)(slots + 5 * SLOT_ELEMS + o + 8 * q), bq = *(const u32x4*)(slots + 0 * SLOT_ELEMS + o + 8 * q);
      const u32x4 vq = *(const u32x4*)(slots + 3 * SLOT_ELEMS + o + 8 * q), gq = *(const u32x4*)(slots + 4 * SLOT_ELEMS + o + 8 * q);
#pragma unroll
      for (int i = 0; i < 4; ++i) { y[8 * q + 2 * i] = bflo(a[i]) + bflo(bq[i]); y[8 * q + 2 * i + 1] = bfhi(a[i]) + bfhi(bq[i]);
        v[8 * q + 2 * i] = bflo(vq[i]); v[8 * q + 2 * i + 1] = bfhi(vq[i]); gg[8 * q + 2 * i] = bflo(gq[i]); gg[8 * q + 2 * i + 1] = bfhi(gq[i]); }
    }
    float s = 0.f;
#pragma unroll
    for (int i = 0; i < 16; ++i) s += y[i];
    const float mean = quad_sum(s) * (1.f / 64.f);
    float vs = 0.f;
#pragma unroll
    for (int i = 0; i < 16; ++i) { const float d = y[i] - mean; vs += d * d; }
    const float rstd = rsqrtf(quad_sum(vs) * (1.f / 64.f) + 64e-5f);
    const float bs = bon[((size_t)t * 16 + head) * 2] + bon[((size_t)t * 16 + head) * 2 + 1];
    const float* gw = p.in[22] + jl * 1024 + 16 * lane; const float* gb = p.in[23] + jl * 1024 + 16 * lane;
    float ov[16];
#pragma unroll
    for (int i = 0; i < 16; ++i) ov[i] = ((y[i] - mean) * rstd * gw[i] + gb[i] + bs * v[i]) * silu(gg[i]);
#pragma unroll
    for (int q = 0; q < 2; ++q) { u32x4 w; w[0] = pack2(ov[8 * q], ov[8 * q + 1]); w[1] = pack2(ov[8 * q + 2], ov[8 * q + 3]); w[2] = pack2(ov[8 * q + 4], ov[8 * q + 5]); w[3] = pack2(ov[8 * q + 6], ov[8 * q + 7]);
      *(u32x4*)(slots + 4 * SLOT_ELEMS + o + 8 * q) = w; }
  }
}

DI void phase_conv(const P& p, int g) {
  const int T = g ? 16384 : 8192, Lmask = g ? 4095 : 255;
  bf16_t* slots = (bf16_t*)(p.ws + WS_SLOT);
  const bf16_t* BG = slots + 2 * SLOT_ELEMS; const bf16_t* CG = slots + 3 * SLOT_ELEMS; const bf16_t* U = slots + 4 * SLOT_ELEMS; const bf16_t* G = slots + 5 * SLOT_ELEMS;
  bf16_t* O = slots;
  for (int e = blockIdx.x * NT + otid(); e < T * 128; e += gridDim.x * NT) {
    const int t = e >> 7, c = (e & 127) * 8; const size_t o = (size_t)t * 1024 + c; const int tl = t & Lmask;
    const u32x4 zz = {0u, 0u, 0u, 0u};
    const u32x4 c1 = *(const u32x4*)(CG + o), u1 = *(const u32x4*)(U + o);
    const u32x4 c0 = tl != 0 ? *(const u32x4*)(CG + o - 1024) : zz, u0 = tl != 0 ? *(const u32x4*)(U + o - 1024) : zz;
    const u32x4 c2 = tl != Lmask ? *(const u32x4*)(CG + o + 1024) : zz, u2 = tl != Lmask ? *(const u32x4*)(U + o + 1024) : zz;
    const u32x4 bg = *(const u32x4*)(BG + o), gg = *(const u32x4*)(G + o);
    const float* cw = p.in[30]; const float* cb = p.in[31];
    u32x4 w;
#pragma unroll
    for (int i = 0; i < 4; ++i) {
      const int ch = c + 2 * i;
      const float lo = bflo(bg[i]) * (cw[ch] * bflo(c0[i]) * bflo(u0[i]) + cw[1024 + ch] * bflo(c1[i]) * bflo(u1[i]) + cw[2048 + ch] * bflo(c2[i]) * bflo(u2[i]) + cb[ch]) * silu(bflo(gg[i]));
      const float hi = bfhi(bg[i]) * (cw[ch + 1] * bfhi(c0[i]) * bfhi(u0[i]) + cw[1024 + ch + 1] * bfhi(c1[i]) * bfhi(u1[i]) + cw[2048 + ch + 1] * bfhi(c2[i]) * bfhi(u2[i]) + cb[ch + 1]) * silu(bfhi(gg[i]));
      w[i] = pack2(lo, hi);
    }
    *(u32x4*)(O + o) = w;
  }
}

DI void phase_attn(const P& p, int g, unsigned char* lds) {
  const int tid = otid(), lane = tid & 63, wave = tid >> 6, r = lane & 31, h = lane >> 5;
  const int L = g ? 4096 : 256, Ltot = g ? 4352 : 256, B = g ? 4 : 32;
  const int nq = L >> 6, ntasks = B * 4 * nq, nkt = Ltot >> 6;
  bf16_t* slots = (bf16_t*)(p.ws + WS_SLOT);
  bf16_t* Q = slots + 2 * SLOT_ELEMS; const bf16_t* G = slots + 3 * SLOT_ELEMS;
  const bf16_t* Kb = slots + 4 * SLOT_ELEMS; const bf16_t* Vt = Kb + SLOT_ELEMS / 2;
  const float SC = 0.125f * 1.4426950408889634f;
  for (int task = blockIdx.x; task < ntasks; task += gridDim.x) {
    const int qt = task % nq, kvh = (task / nq) & 3, b = task / (nq * 4);
    const int head = kvh * 4 + (wave >> 1); const int q0 = qt * 64 + (wave & 1) * 32;
    const size_t tok = (size_t)b * L + q0 + r;
    bf16x8 qf[4];
#pragma unroll
    for (int ds = 0; ds < 4; ++ds) qf[ds] = *(const bf16x8*)(Q + tok * 1024 + head * 64 + ds * 16 + h * 8);
    float m = -1e30f, lsum = 0.f;
    f32x16 O0, O1;
#pragma unroll
    for (int i = 0; i < 16; ++i) { O0[i] = 0.f; O1[i] = 0.f; }
    const int lrow = tid >> 3, lc = (tid & 7) * 8;
    const bf16_t* gK = Kb + ((size_t)b * Ltot + lrow) * 256 + kvh * 64 + lc;
    const bf16_t* gV = Vt + ((size_t)(b * 4 + kvh) * 64 + lrow) * Ltot + lc;
    u32x4 rk = *(const u32x4*)gK, rv = *(const u32x4*)gV;
    *(u32x4*)(lds + lrow * 144 + lc * 2) = rk; *(u32x4*)(lds + 9216 + lrow * 144 + lc * 2) = rv;
    __syncthreads();
    for (int kt = 0; kt < nkt; ++kt) {
      const unsigned char* cur = lds + (kt & 1) * 18432; unsigned char* nxt = lds + ((kt + 1) & 1) * 18432;
      if (kt + 1 < nkt) { rk = *(const u32x4*)(gK + (size_t)(kt + 1) * 64 * 256); rv = *(const u32x4*)(gV + (kt + 1) * 64); }
      f32x16 s0, s1;
#pragma unroll
      for (int i = 0; i < 16; ++i) { s0[i] = 0.f; s1[i] = 0.f; }
#pragma unroll
      for (int ds = 0; ds < 4; ++ds) {
        const bf16x8 a0 = *(const bf16x8*)(cur + r * 144 + (ds * 16 + h * 8) * 2);
        const bf16x8 a1 = *(const bf16x8*)(cur + (32 + r) * 144 + (ds * 16 + h * 8) * 2);
        s0 = MFMA32(a0, qf[ds], s0); s1 = MFMA32(a1, qf[ds], s1);
      }
      float tmax = s0[0];
#pragma unroll
      for (int i = 1; i < 16; ++i) tmax = fmaxf(tmax, s0[i]);
#pragma unroll
      for (int i = 0; i < 16; ++i) tmax = fmaxf(tmax, s1[i]);
      tmax = xhalf_max(tmax);
      const float mnew = fmaxf(m, tmax * SC);
      const float alpha = __builtin_amdgcn_exp2f(m - mnew);
      float ps = 0.f;
#pragma unroll
      for (int i = 0; i < 16; ++i) { s0[i] = __builtin_amdgcn_exp2f(s0[i] * SC - mnew); s1[i] = __builtin_amdgcn_exp2f(s1[i] * SC - mnew); ps += s0[i] + s1[i]; }
      lsum = lsum * alpha + ps; m = mnew;
#pragma unroll
      for (int i = 0; i < 16; ++i) { O0[i] *= alpha; O1[i] *= alpha; }
      const unsigned char* vs = cur + 9216;
#pragma unroll
      for (int kb = 0; kb < 2; ++kb)
#pragma unroll
        for (int s = 0; s < 2; ++s) {
          u32x4 pk;
#pragma unroll
          for (int j = 0; j < 4; ++j) pk[j] = kb ? pack2(s1[8 * s + 2 * j], s1[8 * s + 2 * j + 1]) : pack2(s0[8 * s + 2 * j], s0[8 * s + 2 * j + 1]);
          const bf16x8 pf = __builtin_bit_cast(bf16x8, pk);
          const int ko = (32 * kb + 16 * s + 4 * h) * 2;
          { const u32x2 lo = *(const u32x2*)(vs + r * 144 + ko), hi = *(const u32x2*)(vs + r * 144 + ko + 16);
            u32x4 av; av[0] = lo[0]; av[1] = lo[1]; av[2] = hi[0]; av[3] = hi[1];
            O0 = MFMA32(__builtin_bit_cast(bf16x8, av), pf, O0); }
          { const u32x2 lo = *(const u32x2*)(vs + (32 + r) * 144 + ko), hi = *(const u32x2*)(vs + (32 + r) * 144 + ko + 16);
            u32x4 av; av[0] = lo[0]; av[1] = lo[1]; av[2] = hi[0]; av[3] = hi[1];
            O1 = MFMA32(__builtin_bit_cast(bf16x8, av), pf, O1); }
        }
      if (kt + 1 < nkt) { *(u32x4*)(nxt + lrow * 144 + lc * 2) = rk; *(u32x4*)(nxt + 9216 + lrow * 144 + lc * 2) = rv; }
      __syncthreads();
    }
    lsum = xhalf_sum(lsum);
    const float inv = 1.f / lsum;
#pragma unroll
    for (int db = 0; db < 2; ++db)
#pragma unroll
      for (int i4 = 0; i4 < 4; ++i4) {
        const size_t o = tok * 1024 + head * 64 + 32 * db + 8 * i4 + 4 * h;
        const u32x2 gq = *(const u32x2*)(G + o);
        const float v0 = (db ? O1[4 * i4] : O0[4 * i4]) * inv, v1 = (db ? O1[4 * i4 + 1] : O0[4 * i4 + 1]) * inv;
        const float v2 = (db ? O1[4 * i4 + 2] : O0[4 * i4 + 2]) * inv, v3 = (db ? O1[4 * i4 + 3] : O0[4 * i4 + 3]) * inv;
        u32x2 w; w[0] = pack2(v0 * silu(bflo(gq[0])), v1 * silu(bfhi(gq[0]))); w[1] = pack2(v2 * silu(bflo(gq[1])), v3 * silu(bfhi(gq[1])));
        *(u32x2*)(slots + 5 * SLOT_ELEMS + o) = w;
      }
  }
}


#define XB_TMO      128
#define XB_XCNT(j)  (256  + 64 * (j))
#define XB_XSUB(j)  (1280 + 64 * (j))
#define XB_XGEN(j)  (2304 + 64 * (j))
#define XB_TOP      3328
#define XB_TOPGEN   3392
#define XCD_BAR_WORDS 3456
#define XB_SPIN_CAP (1u << 22)
#define LAS __attribute__((address_space(3)))
DI unsigned xb_ld(unsigned* p) { return __hip_atomic_load(p, __ATOMIC_RELAXED, __HIP_MEMORY_SCOPE_AGENT); }
DI unsigned xb_add(unsigned* p, unsigned v) { return __hip_atomic_fetch_add(p, v, __ATOMIC_RELAXED, __HIP_MEMORY_SCOPE_AGENT); }
DI unsigned xb_xcc_id() { return (unsigned)__builtin_amdgcn_s_getreg((3 << 11) | 20) & 0xFu; }
#define XB_SPIN(cond, bar) do { unsigned _sp = 0; while (cond) { __builtin_amdgcn_s_sleep(1); \
    if ((++_sp & 255u) == 0u) { if (xb_ld(&(bar)[XB_TMO])) break; if (_sp > XB_SPIN_CAP) { atomicAdd(&(bar)[XB_TMO], 1u); break; } } } } while (0)
struct XcdBarrier { unsigned* bar; unsigned x; volatile LAS unsigned* st; };
DI XcdBarrier xcd_barrier_post(unsigned* bar, volatile LAS unsigned* st) {
  XcdBarrier b; b.bar = bar; b.x = xb_xcc_id(); b.st = st;
  if (threadIdx.x == 0) (void)xb_add(&bar[XB_XCNT(b.x)], 1u);
  return b;
}
DI void xcd_barrier_complete(unsigned* bar, unsigned x, unsigned& nloc, unsigned& nx) {
  const unsigned G = gridDim.x * gridDim.y * gridDim.z;
  unsigned sum, cnt, mine, sp = 0u;
  for (;;) {
    sum = 0u; cnt = 0u; mine = 0u;
#pragma unroll
    for (unsigned j = 0; j < 16; ++j) { const unsigned c = xb_ld(&bar[XB_XCNT(j)]); sum += c; cnt += (c > 0u) ? 1u : 0u; mine = (j == x) ? c : mine; }
    if (sum == G) break;
    __builtin_amdgcn_s_sleep(1);
    if ((++sp & 255u) == 0u) { if (xb_ld(&bar[XB_TMO])) break; if (sp > XB_SPIN_CAP) { atomicAdd(&bar[XB_TMO], 1u); break; } }
  }
  nloc = mine > 0u ? mine : 1u; nx = cnt > 0u ? cnt : 1u;
}
DI void xcd_barrier(const XcdBarrier& b) {
  asm volatile("s_waitcnt vmcnt(0)" ::: "memory");
  __syncthreads();
  if (threadIdx.x == 0) {
    unsigned* bar = b.bar;
    __builtin_amdgcn_s_waitcnt(0);
    unsigned nloc = b.st[0], nx = b.st[1];
    if (nloc == 0u) { xcd_barrier_complete(bar, b.x, nloc, nx); b.st[0] = nloc; b.st[1] = nx; }
    const unsigned old = xb_add(&bar[XB_XSUB(b.x)], 1u);
    const unsigned gen = old / nloc;
    if (old + 1u == (gen + 1u) * nloc) {
      __builtin_amdgcn_fence(__ATOMIC_RELEASE, "agent");
      asm volatile("s_waitcnt vmcnt(0)" ::: "memory");
      const unsigned og = xb_add(&bar[XB_TOP], 1u);
      const unsigned tg = og / nx;
      if (og + 1u == (tg + 1u) * nx) xb_add(&bar[XB_TOPGEN], 1u);
      else XB_SPIN(xb_ld(&bar[XB_TOPGEN]) == tg, bar);
      __builtin_amdgcn_fence(__ATOMIC_ACQUIRE, "agent");
      xb_add(&bar[XB_XGEN(b.x)], 1u);
      asm volatile("s_waitcnt vmcnt(0)" ::: "memory");
    } else {
      XB_SPIN(xb_ld(&bar[XB_XGEN(b.x)]) == gen, bar);
      __builtin_amdgcn_fence(__ATOMIC_ACQUIRE, "agent");
      asm volatile("s_waitcnt vmcnt(0)" ::: "memory");
    }
  }
  __syncthreads();
}

#define GPTR(T, x) ((T*)(__attribute__((address_space(1))) T*)(x))
__global__ void __launch_bounds__(NT) mega(P p) {
  extern __shared__ __attribute__((aligned(16))) unsigned char lds[];
  cg::grid_group grid = cg::this_grid();
  volatile LAS unsigned* st = (volatile LAS unsigned*)(lds + LDS_BYTES - 16);
  if (threadIdx.x < 4) st[threadIdx.x] = 0u;
  __syncthreads();
  const XcdBarrier xbar = xcd_barrier_post((unsigned*)(p.ws + WS_BAR), st);
  phase0(p, lds);
  grid.sync();
  const P& p0 = p;
  for (int step = 0; step < 50; ++step) {
    const int g = step / 25, rem = step - g * 25, layer = rem / 5, sub = rem - layer * 5;
    const int kind = layer % 3, jl = layer / 3;
    const int T = g ? 16384 : 8192, Lmask = g ? 4095 : 255;
    int op = -1;
    if (layer == 4) op = (sub == 0) ? 0 : -1;
    else if (sub == 0) op = 0;
    else if (kind == 0) op = sub == 1 ? 1 : (sub == 2 ? 2 : (sub == 3 ? 3 : 4));
    else if (kind == 1) op = sub == 1 ? 5 : (sub == 2 ? 6 : (sub == 3 ? 4 : -1));
    else op = sub == 1 ? 4 : (sub == 2 ? 7 : (sub == 3 ? 4 : -1));
    if (op < 0) continue;
    P p = p0;
    { size_t zo_ = 0; asm volatile("" : "+s"(zo_)); p.ws = p0.ws + zo_; p.out = p0.out + zo_; }
    bf16_t* slots = (bf16_t*)(p.ws + WS_SLOT);
    const bf16_t* W = (const bf16_t*)(p.ws + WS_W);
    if (op == 0) {
      const float* xin = p.in[g]; float* xout = p.out + (g ? OUT_YS : OUT_YP);
      phase_norm(p, g, layer - 1, layer < 4 ? layer : -1, layer <= 1 ? xin : xout, xout, slots + SLOT_ELEMS, slots);
      if (kind == 1 && g == 1 && layer < 4) phase_cache_copy(p);
    } else if (op == 1) {
      for (int rep = 0; rep < opq(REP_GEMM); ++rep) phase_gemm<1, 0>(p, g, slots, W + (size_t)(RW_IN0 + jl * RW_STRIDE) * 1024, T, 4352, p.in[11] + jl * 6144, Lmask, slots + SLOT_ELEMS, 1, lds);
    } else if (op == 2) {
      for (int rep = 0; rep < opq(REP_SCAN); ++rep) phase_scan(p, g, jl, lds);
    } else if (op == 3) {
      phase_rwkv_combine(p, g, jl);
    } else if (op == 4) {
      const bf16_t* A; const bf16_t* Bt; int N; bf16_t* dst;
      if (sub == 1) { A = slots; Bt = W + (size_t)CV_IN * 1024; N = 4096; dst = slots + 2 * SLOT_ELEMS; }
      else {
        N = 1024; dst = slots + SLOT_ELEMS;
        if (kind == 0) { A = slots + 4 * SLOT_ELEMS; Bt = W + (size_t)(RW_OUT0 + jl * RW_STRIDE) * 1024; }
        else if (kind == 1) { A = slots + 5 * SLOT_ELEMS; Bt = W + (size_t)AT_OUT * 1024; }
        else { A = slots; Bt = W + (size_t)CV_OUT * 1024; }
      }
      for (int rep = 0; rep < opq(REP_GEMM); ++rep) phase_gemm<0, 0>(p, g, A, Bt, T, N, nullptr, 0, dst, 0, lds);
    } else if (op == 5) {
      for (int rep = 0; rep < opq(REP_GEMM); ++rep) phase_gemm<0, 1>(p, g, slots, W + (size_t)AT_IN * 1024, T, 2560, nullptr, 0, nullptr, 0, lds);
    } else if (op == 6) {
      for (int rep = 0; rep < opq(REP_ATTN); ++rep) phase_attn(p, g, lds);
    } else {
      phase_conv(p, g);
    }
    if (!(g == 1 && layer == 4)) for (int rep = 0; rep < opq(REP_SYNC); ++rep) xcd_barrier(xbar);
  }
}

extern "C" void kernel_launch(void* const* d_in, const int* in_sizes, int n_in, void* d_out, int out_size, void* d_ws, size_t ws_size, hipStream_t stream) {
  static int grid_blocks = 0;
  if (!grid_blocks) {
    int dev = 0, cus = 0, per_cu = 0;
    hipGetDevice(&dev);
    hipDeviceGetAttribute(&cus, hipDeviceAttributeMultiprocessorCount, dev);
    hipFuncSetAttribute((const void*)mega, hipFuncAttributeMaxDynamicSharedMemorySize, LDS_BYTES);
    hipOccupancyMaxActiveBlocksPerMultiprocessor(&per_cu, (const void*)mega, NT, LDS_BYTES);
    if (per_cu < 1) per_cu = 1;
    if (per_cu > 1) per_cu = 1;
    grid_blocks = cus * per_cu;
    if (ws_size < WS_SLOT + 6 * SLOT_ELEMS * 2) fprintf(stderr, "workspace too small: %zu\n", ws_size);
  }
  (void)hipMemsetAsync((unsigned char*)d_ws + WS_BAR, 0, XCD_BAR_WORDS * sizeof(unsigned), stream);
  P p{};
  for (int i = 0; i < 33; ++i) p.in[i] = (const float*)d_in[i];
  p.out = (float*)d_out; p.ws = (unsigned char*)d_ws;
  void* args[] = {&p};
  hipError_t e = hipLaunchCooperativeKernel((const void*)mega, dim3(grid_blocks), dim3(NT), args, LDS_BYTES, stream);
  if (e != hipSuccess) fprintf(stderr, "cooperative launch failed: %s (grid %d)\n", hipGetErrorString(e), grid_blocks);
}
```

```cpp
#include <hip/hip_runtime.h>
#include <hip/hip_cooperative_groups.h>
#include <cstdio>
namespace cg = cooperative_groups;

typedef unsigned short bf16_t;
using bf16x8 = __attribute__((ext_vector_type(8))) short;
using f32x16 = __attribute__((ext_vector_type(16))) float;
using u32x4 = __attribute__((ext_vector_type(4))) unsigned;
using u32x2 = __attribute__((ext_vector_type(2))) unsigned;

#define NT 512
#ifndef REP_GEMM
#define REP_GEMM 1
#endif
#ifndef REP_SCAN
#define REP_SCAN 1
#endif
#ifndef REP_ATTN
#define REP_ATTN 1
#endif
#ifndef REP_SYNC
#define REP_SYNC 1
#endif
#define DI __device__ __forceinline__
#define MFMA32(a, b, c) __builtin_amdgcn_mfma_f32_32x32x16_bf16((a), (b), (c), 0, 0, 0)

struct P { const float* in[33]; float* out; unsigned char* ws; };

constexpr size_t WS_ADA = 0;
constexpr size_t WS_ROPE = 262144;
constexpr size_t WS_BON = 327680;
constexpr size_t WS_HID = WS_BON + 2097152;
constexpr size_t WS_W = WS_HID + 8388608;
constexpr size_t WS_SLOT = WS_W + 39845888;
constexpr size_t SLOT_ELEMS = (size_t)16384 * 1024;
constexpr int RW_IN0 = 0, RW_OUT0 = 4352, RW_STRIDE = 5376, AT_IN = 10752, AT_OUT = 13312, CV_IN = 14336, CV_OUT = 18432;
constexpr size_t OUT_YP = 0, OUT_YS = 8388608, OUT_ST = 25165824, OUT_CK = 33554432, OUT_CV = 35651584;
constexpr int LDS_BYTES = 156416 + 16;
constexpr size_t WS_BAR = 278528;

typedef __bf16 bf16x2_t __attribute__((ext_vector_type(2)));
typedef float f32x2_t __attribute__((ext_vector_type(2)));
DI unsigned pack2(float a, float b) { f32x2_t v = {a, b}; return __builtin_bit_cast(unsigned, __builtin_convertvector(v, bf16x2_t)); }
DI unsigned f2bf(float x) { return (unsigned)__builtin_bit_cast(unsigned short, (__bf16)x); }
DI float bflo(unsigned u) { return __uint_as_float(u << 16); }
DI float bfhi(unsigned u) { return __uint_as_float(u & 0xffff0000u); }
DI float bf1(bf16_t u) { return __uint_as_float(((unsigned)u) << 16); }

template <int CTRL> DI float dppf(float v) { return __int_as_float(__builtin_amdgcn_update_dpp(0, __float_as_int(v), CTRL, 0xF, 0xF, true)); }
DI float reduce16(float v) { v += dppf<0xB1>(v); v += dppf<0x4E>(v); v += dppf<0x141>(v); v += dppf<0x140>(v); return v; }
DI float rdl(float v, int l) { return __int_as_float(__builtin_amdgcn_readlane(__float_as_int(v), l)); }
DI float wave_sum(float v) { v = reduce16(v); return (rdl(v, 0) + rdl(v, 16)) + (rdl(v, 32) + rdl(v, 48)); }
DI float xhalf_max(float x) { const auto r2 = __builtin_amdgcn_permlane32_swap(__float_as_uint(x), __float_as_uint(x), false, false); return fmaxf(__uint_as_float(r2[0]), __uint_as_float(r2[1])); }
DI float xhalf_sum(float x) { const auto r2 = __builtin_amdgcn_permlane32_swap(__float_as_uint(x), __float_as_uint(x), false, false); return __uint_as_float(r2[0]) + __uint_as_float(r2[1]); }
DI float quad_sum(float v) { v += dppf<0xB1>(v); v += dppf<0x4E>(v); return v; }
DI float silu(float x) { return x / (1.f + __expf(-x)); }
DI int opq(int v) { asm volatile("" : "+s"(v)); return v; }
DI int otid() { int t = threadIdx.x; asm volatile("" : "+v"(t)); return t; }

DI void conv_tiles(const float* __restrict__ src, int N, bf16_t* __restrict__ dst, float* lds) {
  const int tid = otid();
  const int tilesN = N >> 6, ntiles = 16 * tilesN;
  for (int tile = blockIdx.x; tile < ntiles; tile += gridDim.x) {
    const int kt = tile / tilesN, nt = tile - kt * tilesN, k0 = kt * 64, n0 = nt * 64;
#pragma unroll
    for (int i = 0; i < 8; ++i) { const int k = (tid >> 6) + 8 * i, n = tid & 63; lds[k * 65 + n] = src[(size_t)(k0 + k) * N + n0 + n]; }
    __syncthreads();
    { const int n = tid >> 3, kc = (tid & 7) * 8; u32x4 o;
#pragma unroll
      for (int j = 0; j < 4; ++j) o[j] = pack2(lds[(kc + 2 * j) * 65 + n], lds[(kc + 2 * j + 1) * 65 + n]);
      *(u32x4*)(dst + (size_t)(n0 + n) * 1024 + k0 + kc) = o; }
    __syncthreads();
  }
}

DI void phase0(const P& p, unsigned char* ldsb) {
  float* lds = (float*)ldsb;
  const int tid = otid();
  bf16_t* W = (bf16_t*)(p.ws + WS_W);
#pragma unroll 1
  for (int e = 0; e < opq(22); ++e) {
    const float* src; int N, drow;
    if (e < 18) {
      const int j = e / 9, q = e - j * 9;
      if (q < 4) { src = p.in[12] + (size_t)(j * 4 + q) * 1048576; N = 1024; drow = RW_IN0 + j * RW_STRIDE + q * 1024; }
      else if (q < 6) { src = p.in[14] + (size_t)(j * 2 + q - 4) * 65536; N = 64; drow = RW_IN0 + j * RW_STRIDE + 4096 + (q - 4) * 64; }
      else if (q < 8) { src = p.in[17] + (size_t)(j * 2 + q - 6) * 65536; N = 64; drow = RW_IN0 + j * RW_STRIDE + 4224 + (q - 6) * 64; }
      else { src = p.in[24] + (size_t)j * 1048576; N = 1024; drow = RW_OUT0 + j * RW_STRIDE; }
    } else if (e == 18) { src = p.in[25]; N = 2560; drow = AT_IN; }
    else if (e == 19) { src = p.in[28]; N = 1024; drow = AT_OUT; }
    else if (e == 20) { src = p.in[29]; N = 4096; drow = CV_IN; }
    else { src = p.in[32]; N = 1024; drow = CV_OUT; }
    conv_tiles(src, N, W + (size_t)drow * 1024, lds);
  }
  {
    float* scond = lds;
    float* red = lds + 5120;
    for (int e = tid; e < 5120; e += NT) { const int cnd = e >> 10, k = e & 1023; const float cv = cnd == 0 ? p.in[6][k] : p.in[5][(cnd - 1) * 1024 + k]; scond[e] = silu(cv); }
    __syncthreads();
    float* ada = (float*)(p.ws + WS_ADA);
    for (int task = blockIdx.x; task < 192; task += gridDim.x) {
      const int layer = task / 48, n0 = (task % 48) * 64, c = tid & 63, kg = tid >> 6;
      float a0 = 0.f, a1 = 0.f, a2 = 0.f, a3 = 0.f, a4 = 0.f;
      const float* wp = p.in[9] + ((size_t)layer * 1024 + kg * 128) * 3072 + n0 + c;
#pragma unroll 8
      for (int k = 0; k < 128; ++k) { const float w = wp[(size_t)k * 3072]; const int kk = kg * 128 + k;
        a0 += scond[kk] * w; a1 += scond[1024 + kk] * w; a2 += scond[2048 + kk] * w; a3 += scond[3072 + kk] * w; a4 += scond[4096 + kk] * w; }
      red[(kg * 5 + 0) * 64 + c] = a0; red[(kg * 5 + 1) * 64 + c] = a1; red[(kg * 5 + 2) * 64 + c] = a2; red[(kg * 5 + 3) * 64 + c] = a3; red[(kg * 5 + 4) * 64 + c] = a4;
      __syncthreads();
      if (tid < 320) { const int cnd = tid >> 6; float s = p.in[10][layer * 3072 + n0 + c];
#pragma unroll
        for (int q = 0; q < 8; ++q) s += red[(q * 5 + cnd) * 64 + c];
        ada[(cnd * 4 + layer) * 3072 + n0 + c] = s; }
      __syncthreads();
    }
  }
  if (blockIdx.x == gridDim.x - 1) {
    float* rope = (float*)(p.ws + WS_ROPE);
    for (int e = tid; e < 1024; e += NT) {
      const int pos = e >> 4, f = e & 15;
      double inv = 1.0; for (int q = 0; q < f; ++q) inv *= 0.5623413251903491;
      double ang = (double)pos * inv;
      const double twopi = 6.283185307179586476925286766559;
      double n = __builtin_rint(ang / twopi); double rr = ang - n * twopi;
      double r2 = rr * rr, sn = 0.0, cs = 0.0, ts = rr, tc = 1.0;
      for (int q = 0; q < 16; ++q) { cs += tc; sn += ts; tc = -tc * r2 / (double)((2 * q + 1) * (2 * q + 2)); ts = -ts * r2 / (double)((2 * q + 2) * (2 * q + 3)); }
      rope[e * 2] = (float)cs; rope[e * 2 + 1] = (float)sn;
    }
  }
}

DI void phase_norm(const P& p, int g, int lpost, int lpre, const float* __restrict__ xsrc, float* __restrict__ xdst,
                   const bf16_t* __restrict__ Mb, bf16_t* __restrict__ H) {
  const int T = g ? 16384 : 8192;
  const int tid = otid(); const int lane = tid & 63, wave = tid >> 6;
  const float* ada = (const float*)(p.ws + WS_ADA);
  float4 xn[4]; u32x2 mn[4];
  const int t0 = blockIdx.x * 8 + wave, tstep = gridDim.x * 8;
#pragma unroll
  for (int i = 0; i < 4; ++i) { xn[i] = make_float4(0.f, 0.f, 0.f, 0.f); mn[i] = (u32x2){0u, 0u}; }
  if (t0 < T) {
#pragma unroll
    for (int i = 0; i < 4; ++i) { xn[i] = *(const float4*)(xsrc + (size_t)t0 * 1024 + 256 * i + 4 * lane); if (lpost >= 0) mn[i] = *(const u32x2*)(Mb + (size_t)t0 * 1024 + 256 * i + 4 * lane); }
  }
  for (int t = t0; t < T; t += tstep) {
    const int cond = g ? 1 + (t >> 12) : 0;
    float4 x[4]; u32x2 mr[4];
#pragma unroll
    for (int i = 0; i < 4; ++i) { x[i] = xn[i]; mr[i] = mn[i]; }
    if (t + tstep < T) {
#pragma unroll
      for (int i = 0; i < 4; ++i) { xn[i] = *(const float4*)(xsrc + (size_t)(t + tstep) * 1024 + 256 * i + 4 * lane); if (lpost >= 0) mn[i] = *(const u32x2*)(Mb + (size_t)(t + tstep) * 1024 + 256 * i + 4 * lane); }
    }
    if (lpost >= 0) {
      float m[16]; float ss = 0.f;
#pragma unroll
      for (int i = 0; i < 4; ++i) { const u32x2 u = mr[i];
        m[4 * i] = bflo(u[0]); m[4 * i + 1] = bfhi(u[0]); m[4 * i + 2] = bflo(u[1]); m[4 * i + 3] = bfhi(u[1]); }
#pragma unroll
      for (int i = 0; i < 16; ++i) ss += m[i] * m[i];
      ss = wave_sum(ss);
      const float rs = rsqrtf(ss * (1.f / 1024.f) + 1e-6f);
      const float* gate = ada + (cond * 4 + lpost) * 3072 + 2048;
      const float* wpo = p.in[8] + lpost * 1024;
#pragma unroll
      for (int i = 0; i < 4; ++i) { const int c = 256 * i + 4 * lane; const float4 gt = *(const float4*)(gate + c); const float4 wv = *(const float4*)(wpo + c);
        x[i].x += gt.x * (m[4 * i] * rs * wv.x); x[i].y += gt.y * (m[4 * i + 1] * rs * wv.y); x[i].z += gt.z * (m[4 * i + 2] * rs * wv.z); x[i].w += gt.w * (m[4 * i + 3] * rs * wv.w);
        *(float4*)(xdst + (size_t)t * 1024 + c) = x[i]; }
    }
    if (lpre >= 0) {
      float ss = 0.f;
#pragma unroll
      for (int i = 0; i < 4; ++i) ss += x[i].x * x[i].x + x[i].y * x[i].y + x[i].z * x[i].z + x[i].w * x[i].w;
      ss = wave_sum(ss);
      const float rs = rsqrtf(ss * (1.f / 1024.f) + 1e-6f);
      const float* sh = ada + (cond * 4 + lpre) * 3072; const float* sc = sh + 1024; const float* wpr = p.in[7] + lpre * 1024;
#pragma unroll
      for (int i = 0; i < 4; ++i) { const int c = 256 * i + 4 * lane; const float4 s4 = *(const float4*)(sh + c); const float4 c4 = *(const float4*)(sc + c); const float4 wv = *(const float4*)(wpr + c);
        u32x2 o; o[0] = pack2(x[i].x * rs * wv.x * (1.f + c4.x) + s4.x, x[i].y * rs * wv.y * (1.f + c4.y) + s4.y);
        o[1] = pack2(x[i].z * rs * wv.z * (1.f + c4.z) + s4.z, x[i].w * rs * wv.w * (1.f + c4.w) + s4.w);
        *(u32x2*)(H + (size_t)t * 1024 + c) = o; }
    }
  }
}

DI void phase_cache_copy(const P& p) {
  bf16_t* Kb = (bf16_t*)(p.ws + WS_SLOT) + 4 * SLOT_ELEMS; bf16_t* Vt = Kb + SLOT_ELEMS / 2;
  for (int e = blockIdx.x * NT + otid(); e < 262144; e += gridDim.x * NT) {
    const int c = e & 255, pp = (e >> 8) & 255, b = e >> 16; const int kvh = c >> 6, d = c & 63;
    Kb[((size_t)b * 4352 + 4096 + pp) * 256 + c] = (bf16_t)f2bf(p.in[3][e]);
    Vt[((size_t)(b * 4 + kvh) * 64 + d) * 4352 + 4096 + pp] = (bf16_t)f2bf(p.in[4][e]);
  }
}

template <int SHIFT> DI void ld_half(const bf16_t* __restrict__ A, int t, int k, int Lmask, u32x4 (&raw)[4]) {
  raw[1] = *(const u32x4*)(A + (size_t)t * 1024 + k);
  raw[2] = *(const u32x4*)(A + (size_t)(t + 1) * 1024 + k);
  if (SHIFT) {
    raw[0] = (u32x4){0u, 0u, 0u, 0u}; raw[3] = (u32x4){0u, 0u, 0u, 0u};
    if ((t & Lmask) != 0) raw[0] = *(const u32x4*)(A + (size_t)(t - 1) * 1024 + k);
    if (((t + 1) & Lmask) != Lmask) raw[3] = *(const u32x4*)(A + (size_t)(t + 2) * 1024 + k);
  }
}
DI u32x4 mix3(const u32x4& c, const u32x4& pz, const u32x4& nz, const float* smu, int k) {
  const float4 m0 = *(const float4*)(smu + k), m1 = *(const float4*)(smu + k + 4);
  const float mu[8] = {m0.x, m0.y, m0.z, m0.w, m1.x, m1.y, m1.z, m1.w};
  u32x4 o;
#pragma unroll
  for (int i = 0; i < 4; ++i) {
    const float h0 = bflo(c[i]), h1 = bfhi(c[i]);
    const float x0 = h0 + (0.5f * (bflo(pz[i]) + bflo(nz[i])) - h0) * mu[2 * i];
    const float x1 = h1 + (0.5f * (bfhi(pz[i]) + bfhi(nz[i])) - h1) * mu[2 * i + 1];
    o[i] = pack2(x0, x1);
  }
  return o;
}
DI int swz(int row, int c) { return row * 128 + ((c ^ ((row >> 1) & 7)) << 4); }
template <int SHIFT> DI void st_half(unsigned char* base, int row, int c, const u32x4 (&raw)[4], const float* smu, int k) {
  if (!SHIFT) { *(u32x4*)(base + swz(row, c)) = raw[1]; *(u32x4*)(base + swz(row + 1, c)) = raw[2]; }
  else { *(u32x4*)(base + swz(row, c)) = mix3(raw[1], raw[0], raw[2], smu, k); *(u32x4*)(base + swz(row + 1, c)) = mix3(raw[2], raw[1], raw[3], smu, k); }
}

template <int SHIFT, int EPI>
DI void phase_gemm(const P& p, int g, const bf16_t* __restrict__ A, const bf16_t* __restrict__ Bt, int M, int N,
                   const float* __restrict__ mu, int Lmask, bf16_t* __restrict__ dst, int rw, unsigned char* lds) {
  const int tid = otid(), lane = tid & 63, wave = tid >> 6;
  const int wm = wave >> 1, wn = wave & 1, r = lane & 31, h = lane >> 5;
  const int ntn = N >> 7, ntiles = ntn * (M >> 8);
  float* Cs = (float*)lds;
  float* smu = (float*)(lds + 110592);
  for (int tile = blockIdx.x; tile < ntiles; tile += gridDim.x) {
    const int mt = tile / ntn, nt = tile - mt * ntn; const int m0 = mt * 256, n0 = nt * 128;
    f32x16 acc[2][2];
#pragma unroll
    for (int a = 0; a < 2; ++a)
#pragma unroll
      for (int b = 0; b < 2; ++b)
#pragma unroll
        for (int i = 0; i < 16; ++i) acc[a][b][i] = 0.f;
    if (SHIFT) {
      const float* mup = mu + (nt < 32 ? (nt >> 3) : (nt == 32 ? 4 : 5)) * 1024;
      smu[tid] = mup[tid]; smu[tid + 512] = mup[tid + 512];
      __syncthreads();
    }
    if (!SHIFT) {
      u32x4 s0[6], s1[6];
      const int lrow = tid >> 3, lkc = (tid & 7) * 8;
#define G_LOAD(S, K0)  { _Pragma("unroll") for (int i = 0; i < 4; ++i) S[i] = *(const u32x4*)(A + (size_t)(m0 + lrow + 64 * i) * 1024 + (K0) + lkc); \
                         _Pragma("unroll") for (int i = 0; i < 2; ++i) S[4 + i] = *(const u32x4*)(Bt + (size_t)(n0 + lrow + 64 * i) * 1024 + (K0) + lkc); }
#define G_STORE(S, BUF) { _Pragma("unroll") for (int i = 0; i < 4; ++i) *(u32x4*)((BUF) + swz(lrow + 64 * i, tid & 7)) = S[i]; \
                          _Pragma("unroll") for (int i = 0; i < 2; ++i) *(u32x4*)((BUF) + 32768 + swz(lrow + 64 * i, tid & 7)) = S[4 + i]; }
#define G_COMPUTE(BUF) { _Pragma("unroll") for (int ks = 0; ks < 4; ++ks) { const int kc_ = ks * 2 + h; \
        const bf16x8 a0 = *(const bf16x8*)((BUF) + swz(wm * 64 + r, kc_)); const bf16x8 a1 = *(const bf16x8*)((BUF) + swz(wm * 64 + 32 + r, kc_)); \
        const bf16x8 b0 = *(const bf16x8*)((BUF) + 32768 + swz(wn * 64 + r, kc_)); const bf16x8 b1 = *(const bf16x8*)((BUF) + 32768 + swz(wn * 64 + 32 + r, kc_)); \
        acc[0][0] = MFMA32(a0, b0, acc[0][0]); acc[0][1] = MFMA32(a0, b1, acc[0][1]); acc[1][0] = MFMA32(a1, b0, acc[1][0]); acc[1][1] = MFMA32(a1, b1, acc[1][1]); } }
      G_LOAD(s0, 0) G_STORE(s0, lds)
      G_LOAD(s0, 64) G_LOAD(s1, 128)
      __syncthreads();
      for (int kt = 0; kt < 16; kt += 2) {
        G_COMPUTE(lds)
        G_STORE(s0, lds + 49152)
        if (kt + 3 < 16) G_LOAD(s0, (kt + 3) * 64)
        __syncthreads();
        G_COMPUTE(lds + 49152)
        if (kt + 2 < 16) G_STORE(s1, lds)
        if (kt + 4 < 16) G_LOAD(s1, (kt + 4) * 64)
        __syncthreads();
      }
#undef G_LOAD
#undef G_STORE
#undef G_COMPUTE
    } else {
    u32x4 raw[4], raw2[4], rb[2];
    const int arow = 4 * (tid >> 3), akc = (tid & 7) * 8;
#pragma unroll
    for (int hf = 0; hf < 2; ++hf) { ld_half<SHIFT>(A, m0 + arow + 2 * hf, akc, Lmask, raw); st_half<SHIFT>(lds, arow + 2 * hf, tid & 7, raw, smu, akc); }
#pragma unroll
    for (int i = 0; i < 2; ++i) { const int id = tid + 512 * i; rb[i] = *(const u32x4*)(Bt + (size_t)(n0 + (id >> 3)) * 1024 + (id & 7) * 8); }
#pragma unroll
    for (int i = 0; i < 2; ++i) { const int id = tid + 512 * i; *(u32x4*)(lds + 32768 + swz(id >> 3, id & 7)) = rb[i]; }
    __syncthreads();
    for (int kt = 0; kt < 16; ++kt) {
      unsigned char* cur = lds + (kt & 1) * 49152; unsigned char* nxt = lds + ((kt + 1) & 1) * 49152;
      const int k1 = (kt + 1) * 64;
      if (kt < 15) {
        ld_half<SHIFT>(A, m0 + arow, k1 + akc, Lmask, raw);
        ld_half<SHIFT>(A, m0 + arow + 2, k1 + akc, Lmask, raw2);
#pragma unroll
        for (int i = 0; i < 2; ++i) { const int id = tid + 512 * i; rb[i] = *(const u32x4*)(Bt + (size_t)(n0 + (id >> 3)) * 1024 + k1 + (id & 7) * 8); }
      }
#pragma unroll
      for (int ks = 0; ks < 4; ++ks) {
        const int kc_ = ks * 2 + h;
        const bf16x8 a0 = *(const bf16x8*)(cur + swz(wm * 64 + r, kc_));
        const bf16x8 a1 = *(const bf16x8*)(cur + swz(wm * 64 + 32 + r, kc_));
        const bf16x8 b0 = *(const bf16x8*)(cur + 32768 + swz(wn * 64 + r, kc_));
        const bf16x8 b1 = *(const bf16x8*)(cur + 32768 + swz(wn * 64 + 32 + r, kc_));
        acc[0][0] = MFMA32(a0, b0, acc[0][0]); acc[0][1] = MFMA32(a0, b1, acc[0][1]);
        acc[1][0] = MFMA32(a1, b0, acc[1][0]); acc[1][1] = MFMA32(a1, b1, acc[1][1]);
      }
      if (kt < 15) {
        st_half<SHIFT>(nxt, arow, tid & 7, raw, smu, k1 + akc);
        st_half<SHIFT>(nxt, arow + 2, tid & 7, raw2, smu, k1 + akc);
#pragma unroll
        for (int i = 0; i < 2; ++i) { const int id = tid + 512 * i; *(u32x4*)(nxt + 32768 + swz(id >> 3, id & 7)) = rb[i]; }
      }
      __syncthreads();
    }
    }
#pragma unroll
    for (int mi = 0; mi < 2; ++mi)
#pragma unroll
      for (int ni = 0; ni < 2; ++ni)
#pragma unroll
        for (int i = 0; i < 16; ++i) {
          const int row = wm * 64 + mi * 32 + (i & 3) + 8 * (i >> 2) + 4 * h, col = wn * 64 + ni * 32 + r;
          Cs[row * 132 + col] = acc[mi][ni][i];
        }
    __syncthreads();
    if (EPI == 0) {
#pragma unroll
      for (int i = 0; i < 8; ++i) {
        const int id = tid + 512 * i, row = id >> 4, cc = (id & 15) * 8;
        float4 v0 = *(const float4*)(Cs + row * 132 + cc), v1 = *(const float4*)(Cs + row * 132 + cc + 4);
        if (rw && nt == 32) { v0.x = tanhf(v0.x); v0.y = tanhf(v0.y); v0.z = tanhf(v0.z); v0.w = tanhf(v0.w); v1.x = tanhf(v1.x); v1.y = tanhf(v1.y); v1.z = tanhf(v1.z); v1.w = tanhf(v1.w); }
        u32x4 o; o[0] = pack2(v0.x, v0.y); o[1] = pack2(v0.z, v0.w); o[2] = pack2(v1.x, v1.y); o[3] = pack2(v1.z, v1.w);
        if (rw && nt >= 32) *(u32x4*)((bf16_t*)(p.ws + WS_HID) + (size_t)(m0 + row) * 256 + (nt - 32) * 128 + cc) = o;
        else *(u32x4*)(dst + (size_t)(nt >> 3) * SLOT_ELEMS + (size_t)(m0 + row) * 1024 + (nt & 7) * 128 + cc) = o;
      }
    } else {
      const int row = tid & 255, hh = tid >> 8; const int t = m0 + row;
      float x[64];
#pragma unroll
      for (int q = 0; q < 16; ++q) { const float4 v = *(const float4*)(Cs + row * 132 + hh * 64 + 4 * q); x[4 * q] = v.x; x[4 * q + 1] = v.y; x[4 * q + 2] = v.z; x[4 * q + 3] = v.w; }
      bf16_t* slots = (bf16_t*)(p.ws + WS_SLOT);
      const int L = g ? 4096 : 256, Ltot = g ? 4352 : 256;
      const int b = g ? (t >> 12) : (t >> 8), s = t & (L - 1);
      if (nt < 10) {
        int vz = 0; asm volatile("" : "+v"(vz));
        const float* nw = (nt < 8 ? p.in[26] : p.in[27]) + vz;
        float ss = 0.f;
#pragma unroll
        for (int d = 0; d < 64; ++d) ss += x[d] * x[d];
        const float rs = rsqrtf(ss * (1.f / 64.f) + 1e-6f);
#pragma unroll
        for (int d = 0; d < 64; ++d) x[d] *= rs * nw[d];
        if (g == 0 && nt >= 8) {
          float* ck = p.out + OUT_CK + (size_t)t * 256 + ((nt - 8) * 2 + hh) * 64;
#pragma unroll
          for (int q = 0; q < 16; ++q) *(float4*)(ck + 4 * q) = make_float4(x[4 * q], x[4 * q + 1], x[4 * q + 2], x[4 * q + 3]);
        }
        if (g == 1) {
          const float2* rope = (const float2*)(p.ws + WS_ROPE);
          const int ri = s >> 6, ci = s & 63;
#pragma unroll
          for (int f = 0; f < 16; ++f) {
            const float2 cr = rope[ri * 16 + f]; const float x1 = x[f], x2 = x[16 + f];
            x[f] = x1 * cr.x - x2 * cr.y; x[16 + f] = x2 * cr.x + x1 * cr.y;
            const float2 cc = rope[ci * 16 + f]; const float y1 = x[32 + f], y2 = x[48 + f];
            x[32 + f] = y1 * cc.x - y2 * cc.y; x[48 + f] = y2 * cc.x + y1 * cc.y;
          }
        }
        bf16_t* dq = nt < 8 ? slots + 2 * SLOT_ELEMS + (size_t)t * 1024 + (nt * 2 + hh) * 64
                            : slots + 4 * SLOT_ELEMS + ((size_t)b * Ltot + s) * 256 + ((nt - 8) * 2 + hh) * 64;
#pragma unroll
        for (int q = 0; q < 8; ++q) { u32x4 o; o[0] = pack2(x[8 * q], x[8 * q + 1]); o[1] = pack2(x[8 * q + 2], x[8 * q + 3]); o[2] = pack2(x[8 * q + 4], x[8 * q + 5]); o[3] = pack2(x[8 * q + 6], x[8 * q + 7]); *(u32x4*)(dq + 8 * q) = o; }
      } else if (nt < 12) {
        const int kvh = (nt - 10) * 2 + hh;
        if (g == 0) {
          float* cv = p.out + OUT_CV + (size_t)t * 256 + kvh * 64;
#pragma unroll
          for (int q = 0; q < 16; ++q) *(float4*)(cv + 4 * q) = make_float4(x[4 * q], x[4 * q + 1], x[4 * q + 2], x[4 * q + 3]);
        }
        bf16_t* vt = slots + 4 * SLOT_ELEMS + SLOT_ELEMS / 2 + ((size_t)(b * 4 + kvh) * 64) * Ltot + s;
        { size_t vo = 0;
#pragma unroll
        for (int d = 0; d < 64; ++d) { vt[vo] = (bf16_t)f2bf(x[d]); vo += Ltot; asm volatile("" : "+v"(vo)); } }
      } else {
        bf16_t* dg = slots + 3 * SLOT_ELEMS + (size_t)t * 1024 + (nt - 12) * 128 + hh * 64;
#pragma unroll
        for (int q = 0; q < 8; ++q) { u32x4 o; o[0] = pack2(x[8 * q], x[8 * q + 1]); o[1] = pack2(x[8 * q + 2], x[8 * q + 3]); o[2] = pack2(x[8 * q + 4], x[8 * q + 5]); o[3] = pack2(x[8 * q + 6], x[8 * q + 7]); *(u32x4*)(dg + 8 * q) = o; }
      }
    }
    __syncthreads();
  }
}

DI u32x4 cat8(const u32x2 lo, const u32x2 hi) { u32x4 v; v[0] = lo[0]; v[1] = lo[1]; v[2] = hi[0]; v[3] = hi[1]; return v; }
DI void phase_scan(const P& p, int g, int jl, unsigned char* lds) {
  const int tid = otid(), lane = tid & 63, wave = tid >> 6, r = lane & 31, h = lane >> 5;
  const int L = g ? 4096 : 256, B = g ? 4 : 32, nsc = L >> 5;
  float* sR = (float*)lds; float* sW = sR + 2048; float* sKD = sW + 2048; float* sKK = sKD + 2048; float* sKKA = sKK + 2048;
  bf16_t* sHW = (bf16_t*)(lds + 40960); bf16_t* sHA = (bf16_t*)(lds + 45568);
  bf16_t* oAL = (bf16_t*)(lds + 50176); bf16_t* oRH = (bf16_t*)(lds + 54784); bf16_t* oBE = (bf16_t*)(lds + 59392); bf16_t* oGA = (bf16_t*)(lds + 64000);
  bf16_t* oBEt = (bf16_t*)(lds + 68608); bf16_t* oGAt = (bf16_t*)(lds + 73728); bf16_t* oUt = (bf16_t*)(lds + 78848); bf16_t* oZt = (bf16_t*)(lds + 83968);
  float* Bm = (float*)(lds + 89088); float* RHS = (float*)(lds + 93696); float* lamC = (float*)(lds + 101888); float* sP = (float*)(lds + 102144);
  unsigned char* frag = lds + 104192;
  const bf16_t* slots = (const bf16_t*)(p.ws + WS_SLOT);
  const bf16_t* Rg = slots + 1 * SLOT_ELEMS; const bf16_t* Kg = slots + 2 * SLOT_ELEMS; const bf16_t* Vg = slots + 3 * SLOT_ELEMS;
  const bf16_t* hid = (const bf16_t*)(p.ws + WS_HID);
  float* bon = (float*)(p.ws + WS_BON);
  const int ntasks = B * 32;
  for (int task = blockIdx.x; task < ntasks; task += gridDim.x) {
    const int z = task & 1, head = (task >> 1) & 15, b = task >> 5;
    bf16_t* Yg = (bf16_t*)(p.ws + WS_SLOT) + (z ? 0 : 5) * SLOT_ELEMS;
    const int mat = (wave >> 1) & 1, ntt = wave & 1;
    unsigned char* lfr = lds + 110336 + (wave & 3) * 4096;
    if (wave >= 4) {
      const float* W2 = (mat ? p.in[18] : p.in[15]) + (size_t)(jl * 2 + z) * 65536 + head * 64 + 32 * ntt + r;
#pragma unroll
      for (int kk = 0; kk < 4; ++kk) { u32x4 pk;
#pragma unroll
        for (int j = 0; j < 4; ++j) pk[j] = pack2(W2[(size_t)(16 * kk + 8 * h + 2 * j) * 1024], W2[(size_t)(16 * kk + 8 * h + 2 * j + 1) * 1024]);
        *(u32x4*)(lfr + (kk * 64 + lane) * 16) = pk; }
    }
    const float bias = (mat ? p.in[16] : p.in[13])[(jl * 2 + z) * 1024 + head * 64 + 32 * ntt + r];
    const float kkc = p.in[19][jl * 1024 + head * 64 + lane], kac = p.in[20][jl * 1024 + head * 64 + lane], rkc = p.in[21][jl * 1024 + head * 64 + lane];
    f32x16 st0, st1;
#pragma unroll
    for (int q = 0; q < 16; ++q) { st0[q] = 0.f; st1[q] = 0.f; }
    const size_t stbase = ((((size_t)(b * 2 + jl) * 2 + z) * 16 + head) * 64 + (32 * (wave & 1) + r)) * 64;
    if (g && wave < 2) {
#pragma unroll
      for (int gq = 0; gq < 4; ++gq) {
        const float4 s0 = *(const float4*)(p.in[2] + stbase + 8 * gq + 4 * h), s1 = *(const float4*)(p.in[2] + stbase + 32 + 8 * gq + 4 * h);
        st0[4 * gq] = s0.x; st0[4 * gq + 1] = s0.y; st0[4 * gq + 2] = s0.z; st0[4 * gq + 3] = s0.w;
        st1[4 * gq] = s1.x; st1[4 * gq + 1] = s1.y; st1[4 * gq + 2] = s1.z; st1[4 * gq + 3] = s1.w;
      }
    }
    u32x4 pre[5];
    const int ht = tid - 256;
#define SCAN_LOAD(sc_)                                                                                    \
    { const int ht2 = otid() - 256;                                                                       \
    _Pragma("unroll") for (int i = 0; i < 5; ++i) {                                                       \
      const int id = ht2 + 256 * i;                                                                       \
      const int arr = id >> 8, s = (id >> 3) & 31, cc = (id & 7) * 8;                                     \
      const int tl = z ? (L - 1 - ((sc_) * 32 + s)) : ((sc_) * 32 + s);                                   \
      const size_t tok = (size_t)b * L + tl;                                                              \
      if (arr < 3) pre[i] = *(const u32x4*)((arr == 0 ? Rg : (arr == 1 ? Kg : Vg)) + tok * 1024 + head * 64 + cc); \
      else pre[i] = *(const u32x4*)(hid + tok * 256 + (arr - 3) * 128 + z * 64 + cc);                     \
    } }
#define NQ(t_) ((((t_) + 3) / 4 + 1) / 2)
#define SOLVE_ROWS(T0, T1)                                                                                \
    _Pragma("unroll") for (int t = (T0); t < (T1); ++t) {                                                 \
      if (t + 2 < 32) {                                                                                   \
        n2rhs = RHo[(t + 2) * 64];                                                                        \
        _Pragma("unroll") for (int q = 0; q < NQ(t + 2); ++q) { const f4v q4 = *(const __attribute__((address_space(3))) f4v*)(Bmo + (t + 2) * 36 + 8 * q); nc8[q] = make_float4(q4[0], q4[1], q4[2], q4[3]); } \
      }                                                                                                   \
      float a0s = crhs * mh, a1s = 0.f;                                                                   \
      _Pragma("unroll") for (int q = 0; q < NQ(t); ++q) {                                                 \
        a0s -= cb[q].x * zv[4 * q]; a1s -= cb[q].y * zv[4 * q + 1]; a0s -= cb[q].z * zv[4 * q + 2]; a1s -= cb[q].w * zv[4 * q + 3]; } \
      float zt = xhalf_sum(a0s + a1s);                                                                    \
      asm volatile("" : "+v"(zt) :: "memory");                                                            \
      zv[4 * (t >> 3) + (t & 3)] = ((((t >> 2) & 1) == h)) ? zt : zv[4 * (t >> 3) + (t & 3)];             \
      crhs = nrhs; nrhs = n2rhs;                                                                          \
      _Pragma("unroll") for (int q = 0; q < 4; ++q) { cb[q] = nb8[q]; nb8[q] = nc8[q]; }                  \
    }
    typedef float f4v __attribute__((ext_vector_type(4)));
    if (wave >= 4) { SCAN_LOAD(0) }
    for (int sc = -1; sc < nsc; ++sc) {
      const bool st_on = sc >= 0, hl_on = sc + 1 < nsc;
      bf16_t* oUc = (bf16_t*)(lds + ((sc & 1) ? 126720 : 78848));
      bf16_t* oUn = (bf16_t*)(lds + ((sc & 1) ? 78848 : 126720));
      f32x16 y0;
      const int vloc = 32 * (wave & 1) + r;
      if (st_on) {
      {
        const int k = lane, tq = wave;
        float wq[4];
#pragma unroll
        for (int j = 0; j < 4; ++j) wq[j] = sW[(4 * tq + j) * 64 + k];
        sP[tq * 64 + k] = (wq[0] * wq[1]) * (wq[2] * wq[3]);
        __syncthreads();
        float lam = 1.f;
#pragma unroll
        for (int q = 0; q < 7; ++q) { const float pq = sP[q * 64 + k]; lam *= (q < tq) ? pq : 1.f; }
        u32x2 bt, gt; float nb[4], gg[4];
#pragma unroll
        for (int j = 0; j < 4; ++j) {
          const int t = 4 * tq + j;
          const float lamp = lam; lam = lamp * wq[j];
          const float inv = __builtin_amdgcn_rcpf(lam);
          const float al = lamp * sKK[t * 64 + k], be = sKKA[t * 64 + k] * inv, ga = sKD[t * 64 + k] * inv, rh = lam * sR[t * 64 + k];
          oAL[t * 72 + k] = (bf16_t)f2bf(al); oRH[t * 72 + k] = (bf16_t)f2bf(rh); oBE[t * 72 + k] = (bf16_t)f2bf(be); oGA[t * 72 + k] = (bf16_t)f2bf(ga);
          nb[j] = -be; gg[j] = ga;
        }
        bt[0] = pack2(nb[0], nb[1]); bt[1] = pack2(nb[2], nb[3]); gt[0] = pack2(gg[0], gg[1]); gt[1] = pack2(gg[2], gg[3]);
        *(u32x2*)(oBEt + k * 40 + 4 * tq) = bt; *(u32x2*)(oGAt + k * 40 + 4 * tq) = gt;
        if (tq == 7) lamC[k] = lam;
      }
      __syncthreads();
      {
      const int tid = otid(), lane = tid & 63, wave = tid >> 6, r = lane & 31, h = lane >> 5; (void)r; (void)h; (void)lane; (void)wave;
      if (wave < 4) {
        const bf16_t* As = (wave & 1) ? oGA : oBE; const bf16_t* Bs = (wave < 2) ? oAL : oRH;
        f32x16 x;
#pragma unroll
        for (int q = 0; q < 16; ++q) x[q] = 0.f;
#pragma unroll
        for (int s = 0; s < 4; ++s) { const bf16x8 a = *(const bf16x8*)(As + r * 72 + 16 * s + 8 * h); const bf16x8 bb = *(const bf16x8*)(Bs + r * 72 + 16 * s + 8 * h); x = MFMA32(a, bb, x); }
#pragma unroll
        for (int q = 0; q < 16; ++q) { const int i = (q & 3) + 8 * (q >> 2) + 4 * h; const bool keep = (wave < 2) ? (i < r) : (i <= r); x[q] = keep ? x[q] : 0.f; }
        if (wave == 0) {
#pragma unroll
          for (int gq = 0; gq < 4; ++gq) *(float4*)(Bm + r * 36 + 8 * gq + 4 * h) = make_float4(x[4 * gq], x[4 * gq + 1], x[4 * gq + 2], x[4 * gq + 3]);
        } else {
          const float sg = (wave == 2) ? -1.f : 1.f;
#pragma unroll
          for (int s = 0; s < 2; ++s) { u32x4 pk;
#pragma unroll
            for (int j = 0; j < 4; ++j) pk[j] = pack2(sg * x[8 * s + 2 * j], sg * x[8 * s + 2 * j + 1]);
            *(u32x4*)(frag + (((wave - 1) * 2 + s) * 64 + lane) * 16) = pk; }
        }
      }
      }
      __syncthreads();
      if (wave < 2) {
        f32x16 a0;
#pragma unroll
        for (int q = 0; q < 16; ++q) a0[q] = 0.f;
#pragma unroll
        for (int kb = 0; kb < 2; ++kb)
#pragma unroll
          for (int s = 0; s < 2; ++s) {
            u32x4 pk;
#pragma unroll
            for (int j = 0; j < 4; ++j) pk[j] = kb ? pack2(st1[8 * s + 2 * j], st1[8 * s + 2 * j + 1]) : pack2(st0[8 * s + 2 * j], st0[8 * s + 2 * j + 1]);
            const bf16x8 sf = __builtin_bit_cast(bf16x8, pk);
            const int ko = 32 * kb + 16 * s + 4 * h;
            const u32x4 aa = cat8(*(const u32x2*)(oAL + r * 72 + ko), *(const u32x2*)(oAL + r * 72 + ko + 8));
            a0 = MFMA32(__builtin_bit_cast(bf16x8, aa), sf, a0);
          }
#pragma unroll
        for (int s = 0; s < 2; ++s) {
          const bf16x8 fg = *(const bf16x8*)(frag + ((0 * 2 + s) * 64 + lane) * 16);
          const u32x4 ub = cat8(*(const u32x2*)(oUc + vloc * 40 + 16 * s + 4 * h), *(const u32x2*)(oUc + vloc * 40 + 16 * s + 4 * h + 8));
          a0 = MFMA32(fg, __builtin_bit_cast(bf16x8, ub), a0);
        }
#pragma unroll
        for (int q = 0; q < 16; ++q) RHS[((q & 3) + 8 * (q >> 2) + 4 * h) * 64 + vloc] = a0[q];
        float* park = (float*)(lds + 131840) + wave * 3072 + lane * 4;
#pragma unroll
        for (int gq = 0; gq < 4; ++gq) {
          *(float4*)(park + gq * 256) = make_float4(st0[4 * gq], st0[4 * gq + 1], st0[4 * gq + 2], st0[4 * gq + 3]);
          *(float4*)(park + 1024 + gq * 256) = make_float4(st1[4 * gq], st1[4 * gq + 1], st1[4 * gq + 2], st1[4 * gq + 3]);
        }
      }
      }
      float zv[16]; float4 cb[4], nb8[4], nc8[4]; float crhs = 0.f, nrhs = 0.f, n2rhs = 0.f;
      const float mh = h ? 0.f : 1.f;
#pragma unroll
      for (int t = 0; t < 16; ++t) zv[t] = 0.f;
#pragma unroll
      for (int q = 0; q < 4; ++q) { cb[q] = make_float4(0.f, 0.f, 0.f, 0.f); nb8[q] = make_float4(0.f, 0.f, 0.f, 0.f); nc8[q] = make_float4(0.f, 0.f, 0.f, 0.f); }
      const __attribute__((address_space(3))) float* Bmo = (const __attribute__((address_space(3))) float*)(unsigned)(unsigned long long)(Bm + 4 * h);
      const __attribute__((address_space(3))) float* RHo = (const __attribute__((address_space(3))) float*)(unsigned)(unsigned long long)(RHS + vloc);
      asm volatile("" : "+v"(Bmo), "+v"(RHo));
      if (wave < 2 && st_on) { crhs = RHo[0]; nrhs = RHo[64]; const f4v q4 = *(const __attribute__((address_space(3))) f4v*)(Bmo + 36); nb8[0] = make_float4(q4[0], q4[1], q4[2], q4[3]); }
      if (wave < 2) { if (st_on) { SOLVE_ROWS(0, 6) } }
      else if (wave >= 4 && hl_on) {
#pragma unroll
        for (int i = 0; i < 5; ++i) {
          const int id = ht + 256 * i; const int arr = id >> 8, s = (id >> 3) & 31, cc = (id & 7) * 8;
          const u32x4 u = pre[i];
          if (arr < 2) { float* d = (arr == 0 ? sR : sKD) + s * 64 + cc;
            *(float4*)d = make_float4(bflo(u[0]), bfhi(u[0]), bflo(u[1]), bfhi(u[1])); *(float4*)(d + 4) = make_float4(bflo(u[2]), bfhi(u[2]), bflo(u[3]), bfhi(u[3])); }
          else if (arr == 2) {
#pragma unroll
            for (int j = 0; j < 4; ++j) { oUn[(cc + 2 * j) * 40 + s] = (bf16_t)(u[j] & 0xffffu); oUn[(cc + 2 * j + 1) * 40 + s] = (bf16_t)(u[j] >> 16); }
          } else *(u32x4*)((arr == 3 ? sHW : sHA) + s * 72 + cc) = u;
        }
        if (sc + 2 < nsc) { SCAN_LOAD(sc + 2) }
      }
      __syncthreads();
      if (wave < 2) { if (st_on) { SOLVE_ROWS(6, 24) } }
      else if (wave < 4) { if (st_on) {
        const float* park = (const float*)(lds + 131840) + (wave - 2) * 3072 + lane * 4;
#pragma unroll
        for (int gq = 0; gq < 4; ++gq) {
          const float4 a = *(const float4*)(park + gq * 256), bq = *(const float4*)(park + 1024 + gq * 256);
          st0[4 * gq] = a.x; st0[4 * gq + 1] = a.y; st0[4 * gq + 2] = a.z; st0[4 * gq + 3] = a.w;
          st1[4 * gq] = bq.x; st1[4 * gq + 1] = bq.y; st1[4 * gq + 2] = bq.z; st1[4 * gq + 3] = bq.w;
        }
#pragma unroll
        for (int q = 0; q < 16; ++q) y0[q] = 0.f;
#pragma unroll
        for (int kb = 0; kb < 2; ++kb)
#pragma unroll
          for (int s = 0; s < 2; ++s) {
            u32x4 pk;
#pragma unroll
            for (int j = 0; j < 4; ++j) pk[j] = kb ? pack2(st1[8 * s + 2 * j], st1[8 * s + 2 * j + 1]) : pack2(st0[8 * s + 2 * j], st0[8 * s + 2 * j + 1]);
            const int ko = 32 * kb + 16 * s + 4 * h;
            const u32x4 ar = cat8(*(const u32x2*)(oRH + r * 72 + ko), *(const u32x2*)(oRH + r * 72 + ko + 8));
            y0 = MFMA32(__builtin_bit_cast(bf16x8, ar), __builtin_bit_cast(bf16x8, pk), y0);
          }
#pragma unroll
        for (int s = 0; s < 2; ++s) {
          const bf16x8 fpg = *(const bf16x8*)(frag + ((2 * 2 + s) * 64 + lane) * 16);
          const u32x4 ub = cat8(*(const u32x2*)(oUc + vloc * 40 + 16 * s + 4 * h), *(const u32x2*)(oUc + vloc * 40 + 16 * s + 4 * h + 8));
          y0 = MFMA32(fpg, __builtin_bit_cast(bf16x8, ub), y0);
        }
      } }
      else if (wave >= 4 && hl_on) {
        f32x16 acc;
#pragma unroll
        for (int i = 0; i < 16; ++i) acc[i] = 0.f;
        const bf16_t* sH = mat ? sHA : sHW;
#pragma unroll
        for (int kk = 0; kk < 4; ++kk) { const bf16x8 a = *(const bf16x8*)(sH + r * 72 + 16 * kk + 8 * h); const bf16x8 bw = *(const bf16x8*)(lfr + (kk * 64 + lane) * 16); acc = MFMA32(a, bw, acc); }
#pragma unroll
        for (int i = 0; i < 16; ++i) {
          const int srow = (i & 3) + 8 * (i >> 2) + 4 * h, c = 32 * ntt + r;
          const float xv = acc[i] + bias;
          const float sg = __builtin_amdgcn_rcpf(1.f + __expf(-xv));
          if (mat == 0) sW[srow * 64 + c] = __expf(-0.60653065971263342f * sg);
          else sKKA[srow * 64 + c] = sg;
        }
      }
      __syncthreads();
      if (wave < 2) { if (st_on) {
        SOLVE_ROWS(24, 32)
#pragma unroll
        for (int q = 0; q < 4; ++q) { u32x2 o; o[0] = pack2(zv[4 * q], zv[4 * q + 1]); o[1] = pack2(zv[4 * q + 2], zv[4 * q + 3]);
          *(u32x2*)(oZt + vloc * 40 + 4 * (2 * q + h)) = o; }
        } }
      else if (wave >= 4 && hl_on) {
#pragma unroll
        for (int i = 0; i < 8; ++i) {
          const int s = (wave - 4) + 4 * i; const int c = lane;
          const float kraw = sKD[s * 64 + c], a = sKKA[s * 64 + c], rr = sR[s * 64 + c];
          const float pk = kraw * kkc; const float ss = wave_sum(pk * pk);
          const float kk = pk * rsqrtf(fmaxf(ss, 1e-24f));
          const float kd = kraw * (1.f + (a - 1.f) * kac);
          const float bs = wave_sum(rr * kd * rkc);
          sKD[s * 64 + c] = kd; sKK[s * 64 + c] = kk; sKKA[s * 64 + c] = kk * a;
          if (c == 0) { const int tl = z ? (L - 1 - ((sc + 1) * 32 + s)) : ((sc + 1) * 32 + s); bon[(((size_t)b * L + tl) * 16 + head) * 2 + z] = bs; }
        }
      }
      __syncthreads();
      if (st_on) {
      {
      const int tid = otid(), lane = tid & 63, wave = tid >> 6, r = lane & 31, h = lane >> 5; (void)r; (void)h; (void)lane; (void)wave;
      if (wave < 2) {
        { const float* park = (const float*)(lds + 131840) + wave * 3072 + lane * 4;
#pragma unroll
          for (int gq = 0; gq < 4; ++gq) {
            const float4 a = *(const float4*)(park + gq * 256), bq = *(const float4*)(park + 1024 + gq * 256);
            st0[4 * gq] = a.x; st0[4 * gq + 1] = a.y; st0[4 * gq + 2] = a.z; st0[4 * gq + 3] = a.w;
            st1[4 * gq] = bq.x; st1[4 * gq + 1] = bq.y; st1[4 * gq + 2] = bq.z; st1[4 * gq + 3] = bq.w;
          } }
#pragma unroll
        for (int s = 0; s < 2; ++s) {
          const bf16x8 ub = *(const bf16x8*)(oUc + vloc * 40 + 16 * s + 8 * h), zb = *(const bf16x8*)(oZt + vloc * 40 + 16 * s + 8 * h);
          const bf16x8 g0 = *(const bf16x8*)(oGAt + r * 40 + 16 * s + 8 * h), g1 = *(const bf16x8*)(oGAt + (32 + r) * 40 + 16 * s + 8 * h);
          const bf16x8 b0 = *(const bf16x8*)(oBEt + r * 40 + 16 * s + 8 * h), b1 = *(const bf16x8*)(oBEt + (32 + r) * 40 + 16 * s + 8 * h);
          st0 = MFMA32(g0, ub, st0); st0 = MFMA32(b0, zb, st0);
          st1 = MFMA32(g1, ub, st1); st1 = MFMA32(b1, zb, st1);
        }
#pragma unroll
        for (int gq = 0; gq < 4; ++gq) {
          const float4 l0 = *(const float4*)(lamC + 8 * gq + 4 * h), l1 = *(const float4*)(lamC + 32 + 8 * gq + 4 * h);
          st0[4 * gq] *= l0.x; st0[4 * gq + 1] *= l0.y; st0[4 * gq + 2] *= l0.z; st0[4 * gq + 3] *= l0.w;
          st1[4 * gq] *= l1.x; st1[4 * gq + 1] *= l1.y; st1[4 * gq + 2] *= l1.z; st1[4 * gq + 3] *= l1.w;
        }
      } else if (wave < 4) {
#pragma unroll
        for (int s = 0; s < 2; ++s) {
          const bf16x8 fpb = *(const bf16x8*)(frag + ((1 * 2 + s) * 64 + lane) * 16);
          const u32x4 z8 = cat8(*(const u32x2*)(oZt + vloc * 40 + 16 * s + 4 * h), *(const u32x2*)(oZt + vloc * 40 + 16 * s + 4 * h + 8));
          y0 = MFMA32(fpb, __builtin_bit_cast(bf16x8, z8), y0);
        }
#pragma unroll
        for (int q = 0; q < 16; ++q) {
          const int t = (q & 3) + 8 * (q >> 2) + 4 * h; const int tl = z ? (L - 1 - (sc * 32 + t)) : (sc * 32 + t);
          Yg[((size_t)b * L + tl) * 1024 + head * 64 + vloc] = (bf16_t)f2bf(y0[q]);
        }
      }
      }
      __syncthreads();
      }
    }
#undef SOLVE_ROWS
#undef SCAN_LOAD
    if (g == 0 && wave < 2) {
#pragma unroll
      for (int gq = 0; gq < 4; ++gq) {
        *(float4*)(p.out + OUT_ST + stbase + 8 * gq + 4 * h) = make_float4(st0[4 * gq], st0[4 * gq + 1], st0[4 * gq + 2], st0[4 * gq + 3]);
        *(float4*)(p.out + OUT_ST + stbase + 32 + 8 * gq + 4 * h) = make_float4(st1[4 * gq], st1[4 * gq + 1], st1[4 * gq + 2], st1[4 * gq + 3]);
      }
    }
    __syncthreads();
  }
}

DI void phase_rwkv_combine(const P& p, int g, int jl) {
  const int T = g ? 16384 : 8192;
  const int tid = otid(); const int lane = tid & 63, wave = tid >> 6;
  bf16_t* slots = (bf16_t*)(p.ws + WS_SLOT);
  const float* bon = (const float*)(p.ws + WS_BON);
  for (int t = blockIdx.x * 8 + wave; t < T; t += gridDim.x * 8) {
    const size_t o = (size_t)t * 1024 + 16 * lane; const int head = lane >> 2;
    float y[16], v[16], gg[16];
#pragma unroll
    for (int q = 0; q < 2; ++q) {
      const u32x4 a = *(const u32x4*)(slots + 5 * SLOT_ELEMS + o + 8 * q), bq = *(const u32x4*)(slots + 0 * SLOT_ELEMS + o + 8 * q);
      const u32x4 vq = *(const u32x4*)(slots + 3 * SLOT_ELEMS + o + 8 * q), gq = *(const u32x4*)(slots + 4 * SLOT_ELEMS + o + 8 * q);
#pragma unroll
      for (int i = 0; i < 4; ++i) { y[8 * q + 2 * i] = bflo(a[i]) + bflo(bq[i]); y[8 * q + 2 * i + 1] = bfhi(a[i]) + bfhi(bq[i]);
        v[8 * q + 2 * i] = bflo(vq[i]); v[8 * q + 2 * i + 1] = bfhi(vq[i]); gg[8 * q + 2 * i] = bflo(gq[i]); gg[8 * q + 2 * i + 1] = bfhi(gq[i]); }
    }
    float s = 0.f;
#pragma unroll
    for (int i = 0; i < 16; ++i) s += y[i];
    const float mean = quad_sum(s) * (1.f / 64.f);
    float vs = 0.f;
#pragma unroll
    for (int i = 0; i < 16; ++i) { const float d = y[i] - mean; vs += d * d; }
    const float rstd = rsqrtf(quad_sum(vs) * (1.f / 64.f) + 64e-5f);
    const float bs = bon[((size_t)t * 16 + head) * 2] + bon[((size_t)t * 16 + head) * 2 + 1];
    const float* gw = p.in[22] + jl * 1024 + 16 * lane; const float* gb = p.in[23] + jl * 1024 + 16 * lane;
    float ov[16];
#pragma unroll
    for (int i = 0; i < 16; ++i) ov[i] = ((y[i] - mean) * rstd * gw[i] + gb[i] + bs * v[i]) * silu(gg[i]);
#pragma unroll
    for (int q = 0; q < 2; ++q) { u32x4 w; w[0] = pack2(ov[8 * q], ov[8 * q + 1]); w[1] = pack2(ov[8 * q + 2], ov[8 * q + 3]); w[2] = pack2(ov[8 * q + 4], ov[8 * q + 5]); w[3] = pack2(ov[8 * q + 6], ov[8 * q + 7]);
      *(u32x4*)(slots + 4 * SLOT_ELEMS + o + 8 * q) = w; }
  }
}

DI void phase_conv(const P& p, int g) {
  const int T = g ? 16384 : 8192, Lmask = g ? 4095 : 255;
  bf16_t* slots = (bf16_t*)(p.ws + WS_SLOT);
  const bf16_t* BG = slots + 2 * SLOT_ELEMS; const bf16_t* CG = slots + 3 * SLOT_ELEMS; const bf16_t* U = slots + 4 * SLOT_ELEMS; const bf16_t* G = slots + 5 * SLOT_ELEMS;
  bf16_t* O = slots;
  for (int e = blockIdx.x * NT + otid(); e < T * 128; e += gridDim.x * NT) {
    const int t = e >> 7, c = (e & 127) * 8; const size_t o = (size_t)t * 1024 + c; const int tl = t & Lmask;
    const u32x4 zz = {0u, 0u, 0u, 0u};
    const u32x4 c1 = *(const u32x4*)(CG + o), u1 = *(const u32x4*)(U + o);
    const u32x4 c0 = tl != 0 ? *(const u32x4*)(CG + o - 1024) : zz, u0 = tl != 0 ? *(const u32x4*)(U + o - 1024) : zz;
    const u32x4 c2 = tl != Lmask ? *(const u32x4*)(CG + o + 1024) : zz, u2 = tl != Lmask ? *(const u32x4*)(U + o + 1024) : zz;
    const u32x4 bg = *(const u32x4*)(BG + o), gg = *(const u32x4*)(G + o);
    const float* cw = p.in[30]; const float* cb = p.in[31];
    u32x4 w;
#pragma unroll
    for (int i = 0; i < 4; ++i) {
      const int ch = c + 2 * i;
      const float lo = bflo(bg[i]) * (cw[ch] * bflo(c0[i]) * bflo(u0[i]) + cw[1024 + ch] * bflo(c1[i]) * bflo(u1[i]) + cw[2048 + ch] * bflo(c2[i]) * bflo(u2[i]) + cb[ch]) * silu(bflo(gg[i]));
      const float hi = bfhi(bg[i]) * (cw[ch + 1] * bfhi(c0[i]) * bfhi(u0[i]) + cw[1024 + ch + 1] * bfhi(c1[i]) * bfhi(u1[i]) + cw[2048 + ch + 1] * bfhi(c2[i]) * bfhi(u2[i]) + cb[ch + 1]) * silu(bfhi(gg[i]));
      w[i] = pack2(lo, hi);
    }
    *(u32x4*)(O + o) = w;
  }
}

DI void phase_attn(const P& p, int g, unsigned char* lds) {
  const int tid = otid(), lane = tid & 63, wave = tid >> 6, r = lane & 31, h = lane >> 5;
  const int L = g ? 4096 : 256, Ltot = g ? 4352 : 256, B = g ? 4 : 32;
  const int nq = L >> 6, ntasks = B * 4 * nq, nkt = Ltot >> 6;
  bf16_t* slots = (bf16_t*)(p.ws + WS_SLOT);
  bf16_t* Q = slots + 2 * SLOT_ELEMS; const bf16_t* G = slots + 3 * SLOT_ELEMS;
  const bf16_t* Kb = slots + 4 * SLOT_ELEMS; const bf16_t* Vt = Kb + SLOT_ELEMS / 2;
  const float SC = 0.125f * 1.4426950408889634f;
  for (int task = blockIdx.x; task < ntasks; task += gridDim.x) {
    const int qt = task % nq, kvh = (task / nq) & 3, b = task / (nq * 4);
    const int head = kvh * 4 + (wave >> 1); const int q0 = qt * 64 + (wave & 1) * 32;
    const size_t tok = (size_t)b * L + q0 + r;
    bf16x8 qf[4];
#pragma unroll
    for (int ds = 0; ds < 4; ++ds) qf[ds] = *(const bf16x8*)(Q + tok * 1024 + head * 64 + ds * 16 + h * 8);
    float m = -1e30f, lsum = 0.f;
    f32x16 O0, O1;
#pragma unroll
    for (int i = 0; i < 16; ++i) { O0[i] = 0.f; O1[i] = 0.f; }
    const int lrow = tid >> 3, lc = (tid & 7) * 8;
    const bf16_t* gK = Kb + ((size_t)b * Ltot + lrow) * 256 + kvh * 64 + lc;
    const bf16_t* gV = Vt + ((size_t)(b * 4 + kvh) * 64 + lrow) * Ltot + lc;
    u32x4 rk = *(const u32x4*)gK, rv = *(const u32x4*)gV;
    *(u32x4*)(lds + lrow * 144 + lc * 2) = rk; *(u32x4*)(lds + 9216 + lrow * 144 + lc * 2) = rv;
    __syncthreads();
    for (int kt = 0; kt < nkt; ++kt) {
      const unsigned char* cur = lds + (kt & 1) * 18432; unsigned char* nxt = lds + ((kt + 1) & 1) * 18432;
      if (kt + 1 < nkt) { rk = *(const u32x4*)(gK + (size_t)(kt + 1) * 64 * 256); rv = *(const u32x4*)(gV + (kt + 1) * 64); }
      f32x16 s0, s1;
#pragma unroll
      for (int i = 0; i < 16; ++i) { s0[i] = 0.f; s1[i] = 0.f; }
#pragma unroll
      for (int ds = 0; ds < 4; ++ds) {
        const bf16x8 a0 = *(const bf16x8*)(cur + r * 144 + (ds * 16 + h * 8) * 2);
        const bf16x8 a1 = *(const bf16x8*)(cur + (32 + r) * 144 + (ds * 16 + h * 8) * 2);
        s0 = MFMA32(a0, qf[ds], s0); s1 = MFMA32(a1, qf[ds], s1);
      }
      float tmax = s0[0];
#pragma unroll
      for (int i = 1; i < 16; ++i) tmax = fmaxf(tmax, s0[i]);
#pragma unroll
      for (int i = 0; i < 16; ++i) tmax = fmaxf(tmax, s1[i]);
      tmax = xhalf_max(tmax);
      const float mnew = fmaxf(m, tmax * SC);
      const float alpha = __builtin_amdgcn_exp2f(m - mnew);
      float ps = 0.f;
#pragma unroll
      for (int i = 0; i < 16; ++i) { s0[i] = __builtin_amdgcn_exp2f(s0[i] * SC - mnew); s1[i] = __builtin_amdgcn_exp2f(s1[i] * SC - mnew); ps += s0[i] + s1[i]; }
      lsum = lsum * alpha + ps; m = mnew;
#pragma unroll
      for (int i = 0; i < 16; ++i) { O0[i] *= alpha; O1[i] *= alpha; }
      const unsigned char* vs = cur + 9216;
#pragma unroll
      for (int kb = 0; kb < 2; ++kb)
#pragma unroll
        for (int s = 0; s < 2; ++s) {
          u32x4 pk;
#pragma unroll
          for (int j = 0; j < 4; ++j) pk[j] = kb ? pack2(s1[8 * s + 2 * j], s1[8 * s + 2 * j + 1]) : pack2(s0[8 * s + 2 * j], s0[8 * s + 2 * j + 1]);
          const bf16x8 pf = __builtin_bit_cast(bf16x8, pk);
          const int ko = (32 * kb + 16 * s + 4 * h) * 2;
          { const u32x2 lo = *(const u32x2*)(vs + r * 144 + ko), hi = *(const u32x2*)(vs + r * 144 + ko + 16);
            u32x4 av; av[0] = lo[0]; av[1] = lo[1]; av[2] = hi[0]; av[3] = hi[1];
            O0 = MFMA32(__builtin_bit_cast(bf16x8, av), pf, O0); }
          { const u32x2 lo = *(const u32x2*)(vs + (32 + r) * 144 + ko), hi = *(const u32x2*)(vs + (32 + r) * 144 + ko + 16);
            u32x4 av; av[0] = lo[0]; av[1] = lo[1]; av[2] = hi[0]; av[3] = hi[1];
            O1 = MFMA32(__builtin_bit_cast(bf16x8, av), pf, O1); }
        }
      if (kt + 1 < nkt) { *(u32x4*)(nxt + lrow * 144 + lc * 2) = rk; *(u32x4*)(nxt + 9216 + lrow * 144 + lc * 2) = rv; }
      __syncthreads();
    }
    lsum = xhalf_sum(lsum);
    const float inv = 1.f / lsum;
#pragma unroll
    for (int db = 0; db < 2; ++db)
#pragma unroll
      for (int i4 = 0; i4 < 4; ++i4) {
        const size_t o = tok * 1024 + head * 64 + 32 * db + 8 * i4 + 4 * h;
        const u32x2 gq = *(const u32x2*)(G + o);
        const float v0 = (db ? O1[4 * i4] : O0[4 * i4]) * inv, v1 = (db ? O1[4 * i4 + 1] : O0[4 * i4 + 1]) * inv;
        const float v2 = (db ? O1[4 * i4 + 2] : O0[4 * i4 + 2]) * inv, v3 = (db ? O1[4 * i4 + 3] : O0[4 * i4 + 3]) * inv;
        u32x2 w; w[0] = pack2(v0 * silu(bflo(gq[0])), v1 * silu(bfhi(gq[0]))); w[1] = pack2(v2 * silu(bflo(gq[1])), v3 * silu(bfhi(gq[1])));
        *(u32x2*)(slots + 5 * SLOT_ELEMS + o) = w;
      }
  }
}


#define XB_TMO      128
#define XB_XCNT(j)  (256  + 64 * (j))
#define XB_XSUB(j)  (1280 + 64 * (j))
#define XB_XGEN(j)  (2304 + 64 * (j))
#define XB_TOP      3328
#define XB_TOPGEN   3392
#define XCD_BAR_WORDS 3456
#define XB_SPIN_CAP (1u << 22)
#define LAS __attribute__((address_space(3)))
DI unsigned xb_ld(unsigned* p) { return __hip_atomic_load(p, __ATOMIC_RELAXED, __HIP_MEMORY_SCOPE_AGENT); }
DI unsigned xb_add(unsigned* p, unsigned v) { return __hip_atomic_fetch_add(p, v, __ATOMIC_RELAXED, __HIP_MEMORY_SCOPE_AGENT); }
DI unsigned xb_xcc_id() { return (unsigned)__builtin_amdgcn_s_getreg((3 << 11) | 20) & 0xFu; }
#define XB_SPIN(cond, bar) do { unsigned _sp = 0; while (cond) { __builtin_amdgcn_s_sleep(1); \
    if ((++_sp & 255u) == 0u) { if (xb_ld(&(bar)[XB_TMO])) break; if (_sp > XB_SPIN_CAP) { atomicAdd(&(bar)[XB_TMO], 1u); break; } } } } while (0)
struct XcdBarrier { unsigned* bar; unsigned x; volatile LAS unsigned* st; };
DI XcdBarrier xcd_barrier_post(unsigned* bar, volatile LAS unsigned* st) {
  XcdBarrier b; b.bar = bar; b.x = xb_xcc_id(); b.st = st;
  if (threadIdx.x == 0) (void)xb_add(&bar[XB_XCNT(b.x)], 1u);
  return b;
}
DI void xcd_barrier_complete(unsigned* bar, unsigned x, unsigned& nloc, unsigned& nx) {
  const unsigned G = gridDim.x * gridDim.y * gridDim.z;
  unsigned sum, cnt, mine, sp = 0u;
  for (;;) {
    sum = 0u; cnt = 0u; mine = 0u;
#pragma unroll
    for (unsigned j = 0; j < 16; ++j) { const unsigned c = xb_ld(&bar[XB_XCNT(j)]); sum += c; cnt += (c > 0u) ? 1u : 0u; mine = (j == x) ? c : mine; }
    if (sum == G) break;
    __builtin_amdgcn_s_sleep(1);
    if ((++sp & 255u) == 0u) { if (xb_ld(&bar[XB_TMO])) break; if (sp > XB_SPIN_CAP) { atomicAdd(&bar[XB_TMO], 1u); break; } }
  }
  nloc = mine > 0u ? mine : 1u; nx = cnt > 0u ? cnt : 1u;
}
DI void xcd_barrier(const XcdBarrier& b) {
  asm volatile("s_waitcnt vmcnt(0)" ::: "memory");
  __syncthreads();
  if (threadIdx.x == 0) {
    unsigned* bar = b.bar;
    __builtin_amdgcn_s_waitcnt(0);
    unsigned nloc = b.st[0], nx = b.st[1];
    if (nloc == 0u) { xcd_barrier_complete(bar, b.x, nloc, nx); b.st[0] = nloc; b.st[1] = nx; }
    const unsigned old = xb_add(&bar[XB_XSUB(b.x)], 1u);
    const unsigned gen = old / nloc;
    if (old + 1u == (gen + 1u) * nloc) {
      __builtin_amdgcn_fence(__ATOMIC_RELEASE, "agent");
      asm volatile("s_waitcnt vmcnt(0)" ::: "memory");
      const unsigned og = xb_add(&bar[XB_TOP], 1u);
      const unsigned tg = og / nx;
      if (og + 1u == (tg + 1u) * nx) xb_add(&bar[XB_TOPGEN], 1u);
      else XB_SPIN(xb_ld(&bar[XB_TOPGEN]) == tg, bar);
      __builtin_amdgcn_fence(__ATOMIC_ACQUIRE, "agent");
      xb_add(&bar[XB_XGEN(b.x)], 1u);
      asm volatile("s_waitcnt vmcnt(0)" ::: "memory");
    } else {
      XB_SPIN(xb_ld(&bar[XB_XGEN(b.x)]) == gen, bar);
      __builtin_amdgcn_fence(__ATOMIC_ACQUIRE, "agent");
      asm volatile("s_waitcnt vmcnt(0)" ::: "memory");
    }
  }
  __syncthreads();
}

#define GPTR(T, x) ((T*)(__attribute__((address_space(1))) T*)(x))
__global__ void __launch_bounds__(NT) mega(P p) {
  extern __shared__ __attribute__((aligned(16))) unsigned char lds[];
  cg::grid_group grid = cg::this_grid();
  volatile LAS unsigned* st = (volatile LAS unsigned*)(lds + LDS_BYTES - 16);
  if (threadIdx.x < 4) st[threadIdx.x] = 0u;
  __syncthreads();
  const XcdBarrier xbar = xcd_barrier_post((unsigned*)(p.ws + WS_BAR), st);
  phase0(p, lds);
  grid.sync();
  const P& p0 = p;
  for (int step = 0; step < 50; ++step) {
    const int g = step / 25, rem = step - g * 25, layer = rem / 5, sub = rem - layer * 5;
    const int kind = layer % 3, jl = layer / 3;
    const int T = g ? 16384 : 8192, Lmask = g ? 4095 : 255;
    int op = -1;
    if (layer == 4) op = (sub == 0) ? 0 : -1;
    else if (sub == 0) op = 0;
    else if (kind == 0) op = sub == 1 ? 1 : (sub == 2 ? 2 : (sub == 3 ? 3 : 4));
    else if (kind == 1) op = sub == 1 ? 5 : (sub == 2 ? 6 : (sub == 3 ? 4 : -1));
    else op = sub == 1 ? 4 : (sub == 2 ? 7 : (sub == 3 ? 4 : -1));
    if (op < 0) continue;
    P p = p0;
    { size_t zo_ = 0; asm volatile("" : "+s"(zo_)); p.ws = p0.ws + zo_; p.out = p0.out + zo_; }
    bf16_t* slots = (bf16_t*)(p.ws + WS_SLOT);
    const bf16_t* W = (const bf16_t*)(p.ws + WS_W);
    if (op == 0) {
      const float* xin = p.in[g]; float* xout = p.out + (g ? OUT_YS : OUT_YP);
      phase_norm(p, g, layer - 1, layer < 4 ? layer : -1, layer <= 1 ? xin : xout, xout, slots + SLOT_ELEMS, slots);
      if (kind == 1 && g == 1 && layer < 4) phase_cache_copy(p);
    } else if (op == 1) {
      for (int rep = 0; rep < opq(REP_GEMM); ++rep) phase_gemm<1, 0>(p, g, slots, W + (size_t)(RW_IN0 + jl * RW_STRIDE) * 1024, T, 4352, p.in[11] + jl * 6144, Lmask, slots + SLOT_ELEMS, 1, lds);
    } else if (op == 2) {
      for (int rep = 0; rep < opq(REP_SCAN); ++rep) phase_scan(p, g, jl, lds);
    } else if (op == 3) {
      phase_rwkv_combine(p, g, jl);
    } else if (op == 4) {
      const bf16_t* A; const bf16_t* Bt; int N; bf16_t* dst;
      if (sub == 1) { A = slots; Bt = W + (size_t)CV_IN * 1024; N = 4096; dst = slots + 2 * SLOT_ELEMS; }
      else {
        N = 1024; dst = slots + SLOT_ELEMS;
        if (kind == 0) { A = slots + 4 * SLOT_ELEMS; Bt = W + (size_t)(RW_OUT0 + jl * RW_STRIDE) * 1024; }
        else if (kind == 1) { A = slots + 5 * SLOT_ELEMS; Bt = W + (size_t)AT_OUT * 1024; }
        else { A = slots; Bt = W + (size_t)CV_OUT * 1024; }
      }
      for (int rep = 0; rep < opq(REP_GEMM); ++rep) phase_gemm<0, 0>(p, g, A, Bt, T, N, nullptr, 0, dst, 0, lds);
    } else if (op == 5) {
      for (int rep = 0; rep < opq(REP_GEMM); ++rep) phase_gemm<0, 1>(p, g, slots, W + (size_t)AT_IN * 1024, T, 2560, nullptr, 0, nullptr, 0, lds);
    } else if (op == 6) {
      for (int rep = 0; rep < opq(REP_ATTN); ++rep) phase_attn(p, g, lds);
    } else {
      phase_conv(p, g);
    }
    if (!(g == 1 && layer == 4)) for (int rep = 0; rep < opq(REP_SYNC); ++rep) xcd_barrier(xbar);
  }
}

extern "C" void kernel_launch(void* const* d_in, const int* in_sizes, int n_in, void* d_out, int out_size, void* d_ws, size_t ws_size, hipStream_t stream) {
  static int grid_blocks = 0;
  if (!grid_blocks) {
    int dev = 0, cus = 0, per_cu = 0;
    hipGetDevice(&dev);
    hipDeviceGetAttribute(&cus, hipDeviceAttributeMultiprocessorCount, dev);
    hipFuncSetAttribute((const void*)mega, hipFuncAttributeMaxDynamicSharedMemorySize, LDS_BYTES);
    hipOccupancyMaxActiveBlocksPerMultiprocessor(&per_cu, (const void*)mega, NT, LDS_BYTES);
    if (per_cu < 1) per_cu = 1;
    if (per_cu > 1) per_cu = 1;
    grid_blocks = cus * per_cu;
    if (ws_size < WS_SLOT + 6 * SLOT_ELEMS * 2) fprintf(stderr, "workspace too small: %zu\n", ws_size);
  }
  (void)hipMemsetAsync((unsigned char*)d_ws + WS_BAR, 0, XCD_BAR_WORDS * sizeof(unsigned), stream);
  P p{};
  for (int i = 0; i < 33; ++i) p.in[i] = (const float*)d_in[i];
  p.out = (float*)d_out; p.ws = (unsigned char*)d_ws;
  void* args[] = {&p};
  hipError_t e = hipLaunchCooperativeKernel((const void*)mega, dim3(grid_blocks), dim3(NT), args, LDS_BYTES, stream);
  if (e != hipSuccess) fprintf(stderr, "cooperative launch failed: %s (grid %d)\n", hipGetErrorString(e), grid_blocks);
}
```

```cpp
#include <hip/hip_runtime.h>
#include <hip/hip_cooperative_groups.h>
#include <cstdio>
namespace cg = cooperative_groups;

typedef unsigned short bf16_t;
using bf16x8 = __attribute__((ext_vector_type(8))) short;
using f32x16 = __attribute__((ext_vector_type(16))) float;
using u32x4 = __attribute__((ext_vector_type(4))) unsigned;
using u32x2 = __attribute__((ext_vector_type(2))) unsigned;

#define NT 512
#ifndef REP_GEMM
#define REP_GEMM 1
#endif
#ifndef REP_SCAN
#define REP_SCAN 1
#endif
#ifndef REP_ATTN
#define REP_ATTN 1
#endif
#ifndef REP_SYNC
#define REP_SYNC 1
#endif
#define DI __device__ __forceinline__
#define MFMA32(a, b, c) __builtin_amdgcn_mfma_f32_32x32x16_bf16((a), (b), (c), 0, 0, 0)

struct P { const float* in[33]; float* out; unsigned char* ws; };

constexpr size_t WS_ADA = 0;
constexpr size_t WS_ROPE = 262144;
constexpr size_t WS_BON = 327680;
constexpr size_t WS_HID = WS_BON + 2097152;
constexpr size_t WS_W = WS_HID + 8388608;
constexpr size_t WS_SLOT = WS_W + 39845888;
constexpr size_t SLOT_ELEMS = (size_t)16384 * 1024;
constexpr int RW_IN0 = 0, RW_OUT0 = 4352, RW_STRIDE = 5376, AT_IN = 10752, AT_OUT = 13312, CV_IN = 14336, CV_OUT = 18432;
constexpr size_t OUT_YP = 0, OUT_YS = 8388608, OUT_ST = 25165824, OUT_CK = 33554432, OUT_CV = 35651584;
constexpr int LDS_BYTES = 156416 + 16;
constexpr size_t WS_BAR = 278528;

typedef __bf16 bf16x2_t __attribute__((ext_vector_type(2)));
typedef float f32x2_t __attribute__((ext_vector_type(2)));
DI unsigned pack2(float a, float b) { f32x2_t v = {a, b}; return __builtin_bit_cast(unsigned, __builtin_convertvector(v, bf16x2_t)); }
DI unsigned f2bf(float x) { return (unsigned)__builtin_bit_cast(unsigned short, (__bf16)x); }
DI float bflo(unsigned u) { return __uint_as_float(u << 16); }
DI float bfhi(unsigned u) { return __uint_as_float(u & 0xffff0000u); }
DI float bf1(bf16_t u) { return __uint_as_float(((unsigned)u) << 16); }

template <int CTRL> DI float dppf(float v) { return __int_as_float(__builtin_amdgcn_update_dpp(0, __float_as_int(v), CTRL, 0xF, 0xF, true)); }
DI float reduce16(float v) { v += dppf<0xB1>(v); v += dppf<0x4E>(v); v += dppf<0x141>(v); v += dppf<0x140>(v); return v; }
DI float rdl(float v, int l) { return __int_as_float(__builtin_amdgcn_readlane(__float_as_int(v), l)); }
DI float wave_sum(float v) { v = reduce16(v); return (rdl(v, 0) + rdl(v, 16)) + (rdl(v, 32) + rdl(v, 48)); }
DI float xhalf_max(float x) { const auto r2 = __builtin_amdgcn_permlane32_swap(__float_as_uint(x), __float_as_uint(x), false, false); return fmaxf(__uint_as_float(r2[0]), __uint_as_float(r2[1])); }
DI float xhalf_sum(float x) { const auto r2 = __builtin_amdgcn_permlane32_swap(__float_as_uint(x), __float_as_uint(x), false, false); return __uint_as_float(r2[0]) + __uint_as_float(r2[1]); }
DI float quad_sum(float v) { v += dppf<0xB1>(v); v += dppf<0x4E>(v); return v; }
DI float silu(float x) { return x / (1.f + __expf(-x)); }
DI int opq(int v) { asm volatile("" : "+s"(v)); return v; }
DI int otid() { int t = threadIdx.x; asm volatile("" : "+v"(t)); return t; }

DI void conv_tiles(const float* __restrict__ src, int N, bf16_t* __restrict__ dst, float* lds) {
  const int tid = otid();
  const int tilesN = N >> 6, ntiles = 16 * tilesN;
  for (int tile = blockIdx.x; tile < ntiles; tile += gridDim.x) {
    const int kt = tile / tilesN, nt = tile - kt * tilesN, k0 = kt * 64, n0 = nt * 64;
#pragma unroll
    for (int i = 0; i < 8; ++i) { const int k = (tid >> 6) + 8 * i, n = tid & 63; lds[k * 65 + n] = src[(size_t)(k0 + k) * N + n0 + n]; }
    __syncthreads();
    { const int n = tid >> 3, kc = (tid & 7) * 8; u32x4 o;
#pragma unroll
      for (int j = 0; j < 4; ++j) o[j] = pack2(lds[(kc + 2 * j) * 65 + n], lds[(kc + 2 * j + 1) * 65 + n]);
      *(u32x4*)(dst + (size_t)(n0 + n) * 1024 + k0 + kc) = o; }
    __syncthreads();
  }
}

DI void phase0(const P& p, unsigned char* ldsb) {
  float* lds = (float*)ldsb;
  const int tid = otid();
  bf16_t* W = (bf16_t*)(p.ws + WS_W);
#pragma unroll 1
  for (int e = 0; e < opq(22); ++e) {
    const float* src; int N, drow;
    if (e < 18) {
      const int j = e / 9, q = e - j * 9;
      if (q < 4) { src = p.in[12] + (size_t)(j * 4 + q) * 1048576; N = 1024; drow = RW_IN0 + j * RW_STRIDE + q * 1024; }
      else if (q < 6) { src = p.in[14] + (size_t)(j * 2 + q - 4) * 65536; N = 64; drow = RW_IN0 + j * RW_STRIDE + 4096 + (q - 4) * 64; }
      else if (q < 8) { src = p.in[17] + (size_t)(j * 2 + q - 6) * 65536; N = 64; drow = RW_IN0 + j * RW_STRIDE + 4224 + (q - 6) * 64; }
      else { src = p.in[24] + (size_t)j * 1048576; N = 1024; drow = RW_OUT0 + j * RW_STRIDE; }
    } else if (e == 18) { src = p.in[25]; N = 2560; drow = AT_IN; }
    else if (e == 19) { src = p.in[28]; N = 1024; drow = AT_OUT; }
    else if (e == 20) { src = p.in[29]; N = 4096; drow = CV_IN; }
    else { src = p.in[32]; N = 1024; drow = CV_OUT; }
    conv_tiles(src, N, W + (size_t)drow * 1024, lds);
  }
  {
    float* scond = lds;
    float* red = lds + 5120;
    for (int e = tid; e < 5120; e += NT) { const int cnd = e >> 10, k = e & 1023; const float cv = cnd == 0 ? p.in[6][k] : p.in[5][(cnd - 1) * 1024 + k]; scond[e] = silu(cv); }
    __syncthreads();
    float* ada = (float*)(p.ws + WS_ADA);
    for (int task = blockIdx.x; task < 192; task += gridDim.x) {
      const int layer = task / 48, n0 = (task % 48) * 64, c = tid & 63, kg = tid >> 6;
      float a0 = 0.f, a1 = 0.f, a2 = 0.f, a3 = 0.f, a4 = 0.f;
      const float* wp = p.in[9] + ((size_t)layer * 1024 + kg * 128) * 3072 + n0 + c;
#pragma unroll 8
      for (int k = 0; k < 128; ++k) { const float w = wp[(size_t)k * 3072]; const int kk = kg * 128 + k;
        a0 += scond[kk] * w; a1 += scond[1024 + kk] * w; a2 += scond[2048 + kk] * w; a3 += scond[3072 + kk] * w; a4 += scond[4096 + kk] * w; }
      red[(kg * 5 + 0) * 64 + c] = a0; red[(kg * 5 + 1) * 64 + c] = a1; red[(kg * 5 + 2) * 64 + c] = a2; red[(kg * 5 + 3) * 64 + c] = a3; red[(kg * 5 + 4) * 64 + c] = a4;
      __syncthreads();
      if (tid < 320) { const int cnd = tid >> 6; float s = p.in[10][layer * 3072 + n0 + c];
#pragma unroll
        for (int q = 0; q < 8; ++q) s += red[(q * 5 + cnd) * 64 + c];
        ada[(cnd * 4 + layer) * 3072 + n0 + c] = s; }
      __syncthreads();
    }
  }
  if (blockIdx.x == gridDim.x - 1) {
    float* rope = (float*)(p.ws + WS_ROPE);
    for (int e = tid; e < 1024; e += NT) {
      const int pos = e >> 4, f = e & 15;
      double inv = 1.0; for (int q = 0; q < f; ++q) inv *= 0.5623413251903491;
      double ang = (double)pos * inv;
      const double twopi = 6.283185307179586476925286766559;
      double n = __builtin_rint(ang / twopi); double rr = ang - n * twopi;
      double r2 = rr * rr, sn = 0.0, cs = 0.0, ts = rr, tc = 1.0;
      for (int q = 0; q < 16; ++q) { cs += tc; sn += ts; tc = -tc * r2 / (double)((2 * q + 1) * (2 * q + 2)); ts = -ts * r2 / (double)((2 * q + 2) * (2 * q + 3)); }
      rope[e * 2] = (float)cs; rope[e * 2 + 1] = (float)sn;
    }
  }
}

DI void phase_norm(const P& p, int g, int lpost, int lpre, const float* __restrict__ xsrc, float* __restrict__ xdst,
                   const bf16_t* __restrict__ Mb, bf16_t* __restrict__ H) {
  const int T = g ? 16384 : 8192;
  const int tid = otid(); const int lane = tid & 63, wave = tid >> 6;
  const float* ada = (const float*)(p.ws + WS_ADA);
  float4 xn[4]; u32x2 mn[4];
  const int t0 = blockIdx.x * 8 + wave, tstep = gridDim.x * 8;
#pragma unroll
  for (int i = 0; i < 4; ++i) { xn[i] = make_float4(0.f, 0.f, 0.f, 0.f); mn[i] = (u32x2){0u, 0u}; }
  if (t0 < T) {
#pragma unroll
    for (int i = 0; i < 4; ++i) { xn[i] = *(const float4*)(xsrc + (size_t)t0 * 1024 + 256 * i + 4 * lane); if (lpost >= 0) mn[i] = *(const u32x2*)(Mb + (size_t)t0 * 1024 + 256 * i + 4 * lane); }
  }
  for (int t = t0; t < T; t += tstep) {
    const int cond = g ? 1 + (t >> 12) : 0;
    float4 x[4]; u32x2 mr[4];
#pragma unroll
    for (int i = 0; i < 4; ++i) { x[i] = xn[i]; mr[i] = mn[i]; }
    if (t + tstep < T) {
#pragma unroll
      for (int i = 0; i < 4; ++i) { xn[i] = *(const float4*)(xsrc + (size_t)(t + tstep) * 1024 + 256 * i + 4 * lane); if (lpost >= 0) mn[i] = *(const u32x2*)(Mb + (size_t)(t + tstep) * 1024 + 256 * i + 4 * lane); }
    }
    if (lpost >= 0) {
      float m[16]; float ss = 0.f;
#pragma unroll
      for (int i = 0; i < 4; ++i) { const u32x2 u = mr[i];
        m[4 * i] = bflo(u[0]); m[4 * i + 1] = bfhi(u[0]); m[4 * i + 2] = bflo(u[1]); m[4 * i + 3] = bfhi(u[1]); }
#pragma unroll
      for (int i = 0; i < 16; ++i) ss += m[i] * m[i];
      ss = wave_sum(ss);
      const float rs = rsqrtf(ss * (1.f / 1024.f) + 1e-6f);
      const float* gate = ada + (cond * 4 + lpost) * 3072 + 2048;
      const float* wpo = p.in[8] + lpost * 1024;
#pragma unroll
      for (int i = 0; i < 4; ++i) { const int c = 256 * i + 4 * lane; const float4 gt = *(const float4*)(gate + c); const float4 wv = *(const float4*)(wpo + c);
        x[i].x += gt.x * (m[4 * i] * rs * wv.x); x[i].y += gt.y * (m[4 * i + 1] * rs * wv.y); x[i].z += gt.z * (m[4 * i + 2] * rs * wv.z); x[i].w += gt.w * (m[4 * i + 3] * rs * wv.w);
        *(float4*)(xdst + (size_t)t * 1024 + c) = x[i]; }
    }
    if (lpre >= 0) {
      float ss = 0.f;
#pragma unroll
      for (int i = 0; i < 4; ++i) ss += x[i].x * x[i].x + x[i].y * x[i].y + x[i].z * x[i].z + x[i].w * x[i].w;
      ss = wave_sum(ss);
      const float rs = rsqrtf(ss * (1.f / 1024.f) + 1e-6f);
      const float* sh = ada + (cond * 4 + lpre) * 3072; const float* sc = sh + 1024; const float* wpr = p.in[7] + lpre * 1024;
#pragma unroll
      for (int i = 0; i < 4; ++i) { const int c = 256 * i + 4 * lane; const float4 s4 = *(const float4*)(sh + c); const float4 c4 = *(const float4*)(sc + c); const float4 wv = *(const float4*)(wpr + c);
        u32x2 o; o[0] = pack2(x[i].x * rs * wv.x * (1.f + c4.x) + s4.x, x[i].y * rs * wv.y * (1.f + c4.y) + s4.y);
        o[1] = pack2(x[i].z * rs * wv.z * (1.f + c4.z) + s4.z, x[i].w * rs * wv.w * (1.f + c4.w) + s4.w);
        *(u32x2*)(H + (size_t)t * 1024 + c) = o; }
    }
  }
}

DI void phase_cache_copy(const P& p) {
  bf16_t* Kb = (bf16_t*)(p.ws + WS_SLOT) + 4 * SLOT_ELEMS; bf16_t* Vt = Kb + SLOT_ELEMS / 2;
  for (int e = blockIdx.x * NT + otid(); e < 262144; e += gridDim.x * NT) {
    const int c = e & 255, pp = (e >> 8) & 255, b = e >> 16; const int kvh = c >> 6, d = c & 63;
    Kb[((size_t)b * 4352 + 4096 + pp) * 256 + c] = (bf16_t)f2bf(p.in[3][e]);
    Vt[((size_t)(b * 4 + kvh) * 64 + d) * 4352 + 4096 + pp] = (bf16_t)f2bf(p.in[4][e]);
  }
}

template <int SHIFT> DI void ld_half(const bf16_t* __restrict__ A, int t, int k, int Lmask, u32x4 (&raw)[4]) {
  raw[1] = *(const u32x4*)(A + (size_t)t * 1024 + k);
  raw[2] = *(const u32x4*)(A + (size_t)(t + 1) * 1024 + k);
  if (SHIFT) {
    raw[0] = (u32x4){0u, 0u, 0u, 0u}; raw[3] = (u32x4){0u, 0u, 0u, 0u};
    if ((t & Lmask) != 0) raw[0] = *(const u32x4*)(A + (size_t)(t - 1) * 1024 + k);
    if (((t + 1) & Lmask) != Lmask) raw[3] = *(const u32x4*)(A + (size_t)(t + 2) * 1024 + k);
  }
}
DI u32x4 mix3(const u32x4& c, const u32x4& pz, const u32x4& nz, const float* smu, int k) {
  const float4 m0 = *(const float4*)(smu + k), m1 = *(const float4*)(smu + k + 4);
  const float mu[8] = {m0.x, m0.y, m0.z, m0.w, m1.x, m1.y, m1.z, m1.w};
  u32x4 o;
#pragma unroll
  for (int i = 0; i < 4; ++i) {
    const float h0 = bflo(c[i]), h1 = bfhi(c[i]);
    const float x0 = h0 + (0.5f * (bflo(pz[i]) + bflo(nz[i])) - h0) * mu[2 * i];
    const float x1 = h1 + (0.5f * (bfhi(pz[i]) + bfhi(nz[i])) - h1) * mu[2 * i + 1];
    o[i] = pack2(x0, x1);
  }
  return o;
}
DI int swz(int row, int c) { return row * 128 + ((c ^ ((row >> 1) & 7)) << 4); }
template <int SHIFT> DI void st_half(unsigned char* base, int row, int c, const u32x4 (&raw)[4], const float* smu, int k) {
  if (!SHIFT) { *(u32x4*)(base + swz(row, c)) = raw[1]; *(u32x4*)(base + swz(row + 1, c)) = raw[2]; }
  else { *(u32x4*)(base + swz(row, c)) = mix3(raw[1], raw[0], raw[2], smu, k); *(u32x4*)(base + swz(row + 1, c)) = mix3(raw[2], raw[1], raw[3], smu, k); }
}

template <int SHIFT, int EPI>
DI void phase_gemm(const P& p, int g, const bf16_t* __restrict__ A, const bf16_t* __restrict__ Bt, int M, int N,
                   const float* __restrict__ mu, int Lmask, bf16_t* __restrict__ dst, int rw, unsigned char* lds) {
  const int tid = otid(), lane = tid & 63, wave = tid >> 6;
  const int wm = wave >> 1, wn = wave & 1, r = lane & 31, h = lane >> 5;
  const int ntn = N >> 7, ntiles = ntn * (M >> 8);
  float* Cs = (float*)lds;
  float* smu = (float*)(lds + 110592);
  for (int tile = blockIdx.x; tile < ntiles; tile += gridDim.x) {
    const int mt = tile / ntn, nt = tile - mt * ntn; const int m0 = mt * 256, n0 = nt * 128;
    f32x16 acc[2][2];
#pragma unroll
    for (int a = 0; a < 2; ++a)
#pragma unroll
      for (int b = 0; b < 2; ++b)
#pragma unroll
        for (int i = 0; i < 16; ++i) acc[a][b][i] = 0.f;
    if (SHIFT) {
      const float* mup = mu + (nt < 32 ? (nt >> 3) : (nt == 32 ? 4 : 5)) * 1024;
      smu[tid] = mup[tid]; smu[tid + 512] = mup[tid + 512];
      __syncthreads();
    }
    if (!SHIFT) {
      u32x4 s0[6], s1[6];
      const int lrow = tid >> 3, lkc = (tid & 7) * 8;
#define G_LOAD(S, K0)  { _Pragma("unroll") for (int i = 0; i < 4; ++i) S[i] = *(const u32x4*)(A + (size_t)(m0 + lrow + 64 * i) * 1024 + (K0) + lkc); \
                         _Pragma("unroll") for (int i = 0; i < 2; ++i) S[4 + i] = *(const u32x4*)(Bt + (size_t)(n0 + lrow + 64 * i) * 1024 + (K0) + lkc); }
#define G_STORE(S, BUF) { _Pragma("unroll") for (int i = 0; i < 4; ++i) *(u32x4*)((BUF) + swz(lrow + 64 * i, tid & 7)) = S[i]; \
                          _Pragma("unroll") for (int i = 0; i < 2; ++i) *(u32x4*)((BUF) + 32768 + swz(lrow + 64 * i, tid & 7)) = S[4 + i]; }
#define G_COMPUTE(BUF) { _Pragma("unroll") for (int ks = 0; ks < 4; ++ks) { const int kc_ = ks * 2 + h; \
        const bf16x8 a0 = *(const bf16x8*)((BUF) + swz(wm * 64 + r, kc_)); const bf16x8 a1 = *(const bf16x8*)((BUF) + swz(wm * 64 + 32 + r, kc_)); \
        const bf16x8 b0 = *(const bf16x8*)((BUF) + 32768 + swz(wn * 64 + r, kc_)); const bf16x8 b1 = *(const bf16x8*)((BUF) + 32768 + swz(wn * 64 + 32 + r, kc_)); \
        acc[0][0] = MFMA32(a0, b0, acc[0][0]); acc[0][1] = MFMA32(a0, b1, acc[0][1]); acc[1][0] = MFMA32(a1, b0, acc[1][0]); acc[1][1] = MFMA32(a1, b1, acc[1][1]); } }
      G_LOAD(s0, 0) G_STORE(s0, lds)
      G_LOAD(s0, 64) G_LOAD(s1, 128)
      __syncthreads();
      for (int kt = 0; kt < 16; kt += 2) {
        G_COMPUTE(lds)
        G_STORE(s0, lds + 49152)
        if (kt + 3 < 16) G_LOAD(s0, (kt + 3) * 64)
        __syncthreads();
        G_COMPUTE(lds + 49152)
        if (kt + 2 < 16) G_STORE(s1, lds)
        if (kt + 4 < 16) G_LOAD(s1, (kt + 4) * 64)
        __syncthreads();
      }
#undef G_LOAD
#undef G_STORE
#undef G_COMPUTE
    } else {
    u32x4 raw[4], raw2[4], rb[2];
    const int arow = 4 * (tid >> 3), akc = (tid & 7) * 8;
#pragma unroll
    for (int hf = 0; hf < 2; ++hf) { ld_half<SHIFT>(A, m0 + arow + 2 * hf, akc, Lmask, raw); st_half<SHIFT>(lds, arow + 2 * hf, tid & 7, raw, smu, akc); }
#pragma unroll
    for (int i = 0; i < 2; ++i) { const int id = tid + 512 * i; rb[i] = *(const u32x4*)(Bt + (size_t)(n0 + (id >> 3)) * 1024 + (id & 7) * 8); }
#pragma unroll
    for (int i = 0; i < 2; ++i) { const int id = tid + 512 * i; *(u32x4*)(lds + 32768 + swz(id >> 3, id & 7)) = rb[i]; }
    __syncthreads();
    for (int kt = 0; kt < 16; ++kt) {
      unsigned char* cur = lds + (kt & 1) * 49152; unsigned char* nxt = lds + ((kt + 1) & 1) * 49152;
      const int k1 = (kt + 1) * 64;
      if (kt < 15) {
        ld_half<SHIFT>(A, m0 + arow, k1 + akc, Lmask, raw);
        ld_half<SHIFT>(A, m0 + arow + 2, k1 + akc, Lmask, raw2);
#pragma unroll
        for (int i = 0; i < 2; ++i) { const int id = tid + 512 * i; rb[i] = *(const u32x4*)(Bt + (size_t)(n0 + (id >> 3)) * 1024 + k1 + (id & 7) * 8); }
      }
#pragma unroll
      for (int ks = 0; ks < 4; ++ks) {
        const int kc_ = ks * 2 + h;
        const bf16x8 a0 = *(const bf16x8*)(cur + swz(wm * 64 + r, kc_));
        const bf16x8 a1 = *(const bf16x8*)(cur + swz(wm * 64 + 32 + r, kc_));
        const bf16x8 b0 = *(const bf16x8*)(cur + 32768 + swz(wn * 64 + r, kc_));
        const bf16x8 b1 = *(const bf16x8*)(cur + 32768 + swz(wn * 64 + 32 + r, kc_));
        acc[0][0] = MFMA32(a0, b0, acc[0][0]); acc[0][1] = MFMA32(a0, b1, acc[0][1]);
        acc[1][0] = MFMA32(a1, b0, acc[1][0]); acc[1][1] = MFMA32(a1, b1, acc[1][1]);
      }
      if (kt < 15) {
        st_half<SHIFT>(nxt, arow, tid & 7, raw, smu, k1 + akc);
        st_half<SHIFT>(nxt, arow + 2, tid & 7, raw2, smu, k1 + akc);
#pragma unroll
        for (int i = 0; i < 2; ++i) { const int id = tid + 512 * i; *(u32x4*)(nxt + 32768 + swz(id >> 3, id & 7)) = rb[i]; }
      }
      __syncthreads();
    }
    }
#pragma unroll
    for (int mi = 0; mi < 2; ++mi)
#pragma unroll
      for (int ni = 0; ni < 2; ++ni)
#pragma unroll
        for (int i = 0; i < 16; ++i) {
          const int row = wm * 64 + mi * 32 + (i & 3) + 8 * (i >> 2) + 4 * h, col = wn * 64 + ni * 32 + r;
          Cs[row * 132 + col] = acc[mi][ni][i];
        }
    __syncthreads();
    if (EPI == 0) {
#pragma unroll
      for (int i = 0; i < 8; ++i) {
        const int id = tid + 512 * i, row = id >> 4, cc = (id & 15) * 8;
        float4 v0 = *(const float4*)(Cs + row * 132 + cc), v1 = *(const float4*)(Cs + row * 132 + cc + 4);
        if (rw && nt == 32) { v0.x = tanhf(v0.x); v0.y = tanhf(v0.y); v0.z = tanhf(v0.z); v0.w = tanhf(v0.w); v1.x = tanhf(v1.x); v1.y = tanhf(v1.y); v1.z = tanhf(v1.z); v1.w = tanhf(v1.w); }
        u32x4 o; o[0] = pack2(v0.x, v0.y); o[1] = pack2(v0.z, v0.w); o[2] = pack2(v1.x, v1.y); o[3] = pack2(v1.z, v1.w);
        if (rw && nt >= 32) *(u32x4*)((bf16_t*)(p.ws + WS_HID) + (size_t)(m0 + row) * 256 + (nt - 32) * 128 + cc) = o;
        else *(u32x4*)(dst + (size_t)(nt >> 3) * SLOT_ELEMS + (size_t)(m0 + row) * 1024 + (nt & 7) * 128 + cc) = o;
      }
    } else {
      const int row = tid & 255, hh = tid >> 8; const int t = m0 + row;
      float x[64];
#pragma unroll
      for (int q = 0; q < 16; ++q) { const float4 v = *(const float4*)(Cs + row * 132 + hh * 64 + 4 * q); x[4 * q] = v.x; x[4 * q + 1] = v.y; x[4 * q + 2] = v.z; x[4 * q + 3] = v.w; }
      bf16_t* slots = (bf16_t*)(p.ws + WS_SLOT);
      const int L = g ? 4096 : 256, Ltot = g ? 4352 : 256;
      const int b = g ? (t >> 12) : (t >> 8), s = t & (L - 1);
      if (nt < 10) {
        int vz = 0; asm volatile("" : "+v"(vz));
        const float* nw = (nt < 8 ? p.in[26] : p.in[27]) + vz;
        float ss = 0.f;
#pragma unroll
        for (int d = 0; d < 64; ++d) ss += x[d] * x[d];
        const float rs = rsqrtf(ss * (1.f / 64.f) + 1e-6f);
#pragma unroll
        for (int d = 0; d < 64; ++d) x[d] *= rs * nw[d];
        if (g == 0 && nt >= 8) {
          float* ck = p.out + OUT_CK + (size_t)t * 256 + ((nt - 8) * 2 + hh) * 64;
#pragma unroll
          for (int q = 0; q < 16; ++q) *(float4*)(ck + 4 * q) = make_float4(x[4 * q], x[4 * q + 1], x[4 * q + 2], x[4 * q + 3]);
        }
        if (g == 1) {
          const float2* rope = (const float2*)(p.ws + WS_ROPE);
          const int ri = s >> 6, ci = s & 63;
#pragma unroll
          for (int f = 0; f < 16; ++f) {
            const float2 cr = rope[ri * 16 + f]; const float x1 = x[f], x2 = x[16 + f];
            x[f] = x1 * cr.x - x2 * cr.y; x[16 + f] = x2 * cr.x + x1 * cr.y;
            const float2 cc = rope[ci * 16 + f]; const float y1 = x[32 + f], y2 = x[48 + f];
            x[32 + f] = y1 * cc.x - y2 * cc.y; x[48 + f] = y2 * cc.x + y1 * cc.y;
          }
        }
        bf16_t* dq = nt < 8 ? slots + 2 * SLOT_ELEMS + (size_t)t * 1024 + (nt * 2 + hh) * 64
                            : slots + 4 * SLOT_ELEMS + ((size_t)b * Ltot + s) * 256 + ((nt - 8) * 2 + hh) * 64;
#pragma unroll
        for (int q = 0; q < 8; ++q) { u32x4 o; o[0] = pack2(x[8 * q], x[8 * q + 1]); o[1] = pack2(x[8 * q + 2], x[8 * q + 3]); o[2] = pack2(x[8 * q + 4], x[8 * q + 5]); o[3] = pack2(x[8 * q + 6], x[8 * q + 7]); *(u32x4*)(dq + 8 * q) = o; }
      } else if (nt < 12) {
        const int kvh = (nt - 10) * 2 + hh;
        if (g == 0) {
          float* cv = p.out + OUT_CV + (size_t)t * 256 + kvh * 64;
#pragma unroll
          for (int q = 0; q < 16; ++q) *(float4*)(cv + 4 * q) = make_float4(x[4 * q], x[4 * q + 1], x[4 * q + 2], x[4 * q + 3]);
        }
        bf16_t* vt = slots + 4 * SLOT_ELEMS + SLOT_ELEMS / 2 + ((size_t)(b * 4 + kvh) * 64) * Ltot + s;
        { size_t vo = 0;
#pragma unroll
        for (int d = 0; d < 64; ++d) { vt[vo] = (bf16_t)f2bf(x[d]); vo += Ltot; asm volatile("" : "+v"(vo)); } }
      } else {
        bf16_t* dg = slots + 3 * SLOT_ELEMS + (size_t)t * 1024 + (nt - 12) * 128 + hh * 64;
#pragma unroll
        for (int q = 0; q < 8; ++q) { u32x4 o; o[0] = pack2(x[8 * q], x[8 * q + 1]); o[1] = pack2(x[8 * q + 2], x[8 * q + 3]); o[2] = pack2(x[8 * q + 4], x[8 * q + 5]); o[3] = pack2(x[8 * q + 6], x[8 * q + 7]); *(u32x4*)(dg + 8 * q) = o; }
      }
    }
    __syncthreads();
  }
}

DI u32x4 cat8(const u32x2 lo, const u32x2 hi) { u32x4 v; v[0] = lo[0]; v[1] = lo[1]; v[2] = hi[0]; v[3] = hi[1]; return v; }
DI void phase_scan(const P& p, int g, int jl, unsigned char* lds) {
  const int tid = otid(), lane = tid & 63, wave = tid >> 6, r = lane & 31, h = lane >> 5;
  const int L = g ? 4096 : 256, B = g ? 4 : 32, nsc = L >> 5;
  float* sR = (float*)lds; float* sW = sR + 2048; float* sKD = sW + 2048; float* sKK = sKD + 2048; float* sKKA = sKK + 2048;
  bf16_t* sHW = (bf16_t*)(lds + 40960); bf16_t* sHA = (bf16_t*)(lds + 45568);
  bf16_t* oAL = (bf16_t*)(lds + 50176); bf16_t* oRH = (bf16_t*)(lds + 54784); bf16_t* oBE = (bf16_t*)(lds + 59392); bf16_t* oGA = (bf16_t*)(lds + 64000);
  bf16_t* oBEt = (bf16_t*)(lds + 68608); bf16_t* oGAt = (bf16_t*)(lds + 73728); bf16_t* oUt = (bf16_t*)(lds + 78848); bf16_t* oZt = (bf16_t*)(lds + 83968);
  float* Bm = (float*)(lds + 89088); float* RHS = (float*)(lds + 93696); float* lamC = (float*)(lds + 101888); float* sP = (float*)(lds + 102144);
  unsigned char* frag = lds + 104192;
  const bf16_t* slots = (const bf16_t*)(p.ws + WS_SLOT);
  const bf16_t* Rg = slots + 1 * SLOT_ELEMS; const bf16_t* Kg = slots + 2 * SLOT_ELEMS; const bf16_t* Vg = slots + 3 * SLOT_ELEMS;
  const bf16_t* hid = (const bf16_t*)(p.ws + WS_HID);
  float* bon = (float*)(p.ws + WS_BON);
  const int ntasks = B * 32;
  for (int task = blockIdx.x; task < ntasks; task += gridDim.x) {
    const int z = task & 1, head = (task >> 1) & 15, b = task >> 5;
    bf16_t* Yg = (bf16_t*)(p.ws + WS_SLOT) + (z ? 0 : 5) * SLOT_ELEMS;
    const int mat = (wave >> 1) & 1, ntt = wave & 1;
    unsigned char* lfr = lds + 110336 + (wave & 3) * 4096;
    if (wave >= 4) {
      const float* W2 = (mat ? p.in[18] : p.in[15]) + (size_t)(jl * 2 + z) * 65536 + head * 64 + 32 * ntt + r;
#pragma unroll
      for (int kk = 0; kk < 4; ++kk) { u32x4 pk;
#pragma unroll
        for (int j = 0; j < 4; ++j) pk[j] = pack2(W2[(size_t)(16 * kk + 8 * h + 2 * j) * 1024], W2[(size_t)(16 * kk + 8 * h + 2 * j + 1) * 1024]);
        *(u32x4*)(lfr + (kk * 64 + lane) * 16) = pk; }
    }
    const float bias = (mat ? p.in[16] : p.in[13])[(jl * 2 + z) * 1024 + head * 64 + 32 * ntt + r];
    const float kkc = p.in[19][jl * 1024 + head * 64 + lane], kac = p.in[20][jl * 1024 + head * 64 + lane], rkc = p.in[21][jl * 1024 + head * 64 + lane];
    f32x16 st0, st1;
#pragma unroll
    for (int q = 0; q < 16; ++q) { st0[q] = 0.f; st1[q] = 0.f; }
    const size_t stbase = ((((size_t)(b * 2 + jl) * 2 + z) * 16 + head) * 64 + (32 * (wave & 1) + r)) * 64;
    if (g && wave < 2) {
#pragma unroll
      for (int gq = 0; gq < 4; ++gq) {
        const float4 s0 = *(const float4*)(p.in[2] + stbase + 8 * gq + 4 * h), s1 = *(const float4*)(p.in[2] + stbase + 32 + 8 * gq + 4 * h);
        st0[4 * gq] = s0.x; st0[4 * gq + 1] = s0.y; st0[4 * gq + 2] = s0.z; st0[4 * gq + 3] = s0.w;
        st1[4 * gq] = s1.x; st1[4 * gq + 1] = s1.y; st1[4 * gq + 2] = s1.z; st1[4 * gq + 3] = s1.w;
      }
    }
    u32x4 pre[5];
    const int ht = tid - 256;
#define SCAN_LOAD(sc_)                                                                                    \
    { const int ht2 = otid() - 256;                                                                       \
    _Pragma("unroll") for (int i = 0; i < 5; ++i) {                                                       \
      const int id = ht2 + 256 * i;                                                                       \
      const int arr = id >> 8, s = (id >> 3) & 31, cc = (id & 7) * 8;                                     \
      const int tl = z ? (L - 1 - ((sc_) * 32 + s)) : ((sc_) * 32 + s);                                   \
      const size_t tok = (size_t)b * L + tl;                                                              \
      if (arr < 3) pre[i] = *(const u32x4*)((arr == 0 ? Rg : (arr == 1 ? Kg : Vg)) + tok * 1024 + head * 64 + cc); \
      else pre[i] = *(const u32x4*)(hid + tok * 256 + (arr - 3) * 128 + z * 64 + cc);                     \
    } }
#define NQ(t_) ((((t_) + 3) / 4 + 1) / 2)
#define SOLVE_ROWS(T0, T1)                                                                                \
    _Pragma("unroll") for (int t = (T0); t < (T1); ++t) {                                                 \
      if (t + 2 < 32) {                                                                                   \
        n2rhs = RHo[(t + 2) * 64];                                                                        \
        _Pragma("unroll") for (int q = 0; q < NQ(t + 2); ++q) { const f4v q4 = *(const __attribute__((address_space(3))) f4v*)(Bmo + (t + 2) * 36 + 8 * q); nc8[q] = make_float4(q4[0], q4[1], q4[2], q4[3]); } \
      }                                                                                                   \
      float a0s = crhs * mh, a1s = 0.f;                                                                   \
      _Pragma("unroll") for (int q = 0; q < NQ(t); ++q) {                                                 \
        a0s -= cb[q].x * zv[4 * q]; a1s -= cb[q].y * zv[4 * q + 1]; a0s -= cb[q].z * zv[4 * q + 2]; a1s -= cb[q].w * zv[4 * q + 3]; } \
      float zt = xhalf_sum(a0s + a1s);                                                                    \
      asm volatile("" : "+v"(zt) :: "memory");                                                            \
      zv[4 * (t >> 3) + (t & 3)] = ((((t >> 2) & 1) == h)) ? zt : zv[4 * (t >> 3) + (t & 3)];             \
      crhs = nrhs; nrhs = n2rhs;                                                                          \
      _Pragma("unroll") for (int q = 0; q < 4; ++q) { cb[q] = nb8[q]; nb8[q] = nc8[q]; }                  \
    }
    typedef float f4v __attribute__((ext_vector_type(4)));
    if (wave >= 4) { SCAN_LOAD(0) }
    for (int sc = -1; sc < nsc; ++sc) {
      const bool st_on = sc >= 0, hl_on = sc + 1 < nsc;
      bf16_t* oUc = (bf16_t*)(lds + ((sc & 1) ? 126720 : 78848));
      bf16_t* oUn = (bf16_t*)(lds + ((sc & 1) ? 78848 : 126720));
      f32x16 y0;
      const int vloc = 32 * (wave & 1) + r;
      if (st_on) {
      {
        const int k = lane, tq = wave;
        float wq[4];
#pragma unroll
        for (int j = 0; j < 4; ++j) wq[j] = sW[(4 * tq + j) * 64 + k];
        sP[tq * 64 + k] = (wq[0] * wq[1]) * (wq[2] * wq[3]);
        __syncthreads();
        float lam = 1.f;
#pragma unroll
        for (int q = 0; q < 7; ++q) { const float pq = sP[q * 64 + k]; lam *= (q < tq) ? pq : 1.f; }
        u32x2 bt, gt; float nb[4], gg[4];
#pragma unroll
        for (int j = 0; j < 4; ++j) {
          const int t = 4 * tq + j;
          const float lamp = lam; lam = lamp * wq[j];
          const float inv = __builtin_amdgcn_rcpf(lam);
          const float al = lamp * sKK[t * 64 + k], be = sKKA[t * 64 + k] * inv, ga = sKD[t * 64 + k] * inv, rh = lam * sR[t * 64 + k];
          oAL[t * 72 + k] = (bf16_t)f2bf(al); oRH[t * 72 + k] = (bf16_t)f2bf(rh); oBE[t * 72 + k] = (bf16_t)f2bf(be); oGA[t * 72 + k] = (bf16_t)f2bf(ga);
          nb[j] = -be; gg[j] = ga;
        }
        bt[0] = pack2(nb[0], nb[1]); bt[1] = pack2(nb[2], nb[3]); gt[0] = pack2(gg[0], gg[1]); gt[1] = pack2(gg[2], gg[3]);
        *(u32x2*)(oBEt + k * 40 + 4 * tq) = bt; *(u32x2*)(oGAt + k * 40 + 4 * tq) = gt;
        if (tq == 7) lamC[k] = lam;
      }
      __syncthreads();
      {
      const int tid = otid(), lane = tid & 63, wave = tid >> 6, r = lane & 31, h = lane >> 5; (void)r; (void)h; (void)lane; (void)wave;
      if (wave < 4) {
        const bf16_t* As = (wave & 1) ? oGA : oBE; const bf16_t* Bs = (wave < 2) ? oAL : oRH;
        f32x16 x;
#pragma unroll
        for (int q = 0; q < 16; ++q) x[q] = 0.f;
#pragma unroll
        for (int s = 0; s < 4; ++s) { const bf16x8 a = *(const bf16x8*)(As + r * 72 + 16 * s + 8 * h); const bf16x8 bb = *(const bf16x8*)(Bs + r * 72 + 16 * s + 8 * h); x = MFMA32(a, bb, x); }
#pragma unroll
        for (int q = 0; q < 16; ++q) { const int i = (q & 3) + 8 * (q >> 2) + 4 * h; const bool keep = (wave < 2) ? (i < r) : (i <= r); x[q] = keep ? x[q] : 0.f; }
        if (wave == 0) {
#pragma unroll
          for (int gq = 0; gq < 4; ++gq) *(float4*)(Bm + r * 36 + 8 * gq + 4 * h) = make_float4(x[4 * gq], x[4 * gq + 1], x[4 * gq + 2], x[4 * gq + 3]);
        } else {
          const float sg = (wave == 2) ? -1.f : 1.f;
#pragma unroll
          for (int s = 0; s < 2; ++s) { u32x4 pk;
#pragma unroll
            for (int j = 0; j < 4; ++j) pk[j] = pack2(sg * x[8 * s + 2 * j], sg * x[8 * s + 2 * j + 1]);
            *(u32x4*)(frag + (((wave - 1) * 2 + s) * 64 + lane) * 16) = pk; }
        }
      }
      }
      __syncthreads();
      if (wave < 2) {
        f32x16 a0;
#pragma unroll
        for (int q = 0; q < 16; ++q) a0[q] = 0.f;
#pragma unroll
        for (int kb = 0; kb < 2; ++kb)
#pragma unroll
          for (int s = 0; s < 2; ++s) {
            u32x4 pk;
#pragma unroll
            for (int j = 0; j < 4; ++j) pk[j] = kb ? pack2(st1[8 * s + 2 * j], st1[8 * s + 2 * j + 1]) : pack2(st0[8 * s + 2 * j], st0[8 * s + 2 * j + 1]);
            const bf16x8 sf = __builtin_bit_cast(bf16x8, pk);
            const int ko = 32 * kb + 16 * s + 4 * h;
            const u32x4 aa = cat8(*(const u32x2*)(oAL + r * 72 + ko), *(const u32x2*)(oAL + r * 72 + ko + 8));
            a0 = MFMA32(__builtin_bit_cast(bf16x8, aa), sf, a0);
          }
#pragma unroll
        for (int s = 0; s < 2; ++s) {
          const bf16x8 fg = *(const bf16x8*)(frag + ((0 * 2 + s) * 64 + lane) * 16);
          const u32x4 ub = cat8(*(const u32x2*)(oUc + vloc * 40 + 16 * s + 4 * h), *(const u32x2*)(oUc + vloc * 40 + 16 * s + 4 * h + 8));
          a0 = MFMA32(fg, __builtin_bit_cast(bf16x8, ub), a0);
        }
#pragma unroll
        for (int q = 0; q < 16; ++q) RHS[((q & 3) + 8 * (q >> 2) + 4 * h) * 64 + vloc] = a0[q];
        float* park = (float*)(lds + 131840) + wave * 3072 + lane * 4;
#pragma unroll
        for (int gq = 0; gq < 4; ++gq) {
          *(float4*)(park + gq * 256) = make_float4(st0[4 * gq], st0[4 * gq + 1], st0[4 * gq + 2], st0[4 * gq + 3]);
          *(float4*)(park + 1024 + gq * 256) = make_float4(st1[4 * gq], st1[4 * gq + 1], st1[4 * gq + 2], st1[4 * gq + 3]);
        }
      }
      }
      float zv[16]; float4 cb[4], nb8[4], nc8[4]; float crhs = 0.f, nrhs = 0.f, n2rhs = 0.f;
      const float mh = h ? 0.f : 1.f;
#pragma unroll
      for (int t = 0; t < 16; ++t) zv[t] = 0.f;
#pragma unroll
      for (int q = 0; q < 4; ++q) { cb[q] = make_float4(0.f, 0.f, 0.f, 0.f); nb8[q] = make_float4(0.f, 0.f, 0.f, 0.f); nc8[q] = make_float4(0.f, 0.f, 0.f, 0.f); }
      const __attribute__((address_space(3))) float* Bmo = (const __attribute__((address_space(3))) float*)(unsigned)(unsigned long long)(Bm + 4 * h);
      const __attribute__((address_space(3))) float* RHo = (const __attribute__((address_space(3))) float*)(unsigned)(unsigned long long)(RHS + vloc);
      asm volatile("" : "+v"(Bmo), "+v"(RHo));
      if (wave < 2 && st_on) { crhs = RHo[0]; nrhs = RHo[64]; const f4v q4 = *(const __attribute__((address_space(3))) f4v*)(Bmo + 36); nb8[0] = make_float4(q4[0], q4[1], q4[2], q4[3]); }
      if (wave < 2) { if (st_on) { SOLVE_ROWS(0, 6) } }
      else if (wave >= 4 && hl_on) {
#pragma unroll
        for (int i = 0; i < 5; ++i) {
          const int id = ht + 256 * i; const int arr = id >> 8, s = (id >> 3) & 31, cc = (id & 7) * 8;
          const u32x4 u = pre[i];
          if (arr < 2) { float* d = (arr == 0 ? sR : sKD) + s * 64 + cc;
            *(float4*)d = make_float4(bflo(u[0]), bfhi(u[0]), bflo(u[1]), bfhi(u[1])); *(float4*)(d + 4) = make_float4(bflo(u[2]), bfhi(u[2]), bflo(u[3]), bfhi(u[3])); }
          else if (arr == 2) {
#pragma unroll
            for (int j = 0; j < 4; ++j) { oUn[(cc + 2 * j) * 40 + s] = (bf16_t)(u[j] & 0xffffu); oUn[(cc + 2 * j + 1) * 40 + s] = (bf16_t)(u[j] >> 16); }
          } else *(u32x4*)((arr == 3 ? sHW : sHA) + s * 72 + cc) = u;
        }
        if (sc + 2 < nsc) { SCAN_LOAD(sc + 2) }
      }
      __syncthreads();
      if (wave < 2) { if (st_on) { SOLVE_ROWS(6, 24) } }
      else if (wave < 4) { if (st_on) {
        const float* park = (const float*)(lds + 131840) + (wave - 2) * 3072 + lane * 4;
#pragma unroll
        for (int gq = 0; gq < 4; ++gq) {
          const float4 a = *(const float4*)(park + gq * 256), bq = *(const float4*)(park + 1024 + gq * 256);
          st0[4 * gq] = a.x; st0[4 * gq + 1] = a.y; st0[4 * gq + 2] = a.z; st0[4 * gq + 3] = a.w;
          st1[4 * gq] = bq.x; st1[4 * gq + 1] = bq.y; st1[4 * gq + 2] = bq.z; st1[4 * gq + 3] = bq.w;
        }
#pragma unroll
        for (int q = 0; q < 16; ++q) y0[q] = 0.f;
#pragma unroll
        for (int kb = 0; kb < 2; ++kb)
#pragma unroll
          for (int s = 0; s < 2; ++s) {
            u32x4 pk;
#pragma unroll
            for (int j = 0; j < 4; ++j) pk[j] = kb ? pack2(st1[8 * s + 2 * j], st1[8 * s + 2 * j + 1]) : pack2(st0[8 * s + 2 * j], st0[8 * s + 2 * j + 1]);
            const int ko = 32 * kb + 16 * s + 4 * h;
            const u32x4 ar = cat8(*(const u32x2*)(oRH + r * 72 + ko), *(const u32x2*)(oRH + r * 72 + ko + 8));
            y0 = MFMA32(__builtin_bit_cast(bf16x8, ar), __builtin_bit_cast(bf16x8, pk), y0);
          }
#pragma unroll
        for (int s = 0; s < 2; ++s) {
          const bf16x8 fpg = *(const bf16x8*)(frag + ((2 * 2 + s) * 64 + lane) * 16);
          const u32x4 ub = cat8(*(const u32x2*)(oUc + vloc * 40 + 16 * s + 4 * h), *(const u32x2*)(oUc + vloc * 40 + 16 * s + 4 * h + 8));
          y0 = MFMA32(fpg, __builtin_bit_cast(bf16x8, ub), y0);
        }
      } }
      else if (wave >= 4 && hl_on) {
        f32x16 acc;
#pragma unroll
        for (int i = 0; i < 16; ++i) acc[i] = 0.f;
        const bf16_t* sH = mat ? sHA : sHW;
#pragma unroll
        for (int kk = 0; kk < 4; ++kk) { const bf16x8 a = *(const bf16x8*)(sH + r * 72 + 16 * kk + 8 * h); const bf16x8 bw = *(const bf16x8*)(lfr + (kk * 64 + lane) * 16); acc = MFMA32(a, bw, acc); }
#pragma unroll
        for (int i = 0; i < 16; ++i) {
          const int srow = (i & 3) + 8 * (i >> 2) + 4 * h, c = 32 * ntt + r;
          const float xv = acc[i] + bias;
          const float sg = __builtin_amdgcn_rcpf(1.f + __expf(-xv));
          if (mat == 0) sW[srow * 64 + c] = __expf(-0.60653065971263342f * sg);
          else sKKA[srow * 64 + c] = sg;
        }
      }
      __syncthreads();
      if (wave < 2) { if (st_on) {
        SOLVE_ROWS(24, 32)
#pragma unroll
        for (int q = 0; q < 4; ++q) { u32x2 o; o[0] = pack2(zv[4 * q], zv[4 * q + 1]); o[1] = pack2(zv[4 * q + 2], zv[4 * q + 3]);
          *(u32x2*)(oZt + vloc * 40 + 4 * (2 * q + h)) = o; }
        } }
      else if (wave >= 4 && hl_on) {
#pragma unroll
        for (int i = 0; i < 8; ++i) {
          const int s = (wave - 4) + 4 * i; const int c = lane;
          const float kraw = sKD[s * 64 + c], a = sKKA[s * 64 + c], rr = sR[s * 64 + c];
          const float pk = kraw * kkc; const float ss = wave_sum(pk * pk);
          const float kk = pk * rsqrtf(fmaxf(ss, 1e-24f));
          const float kd = kraw * (1.f + (a - 1.f) * kac);
          const float bs = wave_sum(rr * kd * rkc);
          sKD[s * 64 + c] = kd; sKK[s * 64 + c] = kk; sKKA[s * 64 + c] = kk * a;
          if (c == 0) { const int tl = z ? (L - 1 - ((sc + 1) * 32 + s)) : ((sc + 1) * 32 + s); bon[(((size_t)b * L + tl) * 16 + head) * 2 + z] = bs; }
        }
      }
      __syncthreads();
      if (st_on) {
      {
      const int tid = otid(), lane = tid & 63, wave = tid >> 6, r = lane & 31, h = lane >> 5; (void)r; (void)h; (void)lane; (void)wave;
      if (wave < 2) {
        { const float* park = (const float*)(lds + 131840) + wave * 3072 + lane * 4;
#pragma unroll
          for (int gq = 0; gq < 4; ++gq) {
            const float4 a = *(const float4*)(park + gq * 256), bq = *(const float4*)(park + 1024 + gq * 256);
            st0[4 * gq] = a.x; st0[4 * gq + 1] = a.y; st0[4 * gq + 2] = a.z; st0[4 * gq + 3] = a.w;
            st1[4 * gq] = bq.x; st1[4 * gq + 1] = bq.y; st1[4 * gq + 2] = bq.z; st1[4 * gq + 3] = bq.w;
          } }
#pragma unroll
        for (int s = 0; s < 2; ++s) {
          const bf16x8 ub = *(const bf16x8*)(oUc + vloc * 40 + 16 * s + 8 * h), zb = *(const bf16x8*)(oZt + vloc * 40 + 16 * s + 8 * h);
          const bf16x8 g0 = *(const bf16x8*)(oGAt + r * 40 + 16 * s + 8 * h), g1 = *(const bf16x8*)(oGAt + (32 + r) * 40 + 16 * s + 8 * h);
          const bf16x8 b0 = *(const bf16x8*)(oBEt + r * 40 + 16 * s + 8 * h), b1 = *(const bf16x8*)(oBEt + (32 + r) * 40 + 16 * s + 8 * h);
          st0 = MFMA32(g0, ub, st0); st0 = MFMA32(b0, zb, st0);
          st1 = MFMA32(g1, ub, st1); st1 = MFMA32(b1, zb, st1);
        }
#pragma unroll
        for (int gq = 0; gq < 4; ++gq) {
          const float4 l0 = *(const float4*)(lamC + 8 * gq + 4 * h), l1 = *(const float4*)(lamC + 32 + 8 * gq + 4 * h);
          st0[4 * gq] *= l0.x; st0[4 * gq + 1] *= l0.y; st0[4 * gq + 2] *= l0.z; st0[4 * gq + 3] *= l0.w;
          st1[4 * gq] *= l1.x; st1[4 * gq + 1] *= l1.y; st1[4 * gq + 2] *= l1.z; st1[4 * gq + 3] *= l1.w;
        }
      } else if (wave < 4) {
#pragma unroll
        for (int s = 0; s < 2; ++s) {
          const bf16x8 fpb = *(const bf16x8*)(frag + ((1 * 2 + s) * 64 + lane) * 16);
          const u32x4 z8 = cat8(*(const u32x2*)(oZt + vloc * 40 + 16 * s + 4 * h), *(const u32x2*)(oZt + vloc * 40 + 16 * s + 4 * h + 8));
          y0 = MFMA32(fpb, __builtin_bit_cast(bf16x8, z8), y0);
        }
#pragma unroll
        for (int q = 0; q < 16; ++q) {
          const int t = (q & 3) + 8 * (q >> 2) + 4 * h; const int tl = z ? (L - 1 - (sc * 32 + t)) : (sc * 32 + t);
          Yg[((size_t)b * L + tl) * 1024 + head * 64 + vloc] = (bf16_t)f2bf(y0[q]);
        }
      }
      }
      __syncthreads();
      }
    }
#undef SOLVE_ROWS
#undef SCAN_LOAD
    if (g == 0 && wave < 2) {
#pragma unroll
      for (int gq = 0; gq < 4; ++gq) {
        *(float4*)(p.out + OUT_ST + stbase + 8 * gq + 4 * h) = make_float4(st0[4 * gq], st0[4 * gq + 1], st0[4 * gq + 2], st0[4 * gq + 3]);
        *(float4*)(p.out + OUT_ST + stbase + 32 + 8 * gq + 4 * h) = make_float4(st1[4 * gq], st1[4 * gq + 1], st1[4 * gq + 2], st1[4 * gq + 3]);
      }
    }
    __syncthreads();
  }
}

DI void phase_rwkv_combine(const P& p, int g, int jl) {
  const int T = g ? 16384 : 8192;
  const int tid = otid(); const int lane = tid & 63, wave = tid >> 6;
  bf16_t* slots = (bf16_t*)(p.ws + WS_SLOT);
  const float* bon = (const float*)(p.ws + WS_BON);
  for (int t = blockIdx.x * 8 + wave; t < T; t += gridDim.x * 8) {
    const size_t o = (size_t)t * 1024 + 16 * lane; const int head = lane >> 2;
    float y[16], v[16], gg[16];
#pragma unroll
    for (int q = 0; q < 2; ++q) {
      const u32x4 a = *(const u32x4*)(slots + 5 * SLOT_ELEMS + o + 8 * q), bq = *(const u32x4*)(slots + 0 * SLOT_ELEMS + o + 8 * q);
      const u32x4 vq = *(const u32x4*)(slots + 3 * SLOT_ELEMS + o + 8 * q), gq = *(const u32x4*)(slots + 4 * SLOT_ELEMS + o + 8 * q);
#pragma unroll
      for (int i = 0; i < 4; ++i) { y[8 * q + 2 * i] = bflo(a[i]) + bflo(bq[i]); y[8 * q + 2 * i + 1] = bfhi(a[i]) + bfhi(bq[i]);
        v[8 * q + 2 * i] = bflo(vq[i]); v[8 * q + 2 * i + 1] = bfhi(vq[i]); gg[8 * q + 2 * i] = bflo(gq[i]); gg[8 * q + 2 * i + 1] = bfhi(gq[i]); }
    }
    float s = 0.f;
#pragma unroll
    for (int i = 0; i < 16; ++i) s += y[i];
    const float mean = quad_sum(s) * (1.f / 64.f);
    float vs = 0.f;
#pragma unroll
    for (int i = 0; i < 16; ++i) { const float d = y[i] - mean; vs += d * d; }
    const float rstd = rsqrtf(quad_sum(vs) * (1.f / 64.f) + 64e-5f);
    const float bs = bon[((size_t)t * 16 + head) * 2] + bon[((size_t)t * 16 + head) * 2 + 1];
    const float* gw = p.in[22] + jl * 1024 + 16 * lane; const float* gb = p.in[23] + jl * 1024 + 16 * lane;
    float ov[16];
#pragma unroll
    for (int i = 0; i < 16; ++i) ov[i] = ((y[i] - mean) * rstd * gw[i] + gb[i] + bs * v[i]) * silu(gg[i]);
#pragma unroll
    for (int q = 0; q < 2; ++q) { u32x4 w; w[0] = pack2(ov[8 * q], ov[8 * q + 1]); w[1] = pack2(ov[8 * q + 2], ov[8 * q + 3]); w[2] = pack2(ov[8 * q + 4], ov[8 * q + 5]); w[3] = pack2(ov[8 * q + 6], ov[8 * q + 7]);
      *(u32x4*)(slots + 4 * SLOT_ELEMS + o + 8 * q) = w; }
  }
}

DI void phase_conv(const P& p, int g) {
  const int T = g ? 16384 : 8192, Lmask = g ? 4095 : 255;
  bf16_t* slots = (bf16_t*)(p.ws + WS_SLOT);
  const bf16_t* BG = slots + 2 * SLOT_ELEMS; const bf16_t* CG = slots + 3 * SLOT_ELEMS; const bf16_t* U = slots + 4 * SLOT_ELEMS; const bf16_t* G = slots + 5 * SLOT_ELEMS;
  bf16_t* O = slots;
  for (int e = blockIdx.x * NT + otid(); e < T * 128; e += gridDim.x * NT) {
    const int t = e >> 7, c = (e & 127) * 8; const size_t o = (size_t)t * 1024 + c; const int tl = t & Lmask;
    const u32x4 zz = {0u, 0u, 0u, 0u};
    const u32x4 c1 = *(const u32x4*)(CG + o), u1 = *(const u32x4*)(U + o);
    const u32x4 c0 = tl != 0 ? *(const u32x4*)(CG + o - 1024) : zz, u0 = tl != 0 ? *(const u32x4*)(U + o - 1024) : zz;
    const u32x4 c2 = tl != Lmask ? *(const u32x4*)(CG + o + 1024) : zz, u2 = tl != Lmask ? *(const u32x4*)(U + o + 1024) : zz;
    const u32x4 bg = *(const u32x4*)(BG + o), gg = *(const u32x4*)(G + o);
    const float* cw = p.in[30]; const float* cb = p.in[31];
    u32x4 w;
#pragma unroll
    for (int i = 0; i < 4; ++i) {
      const int ch = c + 2 * i;
      const float lo = bflo(bg[i]) * (cw[ch] * bflo(c0[i]) * bflo(u0[i]) + cw[1024 + ch] * bflo(c1[i]) * bflo(u1[i]) + cw[2048 + ch] * bflo(c2[i]) * bflo(u2[i]) + cb[ch]) * silu(bflo(gg[i]));
      const float hi = bfhi(bg[i]) * (cw[ch + 1] * bfhi(c0[i]) * bfhi(u0[i]) + cw[1024 + ch + 1] * bfhi(c1[i]) * bfhi(u1[i]) + cw[2048 + ch + 1] * bfhi(c2[i]) * bfhi(u2[i]) + cb[ch + 1]) * silu(bfhi(gg[i]));
      w[i] = pack2(lo, hi);
    }
    *(u32x4*)(O + o) = w;
  }
}

DI void phase_attn(const P& p, int g, unsigned char* lds) {
  const int tid = otid(), lane = tid & 63, wave = tid >> 6, r = lane & 31, h = lane >> 5;
  const int L = g ? 4096 : 256, Ltot = g ? 4352 : 256, B = g ? 4 : 32;
  const int nq = L >> 6, ntasks = B * 4 * nq, nkt = Ltot >> 6;
  bf16_t* slots = (bf16_t*)(p.ws + WS_SLOT);
  bf16_t* Q = slots + 2 * SLOT_ELEMS; const bf16_t* G = slots + 3 * SLOT_ELEMS;
  const bf16_t* Kb = slots + 4 * SLOT_ELEMS; const bf16_t* Vt = Kb + SLOT_ELEMS / 2;
  const float SC = 0.125f * 1.4426950408889634f;
  for (int task = blockIdx.x; task < ntasks; task += gridDim.x) {
    const int qt = task % nq, kvh = (task / nq) & 3, b = task / (nq * 4);
    const int head = kvh * 4 + (wave >> 1); const int q0 = qt * 64 + (wave & 1) * 32;
    const size_t tok = (size_t)b * L + q0 + r;
    bf16x8 qf[4];
#pragma unroll
    for (int ds = 0; ds < 4; ++ds) qf[ds] = *(const bf16x8*)(Q + tok * 1024 + head * 64 + ds * 16 + h * 8);
    float m = -1e30f, lsum = 0.f;
    f32x16 O0, O1;
#pragma unroll
    for (int i = 0; i < 16; ++i) { O0[i] = 0.f; O1[i] = 0.f; }
    const int lrow = tid >> 3, lc = (tid & 7) * 8;
    const bf16_t* gK = Kb + ((size_t)b * Ltot + lrow) * 256 + kvh * 64 + lc;
    const bf16_t* gV = Vt + ((size_t)(b * 4 + kvh) * 64 + lrow) * Ltot + lc;
    u32x4 rk = *(const u32x4*)gK, rv = *(const u32x4*)gV;
    *(u32x4*)(lds + lrow * 144 + lc * 2) = rk; *(u32x4*)(lds + 9216 + lrow * 144 + lc * 2) = rv;
    __syncthreads();
    for (int kt = 0; kt < nkt; ++kt) {
      const unsigned char* cur = lds + (kt & 1) * 18432; unsigned char* nxt = lds + ((kt + 1) & 1) * 18432;
      if (kt + 1 < nkt) { rk = *(const u32x4*)(gK + (size_t)(kt + 1) * 64 * 256); rv = *(const u32x4*)(gV + (kt + 1) * 64); }
      f32x16 s0, s1;
#pragma unroll
      for (int i = 0; i < 16; ++i) { s0[i] = 0.f; s1[i] = 0.f; }
#pragma unroll
      for (int ds = 0; ds < 4; ++ds) {
        const bf16x8 a0 = *(const bf16x8*)(cur + r * 144 + (ds * 16 + h * 8) * 2);
        const bf16x8 a1 = *(const bf16x8*)(cur + (32 + r) * 144 + (ds * 16 + h * 8) * 2);
        s0 = MFMA32(a0, qf[ds], s0); s1 = MFMA32(a1, qf[ds], s1);
      }
      float tmax = s0[0];
#pragma unroll
      for (int i = 1; i < 16; ++i) tmax = fmaxf(tmax, s0[i]);
#pragma unroll
      for (int i = 0; i < 16; ++i) tmax = fmaxf(tmax, s1[i]);
      tmax = xhalf_max(tmax);
      const float mnew = fmaxf(m, tmax * SC);
      const float alpha = __builtin_amdgcn_exp2f(m - mnew);
      float ps = 0.f;
#pragma unroll
      for (int i = 0; i < 16; ++i) { s0[i] = __builtin_amdgcn_exp2f(s0[i] * SC - mnew); s1[i] = __builtin_amdgcn_exp2f(s1[i] * SC - mnew); ps += s0[i] + s1[i]; }
      lsum = lsum * alpha + ps; m = mnew;
      if (__builtin_amdgcn_ballot_w64(alpha != 1.f) != 0ull) {
#pragma unroll
        for (int i = 0; i < 16; ++i) { O0[i] *= alpha; O1[i] *= alpha; }
      }
      const unsigned char* vs = cur + 9216;
#pragma unroll
      for (int kb = 0; kb < 2; ++kb)
#pragma unroll
        for (int s = 0; s < 2; ++s) {
          u32x4 pk;
#pragma unroll
          for (int j = 0; j < 4; ++j) pk[j] = kb ? pack2(s1[8 * s + 2 * j], s1[8 * s + 2 * j + 1]) : pack2(s0[8 * s + 2 * j], s0[8 * s + 2 * j + 1]);
          const bf16x8 pf = __builtin_bit_cast(bf16x8, pk);
          const int ko = (32 * kb + 16 * s + 4 * h) * 2;
          { const u32x2 lo = *(const u32x2*)(vs + r * 144 + ko), hi = *(const u32x2*)(vs + r * 144 + ko + 16);
            u32x4 av; av[0] = lo[0]; av[1] = lo[1]; av[2] = hi[0]; av[3] = hi[1];
            O0 = MFMA32(__builtin_bit_cast(bf16x8, av), pf, O0); }
          { const u32x2 lo = *(const u32x2*)(vs + (32 + r) * 144 + ko), hi = *(const u32x2*)(vs + (32 + r) * 144 + ko + 16);
            u32x4 av; av[0] = lo[0]; av[1] = lo[1]; av[2] = hi[0]; av[3] = hi[1];
            O1 = MFMA32(__builtin_bit_cast(bf16x8, av), pf, O1); }
        }
      if (kt + 1 < nkt) { *(u32x4*)(nxt + lrow * 144 + lc * 2) = rk; *(u32x4*)(nxt + 9216 + lrow * 144 + lc * 2) = rv; }
      __syncthreads();
    }
    lsum = xhalf_sum(lsum);
    const float inv = 1.f / lsum;
#pragma unroll
    for (int db = 0; db < 2; ++db)
#pragma unroll
      for (int i4 = 0; i4 < 4; ++i4) {
        const size_t o = tok * 1024 + head * 64 + 32 * db + 8 * i4 + 4 * h;
        const u32x2 gq = *(const u32x2*)(G + o);
        const float v0 = (db ? O1[4 * i4] : O0[4 * i4]) * inv, v1 = (db ? O1[4 * i4 + 1] : O0[4 * i4 + 1]) * inv;
        const float v2 = (db ? O1[4 * i4 + 2] : O0[4 * i4 + 2]) * inv, v3 = (db ? O1[4 * i4 + 3] : O0[4 * i4 + 3]) * inv;
        u32x2 w; w[0] = pack2(v0 * silu(bflo(gq[0])), v1 * silu(bfhi(gq[0]))); w[1] = pack2(v2 * silu(bflo(gq[1])), v3 * silu(bfhi(gq[1])));
        *(u32x2*)(slots + 5 * SLOT_ELEMS + o) = w;
      }
  }
}


#define XB_TMO      128
#define XB_XCNT(j)  (256  + 64 * (j))
#define XB_XSUB(j)  (1280 + 64 * (j))
#define XB_XGEN(j)  (2304 + 64 * (j))
#define XB_TOP      3328
#define XB_TOPGEN   3392
#define XCD_BAR_WORDS 3456
#define XB_SPIN_CAP (1u << 22)
#define LAS __attribute__((address_space(3)))
DI unsigned xb_ld(unsigned* p) { return __hip_atomic_load(p, __ATOMIC_RELAXED, __HIP_MEMORY_SCOPE_AGENT); }
DI unsigned xb_add(unsigned* p, unsigned v) { return __hip_atomic_fetch_add(p, v, __ATOMIC_RELAXED, __HIP_MEMORY_SCOPE_AGENT); }
DI unsigned xb_xcc_id() { return (unsigned)__builtin_amdgcn_s_getreg((3 << 11) | 20) & 0xFu; }
#define XB_SPIN(cond, bar) do { unsigned _sp = 0; while (cond) { __builtin_amdgcn_s_sleep(1); \
    if ((++_sp & 255u) == 0u) { if (xb_ld(&(bar)[XB_TMO])) break; if (_sp > XB_SPIN_CAP) { atomicAdd(&(bar)[XB_TMO], 1u); break; } } } } while (0)
struct XcdBarrier { unsigned* bar; unsigned x; volatile LAS unsigned* st; };
DI XcdBarrier xcd_barrier_post(unsigned* bar, volatile LAS unsigned* st) {
  XcdBarrier b; b.bar = bar; b.x = xb_xcc_id(); b.st = st;
  if (threadIdx.x == 0) (void)xb_add(&bar[XB_XCNT(b.x)], 1u);
  return b;
}
DI void xcd_barrier_complete(unsigned* bar, unsigned x, unsigned& nloc, unsigned& nx) {
  const unsigned G = gridDim.x * gridDim.y * gridDim.z;
  unsigned sum, cnt, mine, sp = 0u;
  for (;;) {
    sum = 0u; cnt = 0u; mine = 0u;
#pragma unroll
    for (unsigned j = 0; j < 16; ++j) { const unsigned c = xb_ld(&bar[XB_XCNT(j)]); sum += c; cnt += (c > 0u) ? 1u : 0u; mine = (j == x) ? c : mine; }
    if (sum == G) break;
    __builtin_amdgcn_s_sleep(1);
    if ((++sp & 255u) == 0u) { if (xb_ld(&bar[XB_TMO])) break; if (sp > XB_SPIN_CAP) { atomicAdd(&bar[XB_TMO], 1u); break; } }
  }
  nloc = mine > 0u ? mine : 1u; nx = cnt > 0u ? cnt : 1u;
}
DI void xcd_barrier(const XcdBarrier& b) {
  asm volatile("s_waitcnt vmcnt(0)" ::: "memory");
  __syncthreads();
  if (threadIdx.x == 0) {
    unsigned* bar = b.bar;
    __builtin_amdgcn_s_waitcnt(0);
    unsigned nloc = b.st[0], nx = b.st[1];
    if (nloc == 0u) { xcd_barrier_complete(bar, b.x, nloc, nx); b.st[0] = nloc; b.st[1] = nx; }
    const unsigned old = xb_add(&bar[XB_XSUB(b.x)], 1u);
    const unsigned gen = old / nloc;
    if (old + 1u == (gen + 1u) * nloc) {
      __builtin_amdgcn_fence(__ATOMIC_RELEASE, "agent");
      asm volatile("s_waitcnt vmcnt(0)" ::: "memory");
      const unsigned og = xb_add(&bar[XB_TOP], 1u);
      const unsigned tg = og / nx;
      if (og + 1u == (tg + 1u) * nx) xb_add(&bar[XB_TOPGEN], 1u);
      else XB_SPIN(xb_ld(&bar[XB_TOPGEN]) == tg, bar);
      __builtin_amdgcn_fence(__ATOMIC_ACQUIRE, "agent");
      xb_add(&bar[XB_XGEN(b.x)], 1u);
      asm volatile("s_waitcnt vmcnt(0)" ::: "memory");
    } else {
      XB_SPIN(xb_ld(&bar[XB_XGEN(b.x)]) == gen, bar);
      __builtin_amdgcn_fence(__ATOMIC_ACQUIRE, "agent");
      asm volatile("s_waitcnt vmcnt(0)" ::: "memory");
    }
  }
  __syncthreads();
}

#define GPTR(T, x) ((T*)(__attribute__((address_space(1))) T*)(x))
__global__ void __launch_bounds__(NT) mega(P p) {
  extern __shared__ __attribute__((aligned(16))) unsigned char lds[];
  cg::grid_group grid = cg::this_grid();
  volatile LAS unsigned* st = (volatile LAS unsigned*)(lds + LDS_BYTES - 16);
  if (threadIdx.x < 4) st[threadIdx.x] = 0u;
  __syncthreads();
  const XcdBarrier xbar = xcd_barrier_post((unsigned*)(p.ws + WS_BAR), st);
  phase0(p, lds);
  grid.sync();
  const P& p0 = p;
  for (int step = 0; step < 50; ++step) {
    const int g = step / 25, rem = step - g * 25, layer = rem / 5, sub = rem - layer * 5;
    const int kind = layer % 3, jl = layer / 3;
    const int T = g ? 16384 : 8192, Lmask = g ? 4095 : 255;
    int op = -1;
    if (layer == 4) op = (sub == 0) ? 0 : -1;
    else if (sub == 0) op = 0;
    else if (kind == 0) op = sub == 1 ? 1 : (sub == 2 ? 2 : (sub == 3 ? 3 : 4));
    else if (kind == 1) op = sub == 1 ? 5 : (sub == 2 ? 6 : (sub == 3 ? 4 : -1));
    else op = sub == 1 ? 4 : (sub == 2 ? 7 : (sub == 3 ? 4 : -1));
    if (op < 0) continue;
    P p = p0;
    { size_t zo_ = 0; asm volatile("" : "+s"(zo_)); p.ws = p0.ws + zo_; p.out = p0.out + zo_; }
    bf16_t* slots = (bf16_t*)(p.ws + WS_SLOT);
    const bf16_t* W = (const bf16_t*)(p.ws + WS_W);
    if (op == 0) {
      const float* xin = p.in[g]; float* xout = p.out + (g ? OUT_YS : OUT_YP);
      phase_norm(p, g, layer - 1, layer < 4 ? layer : -1, layer <= 1 ? xin : xout, xout, slots + SLOT_ELEMS, slots);
      if (kind == 1 && g == 1 && layer < 4) phase_cache_copy(p);
    } else if (op == 1) {
      for (int rep = 0; rep < opq(REP_GEMM); ++rep) phase_gemm<1, 0>(p, g, slots, W + (size_t)(RW_IN0 + jl * RW_STRIDE) * 1024, T, 4352, p.in[11] + jl * 6144, Lmask, slots + SLOT_ELEMS, 1, lds);
    } else if (op == 2) {
      for (int rep = 0; rep < opq(REP_SCAN); ++rep) phase_scan(p, g, jl, lds);
    } else if (op == 3) {
      phase_rwkv_combine(p, g, jl);
    } else if (op == 4) {
      const bf16_t* A; const bf16_t* Bt; int N; bf16_t* dst;
      if (sub == 1) { A = slots; Bt = W + (size_t)CV_IN * 1024; N = 4096; dst = slots + 2 * SLOT_ELEMS; }
      else {
        N = 1024; dst = slots + SLOT_ELEMS;
        if (kind == 0) { A = slots + 4 * SLOT_ELEMS; Bt = W + (size_t)(RW_OUT0 + jl * RW_STRIDE) * 1024; }
        else if (kind == 1) { A = slots + 5 * SLOT_ELEMS; Bt = W + (size_t)AT_OUT * 1024; }
        else { A = slots; Bt = W + (size_t)CV_OUT * 1024; }
      }
      for (int rep = 0; rep < opq(REP_GEMM); ++rep) phase_gemm<0, 0>(p, g, A, Bt, T, N, nullptr, 0, dst, 0, lds);
    } else if (op == 5) {
      for (int rep = 0; rep < opq(REP_GEMM); ++rep) phase_gemm<0, 1>(p, g, slots, W + (size_t)AT_IN * 1024, T, 2560, nullptr, 0, nullptr, 0, lds);
    } else if (op == 6) {
      for (int rep = 0; rep < opq(REP_ATTN); ++rep) phase_attn(p, g, lds);
    } else {
      phase_conv(p, g);
    }
    if (!(g == 1 && layer == 4)) for (int rep = 0; rep < opq(REP_SYNC); ++rep) xcd_barrier(xbar);
  }
}

extern "C" void kernel_launch(void* const* d_in, const int* in_sizes, int n_in, void* d_out, int out_size, void* d_ws, size_t ws_size, hipStream_t stream) {
  static int grid_blocks = 0;
  if (!grid_blocks) {
    int dev = 0, cus = 0, per_cu = 0;
    hipGetDevice(&dev);
    hipDeviceGetAttribute(&cus, hipDeviceAttributeMultiprocessorCount, dev);
    hipFuncSetAttribute((const void*)mega, hipFuncAttributeMaxDynamicSharedMemorySize, LDS_BYTES);
    hipOccupancyMaxActiveBlocksPerMultiprocessor(&per_cu, (const void*)mega, NT, LDS_BYTES);
    if (per_cu < 1) per_cu = 1;
    if (per_cu > 1) per_cu = 1;
    grid_blocks = cus * per_cu;
    if (ws_size < WS_SLOT + 6 * SLOT_ELEMS * 2) fprintf(stderr, "workspace too small: %zu\n", ws_size);
  }
  (void)hipMemsetAsync((unsigned char*)d_ws + WS_BAR, 0, XCD_BAR_WORDS * sizeof(unsigned), stream);
  P p{};
  for (int i = 0; i < 33; ++i) p.in[i] = (const float*)d_in[i];
  p.out = (float*)d_out; p.ws = (unsigned char*)d_ws;
  void* args[] = {&p};
  hipError_t e = hipLaunchCooperativeKernel((const void*)mega, dim3(grid_blocks), dim3(NT), args, LDS_BYTES, stream);
  if (e != hipSuccess) fprintf(stderr, "cooperative launch failed: %s (grid %d)\n", hipGetErrorString(e), grid_blocks);
}
```

```cpp
#include <hip/hip_runtime.h>
#include <hip/hip_cooperative_groups.h>
#include <cstdio>
namespace cg = cooperative_groups;

typedef unsigned short bf16_t;
using bf16x8 = __attribute__((ext_vector_type(8))) short;
using f32x16 = __attribute__((ext_vector_type(16))) float;
using u32x4 = __attribute__((ext_vector_type(4))) unsigned;
using u32x2 = __attribute__((ext_vector_type(2))) unsigned;

#define NT 512
#ifndef REP_GEMM
#define REP_GEMM 1
#endif
#ifndef REP_SCAN
#define REP_SCAN 1
#endif
#ifndef REP_ATTN
#define REP_ATTN 1
#endif
#ifndef REP_SYNC
#define REP_SYNC 1
#endif
#define DI __device__ __forceinline__
#define MFMA32(a, b, c) __builtin_amdgcn_mfma_f32_32x32x16_bf16((a), (b), (c), 0, 0, 0)

struct P { const float* in[33]; float* out; unsigned char* ws; };

constexpr size_t WS_ADA = 0;
constexpr size_t WS_ROPE = 262144;
constexpr size_t WS_BON = 327680;
constexpr size_t WS_HID = WS_BON + 2097152;
constexpr size_t WS_W = WS_HID + 8388608;
constexpr size_t WS_SLOT = WS_W + 39845888;
constexpr size_t SLOT_ELEMS = (size_t)16384 * 1024;
constexpr int RW_IN0 = 0, RW_OUT0 = 4352, RW_STRIDE = 5376, AT_IN = 10752, AT_OUT = 13312, CV_IN = 14336, CV_OUT = 18432;
constexpr size_t OUT_YP = 0, OUT_YS = 8388608, OUT_ST = 25165824, OUT_CK = 33554432, OUT_CV = 35651584;
constexpr int LDS_BYTES = 156416 + 16;
constexpr size_t WS_BAR = 278528;

typedef __bf16 bf16x2_t __attribute__((ext_vector_type(2)));
typedef float f32x2_t __attribute__((ext_vector_type(2)));
DI unsigned pack2(float a, float b) { f32x2_t v = {a, b}; return __builtin_bit_cast(unsigned, __builtin_convertvector(v, bf16x2_t)); }
DI unsigned f2bf(float x) { return (unsigned)__builtin_bit_cast(unsigned short, (__bf16)x); }
DI float bflo(unsigned u) { return __uint_as_float(u << 16); }
DI float bfhi(unsigned u) { return __uint_as_float(u & 0xffff0000u); }
DI float bf1(bf16_t u) { return __uint_as_float(((unsigned)u) << 16); }

template <int CTRL> DI float dppf(float v) { return __int_as_float(__builtin_amdgcn_update_dpp(0, __float_as_int(v), CTRL, 0xF, 0xF, true)); }
DI float reduce16(float v) { v += dppf<0xB1>(v); v += dppf<0x4E>(v); v += dppf<0x141>(v); v += dppf<0x140>(v); return v; }
DI float rdl(float v, int l) { return __int_as_float(__builtin_amdgcn_readlane(__float_as_int(v), l)); }
DI float wave_sum(float v) { v = reduce16(v); return (rdl(v, 0) + rdl(v, 16)) + (rdl(v, 32) + rdl(v, 48)); }
DI float xhalf_max(float x) { const auto r2 = __builtin_amdgcn_permlane32_swap(__float_as_uint(x), __float_as_uint(x), false, false); return fmaxf(__uint_as_float(r2[0]), __uint_as_float(r2[1])); }
DI float xhalf_sum(float x) { const auto r2 = __builtin_amdgcn_permlane32_swap(__float_as_uint(x), __float_as_uint(x), false, false); return __uint_as_float(r2[0]) + __uint_as_float(r2[1]); }
DI float quad_sum(float v) { v += dppf<0xB1>(v); v += dppf<0x4E>(v); return v; }
DI float silu(float x) { return x / (1.f + __expf(-x)); }
DI int opq(int v) { asm volatile("" : "+s"(v)); return v; }
DI int otid() { int t = threadIdx.x; asm volatile("" : "+v"(t)); return t; }

DI void conv_tiles(const float* __restrict__ src, int N, bf16_t* __restrict__ dst, float* lds) {
  const int tid = otid();
  const int tilesN = N >> 6, ntiles = 16 * tilesN;
  for (int tile = blockIdx.x; tile < ntiles; tile += gridDim.x) {
    const int kt = tile / tilesN, nt = tile - kt * tilesN, k0 = kt * 64, n0 = nt * 64;
#pragma unroll
    for (int i = 0; i < 8; ++i) { const int k = (tid >> 6) + 8 * i, n = tid & 63; lds[k * 65 + n] = src[(size_t)(k0 + k) * N + n0 + n]; }
    __syncthreads();
    { const int n = tid >> 3, kc = (tid & 7) * 8; u32x4 o;
#pragma unroll
      for (int j = 0; j < 4; ++j) o[j] = pack2(lds[(kc + 2 * j) * 65 + n], lds[(kc + 2 * j + 1) * 65 + n]);
      *(u32x4*)(dst + (size_t)(n0 + n) * 1024 + k0 + kc) = o; }
    __syncthreads();
  }
}

DI void phase0(const P& p, unsigned char* ldsb) {
  float* lds = (float*)ldsb;
  const int tid = otid();
  bf16_t* W = (bf16_t*)(p.ws + WS_W);
#pragma unroll 1
  for (int e = 0; e < opq(22); ++e) {
    const float* src; int N, drow;
    if (e < 18) {
      const int j = e / 9, q = e - j * 9;
      if (q < 4) { src = p.in[12] + (size_t)(j * 4 + q) * 1048576; N = 1024; drow = RW_IN0 + j * RW_STRIDE + q * 1024; }
      else if (q < 6) { src = p.in[14] + (size_t)(j * 2 + q - 4) * 65536; N = 64; drow = RW_IN0 + j * RW_STRIDE + 4096 + (q - 4) * 64; }
      else if (q < 8) { src = p.in[17] + (size_t)(j * 2 + q - 6) * 65536; N = 64; drow = RW_IN0 + j * RW_STRIDE + 4224 + (q - 6) * 64; }
      else { src = p.in[24] + (size_t)j * 1048576; N = 1024; drow = RW_OUT0 + j * RW_STRIDE; }
    } else if (e == 18) { src = p.in[25]; N = 2560; drow = AT_IN; }
    else if (e == 19) { src = p.in[28]; N = 1024; drow = AT_OUT; }
    else if (e == 20) { src = p.in[29]; N = 4096; drow = CV_IN; }
    else { src = p.in[32]; N = 1024; drow = CV_OUT; }
    conv_tiles(src, N, W + (size_t)drow * 1024, lds);
  }
  {
    float* scond = lds;
    float* red = lds + 5120;
    for (int e = tid; e < 5120; e += NT) { const int cnd = e >> 10, k = e & 1023; const float cv = cnd == 0 ? p.in[6][k] : p.in[5][(cnd - 1) * 1024 + k]; scond[e] = silu(cv); }
    __syncthreads();
    float* ada = (float*)(p.ws + WS_ADA);
    for (int task = blockIdx.x; task < 192; task += gridDim.x) {
      const int layer = task / 48, n0 = (task % 48) * 64, c = tid & 63, kg = tid >> 6;
      float a0 = 0.f, a1 = 0.f, a2 = 0.f, a3 = 0.f, a4 = 0.f;
      const float* wp = p.in[9] + ((size_t)layer * 1024 + kg * 128) * 3072 + n0 + c;
#pragma unroll 8
      for (int k = 0; k < 128; ++k) { const float w = wp[(size_t)k * 3072]; const int kk = kg * 128 + k;
        a0 += scond[kk] * w; a1 += scond[1024 + kk] * w; a2 += scond[2048 + kk] * w; a3 += scond[3072 + kk] * w; a4 += scond[4096 + kk] * w; }
      red[(kg * 5 + 0) * 64 + c] = a0; red[(kg * 5 + 1) * 64 + c] = a1; red[(kg * 5 + 2) * 64 + c] = a2; red[(kg * 5 + 3) * 64 + c] = a3; red[(kg * 5 + 4) * 64 + c] = a4;
      __syncthreads();
      if (tid < 320) { const int cnd = tid >> 6; float s = p.in[10][layer * 3072 + n0 + c];
#pragma unroll
        for (int q = 0; q < 8; ++q) s += red[(q * 5 + cnd) * 64 + c];
        ada[(cnd * 4 + layer) * 3072 + n0 + c] = s; }
      __syncthreads();
    }
  }
  if (blockIdx.x == gridDim.x - 1) {
    float* rope = (float*)(p.ws + WS_ROPE);
    for (int e = tid; e < 1024; e += NT) {
      const int pos = e >> 4, f = e & 15;
      double inv = 1.0; for (int q = 0; q < f; ++q) inv *= 0.5623413251903491;
      double ang = (double)pos * inv;
      const double twopi = 6.283185307179586476925286766559;
      double n = __builtin_rint(ang / twopi); double rr = ang - n * twopi;
      double r2 = rr * rr, sn = 0.0, cs = 0.0, ts = rr, tc = 1.0;
      for (int q = 0; q < 16; ++q) { cs += tc; sn += ts; tc = -tc * r2 / (double)((2 * q + 1) * (2 * q + 2)); ts = -ts * r2 / (double)((2 * q + 2) * (2 * q + 3)); }
      rope[e * 2] = (float)cs; rope[e * 2 + 1] = (float)sn;
    }
  }
}

DI void phase_norm(const P& p, int g, int lpost, int lpre, const float* __restrict__ xsrc, float* __restrict__ xdst,
                   const bf16_t* __restrict__ Mb, bf16_t* __restrict__ H) {
  const int T = g ? 16384 : 8192;
  const int tid = otid(); const int lane = tid & 63, wave = tid >> 6;
  const float* ada = (const float*)(p.ws + WS_ADA);
  float4 xn[4]; u32x2 mn[4];
  const int t0 = blockIdx.x * 8 + wave, tstep = gridDim.x * 8;
#pragma unroll
  for (int i = 0; i < 4; ++i) { xn[i] = make_float4(0.f, 0.f, 0.f, 0.f); mn[i] = (u32x2){0u, 0u}; }
  if (t0 < T) {
#pragma unroll
    for (int i = 0; i < 4; ++i) { xn[i] = *(const float4*)(xsrc + (size_t)t0 * 1024 + 256 * i + 4 * lane); if (lpost >= 0) mn[i] = *(const u32x2*)(Mb + (size_t)t0 * 1024 + 256 * i + 4 * lane); }
  }
  for (int t = t0; t < T; t += tstep) {
    const int cond = g ? 1 + (t >> 12) : 0;
    float4 x[4]; u32x2 mr[4];
#pragma unroll
    for (int i = 0; i < 4; ++i) { x[i] = xn[i]; mr[i] = mn[i]; }
    if (t + tstep < T) {
#pragma unroll
      for (int i = 0; i < 4; ++i) { xn[i] = *(const float4*)(xsrc + (size_t)(t + tstep) * 1024 + 256 * i + 4 * lane); if (lpost >= 0) mn[i] = *(const u32x2*)(Mb + (size_t)(t + tstep) * 1024 + 256 * i + 4 * lane); }
    }
    if (lpost >= 0) {
      float m[16]; float ss = 0.f;
#pragma unroll
      for (int i = 0; i < 4; ++i) { const u32x2 u = mr[i];
        m[4 * i] = bflo(u[0]); m[4 * i + 1] = bfhi(u[0]); m[4 * i + 2] = bflo(u[1]); m[4 * i + 3] = bfhi(u[1]); }
#pragma unroll
      for (int i = 0; i < 16; ++i) ss += m[i] * m[i];
      ss = wave_sum(ss);
      const float rs = rsqrtf(ss * (1.f / 1024.f) + 1e-6f);
      const float* gate = ada + (cond * 4 + lpost) * 3072 + 2048;
      const float* wpo = p.in[8] + lpost * 1024;
#pragma unroll
      for (int i = 0; i < 4; ++i) { const int c = 256 * i + 4 * lane; const float4 gt = *(const float4*)(gate + c); const float4 wv = *(const float4*)(wpo + c);
        x[i].x += gt.x * (m[4 * i] * rs * wv.x); x[i].y += gt.y * (m[4 * i + 1] * rs * wv.y); x[i].z += gt.z * (m[4 * i + 2] * rs * wv.z); x[i].w += gt.w * (m[4 * i + 3] * rs * wv.w);
        *(float4*)(xdst + (size_t)t * 1024 + c) = x[i]; }
    }
    if (lpre >= 0) {
      float ss = 0.f;
#pragma unroll
      for (int i = 0; i < 4; ++i) ss += x[i].x * x[i].x + x[i].y * x[i].y + x[i].z * x[i].z + x[i].w * x[i].w;
      ss = wave_sum(ss);
      const float rs = rsqrtf(ss * (1.f / 1024.f) + 1e-6f);
      const float* sh = ada + (cond * 4 + lpre) * 3072; const float* sc = sh + 1024; const float* wpr = p.in[7] + lpre * 1024;
#pragma unroll
      for (int i = 0; i < 4; ++i) { const int c = 256 * i + 4 * lane; const float4 s4 = *(const float4*)(sh + c); const float4 c4 = *(const float4*)(sc + c); const float4 wv = *(const float4*)(wpr + c);
        u32x2 o; o[0] = pack2(x[i].x * rs * wv.x * (1.f + c4.x) + s4.x, x[i].y * rs * wv.y * (1.f + c4.y) + s4.y);
        o[1] = pack2(x[i].z * rs * wv.z * (1.f + c4.z) + s4.z, x[i].w * rs * wv.w * (1.f + c4.w) + s4.w);
        *(u32x2*)(H + (size_t)t * 1024 + c) = o; }
    }
  }
}

DI void phase_cache_copy(const P& p) {
  bf16_t* Kb = (bf16_t*)(p.ws + WS_SLOT) + 4 * SLOT_ELEMS; bf16_t* Vt = Kb + SLOT_ELEMS / 2;
  for (int e = blockIdx.x * NT + otid(); e < 262144; e += gridDim.x * NT) {
    const int c = e & 255, pp = (e >> 8) & 255, b = e >> 16; const int kvh = c >> 6, d = c & 63;
    Kb[((size_t)b * 4352 + 4096 + pp) * 256 + c] = (bf16_t)f2bf(p.in[3][e]);
    Vt[((size_t)(b * 4 + kvh) * 64 + d) * 4352 + 4096 + pp] = (bf16_t)f2bf(p.in[4][e]);
  }
}

template <int SHIFT> DI void ld_half(const bf16_t* __restrict__ A, int t, int k, int Lmask, u32x4 (&raw)[4]) {
  raw[1] = *(const u32x4*)(A + (size_t)t * 1024 + k);
  raw[2] = *(const u32x4*)(A + (size_t)(t + 1) * 1024 + k);
  if (SHIFT) {
    raw[0] = (u32x4){0u, 0u, 0u, 0u}; raw[3] = (u32x4){0u, 0u, 0u, 0u};
    if ((t & Lmask) != 0) raw[0] = *(const u32x4*)(A + (size_t)(t - 1) * 1024 + k);
    if (((t + 1) & Lmask) != Lmask) raw[3] = *(const u32x4*)(A + (size_t)(t + 2) * 1024 + k);
  }
}
DI u32x4 mix3(const u32x4& c, const u32x4& pz, const u32x4& nz, const float* smu, int k) {
  const float4 m0 = *(const float4*)(smu + k), m1 = *(const float4*)(smu + k + 4);
  const float mu[8] = {m0.x, m0.y, m0.z, m0.w, m1.x, m1.y, m1.z, m1.w};
  u32x4 o;
#pragma unroll
  for (int i = 0; i < 4; ++i) {
    const float h0 = bflo(c[i]), h1 = bfhi(c[i]);
    const float x0 = h0 + (0.5f * (bflo(pz[i]) + bflo(nz[i])) - h0) * mu[2 * i];
    const float x1 = h1 + (0.5f * (bfhi(pz[i]) + bfhi(nz[i])) - h1) * mu[2 * i + 1];
    o[i] = pack2(x0, x1);
  }
  return o;
}
DI int swz(int row, int c) { return row * 128 + ((c ^ ((row >> 1) & 7)) << 4); }
template <int SHIFT> DI void st_half(unsigned char* base, int row, int c, const u32x4 (&raw)[4], const float* smu, int k) {
  if (!SHIFT) { *(u32x4*)(base + swz(row, c)) = raw[1]; *(u32x4*)(base + swz(row + 1, c)) = raw[2]; }
  else { *(u32x4*)(base + swz(row, c)) = mix3(raw[1], raw[0], raw[2], smu, k); *(u32x4*)(base + swz(row + 1, c)) = mix3(raw[2], raw[1], raw[3], smu, k); }
}

template <int SHIFT, int EPI>
DI void phase_gemm(const P& p, int g, const bf16_t* __restrict__ A, const bf16_t* __restrict__ Bt, int M, int N,
                   const float* __restrict__ mu, int Lmask, bf16_t* __restrict__ dst, int rw, unsigned char* lds) {
  const int tid = otid(), lane = tid & 63, wave = tid >> 6;
  const int wm = wave >> 1, wn = wave & 1, r = lane & 31, h = lane >> 5;
  const int ntn = N >> 7, ntiles = ntn * (M >> 8);
  float* Cs = (float*)lds;
  float* smu = (float*)(lds + 110592);
  const bool xo = (gridDim.x == 256) && ((ntiles & 7) == 0);
  const int nper = xo ? (ntiles >> 3) : ntiles, tbase = xo ? (blockIdx.x & 7) * nper : 0, tfirst = xo ? (blockIdx.x >> 3) : blockIdx.x, tstep = xo ? 32 : gridDim.x;
  for (int tl_ = tfirst; tl_ < nper; tl_ += tstep) {
    const int tile = tbase + tl_;
    const int mt = tile / ntn, nt = tile - mt * ntn; const int m0 = mt * 256, n0 = nt * 128;
    f32x16 acc[2][2];
#pragma unroll
    for (int a = 0; a < 2; ++a)
#pragma unroll
      for (int b = 0; b < 2; ++b)
#pragma unroll
        for (int i = 0; i < 16; ++i) acc[a][b][i] = 0.f;
    if (SHIFT) {
      const float* mup = mu + (nt < 32 ? (nt >> 3) : (nt == 32 ? 4 : 5)) * 1024;
      smu[tid] = mup[tid]; smu[tid + 512] = mup[tid + 512];
      __syncthreads();
    }
    if (!SHIFT) {
      u32x4 s0[6], s1[6];
      const int lrow = tid >> 3, lkc = (tid & 7) * 8;
#define G_LOAD(S, K0)  { _Pragma("unroll") for (int i = 0; i < 4; ++i) S[i] = *(const u32x4*)(A + (size_t)(m0 + lrow + 64 * i) * 1024 + (K0) + lkc); \
                         _Pragma("unroll") for (int i = 0; i < 2; ++i) S[4 + i] = *(const u32x4*)(Bt + (size_t)(n0 + lrow + 64 * i) * 1024 + (K0) + lkc); }
#define G_STORE(S, BUF) { _Pragma("unroll") for (int i = 0; i < 4; ++i) *(u32x4*)((BUF) + swz(lrow + 64 * i, tid & 7)) = S[i]; \
                          _Pragma("unroll") for (int i = 0; i < 2; ++i) *(u32x4*)((BUF) + 32768 + swz(lrow + 64 * i, tid & 7)) = S[4 + i]; }
#define G_COMPUTE(BUF) { _Pragma("unroll") for (int ks = 0; ks < 4; ++ks) { const int kc_ = ks * 2 + h; \
        const bf16x8 a0 = *(const bf16x8*)((BUF) + swz(wm * 64 + r, kc_)); const bf16x8 a1 = *(const bf16x8*)((BUF) + swz(wm * 64 + 32 + r, kc_)); \
        const bf16x8 b0 = *(const bf16x8*)((BUF) + 32768 + swz(wn * 64 + r, kc_)); const bf16x8 b1 = *(const bf16x8*)((BUF) + 32768 + swz(wn * 64 + 32 + r, kc_)); \
        acc[0][0] = MFMA32(a0, b0, acc[0][0]); acc[0][1] = MFMA32(a0, b1, acc[0][1]); acc[1][0] = MFMA32(a1, b0, acc[1][0]); acc[1][1] = MFMA32(a1, b1, acc[1][1]); } }
      G_LOAD(s0, 0) G_STORE(s0, lds)
      G_LOAD(s0, 64) G_LOAD(s1, 128)
      __syncthreads();
      for (int kt = 0; kt < 16; kt += 2) {
        G_COMPUTE(lds)
        G_STORE(s0, lds + 49152)
        if (kt + 3 < 16) G_LOAD(s0, (kt + 3) * 64)
        __syncthreads();
        G_COMPUTE(lds + 49152)
        if (kt + 2 < 16) G_STORE(s1, lds)
        if (kt + 4 < 16) G_LOAD(s1, (kt + 4) * 64)
        __syncthreads();
      }
#undef G_LOAD
#undef G_STORE
#undef G_COMPUTE
    } else {
    u32x4 raw[4], raw2[4], rb[2];
    const int arow = 4 * (tid >> 3), akc = (tid & 7) * 8;
#pragma unroll
    for (int hf = 0; hf < 2; ++hf) { ld_half<SHIFT>(A, m0 + arow + 2 * hf, akc, Lmask, raw); st_half<SHIFT>(lds, arow + 2 * hf, tid & 7, raw, smu, akc); }
#pragma unroll
    for (int i = 0; i < 2; ++i) { const int id = tid + 512 * i; rb[i] = *(const u32x4*)(Bt + (size_t)(n0 + (id >> 3)) * 1024 + (id & 7) * 8); }
#pragma unroll
    for (int i = 0; i < 2; ++i) { const int id = tid + 512 * i; *(u32x4*)(lds + 32768 + swz(id >> 3, id & 7)) = rb[i]; }
    __syncthreads();
    for (int kt = 0; kt < 16; ++kt) {
      unsigned char* cur = lds + (kt & 1) * 49152; unsigned char* nxt = lds + ((kt + 1) & 1) * 49152;
      const int k1 = (kt + 1) * 64;
      if (kt < 15) {
        ld_half<SHIFT>(A, m0 + arow, k1 + akc, Lmask, raw);
        ld_half<SHIFT>(A, m0 + arow + 2, k1 + akc, Lmask, raw2);
#pragma unroll
        for (int i = 0; i < 2; ++i) { const int id = tid + 512 * i; rb[i] = *(const u32x4*)(Bt + (size_t)(n0 + (id >> 3)) * 1024 + k1 + (id & 7) * 8); }
      }
#pragma unroll
      for (int ks = 0; ks < 4; ++ks) {
        const int kc_ = ks * 2 + h;
        const bf16x8 a0 = *(const bf16x8*)(cur + swz(wm * 64 + r, kc_));
        const bf16x8 a1 = *(const bf16x8*)(cur + swz(wm * 64 + 32 + r, kc_));
        const bf16x8 b0 = *(const bf16x8*)(cur + 32768 + swz(wn * 64 + r, kc_));
        const bf16x8 b1 = *(const bf16x8*)(cur + 32768 + swz(wn * 64 + 32 + r, kc_));
        acc[0][0] = MFMA32(a0, b0, acc[0][0]); acc[0][1] = MFMA32(a0, b1, acc[0][1]);
        acc[1][0] = MFMA32(a1, b0, acc[1][0]); acc[1][1] = MFMA32(a1, b1, acc[1][1]);
      }
      if (kt < 15) {
        st_half<SHIFT>(nxt, arow, tid & 7, raw, smu, k1 + akc);
        st_half<SHIFT>(nxt, arow + 2, tid & 7, raw2, smu, k1 + akc);
#pragma unroll
        for (int i = 0; i < 2; ++i) { const int id = tid + 512 * i; *(u32x4*)(nxt + 32768 + swz(id >> 3, id & 7)) = rb[i]; }
      }
      __syncthreads();
    }
    }
#pragma unroll
    for (int mi = 0; mi < 2; ++mi)
#pragma unroll
      for (int ni = 0; ni < 2; ++ni)
#pragma unroll
        for (int i = 0; i < 16; ++i) {
          const int row = wm * 64 + mi * 32 + (i & 3) + 8 * (i >> 2) + 4 * h, col = wn * 64 + ni * 32 + r;
          Cs[row * 132 + col] = acc[mi][ni][i];
        }
    __syncthreads();
    if (EPI == 0) {
#pragma unroll
      for (int i = 0; i < 8; ++i) {
        const int id = tid + 512 * i, row = id >> 4, cc = (id & 15) * 8;
        float4 v0 = *(const float4*)(Cs + row * 132 + cc), v1 = *(const float4*)(Cs + row * 132 + cc + 4);
        if (rw && nt == 32) { v0.x = tanhf(v0.x); v0.y = tanhf(v0.y); v0.z = tanhf(v0.z); v0.w = tanhf(v0.w); v1.x = tanhf(v1.x); v1.y = tanhf(v1.y); v1.z = tanhf(v1.z); v1.w = tanhf(v1.w); }
        u32x4 o; o[0] = pack2(v0.x, v0.y); o[1] = pack2(v0.z, v0.w); o[2] = pack2(v1.x, v1.y); o[3] = pack2(v1.z, v1.w);
        if (rw && nt >= 32) *(u32x4*)((bf16_t*)(p.ws + WS_HID) + (size_t)(m0 + row) * 256 + (nt - 32) * 128 + cc) = o;
        else *(u32x4*)(dst + (size_t)(nt >> 3) * SLOT_ELEMS + (size_t)(m0 + row) * 1024 + (nt & 7) * 128 + cc) = o;
      }
    } else {
      const int row = tid & 255, hh = tid >> 8; const int t = m0 + row;
      float x[64];
#pragma unroll
      for (int q = 0; q < 16; ++q) { const float4 v = *(const float4*)(Cs + row * 132 + hh * 64 + 4 * q); x[4 * q] = v.x; x[4 * q + 1] = v.y; x[4 * q + 2] = v.z; x[4 * q + 3] = v.w; }
      bf16_t* slots = (bf16_t*)(p.ws + WS_SLOT);
      const int L = g ? 4096 : 256, Ltot = g ? 4352 : 256;
      const int b = g ? (t >> 12) : (t >> 8), s = t & (L - 1);
      if (nt < 10) {
        int vz = 0; asm volatile("" : "+v"(vz));
        const float* nw = (nt < 8 ? p.in[26] : p.in[27]) + vz;
        float ss = 0.f;
#pragma unroll
        for (int d = 0; d < 64; ++d) ss += x[d] * x[d];
        const float rs = rsqrtf(ss * (1.f / 64.f) + 1e-6f);
#pragma unroll
        for (int d = 0; d < 64; ++d) x[d] *= rs * nw[d];
        if (g == 0 && nt >= 8) {
          float* ck = p.out + OUT_CK + (size_t)t * 256 + ((nt - 8) * 2 + hh) * 64;
#pragma unroll
          for (int q = 0; q < 16; ++q) *(float4*)(ck + 4 * q) = make_float4(x[4 * q], x[4 * q + 1], x[4 * q + 2], x[4 * q + 3]);
        }
        if (g == 1) {
          const float2* rope = (const float2*)(p.ws + WS_ROPE);
          const int ri = s >> 6, ci = s & 63;
#pragma unroll
          for (int f = 0; f < 16; ++f) {
            const float2 cr = rope[ri * 16 + f]; const float x1 = x[f], x2 = x[16 + f];
            x[f] = x1 * cr.x - x2 * cr.y; x[16 + f] = x2 * cr.x + x1 * cr.y;
            const float2 cc = rope[ci * 16 + f]; const float y1 = x[32 + f], y2 = x[48 + f];
            x[32 + f] = y1 * cc.x - y2 * cc.y; x[48 + f] = y2 * cc.x + y1 * cc.y;
          }
        }
        bf16_t* dq = nt < 8 ? slots + 2 * SLOT_ELEMS + (size_t)t * 1024 + (nt * 2 + hh) * 64
                            : slots + 4 * SLOT_ELEMS + ((size_t)b * Ltot + s) * 256 + ((nt - 8) * 2 + hh) * 64;
#pragma unroll
        for (int q = 0; q < 8; ++q) { u32x4 o; o[0] = pack2(x[8 * q], x[8 * q + 1]); o[1] = pack2(x[8 * q + 2], x[8 * q + 3]); o[2] = pack2(x[8 * q + 4], x[8 * q + 5]); o[3] = pack2(x[8 * q + 6], x[8 * q + 7]); *(u32x4*)(dq + 8 * q) = o; }
      } else if (nt < 12) {
        const int kvh = (nt - 10) * 2 + hh;
        if (g == 0) {
          float* cv = p.out + OUT_CV + (size_t)t * 256 + kvh * 64;
#pragma unroll
          for (int q = 0; q < 16; ++q) *(float4*)(cv + 4 * q) = make_float4(x[4 * q], x[4 * q + 1], x[4 * q + 2], x[4 * q + 3]);
        }
        bf16_t* vt = slots + 4 * SLOT_ELEMS + SLOT_ELEMS / 2 + ((size_t)(b * 4 + kvh) * 64) * Ltot + s;
        { size_t vo = 0;
#pragma unroll
        for (int d = 0; d < 64; ++d) { vt[vo] = (bf16_t)f2bf(x[d]); vo += Ltot; asm volatile("" : "+v"(vo)); } }
      } else {
        bf16_t* dg = slots + 3 * SLOT_ELEMS + (size_t)t * 1024 + (nt - 12) * 128 + hh * 64;
#pragma unroll
        for (int q = 0; q < 8; ++q) { u32x4 o; o[0] = pack2(x[8 * q], x[8 * q + 1]); o[1] = pack2(x[8 * q + 2], x[8 * q + 3]); o[2] = pack2(x[8 * q + 4], x[8 * q + 5]); o[3] = pack2(x[8 * q + 6], x[8 * q + 7]); *(u32x4*)(dg + 8 * q) = o; }
      }
    }
    __syncthreads();
  }
}

DI u32x4 cat8(const u32x2 lo, const u32x2 hi) { u32x4 v; v[0] = lo[0]; v[1] = lo[1]; v[2] = hi[0]; v[3] = hi[1]; return v; }
DI void phase_scan(const P& p, int g, int jl, unsigned char* lds) {
  const int tid = otid(), lane = tid & 63, wave = tid >> 6, r = lane & 31, h = lane >> 5;
  const int L = g ? 4096 : 256, B = g ? 4 : 32, nsc = L >> 5;
  float* sR = (float*)lds; float* sW = sR + 2048; float* sKD = sW + 2048; float* sKK = sKD + 2048; float* sKKA = sKK + 2048;
  bf16_t* sHW = (bf16_t*)(lds + 40960); bf16_t* sHA = (bf16_t*)(lds + 45568);
  bf16_t* oAL = (bf16_t*)(lds + 50176); bf16_t* oRH = (bf16_t*)(lds + 54784); bf16_t* oBE = (bf16_t*)(lds + 59392); bf16_t* oGA = (bf16_t*)(lds + 64000);
  bf16_t* oBEt = (bf16_t*)(lds + 68608); bf16_t* oGAt = (bf16_t*)(lds + 73728); bf16_t* oUt = (bf16_t*)(lds + 78848); bf16_t* oZt = (bf16_t*)(lds + 83968);
  float* Bm = (float*)(lds + 89088); float* RHS = (float*)(lds + 93696); float* lamC = (float*)(lds + 101888); float* sP = (float*)(lds + 102144);
  unsigned char* frag = lds + 104192;
  const bf16_t* slots = (const bf16_t*)(p.ws + WS_SLOT);
  const bf16_t* Rg = slots + 1 * SLOT_ELEMS; const bf16_t* Kg = slots + 2 * SLOT_ELEMS; const bf16_t* Vg = slots + 3 * SLOT_ELEMS;
  const bf16_t* hid = (const bf16_t*)(p.ws + WS_HID);
  float* bon = (float*)(p.ws + WS_BON);
  const int ntasks = B * 32;
  for (int task = blockIdx.x; task < ntasks; task += gridDim.x) {
    const int z = task & 1, head = (task >> 1) & 15, b = task >> 5;
    bf16_t* Yg = (bf16_t*)(p.ws + WS_SLOT) + (z ? 0 : 5) * SLOT_ELEMS;
    const int mat = (wave >> 1) & 1, ntt = wave & 1;
    unsigned char* lfr = lds + 110336 + (wave & 3) * 4096;
    if (wave >= 4) {
      const float* W2 = (mat ? p.in[18] : p.in[15]) + (size_t)(jl * 2 + z) * 65536 + head * 64 + 32 * ntt + r;
#pragma unroll
      for (int kk = 0; kk < 4; ++kk) { u32x4 pk;
#pragma unroll
        for (int j = 0; j < 4; ++j) pk[j] = pack2(W2[(size_t)(16 * kk + 8 * h + 2 * j) * 1024], W2[(size_t)(16 * kk + 8 * h + 2 * j + 1) * 1024]);
        *(u32x4*)(lfr + (kk * 64 + lane) * 16) = pk; }
    }
    const float bias = (mat ? p.in[16] : p.in[13])[(jl * 2 + z) * 1024 + head * 64 + 32 * ntt + r];
    const float kkc = p.in[19][jl * 1024 + head * 64 + lane], kac = p.in[20][jl * 1024 + head * 64 + lane], rkc = p.in[21][jl * 1024 + head * 64 + lane];
    f32x16 st0, st1;
#pragma unroll
    for (int q = 0; q < 16; ++q) { st0[q] = 0.f; st1[q] = 0.f; }
    const size_t stbase = ((((size_t)(b * 2 + jl) * 2 + z) * 16 + head) * 64 + (32 * (wave & 1) + r)) * 64;
    if (g && wave < 2) {
#pragma unroll
      for (int gq = 0; gq < 4; ++gq) {
        const float4 s0 = *(const float4*)(p.in[2] + stbase + 8 * gq + 4 * h), s1 = *(const float4*)(p.in[2] + stbase + 32 + 8 * gq + 4 * h);
        st0[4 * gq] = s0.x; st0[4 * gq + 1] = s0.y; st0[4 * gq + 2] = s0.z; st0[4 * gq + 3] = s0.w;
        st1[4 * gq] = s1.x; st1[4 * gq + 1] = s1.y; st1[4 * gq + 2] = s1.z; st1[4 * gq + 3] = s1.w;
      }
    }
    u32x4 pre[5];
    const int ht = tid - 256;
#define SCAN_LOAD(sc_)                                                                                    \
    { const int ht2 = otid() - 256;                                                                       \
    _Pragma("unroll") for (int i = 0; i < 5; ++i) {                                                       \
      const int id = ht2 + 256 * i;                                                                       \
      const int arr = id >> 8, s = (id >> 3) & 31, cc = (id & 7) * 8;                                     \
      const int tl = z ? (L - 1 - ((sc_) * 32 + s)) : ((sc_) * 32 + s);                                   \
      const size_t tok = (size_t)b * L + tl;                                                              \
      if (arr < 3) pre[i] = *(const u32x4*)((arr == 0 ? Rg : (arr == 1 ? Kg : Vg)) + tok * 1024 + head * 64 + cc); \
      else pre[i] = *(const u32x4*)(hid + tok * 256 + (arr - 3) * 128 + z * 64 + cc);                     \
    } }
#define NQ(t_) ((((t_) + 3) / 4 + 1) / 2)
#define SOLVE_ROWS(T0, T1)                                                                                \
    _Pragma("unroll") for (int t = (T0); t < (T1); ++t) {                                                 \
      if (t + 2 < 32) {                                                                                   \
        n2rhs = RHo[(t + 2) * 64];                                                                        \
        _Pragma("unroll") for (int q = 0; q < NQ(t + 2); ++q) { const f4v q4 = *(const __attribute__((address_space(3))) f4v*)(Bmo + (t + 2) * 36 + 8 * q); nc8[q] = make_float4(q4[0], q4[1], q4[2], q4[3]); } \
      }                                                                                                   \
      float a0s = crhs * mh, a1s = 0.f;                                                                   \
      _Pragma("unroll") for (int q = 0; q < NQ(t); ++q) {                                                 \
        a0s -= cb[q].x * zv[4 * q]; a1s -= cb[q].y * zv[4 * q + 1]; a0s -= cb[q].z * zv[4 * q + 2]; a1s -= cb[q].w * zv[4 * q + 3]; } \
      float zt = xhalf_sum(a0s + a1s);                                                                    \
      asm volatile("" : "+v"(zt) :: "memory");                                                            \
      zv[4 * (t >> 3) + (t & 3)] = ((((t >> 2) & 1) == h)) ? zt : zv[4 * (t >> 3) + (t & 3)];             \
      crhs = nrhs; nrhs = n2rhs;                                                                          \
      _Pragma("unroll") for (int q = 0; q < 4; ++q) { cb[q] = nb8[q]; nb8[q] = nc8[q]; }                  \
    }
    typedef float f4v __attribute__((ext_vector_type(4)));
    if (wave >= 4) { SCAN_LOAD(0) }
    for (int sc = -1; sc < nsc; ++sc) {
      const bool st_on = sc >= 0, hl_on = sc + 1 < nsc;
      bf16_t* oUc = (bf16_t*)(lds + ((sc & 1) ? 126720 : 78848));
      bf16_t* oUn = (bf16_t*)(lds + ((sc & 1) ? 78848 : 126720));
      f32x16 y0;
      const int vloc = 32 * (wave & 1) + r;
      if (st_on) {
      {
        const int k = lane, tq = wave;
        float wq[4];
#pragma unroll
        for (int j = 0; j < 4; ++j) wq[j] = sW[(4 * tq + j) * 64 + k];
        sP[tq * 64 + k] = (wq[0] * wq[1]) * (wq[2] * wq[3]);
        __syncthreads();
        float lam = 1.f;
#pragma unroll
        for (int q = 0; q < 7; ++q) { const float pq = sP[q * 64 + k]; lam *= (q < tq) ? pq : 1.f; }
        u32x2 bt, gt; float nb[4], gg[4];
#pragma unroll
        for (int j = 0; j < 4; ++j) {
          const int t = 4 * tq + j;
          const float lamp = lam; lam = lamp * wq[j];
          const float inv = __builtin_amdgcn_rcpf(lam);
          const float al = lamp * sKK[t * 64 + k], be = sKKA[t * 64 + k] * inv, ga = sKD[t * 64 + k] * inv, rh = lam * sR[t * 64 + k];
          oAL[t * 72 + k] = (bf16_t)f2bf(al); oRH[t * 72 + k] = (bf16_t)f2bf(rh); oBE[t * 72 + k] = (bf16_t)f2bf(be); oGA[t * 72 + k] = (bf16_t)f2bf(ga);
          nb[j] = -be; gg[j] = ga;
        }
        bt[0] = pack2(nb[0], nb[1]); bt[1] = pack2(nb[2], nb[3]); gt[0] = pack2(gg[0], gg[1]); gt[1] = pack2(gg[2], gg[3]);
        *(u32x2*)(oBEt + k * 40 + 4 * tq) = bt; *(u32x2*)(oGAt + k * 40 + 4 * tq) = gt;
        if (tq == 7) lamC[k] = lam;
      }
      __syncthreads();
      {
      const int tid = otid(), lane = tid & 63, wave = tid >> 6, r = lane & 31, h = lane >> 5; (void)r; (void)h; (void)lane; (void)wave;
      if (wave < 4) {
        const bf16_t* As = (wave & 1) ? oGA : oBE; const bf16_t* Bs = (wave < 2) ? oAL : oRH;
        f32x16 x;
#pragma unroll
        for (int q = 0; q < 16; ++q) x[q] = 0.f;
#pragma unroll
        for (int s = 0; s < 4; ++s) { const bf16x8 a = *(const bf16x8*)(As + r * 72 + 16 * s + 8 * h); const bf16x8 bb = *(const bf16x8*)(Bs + r * 72 + 16 * s + 8 * h); x = MFMA32(a, bb, x); }
#pragma unroll
        for (int q = 0; q < 16; ++q) { const int i = (q & 3) + 8 * (q >> 2) + 4 * h; const bool keep = (wave < 2) ? (i < r) : (i <= r); x[q] = keep ? x[q] : 0.f; }
        if (wave == 0) {
#pragma unroll
          for (int gq = 0; gq < 4; ++gq) *(float4*)(Bm + r * 36 + 8 * gq + 4 * h) = make_float4(x[4 * gq], x[4 * gq + 1], x[4 * gq + 2], x[4 * gq + 3]);
        } else {
          const float sg = (wave == 2) ? -1.f : 1.f;
#pragma unroll
          for (int s = 0; s < 2; ++s) { u32x4 pk;
#pragma unroll
            for (int j = 0; j < 4; ++j) pk[j] = pack2(sg * x[8 * s + 2 * j], sg * x[8 * s + 2 * j + 1]);
            *(u32x4*)(frag + (((wave - 1) * 2 + s) * 64 + lane) * 16) = pk; }
        }
      }
      }
      __syncthreads();
      if (wave < 2) {
        f32x16 a0;
#pragma unroll
        for (int q = 0; q < 16; ++q) a0[q] = 0.f;
#pragma unroll
        for (int kb = 0; kb < 2; ++kb)
#pragma unroll
          for (int s = 0; s < 2; ++s) {
            u32x4 pk;
#pragma unroll
            for (int j = 0; j < 4; ++j) pk[j] = kb ? pack2(st1[8 * s + 2 * j], st1[8 * s + 2 * j + 1]) : pack2(st0[8 * s + 2 * j], st0[8 * s + 2 * j + 1]);
            const bf16x8 sf = __builtin_bit_cast(bf16x8, pk);
            const int ko = 32 * kb + 16 * s + 4 * h;
            const u32x4 aa = cat8(*(const u32x2*)(oAL + r * 72 + ko), *(const u32x2*)(oAL + r * 72 + ko + 8));
            a0 = MFMA32(__builtin_bit_cast(bf16x8, aa), sf, a0);
          }
#pragma unroll
        for (int s = 0; s < 2; ++s) {
          const bf16x8 fg = *(const bf16x8*)(frag + ((0 * 2 + s) * 64 + lane) * 16);
          const u32x4 ub = cat8(*(const u32x2*)(oUc + vloc * 40 + 16 * s + 4 * h), *(const u32x2*)(oUc + vloc * 40 + 16 * s + 4 * h + 8));
          a0 = MFMA32(fg, __builtin_bit_cast(bf16x8, ub), a0);
        }
#pragma unroll
        for (int q = 0; q < 16; ++q) RHS[((q & 3) + 8 * (q >> 2) + 4 * h) * 64 + vloc] = a0[q];
        float* park = (float*)(lds + 131840) + wave * 3072 + lane * 4;
#pragma unroll
        for (int gq = 0; gq < 4; ++gq) {
          *(float4*)(park + gq * 256) = make_float4(st0[4 * gq], st0[4 * gq + 1], st0[4 * gq + 2], st0[4 * gq + 3]);
          *(float4*)(park + 1024 + gq * 256) = make_float4(st1[4 * gq], st1[4 * gq + 1], st1[4 * gq + 2], st1[4 * gq + 3]);
        }
      }
      }
      float zv[16]; float4 cb[4], nb8[4], nc8[4]; float crhs = 0.f, nrhs = 0.f, n2rhs = 0.f;
      const float mh = h ? 0.f : 1.f;
#pragma unroll
      for (int t = 0; t < 16; ++t) zv[t] = 0.f;
#pragma unroll
      for (int q = 0; q < 4; ++q) { cb[q] = make_float4(0.f, 0.f, 0.f, 0.f); nb8[q] = make_float4(0.f, 0.f, 0.f, 0.f); nc8[q] = make_float4(0.f, 0.f, 0.f, 0.f); }
      const __attribute__((address_space(3))) float* Bmo = (const __attribute__((address_space(3))) float*)(unsigned)(unsigned long long)(Bm + 4 * h);
      const __attribute__((address_space(3))) float* RHo = (const __attribute__((address_space(3))) float*)(unsigned)(unsigned long long)(RHS + vloc);
      asm volatile("" : "+v"(Bmo), "+v"(RHo));
      if (wave < 2 && st_on) { crhs = RHo[0]; nrhs = RHo[64]; const f4v q4 = *(const __attribute__((address_space(3))) f4v*)(Bmo + 36); nb8[0] = make_float4(q4[0], q4[1], q4[2], q4[3]); }
      if (wave < 2) { if (st_on) { SOLVE_ROWS(0, 6) } }
      else if (wave >= 4 && hl_on) {
#pragma unroll
        for (int i = 0; i < 5; ++i) {
          const int id = ht + 256 * i; const int arr = id >> 8, s = (id >> 3) & 31, cc = (id & 7) * 8;
          const u32x4 u = pre[i];
          if (arr < 2) { float* d = (arr == 0 ? sR : sKD) + s * 64 + cc;
            *(float4*)d = make_float4(bflo(u[0]), bfhi(u[0]), bflo(u[1]), bfhi(u[1])); *(float4*)(d + 4) = make_float4(bflo(u[2]), bfhi(u[2]), bflo(u[3]), bfhi(u[3])); }
          else if (arr == 2) {
#pragma unroll
            for (int j = 0; j < 4; ++j) { oUn[(cc + 2 * j) * 40 + s] = (bf16_t)(u[j] & 0xffffu); oUn[(cc + 2 * j + 1) * 40 + s] = (bf16_t)(u[j] >> 16); }
          } else *(u32x4*)((arr == 3 ? sHW : sHA) + s * 72 + cc) = u;
        }
        if (sc + 2 < nsc) { SCAN_LOAD(sc + 2) }
      }
      __syncthreads();
      if (wave < 2) { if (st_on) { SOLVE_ROWS(6, 24) } }
      else if (wave < 4) { if (st_on) {
        const float* park = (const float*)(lds + 131840) + (wave - 2) * 3072 + lane * 4;
#pragma unroll
        for (int gq = 0; gq < 4; ++gq) {
          const float4 a = *(const float4*)(park + gq * 256), bq = *(const float4*)(park + 1024 + gq * 256);
          st0[4 * gq] = a.x; st0[4 * gq + 1] = a.y; st0[4 * gq + 2] = a.z; st0[4 * gq + 3] = a.w;
          st1[4 * gq] = bq.x; st1[4 * gq + 1] = bq.y; st1[4 * gq + 2] = bq.z; st1[4 * gq + 3] = bq.w;
        }
#pragma unroll
        for (int q = 0; q < 16; ++q) y0[q] = 0.f;
#pragma unroll
        for (int kb = 0; kb < 2; ++kb)
#pragma unroll
          for (int s = 0; s < 2; ++s) {
            u32x4 pk;
#pragma unroll
            for (int j = 0; j < 4; ++j) pk[j] = kb ? pack2(st1[8 * s + 2 * j], st1[8 * s + 2 * j + 1]) : pack2(st0[8 * s + 2 * j], st0[8 * s + 2 * j + 1]);
            const int ko = 32 * kb + 16 * s + 4 * h;
            const u32x4 ar = cat8(*(const u32x2*)(oRH + r * 72 + ko), *(const u32x2*)(oRH + r * 72 + ko + 8));
            y0 = MFMA32(__builtin_bit_cast(bf16x8, ar), __builtin_bit_cast(bf16x8, pk), y0);
          }
#pragma unroll
        for (int s = 0; s < 2; ++s) {
          const bf16x8 fpg = *(const bf16x8*)(frag + ((2 * 2 + s) * 64 + lane) * 16);
          const u32x4 ub = cat8(*(const u32x2*)(oUc + vloc * 40 + 16 * s + 4 * h), *(const u32x2*)(oUc + vloc * 40 + 16 * s + 4 * h + 8));
          y0 = MFMA32(fpg, __builtin_bit_cast(bf16x8, ub), y0);
        }
      } }
      else if (wave >= 4 && hl_on) {
        f32x16 acc;
#pragma unroll
        for (int i = 0; i < 16; ++i) acc[i] = 0.f;
        const bf16_t* sH = mat ? sHA : sHW;
#pragma unroll
        for (int kk = 0; kk < 4; ++kk) { const bf16x8 a = *(const bf16x8*)(sH + r * 72 + 16 * kk + 8 * h); const bf16x8 bw = *(const bf16x8*)(lfr + (kk * 64 + lane) * 16); acc = MFMA32(a, bw, acc); }
#pragma unroll
        for (int i = 0; i < 16; ++i) {
          const int srow = (i & 3) + 8 * (i >> 2) + 4 * h, c = 32 * ntt + r;
          const float xv = acc[i] + bias;
          const float sg = __builtin_amdgcn_rcpf(1.f + __expf(-xv));
          if (mat == 0) sW[srow * 64 + c] = __expf(-0.60653065971263342f * sg);
          else sKKA[srow * 64 + c] = sg;
        }
      }
      __syncthreads();
      if (wave < 2) { if (st_on) {
        SOLVE_ROWS(24, 32)
#pragma unroll
        for (int q = 0; q < 4; ++q) { u32x2 o; o[0] = pack2(zv[4 * q], zv[4 * q + 1]); o[1] = pack2(zv[4 * q + 2], zv[4 * q + 3]);
          *(u32x2*)(oZt + vloc * 40 + 4 * (2 * q + h)) = o; }
        } }
      else if (wave >= 4 && hl_on) {
#pragma unroll
        for (int i = 0; i < 8; ++i) {
          const int s = (wave - 4) + 4 * i; const int c = lane;
          const float kraw = sKD[s * 64 + c], a = sKKA[s * 64 + c], rr = sR[s * 64 + c];
          const float pk = kraw * kkc; const float ss = wave_sum(pk * pk);
          const float kk = pk * rsqrtf(fmaxf(ss, 1e-24f));
          const float kd = kraw * (1.f + (a - 1.f) * kac);
          const float bs = wave_sum(rr * kd * rkc);
          sKD[s * 64 + c] = kd; sKK[s * 64 + c] = kk; sKKA[s * 64 + c] = kk * a;
          if (c == 0) { const int tl = z ? (L - 1 - ((sc + 1) * 32 + s)) : ((sc + 1) * 32 + s); bon[(((size_t)b * L + tl) * 16 + head) * 2 + z] = bs; }
        }
      }
      __syncthreads();
      if (st_on) {
      {
      const int tid = otid(), lane = tid & 63, wave = tid >> 6, r = lane & 31, h = lane >> 5; (void)r; (void)h; (void)lane; (void)wave;
      if (wave < 2) {
        { const float* park = (const float*)(lds + 131840) + wave * 3072 + lane * 4;
#pragma unroll
          for (int gq = 0; gq < 4; ++gq) {
            const float4 a = *(const float4*)(park + gq * 256), bq = *(const float4*)(park + 1024 + gq * 256);
            st0[4 * gq] = a.x; st0[4 * gq + 1] = a.y; st0[4 * gq + 2] = a.z; st0[4 * gq + 3] = a.w;
            st1[4 * gq] = bq.x; st1[4 * gq + 1] = bq.y; st1[4 * gq + 2] = bq.z; st1[4 * gq + 3] = bq.w;
          } }
#pragma unroll
        for (int s = 0; s < 2; ++s) {
          const bf16x8 ub = *(const bf16x8*)(oUc + vloc * 40 + 16 * s + 8 * h), zb = *(const bf16x8*)(oZt + vloc * 40 + 16 * s + 8 * h);
          const bf16x8 g0 = *(const bf16x8*)(oGAt + r * 40 + 16 * s + 8 * h), g1 = *(const bf16x8*)(oGAt + (32 + r) * 40 + 16 * s + 8 * h);
          const bf16x8 b0 = *(const bf16x8*)(oBEt + r * 40 + 16 * s + 8 * h), b1 = *(const bf16x8*)(oBEt + (32 + r) * 40 + 16 * s + 8 * h);
          st0 = MFMA32(g0, ub, st0); st0 = MFMA32(b0, zb, st0);
          st1 = MFMA32(g1, ub, st1); st1 = MFMA32(b1, zb, st1);
        }
#pragma unroll
        for (int gq = 0; gq < 4; ++gq) {
          const float4 l0 = *(const float4*)(lamC + 8 * gq + 4 * h), l1 = *(const float4*)(lamC + 32 + 8 * gq + 4 * h);
          st0[4 * gq] *= l0.x; st0[4 * gq + 1] *= l0.y; st0[4 * gq + 2] *= l0.z; st0[4 * gq + 3] *= l0.w;
          st1[4 * gq] *= l1.x; st1[4 * gq + 1] *= l1.y; st1[4 * gq + 2] *= l1.z; st1[4 * gq + 3] *= l1.w;
        }
      } else if (wave < 4) {
#pragma unroll
        for (int s = 0; s < 2; ++s) {
          const bf16x8 fpb = *(const bf16x8*)(frag + ((1 * 2 + s) * 64 + lane) * 16);
          const u32x4 z8 = cat8(*(const u32x2*)(oZt + vloc * 40 + 16 * s + 4 * h), *(const u32x2*)(oZt + vloc * 40 + 16 * s + 4 * h + 8));
          y0 = MFMA32(fpb, __builtin_bit_cast(bf16x8, z8), y0);
        }
#pragma unroll
        for (int q = 0; q < 16; ++q) {
          const int t = (q & 3) + 8 * (q >> 2) + 4 * h; const int tl = z ? (L - 1 - (sc * 32 + t)) : (sc * 32 + t);
          Yg[((size_t)b * L + tl) * 1024 + head * 64 + vloc] = (bf16_t)f2bf(y0[q]);
        }
      }
      }
      __syncthreads();
      }
    }
#undef SOLVE_ROWS
#undef SCAN_LOAD
    if (g == 0 && wave < 2) {
#pragma unroll
      for (int gq = 0; gq < 4; ++gq) {
        *(float4*)(p.out + OUT_ST + stbase + 8 * gq + 4 * h) = make_float4(st0[4 * gq], st0[4 * gq + 1], st0[4 * gq + 2], st0[4 * gq + 3]);
        *(float4*)(p.out + OUT_ST + stbase + 32 + 8 * gq + 4 * h) = make_float4(st1[4 * gq], st1[4 * gq + 1], st1[4 * gq + 2], st1[4 * gq + 3]);
      }
    }
    __syncthreads();
  }
}

DI void phase_rwkv_combine(const P& p, int g, int jl) {
  const int T = g ? 16384 : 8192;
  const int tid = otid(); const int lane = tid & 63, wave = tid >> 6;
  bf16_t* slots = (bf16_t*)(p.ws + WS_SLOT);
  const float* bon = (const float*)(p.ws + WS_BON);
  for (int t = blockIdx.x * 8 + wave; t < T; t += gridDim.x * 8) {
    const size_t o = (size_t)t * 1024 + 16 * lane; const int head = lane >> 2;
    float y[16], v[16], gg[16];
#pragma unroll
    for (int q = 0; q < 2; ++q) {
      const u32x4 a = *(const u32x4*)(slots + 5 * SLOT_ELEMS + o + 8 * q), bq = *(const u32x4*)(slots + 0 * SLOT_ELEMS + o + 8 * q);
      const u32x4 vq = *(const u32x4*)(slots + 3 * SLOT_ELEMS + o + 8 * q), gq = *(const u32x4*)(slots + 4 * SLOT_ELEMS + o + 8 * q);
#pragma unroll
      for (int i = 0; i < 4; ++i) { y[8 * q + 2 * i] = bflo(a[i]) + bflo(bq[i]); y[8 * q + 2 * i + 1] = bfhi(a[i]) + bfhi(bq[i]);
        v[8 * q + 2 * i] = bflo(vq[i]); v[8 * q + 2 * i + 1] = bfhi(vq[i]); gg[8 * q + 2 * i] = bflo(gq[i]); gg[8 * q + 2 * i + 1] = bfhi(gq[i]); }
    }
    float s = 0.f;
#pragma unroll
    for (int i = 0; i < 16; ++i) s += y[i];
    const float mean = quad_sum(s) * (1.f / 64.f);
    float vs = 0.f;
#pragma unroll
    for (int i = 0; i < 16; ++i) { const float d = y[i] - mean; vs += d * d; }
    const float rstd = rsqrtf(quad_sum(vs) * (1.f / 64.f) + 64e-5f);
    const float bs = bon[((size_t)t * 16 + head) * 2] + bon[((size_t)t * 16 + head) * 2 + 1];
    const float* gw = p.in[22] + jl * 1024 + 16 * lane; const float* gb = p.in[23] + jl * 1024 + 16 * lane;
    float ov[16];
#pragma unroll
    for (int i = 0; i < 16; ++i) ov[i] = ((y[i] - mean) * rstd * gw[i] + gb[i] + bs * v[i]) * silu(gg[i]);
#pragma unroll
    for (int q = 0; q < 2; ++q) { u32x4 w; w[0] = pack2(ov[8 * q], ov[8 * q + 1]); w[1] = pack2(ov[8 * q + 2], ov[8 * q + 3]); w[2] = pack2(ov[8 * q + 4], ov[8 * q + 5]); w[3] = pack2(ov[8 * q + 6], ov[8 * q + 7]);
      *(u32x4*)(slots + 4 * SLOT_ELEMS + o + 8 * q) = w; }
  }
}

DI void phase_conv(const P& p, int g) {
  const int T = g ? 16384 : 8192, Lmask = g ? 4095 : 255;
  bf16_t* slots = (bf16_t*)(p.ws + WS_SLOT);
  const bf16_t* BG = slots + 2 * SLOT_ELEMS; const bf16_t* CG = slots + 3 * SLOT_ELEMS; const bf16_t* U = slots + 4 * SLOT_ELEMS; const bf16_t* G = slots + 5 * SLOT_ELEMS;
  bf16_t* O = slots;
  for (int e = blockIdx.x * NT + otid(); e < T * 128; e += gridDim.x * NT) {
    const int t = e >> 7, c = (e & 127) * 8; const size_t o = (size_t)t * 1024 + c; const int tl = t & Lmask;
    const u32x4 zz = {0u, 0u, 0u, 0u};
    const u32x4 c1 = *(const u32x4*)(CG + o), u1 = *(const u32x4*)(U + o);
    const u32x4 c0 = tl != 0 ? *(const u32x4*)(CG + o - 1024) : zz, u0 = tl != 0 ? *(const u32x4*)(U + o - 1024) : zz;
    const u32x4 c2 = tl != Lmask ? *(const u32x4*)(CG + o + 1024) : zz, u2 = tl != Lmask ? *(const u32x4*)(U + o + 1024) : zz;
    const u32x4 bg = *(const u32x4*)(BG + o), gg = *(const u32x4*)(G + o);
    const float* cw = p.in[30]; const float* cb = p.in[31];
    u32x4 w;
#pragma unroll
    for (int i = 0; i < 4; ++i) {
      const int ch = c + 2 * i;
      const float lo = bflo(bg[i]) * (cw[ch] * bflo(c0[i]) * bflo(u0[i]) + cw[1024 + ch] * bflo(c1[i]) * bflo(u1[i]) + cw[2048 + ch] * bflo(c2[i]) * bflo(u2[i]) + cb[ch]) * silu(bflo(gg[i]));
      const float hi = bfhi(bg[i]) * (cw[ch + 1] * bfhi(c0[i]) * bfhi(u0[i]) + cw[1024 + ch + 1] * bfhi(c1[i]) * bfhi(u1[i]) + cw[2048 + ch + 1] * bfhi(c2[i]) * bfhi(u2[i]) + cb[ch + 1]) * silu(bfhi(gg[i]));
      w[i] = pack2(lo, hi);
    }
    *(u32x4*)(O + o) = w;
  }
}

DI void phase_attn(const P& p, int g, unsigned char* lds) {
  const int tid = otid(), lane = tid & 63, wave = tid >> 6, r = lane & 31, h = lane >> 5;
  const int L = g ? 4096 : 256, Ltot = g ? 4352 : 256, B = g ? 4 : 32;
  const int nq = L >> 6, ntasks = B * 4 * nq, nkt = Ltot >> 6;
  bf16_t* slots = (bf16_t*)(p.ws + WS_SLOT);
  bf16_t* Q = slots + 2 * SLOT_ELEMS; const bf16_t* G = slots + 3 * SLOT_ELEMS;
  const bf16_t* Kb = slots + 4 * SLOT_ELEMS; const bf16_t* Vt = Kb + SLOT_ELEMS / 2;
  const float SC = 0.125f * 1.4426950408889634f;
  for (int task = blockIdx.x; task < ntasks; task += gridDim.x) {
    const int qt = task % nq, kvh = (task / nq) & 3, b = task / (nq * 4);
    const int head = kvh * 4 + (wave >> 1); const int q0 = qt * 64 + (wave & 1) * 32;
    const size_t tok = (size_t)b * L + q0 + r;
    bf16x8 qf[4];
#pragma unroll
    for (int ds = 0; ds < 4; ++ds) qf[ds] = *(const bf16x8*)(Q + tok * 1024 + head * 64 + ds * 16 + h * 8);
    float m = -1e30f, lsum = 0.f;
    f32x16 O0, O1;
#pragma unroll
    for (int i = 0; i < 16; ++i) { O0[i] = 0.f; O1[i] = 0.f; }
    const int lrow = tid >> 3, lc = (tid & 7) * 8;
    const bf16_t* gK = Kb + ((size_t)b * Ltot + lrow) * 256 + kvh * 64 + lc;
    const bf16_t* gV = Vt + ((size_t)(b * 4 + kvh) * 64 + lrow) * Ltot + lc;
    u32x4 rk = *(const u32x4*)gK, rv = *(const u32x4*)gV;
    *(u32x4*)(lds + lrow * 144 + lc * 2) = rk; *(u32x4*)(lds + 9216 + lrow * 144 + lc * 2) = rv;
    __syncthreads();
    for (int kt = 0; kt < nkt; ++kt) {
      const unsigned char* cur = lds + (kt & 1) * 18432; unsigned char* nxt = lds + ((kt + 1) & 1) * 18432;
      if (kt + 1 < nkt) { rk = *(const u32x4*)(gK + (size_t)(kt + 1) * 64 * 256); rv = *(const u32x4*)(gV + (kt + 1) * 64); }
      f32x16 s0, s1;
#pragma unroll
      for (int i = 0; i < 16; ++i) { s0[i] = 0.f; s1[i] = 0.f; }
#pragma unroll
      for (int ds = 0; ds < 4; ++ds) {
        const bf16x8 a0 = *(const bf16x8*)(cur + r * 144 + (ds * 16 + h * 8) * 2);
        const bf16x8 a1 = *(const bf16x8*)(cur + (32 + r) * 144 + (ds * 16 + h * 8) * 2);
        s0 = MFMA32(a0, qf[ds], s0); s1 = MFMA32(a1, qf[ds], s1);
      }
      float tmax = s0[0];
#pragma unroll
      for (int i = 1; i < 16; ++i) tmax = fmaxf(tmax, s0[i]);
#pragma unroll
      for (int i = 0; i < 16; ++i) tmax = fmaxf(tmax, s1[i]);
      tmax = xhalf_max(tmax);
      const float mnew = fmaxf(m, tmax * SC);
      const float alpha = __builtin_amdgcn_exp2f(m - mnew);
      float ps = 0.f;
#pragma unroll
      for (int i = 0; i < 16; ++i) { s0[i] = __builtin_amdgcn_exp2f(s0[i] * SC - mnew); s1[i] = __builtin_amdgcn_exp2f(s1[i] * SC - mnew); ps += s0[i] + s1[i]; }
      lsum = lsum * alpha + ps; m = mnew;
      if (__builtin_amdgcn_ballot_w64(alpha != 1.f) != 0ull) {
#pragma unroll
        for (int i = 0; i < 16; ++i) { O0[i] *= alpha; O1[i] *= alpha; }
      }
      const unsigned char* vs = cur + 9216;
#pragma unroll
      for (int kb = 0; kb < 2; ++kb)
#pragma unroll
        for (int s = 0; s < 2; ++s) {
          u32x4 pk;
#pragma unroll
          for (int j = 0; j < 4; ++j) pk[j] = kb ? pack2(s1[8 * s + 2 * j], s1[8 * s + 2 * j + 1]) : pack2(s0[8 * s + 2 * j], s0[8 * s + 2 * j + 1]);
          const bf16x8 pf = __builtin_bit_cast(bf16x8, pk);
          const int ko = (32 * kb + 16 * s + 4 * h) * 2;
          { const u32x2 lo = *(const u32x2*)(vs + r * 144 + ko), hi = *(const u32x2*)(vs + r * 144 + ko + 16);
            u32x4 av; av[0] = lo[0]; av[1] = lo[1]; av[2] = hi[0]; av[3] = hi[1];
            O0 = MFMA32(__builtin_bit_cast(bf16x8, av), pf, O0); }
          { const u32x2 lo = *(const u32x2*)(vs + (32 + r) * 144 + ko), hi = *(const u32x2*)(vs + (32 + r) * 144 + ko + 16);
            u32x4 av; av[0] = lo[0]; av[1] = lo[1]; av[2] = hi[0]; av[3] = hi[1];
            O1 = MFMA32(__builtin_bit_cast(bf16x8, av), pf, O1); }
        }
      if (kt + 1 < nkt) { *(u32x4*)(nxt + lrow * 144 + lc * 2) = rk; *(u32x4*)(nxt + 9216 + lrow * 144 + lc * 2) = rv; }
      __syncthreads();
    }
    lsum = xhalf_sum(lsum);
    const float inv = 1.f / lsum;
#pragma unroll
    for (int db = 0; db < 2; ++db)
#pragma unroll
      for (int i4 = 0; i4 < 4; ++i4) {
        const size_t o = tok * 1024 + head * 64 + 32 * db + 8 * i4 + 4 * h;
        const u32x2 gq = *(const u32x2*)(G + o);
        const float v0 = (db ? O1[4 * i4] : O0[4 * i4]) * inv, v1 = (db ? O1[4 * i4 + 1] : O0[4 * i4 + 1]) * inv;
        const float v2 = (db ? O1[4 * i4 + 2] : O0[4 * i4 + 2]) * inv, v3 = (db ? O1[4 * i4 + 3] : O0[4 * i4 + 3]) * inv;
        u32x2 w; w[0] = pack2(v0 * silu(bflo(gq[0])), v1 * silu(bfhi(gq[0]))); w[1] = pack2(v2 * silu(bflo(gq[1])), v3 * silu(bfhi(gq[1])));
        *(u32x2*)(slots + 5 * SLOT_ELEMS + o) = w;
      }
  }
}


#define XB_TMO      128
#define XB_XCNT(j)  (256  + 64 * (j))
#define XB_XSUB(j)  (1280 + 64 * (j))
#define XB_XGEN(j)  (2304 + 64 * (j))
#define XB_TOP      3328
#define XB_TOPGEN   3392
#define XCD_BAR_WORDS 3456
#define XB_SPIN_CAP (1u << 22)
#define LAS __attribute__((address_space(3)))
DI unsigned xb_ld(unsigned* p) { return __hip_atomic_load(p, __ATOMIC_RELAXED, __HIP_MEMORY_SCOPE_AGENT); }
DI unsigned xb_add(unsigned* p, unsigned v) { return __hip_atomic_fetch_add(p, v, __ATOMIC_RELAXED, __HIP_MEMORY_SCOPE_AGENT); }
DI unsigned xb_xcc_id() { return (unsigned)__builtin_amdgcn_s_getreg((3 << 11) | 20) & 0xFu; }
#define XB_SPIN(cond, bar) do { unsigned _sp = 0; while (cond) { __builtin_amdgcn_s_sleep(1); \
    if ((++_sp & 255u) == 0u) { if (xb_ld(&(bar)[XB_TMO])) break; if (_sp > XB_SPIN_CAP) { atomicAdd(&(bar)[XB_TMO], 1u); break; } } } } while (0)
struct XcdBarrier { unsigned* bar; unsigned x; volatile LAS unsigned* st; };
DI XcdBarrier xcd_barrier_post(unsigned* bar, volatile LAS unsigned* st) {
  XcdBarrier b; b.bar = bar; b.x = xb_xcc_id(); b.st = st;
  if (threadIdx.x == 0) (void)xb_add(&bar[XB_XCNT(b.x)], 1u);
  return b;
}
DI void xcd_barrier_complete(unsigned* bar, unsigned x, unsigned& nloc, unsigned& nx) {
  const unsigned G = gridDim.x * gridDim.y * gridDim.z;
  unsigned sum, cnt, mine, sp = 0u;
  for (;;) {
    sum = 0u; cnt = 0u; mine = 0u;
#pragma unroll
    for (unsigned j = 0; j < 16; ++j) { const unsigned c = xb_ld(&bar[XB_XCNT(j)]); sum += c; cnt += (c > 0u) ? 1u : 0u; mine = (j == x) ? c : mine; }
    if (sum == G) break;
    __builtin_amdgcn_s_sleep(1);
    if ((++sp & 255u) == 0u) { if (xb_ld(&bar[XB_TMO])) break; if (sp > XB_SPIN_CAP) { atomicAdd(&bar[XB_TMO], 1u); break; } }
  }
  nloc = mine > 0u ? mine : 1u; nx = cnt > 0u ? cnt : 1u;
}
DI void xcd_barrier(const XcdBarrier& b) {
  asm volatile("s_waitcnt vmcnt(0)" ::: "memory");
  __syncthreads();
  if (threadIdx.x == 0) {
    unsigned* bar = b.bar;
    __builtin_amdgcn_s_waitcnt(0);
    unsigned nloc = b.st[0], nx = b.st[1];
    if (nloc == 0u) { xcd_barrier_complete(bar, b.x, nloc, nx); b.st[0] = nloc; b.st[1] = nx; }
    const unsigned old = xb_add(&bar[XB_XSUB(b.x)], 1u);
    const unsigned gen = old / nloc;
    if (old + 1u == (gen + 1u) * nloc) {
      __builtin_amdgcn_fence(__ATOMIC_RELEASE, "agent");
      asm volatile("s_waitcnt vmcnt(0)" ::: "memory");
      const unsigned og = xb_add(&bar[XB_TOP], 1u);
      const unsigned tg = og / nx;
      if (og + 1u == (tg + 1u) * nx) xb_add(&bar[XB_TOPGEN], 1u);
      else XB_SPIN(xb_ld(&bar[XB_TOPGEN]) == tg, bar);
      __builtin_amdgcn_fence(__ATOMIC_ACQUIRE, "agent");
      xb_add(&bar[XB_XGEN(b.x)], 1u);
      asm volatile("s_waitcnt vmcnt(0)" ::: "memory");
    } else {
      XB_SPIN(xb_ld(&bar[XB_XGEN(b.x)]) == gen, bar);
      __builtin_amdgcn_fence(__ATOMIC_ACQUIRE, "agent");
      asm volatile("s_waitcnt vmcnt(0)" ::: "memory");
    }
  }
  __syncthreads();
}

#define GPTR(T, x) ((T*)(__attribute__((address_space(1))) T*)(x))
__global__ void __launch_bounds__(NT) mega(P p) {
  extern __shared__ __attribute__((aligned(16))) unsigned char lds[];
  cg::grid_group grid = cg::this_grid();
  volatile LAS unsigned* st = (volatile LAS unsigned*)(lds + LDS_BYTES - 16);
  if (threadIdx.x < 4) st[threadIdx.x] = 0u;
  __syncthreads();
  const XcdBarrier xbar = xcd_barrier_post((unsigned*)(p.ws + WS_BAR), st);
  phase0(p, lds);
  grid.sync();
  const P& p0 = p;
  for (int step = 0; step < 50; ++step) {
    const int g = step / 25, rem = step - g * 25, layer = rem / 5, sub = rem - layer * 5;
    const int kind = layer % 3, jl = layer / 3;
    const int T = g ? 16384 : 8192, Lmask = g ? 4095 : 255;
    int op = -1;
    if (layer == 4) op = (sub == 0) ? 0 : -1;
    else if (sub == 0) op = 0;
    else if (kind == 0) op = sub == 1 ? 1 : (sub == 2 ? 2 : (sub == 3 ? 3 : 4));
    else if (kind == 1) op = sub == 1 ? 5 : (sub == 2 ? 6 : (sub == 3 ? 4 : -1));
    else op = sub == 1 ? 4 : (sub == 2 ? 7 : (sub == 3 ? 4 : -1));
    if (op < 0) continue;
    P p = p0;
    { size_t zo_ = 0; asm volatile("" : "+s"(zo_)); p.ws = p0.ws + zo_; p.out = p0.out + zo_; }
    bf16_t* slots = (bf16_t*)(p.ws + WS_SLOT);
    const bf16_t* W = (const bf16_t*)(p.ws + WS_W);
    if (op == 0) {
      const float* xin = p.in[g]; float* xout = p.out + (g ? OUT_YS : OUT_YP);
      phase_norm(p, g, layer - 1, layer < 4 ? layer : -1, layer <= 1 ? xin : xout, xout, slots + SLOT_ELEMS, slots);
      if (kind == 1 && g == 1 && layer < 4) phase_cache_copy(p);
    } else if (op == 1) {
      for (int rep = 0; rep < opq(REP_GEMM); ++rep) phase_gemm<1, 0>(p, g, slots, W + (size_t)(RW_IN0 + jl * RW_STRIDE) * 1024, T, 4352, p.in[11] + jl * 6144, Lmask, slots + SLOT_ELEMS, 1, lds);
    } else if (op == 2) {
      for (int rep = 0; rep < opq(REP_SCAN); ++rep) phase_scan(p, g, jl, lds);
    } else if (op == 3) {
      phase_rwkv_combine(p, g, jl);
    } else if (op == 4) {
      const bf16_t* A; const bf16_t* Bt; int N; bf16_t* dst;
      if (sub == 1) { A = slots; Bt = W + (size_t)CV_IN * 1024; N = 4096; dst = slots + 2 * SLOT_ELEMS; }
      else {
        N = 1024; dst = slots + SLOT_ELEMS;
        if (kind == 0) { A = slots + 4 * SLOT_ELEMS; Bt = W + (size_t)(RW_OUT0 + jl * RW_STRIDE) * 1024; }
        else if (kind == 1) { A = slots + 5 * SLOT_ELEMS; Bt = W + (size_t)AT_OUT * 1024; }
        else { A = slots; Bt = W + (size_t)CV_OUT * 1024; }
      }
      for (int rep = 0; rep < opq(REP_GEMM); ++rep) phase_gemm<0, 0>(p, g, A, Bt, T, N, nullptr, 0, dst, 0, lds);
    } else if (op == 5) {
      for (int rep = 0; rep < opq(REP_GEMM); ++rep) phase_gemm<0, 1>(p, g, slots, W + (size_t)AT_IN * 1024, T, 2560, nullptr, 0, nullptr, 0, lds);
    } else if (op == 6) {
      for (int rep = 0; rep < opq(REP_ATTN); ++rep) phase_attn(p, g, lds);
    } else {
      phase_conv(p, g);
    }
    if (!(g == 1 && layer == 4)) for (int rep = 0; rep < opq(REP_SYNC); ++rep) xcd_barrier(xbar);
  }
}

extern "C" void kernel_launch(void* const* d_in, const int* in_sizes, int n_in, void* d_out, int out_size, void* d_ws, size_t ws_size, hipStream_t stream) {
  static int grid_blocks = 0;
  if (!grid_blocks) {
    int dev = 0, cus = 0, per_cu = 0;
    hipGetDevice(&dev);
    hipDeviceGetAttribute(&cus, hipDeviceAttributeMultiprocessorCount, dev);
    hipFuncSetAttribute((const void*)mega, hipFuncAttributeMaxDynamicSharedMemorySize, LDS_BYTES);
    hipOccupancyMaxActiveBlocksPerMultiprocessor(&per_cu, (const void*)mega, NT, LDS_BYTES);
    if (per_cu < 1) per_cu = 1;
    if (per_cu > 1) per_cu = 1;
    grid_blocks = cus * per_cu;
    if (ws_size < WS_SLOT + 6 * SLOT_ELEMS * 2) fprintf(stderr, "workspace too small: %zu\n", ws_size);
  }
  (void)hipMemsetAsync((unsigned char*)d_ws + WS_BAR, 0, XCD_BAR_WORDS * sizeof(unsigned), stream);
  P p{};
  for (int i = 0; i < 33; ++i) p.in[i] = (const float*)d_in[i];
  p.out = (float*)d_out; p.ws = (unsigned char*)d_ws;
  void* args[] = {&p};
  hipError_t e = hipLaunchCooperativeKernel((const void*)mega, dim3(grid_blocks), dim3(NT), args, LDS_BYTES, stream);
  if (e != hipSuccess) fprintf(stderr, "cooperative launch failed: %s (grid %d)\n", hipGetErrorString(e), grid_blocks);
}
```

```cpp
#include <hip/hip_runtime.h>
#include <hip/hip_cooperative_groups.h>
#include <cstdio>
namespace cg = cooperative_groups;

typedef unsigned short bf16_t;
using bf16x8 = __attribute__((ext_vector_type(8))) short;
using f32x16 = __attribute__((ext_vector_type(16))) float;
using u32x4 = __attribute__((ext_vector_type(4))) unsigned;
using u32x2 = __attribute__((ext_vector_type(2))) unsigned;

#define NT 512
#ifndef REP_GEMM
#define REP_GEMM 1
#endif
#ifndef REP_SCAN
#define REP_SCAN 1
#endif
#ifndef REP_ATTN
#define REP_ATTN 1
#endif
#ifndef REP_SYNC
#define REP_SYNC 1
#endif
#define DI __device__ __forceinline__
#define MFMA32(a, b, c) __builtin_amdgcn_mfma_f32_32x32x16_bf16((a), (b), (c), 0, 0, 0)

struct P { const float* in[33]; float* out; unsigned char* ws; };

constexpr size_t WS_ADA = 0;
constexpr size_t WS_ROPE = 262144;
constexpr size_t WS_BON = 327680;
constexpr size_t WS_HID = WS_BON + 2097152;
constexpr size_t WS_W = WS_HID + 8388608;
constexpr size_t WS_SLOT = WS_W + 39845888;
constexpr size_t SLOT_ELEMS = (size_t)16384 * 1024;
constexpr int RW_IN0 = 0, RW_OUT0 = 4352, RW_STRIDE = 5376, AT_IN = 10752, AT_OUT = 13312, CV_IN = 14336, CV_OUT = 18432;
constexpr size_t OUT_YP = 0, OUT_YS = 8388608, OUT_ST = 25165824, OUT_CK = 33554432, OUT_CV = 35651584;
constexpr int LDS_BYTES = 156416 + 16;
constexpr size_t WS_BAR = 278528;

typedef __bf16 bf16x2_t __attribute__((ext_vector_type(2)));
typedef float f32x2_t __attribute__((ext_vector_type(2)));
DI unsigned pack2(float a, float b) { f32x2_t v = {a, b}; return __builtin_bit_cast(unsigned, __builtin_convertvector(v, bf16x2_t)); }
DI unsigned f2bf(float x) { return (unsigned)__builtin_bit_cast(unsigned short, (__bf16)x); }
DI float bflo(unsigned u) { return __uint_as_float(u << 16); }
DI float bfhi(unsigned u) { return __uint_as_float(u & 0xffff0000u); }
DI float bf1(bf16_t u) { return __uint_as_float(((unsigned)u) << 16); }

template <int CTRL> DI float dppf(float v) { return __int_as_float(__builtin_amdgcn_update_dpp(0, __float_as_int(v), CTRL, 0xF, 0xF, true)); }
DI float reduce16(float v) { v += dppf<0xB1>(v); v += dppf<0x4E>(v); v += dppf<0x141>(v); v += dppf<0x140>(v); return v; }
DI float rdl(float v, int l) { return __int_as_float(__builtin_amdgcn_readlane(__float_as_int(v), l)); }
DI float wave_sum(float v) { v = reduce16(v); return (rdl(v, 0) + rdl(v, 16)) + (rdl(v, 32) + rdl(v, 48)); }
DI float xhalf_max(float x) { const auto r2 = __builtin_amdgcn_permlane32_swap(__float_as_uint(x), __float_as_uint(x), false, false); return fmaxf(__uint_as_float(r2[0]), __uint_as_float(r2[1])); }
DI float xhalf_sum(float x) { const auto r2 = __builtin_amdgcn_permlane32_swap(__float_as_uint(x), __float_as_uint(x), false, false); return __uint_as_float(r2[0]) + __uint_as_float(r2[1]); }
DI float quad_sum(float v) { v += dppf<0xB1>(v); v += dppf<0x4E>(v); return v; }
DI float silu(float x) { return x / (1.f + __expf(-x)); }
DI int opq(int v) { asm volatile("" : "+s"(v)); return v; }
DI int otid() { int t = threadIdx.x; asm volatile("" : "+v"(t)); return t; }

DI void conv_tiles(const float* __restrict__ src, int N, bf16_t* __restrict__ dst, float* lds) {
  const int tid = otid();
  const int tilesN = N >> 6, ntiles = 16 * tilesN;
  for (int tile = blockIdx.x; tile < ntiles; tile += gridDim.x) {
    const int kt = tile / tilesN, nt = tile - kt * tilesN, k0 = kt * 64, n0 = nt * 64;
#pragma unroll
    for (int i = 0; i < 8; ++i) { const int k = (tid >> 6) + 8 * i, n = tid & 63; lds[k * 65 + n] = src[(size_t)(k0 + k) * N + n0 + n]; }
    __syncthreads();
    { const int n = tid >> 3, kc = (tid & 7) * 8; u32x4 o;
#pragma unroll
      for (int j = 0; j < 4; ++j) o[j] = pack2(lds[(kc + 2 * j) * 65 + n], lds[(kc + 2 * j + 1) * 65 + n]);
      *(u32x4*)(dst + (size_t)(n0 + n) * 1024 + k0 + kc) = o; }
    __syncthreads();
  }
}

DI void phase0(const P& p, unsigned char* ldsb) {
  float* lds = (float*)ldsb;
  const int tid = otid();
  bf16_t* W = (bf16_t*)(p.ws + WS_W);
#pragma unroll 1
  for (int e = 0; e < opq(22); ++e) {
    const float* src; int N, drow;
    if (e < 18) {
      const int j = e / 9, q = e - j * 9;
      if (q < 4) { src = p.in[12] + (size_t)(j * 4 + q) * 1048576; N = 1024; drow = RW_IN0 + j * RW_STRIDE + q * 1024; }
      else if (q < 6) { src = p.in[14] + (size_t)(j * 2 + q - 4) * 65536; N = 64; drow = RW_IN0 + j * RW_STRIDE + 4096 + (q - 4) * 64; }
      else if (q < 8) { src = p.in[17] + (size_t)(j * 2 + q - 6) * 65536; N = 64; drow = RW_IN0 + j * RW_STRIDE + 4224 + (q - 6) * 64; }
      else { src = p.in[24] + (size_t)j * 1048576; N = 1024; drow = RW_OUT0 + j * RW_STRIDE; }
    } else if (e == 18) { src = p.in[25]; N = 2560; drow = AT_IN; }
    else if (e == 19) { src = p.in[28]; N = 1024; drow = AT_OUT; }
    else if (e == 20) { src = p.in[29]; N = 4096; drow = CV_IN; }
    else { src = p.in[32]; N = 1024; drow = CV_OUT; }
    conv_tiles(src, N, W + (size_t)drow * 1024, lds);
  }
  {
    float* scond = lds;
    float* red = lds + 5120;
    for (int e = tid; e < 5120; e += NT) { const int cnd = e >> 10, k = e & 1023; const float cv = cnd == 0 ? p.in[6][k] : p.in[5][(cnd - 1) * 1024 + k]; scond[e] = silu(cv); }
    __syncthreads();
    float* ada = (float*)(p.ws + WS_ADA);
    for (int task = blockIdx.x; task < 192; task += gridDim.x) {
      const int layer = task / 48, n0 = (task % 48) * 64, c = tid & 63, kg = tid >> 6;
      float a0 = 0.f, a1 = 0.f, a2 = 0.f, a3 = 0.f, a4 = 0.f;
      const float* wp = p.in[9] + ((size_t)layer * 1024 + kg * 128) * 3072 + n0 + c;
#pragma unroll 8
      for (int k = 0; k < 128; ++k) { const float w = wp[(size_t)k * 3072]; const int kk = kg * 128 + k;
        a0 += scond[kk] * w; a1 += scond[1024 + kk] * w; a2 += scond[2048 + kk] * w; a3 += scond[3072 + kk] * w; a4 += scond[4096 + kk] * w; }
      red[(kg * 5 + 0) * 64 + c] = a0; red[(kg * 5 + 1) * 64 + c] = a1; red[(kg * 5 + 2) * 64 + c] = a2; red[(kg * 5 + 3) * 64 + c] = a3; red[(kg * 5 + 4) * 64 + c] = a4;
      __syncthreads();
      if (tid < 320) { const int cnd = tid >> 6; float s = p.in[10][layer * 3072 + n0 + c];
#pragma unroll
        for (int q = 0; q < 8; ++q) s += red[(q * 5 + cnd) * 64 + c];
        ada[(cnd * 4 + layer) * 3072 + n0 + c] = s; }
      __syncthreads();
    }
  }
  if (blockIdx.x == gridDim.x - 1) {
    float* rope = (float*)(p.ws + WS_ROPE);
    for (int e = tid; e < 1024; e += NT) {
      const int pos = e >> 4, f = e & 15;
      double inv = 1.0; for (int q = 0; q < f; ++q) inv *= 0.5623413251903491;
      double ang = (double)pos * inv;
      const double twopi = 6.283185307179586476925286766559;
      double n = __builtin_rint(ang / twopi); double rr = ang - n * twopi;
      double r2 = rr * rr, sn = 0.0, cs = 0.0, ts = rr, tc = 1.0;
      for (int q = 0; q < 16; ++q) { cs += tc; sn += ts; tc = -tc * r2 / (double)((2 * q + 1) * (2 * q + 2)); ts = -ts * r2 / (double)((2 * q + 2) * (2 * q + 3)); }
      rope[e * 2] = (float)cs; rope[e * 2 + 1] = (float)sn;
    }
  }
}

DI void phase_norm(const P& p, int g, int lpost, int lpre, const float* __restrict__ xsrc, float* __restrict__ xdst,
                   const bf16_t* __restrict__ Mb, bf16_t* __restrict__ H) {
  const int T = g ? 16384 : 8192;
  const int tid = otid(); const int lane = tid & 63, wave = tid >> 6;
  const float* ada = (const float*)(p.ws + WS_ADA);
  float4 xn[4]; u32x2 mn[4];
  const int t0 = blockIdx.x * 8 + wave, tstep = gridDim.x * 8;
#pragma unroll
  for (int i = 0; i < 4; ++i) { xn[i] = make_float4(0.f, 0.f, 0.f, 0.f); mn[i] = (u32x2){0u, 0u}; }
  if (t0 < T) {
#pragma unroll
    for (int i = 0; i < 4; ++i) { xn[i] = *(const float4*)(xsrc + (size_t)t0 * 1024 + 256 * i + 4 * lane); if (lpost >= 0) mn[i] = *(const u32x2*)(Mb + (size_t)t0 * 1024 + 256 * i + 4 * lane); }
  }
  for (int t = t0; t < T; t += tstep) {
    const int cond = g ? 1 + (t >> 12) : 0;
    float4 x[4]; u32x2 mr[4];
#pragma unroll
    for (int i = 0; i < 4; ++i) { x[i] = xn[i]; mr[i] = mn[i]; }
    if (t + tstep < T) {
#pragma unroll
      for (int i = 0; i < 4; ++i) { xn[i] = *(const float4*)(xsrc + (size_t)(t + tstep) * 1024 + 256 * i + 4 * lane); if (lpost >= 0) mn[i] = *(const u32x2*)(Mb + (size_t)(t + tstep) * 1024 + 256 * i + 4 * lane); }
    }
    if (lpost >= 0) {
      float m[16]; float ss = 0.f;
#pragma unroll
      for (int i = 0; i < 4; ++i) { const u32x2 u = mr[i];
        m[4 * i] = bflo(u[0]); m[4 * i + 1] = bfhi(u[0]); m[4 * i + 2] = bflo(u[1]); m[4 * i + 3] = bfhi(u[1]); }
#pragma unroll
      for (int i = 0; i < 16; ++i) ss += m[i] * m[i];
      ss = wave_sum(ss);
      const float rs = rsqrtf(ss * (1.f / 1024.f) + 1e-6f);
      const float* gate = ada + (cond * 4 + lpost) * 3072 + 2048;
      const float* wpo = p.in[8] + lpost * 1024;
#pragma unroll
      for (int i = 0; i < 4; ++i) { const int c = 256 * i + 4 * lane; const float4 gt = *(const float4*)(gate + c); const float4 wv = *(const float4*)(wpo + c);
        x[i].x += gt.x * (m[4 * i] * rs * wv.x); x[i].y += gt.y * (m[4 * i + 1] * rs * wv.y); x[i].z += gt.z * (m[4 * i + 2] * rs * wv.z); x[i].w += gt.w * (m[4 * i + 3] * rs * wv.w);
        *(float4*)(xdst + (size_t)t * 1024 + c) = x[i]; }
    }
    if (lpre >= 0) {
      float ss = 0.f;
#pragma unroll
      for (int i = 0; i < 4; ++i) ss += x[i].x * x[i].x + x[i].y * x[i].y + x[i].z * x[i].z + x[i].w * x[i].w;
      ss = wave_sum(ss);
      const float rs = rsqrtf(ss * (1.f / 1024.f) + 1e-6f);
      const float* sh = ada + (cond * 4 + lpre) * 3072; const float* sc = sh + 1024; const float* wpr = p.in[7] + lpre * 1024;
#pragma unroll
      for (int i = 0; i < 4; ++i) { const int c = 256 * i + 4 * lane; const float4 s4 = *(const float4*)(sh + c); const float4 c4 = *(const float4*)(sc + c); const float4 wv = *(const float4*)(wpr + c);
        u32x2 o; o[0] = pack2(x[i].x * rs * wv.x * (1.f + c4.x) + s4.x, x[i].y * rs * wv.y * (1.f + c4.y) + s4.y);
        o[1] = pack2(x[i].z * rs * wv.z * (1.f + c4.z) + s4.z, x[i].w * rs * wv.w * (1.f + c4.w) + s4.w);
        *(u32x2*)(H + (size_t)t * 1024 + c) = o; }
    }
  }
}

DI void phase_cache_copy(const P& p) {
  bf16_t* Kb = (bf16_t*)(p.ws + WS_SLOT) + 4 * SLOT_ELEMS; bf16_t* Vt = Kb + SLOT_ELEMS / 2;
  for (int e = blockIdx.x * NT + otid(); e < 262144; e += gridDim.x * NT) {
    const int c = e & 255, pp = (e >> 8) & 255, b = e >> 16; const int kvh = c >> 6, d = c & 63;
    Kb[((size_t)b * 4352 + 4096 + pp) * 256 + c] = (bf16_t)f2bf(p.in[3][e]);
    Vt[((size_t)(b * 4 + kvh) * 64 + d) * 4352 + 4096 + pp] = (bf16_t)f2bf(p.in[4][e]);
  }
}

template <int SHIFT> DI void ld_half(const bf16_t* __restrict__ A, int t, int k, int Lmask, u32x4 (&raw)[4]) {
  raw[1] = *(const u32x4*)(A + (size_t)t * 1024 + k);
  raw[2] = *(const u32x4*)(A + (size_t)(t + 1) * 1024 + k);
  if (SHIFT) {
    raw[0] = (u32x4){0u, 0u, 0u, 0u}; raw[3] = (u32x4){0u, 0u, 0u, 0u};
    if ((t & Lmask) != 0) raw[0] = *(const u32x4*)(A + (size_t)(t - 1) * 1024 + k);
    if (((t + 1) & Lmask) != Lmask) raw[3] = *(const u32x4*)(A + (size_t)(t + 2) * 1024 + k);
  }
}
DI u32x4 mix3(const u32x4& c, const u32x4& pz, const u32x4& nz, const float* smu, int k) {
  const float4 m0 = *(const float4*)(smu + k), m1 = *(const float4*)(smu + k + 4);
  const float mu[8] = {m0.x, m0.y, m0.z, m0.w, m1.x, m1.y, m1.z, m1.w};
  u32x4 o;
#pragma unroll
  for (int i = 0; i < 4; ++i) {
    const float h0 = bflo(c[i]), h1 = bfhi(c[i]);
    const float x0 = h0 + (0.5f * (bflo(pz[i]) + bflo(nz[i])) - h0) * mu[2 * i];
    const float x1 = h1 + (0.5f * (bfhi(pz[i]) + bfhi(nz[i])) - h1) * mu[2 * i + 1];
    o[i] = pack2(x0, x1);
  }
  return o;
}
DI int swz(int row, int c) { return row * 128 + ((c ^ ((row >> 1) & 7)) << 4); }
template <int SHIFT> DI void st_half(unsigned char* base, int row, int c, const u32x4 (&raw)[4], const float* smu, int k) {
  if (!SHIFT) { *(u32x4*)(base + swz(row, c)) = raw[1]; *(u32x4*)(base + swz(row + 1, c)) = raw[2]; }
  else { *(u32x4*)(base + swz(row, c)) = mix3(raw[1], raw[0], raw[2], smu, k); *(u32x4*)(base + swz(row + 1, c)) = mix3(raw[2], raw[1], raw[3], smu, k); }
}

template <int SHIFT, int EPI>
DI void phase_gemm(const P& p, int g, const bf16_t* __restrict__ A, const bf16_t* __restrict__ Bt, int M, int N,
                   const float* __restrict__ mu, int Lmask, bf16_t* __restrict__ dst, int rw, unsigned char* lds) {
  const int tid = otid(), lane = tid & 63, wave = tid >> 6;
  const int wm = wave >> 1, wn = wave & 1, r = lane & 31, h = lane >> 5;
  const int ntn = N >> 7, ntiles = ntn * (M >> 8);
  float* Cs = (float*)lds;
  float* smu = (float*)(lds + 110592);
  for (int tile = blockIdx.x; tile < ntiles; tile += gridDim.x) {
    const int mt = tile / ntn, nt = tile - mt * ntn; const int m0 = mt * 256, n0 = nt * 128;
    f32x16 acc[2][2];
#pragma unroll
    for (int a = 0; a < 2; ++a)
#pragma unroll
      for (int b = 0; b < 2; ++b)
#pragma unroll
        for (int i = 0; i < 16; ++i) acc[a][b][i] = 0.f;
    if (SHIFT) {
      const float* mup = mu + (nt < 32 ? (nt >> 3) : (nt == 32 ? 4 : 5)) * 1024;
      smu[tid] = mup[tid]; smu[tid + 512] = mup[tid + 512];
      __syncthreads();
    }
    if (!SHIFT) {
      u32x4 s0[6], s1[6];
      const int lrow = tid >> 3, lkc = (tid & 7) * 8;
#define G_LOAD(S, K0)  { _Pragma("unroll") for (int i = 0; i < 4; ++i) S[i] = *(const u32x4*)(A + (size_t)(m0 + lrow + 64 * i) * 1024 + (K0) + lkc); \
                         _Pragma("unroll") for (int i = 0; i < 2; ++i) S[4 + i] = *(const u32x4*)(Bt + (size_t)(n0 + lrow + 64 * i) * 1024 + (K0) + lkc); }
#define G_STORE(S, BUF) { _Pragma("unroll") for (int i = 0; i < 4; ++i) *(u32x4*)((BUF) + swz(lrow + 64 * i, tid & 7)) = S[i]; \
                          _Pragma("unroll") for (int i = 0; i < 2; ++i) *(u32x4*)((BUF) + 32768 + swz(lrow + 64 * i, tid & 7)) = S[4 + i]; }
#define G_COMPUTE(BUF) { _Pragma("unroll") for (int ks = 0; ks < 4; ++ks) { const int kc_ = ks * 2 + h; \
        const bf16x8 a0 = *(const bf16x8*)((BUF) + swz(wm * 64 + r, kc_)); const bf16x8 a1 = *(const bf16x8*)((BUF) + swz(wm * 64 + 32 + r, kc_)); \
        const bf16x8 b0 = *(const bf16x8*)((BUF) + 32768 + swz(wn * 64 + r, kc_)); const bf16x8 b1 = *(const bf16x8*)((BUF) + 32768 + swz(wn * 64 + 32 + r, kc_)); \
        acc[0][0] = MFMA32(a0, b0, acc[0][0]); acc[0][1] = MFMA32(a0, b1, acc[0][1]); acc[1][0] = MFMA32(a1, b0, acc[1][0]); acc[1][1] = MFMA32(a1, b1, acc[1][1]); } }
      G_LOAD(s0, 0) G_STORE(s0, lds)
      G_LOAD(s0, 64) G_LOAD(s1, 128)
      __syncthreads();
      for (int kt = 0; kt < 16; kt += 2) {
        G_COMPUTE(lds)
        G_STORE(s0, lds + 49152)
        if (kt + 3 < 16) G_LOAD(s0, (kt + 3) * 64)
        __syncthreads();
        G_COMPUTE(lds + 49152)
        if (kt + 2 < 16) G_STORE(s1, lds)
        if (kt + 4 < 16) G_LOAD(s1, (kt + 4) * 64)
        __syncthreads();
      }
#undef G_LOAD
#undef G_STORE
#undef G_COMPUTE
    } else {
    u32x4 raw[4], raw2[4], rb[2];
    const int arow = 4 * (tid >> 3), akc = (tid & 7) * 8;
#pragma unroll
    for (int hf = 0; hf < 2; ++hf) { ld_half<SHIFT>(A, m0 + arow + 2 * hf, akc, Lmask, raw); st_half<SHIFT>(lds, arow + 2 * hf, tid & 7, raw, smu, akc); }
#pragma unroll
    for (int i = 0; i < 2; ++i) { const int id = tid + 512 * i; rb[i] = *(const u32x4*)(Bt + (size_t)(n0 + (id >> 3)) * 1024 + (id & 7) * 8); }
#pragma unroll
    for (int i = 0; i < 2; ++i) { const int id = tid + 512 * i; *(u32x4*)(lds + 32768 + swz(id >> 3, id & 7)) = rb[i]; }
    __syncthreads();
    for (int kt = 0; kt < 16; ++kt) {
      unsigned char* cur = lds + (kt & 1) * 49152; unsigned char* nxt = lds + ((kt + 1) & 1) * 49152;
      const int k1 = (kt + 1) * 64;
      if (kt < 15) {
        ld_half<SHIFT>(A, m0 + arow, k1 + akc, Lmask, raw);
        ld_half<SHIFT>(A, m0 + arow + 2, k1 + akc, Lmask, raw2);
#pragma unroll
        for (int i = 0; i < 2; ++i) { const int id = tid + 512 * i; rb[i] = *(const u32x4*)(Bt + (size_t)(n0 + (id >> 3)) * 1024 + k1 + (id & 7) * 8); }
      }
#pragma unroll
      for (int ks = 0; ks < 4; ++ks) {
        const int kc_ = ks * 2 + h;
        const bf16x8 a0 = *(const bf16x8*)(cur + swz(wm * 64 + r, kc_));
        const bf16x8 a1 = *(const bf16x8*)(cur + swz(wm * 64 + 32 + r, kc_));
        const bf16x8 b0 = *(const bf16x8*)(cur + 32768 + swz(wn * 64 + r, kc_));
        const bf16x8 b1 = *(const bf16x8*)(cur + 32768 + swz(wn * 64 + 32 + r, kc_));
        acc[0][0] = MFMA32(a0, b0, acc[0][0]); acc[0][1] = MFMA32(a0, b1, acc[0][1]);
        acc[1][0] = MFMA32(a1, b0, acc[1][0]); acc[1][1] = MFMA32(a1, b1, acc[1][1]);
      }
      if (kt < 15) {
        st_half<SHIFT>(nxt, arow, tid & 7, raw, smu, k1 + akc);
        st_half<SHIFT>(nxt, arow + 2, tid & 7, raw2, smu, k1 + akc);
#pragma unroll
        for (int i = 0; i < 2; ++i) { const int id = tid + 512 * i; *(u32x4*)(nxt + 32768 + swz(id >> 3, id & 7)) = rb[i]; }
      }
      __syncthreads();
    }
    }
#pragma unroll
    for (int mi = 0; mi < 2; ++mi)
#pragma unroll
      for (int ni = 0; ni < 2; ++ni)
#pragma unroll
        for (int i = 0; i < 16; ++i) {
          const int row = wm * 64 + mi * 32 + (i & 3) + 8 * (i >> 2) + 4 * h, col = wn * 64 + ni * 32 + r;
          Cs[row * 132 + col] = acc[mi][ni][i];
        }
    __syncthreads();
    if (EPI == 0) {
#pragma unroll
      for (int i = 0; i < 8; ++i) {
        const int id = tid + 512 * i, row = id >> 4, cc = (id & 15) * 8;
        float4 v0 = *(const float4*)(Cs + row * 132 + cc), v1 = *(const float4*)(Cs + row * 132 + cc + 4);
        if (rw && nt == 32) { v0.x = tanhf(v0.x); v0.y = tanhf(v0.y); v0.z = tanhf(v0.z); v0.w = tanhf(v0.w); v1.x = tanhf(v1.x); v1.y = tanhf(v1.y); v1.z = tanhf(v1.z); v1.w = tanhf(v1.w); }
        u32x4 o; o[0] = pack2(v0.x, v0.y); o[1] = pack2(v0.z, v0.w); o[2] = pack2(v1.x, v1.y); o[3] = pack2(v1.z, v1.w);
        if (rw && nt >= 32) *(u32x4*)((bf16_t*)(p.ws + WS_HID) + (size_t)(m0 + row) * 256 + (nt - 32) * 128 + cc) = o;
        else *(u32x4*)(dst + (size_t)(nt >> 3) * SLOT_ELEMS + (size_t)(m0 + row) * 1024 + (nt & 7) * 128 + cc) = o;
      }
    } else {
      const int row = tid & 255, hh = tid >> 8; const int t = m0 + row;
      float x[64];
#pragma unroll
      for (int q = 0; q < 16; ++q) { const float4 v = *(const float4*)(Cs + row * 132 + hh * 64 + 4 * q); x[4 * q] = v.x; x[4 * q + 1] = v.y; x[4 * q + 2] = v.z; x[4 * q + 3] = v.w; }
      bf16_t* slots = (bf16_t*)(p.ws + WS_SLOT);
      const int L = g ? 4096 : 256, Ltot = g ? 4352 : 256;
      const int b = g ? (t >> 12) : (t >> 8), s = t & (L - 1);
      if (nt < 10) {
        int vz = 0; asm volatile("" : "+v"(vz));
        const float* nw = (nt < 8 ? p.in[26] : p.in[27]) + vz;
        float ss = 0.f;
#pragma unroll
        for (int d = 0; d < 64; ++d) ss += x[d] * x[d];
        const float rs = rsqrtf(ss * (1.f / 64.f) + 1e-6f);
#pragma unroll
        for (int d = 0; d < 64; ++d) x[d] *= rs * nw[d];
        if (g == 0 && nt >= 8) {
          float* ck = p.out + OUT_CK + (size_t)t * 256 + ((nt - 8) * 2 + hh) * 64;
#pragma unroll
          for (int q = 0; q < 16; ++q) *(float4*)(ck + 4 * q) = make_float4(x[4 * q], x[4 * q + 1], x[4 * q + 2], x[4 * q + 3]);
        }
        if (g == 1) {
          const float2* rope = (const float2*)(p.ws + WS_ROPE);
          const int ri = s >> 6, ci = s & 63;
#pragma unroll
          for (int f = 0; f < 16; ++f) {
            const float2 cr = rope[ri * 16 + f]; const float x1 = x[f], x2 = x[16 + f];
            x[f] = x1 * cr.x - x2 * cr.y; x[16 + f] = x2 * cr.x + x1 * cr.y;
            const float2 cc = rope[ci * 16 + f]; const float y1 = x[32 + f], y2 = x[48 + f];
            x[32 + f] = y1 * cc.x - y2 * cc.y; x[48 + f] = y2 * cc.x + y1 * cc.y;
          }
        }
        bf16_t* dq = nt < 8 ? slots + 2 * SLOT_ELEMS + (size_t)t * 1024 + (nt * 2 + hh) * 64
                            : slots + 4 * SLOT_ELEMS + ((size_t)b * Ltot + s) * 256 + ((nt - 8) * 2 + hh) * 64;
#pragma unroll
        for (int q = 0; q < 8; ++q) { u32x4 o; o[0] = pack2(x[8 * q], x[8 * q + 1]); o[1] = pack2(x[8 * q + 2], x[8 * q + 3]); o[2] = pack2(x[8 * q + 4], x[8 * q + 5]); o[3] = pack2(x[8 * q + 6], x[8 * q + 7]); *(u32x4*)(dq + 8 * q) = o; }
      } else if (nt < 12) {
        const int kvh = (nt - 10) * 2 + hh;
        if (g == 0) {
          float* cv = p.out + OUT_CV + (size_t)t * 256 + kvh * 64;
#pragma unroll
          for (int q = 0; q < 16; ++q) *(float4*)(cv + 4 * q) = make_float4(x[4 * q], x[4 * q + 1], x[4 * q + 2], x[4 * q + 3]);
        }
        bf16_t* vt = slots + 4 * SLOT_ELEMS + SLOT_ELEMS / 2 + ((size_t)(b * 4 + kvh) * 64) * Ltot + s;
        { size_t vo = 0;
#pragma unroll
        for (int d = 0; d < 64; ++d) { vt[vo] = (bf16_t)f2bf(x[d]); vo += Ltot; asm volatile("" : "+v"(vo)); } }
      } else {
        bf16_t* dg = slots + 3 * SLOT_ELEMS + (size_t)t * 1024 + (nt - 12) * 128 + hh * 64;
#pragma unroll
        for (int q = 0; q < 8; ++q) { u32x4 o; o[0] = pack2(x[8 * q], x[8 * q + 1]); o[1] = pack2(x[8 * q + 2], x[8 * q + 3]); o[2] = pack2(x[8 * q + 4], x[8 * q + 5]); o[3] = pack2(x[8 * q + 6], x[8 * q + 7]); *(u32x4*)(dg + 8 * q) = o; }
      }
    }
    __syncthreads();
  }
}

DI u32x4 cat8(const u32x2 lo, const u32x2 hi) { u32x4 v; v[0] = lo[0]; v[1] = lo[1]; v[2] = hi[0]; v[3] = hi[1]; return v; }
DI void phase_scan(const P& p, int g, int jl, unsigned char* lds) {
  const int tid = otid(), lane = tid & 63, wave = tid >> 6, r = lane & 31, h = lane >> 5;
  const int L = g ? 4096 : 256, B = g ? 4 : 32, nsc = L >> 5;
  float* sR = (float*)lds; float* sW = sR + 2048; float* sKD = sW + 2048; float* sKK = sKD + 2048; float* sKKA = sKK + 2048;
  bf16_t* sHW = (bf16_t*)(lds + 40960); bf16_t* sHA = (bf16_t*)(lds + 45568);
  bf16_t* oAL = (bf16_t*)(lds + 50176); bf16_t* oRH = (bf16_t*)(lds + 54784); bf16_t* oBE = (bf16_t*)(lds + 59392); bf16_t* oGA = (bf16_t*)(lds + 64000);
  bf16_t* oBEt = (bf16_t*)(lds + 68608); bf16_t* oGAt = (bf16_t*)(lds + 73728); bf16_t* oUt = (bf16_t*)(lds + 78848); bf16_t* oZt = (bf16_t*)(lds + 83968);
  float* Bm = (float*)(lds + 89088); float* RHS = (float*)(lds + 93696); float* lamC = (float*)(lds + 101888); float* sP = (float*)(lds + 102144);
  unsigned char* frag = lds + 104192;
  const bf16_t* slots = (const bf16_t*)(p.ws + WS_SLOT);
  const bf16_t* Rg = slots + 1 * SLOT_ELEMS; const bf16_t* Kg = slots + 2 * SLOT_ELEMS; const bf16_t* Vg = slots + 3 * SLOT_ELEMS;
  const bf16_t* hid = (const bf16_t*)(p.ws + WS_HID);
  float* bon = (float*)(p.ws + WS_BON);
  const int ntasks = B * 32;
  for (int task = blockIdx.x; task < ntasks; task += gridDim.x) {
    const int z = task & 1, head = (task >> 1) & 15, b = task >> 5;
    bf16_t* Yg = (bf16_t*)(p.ws + WS_SLOT) + (z ? 0 : 5) * SLOT_ELEMS;
    const int mat = (wave >> 1) & 1, ntt = wave & 1;
    unsigned char* lfr = lds + 110336 + (wave & 3) * 4096;
    if (wave >= 4) {
      const float* W2 = (mat ? p.in[18] : p.in[15]) + (size_t)(jl * 2 + z) * 65536 + head * 64 + 32 * ntt + r;
#pragma unroll
      for (int kk = 0; kk < 4; ++kk) { u32x4 pk;
#pragma unroll
        for (int j = 0; j < 4; ++j) pk[j] = pack2(W2[(size_t)(16 * kk + 8 * h + 2 * j) * 1024], W2[(size_t)(16 * kk + 8 * h + 2 * j + 1) * 1024]);
        *(u32x4*)(lfr + (kk * 64 + lane) * 16) = pk; }
    }
    const float bias = (mat ? p.in[16] : p.in[13])[(jl * 2 + z) * 1024 + head * 64 + 32 * ntt + r];
    const float kkc = p.in[19][jl * 1024 + head * 64 + lane], kac = p.in[20][jl * 1024 + head * 64 + lane], rkc = p.in[21][jl * 1024 + head * 64 + lane];
    f32x16 st0, st1;
#pragma unroll
    for (int q = 0; q < 16; ++q) { st0[q] = 0.f; st1[q] = 0.f; }
    const size_t stbase = ((((size_t)(b * 2 + jl) * 2 + z) * 16 + head) * 64 + (32 * (wave & 1) + r)) * 64;
    if (g && wave < 2) {
#pragma unroll
      for (int gq = 0; gq < 4; ++gq) {
        const float4 s0 = *(const float4*)(p.in[2] + stbase + 8 * gq + 4 * h), s1 = *(const float4*)(p.in[2] + stbase + 32 + 8 * gq + 4 * h);
        st0[4 * gq] = s0.x; st0[4 * gq + 1] = s0.y; st0[4 * gq + 2] = s0.z; st0[4 * gq + 3] = s0.w;
        st1[4 * gq] = s1.x; st1[4 * gq + 1] = s1.y; st1[4 * gq + 2] = s1.z; st1[4 * gq + 3] = s1.w;
      }
    }
    u32x4 pre[5];
    const int ht = tid - 256;
#define SCAN_LOAD(sc_)                                                                                    \
    { const int ht2 = otid() - 256;                                                                       \
    _Pragma("unroll") for (int i = 0; i < 5; ++i) {                                                       \
      const int id = ht2 + 256 * i;                                                                       \
      const int arr = id >> 8, s = (id >> 3) & 31, cc = (id & 7) * 8;                                     \
      const int tl = z ? (L - 1 - ((sc_) * 32 + s)) : ((sc_) * 32 + s);                                   \
      const size_t tok = (size_t)b * L + tl;                                                              \
      if (arr < 3) pre[i] = *(const u32x4*)((arr == 0 ? Rg : (arr == 1 ? Kg : Vg)) + tok * 1024 + head * 64 + cc); \
      else pre[i] = *(const u32x4*)(hid + tok * 256 + (arr - 3) * 128 + z * 64 + cc);                     \
    } }
#define NQ(t_) ((((t_) + 3) / 4 + 1) / 2)
#define SOLVE_ROWS(T0, T1)                                                                                \
    _Pragma("unroll") for (int t = (T0); t < (T1); ++t) {                                                 \
      if (t + 2 < 32) {                                                                                   \
        n2rhs = RHo[(t + 2) * 64];                                                                        \
        _Pragma("unroll") for (int q = 0; q < NQ(t + 2); ++q) { const f4v q4 = *(const __attribute__((address_space(3))) f4v*)(Bmo + (t + 2) * 36 + 8 * q); nc8[q] = make_float4(q4[0], q4[1], q4[2], q4[3]); } \
      }                                                                                                   \
      float a0s = crhs * mh, a1s = 0.f;                                                                   \
      _Pragma("unroll") for (int q = 0; q < NQ(t); ++q) {                                                 \
        a0s -= cb[q].x * zv[4 * q]; a1s -= cb[q].y * zv[4 * q + 1]; a0s -= cb[q].z * zv[4 * q + 2]; a1s -= cb[q].w * zv[4 * q + 3]; } \
      float zt = xhalf_sum(a0s + a1s);                                                                    \
      asm volatile("" : "+v"(zt) :: "memory");                                                            \
      zv[4 * (t >> 3) + (t & 3)] = ((((t >> 2) & 1) == h)) ? zt : zv[4 * (t >> 3) + (t & 3)];             \
      crhs = nrhs; nrhs = n2rhs;                                                                          \
      _Pragma("unroll") for (int q = 0; q < 4; ++q) { cb[q] = nb8[q]; nb8[q] = nc8[q]; }                  \
    }
    typedef float f4v __attribute__((ext_vector_type(4)));
    if (wave >= 4) { SCAN_LOAD(0) }
    for (int sc = -1; sc < nsc; ++sc) {
      const bool st_on = sc >= 0, hl_on = sc + 1 < nsc;
      bf16_t* oUc = (bf16_t*)(lds + ((sc & 1) ? 126720 : 78848));
      bf16_t* oUn = (bf16_t*)(lds + ((sc & 1) ? 78848 : 126720));
      f32x16 y0;
      const int vloc = 32 * (wave & 1) + r;
      if (st_on) {
      {
        const int k = lane, tq = wave;
        float wq[4];
#pragma unroll
        for (int j = 0; j < 4; ++j) wq[j] = sW[(4 * tq + j) * 64 + k];
        sP[tq * 64 + k] = (wq[0] * wq[1]) * (wq[2] * wq[3]);
        __syncthreads();
        float lam = 1.f;
#pragma unroll
        for (int q = 0; q < 7; ++q) { const float pq = sP[q * 64 + k]; lam *= (q < tq) ? pq : 1.f; }
        u32x2 bt, gt; float nb[4], gg[4];
#pragma unroll
        for (int j = 0; j < 4; ++j) {
          const int t = 4 * tq + j;
          const float lamp = lam; lam = lamp * wq[j];
          const float inv = __builtin_amdgcn_rcpf(lam);
          const float al = lamp * sKK[t * 64 + k], be = sKKA[t * 64 + k] * inv, ga = sKD[t * 64 + k] * inv, rh = lam * sR[t * 64 + k];
          oAL[t * 72 + k] = (bf16_t)f2bf(al); oRH[t * 72 + k] = (bf16_t)f2bf(rh); oBE[t * 72 + k] = (bf16_t)f2bf(be); oGA[t * 72 + k] = (bf16_t)f2bf(ga);
          nb[j] = -be; gg[j] = ga;
        }
        bt[0] = pack2(nb[0], nb[1]); bt[1] = pack2(nb[2], nb[3]); gt[0] = pack2(gg[0], gg[1]); gt[1] = pack2(gg[2], gg[3]);
        *(u32x2*)(oBEt + k * 40 + 4 * tq) = bt; *(u32x2*)(oGAt + k * 40 + 4 * tq) = gt;
        if (tq == 7) lamC[k] = lam;
      }
      __syncthreads();
      {
      const int tid = otid(), lane = tid & 63, wave = tid >> 6, r = lane & 31, h = lane >> 5; (void)r; (void)h; (void)lane; (void)wave;
      if (wave < 4) {
        const bf16_t* As = (wave & 1) ? oGA : oBE; const bf16_t* Bs = (wave < 2) ? oAL : oRH;
        f32x16 x;
#pragma unroll
        for (int q = 0; q < 16; ++q) x[q] = 0.f;
#pragma unroll
        for (int s = 0; s < 4; ++s) { const bf16x8 a = *(const bf16x8*)(As + r * 72 + 16 * s + 8 * h); const bf16x8 bb = *(const bf16x8*)(Bs + r * 72 + 16 * s + 8 * h); x = MFMA32(a, bb, x); }
#pragma unroll
        for (int q = 0; q < 16; ++q) { const int i = (q & 3) + 8 * (q >> 2) + 4 * h; const bool keep = (wave < 2) ? (i < r) : (i <= r); x[q] = keep ? x[q] : 0.f; }
        if (wave == 0) {
#pragma unroll
          for (int gq = 0; gq < 4; ++gq) *(float4*)(Bm + r * 36 + 8 * gq + 4 * h) = make_float4(x[4 * gq], x[4 * gq + 1], x[4 * gq + 2], x[4 * gq + 3]);
        } else {
          const float sg = (wave == 2) ? -1.f : 1.f;
#pragma unroll
          for (int s = 0; s < 2; ++s) { u32x4 pk;
#pragma unroll
            for (int j = 0; j < 4; ++j) pk[j] = pack2(sg * x[8 * s + 2 * j], sg * x[8 * s + 2 * j + 1]);
            *(u32x4*)(frag + (((wave - 1) * 2 + s) * 64 + lane) * 16) = pk; }
        }
      }
      }
      __syncthreads();
      if (wave < 2) {
        f32x16 a0;
#pragma unroll
        for (int q = 0; q < 16; ++q) a0[q] = 0.f;
#pragma unroll
        for (int kb = 0; kb < 2; ++kb)
#pragma unroll
          for (int s = 0; s < 2; ++s) {
            u32x4 pk;
#pragma unroll
            for (int j = 0; j < 4; ++j) pk[j] = kb ? pack2(st1[8 * s + 2 * j], st1[8 * s + 2 * j + 1]) : pack2(st0[8 * s + 2 * j], st0[8 * s + 2 * j + 1]);
            const bf16x8 sf = __builtin_bit_cast(bf16x8, pk);
            const int ko = 32 * kb + 16 * s + 4 * h;
            const u32x4 aa = cat8(*(const u32x2*)(oAL + r * 72 + ko), *(const u32x2*)(oAL + r * 72 + ko + 8));
            a0 = MFMA32(__builtin_bit_cast(bf16x8, aa), sf, a0);
          }
#pragma unroll
        for (int s = 0; s < 2; ++s) {
          const bf16x8 fg = *(const bf16x8*)(frag + ((0 * 2 + s) * 64 + lane) * 16);
          const u32x4 ub = cat8(*(const u32x2*)(oUc + vloc * 40 + 16 * s + 4 * h), *(const u32x2*)(oUc + vloc * 40 + 16 * s + 4 * h + 8));
          a0 = MFMA32(fg, __builtin_bit_cast(bf16x8, ub), a0);
        }
#pragma unroll
        for (int q = 0; q < 16; ++q) RHS[((q & 3) + 8 * (q >> 2) + 4 * h) * 64 + vloc] = a0[q];
        float* park = (float*)(lds + 131840) + wave * 3072 + lane * 4;
#pragma unroll
        for (int gq = 0; gq < 4; ++gq) {
          *(float4*)(park + gq * 256) = make_float4(st0[4 * gq], st0[4 * gq + 1], st0[4 * gq + 2], st0[4 * gq + 3]);
          *(float4*)(park + 1024 + gq * 256) = make_float4(st1[4 * gq], st1[4 * gq + 1], st1[4 * gq + 2], st1[4 * gq + 3]);
        }
      }
      }
      float zv[16]; float4 cb[4], nb8[4], nc8[4]; float crhs = 0.f, nrhs = 0.f, n2rhs = 0.f;
      const float mh = h ? 0.f : 1.f;
#pragma unroll
      for (int t = 0; t < 16; ++t) zv[t] = 0.f;
#pragma unroll
      for (int q = 0; q < 4; ++q) { cb[q] = make_float4(0.f, 0.f, 0.f, 0.f); nb8[q] = make_float4(0.f, 0.f, 0.f, 0.f); nc8[q] = make_float4(0.f, 0.f, 0.f, 0.f); }
      const __attribute__((address_space(3))) float* Bmo = (const __attribute__((address_space(3))) float*)(unsigned)(unsigned long long)(Bm + 4 * h);
      const __attribute__((address_space(3))) float* RHo = (const __attribute__((address_space(3))) float*)(unsigned)(unsigned long long)(RHS + vloc);
      asm volatile("" : "+v"(Bmo), "+v"(RHo));
      if (wave < 2 && st_on) { crhs = RHo[0]; nrhs = RHo[64]; const f4v q4 = *(const __attribute__((address_space(3))) f4v*)(Bmo + 36); nb8[0] = make_float4(q4[0], q4[1], q4[2], q4[3]); }
      if (wave < 2) { if (st_on) { SOLVE_ROWS(0, 6) } }
      else if (wave >= 4 && hl_on) {
#pragma unroll
        for (int i = 0; i < 5; ++i) {
          const int id = ht + 256 * i; const int arr = id >> 8, s = (id >> 3) & 31, cc = (id & 7) * 8;
          const u32x4 u = pre[i];
          if (arr < 2) { float* d = (arr == 0 ? sR : sKD) + s * 64 + cc;
            *(float4*)d = make_float4(bflo(u[0]), bfhi(u[0]), bflo(u[1]), bfhi(u[1])); *(float4*)(d + 4) = make_float4(bflo(u[2]), bfhi(u[2]), bflo(u[3]), bfhi(u[3])); }
          else if (arr == 2) {
#pragma unroll
            for (int j = 0; j < 4; ++j) { oUn[(cc + 2 * j) * 40 + s] = (bf16_t)(u[j] & 0xffffu); oUn[(cc + 2 * j + 1) * 40 + s] = (bf16_t)(u[j] >> 16); }
          } else *(u32x4*)((arr == 3 ? sHW : sHA) + s * 72 + cc) = u;
        }
        if (sc + 2 < nsc) { SCAN_LOAD(sc + 2) }
      }
      __syncthreads();
      if (wave < 2) { if (st_on) { SOLVE_ROWS(6, 24) } }
      else if (wave < 4) { if (st_on) {
        const float* park = (const float*)(lds + 131840) + (wave - 2) * 3072 + lane * 4;
#pragma unroll
        for (int gq = 0; gq < 4; ++gq) {
          const float4 a = *(const float4*)(park + gq * 256), bq = *(const float4*)(park + 1024 + gq * 256);
          st0[4 * gq] = a.x; st0[4 * gq + 1] = a.y; st0[4 * gq + 2] = a.z; st0[4 * gq + 3] = a.w;
          st1[4 * gq] = bq.x; st1[4 * gq + 1] = bq.y; st1[4 * gq + 2] = bq.z; st1[4 * gq + 3] = bq.w;
        }
#pragma unroll
        for (int q = 0; q < 16; ++q) y0[q] = 0.f;
#pragma unroll
        for (int kb = 0; kb < 2; ++kb)
#pragma unroll
          for (int s = 0; s < 2; ++s) {
            u32x4 pk;
#pragma unroll
            for (int j = 0; j < 4; ++j) pk[j] = kb ? pack2(st1[8 * s + 2 * j], st1[8 * s + 2 * j + 1]) : pack2(st0[8 * s + 2 * j], st0[8 * s + 2 * j + 1]);
            const int ko = 32 * kb + 16 * s + 4 * h;
            const u32x4 ar = cat8(*(const u32x2*)(oRH + r * 72 + ko), *(const u32x2*)(oRH + r * 72 + ko + 8));
            y0 = MFMA32(__builtin_bit_cast(bf16x8, ar), __builtin_bit_cast(bf16x8, pk), y0);
          }
#pragma unroll
        for (int s = 0; s < 2; ++s) {
          const bf16x8 fpg = *(const bf16x8*)(frag + ((2 * 2 + s) * 64 + lane) * 16);
          const u32x4 ub = cat8(*(const u32x2*)(oUc + vloc * 40 + 16 * s + 4 * h), *(const u32x2*)(oUc + vloc * 40 + 16 * s + 4 * h + 8));
          y0 = MFMA32(fpg, __builtin_bit_cast(bf16x8, ub), y0);
        }
      } }
      else if (wave >= 4 && hl_on) {
        f32x16 acc;
#pragma unroll
        for (int i = 0; i < 16; ++i) acc[i] = 0.f;
        const bf16_t* sH = mat ? sHA : sHW;
#pragma unroll
        for (int kk = 0; kk < 4; ++kk) { const bf16x8 a = *(const bf16x8*)(sH + r * 72 + 16 * kk + 8 * h); const bf16x8 bw = *(const bf16x8*)(lfr + (kk * 64 + lane) * 16); acc = MFMA32(a, bw, acc); }
#pragma unroll
        for (int i = 0; i < 16; ++i) {
          const int srow = (i & 3) + 8 * (i >> 2) + 4 * h, c = 32 * ntt + r;
          const float xv = acc[i] + bias;
          const float sg = __builtin_amdgcn_rcpf(1.f + __expf(-xv));
          if (mat == 0) sW[srow * 64 + c] = __expf(-0.60653065971263342f * sg);
          else sKKA[srow * 64 + c] = sg;
        }
      }
      __syncthreads();
      if (wave < 2) { if (st_on) {
        SOLVE_ROWS(24, 32)
#pragma unroll
        for (int q = 0; q < 4; ++q) { u32x2 o; o[0] = pack2(zv[4 * q], zv[4 * q + 1]); o[1] = pack2(zv[4 * q + 2], zv[4 * q + 3]);
          *(u32x2*)(oZt + vloc * 40 + 4 * (2 * q + h)) = o; }
        } }
      else if (wave >= 4 && hl_on) {
#pragma unroll
        for (int i = 0; i < 8; ++i) {
          const int s = (wave - 4) + 4 * i; const int c = lane;
          const float kraw = sKD[s * 64 + c], a = sKKA[s * 64 + c], rr = sR[s * 64 + c];
          const float pk = kraw * kkc; const float ss = wave_sum(pk * pk);
          const float kk = pk * rsqrtf(fmaxf(ss, 1e-24f));
          const float kd = kraw * (1.f + (a - 1.f) * kac);
          const float bs = wave_sum(rr * kd * rkc);
          sKD[s * 64 + c] = kd; sKK[s * 64 + c] = kk; sKKA[s * 64 + c] = kk * a;
          if (c == 0) { const int tl = z ? (L - 1 - ((sc + 1) * 32 + s)) : ((sc + 1) * 32 + s); bon[(((size_t)b * L + tl) * 16 + head) * 2 + z] = bs; }
        }
      }
      __syncthreads();
      if (st_on) {
      {
      const int tid = otid(), lane = tid & 63, wave = tid >> 6, r = lane & 31, h = lane >> 5; (void)r; (void)h; (void)lane; (void)wave;
      if (wave < 2) {
        { const float* park = (const float*)(lds + 131840) + wave * 3072 + lane * 4;
#pragma unroll
          for (int gq = 0; gq < 4; ++gq) {
            const float4 a = *(const float4*)(park + gq * 256), bq = *(const float4*)(park + 1024 + gq * 256);
            st0[4 * gq] = a.x; st0[4 * gq + 1] = a.y; st0[4 * gq + 2] = a.z; st0[4 * gq + 3] = a.w;
            st1[4 * gq] = bq.x; st1[4 * gq + 1] = bq.y; st1[4 * gq + 2] = bq.z; st1[4 * gq + 3] = bq.w;
          } }
#pragma unroll
        for (int s = 0; s < 2; ++s) {
          const bf16x8 ub = *(const bf16x8*)(oUc + vloc * 40 + 16 * s + 8 * h), zb = *(const bf16x8*)(oZt + vloc * 40 + 16 * s + 8 * h);
          const bf16x8 g0 = *(const bf16x8*)(oGAt + r * 40 + 16 * s + 8 * h), g1 = *(const bf16x8*)(oGAt + (32 + r) * 40 + 16 * s + 8 * h);
          const bf16x8 b0 = *(const bf16x8*)(oBEt + r * 40 + 16 * s + 8 * h), b1 = *(const bf16x8*)(oBEt + (32 + r) * 40 + 16 * s + 8 * h);
          st0 = MFMA32(g0, ub, st0); st0 = MFMA32(b0, zb, st0);
          st1 = MFMA32(g1, ub, st1); st1 = MFMA32(b1, zb, st1);
        }
#pragma unroll
        for (int gq = 0; gq < 4; ++gq) {
          const float4 l0 = *(const float4*)(lamC + 8 * gq + 4 * h), l1 = *(const float4*)(lamC + 32 + 8 * gq + 4 * h);
          st0[4 * gq] *= l0.x; st0[4 * gq + 1] *= l0.y; st0[4 * gq + 2] *= l0.z; st0[4 * gq + 3] *= l0.w;
          st1[4 * gq] *= l1.x; st1[4 * gq + 1] *= l1.y; st1[4 * gq + 2] *= l1.z; st1[4 * gq + 3] *= l1.w;
        }
      } else if (wave < 4) {
#pragma unroll
        for (int s = 0; s < 2; ++s) {
          const bf16x8 fpb = *(const bf16x8*)(frag + ((1 * 2 + s) * 64 + lane) * 16);
          const u32x4 z8 = cat8(*(const u32x2*)(oZt + vloc * 40 + 16 * s + 4 * h), *(const u32x2*)(oZt + vloc * 40 + 16 * s + 4 * h + 8));
          y0 = MFMA32(fpb, __builtin_bit_cast(bf16x8, z8), y0);
        }
#pragma unroll
        for (int q = 0; q < 16; ++q) {
          const int t = (q & 3) + 8 * (q >> 2) + 4 * h; const int tl = z ? (L - 1 - (sc * 32 + t)) : (sc * 32 + t);
          Yg[((size_t)b * L + tl) * 1024 + head * 64 + vloc] = (bf16_t)f2bf(y0[q]);
        }
      }
      }
      __syncthreads();
      }
    }
#undef SOLVE_ROWS
#undef SCAN_LOAD
    if (g == 0 && wave < 2) {
#pragma unroll
      for (int gq = 0; gq < 4; ++gq) {
        *(float4*)(p.out + OUT_ST + stbase + 8 * gq + 4 * h) = make_float4(st0[4 * gq], st0[4 * gq + 1], st0[4 * gq + 2], st0[4 * gq + 3]);
        *(float4*)(p.out + OUT_ST + stbase + 32 + 8 * gq + 4 * h) = make_float4(st1[4 * gq], st1[4 * gq + 1], st1[4 * gq + 2], st1[4 * gq + 3]);
      }
    }
    __syncthreads();
  }
}

DI void phase_rwkv_combine(const P& p, int g, int jl) {
  const int T = g ? 16384 : 8192;
  const int tid = otid(); const int lane = tid & 63, wave = tid >> 6;
  bf16_t* slots = (bf16_t*)(p.ws + WS_SLOT);
  const float* bon = (const float*)(p.ws + WS_BON);
  for (int t = blockIdx.x * 8 + wave; t < T; t += gridDim.x * 8) {
    const size_t o = (size_t)t * 1024 + 16 * lane; const int head = lane >> 2;
    float y[16], v[16], gg[16];
#pragma unroll
    for (int q = 0; q < 2; ++q) {
      const u32x4 a = *(const u32x4*)(slots + 5 * SLOT_ELEMS + o + 8 * q), bq = *(const u32x4*)(slots + 0 * SLOT_ELEMS + o + 8 * q);
      const u32x4 vq = *(const u32x4*)(slots + 3 * SLOT_ELEMS + o + 8 * q), gq = *(const u32x4*)(slots + 4 * SLOT_ELEMS + o + 8 * q);
#pragma unroll
      for (int i = 0; i < 4; ++i) { y[8 * q + 2 * i] = bflo(a[i]) + bflo(bq[i]); y[8 * q + 2 * i + 1] = bfhi(a[i]) + bfhi(bq[i]);
        v[8 * q + 2 * i] = bflo(vq[i]); v[8 * q + 2 * i + 1] = bfhi(vq[i]); gg[8 * q + 2 * i] = bflo(gq[i]); gg[8 * q + 2 * i + 1] = bfhi(gq[i]); }
    }
    float s = 0.f;
#pragma unroll
    for (int i = 0; i < 16; ++i) s += y[i];
    const float mean = quad_sum(s) * (1.f / 64.f);
    float vs = 0.f;
#pragma unroll
    for (int i = 0; i < 16; ++i) { const float d = y[i] - mean; vs += d * d; }
    const float rstd = rsqrtf(quad_sum(vs) * (1.f / 64.f) + 64e-5f);
    const float bs = bon[((size_t)t * 16 + head) * 2] + bon[((size_t)t * 16 + head) * 2 + 1];
    const float* gw = p.in[22] + jl * 1024 + 16 * lane; const float* gb = p.in[23] + jl * 1024 + 16 * lane;
    float ov[16];
#pragma unroll
    for (int i = 0; i < 16; ++i) ov[i] = ((y[i] - mean) * rstd * gw[i] + gb[i] + bs * v[i]) * silu(gg[i]);
#pragma unroll
    for (int q = 0; q < 2; ++q) { u32x4 w; w[0] = pack2(ov[8 * q], ov[8 * q + 1]); w[1] = pack2(ov[8 * q + 2], ov[8 * q + 3]); w[2] = pack2(ov[8 * q + 4], ov[8 * q + 5]); w[3] = pack2(ov[8 * q + 6], ov[8 * q + 7]);
      *(u32x4*)(slots + 4 * SLOT_ELEMS + o + 8 * q) = w; }
  }
}

DI void phase_conv(const P& p, int g) {
  const int T = g ? 16384 : 8192, Lmask = g ? 4095 : 255;
  bf16_t* slots = (bf16_t*)(p.ws + WS_SLOT);
  const bf16_t* BG = slots + 2 * SLOT_ELEMS; const bf16_t* CG = slots + 3 * SLOT_ELEMS; const bf16_t* U = slots + 4 * SLOT_ELEMS; const bf16_t* G = slots + 5 * SLOT_ELEMS;
  bf16_t* O = slots;
  for (int e = blockIdx.x * NT + otid(); e < T * 128; e += gridDim.x * NT) {
    const int t = e >> 7, c = (e & 127) * 8; const size_t o = (size_t)t * 1024 + c; const int tl = t & Lmask;
    const u32x4 zz = {0u, 0u, 0u, 0u};
    const u32x4 c1 = *(const u32x4*)(CG + o), u1 = *(const u32x4*)(U + o);
    const u32x4 c0 = tl != 0 ? *(const u32x4*)(CG + o - 1024) : zz, u0 = tl != 0 ? *(const u32x4*)(U + o - 1024) : zz;
    const u32x4 c2 = tl != Lmask ? *(const u32x4*)(CG + o + 1024) : zz, u2 = tl != Lmask ? *(const u32x4*)(U + o + 1024) : zz;
    const u32x4 bg = *(const u32x4*)(BG + o), gg = *(const u32x4*)(G + o);
    const float* cw = p.in[30]; const float* cb = p.in[31];
    u32x4 w;
#pragma unroll
    for (int i = 0; i < 4; ++i) {
      const int ch = c + 2 * i;
      const float lo = bflo(bg[i]) * (cw[ch] * bflo(c0[i]) * bflo(u0[i]) + cw[1024 + ch] * bflo(c1[i]) * bflo(u1[i]) + cw[2048 + ch] * bflo(c2[i]) * bflo(u2[i]) + cb[ch]) * silu(bflo(gg[i]));
      const float hi = bfhi(bg[i]) * (cw[ch + 1] * bfhi(c0[i]) * bfhi(u0[i]) + cw[1024 + ch + 1] * bfhi(c1[i]) * bfhi(u1[i]) + cw[2048 + ch + 1] * bfhi(c2[i]) * bfhi(u2[i]) + cb[ch + 1]) * silu(bfhi(gg[i]));
      w[i] = pack2(lo, hi);
    }
    *(u32x4*)(O + o) = w;
  }
}

DI void phase_attn(const P& p, int g, unsigned char* lds) {
  const int tid = otid(), lane = tid & 63, wave = tid >> 6, r = lane & 31, h = lane >> 5;
  const int L = g ? 4096 : 256, Ltot = g ? 4352 : 256, B = g ? 4 : 32;
  const int nq = L >> 6, ntasks = B * 4 * nq, nkt = Ltot >> 6;
  bf16_t* slots = (bf16_t*)(p.ws + WS_SLOT);
  bf16_t* Q = slots + 2 * SLOT_ELEMS; const bf16_t* G = slots + 3 * SLOT_ELEMS;
  const bf16_t* Kb = slots + 4 * SLOT_ELEMS; const bf16_t* Vt = Kb + SLOT_ELEMS / 2;
  const float SC = 0.125f * 1.4426950408889634f;
  for (int task = blockIdx.x; task < ntasks; task += gridDim.x) {
    const int qt = task % nq, kvh = (task / nq) & 3, b = task / (nq * 4);
    const int head = kvh * 4 + (wave >> 1); const int q0 = qt * 64 + (wave & 1) * 32;
    const size_t tok = (size_t)b * L + q0 + r;
    bf16x8 qf[4];
#pragma unroll
    for (int ds = 0; ds < 4; ++ds) qf[ds] = *(const bf16x8*)(Q + tok * 1024 + head * 64 + ds * 16 + h * 8);
    float m = -1e30f, lsum = 0.f;
    f32x16 O0, O1;
#pragma unroll
    for (int i = 0; i < 16; ++i) { O0[i] = 0.f; O1[i] = 0.f; }
    const int lrow = tid >> 3, lc = (tid & 7) * 8;
    const bf16_t* gK = Kb + ((size_t)b * Ltot + lrow) * 256 + kvh * 64 + lc;
    const bf16_t* gV = Vt + ((size_t)(b * 4 + kvh) * 64 + lrow) * Ltot + lc;
    u32x4 rk = *(const u32x4*)gK, rv = *(const u32x4*)gV;
    *(u32x4*)(lds + lrow * 144 + lc * 2) = rk; *(u32x4*)(lds + 9216 + lrow * 144 + lc * 2) = rv;
    __syncthreads();
    for (int kt = 0; kt < nkt; ++kt) {
      const unsigned char* cur = lds + (kt & 1) * 18432; unsigned char* nxt = lds + ((kt + 1) & 1) * 18432;
      if (kt + 1 < nkt) { rk = *(const u32x4*)(gK + (size_t)(kt + 1) * 64 * 256); rv = *(const u32x4*)(gV + (kt + 1) * 64); }
      f32x16 s0, s1;
#pragma unroll
      for (int i = 0; i < 16; ++i) { s0[i] = 0.f; s1[i] = 0.f; }
#pragma unroll
      for (int ds = 0; ds < 4; ++ds) {
        const bf16x8 a0 = *(const bf16x8*)(cur + r * 144 + (ds * 16 + h * 8) * 2);
        const bf16x8 a1 = *(const bf16x8*)(cur + (32 + r) * 144 + (ds * 16 + h * 8) * 2);
        s0 = MFMA32(a0, qf[ds], s0); s1 = MFMA32(a1, qf[ds], s1);
      }
      float tmax = s0[0];
#pragma unroll
      for (int i = 1; i < 16; ++i) tmax = fmaxf(tmax, s0[i]);
#pragma unroll
      for (int i = 0; i < 16; ++i) tmax = fmaxf(tmax, s1[i]);
      tmax = xhalf_max(tmax);
      const float mnew = fmaxf(m, tmax * SC);
      const float alpha = __builtin_amdgcn_exp2f(m - mnew);
      float ps = 0.f;
#pragma unroll
      for (int i = 0; i < 16; ++i) { s0[i] = __builtin_amdgcn_exp2f(s0[i] * SC - mnew); s1[i] = __builtin_amdgcn_exp2f(s1[i] * SC - mnew); ps += s0[i] + s1[i]; }
      lsum = lsum * alpha + ps; m = mnew;
      if (__builtin_amdgcn_ballot_w64(alpha != 1.f) != 0ull) {
#pragma unroll
        for (int i = 0; i < 16; ++i) { O0[i] *= alpha; O1[i] *= alpha; }
      }
      const unsigned char* vs = cur + 9216;
#pragma unroll
      for (int kb = 0; kb < 2; ++kb)
#pragma unroll
        for (int s = 0; s < 2; ++s) {
          u32x4 pk;
#pragma unroll
          for (int j = 0; j < 4; ++j) pk[j] = kb ? pack2(s1[8 * s + 2 * j], s1[8 * s + 2 * j + 1]) : pack2(s0[8 * s + 2 * j], s0[8 * s + 2 * j + 1]);
          const bf16x8 pf = __builtin_bit_cast(bf16x8, pk);
          const int ko = (32 * kb + 16 * s + 4 * h) * 2;
          { const u32x2 lo = *(const u32x2*)(vs + r * 144 + ko), hi = *(const u32x2*)(vs + r * 144 + ko + 16);
            u32x4 av; av[0] = lo[0]; av[1] = lo[1]; av[2] = hi[0]; av[3] = hi[1];
            O0 = MFMA32(__builtin_bit_cast(bf16x8, av), pf, O0); }
          { const u32x2 lo = *(const u32x2*)(vs + (32 + r) * 144 + ko), hi = *(const u32x2*)(vs + (32 + r) * 144 + ko + 16);
            u32x4 av; av[0] = lo[0]; av[1] = lo[1]; av[2] = hi[0]; av[3] = hi[1];
            O1 = MFMA32(__builtin_bit_cast(bf16x8, av), pf, O1); }
        }
      if (kt + 1 < nkt) { *(u32x4*)(nxt + lrow * 144 + lc * 2) = rk; *(u32x4*)(nxt + 9216 + lrow * 144 + lc * 2) = rv; }
      __syncthreads();
    }
    lsum = xhalf_sum(lsum);
    const float inv = 1.f / lsum;
#pragma unroll
    for (int db = 0; db < 2; ++db)
#pragma unroll
      for (int i4 = 0; i4 < 4; ++i4) {
        const size_t o = tok * 1024 + head * 64 + 32 * db + 8 * i4 + 4 * h;
        const u32x2 gq = *(const u32x2*)(G + o);
        const float v0 = (db ? O1[4 * i4] : O0[4 * i4]) * inv, v1 = (db ? O1[4 * i4 + 1] : O0[4 * i4 + 1]) * inv;
        const float v2 = (db ? O1[4 * i4 + 2] : O0[4 * i4 + 2]) * inv, v3 = (db ? O1[4 * i4 + 3] : O0[4 * i4 + 3]) * inv;
        u32x2 w; w[0] = pack2(v0 * silu(bflo(gq[0])), v1 * silu(bfhi(gq[0]))); w[1] = pack2(v2 * silu(bflo(gq[1])), v3 * silu(bfhi(gq[1])));
        *(u32x2*)(slots + 5 * SLOT_ELEMS + o) = w;
      }
  }
}


namespace pg8 {
#define PG8_LAS __attribute__((address_space(3)))
typedef unsigned short bf16_t;
typedef short bf16x8 __attribute__((ext_vector_type(8)));
typedef float f32x4 __attribute__((ext_vector_type(4)));
typedef unsigned u32x4 __attribute__((ext_vector_type(4)));
constexpr int BM = 256, BK = 64, HALF = 128, HTB = HALF * BK * 2  , STAGE_BYTES = 8 * HTB, NXCD = 8, WGM = 8;

__host__ __device__ __forceinline__ int lds_byte(int r, int c) { const int st = (r >> 4) * 2 + (c >> 5), rr = r & 15, cc = c & 31, ob = rr * 64 + cc * 2; return st * 1024 + (ob ^ (((ob >> 9) & 1) << 5)); }
__host__ __device__ __forceinline__ void stage_rc(int b, int& R, int& C) { const int st = b / 1024, sb = b % 1024, swz = sb ^ (((sb >> 9) & 1) << 5); R = (st >> 1) * 16 + swz / 64; C = (st & 1) * 32 + (swz % 64) / 2; }
__host__ __device__ __forceinline__ int perm32(int rho) { const int n = rho >> 4, i = rho & 15; return 8 * (i >> 2) + 4 * n + (i & 3); }

struct Unit { int pm, pn; };
struct Gemm { const bf16_t* A; const bf16_t* Bt; int M, N, K; };

struct StaticOrder {
    int nM, nN, nwg, G, c;
    __host__ __device__ void init(int M, int N, int G_, int c_) { nM = M / BM; nN = N / BM; nwg = nM * nN; G = G_; c = c_; }
    __host__ __device__ bool next(int i, Unit& u) const {
        const long L = (long)i * G + c; if (L >= nwg) return false;
        int wgid = (int)L; { const int q = nwg / NXCD, r = nwg % NXCD, xcd = wgid % NXCD, off = wgid / NXCD; wgid = (xcd < r ? xcd * (q + 1) : r * (q + 1) + (xcd - r) * q) + off; }
        const int nig = WGM * nN, gid = wgid / nig, fm = gid * WGM, gsz = (nM - fm) < WGM ? (nM - fm) : WGM;
        u.pm = fm + ((wgid % nig) % gsz); u.pn = (wgid % nig) / gsz; return true;
    }
    __device__ __forceinline__ void a_ready(const Unit&) const {}
    __device__ __forceinline__ void done(const Unit&) const {}
};
struct CountedOrder : StaticOrder {
    const unsigned* ready; unsigned need; unsigned* tmo;
    __device__ __forceinline__ void a_ready(const Unit& u) const {
        if (threadIdx.x < 64) {
            const unsigned long long t0 = __builtin_amdgcn_s_memrealtime(); unsigned polls = 0;
            while ((unsigned)__builtin_amdgcn_readfirstlane(__hip_atomic_load(ready + 64 * u.pm, __ATOMIC_RELAXED, __HIP_MEMORY_SCOPE_AGENT)) < need) {
                if ((++polls & 255u) == 0u && __builtin_amdgcn_readfirstlane(__hip_atomic_load(tmo, __ATOMIC_RELAXED, __HIP_MEMORY_SCOPE_AGENT)) != 0u) break;
                if (__builtin_amdgcn_s_memrealtime() - t0 > 2000000ull) {
                    if (threadIdx.x == 0) { unsigned expect = 0u; __hip_atomic_compare_exchange_strong(tmo + 1, &expect, 0x600u | (unsigned)(u.pm & 0xff), __ATOMIC_RELAXED, __ATOMIC_RELAXED, __HIP_MEMORY_SCOPE_AGENT); __hip_atomic_store(tmo, 1u, __ATOMIC_RELAXED, __HIP_MEMORY_SCOPE_AGENT); }
                    break; }
                __builtin_amdgcn_s_sleep(2); }
            __builtin_amdgcn_fence(__ATOMIC_ACQUIRE, "agent");
            asm volatile("s_waitcnt vmcnt(0)" ::: "memory");
        }
#if !defined(BROKEN_HOOK_NO_BARRIER)
        asm volatile("" ::: "memory"); __builtin_amdgcn_s_barrier(); asm volatile("" ::: "memory");
#endif
    }
};

__device__ __forceinline__ unsigned cvt_pk_bf16(float lo, float hi) { unsigned r; asm volatile("v_cvt_pk_bf16_f32 %0, %1, %2" : "=v"(r) : "v"(lo), "v"(hi)); return r; }
typedef float f32x2 __attribute__((ext_vector_type(2)));
__device__ __forceinline__ f32x2 gelu_pk(f32x2 v) {
    const f32x2 av = __builtin_elementwise_abs(v), d = av * 0.2316418882f + 1.0f;
    f32x2 t; t.x = __builtin_amdgcn_rcpf(d.x); t.y = __builtin_amdgcn_rcpf(d.y);
    f32x2 q = t * 0.5307027145f + (-0.7265760135f); q = q * t + 0.7107068705f; q = q * t + (-0.142248368f); q = q * t + 0.127414796f; q = q * t;
    const f32x2 s = (v * v) * (-0.72134752044f);
    f32x2 e; e.x = __builtin_amdgcn_exp2f(s.x); e.y = __builtin_amdgcn_exp2f(s.y);
    const f32x2 m = v * (q * e), r = v - m;
    f32x2 o; o.x = v.x < 0.f ? m.x : r.x; o.y = v.y < 0.f ? m.y : r.y; return o;
}

struct EpiF32 {
    static constexpr bool PERM = false, AFTER_DRAIN = false;
    float* C; int ldc; const float* bias;
    __device__ __forceinline__ void operator()(const f32x4 (&acc)[2][2][4][2], const Unit& u, int wr, int wc, int fr, int fq) const {
        const int row0 = u.pm * BM + wr * 64 + fr, col0 = u.pn * BM + wc * 32 + 4 * fq;
        f32x4 bv[2][2];
#pragma unroll
        for (int bj = 0; bj < 2; ++bj)
#pragma unroll
            for (int n = 0; n < 2; ++n) bv[bj][n] = bias ? *(const f32x4*)(bias + col0 + bj * HALF + n * 16) : (f32x4){0.f, 0.f, 0.f, 0.f};
#pragma unroll
        for (int ai = 0; ai < 2; ++ai)
#pragma unroll
            for (int m = 0; m < 4; ++m) { float* rowp = C + (size_t)(row0 + ai * HALF + m * 16) * ldc + col0;
#pragma unroll
                for (int bj = 0; bj < 2; ++bj)
#pragma unroll
                    for (int n = 0; n < 2; ++n) *(f32x4*)(rowp + bj * HALF + n * 16) = acc[ai][bj][m][n] + bv[bj][n]; }
    }
};
template <int ACT  > struct EpiBf16 {
    static constexpr bool PERM = true, AFTER_DRAIN = false;
    bf16_t* O; int ldc; const float* bias; int split_cols; size_t split_stride;
    __device__ __forceinline__ void operator()(const f32x4 (&acc)[2][2][4][2], const Unit& u, int wr, int wc, int fr, int fq) const {
        const int row0 = u.pm * BM + wr * 64 + fr; int colt = u.pn * BM; bf16_t* base = O;
        if (split_cols) { const int t = colt / split_cols; base += (size_t)t * split_stride; colt -= t * split_cols; }
        const int col0 = colt + wc * 32 + 8 * fq, bcol0 = u.pn * BM + wc * 32 + 8 * fq;
        f32x4 bv[2][2];
#pragma unroll
        for (int bj = 0; bj < 2; ++bj)
#pragma unroll
            for (int n = 0; n < 2; ++n) bv[bj][n] = bias ? *(const f32x4*)(bias + bcol0 + bj * HALF + 4 * n) : (f32x4){0.f, 0.f, 0.f, 0.f};
#pragma unroll
        for (int ai = 0; ai < 2; ++ai)
#pragma unroll
            for (int m = 0; m < 4; ++m) { bf16_t* rowp = base + (size_t)(row0 + ai * HALF + m * 16) * ldc + col0;
#pragma unroll
                for (int bj = 0; bj < 2; ++bj) { f32x4 v0 = acc[ai][bj][m][0] + bv[bj][0], v1 = acc[ai][bj][m][1] + bv[bj][1];
                    if (ACT == 1) { f32x2 a = gelu_pk((f32x2){v0[0], v0[1]}), b = gelu_pk((f32x2){v0[2], v0[3]}), c = gelu_pk((f32x2){v1[0], v1[1]}), d = gelu_pk((f32x2){v1[2], v1[3]});
                        v0 = (f32x4){a.x, a.y, b.x, b.y}; v1 = (f32x4){c.x, c.y, d.x, d.y}; }
                    if (ACT == 2) {
#pragma unroll
                        for (int j = 0; j < 4; ++j) { v0[j] = 0.5f * v0[j] * (1.0f + erff(v0[j] * 0.70710678f)); v1[j] = 0.5f * v1[j] * (1.0f + erff(v1[j] * 0.70710678f)); } }
                    u32x4 w; w.x = cvt_pk_bf16(v0[0], v0[1]); w.y = cvt_pk_bf16(v0[2], v0[3]); w.z = cvt_pk_bf16(v1[0], v1[1]); w.w = cvt_pk_bf16(v1[2], v1[3]);
                    *(u32x4*)(rowp + bj * HALF) = w; } }
    }
};

struct PanelStats {
    unsigned* xbuf;
    unsigned* cnt;
    unsigned* tmo;
    int ntn; float eps;
    unsigned code;
    __device__ __forceinline__ bool run(const f32x4 (&v)[2][2][4][2], const Unit& u, int wr, int wc, int fr, int fq, PG8_LAS unsigned char* lds, int wid, int lane) const {
        typedef float f32x2v __attribute__((ext_vector_type(2)));
        PG8_LAS f32x2v* P = (PG8_LAS f32x2v*)lds;
        PG8_LAS f32x2v* S = (PG8_LAS f32x2v*)(lds + 8192);
        PG8_LAS unsigned* flag = (PG8_LAS unsigned*)(lds + 8192 + 2048);
#pragma unroll
        for (int ai = 0; ai < 2; ++ai)
#pragma unroll
            for (int m = 0; m < 4; ++m) {
                float s = 0.f;
#pragma unroll
                for (int bj = 0; bj < 2; ++bj)
#pragma unroll
                    for (int n = 0; n < 2; ++n) { const f32x4 x = v[ai][bj][m][n]; s += (x[0] + x[1]) + (x[2] + x[3]); }
                s += __shfl_xor(s, 16); s += __shfl_xor(s, 32);
                const float mw = s * (1.0f / 64.0f); float q = 0.f;
#pragma unroll
                for (int bj = 0; bj < 2; ++bj)
#pragma unroll
                    for (int n = 0; n < 2; ++n) { const f32x4 d = v[ai][bj][m][n] - mw; q += (d[0] * d[0] + d[1] * d[1]) + (d[2] * d[2] + d[3] * d[3]); }
                q += __shfl_xor(q, 16); q += __shfl_xor(q, 32);
                if (fq == 0) P[(ai * HALF + wr * 64 + m * 16 + fr) * 4 + wc] = (f32x2v){mw, q};
            }
        asm volatile("s_waitcnt lgkmcnt(0)" ::: "memory"); __builtin_amdgcn_s_barrier(); asm volatile("" ::: "memory");
#if defined(BROKEN_NO_WAIT)
        if (blockIdx.x >= 64) { const long long t0 = clock64(); while (clock64() - t0 < 60000) __builtin_amdgcn_s_sleep(8); }
#endif
        const int row = wid * 32 + (lane & 31);
        if (lane < 32) {
            const f32x2v a = P[row * 4 + 0], b = P[row * 4 + 1], c = P[row * 4 + 2], d = P[row * 4 + 3];
            const float mt = (a.x + b.x + c.x + d.x) * 0.25f;
            const float da = a.x - mt, db = b.x - mt, dc = c.x - mt, dd = d.x - mt;
            const float m2 = (a.y + b.y) + (c.y + d.y) + 64.0f * ((da * da + db * db) + (dc * dc + dd * dd));
            unsigned long long* slot = (unsigned long long*)xbuf + ((size_t)(u.pm * BM + row) * 4 + u.pn);
            __hip_atomic_store(slot, ((unsigned long long)__float_as_uint(m2) << 32) | __float_as_uint(mt), __ATOMIC_RELAXED, __HIP_MEMORY_SCOPE_AGENT);
        }
        asm volatile("s_waitcnt vmcnt(0)" ::: "memory");
        if (lane == 0) __hip_atomic_fetch_add(cnt + 64 * u.pm, 1u, __ATOMIC_RELAXED, __HIP_MEMORY_SCOPE_AGENT);
        if (wid == 0) {
            bool dead = false; const unsigned long long t0 = __builtin_amdgcn_s_memrealtime(); const unsigned want = 8u * (unsigned)ntn;
            for (;;) {
#if defined(BROKEN_NO_WAIT)
                break;
#endif
                if ((unsigned)__builtin_amdgcn_readfirstlane(__hip_atomic_load(cnt + 64 * u.pm, __ATOMIC_RELAXED, __HIP_MEMORY_SCOPE_AGENT)) >= want) break;
                if (__builtin_amdgcn_s_memrealtime() - t0 > 2000000ull) {
                    if (lane == 0) { unsigned expect = 0u; __hip_atomic_compare_exchange_strong(tmo + 1, &expect, code | (unsigned)(u.pm & 0xff), __ATOMIC_RELAXED, __ATOMIC_RELAXED, __HIP_MEMORY_SCOPE_AGENT);
                                     __hip_atomic_store(tmo, 1u, __ATOMIC_RELAXED, __HIP_MEMORY_SCOPE_AGENT); }
                    dead = true; break; }
                __builtin_amdgcn_s_sleep(2);
            }
            __builtin_amdgcn_fence(__ATOMIC_ACQUIRE, "agent");
            if (lane == 0) flag[0] = dead ? 1u : 0u;
        }
        asm volatile("s_waitcnt vmcnt(0) lgkmcnt(0)" ::: "memory"); __builtin_amdgcn_s_barrier(); asm volatile("" ::: "memory");
        const bool bad = flag[0] != 0u;
        if (lane < 32) {
            const unsigned long long* slot = (const unsigned long long*)xbuf + (size_t)(u.pm * BM + row) * 4; float mt[4], m2[4]; float ms = 0.f;
#pragma unroll
            for (int t = 0; t < 4; ++t) { if (t < ntn) { const unsigned long long w = __hip_atomic_load(slot + t, __ATOMIC_RELAXED, __HIP_MEMORY_SCOPE_AGENT); mt[t] = __uint_as_float((unsigned)w); m2[t] = __uint_as_float((unsigned)(w >> 32)); } else { mt[t] = 0.f; m2[t] = 0.f; } ms += mt[t]; }
            const float mean = ms / (float)ntn; float q = 0.f;
#pragma unroll
            for (int t = 0; t < 4; ++t) if (t < ntn) { const float dm = mt[t] - mean; q += m2[t] + 256.0f * dm * dm; }
            S[row] = (f32x2v){mean, 1.0f / sqrtf(q / (256.0f * (float)ntn) + eps)};
        }
        asm volatile("s_waitcnt lgkmcnt(0)" ::: "memory"); __builtin_amdgcn_s_barrier(); asm volatile("" ::: "memory");
        return bad;
    }
};
struct EpiLnRes {
    static constexpr bool PERM = false, AFTER_DRAIN = true;
    const float* base; float* out; int ldc; const float* bias; PanelStats st; unsigned poison;
    __device__ __forceinline__ void refuse(size_t i0, size_t stride, int M, int N) const { const float q = __builtin_nanf(""); for (size_t i = i0; i < (size_t)M * N; i += stride) out[(i / N) * ldc + i % N] = q;
        if (i0 == 0) { unsigned expect = 0u; __hip_atomic_compare_exchange_strong(st.tmo + 1, &expect, 0x7f0u, __ATOMIC_RELAXED, __ATOMIC_RELAXED, __HIP_MEMORY_SCOPE_AGENT); __hip_atomic_store(st.tmo, 1u, __ATOMIC_RELAXED, __HIP_MEMORY_SCOPE_AGENT); } }
    __device__ __forceinline__ void fused(f32x4 (&acc)[2][2][4][2], const Unit& u, int wr, int wc, int fr, int fq, PG8_LAS unsigned char* lds, int wid, int lane) const {
        typedef float f32x2v __attribute__((ext_vector_type(2)));
        const PG8_LAS f32x2v* S = (const PG8_LAS f32x2v*)(lds + 8192);
        const int col0 = u.pn * BM + wc * 32 + 4 * fq;
#pragma unroll
        for (int bj = 0; bj < 2; ++bj)
#pragma unroll
            for (int n = 0; n < 2; ++n) { const f32x4 bv = bias ? *(const f32x4*)(bias + col0 + bj * HALF + n * 16) : (f32x4){0.f, 0.f, 0.f, 0.f};
#pragma unroll
                for (int ai = 0; ai < 2; ++ai)
#pragma unroll
                    for (int m = 0; m < 4; ++m) acc[ai][bj][m][n] += bv; }
        const bool bad = st.run(acc, u, wr, wc, fr, fq, lds, wid, lane) || poison != 0u;
        const float qnan = __builtin_nanf("");
#pragma unroll
        for (int ai = 0; ai < 2; ++ai)
#pragma unroll
            for (int m = 0; m < 4; ++m) { const int r = ai * HALF + wr * 64 + m * 16 + fr; const f32x2v sr = S[r]; const size_t off = (size_t)(u.pm * BM + r) * ldc + col0;
#pragma unroll
                for (int bj = 0; bj < 2; ++bj)
#pragma unroll
                    for (int n = 0; n < 2; ++n) { const f32x4 bs = *(const f32x4*)(base + off + bj * HALF + n * 16); f32x4 o = bs + (acc[ai][bj][m][n] - sr.x) * sr.y;
                        if (bad) o = (f32x4){qnan, qnan, qnan, qnan}; *(f32x4*)(out + off + bj * HALF + n * 16) = o; }
                asm volatile("" ::: "memory"); }
    }
};
struct EpiLnResLn {
    static constexpr bool PERM = false, AFTER_DRAIN = true;
    const float* base; float* out; bf16_t* xn; int ldc; const float* bias; PanelStats st1, st2; unsigned poison;
    __device__ __forceinline__ void refuse(size_t i0, size_t stride, int M, int N) const { const float q = __builtin_nanf(""); for (size_t i = i0; i < (size_t)M * N; i += stride) { const size_t o = (i / N) * ldc + i % N; out[o] = q; xn[o] = (bf16_t)0x7fc0u; }
        if (i0 == 0) { unsigned expect = 0u; __hip_atomic_compare_exchange_strong(st1.tmo + 1, &expect, 0x7f0u, __ATOMIC_RELAXED, __ATOMIC_RELAXED, __HIP_MEMORY_SCOPE_AGENT); __hip_atomic_store(st1.tmo, 1u, __ATOMIC_RELAXED, __HIP_MEMORY_SCOPE_AGENT); } }
    __device__ __forceinline__ void fused(f32x4 (&acc)[2][2][4][2], const Unit& u, int wr, int wc, int fr, int fq, PG8_LAS unsigned char* lds, int wid, int lane) const {
        typedef float f32x2v __attribute__((ext_vector_type(2))); typedef unsigned u32x2v __attribute__((ext_vector_type(2)));
        const PG8_LAS f32x2v* S = (const PG8_LAS f32x2v*)(lds + 8192);
        const int col0 = u.pn * BM + wc * 32 + 4 * fq;
#pragma unroll
        for (int bj = 0; bj < 2; ++bj)
#pragma unroll
            for (int n = 0; n < 2; ++n) { const f32x4 bv = bias ? *(const f32x4*)(bias + col0 + bj * HALF + n * 16) : (f32x4){0.f, 0.f, 0.f, 0.f};
#pragma unroll
                for (int ai = 0; ai < 2; ++ai)
#pragma unroll
                    for (int m = 0; m < 4; ++m) acc[ai][bj][m][n] += bv; }
        bool bad = st1.run(acc, u, wr, wc, fr, fq, lds, wid, lane) || poison != 0u;
        const float qnan = __builtin_nanf("");
#pragma unroll
        for (int ai = 0; ai < 2; ++ai)
#pragma unroll
            for (int m = 0; m < 4; ++m) { const int r = ai * HALF + wr * 64 + m * 16 + fr; const f32x2v sr = S[r]; const size_t off = (size_t)(u.pm * BM + r) * ldc + col0;
#pragma unroll
                for (int bj = 0; bj < 2; ++bj)
#pragma unroll
                    for (int n = 0; n < 2; ++n) { const f32x4 bs = *(const f32x4*)(base + off + bj * HALF + n * 16); acc[ai][bj][m][n] = bs + (acc[ai][bj][m][n] - sr.x) * sr.y; }
                asm volatile("" : "+v"(acc[ai][0][m][0]), "+v"(acc[ai][0][m][1]), "+v"(acc[ai][1][m][0]), "+v"(acc[ai][1][m][1]));
                if (m & 1) asm volatile("" ::: "memory"); }
        const bool bad1 = bad;
        bad = st2.run(acc, u, wr, wc, fr, fq, lds, wid, lane) || bad;
#pragma unroll
        for (int ai = 0; ai < 2; ++ai)
#pragma unroll
            for (int m = 0; m < 4; ++m) { const int r = ai * HALF + wr * 64 + m * 16 + fr; const f32x2v sr = S[r]; const size_t off = (size_t)(u.pm * BM + r) * ldc + col0;
#pragma unroll
                for (int bj = 0; bj < 2; ++bj)
#pragma unroll
                    for (int n = 0; n < 2; ++n) { const f32x4 x1 = acc[ai][bj][m][n]; *(f32x4*)(out + off + bj * HALF + n * 16) = bad1 ? (f32x4){qnan, qnan, qnan, qnan} : x1;
                        const f32x4 o = (x1 - sr.x) * sr.y; u32x2v w; w.x = cvt_pk_bf16(o[0], o[1]); w.y = cvt_pk_bf16(o[2], o[3]);
                        if (bad) { w.x = 0x7fc07fc0u; w.y = 0x7fc07fc0u; } *(u32x2v*)(xn + off + bj * HALF + n * 16) = w; }
                asm volatile("" ::: "memory"); }
    }
};

template <class Epi, class Sched, bool STAMP = false>
__device__ __forceinline__ void gemm_phase(PG8_LAS unsigned char* lds, const Gemm g, const Sched& S, const Epi& E, unsigned long long* stamps) {
    const int tid = threadIdx.x, wid = __builtin_amdgcn_readfirstlane(tid >> 6), lane = tid & 63, wr = wid >> 2, wc = wid & 3, fr = lane & 15, fq = lane >> 4;
    const int K = g.K, nt = K / BK;
    int ts_lo = 0, ts_hi = 0, nts = 0; const unsigned long long rt_entry = STAMP ? (unsigned long long)wall_clock64() : 0ull;
#define PG8_STAMP() do { if (STAMP && wid == 0 && nts < 64) { const unsigned long long _c = (unsigned long long)clock64(); \
        ts_lo = (lane == nts) ? (int)(unsigned)_c : ts_lo; ts_hi = (lane == nts) ? (int)(unsigned)(_c >> 32) : ts_hi; ++nts; } } while (0)
    PG8_STAMP();
    unsigned voffA[2], voffB[2];
#pragma unroll
    for (int i = 0; i < 2; ++i) { int R, C; stage_rc(tid * 16 + i * 8192, R, C); const int Rb = Epi::PERM ? ((R & ~31) + perm32(R & 31)) : R;
        voffA[i] = (unsigned)(R * K + C) * 2u; voffB[i] = (unsigned)(Rb * K + C) * 2u; }
    const size_t kstep = (size_t)(BK * 2);
    const size_t hstep = (size_t)HALF * K * 2;
    const size_t tstep = 2 * hstep;
    const unsigned ldsw = (unsigned)wid * 1024u;
    const int aoff = lds_byte(wr * 64 + fr, fq * 8), boff = lds_byte(wc * 32 + fr, fq * 8);
#define PG8_SA(b, h) (((b) * 2 + (h)) * HTB)
#define PG8_SB(b, h) ((4 + (b) * 2 + (h)) * HTB)
#define PG8_STAGE(bufoff, gbase, voff) do { _Pragma("unroll") for (int _i = 0; _i < 2; ++_i) \
        __builtin_amdgcn_global_load_lds((const unsigned*)((const char*)(gbase) + (voff)[_i]), (PG8_LAS unsigned*)(lds + (bufoff) + ldsw + _i * 8192), 16, 0, 0); } while (0)
#define PG8_LDA(dst, b, h) do { _Pragma("unroll") for (int m = 0; m < 4; ++m) _Pragma("unroll") for (int k = 0; k < 2; ++k) dst[m][k] = *(const PG8_LAS bf16x8*)(lds + PG8_SA(b, h) + aoff + m * 2048 + k * 1024); } while (0)
#define PG8_LDB(dst, b, h) do { _Pragma("unroll") for (int n = 0; n < 2; ++n) _Pragma("unroll") for (int k = 0; k < 2; ++k) dst[n][k] = *(const PG8_LAS bf16x8*)(lds + PG8_SB(b, h) + boff + n * 2048 + k * 1024); } while (0)
#define PG8_MMA(ai, bj, At, Bt) do { __builtin_amdgcn_s_setprio(1); _Pragma("unroll") for (int m = 0; m < 4; ++m) _Pragma("unroll") for (int n = 0; n < 2; ++n) _Pragma("unroll") for (int k = 0; k < 2; ++k) \
        acc[ai][bj][m][n] = __builtin_amdgcn_mfma_f32_16x16x32_bf16(Bt[n][k], At[m][k], acc[ai][bj][m][n], 0, 0, 0); __builtin_amdgcn_s_setprio(0); } while (0)
#define PG8_WAIT_V(n) asm volatile("s_waitcnt vmcnt(" #n ")" ::: "memory")
#define PG8_WAIT_L(n) asm volatile("s_waitcnt lgkmcnt(" #n ")" ::: "memory")
#define PG8_BAR __builtin_amdgcn_s_barrier()
#define PG8_SCHED __builtin_amdgcn_sched_barrier(0)
    Unit cur, nxt; int ui = 0;
    if (!S.next(0, cur)) return;
    f32x4 acc[2][2][4][2];
#pragma unroll
    for (int a = 0; a < 2; ++a)
#pragma unroll
        for (int b = 0; b < 2; ++b)
#pragma unroll
            for (int m = 0; m < 4; ++m)
#pragma unroll
                for (int n = 0; n < 2; ++n) acc[a][b][m][n] = (f32x4){0.f, 0.f, 0.f, 0.f};
    bf16x8 At[4][2], B0[2][2], B1[2][2];
    const char* cA = (const char*)g.A + (size_t)cur.pm * tstep; const char* cB = (const char*)g.Bt + (size_t)cur.pn * tstep;
    S.a_ready(cur);
    PG8_STAGE(PG8_SB(0, 0), cB, voffB); PG8_STAGE(PG8_SA(0, 0), cA, voffA); PG8_STAGE(PG8_SB(0, 1), cB + hstep, voffB); PG8_STAGE(PG8_SA(0, 1), cA + hstep, voffA);
    if (wr == 1) PG8_BAR;
    PG8_WAIT_V(4); PG8_BAR;
    PG8_STAGE(PG8_SB(1, 0), cB + kstep, voffB); PG8_STAGE(PG8_SA(1, 0), cA + kstep, voffA); PG8_STAGE(PG8_SB(1, 1), cB + hstep + kstep, voffB);
    PG8_WAIT_V(6); PG8_BAR;
    PG8_STAMP();
    for (;;) {
        const bool has_next = S.next(ui + 1, nxt);
        const char* nA = has_next ? (const char*)g.A + (size_t)nxt.pm * tstep : cA; const char* nB = has_next ? (const char*)g.Bt + (size_t)nxt.pn * tstep : cB;
        for (int t = 0; t < nt; t += 2) {
            const bool last = (t == nt - 2);
            const char* a1 = cA + (size_t)(t + 1) * kstep;
            const char* a2 = last ? nA : cA + (size_t)(t + 2) * kstep; const char* b2 = last ? nB : cB + (size_t)(t + 2) * kstep;
            const char* a3 = a2 + kstep; const char* b3 = b2 + kstep;
            if (last && has_next) S.a_ready(nxt);
            PG8_LDB(B0, 0, 0); PG8_SCHED; PG8_LDA(At, 0, 0); PG8_STAGE(PG8_SA(1, 1), a1 + hstep, voffA);
            PG8_WAIT_L(8); PG8_BAR; PG8_WAIT_L(0); PG8_MMA(0, 0, At, B0); PG8_BAR; PG8_SCHED;
            PG8_LDB(B1, 0, 1); PG8_STAGE(PG8_SB(0, 0), b2, voffB);
            PG8_BAR; PG8_WAIT_L(0); PG8_MMA(0, 1, At, B1); PG8_BAR;
            PG8_LDA(At, 0, 1); PG8_STAGE(PG8_SA(0, 0), a2, voffA);
            PG8_BAR; PG8_WAIT_L(0); PG8_MMA(1, 0, At, B0); PG8_BAR; PG8_SCHED;
            PG8_STAGE(PG8_SB(0, 1), b2 + hstep, voffB);
            PG8_WAIT_V(6); PG8_BAR; PG8_MMA(1, 1, At, B1); PG8_BAR;
            PG8_LDB(B0, 1, 0); PG8_SCHED; PG8_LDA(At, 1, 0); PG8_STAGE(PG8_SA(0, 1), a2 + hstep, voffA);
            PG8_WAIT_L(8); PG8_BAR; PG8_WAIT_L(0); PG8_MMA(0, 0, At, B0); PG8_BAR; PG8_SCHED;
            PG8_LDB(B1, 1, 1); PG8_STAGE(PG8_SB(1, 0), b3, voffB);
            PG8_BAR; PG8_WAIT_L(0); PG8_MMA(0, 1, At, B1); PG8_BAR;
            PG8_LDA(At, 1, 1); PG8_STAGE(PG8_SA(1, 0), a3, voffA);
            PG8_BAR; PG8_WAIT_L(0); PG8_MMA(1, 0, At, B0); PG8_BAR; PG8_SCHED;
            PG8_STAGE(PG8_SB(1, 1), b3 + hstep, voffB);
            PG8_WAIT_V(6); PG8_BAR; PG8_MMA(1, 1, At, B1); PG8_BAR;
        }
        PG8_STAMP();
        if constexpr (!Epi::AFTER_DRAIN) { E(acc, cur, wr, wc, fr, fq); S.done(cur); }
        PG8_STAMP();
        if (!has_next) break;
#pragma unroll
        for (int a = 0; a < 2; ++a)
#pragma unroll
            for (int b = 0; b < 2; ++b)
#pragma unroll
                for (int m = 0; m < 4; ++m)
#pragma unroll
                    for (int n = 0; n < 2; ++n) acc[a][b][m][n] = (f32x4){0.f, 0.f, 0.f, 0.f};
        cur = nxt; cA = nA; cB = nB; ++ui;
    }
    PG8_WAIT_V(0);
    if (wr == 0) PG8_BAR;
    PG8_BAR;
    if constexpr (Epi::AFTER_DRAIN) { E.fused(acc, cur, wr, wc, fr, fq, lds, wid, lane); S.done(cur); }
    PG8_STAMP();
    if (STAMP && wid == 0) { stamps[lane] = lane < nts ? (((unsigned long long)(unsigned)ts_hi << 32) | (unsigned)ts_lo) : 0ull;
        if (lane == 62) stamps[62] = rt_entry; if (lane == 63) stamps[63] = (unsigned long long)wall_clock64(); }
#undef PG8_STAMP
#undef PG8_SA
#undef PG8_SB
#undef PG8_STAGE
#undef PG8_LDA
#undef PG8_LDB
#undef PG8_MMA
#undef PG8_WAIT_V
#undef PG8_WAIT_L
#undef PG8_BAR
#undef PG8_SCHED
}
}

#define XB_TMO      128
#define XB_XCNT(j)  (256  + 64 * (j))
#define XB_XSUB(j)  (1280 + 64 * (j))
#define XB_XGEN(j)  (2304 + 64 * (j))
#define XB_TOP      3328
#define XB_TOPGEN   3392
#define XCD_BAR_WORDS 3456
#define XB_SPIN_CAP (1u << 22)
#define LAS __attribute__((address_space(3)))
DI unsigned xb_ld(unsigned* p) { return __hip_atomic_load(p, __ATOMIC_RELAXED, __HIP_MEMORY_SCOPE_AGENT); }
DI unsigned xb_add(unsigned* p, unsigned v) { return __hip_atomic_fetch_add(p, v, __ATOMIC_RELAXED, __HIP_MEMORY_SCOPE_AGENT); }
DI unsigned xb_xcc_id() { return (unsigned)__builtin_amdgcn_s_getreg((3 << 11) | 20) & 0xFu; }
#define XB_SPIN(cond, bar) do { unsigned _sp = 0; while (cond) { __builtin_amdgcn_s_sleep(1); \
    if ((++_sp & 255u) == 0u) { if (xb_ld(&(bar)[XB_TMO])) break; if (_sp > XB_SPIN_CAP) { atomicAdd(&(bar)[XB_TMO], 1u); break; } } } } while (0)
struct XcdBarrier { unsigned* bar; unsigned x; volatile LAS unsigned* st; };
DI XcdBarrier xcd_barrier_post(unsigned* bar, volatile LAS unsigned* st) {
  XcdBarrier b; b.bar = bar; b.x = xb_xcc_id(); b.st = st;
  if (threadIdx.x == 0) (void)xb_add(&bar[XB_XCNT(b.x)], 1u);
  return b;
}
DI void xcd_barrier_complete(unsigned* bar, unsigned x, unsigned& nloc, unsigned& nx) {
  const unsigned G = gridDim.x * gridDim.y * gridDim.z;
  unsigned sum, cnt, mine, sp = 0u;
  for (;;) {
    sum = 0u; cnt = 0u; mine = 0u;
#pragma unroll
    for (unsigned j = 0; j < 16; ++j) { const unsigned c = xb_ld(&bar[XB_XCNT(j)]); sum += c; cnt += (c > 0u) ? 1u : 0u; mine = (j == x) ? c : mine; }
    if (sum == G) break;
    __builtin_amdgcn_s_sleep(1);
    if ((++sp & 255u) == 0u) { if (xb_ld(&bar[XB_TMO])) break; if (sp > XB_SPIN_CAP) { atomicAdd(&bar[XB_TMO], 1u); break; } }
  }
  nloc = mine > 0u ? mine : 1u; nx = cnt > 0u ? cnt : 1u;
}
DI void xcd_barrier(const XcdBarrier& b) {
  asm volatile("s_waitcnt vmcnt(0)" ::: "memory");
  __syncthreads();
  if (threadIdx.x == 0) {
    unsigned* bar = b.bar;
    __builtin_amdgcn_s_waitcnt(0);
    unsigned nloc = b.st[0], nx = b.st[1];
    if (nloc == 0u) { xcd_barrier_complete(bar, b.x, nloc, nx); b.st[0] = nloc; b.st[1] = nx; }
    const unsigned old = xb_add(&bar[XB_XSUB(b.x)], 1u);
    const unsigned gen = old / nloc;
    if (old + 1u == (gen + 1u) * nloc) {
      __builtin_amdgcn_fence(__ATOMIC_RELEASE, "agent");
      asm volatile("s_waitcnt vmcnt(0)" ::: "memory");
      const unsigned og = xb_add(&bar[XB_TOP], 1u);
      const unsigned tg = og / nx;
      if (og + 1u == (tg + 1u) * nx) xb_add(&bar[XB_TOPGEN], 1u);
      else XB_SPIN(xb_ld(&bar[XB_TOPGEN]) == tg, bar);
      __builtin_amdgcn_fence(__ATOMIC_ACQUIRE, "agent");
      xb_add(&bar[XB_XGEN(b.x)], 1u);
      asm volatile("s_waitcnt vmcnt(0)" ::: "memory");
    } else {
      XB_SPIN(xb_ld(&bar[XB_XGEN(b.x)]) == gen, bar);
      __builtin_amdgcn_fence(__ATOMIC_ACQUIRE, "agent");
      asm volatile("s_waitcnt vmcnt(0)" ::: "memory");
    }
  }
  __syncthreads();
}

#define GPTR(T, x) ((T*)(__attribute__((address_space(1))) T*)(x))
__global__ void __launch_bounds__(NT) mega(P p) {
  extern __shared__ __attribute__((aligned(16))) unsigned char lds[];
  cg::grid_group grid = cg::this_grid();
  volatile LAS unsigned* st = (volatile LAS unsigned*)(lds + LDS_BYTES - 16);
  if (threadIdx.x < 4) st[threadIdx.x] = 0u;
  __syncthreads();
  const XcdBarrier xbar = xcd_barrier_post((unsigned*)(p.ws + WS_BAR), st);
  phase0(p, lds);
  grid.sync();
  const P& p0 = p;
  for (int step = 0; step < 50; ++step) {
    const int g = step / 25, rem = step - g * 25, layer = rem / 5, sub = rem - layer * 5;
    const int kind = layer % 3, jl = layer / 3;
    const int T = g ? 16384 : 8192, Lmask = g ? 4095 : 255;
    int op = -1;
    if (layer == 4) op = (sub == 0) ? 0 : -1;
    else if (sub == 0) op = 0;
    else if (kind == 0) op = sub == 1 ? 1 : (sub == 2 ? 2 : (sub == 3 ? 3 : 4));
    else if (kind == 1) op = sub == 1 ? 5 : (sub == 2 ? 6 : (sub == 3 ? 4 : -1));
    else op = sub == 1 ? 4 : (sub == 2 ? 7 : (sub == 3 ? 4 : -1));
    if (op < 0) continue;
    P p = p0;
    { size_t zo_ = 0; asm volatile("" : "+s"(zo_)); p.ws = p0.ws + zo_; p.out = p0.out + zo_; }
    bf16_t* slots = (bf16_t*)(p.ws + WS_SLOT);
    const bf16_t* W = (const bf16_t*)(p.ws + WS_W);
    if (op == 0) {
      const float* xin = p.in[g]; float* xout = p.out + (g ? OUT_YS : OUT_YP);
      phase_norm(p, g, layer - 1, layer < 4 ? layer : -1, layer <= 1 ? xin : xout, xout, slots + SLOT_ELEMS, slots);
      if (kind == 1 && g == 1 && layer < 4) phase_cache_copy(p);
    } else if (op == 1) {
      for (int rep = 0; rep < opq(REP_GEMM); ++rep) phase_gemm<1, 0>(p, g, slots, W + (size_t)(RW_IN0 + jl * RW_STRIDE) * 1024, T, 4352, p.in[11] + jl * 6144, Lmask, slots + SLOT_ELEMS, 1, lds);
    } else if (op == 2) {
      for (int rep = 0; rep < opq(REP_SCAN); ++rep) phase_scan(p, g, jl, lds);
    } else if (op == 3) {
      phase_rwkv_combine(p, g, jl);
    } else if (op == 4) {
      const bf16_t* A; const bf16_t* Bt; int N; bf16_t* dst;
      if (sub == 1) { A = slots; Bt = W + (size_t)CV_IN * 1024; N = 4096; dst = slots + 2 * SLOT_ELEMS; }
      else {
        N = 1024; dst = slots + SLOT_ELEMS;
        if (kind == 0) { A = slots + 4 * SLOT_ELEMS; Bt = W + (size_t)(RW_OUT0 + jl * RW_STRIDE) * 1024; }
        else if (kind == 1) { A = slots + 5 * SLOT_ELEMS; Bt = W + (size_t)AT_OUT * 1024; }
        else { A = slots; Bt = W + (size_t)CV_OUT * 1024; }
      }
      {
        pg8::Gemm gg{A, Bt, T, N, 1024}; pg8::StaticOrder S; S.init(T, N, (int)gridDim.x, (int)blockIdx.x);
        pg8::EpiBf16<0> E{dst, 1024, nullptr, N > 1024 ? 1024 : 0, SLOT_ELEMS};
        pg8::gemm_phase<pg8::EpiBf16<0>, pg8::StaticOrder, false>((PG8_LAS unsigned char*)(unsigned)(unsigned long long)lds, gg, S, E, nullptr);
      }
    } else if (op == 5) {
      for (int rep = 0; rep < opq(REP_GEMM); ++rep) phase_gemm<0, 1>(p, g, slots, W + (size_t)AT_IN * 1024, T, 2560, nullptr, 0, nullptr, 0, lds);
    } else if (op == 6) {
      for (int rep = 0; rep < opq(REP_ATTN); ++rep) phase_attn(p, g, lds);
    } else {
      phase_conv(p, g);
    }
    if (!(g == 1 && layer == 4)) for (int rep = 0; rep < opq(REP_SYNC); ++rep) xcd_barrier(xbar);
  }
}

extern "C" void kernel_launch(void* const* d_in, const int* in_sizes, int n_in, void* d_out, int out_size, void* d_ws, size_t ws_size, hipStream_t stream) {
  static int grid_blocks = 0;
  if (!grid_blocks) {
    int dev = 0, cus = 0, per_cu = 0;
    hipGetDevice(&dev);
    hipDeviceGetAttribute(&cus, hipDeviceAttributeMultiprocessorCount, dev);
    hipFuncSetAttribute((const void*)mega, hipFuncAttributeMaxDynamicSharedMemorySize, LDS_BYTES);
    hipOccupancyMaxActiveBlocksPerMultiprocessor(&per_cu, (const void*)mega, NT, LDS_BYTES);
    if (per_cu < 1) per_cu = 1;
    if (per_cu > 1) per_cu = 1;
    grid_blocks = cus * per_cu;
    if (ws_size < WS_SLOT + 6 * SLOT_ELEMS * 2) fprintf(stderr, "workspace too small: %zu\n", ws_size);
  }
  (void)hipMemsetAsync((unsigned char*)d_ws + WS_BAR, 0, XCD_BAR_WORDS * sizeof(unsigned), stream);
  P p{};
  for (int i = 0; i < 33; ++i) p.in[i] = (const float*)d_in[i];
  p.out = (float*)d_out; p.ws = (unsigned char*)d_ws;
  void* args[] = {&p};
  hipError_t e = hipLaunchCooperativeKernel((const void*)mega, dim3(grid_blocks), dim3(NT), args, LDS_BYTES, stream);
  if (e != hipSuccess) fprintf(stderr, "cooperative launch failed: %s (grid %d)\n", hipGetErrorString(e), grid_blocks);
}
```

```cpp
#include <hip/hip_runtime.h>
#include <hip/hip_cooperative_groups.h>
#include <cstdio>
namespace cg = cooperative_groups;

typedef unsigned short bf16_t;
using bf16x8 = __attribute__((ext_vector_type(8))) short;
using f32x16 = __attribute__((ext_vector_type(16))) float;
using u32x4 = __attribute__((ext_vector_type(4))) unsigned;
using u32x2 = __attribute__((ext_vector_type(2))) unsigned;

#define NT 512
#ifndef REP_GEMM
#define REP_GEMM 1
#endif
#ifndef REP_SCAN
#define REP_SCAN 1
#endif
#ifndef REP_ATTN
#define REP_ATTN 1
#endif
#ifndef REP_SYNC
#define REP_SYNC 1
#endif
#define DI __device__ __forceinline__
#define MFMA32(a, b, c) __builtin_amdgcn_mfma_f32_32x32x16_bf16((a), (b), (c), 0, 0, 0)

struct P { const float* in[33]; float* out; unsigned char* ws; };

constexpr size_t WS_ADA = 0;
constexpr size_t WS_ROPE = 262144;
constexpr size_t WS_BON = 327680;
constexpr size_t WS_HID = WS_BON + 2097152;
constexpr size_t WS_W = WS_HID + 8388608;
constexpr size_t WS_SLOT = WS_W + 39845888;
constexpr size_t SLOT_ELEMS = (size_t)16384 * 1024;
constexpr int RW_IN0 = 0, RW_OUT0 = 4352, RW_STRIDE = 5376, AT_IN = 10752, AT_OUT = 13312, CV_IN = 14336, CV_OUT = 18432;
constexpr size_t OUT_YP = 0, OUT_YS = 8388608, OUT_ST = 25165824, OUT_CK = 33554432, OUT_CV = 35651584;
constexpr int LDS_BYTES = 156416 + 16;
constexpr size_t WS_BAR = 278528;

typedef __bf16 bf16x2_t __attribute__((ext_vector_type(2)));
typedef float f32x2_t __attribute__((ext_vector_type(2)));
DI unsigned pack2(float a, float b) { f32x2_t v = {a, b}; return __builtin_bit_cast(unsigned, __builtin_convertvector(v, bf16x2_t)); }
DI unsigned f2bf(float x) { return (unsigned)__builtin_bit_cast(unsigned short, (__bf16)x); }
DI float bflo(unsigned u) { return __uint_as_float(u << 16); }
DI float bfhi(unsigned u) { return __uint_as_float(u & 0xffff0000u); }
DI float bf1(bf16_t u) { return __uint_as_float(((unsigned)u) << 16); }

template <int CTRL> DI float dppf(float v) { return __int_as_float(__builtin_amdgcn_update_dpp(0, __float_as_int(v), CTRL, 0xF, 0xF, true)); }
DI float reduce16(float v) { v += dppf<0xB1>(v); v += dppf<0x4E>(v); v += dppf<0x141>(v); v += dppf<0x140>(v); return v; }
DI float rdl(float v, int l) { return __int_as_float(__builtin_amdgcn_readlane(__float_as_int(v), l)); }
DI float wave_sum(float v) { v = reduce16(v); return (rdl(v, 0) + rdl(v, 16)) + (rdl(v, 32) + rdl(v, 48)); }
DI float xhalf_max(float x) { const auto r2 = __builtin_amdgcn_permlane32_swap(__float_as_uint(x), __float_as_uint(x), false, false); return fmaxf(__uint_as_float(r2[0]), __uint_as_float(r2[1])); }
DI float xhalf_sum(float x) { const auto r2 = __builtin_amdgcn_permlane32_swap(__float_as_uint(x), __float_as_uint(x), false, false); return __uint_as_float(r2[0]) + __uint_as_float(r2[1]); }
DI float quad_sum(float v) { v += dppf<0xB1>(v); v += dppf<0x4E>(v); return v; }
DI float silu(float x) { return x / (1.f + __expf(-x)); }
DI int opq(int v) { asm volatile("" : "+s"(v)); return v; }
DI int otid() { int t = threadIdx.x; asm volatile("" : "+v"(t)); return t; }

DI void conv_tiles(const float* __restrict__ src, int N, bf16_t* __restrict__ dst, float* lds) {
  const int tid = otid();
  const int tilesN = N >> 6, ntiles = 16 * tilesN;
  for (int tile = blockIdx.x; tile < ntiles; tile += gridDim.x) {
    const int kt = tile / tilesN, nt = tile - kt * tilesN, k0 = kt * 64, n0 = nt * 64;
#pragma unroll
    for (int i = 0; i < 8; ++i) { const int k = (tid >> 6) + 8 * i, n = tid & 63; lds[k * 65 + n] = src[(size_t)(k0 + k) * N + n0 + n]; }
    __syncthreads();
    { const int n = tid >> 3, kc = (tid & 7) * 8; u32x4 o;
#pragma unroll
      for (int j = 0; j < 4; ++j) o[j] = pack2(lds[(kc + 2 * j) * 65 + n], lds[(kc + 2 * j + 1) * 65 + n]);
      *(u32x4*)(dst + (size_t)(n0 + n) * 1024 + k0 + kc) = o; }
    __syncthreads();
  }
}

DI void phase0(const P& p, unsigned char* ldsb) {
  float* lds = (float*)ldsb;
  const int tid = otid();
  bf16_t* W = (bf16_t*)(p.ws + WS_W);
#pragma unroll 1
  for (int e = 0; e < opq(22); ++e) {
    const float* src; int N, drow;
    if (e < 18) {
      const int j = e / 9, q = e - j * 9;
      if (q < 4) { src = p.in[12] + (size_t)(j * 4 + q) * 1048576; N = 1024; drow = RW_IN0 + j * RW_STRIDE + q * 1024; }
      else if (q < 6) { src = p.in[14] + (size_t)(j * 2 + q - 4) * 65536; N = 64; drow = RW_IN0 + j * RW_STRIDE + 4096 + (q - 4) * 64; }
      else if (q < 8) { src = p.in[17] + (size_t)(j * 2 + q - 6) * 65536; N = 64; drow = RW_IN0 + j * RW_STRIDE + 4224 + (q - 6) * 64; }
      else { src = p.in[24] + (size_t)j * 1048576; N = 1024; drow = RW_OUT0 + j * RW_STRIDE; }
    } else if (e == 18) { src = p.in[25]; N = 2560; drow = AT_IN; }
    else if (e == 19) { src = p.in[28]; N = 1024; drow = AT_OUT; }
    else if (e == 20) { src = p.in[29]; N = 4096; drow = CV_IN; }
    else { src = p.in[32]; N = 1024; drow = CV_OUT; }
    conv_tiles(src, N, W + (size_t)drow * 1024, lds);
  }
  {
    float* scond = lds;
    float* red = lds + 5120;
    for (int e = tid; e < 5120; e += NT) { const int cnd = e >> 10, k = e & 1023; const float cv = cnd == 0 ? p.in[6][k] : p.in[5][(cnd - 1) * 1024 + k]; scond[e] = silu(cv); }
    __syncthreads();
    float* ada = (float*)(p.ws + WS_ADA);
    for (int task = blockIdx.x; task < 192; task += gridDim.x) {
      const int layer = task / 48, n0 = (task % 48) * 64, c = tid & 63, kg = tid >> 6;
      float a0 = 0.f, a1 = 0.f, a2 = 0.f, a3 = 0.f, a4 = 0.f;
      const float* wp = p.in[9] + ((size_t)layer * 1024 + kg * 128) * 3072 + n0 + c;
#pragma unroll 8
      for (int k = 0; k < 128; ++k) { const float w = wp[(size_t)k * 3072]; const int kk = kg * 128 + k;
        a0 += scond[kk] * w; a1 += scond[1024 + kk] * w; a2 += scond[2048 + kk] * w; a3 += scond[3072 + kk] * w; a4 += scond[4096 + kk] * w; }
      red[(kg * 5 + 0) * 64 + c] = a0; red[(kg * 5 + 1) * 64 + c] = a1; red[(kg * 5 + 2) * 64 + c] = a2; red[(kg * 5 + 3) * 64 + c] = a3; red[(kg * 5 + 4) * 64 + c] = a4;
      __syncthreads();
      if (tid < 320) { const int cnd = tid >> 6; float s = p.in[10][layer * 3072 + n0 + c];
#pragma unroll
        for (int q = 0; q < 8; ++q) s += red[(q * 5 + cnd) * 64 + c];
        ada[(cnd * 4 + layer) * 3072 + n0 + c] = s; }
      __syncthreads();
    }
  }
  if (blockIdx.x == gridDim.x - 1) {
    float* rope = (float*)(p.ws + WS_ROPE);
    for (int e = tid; e < 1024; e += NT) {
      const int pos = e >> 4, f = e & 15;
      double inv = 1.0; for (int q = 0; q < f; ++q) inv *= 0.5623413251903491;
      double ang = (double)pos * inv;
      const double twopi = 6.283185307179586476925286766559;
      double n = __builtin_rint(ang / twopi); double rr = ang - n * twopi;
      double r2 = rr * rr, sn = 0.0, cs = 0.0, ts = rr, tc = 1.0;
      for (int q = 0; q < 16; ++q) { cs += tc; sn += ts; tc = -tc * r2 / (double)((2 * q + 1) * (2 * q + 2)); ts = -ts * r2 / (double)((2 * q + 2) * (2 * q + 3)); }
      rope[e * 2] = (float)cs; rope[e * 2 + 1] = (float)sn;
    }
  }
}

DI void phase_norm(const P& p, int g, int lpost, int lpre, const float* __restrict__ xsrc, float* __restrict__ xdst,
                   const bf16_t* __restrict__ Mb, bf16_t* __restrict__ H) {
  const int T = g ? 16384 : 8192;
  const int tid = otid(); const int lane = tid & 63, wave = tid >> 6;
  const float* ada = (const float*)(p.ws + WS_ADA);
  float4 xn[4]; u32x2 mn[4];
  const int t0 = blockIdx.x * 8 + wave, tstep = gridDim.x * 8;
#pragma unroll
  for (int i = 0; i < 4; ++i) { xn[i] = make_float4(0.f, 0.f, 0.f, 0.f); mn[i] = (u32x2){0u, 0u}; }
  if (t0 < T) {
#pragma unroll
    for (int i = 0; i < 4; ++i) { xn[i] = *(const float4*)(xsrc + (size_t)t0 * 1024 + 256 * i + 4 * lane); if (lpost >= 0) mn[i] = *(const u32x2*)(Mb + (size_t)t0 * 1024 + 256 * i + 4 * lane); }
  }
  for (int t = t0; t < T; t += tstep) {
    const int cond = g ? 1 + (t >> 12) : 0;
    float4 x[4]; u32x2 mr[4];
#pragma unroll
    for (int i = 0; i < 4; ++i) { x[i] = xn[i]; mr[i] = mn[i]; }
    if (t + tstep < T) {
#pragma unroll
      for (int i = 0; i < 4; ++i) { xn[i] = *(const float4*)(xsrc + (size_t)(t + tstep) * 1024 + 256 * i + 4 * lane); if (lpost >= 0) mn[i] = *(const u32x2*)(Mb + (size_t)(t + tstep) * 1024 + 256 * i + 4 * lane); }
    }
    if (lpost >= 0) {
      float m[16]; float ss = 0.f;
#pragma unroll
      for (int i = 0; i < 4; ++i) { const u32x2 u = mr[i];
        m[4 * i] = bflo(u[0]); m[4 * i + 1] = bfhi(u[0]); m[4 * i + 2] = bflo(u[1]); m[4 * i + 3] = bfhi(u[1]); }
#pragma unroll
      for (int i = 0; i < 16; ++i) ss += m[i] * m[i];
      ss = wave_sum(ss);
      const float rs = rsqrtf(ss * (1.f / 1024.f) + 1e-6f);
      const float* gate = ada + (cond * 4 + lpost) * 3072 + 2048;
      const float* wpo = p.in[8] + lpost * 1024;
#pragma unroll
      for (int i = 0; i < 4; ++i) { const int c = 256 * i + 4 * lane; const float4 gt = *(const float4*)(gate + c); const float4 wv = *(const float4*)(wpo + c);
        x[i].x += gt.x * (m[4 * i] * rs * wv.x); x[i].y += gt.y * (m[4 * i + 1] * rs * wv.y); x[i].z += gt.z * (m[4 * i + 2] * rs * wv.z); x[i].w += gt.w * (m[4 * i + 3] * rs * wv.w);
        *(float4*)(xdst + (size_t)t * 1024 + c) = x[i]; }
    }
    if (lpre >= 0) {
      float ss = 0.f;
#pragma unroll
      for (int i = 0; i < 4; ++i) ss += x[i].x * x[i].x + x[i].y * x[i].y + x[i].z * x[i].z + x[i].w * x[i].w;
      ss = wave_sum(ss);
      const float rs = rsqrtf(ss * (1.f / 1024.f) + 1e-6f);
      const float* sh = ada + (cond * 4 + lpre) * 3072; const float* sc = sh + 1024; const float* wpr = p.in[7] + lpre * 1024;
#pragma unroll
      for (int i = 0; i < 4; ++i) { const int c = 256 * i + 4 * lane; const float4 s4 = *(const float4*)(sh + c); const float4 c4 = *(const float4*)(sc + c); const float4 wv = *(const float4*)(wpr + c);
        u32x2 o; o[0] = pack2(x[i].x * rs * wv.x * (1.f + c4.x) + s4.x, x[i].y * rs * wv.y * (1.f + c4.y) + s4.y);
        o[1] = pack2(x[i].z * rs * wv.z * (1.f + c4.z) + s4.z, x[i].w * rs * wv.w * (1.f + c4.w) + s4.w);
        *(u32x2*)(H + (size_t)t * 1024 + c) = o; }
    }
  }
}

DI void phase_xsmix(const P& p, int g, int jl) {
  const int T = g ? 16384 : 8192, Lmask = g ? 4095 : 255;
  const bf16_t* H = (const bf16_t*)(p.ws + WS_SLOT); bf16_t* XS = (bf16_t*)(p.ws + WS_SLOT) + 2 * SLOT_ELEMS;
  const float* mu = p.in[11] + jl * 6144;
  for (int e = blockIdx.x * NT + otid(); e < T * 128; e += gridDim.x * NT) {
    const int t = e >> 7, c = (e & 127) * 8; const size_t o = (size_t)t * 1024 + c; const int tl = t & Lmask;
    const u32x4 zz = {0u, 0u, 0u, 0u};
    const u32x4 hc = *(const u32x4*)(H + o);
    const u32x4 hp = tl != 0 ? *(const u32x4*)(H + o - 1024) : zz, hn = tl != Lmask ? *(const u32x4*)(H + o + 1024) : zz;
    float hv[8], xv[8];
#pragma unroll
    for (int i = 0; i < 4; ++i) { hv[2 * i] = bflo(hc[i]); hv[2 * i + 1] = bfhi(hc[i]);
      xv[2 * i] = 0.5f * (bflo(hp[i]) + bflo(hn[i])) - hv[2 * i]; xv[2 * i + 1] = 0.5f * (bfhi(hp[i]) + bfhi(hn[i])) - hv[2 * i + 1]; }
#pragma unroll
    for (int m = 0; m < 4; ++m) {
      const float4 m0 = *(const float4*)(mu + m * 1024 + c), m1 = *(const float4*)(mu + m * 1024 + c + 4);
      u32x4 w; w[0] = pack2(hv[0] + xv[0] * m0.x, hv[1] + xv[1] * m0.y); w[1] = pack2(hv[2] + xv[2] * m0.z, hv[3] + xv[3] * m0.w);
      w[2] = pack2(hv[4] + xv[4] * m1.x, hv[5] + xv[5] * m1.y); w[3] = pack2(hv[6] + xv[6] * m1.z, hv[7] + xv[7] * m1.w);
      *(u32x4*)(XS + (size_t)m * SLOT_ELEMS + o) = w;
    }
  }
}

DI void phase_cache_copy(const P& p) {
  bf16_t* Kb = (bf16_t*)(p.ws + WS_SLOT) + 4 * SLOT_ELEMS; bf16_t* Vt = Kb + SLOT_ELEMS / 2;
  for (int e = blockIdx.x * NT + otid(); e < 262144; e += gridDim.x * NT) {
    const int c = e & 255, pp = (e >> 8) & 255, b = e >> 16; const int kvh = c >> 6, d = c & 63;
    Kb[((size_t)b * 4352 + 4096 + pp) * 256 + c] = (bf16_t)f2bf(p.in[3][e]);
    Vt[((size_t)(b * 4 + kvh) * 64 + d) * 4352 + 4096 + pp] = (bf16_t)f2bf(p.in[4][e]);
  }
}

template <int SHIFT> DI void ld_half(const bf16_t* __restrict__ A, int t, int k, int Lmask, u32x4 (&raw)[4]) {
  raw[1] = *(const u32x4*)(A + (size_t)t * 1024 + k);
  raw[2] = *(const u32x4*)(A + (size_t)(t + 1) * 1024 + k);
  if (SHIFT) {
    raw[0] = (u32x4){0u, 0u, 0u, 0u}; raw[3] = (u32x4){0u, 0u, 0u, 0u};
    if ((t & Lmask) != 0) raw[0] = *(const u32x4*)(A + (size_t)(t - 1) * 1024 + k);
    if (((t + 1) & Lmask) != Lmask) raw[3] = *(const u32x4*)(A + (size_t)(t + 2) * 1024 + k);
  }
}
DI u32x4 mix3(const u32x4& c, const u32x4& pz, const u32x4& nz, const float* smu, int k) {
  const float4 m0 = *(const float4*)(smu + k), m1 = *(const float4*)(smu + k + 4);
  const float mu[8] = {m0.x, m0.y, m0.z, m0.w, m1.x, m1.y, m1.z, m1.w};
  u32x4 o;
#pragma unroll
  for (int i = 0; i < 4; ++i) {
    const float h0 = bflo(c[i]), h1 = bfhi(c[i]);
    const float x0 = h0 + (0.5f * (bflo(pz[i]) + bflo(nz[i])) - h0) * mu[2 * i];
    const float x1 = h1 + (0.5f * (bfhi(pz[i]) + bfhi(nz[i])) - h1) * mu[2 * i + 1];
    o[i] = pack2(x0, x1);
  }
  return o;
}
DI int swz(int row, int c) { return row * 128 + ((c ^ ((row >> 1) & 7)) << 4); }
template <int SHIFT> DI void st_half(unsigned char* base, int row, int c, const u32x4 (&raw)[4], const float* smu, int k) {
  if (!SHIFT) { *(u32x4*)(base + swz(row, c)) = raw[1]; *(u32x4*)(base + swz(row + 1, c)) = raw[2]; }
  else { *(u32x4*)(base + swz(row, c)) = mix3(raw[1], raw[0], raw[2], smu, k); *(u32x4*)(base + swz(row + 1, c)) = mix3(raw[2], raw[1], raw[3], smu, k); }
}

template <int SHIFT, int EPI>
DI void phase_gemm(const P& p, int g, const bf16_t* __restrict__ A, const bf16_t* __restrict__ Bt, int M, int N,
                   const float* __restrict__ mu, int Lmask, bf16_t* __restrict__ dst, int rw, unsigned char* lds, int nt0 = 0) {
  const int tid = otid(), lane = tid & 63, wave = tid >> 6;
  const int wm = wave >> 1, wn = wave & 1, r = lane & 31, h = lane >> 5;
  const int ntn = N >> 7, ntiles = ntn * (M >> 8);
  float* Cs = (float*)lds;
  float* smu = (float*)(lds + 110592);
  for (int tile = blockIdx.x; tile < ntiles; tile += gridDim.x) {
    const int mt = tile / ntn, nt = tile - mt * ntn; const int m0 = mt * 256, n0 = nt * 128;
    f32x16 acc[2][2];
#pragma unroll
    for (int a = 0; a < 2; ++a)
#pragma unroll
      for (int b = 0; b < 2; ++b)
#pragma unroll
        for (int i = 0; i < 16; ++i) acc[a][b][i] = 0.f;
    if (SHIFT) {
      const int ntm = nt + nt0; const float* mup = mu + (ntm < 32 ? (ntm >> 3) : (ntm == 32 ? 4 : 5)) * 1024;
      smu[tid] = mup[tid]; smu[tid + 512] = mup[tid + 512];
      __syncthreads();
    }
    if (!SHIFT) {
      u32x4 s0[6], s1[6];
      const int lrow = tid >> 3, lkc = (tid & 7) * 8;
#define G_LOAD(S, K0)  { _Pragma("unroll") for (int i = 0; i < 4; ++i) S[i] = *(const u32x4*)(A + (size_t)(m0 + lrow + 64 * i) * 1024 + (K0) + lkc); \
                         _Pragma("unroll") for (int i = 0; i < 2; ++i) S[4 + i] = *(const u32x4*)(Bt + (size_t)(n0 + lrow + 64 * i) * 1024 + (K0) + lkc); }
#define G_STORE(S, BUF) { _Pragma("unroll") for (int i = 0; i < 4; ++i) *(u32x4*)((BUF) + swz(lrow + 64 * i, tid & 7)) = S[i]; \
                          _Pragma("unroll") for (int i = 0; i < 2; ++i) *(u32x4*)((BUF) + 32768 + swz(lrow + 64 * i, tid & 7)) = S[4 + i]; }
#define G_COMPUTE(BUF) { _Pragma("unroll") for (int ks = 0; ks < 4; ++ks) { const int kc_ = ks * 2 + h; \
        const bf16x8 a0 = *(const bf16x8*)((BUF) + swz(wm * 64 + r, kc_)); const bf16x8 a1 = *(const bf16x8*)((BUF) + swz(wm * 64 + 32 + r, kc_)); \
        const bf16x8 b0 = *(const bf16x8*)((BUF) + 32768 + swz(wn * 64 + r, kc_)); const bf16x8 b1 = *(const bf16x8*)((BUF) + 32768 + swz(wn * 64 + 32 + r, kc_)); \
        acc[0][0] = MFMA32(a0, b0, acc[0][0]); acc[0][1] = MFMA32(a0, b1, acc[0][1]); acc[1][0] = MFMA32(a1, b0, acc[1][0]); acc[1][1] = MFMA32(a1, b1, acc[1][1]); } }
      G_LOAD(s0, 0) G_STORE(s0, lds)
      G_LOAD(s0, 64) G_LOAD(s1, 128)
      __syncthreads();
      for (int kt = 0; kt < 16; kt += 2) {
        G_COMPUTE(lds)
        G_STORE(s0, lds + 49152)
        if (kt + 3 < 16) G_LOAD(s0, (kt + 3) * 64)
        __syncthreads();
        G_COMPUTE(lds + 49152)
        if (kt + 2 < 16) G_STORE(s1, lds)
        if (kt + 4 < 16) G_LOAD(s1, (kt + 4) * 64)
        __syncthreads();
      }
#undef G_LOAD
#undef G_STORE
#undef G_COMPUTE
    } else {
    u32x4 raw[4], raw2[4], rb[2];
    const int arow = 4 * (tid >> 3), akc = (tid & 7) * 8;
#pragma unroll
    for (int hf = 0; hf < 2; ++hf) { ld_half<SHIFT>(A, m0 + arow + 2 * hf, akc, Lmask, raw); st_half<SHIFT>(lds, arow + 2 * hf, tid & 7, raw, smu, akc); }
#pragma unroll
    for (int i = 0; i < 2; ++i) { const int id = tid + 512 * i; rb[i] = *(const u32x4*)(Bt + (size_t)(n0 + (id >> 3)) * 1024 + (id & 7) * 8); }
#pragma unroll
    for (int i = 0; i < 2; ++i) { const int id = tid + 512 * i; *(u32x4*)(lds + 32768 + swz(id >> 3, id & 7)) = rb[i]; }
    __syncthreads();
    for (int kt = 0; kt < 16; ++kt) {
      unsigned char* cur = lds + (kt & 1) * 49152; unsigned char* nxt = lds + ((kt + 1) & 1) * 49152;
      const int k1 = (kt + 1) * 64;
      if (kt < 15) {
        ld_half<SHIFT>(A, m0 + arow, k1 + akc, Lmask, raw);
        ld_half<SHIFT>(A, m0 + arow + 2, k1 + akc, Lmask, raw2);
#pragma unroll
        for (int i = 0; i < 2; ++i) { const int id = tid + 512 * i; rb[i] = *(const u32x4*)(Bt + (size_t)(n0 + (id >> 3)) * 1024 + k1 + (id & 7) * 8); }
      }
#pragma unroll
      for (int ks = 0; ks < 4; ++ks) {
        const int kc_ = ks * 2 + h;
        const bf16x8 a0 = *(const bf16x8*)(cur + swz(wm * 64 + r, kc_));
        const bf16x8 a1 = *(const bf16x8*)(cur + swz(wm * 64 + 32 + r, kc_));
        const bf16x8 b0 = *(const bf16x8*)(cur + 32768 + swz(wn * 64 + r, kc_));
        const bf16x8 b1 = *(const bf16x8*)(cur + 32768 + swz(wn * 64 + 32 + r, kc_));
        acc[0][0] = MFMA32(a0, b0, acc[0][0]); acc[0][1] = MFMA32(a0, b1, acc[0][1]);
        acc[1][0] = MFMA32(a1, b0, acc[1][0]); acc[1][1] = MFMA32(a1, b1, acc[1][1]);
      }
      if (kt < 15) {
        st_half<SHIFT>(nxt, arow, tid & 7, raw, smu, k1 + akc);
        st_half<SHIFT>(nxt, arow + 2, tid & 7, raw2, smu, k1 + akc);
#pragma unroll
        for (int i = 0; i < 2; ++i) { const int id = tid + 512 * i; *(u32x4*)(nxt + 32768 + swz(id >> 3, id & 7)) = rb[i]; }
      }
      __syncthreads();
    }
    }
#pragma unroll
    for (int mi = 0; mi < 2; ++mi)
#pragma unroll
      for (int ni = 0; ni < 2; ++ni)
#pragma unroll
        for (int i = 0; i < 16; ++i) {
          const int row = wm * 64 + mi * 32 + (i & 3) + 8 * (i >> 2) + 4 * h, col = wn * 64 + ni * 32 + r;
          Cs[row * 132 + col] = acc[mi][ni][i];
        }
    __syncthreads();
    if (EPI == 0) {
#pragma unroll
      for (int i = 0; i < 8; ++i) {
        const int id = tid + 512 * i, row = id >> 4, cc = (id & 15) * 8;
        float4 v0 = *(const float4*)(Cs + row * 132 + cc), v1 = *(const float4*)(Cs + row * 132 + cc + 4);
        if (rw && nt + nt0 == 32) { v0.x = tanhf(v0.x); v0.y = tanhf(v0.y); v0.z = tanhf(v0.z); v0.w = tanhf(v0.w); v1.x = tanhf(v1.x); v1.y = tanhf(v1.y); v1.z = tanhf(v1.z); v1.w = tanhf(v1.w); }
        u32x4 o; o[0] = pack2(v0.x, v0.y); o[1] = pack2(v0.z, v0.w); o[2] = pack2(v1.x, v1.y); o[3] = pack2(v1.z, v1.w);
        if (rw && nt + nt0 >= 32) *(u32x4*)((bf16_t*)(p.ws + WS_HID) + (size_t)(m0 + row) * 256 + (nt + nt0 - 32) * 128 + cc) = o;
        else *(u32x4*)(dst + (size_t)(nt >> 3) * SLOT_ELEMS + (size_t)(m0 + row) * 1024 + (nt & 7) * 128 + cc) = o;
      }
    } else {
      const int row = tid & 255, hh = tid >> 8; const int t = m0 + row;
      float x[64];
#pragma unroll
      for (int q = 0; q < 16; ++q) { const float4 v = *(const float4*)(Cs + row * 132 + hh * 64 + 4 * q); x[4 * q] = v.x; x[4 * q + 1] = v.y; x[4 * q + 2] = v.z; x[4 * q + 3] = v.w; }
      bf16_t* slots = (bf16_t*)(p.ws + WS_SLOT);
      const int L = g ? 4096 : 256, Ltot = g ? 4352 : 256;
      const int b = g ? (t >> 12) : (t >> 8), s = t & (L - 1);
      if (nt < 10) {
        int vz = 0; asm volatile("" : "+v"(vz));
        const float* nw = (nt < 8 ? p.in[26] : p.in[27]) + vz;
        float ss = 0.f;
#pragma unroll
        for (int d = 0; d < 64; ++d) ss += x[d] * x[d];
        const float rs = rsqrtf(ss * (1.f / 64.f) + 1e-6f);
#pragma unroll
        for (int d = 0; d < 64; ++d) x[d] *= rs * nw[d];
        if (g == 0 && nt >= 8) {
          float* ck = p.out + OUT_CK + (size_t)t * 256 + ((nt - 8) * 2 + hh) * 64;
#pragma unroll
          for (int q = 0; q < 16; ++q) *(float4*)(ck + 4 * q) = make_float4(x[4 * q], x[4 * q + 1], x[4 * q + 2], x[4 * q + 3]);
        }
        if (g == 1) {
          const float2* rope = (const float2*)(p.ws + WS_ROPE);
          const int ri = s >> 6, ci = s & 63;
#pragma unroll
          for (int f = 0; f < 16; ++f) {
            const float2 cr = rope[ri * 16 + f]; const float x1 = x[f], x2 = x[16 + f];
            x[f] = x1 * cr.x - x2 * cr.y; x[16 + f] = x2 * cr.x + x1 * cr.y;
            const float2 cc = rope[ci * 16 + f]; const float y1 = x[32 + f], y2 = x[48 + f];
            x[32 + f] = y1 * cc.x - y2 * cc.y; x[48 + f] = y2 * cc.x + y1 * cc.y;
          }
        }
        bf16_t* dq = nt < 8 ? slots + 2 * SLOT_ELEMS + (size_t)t * 1024 + (nt * 2 + hh) * 64
                            : slots + 4 * SLOT_ELEMS + ((size_t)b * Ltot + s) * 256 + ((nt - 8) * 2 + hh) * 64;
#pragma unroll
        for (int q = 0; q < 8; ++q) { u32x4 o; o[0] = pack2(x[8 * q], x[8 * q + 1]); o[1] = pack2(x[8 * q + 2], x[8 * q + 3]); o[2] = pack2(x[8 * q + 4], x[8 * q + 5]); o[3] = pack2(x[8 * q + 6], x[8 * q + 7]); *(u32x4*)(dq + 8 * q) = o; }
      } else if (nt < 12) {
        const int kvh = (nt - 10) * 2 + hh;
        if (g == 0) {
          float* cv = p.out + OUT_CV + (size_t)t * 256 + kvh * 64;
#pragma unroll
          for (int q = 0; q < 16; ++q) *(float4*)(cv + 4 * q) = make_float4(x[4 * q], x[4 * q + 1], x[4 * q + 2], x[4 * q + 3]);
        }
        bf16_t* vt = slots + 4 * SLOT_ELEMS + SLOT_ELEMS / 2 + ((size_t)(b * 4 + kvh) * 64) * Ltot + s;
        { size_t vo = 0;
#pragma unroll
        for (int d = 0; d < 64; ++d) { vt[vo] = (bf16_t)f2bf(x[d]); vo += Ltot; asm volatile("" : "+v"(vo)); } }
      } else {
        bf16_t* dg = slots + 3 * SLOT_ELEMS + (size_t)t * 1024 + (nt - 12) * 128 + hh * 64;
#pragma unroll
        for (int q = 0; q < 8; ++q) { u32x4 o; o[0] = pack2(x[8 * q], x[8 * q + 1]); o[1] = pack2(x[8 * q + 2], x[8 * q + 3]); o[2] = pack2(x[8 * q + 4], x[8 * q + 5]); o[3] = pack2(x[8 * q + 6], x[8 * q + 7]); *(u32x4*)(dg + 8 * q) = o; }
      }
    }
    __syncthreads();
  }
}

DI u32x4 cat8(const u32x2 lo, const u32x2 hi) { u32x4 v; v[0] = lo[0]; v[1] = lo[1]; v[2] = hi[0]; v[3] = hi[1]; return v; }
DI void phase_scan(const P& p, int g, int jl, unsigned char* lds) {
  const int tid = otid(), lane = tid & 63, wave = tid >> 6, r = lane & 31, h = lane >> 5;
  const int L = g ? 4096 : 256, B = g ? 4 : 32, nsc = L >> 5;
  float* sR = (float*)lds; float* sW = sR + 2048; float* sKD = sW + 2048; float* sKK = sKD + 2048; float* sKKA = sKK + 2048;
  bf16_t* sHW = (bf16_t*)(lds + 40960); bf16_t* sHA = (bf16_t*)(lds + 45568);
  bf16_t* oAL = (bf16_t*)(lds + 50176); bf16_t* oRH = (bf16_t*)(lds + 54784); bf16_t* oBE = (bf16_t*)(lds + 59392); bf16_t* oGA = (bf16_t*)(lds + 64000);
  bf16_t* oBEt = (bf16_t*)(lds + 68608); bf16_t* oGAt = (bf16_t*)(lds + 73728); bf16_t* oUt = (bf16_t*)(lds + 78848); bf16_t* oZt = (bf16_t*)(lds + 83968);
  float* Bm = (float*)(lds + 89088); float* RHS = (float*)(lds + 93696); float* lamC = (float*)(lds + 101888); float* sP = (float*)(lds + 102144);
  unsigned char* frag = lds + 104192;
  const bf16_t* slots = (const bf16_t*)(p.ws + WS_SLOT);
  const bf16_t* Rg = slots + 1 * SLOT_ELEMS; const bf16_t* Kg = slots + 2 * SLOT_ELEMS; const bf16_t* Vg = slots + 3 * SLOT_ELEMS;
  const bf16_t* hid = (const bf16_t*)(p.ws + WS_HID);
  float* bon = (float*)(p.ws + WS_BON);
  const int ntasks = B * 32;
  for (int task = blockIdx.x; task < ntasks; task += gridDim.x) {
    const int z = task & 1, head = (task >> 1) & 15, b = task >> 5;
    bf16_t* Yg = (bf16_t*)(p.ws + WS_SLOT) + (z ? 0 : 5) * SLOT_ELEMS;
    const int mat = (wave >> 1) & 1, ntt = wave & 1;
    unsigned char* lfr = lds + 110336 + (wave & 3) * 4096;
    if (wave >= 4) {
      const float* W2 = (mat ? p.in[18] : p.in[15]) + (size_t)(jl * 2 + z) * 65536 + head * 64 + 32 * ntt + r;
#pragma unroll
      for (int kk = 0; kk < 4; ++kk) { u32x4 pk;
#pragma unroll
        for (int j = 0; j < 4; ++j) pk[j] = pack2(W2[(size_t)(16 * kk + 8 * h + 2 * j) * 1024], W2[(size_t)(16 * kk + 8 * h + 2 * j + 1) * 1024]);
        *(u32x4*)(lfr + (kk * 64 + lane) * 16) = pk; }
    }
    const float bias = (mat ? p.in[16] : p.in[13])[(jl * 2 + z) * 1024 + head * 64 + 32 * ntt + r];
    const float kkc = p.in[19][jl * 1024 + head * 64 + lane], kac = p.in[20][jl * 1024 + head * 64 + lane], rkc = p.in[21][jl * 1024 + head * 64 + lane];
    f32x16 st0, st1;
#pragma unroll
    for (int q = 0; q < 16; ++q) { st0[q] = 0.f; st1[q] = 0.f; }
    const size_t stbase = ((((size_t)(b * 2 + jl) * 2 + z) * 16 + head) * 64 + (32 * (wave & 1) + r)) * 64;
    if (g && wave < 2) {
#pragma unroll
      for (int gq = 0; gq < 4; ++gq) {
        const float4 s0 = *(const float4*)(p.in[2] + stbase + 8 * gq + 4 * h), s1 = *(const float4*)(p.in[2] + stbase + 32 + 8 * gq + 4 * h);
        st0[4 * gq] = s0.x; st0[4 * gq + 1] = s0.y; st0[4 * gq + 2] = s0.z; st0[4 * gq + 3] = s0.w;
        st1[4 * gq] = s1.x; st1[4 * gq + 1] = s1.y; st1[4 * gq + 2] = s1.z; st1[4 * gq + 3] = s1.w;
      }
    }
    u32x4 pre[5];
    const int ht = tid - 256;
#define SCAN_LOAD(sc_)                                                                                    \
    { const int ht2 = otid() - 256;                                                                       \
    _Pragma("unroll") for (int i = 0; i < 5; ++i) {                                                       \
      const int id = ht2 + 256 * i;                                                                       \
      const int arr = id >> 8, s = (id >> 3) & 31, cc = (id & 7) * 8;                                     \
      const int tl = z ? (L - 1 - ((sc_) * 32 + s)) : ((sc_) * 32 + s);                                   \
      const size_t tok = (size_t)b * L + tl;                                                              \
      if (arr < 3) pre[i] = *(const u32x4*)((arr == 0 ? Rg : (arr == 1 ? Kg : Vg)) + tok * 1024 + head * 64 + cc); \
      else pre[i] = *(const u32x4*)(hid + tok * 256 + (arr - 3) * 128 + z * 64 + cc);                     \
    } }
#define NQ(t_) ((((t_) + 3) / 4 + 1) / 2)
#define SOLVE_ROWS(T0, T1)                                                                                \
    _Pragma("unroll") for (int t = (T0); t < (T1); ++t) {                                                 \
      if (t + 2 < 32) {                                                                                   \
        n2rhs = RHo[(t + 2) * 64];                                                                        \
        _Pragma("unroll") for (int q = 0; q < NQ(t + 2); ++q) { const f4v q4 = *(const __attribute__((address_space(3))) f4v*)(Bmo + (t + 2) * 36 + 8 * q); nc8[q] = make_float4(q4[0], q4[1], q4[2], q4[3]); } \
      }                                                                                                   \
      float a0s = crhs * mh, a1s = 0.f;                                                                   \
      _Pragma("unroll") for (int q = 0; q < NQ(t); ++q) {                                                 \
        a0s -= cb[q].x * zv[4 * q]; a1s -= cb[q].y * zv[4 * q + 1]; a0s -= cb[q].z * zv[4 * q + 2]; a1s -= cb[q].w * zv[4 * q + 3]; } \
      float zt = xhalf_sum(a0s + a1s);                                                                    \
      asm volatile("" : "+v"(zt) :: "memory");                                                            \
      zv[4 * (t >> 3) + (t & 3)] = ((((t >> 2) & 1) == h)) ? zt : zv[4 * (t >> 3) + (t & 3)];             \
      crhs = nrhs; nrhs = n2rhs;                                                                          \
      _Pragma("unroll") for (int q = 0; q < 4; ++q) { cb[q] = nb8[q]; nb8[q] = nc8[q]; }                  \
    }
    typedef float f4v __attribute__((ext_vector_type(4)));
    if (wave >= 4) { SCAN_LOAD(0) }
    for (int sc = -1; sc < nsc; ++sc) {
      const bool st_on = sc >= 0, hl_on = sc + 1 < nsc;
      bf16_t* oUc = (bf16_t*)(lds + ((sc & 1) ? 126720 : 78848));
      bf16_t* oUn = (bf16_t*)(lds + ((sc & 1) ? 78848 : 126720));
      f32x16 y0;
      const int vloc = 32 * (wave & 1) + r;
      if (st_on) {
      {
        const int k = lane, tq = wave;
        float wq[4];
#pragma unroll
        for (int j = 0; j < 4; ++j) wq[j] = sW[(4 * tq + j) * 64 + k];
        sP[tq * 64 + k] = (wq[0] * wq[1]) * (wq[2] * wq[3]);
        __syncthreads();
        float lam = 1.f;
#pragma unroll
        for (int q = 0; q < 7; ++q) { const float pq = sP[q * 64 + k]; lam *= (q < tq) ? pq : 1.f; }
        u32x2 bt, gt; float nb[4], gg[4];
#pragma unroll
        for (int j = 0; j < 4; ++j) {
          const int t = 4 * tq + j;
          const float lamp = lam; lam = lamp * wq[j];
          const float inv = __builtin_amdgcn_rcpf(lam);
          const float al = lamp * sKK[t * 64 + k], be = sKKA[t * 64 + k] * inv, ga = sKD[t * 64 + k] * inv, rh = lam * sR[t * 64 + k];
          oAL[t * 72 + k] = (bf16_t)f2bf(al); oRH[t * 72 + k] = (bf16_t)f2bf(rh); oBE[t * 72 + k] = (bf16_t)f2bf(be); oGA[t * 72 + k] = (bf16_t)f2bf(ga);
          nb[j] = -be; gg[j] = ga;
        }
        bt[0] = pack2(nb[0], nb[1]); bt[1] = pack2(nb[2], nb[3]); gt[0] = pack2(gg[0], gg[1]); gt[1] = pack2(gg[2], gg[3]);
        *(u32x2*)(oBEt + k * 40 + 4 * tq) = bt; *(u32x2*)(oGAt + k * 40 + 4 * tq) = gt;
        if (tq == 7) lamC[k] = lam;
      }
      __syncthreads();
      {
      const int tid = otid(), lane = tid & 63, wave = tid >> 6, r = lane & 31, h = lane >> 5; (void)r; (void)h; (void)lane; (void)wave;
      if (wave < 4) {
        const bf16_t* As = (wave & 1) ? oGA : oBE; const bf16_t* Bs = (wave < 2) ? oAL : oRH;
        f32x16 x;
#pragma unroll
        for (int q = 0; q < 16; ++q) x[q] = 0.f;
#pragma unroll
        for (int s = 0; s < 4; ++s) { const bf16x8 a = *(const bf16x8*)(As + r * 72 + 16 * s + 8 * h); const bf16x8 bb = *(const bf16x8*)(Bs + r * 72 + 16 * s + 8 * h); x = MFMA32(a, bb, x); }
#pragma unroll
        for (int q = 0; q < 16; ++q) { const int i = (q & 3) + 8 * (q >> 2) + 4 * h; const bool keep = (wave < 2) ? (i < r) : (i <= r); x[q] = keep ? x[q] : 0.f; }
        if (wave == 0) {
#pragma unroll
          for (int gq = 0; gq < 4; ++gq) *(float4*)(Bm + r * 36 + 8 * gq + 4 * h) = make_float4(x[4 * gq], x[4 * gq + 1], x[4 * gq + 2], x[4 * gq + 3]);
        } else {
          const float sg = (wave == 2) ? -1.f : 1.f;
#pragma unroll
          for (int s = 0; s < 2; ++s) { u32x4 pk;
#pragma unroll
            for (int j = 0; j < 4; ++j) pk[j] = pack2(sg * x[8 * s + 2 * j], sg * x[8 * s + 2 * j + 1]);
            *(u32x4*)(frag + (((wave - 1) * 2 + s) * 64 + lane) * 16) = pk; }
        }
      }
      }
      __syncthreads();
      if (wave < 2) {
        f32x16 a0;
#pragma unroll
        for (int q = 0; q < 16; ++q) a0[q] = 0.f;
#pragma unroll
        for (int kb = 0; kb < 2; ++kb)
#pragma unroll
          for (int s = 0; s < 2; ++s) {
            u32x4 pk;
#pragma unroll
            for (int j = 0; j < 4; ++j) pk[j] = kb ? pack2(st1[8 * s + 2 * j], st1[8 * s + 2 * j + 1]) : pack2(st0[8 * s + 2 * j], st0[8 * s + 2 * j + 1]);
            const bf16x8 sf = __builtin_bit_cast(bf16x8, pk);
            const int ko = 32 * kb + 16 * s + 4 * h;
            const u32x4 aa = cat8(*(const u32x2*)(oAL + r * 72 + ko), *(const u32x2*)(oAL + r * 72 + ko + 8));
            a0 = MFMA32(__builtin_bit_cast(bf16x8, aa), sf, a0);
          }
#pragma unroll
        for (int s = 0; s < 2; ++s) {
          const bf16x8 fg = *(const bf16x8*)(frag + ((0 * 2 + s) * 64 + lane) * 16);
          const u32x4 ub = cat8(*(const u32x2*)(oUc + vloc * 40 + 16 * s + 4 * h), *(const u32x2*)(oUc + vloc * 40 + 16 * s + 4 * h + 8));
          a0 = MFMA32(fg, __builtin_bit_cast(bf16x8, ub), a0);
        }
#pragma unroll
        for (int q = 0; q < 16; ++q) RHS[((q & 3) + 8 * (q >> 2) + 4 * h) * 64 + vloc] = a0[q];
        float* park = (float*)(lds + 131840) + wave * 3072 + lane * 4;
#pragma unroll
        for (int gq = 0; gq < 4; ++gq) {
          *(float4*)(park + gq * 256) = make_float4(st0[4 * gq], st0[4 * gq + 1], st0[4 * gq + 2], st0[4 * gq + 3]);
          *(float4*)(park + 1024 + gq * 256) = make_float4(st1[4 * gq], st1[4 * gq + 1], st1[4 * gq + 2], st1[4 * gq + 3]);
        }
      }
      }
      float zv[16]; float4 cb[4], nb8[4], nc8[4]; float crhs = 0.f, nrhs = 0.f, n2rhs = 0.f;
      const float mh = h ? 0.f : 1.f;
#pragma unroll
      for (int t = 0; t < 16; ++t) zv[t] = 0.f;
#pragma unroll
      for (int q = 0; q < 4; ++q) { cb[q] = make_float4(0.f, 0.f, 0.f, 0.f); nb8[q] = make_float4(0.f, 0.f, 0.f, 0.f); nc8[q] = make_float4(0.f, 0.f, 0.f, 0.f); }
      const __attribute__((address_space(3))) float* Bmo = (const __attribute__((address_space(3))) float*)(unsigned)(unsigned long long)(Bm + 4 * h);
      const __attribute__((address_space(3))) float* RHo = (const __attribute__((address_space(3))) float*)(unsigned)(unsigned long long)(RHS + vloc);
      asm volatile("" : "+v"(Bmo), "+v"(RHo));
      if (wave < 2 && st_on) { crhs = RHo[0]; nrhs = RHo[64]; const f4v q4 = *(const __attribute__((address_space(3))) f4v*)(Bmo + 36); nb8[0] = make_float4(q4[0], q4[1], q4[2], q4[3]); }
      if (wave < 2) { if (st_on) { SOLVE_ROWS(0, 6) } }
      else if (wave >= 4 && hl_on) {
#pragma unroll
        for (int i = 0; i < 5; ++i) {
          const int id = ht + 256 * i; const int arr = id >> 8, s = (id >> 3) & 31, cc = (id & 7) * 8;
          const u32x4 u = pre[i];
          if (arr < 2) { float* d = (arr == 0 ? sR : sKD) + s * 64 + cc;
            *(float4*)d = make_float4(bflo(u[0]), bfhi(u[0]), bflo(u[1]), bfhi(u[1])); *(float4*)(d + 4) = make_float4(bflo(u[2]), bfhi(u[2]), bflo(u[3]), bfhi(u[3])); }
          else if (arr == 2) {
#pragma unroll
            for (int j = 0; j < 4; ++j) { oUn[(cc + 2 * j) * 40 + s] = (bf16_t)(u[j] & 0xffffu); oUn[(cc + 2 * j + 1) * 40 + s] = (bf16_t)(u[j] >> 16); }
          } else *(u32x4*)((arr == 3 ? sHW : sHA) + s * 72 + cc) = u;
        }
        if (sc + 2 < nsc) { SCAN_LOAD(sc + 2) }
      }
      __syncthreads();
      if (wave < 2) { if (st_on) { SOLVE_ROWS(6, 24) } }
      else if (wave < 4) { if (st_on) {
        const float* park = (const float*)(lds + 131840) + (wave - 2) * 3072 + lane * 4;
#pragma unroll
        for (int gq = 0; gq < 4; ++gq) {
          const float4 a = *(const float4*)(park + gq * 256), bq = *(const float4*)(park + 1024 + gq * 256);
          st0[4 * gq] = a.x; st0[4 * gq + 1] = a.y; st0[4 * gq + 2] = a.z; st0[4 * gq + 3] = a.w;
          st1[4 * gq] = bq.x; st1[4 * gq + 1] = bq.y; st1[4 * gq + 2] = bq.z; st1[4 * gq + 3] = bq.w;
        }
#pragma unroll
        for (int q = 0; q < 16; ++q) y0[q] = 0.f;
#pragma unroll
        for (int kb = 0; kb < 2; ++kb)
#pragma unroll
          for (int s = 0; s < 2; ++s) {
            u32x4 pk;
#pragma unroll
            for (int j = 0; j < 4; ++j) pk[j] = kb ? pack2(st1[8 * s + 2 * j], st1[8 * s + 2 * j + 1]) : pack2(st0[8 * s + 2 * j], st0[8 * s + 2 * j + 1]);
            const int ko = 32 * kb + 16 * s + 4 * h;
            const u32x4 ar = cat8(*(const u32x2*)(oRH + r * 72 + ko), *(const u32x2*)(oRH + r * 72 + ko + 8));
            y0 = MFMA32(__builtin_bit_cast(bf16x8, ar), __builtin_bit_cast(bf16x8, pk), y0);
          }
#pragma unroll
        for (int s = 0; s < 2; ++s) {
          const bf16x8 fpg = *(const bf16x8*)(frag + ((2 * 2 + s) * 64 + lane) * 16);
          const u32x4 ub = cat8(*(const u32x2*)(oUc + vloc * 40 + 16 * s + 4 * h), *(const u32x2*)(oUc + vloc * 40 + 16 * s + 4 * h + 8));
          y0 = MFMA32(fpg, __builtin_bit_cast(bf16x8, ub), y0);
        }
      } }
      else if (wave >= 4 && hl_on) {
        f32x16 acc;
#pragma unroll
        for (int i = 0; i < 16; ++i) acc[i] = 0.f;
        const bf16_t* sH = mat ? sHA : sHW;
#pragma unroll
        for (int kk = 0; kk < 4; ++kk) { const bf16x8 a = *(const bf16x8*)(sH + r * 72 + 16 * kk + 8 * h); const bf16x8 bw = *(const bf16x8*)(lfr + (kk * 64 + lane) * 16); acc = MFMA32(a, bw, acc); }
#pragma unroll
        for (int i = 0; i < 16; ++i) {
          const int srow = (i & 3) + 8 * (i >> 2) + 4 * h, c = 32 * ntt + r;
          const float xv = acc[i] + bias;
          const float sg = __builtin_amdgcn_rcpf(1.f + __expf(-xv));
          if (mat == 0) sW[srow * 64 + c] = __expf(-0.60653065971263342f * sg);
          else sKKA[srow * 64 + c] = sg;
        }
      }
      __syncthreads();
      if (wave < 2) { if (st_on) {
        SOLVE_ROWS(24, 32)
#pragma unroll
        for (int q = 0; q < 4; ++q) { u32x2 o; o[0] = pack2(zv[4 * q], zv[4 * q + 1]); o[1] = pack2(zv[4 * q + 2], zv[4 * q + 3]);
          *(u32x2*)(oZt + vloc * 40 + 4 * (2 * q + h)) = o; }
        } }
      else if (wave >= 4 && hl_on) {
#pragma unroll
        for (int i = 0; i < 8; ++i) {
          const int s = (wave - 4) + 4 * i; const int c = lane;
          const float kraw = sKD[s * 64 + c], a = sKKA[s * 64 + c], rr = sR[s * 64 + c];
          const float pk = kraw * kkc; const float ss = wave_sum(pk * pk);
          const float kk = pk * rsqrtf(fmaxf(ss, 1e-24f));
          const float kd = kraw * (1.f + (a - 1.f) * kac);
          const float bs = wave_sum(rr * kd * rkc);
          sKD[s * 64 + c] = kd; sKK[s * 64 + c] = kk; sKKA[s * 64 + c] = kk * a;
          if (c == 0) { const int tl = z ? (L - 1 - ((sc + 1) * 32 + s)) : ((sc + 1) * 32 + s); bon[(((size_t)b * L + tl) * 16 + head) * 2 + z] = bs; }
        }
      }
      __syncthreads();
      if (st_on) {
      {
      const int tid = otid(), lane = tid & 63, wave = tid >> 6, r = lane & 31, h = lane >> 5; (void)r; (void)h; (void)lane; (void)wave;
      if (wave < 2) {
        { const float* park = (const float*)(lds + 131840) + wave * 3072 + lane * 4;
#pragma unroll
          for (int gq = 0; gq < 4; ++gq) {
            const float4 a = *(const float4*)(park + gq * 256), bq = *(const float4*)(park + 1024 + gq * 256);
            st0[4 * gq] = a.x; st0[4 * gq + 1] = a.y; st0[4 * gq + 2] = a.z; st0[4 * gq + 3] = a.w;
            st1[4 * gq] = bq.x; st1[4 * gq + 1] = bq.y; st1[4 * gq + 2] = bq.z; st1[4 * gq + 3] = bq.w;
          } }
#pragma unroll
        for (int s = 0; s < 2; ++s) {
          const bf16x8 ub = *(const bf16x8*)(oUc + vloc * 40 + 16 * s + 8 * h), zb = *(const bf16x8*)(oZt + vloc * 40 + 16 * s + 8 * h);
          const bf16x8 g0 = *(const bf16x8*)(oGAt + r * 40 + 16 * s + 8 * h), g1 = *(const bf16x8*)(oGAt + (32 + r) * 40 + 16 * s + 8 * h);
          const bf16x8 b0 = *(const bf16x8*)(oBEt + r * 40 + 16 * s + 8 * h), b1 = *(const bf16x8*)(oBEt + (32 + r) * 40 + 16 * s + 8 * h);
          st0 = MFMA32(g0, ub, st0); st0 = MFMA32(b0, zb, st0);
          st1 = MFMA32(g1, ub, st1); st1 = MFMA32(b1, zb, st1);
        }
#pragma unroll
        for (int gq = 0; gq < 4; ++gq) {
          const float4 l0 = *(const float4*)(lamC + 8 * gq + 4 * h), l1 = *(const float4*)(lamC + 32 + 8 * gq + 4 * h);
          st0[4 * gq] *= l0.x; st0[4 * gq + 1] *= l0.y; st0[4 * gq + 2] *= l0.z; st0[4 * gq + 3] *= l0.w;
          st1[4 * gq] *= l1.x; st1[4 * gq + 1] *= l1.y; st1[4 * gq + 2] *= l1.z; st1[4 * gq + 3] *= l1.w;
        }
      } else if (wave < 4) {
#pragma unroll
        for (int s = 0; s < 2; ++s) {
          const bf16x8 fpb = *(const bf16x8*)(frag + ((1 * 2 + s) * 64 + lane) * 16);
          const u32x4 z8 = cat8(*(const u32x2*)(oZt + vloc * 40 + 16 * s + 4 * h), *(const u32x2*)(oZt + vloc * 40 + 16 * s + 4 * h + 8));
          y0 = MFMA32(fpb, __builtin_bit_cast(bf16x8, z8), y0);
        }
#pragma unroll
        for (int q = 0; q < 16; ++q) {
          const int t = (q & 3) + 8 * (q >> 2) + 4 * h; const int tl = z ? (L - 1 - (sc * 32 + t)) : (sc * 32 + t);
          Yg[((size_t)b * L + tl) * 1024 + head * 64 + vloc] = (bf16_t)f2bf(y0[q]);
        }
      }
      }
      __syncthreads();
      }
    }
#undef SOLVE_ROWS
#undef SCAN_LOAD
    if (g == 0 && wave < 2) {
#pragma unroll
      for (int gq = 0; gq < 4; ++gq) {
        *(float4*)(p.out + OUT_ST + stbase + 8 * gq + 4 * h) = make_float4(st0[4 * gq], st0[4 * gq + 1], st0[4 * gq + 2], st0[4 * gq + 3]);
        *(float4*)(p.out + OUT_ST + stbase + 32 + 8 * gq + 4 * h) = make_float4(st1[4 * gq], st1[4 * gq + 1], st1[4 * gq + 2], st1[4 * gq + 3]);
      }
    }
    __syncthreads();
  }
}

DI void phase_rwkv_combine(const P& p, int g, int jl) {
  const int T = g ? 16384 : 8192;
  const int tid = otid(); const int lane = tid & 63, wave = tid >> 6;
  bf16_t* slots = (bf16_t*)(p.ws + WS_SLOT);
  const float* bon = (const float*)(p.ws + WS_BON);
  for (int t = blockIdx.x * 8 + wave; t < T; t += gridDim.x * 8) {
    const size_t o = (size_t)t * 1024 + 16 * lane; const int head = lane >> 2;
    float y[16], v[16], gg[16];
#pragma unroll
    for (int q = 0; q < 2; ++q) {
      const u32x4 a = *(const u32x4*)(slots + 5 * SLOT_ELEMS + o + 8 * q), bq = *(const u32x4*)(slots + 0 * SLOT_ELEMS + o + 8 * q);
      const u32x4 vq = *(const u32x4*)(slots + 3 * SLOT_ELEMS + o + 8 * q), gq = *(const u32x4*)(slots + 4 * SLOT_ELEMS + o + 8 * q);
#pragma unroll
      for (int i = 0; i < 4; ++i) { y[8 * q + 2 * i] = bflo(a[i]) + bflo(bq[i]); y[8 * q + 2 * i + 1] = bfhi(a[i]) + bfhi(bq[i]);
        v[8 * q + 2 * i] = bflo(vq[i]); v[8 * q + 2 * i + 1] = bfhi(vq[i]); gg[8 * q + 2 * i] = bflo(gq[i]); gg[8 * q + 2 * i + 1] = bfhi(gq[i]); }
    }
    float s = 0.f;
#pragma unroll
    for (int i = 0; i < 16; ++i) s += y[i];
    const float mean = quad_sum(s) * (1.f / 64.f);
    float vs = 0.f;
#pragma unroll
    for (int i = 0; i < 16; ++i) { const float d = y[i] - mean; vs += d * d; }
    const float rstd = rsqrtf(quad_sum(vs) * (1.f / 64.f) + 64e-5f);
    const float bs = bon[((size_t)t * 16 + head) * 2] + bon[((size_t)t * 16 + head) * 2 + 1];
    const float* gw = p.in[22] + jl * 1024 + 16 * lane; const float* gb = p.in[23] + jl * 1024 + 16 * lane;
    float ov[16];
#pragma unroll
    for (int i = 0; i < 16; ++i) ov[i] = ((y[i] - mean) * rstd * gw[i] + gb[i] + bs * v[i]) * silu(gg[i]);
#pragma unroll
    for (int q = 0; q < 2; ++q) { u32x4 w; w[0] = pack2(ov[8 * q], ov[8 * q + 1]); w[1] = pack2(ov[8 * q + 2], ov[8 * q + 3]); w[2] = pack2(ov[8 * q + 4], ov[8 * q + 5]); w[3] = pack2(ov[8 * q + 6], ov[8 * q + 7]);
      *(u32x4*)(slots + 4 * SLOT_ELEMS + o + 8 * q) = w; }
  }
}

DI void phase_conv(const P& p, int g) {
  const int T = g ? 16384 : 8192, Lmask = g ? 4095 : 255;
  bf16_t* slots = (bf16_t*)(p.ws + WS_SLOT);
  const bf16_t* BG = slots + 2 * SLOT_ELEMS; const bf16_t* CG = slots + 3 * SLOT_ELEMS; const bf16_t* U = slots + 4 * SLOT_ELEMS; const bf16_t* G = slots + 5 * SLOT_ELEMS;
  bf16_t* O = slots;
  for (int e = blockIdx.x * NT + otid(); e < T * 128; e += gridDim.x * NT) {
    const int t = e >> 7, c = (e & 127) * 8; const size_t o = (size_t)t * 1024 + c; const int tl = t & Lmask;
    const u32x4 zz = {0u, 0u, 0u, 0u};
    const u32x4 c1 = *(const u32x4*)(CG + o), u1 = *(const u32x4*)(U + o);
    const u32x4 c0 = tl != 0 ? *(const u32x4*)(CG + o - 1024) : zz, u0 = tl != 0 ? *(const u32x4*)(U + o - 1024) : zz;
    const u32x4 c2 = tl != Lmask ? *(const u32x4*)(CG + o + 1024) : zz, u2 = tl != Lmask ? *(const u32x4*)(U + o + 1024) : zz;
    const u32x4 bg = *(const u32x4*)(BG + o), gg = *(const u32x4*)(G + o);
    const float* cw = p.in[30]; const float* cb = p.in[31];
    u32x4 w;
#pragma unroll
    for (int i = 0; i < 4; ++i) {
      const int ch = c + 2 * i;
      const float lo = bflo(bg[i]) * (cw[ch] * bflo(c0[i]) * bflo(u0[i]) + cw[1024 + ch] * bflo(c1[i]) * bflo(u1[i]) + cw[2048 + ch] * bflo(c2[i]) * bflo(u2[i]) + cb[ch]) * silu(bflo(gg[i]));
      const float hi = bfhi(bg[i]) * (cw[ch + 1] * bfhi(c0[i]) * bfhi(u0[i]) + cw[1024 + ch + 1] * bfhi(c1[i]) * bfhi(u1[i]) + cw[2048 + ch + 1] * bfhi(c2[i]) * bfhi(u2[i]) + cb[ch + 1]) * silu(bfhi(gg[i]));
      w[i] = pack2(lo, hi);
    }
    *(u32x4*)(O + o) = w;
  }
}

DI void phase_attn(const P& p, int g, unsigned char* lds) {
  const int tid = otid(), lane = tid & 63, wave = tid >> 6, r = lane & 31, h = lane >> 5;
  const int L = g ? 4096 : 256, Ltot = g ? 4352 : 256, B = g ? 4 : 32;
  const int nq = L >> 6, ntasks = B * 4 * nq, nkt = Ltot >> 6;
  bf16_t* slots = (bf16_t*)(p.ws + WS_SLOT);
  bf16_t* Q = slots + 2 * SLOT_ELEMS; const bf16_t* G = slots + 3 * SLOT_ELEMS;
  const bf16_t* Kb = slots + 4 * SLOT_ELEMS; const bf16_t* Vt = Kb + SLOT_ELEMS / 2;
  const float SC = 0.125f * 1.4426950408889634f;
  for (int task = blockIdx.x; task < ntasks; task += gridDim.x) {
    const int qt = task % nq, kvh = (task / nq) & 3, b = task / (nq * 4);
    const int head = kvh * 4 + (wave >> 1); const int q0 = qt * 64 + (wave & 1) * 32;
    const size_t tok = (size_t)b * L + q0 + r;
    bf16x8 qf[4];
#pragma unroll
    for (int ds = 0; ds < 4; ++ds) qf[ds] = *(const bf16x8*)(Q + tok * 1024 + head * 64 + ds * 16 + h * 8);
    float m = -1e30f, lsum = 0.f;
    f32x16 O0, O1;
#pragma unroll
    for (int i = 0; i < 16; ++i) { O0[i] = 0.f; O1[i] = 0.f; }
    const int lrow = tid >> 3, lc = (tid & 7) * 8;
    const bf16_t* gK = Kb + ((size_t)b * Ltot + lrow) * 256 + kvh * 64 + lc;
    const bf16_t* gV = Vt + ((size_t)(b * 4 + kvh) * 64 + lrow) * Ltot + lc;
    u32x4 rk = *(const u32x4*)gK, rv = *(const u32x4*)gV;
    *(u32x4*)(lds + lrow * 144 + lc * 2) = rk; *(u32x4*)(lds + 9216 + lrow * 144 + lc * 2) = rv;
    __syncthreads();
    for (int kt = 0; kt < nkt; ++kt) {
      const unsigned char* cur = lds + (kt & 1) * 18432; unsigned char* nxt = lds + ((kt + 1) & 1) * 18432;
      if (kt + 1 < nkt) { rk = *(const u32x4*)(gK + (size_t)(kt + 1) * 64 * 256); rv = *(const u32x4*)(gV + (kt + 1) * 64); }
      f32x16 s0, s1;
#pragma unroll
      for (int i = 0; i < 16; ++i) { s0[i] = 0.f; s1[i] = 0.f; }
#pragma unroll
      for (int ds = 0; ds < 4; ++ds) {
        const bf16x8 a0 = *(const bf16x8*)(cur + r * 144 + (ds * 16 + h * 8) * 2);
        const bf16x8 a1 = *(const bf16x8*)(cur + (32 + r) * 144 + (ds * 16 + h * 8) * 2);
        s0 = MFMA32(a0, qf[ds], s0); s1 = MFMA32(a1, qf[ds], s1);
      }
      float tmax = s0[0];
#pragma unroll
      for (int i = 1; i < 16; ++i) tmax = fmaxf(tmax, s0[i]);
#pragma unroll
      for (int i = 0; i < 16; ++i) tmax = fmaxf(tmax, s1[i]);
      tmax = xhalf_max(tmax);
      const float mnew = fmaxf(m, tmax * SC);
      const float alpha = __builtin_amdgcn_exp2f(m - mnew);
      float ps = 0.f;
#pragma unroll
      for (int i = 0; i < 16; ++i) { s0[i] = __builtin_amdgcn_exp2f(s0[i] * SC - mnew); s1[i] = __builtin_amdgcn_exp2f(s1[i] * SC - mnew); ps += s0[i] + s1[i]; }
      lsum = lsum * alpha + ps; m = mnew;
      if (__builtin_amdgcn_ballot_w64(alpha != 1.f) != 0ull) {
#pragma unroll
        for (int i = 0; i < 16; ++i) { O0[i] *= alpha; O1[i] *= alpha; }
      }
      const unsigned char* vs = cur + 9216;
#pragma unroll
      for (int kb = 0; kb < 2; ++kb)
#pragma unroll
        for (int s = 0; s < 2; ++s) {
          u32x4 pk;
#pragma unroll
          for (int j = 0; j < 4; ++j) pk[j] = kb ? pack2(s1[8 * s + 2 * j], s1[8 * s + 2 * j + 1]) : pack2(s0[8 * s + 2 * j], s0[8 * s + 2 * j + 1]);
          const bf16x8 pf = __builtin_bit_cast(bf16x8, pk);
          const int ko = (32 * kb + 16 * s + 4 * h) * 2;
          { const u32x2 lo = *(const u32x2*)(vs + r * 144 + ko), hi = *(const u32x2*)(vs + r * 144 + ko + 16);
            u32x4 av; av[0] = lo[0]; av[1] = lo[1]; av[2] = hi[0]; av[3] = hi[1];
            O0 = MFMA32(__builtin_bit_cast(bf16x8, av), pf, O0); }
          { const u32x2 lo = *(const u32x2*)(vs + (32 + r) * 144 + ko), hi = *(const u32x2*)(vs + (32 + r) * 144 + ko + 16);
            u32x4 av; av[0] = lo[0]; av[1] = lo[1]; av[2] = hi[0]; av[3] = hi[1];
            O1 = MFMA32(__builtin_bit_cast(bf16x8, av), pf, O1); }
        }
      if (kt + 1 < nkt) { *(u32x4*)(nxt + lrow * 144 + lc * 2) = rk; *(u32x4*)(nxt + 9216 + lrow * 144 + lc * 2) = rv; }
      __syncthreads();
    }
    lsum = xhalf_sum(lsum);
    const float inv = 1.f / lsum;
#pragma unroll
    for (int db = 0; db < 2; ++db)
#pragma unroll
      for (int i4 = 0; i4 < 4; ++i4) {
        const size_t o = tok * 1024 + head * 64 + 32 * db + 8 * i4 + 4 * h;
        const u32x2 gq = *(const u32x2*)(G + o);
        const float v0 = (db ? O1[4 * i4] : O0[4 * i4]) * inv, v1 = (db ? O1[4 * i4 + 1] : O0[4 * i4 + 1]) * inv;
        const float v2 = (db ? O1[4 * i4 + 2] : O0[4 * i4 + 2]) * inv, v3 = (db ? O1[4 * i4 + 3] : O0[4 * i4 + 3]) * inv;
        u32x2 w; w[0] = pack2(v0 * silu(bflo(gq[0])), v1 * silu(bfhi(gq[0]))); w[1] = pack2(v2 * silu(bflo(gq[1])), v3 * silu(bfhi(gq[1])));
        *(u32x2*)(slots + 5 * SLOT_ELEMS + o) = w;
      }
  }
}


namespace pg8 {
#define PG8_LAS __attribute__((address_space(3)))
typedef unsigned short bf16_t;
typedef short bf16x8 __attribute__((ext_vector_type(8)));
typedef float f32x4 __attribute__((ext_vector_type(4)));
typedef unsigned u32x4 __attribute__((ext_vector_type(4)));
constexpr int BM = 256, BK = 64, HALF = 128, HTB = HALF * BK * 2  , STAGE_BYTES = 8 * HTB, NXCD = 8, WGM = 8;

__host__ __device__ __forceinline__ int lds_byte(int r, int c) { const int st = (r >> 4) * 2 + (c >> 5), rr = r & 15, cc = c & 31, ob = rr * 64 + cc * 2; return st * 1024 + (ob ^ (((ob >> 9) & 1) << 5)); }
__host__ __device__ __forceinline__ void stage_rc(int b, int& R, int& C) { const int st = b / 1024, sb = b % 1024, swz = sb ^ (((sb >> 9) & 1) << 5); R = (st >> 1) * 16 + swz / 64; C = (st & 1) * 32 + (swz % 64) / 2; }
__host__ __device__ __forceinline__ int perm32(int rho) { const int n = rho >> 4, i = rho & 15; return 8 * (i >> 2) + 4 * n + (i & 3); }

struct Unit { int pm, pn; };
struct Gemm { const bf16_t* A; const bf16_t* Bt; int M, N, K; };

struct StaticOrder {
    int nM, nN, nwg, G, c;
    __host__ __device__ void init(int M, int N, int G_, int c_) { nM = M / BM; nN = N / BM; nwg = nM * nN; G = G_; c = c_; }
    __host__ __device__ bool next(int i, Unit& u) const {
        const long L = (long)i * G + c; if (L >= nwg) return false;
        int wgid = (int)L; { const int q = nwg / NXCD, r = nwg % NXCD, xcd = wgid % NXCD, off = wgid / NXCD; wgid = (xcd < r ? xcd * (q + 1) : r * (q + 1) + (xcd - r) * q) + off; }
        const int nig = WGM * nN, gid = wgid / nig, fm = gid * WGM, gsz = (nM - fm) < WGM ? (nM - fm) : WGM;
        u.pm = fm + ((wgid % nig) % gsz); u.pn = (wgid % nig) / gsz; return true;
    }
    __device__ __forceinline__ void a_ready(const Unit&) const {}
    __device__ __forceinline__ void done(const Unit&) const {}
};
struct CountedOrder : StaticOrder {
    const unsigned* ready; unsigned need; unsigned* tmo;
    __device__ __forceinline__ void a_ready(const Unit& u) const {
        if (threadIdx.x < 64) {
            const unsigned long long t0 = __builtin_amdgcn_s_memrealtime(); unsigned polls = 0;
            while ((unsigned)__builtin_amdgcn_readfirstlane(__hip_atomic_load(ready + 64 * u.pm, __ATOMIC_RELAXED, __HIP_MEMORY_SCOPE_AGENT)) < need) {
                if ((++polls & 255u) == 0u && __builtin_amdgcn_readfirstlane(__hip_atomic_load(tmo, __ATOMIC_RELAXED, __HIP_MEMORY_SCOPE_AGENT)) != 0u) break;
                if (__builtin_amdgcn_s_memrealtime() - t0 > 2000000ull) {
                    if (threadIdx.x == 0) { unsigned expect = 0u; __hip_atomic_compare_exchange_strong(tmo + 1, &expect, 0x600u | (unsigned)(u.pm & 0xff), __ATOMIC_RELAXED, __ATOMIC_RELAXED, __HIP_MEMORY_SCOPE_AGENT); __hip_atomic_store(tmo, 1u, __ATOMIC_RELAXED, __HIP_MEMORY_SCOPE_AGENT); }
                    break; }
                __builtin_amdgcn_s_sleep(2); }
            __builtin_amdgcn_fence(__ATOMIC_ACQUIRE, "agent");
            asm volatile("s_waitcnt vmcnt(0)" ::: "memory");
        }
#if !defined(BROKEN_HOOK_NO_BARRIER)
        asm volatile("" ::: "memory"); __builtin_amdgcn_s_barrier(); asm volatile("" ::: "memory");
#endif
    }
};

__device__ __forceinline__ unsigned cvt_pk_bf16(float lo, float hi) { unsigned r; asm volatile("v_cvt_pk_bf16_f32 %0, %1, %2" : "=v"(r) : "v"(lo), "v"(hi)); return r; }
typedef float f32x2 __attribute__((ext_vector_type(2)));
__device__ __forceinline__ f32x2 gelu_pk(f32x2 v) {
    const f32x2 av = __builtin_elementwise_abs(v), d = av * 0.2316418882f + 1.0f;
    f32x2 t; t.x = __builtin_amdgcn_rcpf(d.x); t.y = __builtin_amdgcn_rcpf(d.y);
    f32x2 q = t * 0.5307027145f + (-0.7265760135f); q = q * t + 0.7107068705f; q = q * t + (-0.142248368f); q = q * t + 0.127414796f; q = q * t;
    const f32x2 s = (v * v) * (-0.72134752044f);
    f32x2 e; e.x = __builtin_amdgcn_exp2f(s.x); e.y = __builtin_amdgcn_exp2f(s.y);
    const f32x2 m = v * (q * e), r = v - m;
    f32x2 o; o.x = v.x < 0.f ? m.x : r.x; o.y = v.y < 0.f ? m.y : r.y; return o;
}

struct EpiF32 {
    static constexpr bool PERM = false, AFTER_DRAIN = false;
    float* C; int ldc; const float* bias;
    __device__ __forceinline__ void operator()(const f32x4 (&acc)[2][2][4][2], const Unit& u, int wr, int wc, int fr, int fq) const {
        const int row0 = u.pm * BM + wr * 64 + fr, col0 = u.pn * BM + wc * 32 + 4 * fq;
        f32x4 bv[2][2];
#pragma unroll
        for (int bj = 0; bj < 2; ++bj)
#pragma unroll
            for (int n = 0; n < 2; ++n) bv[bj][n] = bias ? *(const f32x4*)(bias + col0 + bj * HALF + n * 16) : (f32x4){0.f, 0.f, 0.f, 0.f};
#pragma unroll
        for (int ai = 0; ai < 2; ++ai)
#pragma unroll
            for (int m = 0; m < 4; ++m) { float* rowp = C + (size_t)(row0 + ai * HALF + m * 16) * ldc + col0;
#pragma unroll
                for (int bj = 0; bj < 2; ++bj)
#pragma unroll
                    for (int n = 0; n < 2; ++n) *(f32x4*)(rowp + bj * HALF + n * 16) = acc[ai][bj][m][n] + bv[bj][n]; }
    }
};
template <int ACT  > struct EpiBf16 {
    static constexpr bool PERM = true, AFTER_DRAIN = false;
    bf16_t* O; int ldc; const float* bias; int split_cols; size_t split_stride;
    __device__ __forceinline__ void operator()(const f32x4 (&acc)[2][2][4][2], const Unit& u, int wr, int wc, int fr, int fq) const {
        const int row0 = u.pm * BM + wr * 64 + fr; int colt = u.pn * BM; bf16_t* base = O;
        if (split_cols) { const int t = colt / split_cols; base += (size_t)t * split_stride; colt -= t * split_cols; }
        const int col0 = colt + wc * 32 + 8 * fq, bcol0 = u.pn * BM + wc * 32 + 8 * fq;
        f32x4 bv[2][2];
#pragma unroll
        for (int bj = 0; bj < 2; ++bj)
#pragma unroll
            for (int n = 0; n < 2; ++n) bv[bj][n] = bias ? *(const f32x4*)(bias + bcol0 + bj * HALF + 4 * n) : (f32x4){0.f, 0.f, 0.f, 0.f};
#pragma unroll
        for (int ai = 0; ai < 2; ++ai)
#pragma unroll
            for (int m = 0; m < 4; ++m) { bf16_t* rowp = base + (size_t)(row0 + ai * HALF + m * 16) * ldc + col0;
#pragma unroll
                for (int bj = 0; bj < 2; ++bj) { f32x4 v0 = acc[ai][bj][m][0] + bv[bj][0], v1 = acc[ai][bj][m][1] + bv[bj][1];
                    if (ACT == 1) { f32x2 a = gelu_pk((f32x2){v0[0], v0[1]}), b = gelu_pk((f32x2){v0[2], v0[3]}), c = gelu_pk((f32x2){v1[0], v1[1]}), d = gelu_pk((f32x2){v1[2], v1[3]});
                        v0 = (f32x4){a.x, a.y, b.x, b.y}; v1 = (f32x4){c.x, c.y, d.x, d.y}; }
                    if (ACT == 2) {
#pragma unroll
                        for (int j = 0; j < 4; ++j) { v0[j] = 0.5f * v0[j] * (1.0f + erff(v0[j] * 0.70710678f)); v1[j] = 0.5f * v1[j] * (1.0f + erff(v1[j] * 0.70710678f)); } }
                    u32x4 w; w.x = cvt_pk_bf16(v0[0], v0[1]); w.y = cvt_pk_bf16(v0[2], v0[3]); w.z = cvt_pk_bf16(v1[0], v1[1]); w.w = cvt_pk_bf16(v1[2], v1[3]);
                    *(u32x4*)(rowp + bj * HALF) = w; } }
    }
};

struct PanelStats {
    unsigned* xbuf;
    unsigned* cnt;
    unsigned* tmo;
    int ntn; float eps;
    unsigned code;
    __device__ __forceinline__ bool run(const f32x4 (&v)[2][2][4][2], const Unit& u, int wr, int wc, int fr, int fq, PG8_LAS unsigned char* lds, int wid, int lane) const {
        typedef float f32x2v __attribute__((ext_vector_type(2)));
        PG8_LAS f32x2v* P = (PG8_LAS f32x2v*)lds;
        PG8_LAS f32x2v* S = (PG8_LAS f32x2v*)(lds + 8192);
        PG8_LAS unsigned* flag = (PG8_LAS unsigned*)(lds + 8192 + 2048);
#pragma unroll
        for (int ai = 0; ai < 2; ++ai)
#pragma unroll
            for (int m = 0; m < 4; ++m) {
                float s = 0.f;
#pragma unroll
                for (int bj = 0; bj < 2; ++bj)
#pragma unroll
                    for (int n = 0; n < 2; ++n) { const f32x4 x = v[ai][bj][m][n]; s += (x[0] + x[1]) + (x[2] + x[3]); }
                s += __shfl_xor(s, 16); s += __shfl_xor(s, 32);
                const float mw = s * (1.0f / 64.0f); float q = 0.f;
#pragma unroll
                for (int bj = 0; bj < 2; ++bj)
#pragma unroll
                    for (int n = 0; n < 2; ++n) { const f32x4 d = v[ai][bj][m][n] - mw; q += (d[0] * d[0] + d[1] * d[1]) + (d[2] * d[2] + d[3] * d[3]); }
                q += __shfl_xor(q, 16); q += __shfl_xor(q, 32);
                if (fq == 0) P[(ai * HALF + wr * 64 + m * 16 + fr) * 4 + wc] = (f32x2v){mw, q};
            }
        asm volatile("s_waitcnt lgkmcnt(0)" ::: "memory"); __builtin_amdgcn_s_barrier(); asm volatile("" ::: "memory");
#if defined(BROKEN_NO_WAIT)
        if (blockIdx.x >= 64) { const long long t0 = clock64(); while (clock64() - t0 < 60000) __builtin_amdgcn_s_sleep(8); }
#endif
        const int row = wid * 32 + (lane & 31);
        if (lane < 32) {
            const f32x2v a = P[row * 4 + 0], b = P[row * 4 + 1], c = P[row * 4 + 2], d = P[row * 4 + 3];
            const float mt = (a.x + b.x + c.x + d.x) * 0.25f;
            const float da = a.x - mt, db = b.x - mt, dc = c.x - mt, dd = d.x - mt;
            const float m2 = (a.y + b.y) + (c.y + d.y) + 64.0f * ((da * da + db * db) + (dc * dc + dd * dd));
            unsigned long long* slot = (unsigned long long*)xbuf + ((size_t)(u.pm * BM + row) * 4 + u.pn);
            __hip_atomic_store(slot, ((unsigned long long)__float_as_uint(m2) << 32) | __float_as_uint(mt), __ATOMIC_RELAXED, __HIP_MEMORY_SCOPE_AGENT);
        }
        asm volatile("s_waitcnt vmcnt(0)" ::: "memory");
        if (lane == 0) __hip_atomic_fetch_add(cnt + 64 * u.pm, 1u, __ATOMIC_RELAXED, __HIP_MEMORY_SCOPE_AGENT);
        if (wid == 0) {
            bool dead = false; const unsigned long long t0 = __builtin_amdgcn_s_memrealtime(); const unsigned want = 8u * (unsigned)ntn;
            for (;;) {
#if defined(BROKEN_NO_WAIT)
                break;
#endif
                if ((unsigned)__builtin_amdgcn_readfirstlane(__hip_atomic_load(cnt + 64 * u.pm, __ATOMIC_RELAXED, __HIP_MEMORY_SCOPE_AGENT)) >= want) break;
                if (__builtin_amdgcn_s_memrealtime() - t0 > 2000000ull) {
                    if (lane == 0) { unsigned expect = 0u; __hip_atomic_compare_exchange_strong(tmo + 1, &expect, code | (unsigned)(u.pm & 0xff), __ATOMIC_RELAXED, __ATOMIC_RELAXED, __HIP_MEMORY_SCOPE_AGENT);
                                     __hip_atomic_store(tmo, 1u, __ATOMIC_RELAXED, __HIP_MEMORY_SCOPE_AGENT); }
                    dead = true; break; }
                __builtin_amdgcn_s_sleep(2);
            }
            __builtin_amdgcn_fence(__ATOMIC_ACQUIRE, "agent");
            if (lane == 0) flag[0] = dead ? 1u : 0u;
        }
        asm volatile("s_waitcnt vmcnt(0) lgkmcnt(0)" ::: "memory"); __builtin_amdgcn_s_barrier(); asm volatile("" ::: "memory");
        const bool bad = flag[0] != 0u;
        if (lane < 32) {
            const unsigned long long* slot = (const unsigned long long*)xbuf + (size_t)(u.pm * BM + row) * 4; float mt[4], m2[4]; float ms = 0.f;
#pragma unroll
            for (int t = 0; t < 4; ++t) { if (t < ntn) { const unsigned long long w = __hip_atomic_load(slot + t, __ATOMIC_RELAXED, __HIP_MEMORY_SCOPE_AGENT); mt[t] = __uint_as_float((unsigned)w); m2[t] = __uint_as_float((unsigned)(w >> 32)); } else { mt[t] = 0.f; m2[t] = 0.f; } ms += mt[t]; }
            const float mean = ms / (float)ntn; float q = 0.f;
#pragma unroll
            for (int t = 0; t < 4; ++t) if (t < ntn) { const float dm = mt[t] - mean; q += m2[t] + 256.0f * dm * dm; }
            S[row] = (f32x2v){mean, 1.0f / sqrtf(q / (256.0f * (float)ntn) + eps)};
        }
        asm volatile("s_waitcnt lgkmcnt(0)" ::: "memory"); __builtin_amdgcn_s_barrier(); asm volatile("" ::: "memory");
        return bad;
    }
};
struct EpiLnRes {
    static constexpr bool PERM = false, AFTER_DRAIN = true;
    const float* base; float* out; int ldc; const float* bias; PanelStats st; unsigned poison;
    __device__ __forceinline__ void refuse(size_t i0, size_t stride, int M, int N) const { const float q = __builtin_nanf(""); for (size_t i = i0; i < (size_t)M * N; i += stride) out[(i / N) * ldc + i % N] = q;
        if (i0 == 0) { unsigned expect = 0u; __hip_atomic_compare_exchange_strong(st.tmo + 1, &expect, 0x7f0u, __ATOMIC_RELAXED, __ATOMIC_RELAXED, __HIP_MEMORY_SCOPE_AGENT); __hip_atomic_store(st.tmo, 1u, __ATOMIC_RELAXED, __HIP_MEMORY_SCOPE_AGENT); } }
    __device__ __forceinline__ void fused(f32x4 (&acc)[2][2][4][2], const Unit& u, int wr, int wc, int fr, int fq, PG8_LAS unsigned char* lds, int wid, int lane) const {
        typedef float f32x2v __attribute__((ext_vector_type(2)));
        const PG8_LAS f32x2v* S = (const PG8_LAS f32x2v*)(lds + 8192);
        const int col0 = u.pn * BM + wc * 32 + 4 * fq;
#pragma unroll
        for (int bj = 0; bj < 2; ++bj)
#pragma unroll
            for (int n = 0; n < 2; ++n) { const f32x4 bv = bias ? *(const f32x4*)(bias + col0 + bj * HALF + n * 16) : (f32x4){0.f, 0.f, 0.f, 0.f};
#pragma unroll
                for (int ai = 0; ai < 2; ++ai)
#pragma unroll
                    for (int m = 0; m < 4; ++m) acc[ai][bj][m][n] += bv; }
        const bool bad = st.run(acc, u, wr, wc, fr, fq, lds, wid, lane) || poison != 0u;
        const float qnan = __builtin_nanf("");
#pragma unroll
        for (int ai = 0; ai < 2; ++ai)
#pragma unroll
            for (int m = 0; m < 4; ++m) { const int r = ai * HALF + wr * 64 + m * 16 + fr; const f32x2v sr = S[r]; const size_t off = (size_t)(u.pm * BM + r) * ldc + col0;
#pragma unroll
                for (int bj = 0; bj < 2; ++bj)
#pragma unroll
                    for (int n = 0; n < 2; ++n) { const f32x4 bs = *(const f32x4*)(base + off + bj * HALF + n * 16); f32x4 o = bs + (acc[ai][bj][m][n] - sr.x) * sr.y;
                        if (bad) o = (f32x4){qnan, qnan, qnan, qnan}; *(f32x4*)(out + off + bj * HALF + n * 16) = o; }
                asm volatile("" ::: "memory"); }
    }
};
struct EpiLnResLn {
    static constexpr bool PERM = false, AFTER_DRAIN = true;
    const float* base; float* out; bf16_t* xn; int ldc; const float* bias; PanelStats st1, st2; unsigned poison;
    __device__ __forceinline__ void refuse(size_t i0, size_t stride, int M, int N) const { const float q = __builtin_nanf(""); for (size_t i = i0; i < (size_t)M * N; i += stride) { const size_t o = (i / N) * ldc + i % N; out[o] = q; xn[o] = (bf16_t)0x7fc0u; }
        if (i0 == 0) { unsigned expect = 0u; __hip_atomic_compare_exchange_strong(st1.tmo + 1, &expect, 0x7f0u, __ATOMIC_RELAXED, __ATOMIC_RELAXED, __HIP_MEMORY_SCOPE_AGENT); __hip_atomic_store(st1.tmo, 1u, __ATOMIC_RELAXED, __HIP_MEMORY_SCOPE_AGENT); } }
    __device__ __forceinline__ void fused(f32x4 (&acc)[2][2][4][2], const Unit& u, int wr, int wc, int fr, int fq, PG8_LAS unsigned char* lds, int wid, int lane) const {
        typedef float f32x2v __attribute__((ext_vector_type(2))); typedef unsigned u32x2v __attribute__((ext_vector_type(2)));
        const PG8_LAS f32x2v* S = (const PG8_LAS f32x2v*)(lds + 8192);
        const int col0 = u.pn * BM + wc * 32 + 4 * fq;
#pragma unroll
        for (int bj = 0; bj < 2; ++bj)
#pragma unroll
            for (int n = 0; n < 2; ++n) { const f32x4 bv = bias ? *(const f32x4*)(bias + col0 + bj * HALF + n * 16) : (f32x4){0.f, 0.f, 0.f, 0.f};
#pragma unroll
                for (int ai = 0; ai < 2; ++ai)
#pragma unroll
                    for (int m = 0; m < 4; ++m) acc[ai][bj][m][n] += bv; }
        bool bad = st1.run(acc, u, wr, wc, fr, fq, lds, wid, lane) || poison != 0u;
        const float qnan = __builtin_nanf("");
#pragma unroll
        for (int ai = 0; ai < 2; ++ai)
#pragma unroll
            for (int m = 0; m < 4; ++m) { const int r = ai * HALF + wr * 64 + m * 16 + fr; const f32x2v sr = S[r]; const size_t off = (size_t)(u.pm * BM + r) * ldc + col0;
#pragma unroll
                for (int bj = 0; bj < 2; ++bj)
#pragma unroll
                    for (int n = 0; n < 2; ++n) { const f32x4 bs = *(const f32x4*)(base + off + bj * HALF + n * 16); acc[ai][bj][m][n] = bs + (acc[ai][bj][m][n] - sr.x) * sr.y; }
                asm volatile("" : "+v"(acc[ai][0][m][0]), "+v"(acc[ai][0][m][1]), "+v"(acc[ai][1][m][0]), "+v"(acc[ai][1][m][1]));
                if (m & 1) asm volatile("" ::: "memory"); }
        const bool bad1 = bad;
        bad = st2.run(acc, u, wr, wc, fr, fq, lds, wid, lane) || bad;
#pragma unroll
        for (int ai = 0; ai < 2; ++ai)
#pragma unroll
            for (int m = 0; m < 4; ++m) { const int r = ai * HALF + wr * 64 + m * 16 + fr; const f32x2v sr = S[r]; const size_t off = (size_t)(u.pm * BM + r) * ldc + col0;
#pragma unroll
                for (int bj = 0; bj < 2; ++bj)
#pragma unroll
                    for (int n = 0; n < 2; ++n) { const f32x4 x1 = acc[ai][bj][m][n]; *(f32x4*)(out + off + bj * HALF + n * 16) = bad1 ? (f32x4){qnan, qnan, qnan, qnan} : x1;
                        const f32x4 o = (x1 - sr.x) * sr.y; u32x2v w; w.x = cvt_pk_bf16(o[0], o[1]); w.y = cvt_pk_bf16(o[2], o[3]);
                        if (bad) { w.x = 0x7fc07fc0u; w.y = 0x7fc07fc0u; } *(u32x2v*)(xn + off + bj * HALF + n * 16) = w; }
                asm volatile("" ::: "memory"); }
    }
};

template <class Epi, class Sched, bool STAMP = false>
__device__ __forceinline__ void gemm_phase(PG8_LAS unsigned char* lds, const Gemm g, const Sched& S, const Epi& E, unsigned long long* stamps) {
    const int tid = threadIdx.x, wid = __builtin_amdgcn_readfirstlane(tid >> 6), lane = tid & 63, wr = wid >> 2, wc = wid & 3, fr = lane & 15, fq = lane >> 4;
    const int K = g.K, nt = K / BK;
    int ts_lo = 0, ts_hi = 0, nts = 0; const unsigned long long rt_entry = STAMP ? (unsigned long long)wall_clock64() : 0ull;
#define PG8_STAMP() do { if (STAMP && wid == 0 && nts < 64) { const unsigned long long _c = (unsigned long long)clock64(); \
        ts_lo = (lane == nts) ? (int)(unsigned)_c : ts_lo; ts_hi = (lane == nts) ? (int)(unsigned)(_c >> 32) : ts_hi; ++nts; } } while (0)
    PG8_STAMP();
    unsigned voffA[2], voffB[2];
#pragma unroll
    for (int i = 0; i < 2; ++i) { int R, C; stage_rc(tid * 16 + i * 8192, R, C); const int Rb = Epi::PERM ? ((R & ~31) + perm32(R & 31)) : R;
        voffA[i] = (unsigned)(R * K + C) * 2u; voffB[i] = (unsigned)(Rb * K + C) * 2u; }
    const size_t kstep = (size_t)(BK * 2);
    const size_t hstep = (size_t)HALF * K * 2;
    const size_t tstep = 2 * hstep;
    const unsigned ldsw = (unsigned)wid * 1024u;
    const int aoff = lds_byte(wr * 64 + fr, fq * 8), boff = lds_byte(wc * 32 + fr, fq * 8);
#define PG8_SA(b, h) (((b) * 2 + (h)) * HTB)
#define PG8_SB(b, h) ((4 + (b) * 2 + (h)) * HTB)
#define PG8_STAGE(bufoff, gbase, voff) do { _Pragma("unroll") for (int _i = 0; _i < 2; ++_i) \
        __builtin_amdgcn_global_load_lds((const unsigned*)((const char*)(gbase) + (voff)[_i]), (PG8_LAS unsigned*)(lds + (bufoff) + ldsw + _i * 8192), 16, 0, 0); } while (0)
#define PG8_LDA(dst, b, h) do { _Pragma("unroll") for (int m = 0; m < 4; ++m) _Pragma("unroll") for (int k = 0; k < 2; ++k) dst[m][k] = *(const PG8_LAS bf16x8*)(lds + PG8_SA(b, h) + aoff + m * 2048 + k * 1024); } while (0)
#define PG8_LDB(dst, b, h) do { _Pragma("unroll") for (int n = 0; n < 2; ++n) _Pragma("unroll") for (int k = 0; k < 2; ++k) dst[n][k] = *(const PG8_LAS bf16x8*)(lds + PG8_SB(b, h) + boff + n * 2048 + k * 1024); } while (0)
#define PG8_MMA(ai, bj, At, Bt) do { __builtin_amdgcn_s_setprio(1); _Pragma("unroll") for (int m = 0; m < 4; ++m) _Pragma("unroll") for (int n = 0; n < 2; ++n) _Pragma("unroll") for (int k = 0; k < 2; ++k) \
        acc[ai][bj][m][n] = __builtin_amdgcn_mfma_f32_16x16x32_bf16(Bt[n][k], At[m][k], acc[ai][bj][m][n], 0, 0, 0); __builtin_amdgcn_s_setprio(0); } while (0)
#define PG8_WAIT_V(n) asm volatile("s_waitcnt vmcnt(" #n ")" ::: "memory")
#define PG8_WAIT_L(n) asm volatile("s_waitcnt lgkmcnt(" #n ")" ::: "memory")
#define PG8_BAR __builtin_amdgcn_s_barrier()
#define PG8_SCHED __builtin_amdgcn_sched_barrier(0)
    Unit cur, nxt; int ui = 0;
    if (!S.next(0, cur)) return;
    f32x4 acc[2][2][4][2];
#pragma unroll
    for (int a = 0; a < 2; ++a)
#pragma unroll
        for (int b = 0; b < 2; ++b)
#pragma unroll
            for (int m = 0; m < 4; ++m)
#pragma unroll
                for (int n = 0; n < 2; ++n) acc[a][b][m][n] = (f32x4){0.f, 0.f, 0.f, 0.f};
    bf16x8 At[4][2], B0[2][2], B1[2][2];
    const char* cA = (const char*)g.A + (size_t)cur.pm * tstep; const char* cB = (const char*)g.Bt + (size_t)cur.pn * tstep;
    S.a_ready(cur);
    PG8_STAGE(PG8_SB(0, 0), cB, voffB); PG8_STAGE(PG8_SA(0, 0), cA, voffA); PG8_STAGE(PG8_SB(0, 1), cB + hstep, voffB); PG8_STAGE(PG8_SA(0, 1), cA + hstep, voffA);
    if (wr == 1) PG8_BAR;
    PG8_WAIT_V(4); PG8_BAR;
    PG8_STAGE(PG8_SB(1, 0), cB + kstep, voffB); PG8_STAGE(PG8_SA(1, 0), cA + kstep, voffA); PG8_STAGE(PG8_SB(1, 1), cB + hstep + kstep, voffB);
    PG8_WAIT_V(6); PG8_BAR;
    PG8_STAMP();
    for (;;) {
        const bool has_next = S.next(ui + 1, nxt);
        const char* nA = has_next ? (const char*)g.A + (size_t)nxt.pm * tstep : cA; const char* nB = has_next ? (const char*)g.Bt + (size_t)nxt.pn * tstep : cB;
        for (int t = 0; t < nt; t += 2) {
            const bool last = (t == nt - 2);
            const char* a1 = cA + (size_t)(t + 1) * kstep;
            const char* a2 = last ? nA : cA + (size_t)(t + 2) * kstep; const char* b2 = last ? nB : cB + (size_t)(t + 2) * kstep;
            const char* a3 = a2 + kstep; const char* b3 = b2 + kstep;
            if (last && has_next) S.a_ready(nxt);
            PG8_LDB(B0, 0, 0); PG8_SCHED; PG8_LDA(At, 0, 0); PG8_STAGE(PG8_SA(1, 1), a1 + hstep, voffA);
            PG8_WAIT_L(8); PG8_BAR; PG8_WAIT_L(0); PG8_MMA(0, 0, At, B0); PG8_BAR; PG8_SCHED;
            PG8_LDB(B1, 0, 1); PG8_STAGE(PG8_SB(0, 0), b2, voffB);
            PG8_BAR; PG8_WAIT_L(0); PG8_MMA(0, 1, At, B1); PG8_BAR;
            PG8_LDA(At, 0, 1); PG8_STAGE(PG8_SA(0, 0), a2, voffA);
            PG8_BAR; PG8_WAIT_L(0); PG8_MMA(1, 0, At, B0); PG8_BAR; PG8_SCHED;
            PG8_STAGE(PG8_SB(0, 1), b2 + hstep, voffB);
            PG8_WAIT_V(6); PG8_BAR; PG8_MMA(1, 1, At, B1); PG8_BAR;
            PG8_LDB(B0, 1, 0); PG8_SCHED; PG8_LDA(At, 1, 0); PG8_STAGE(PG8_SA(0, 1), a2 + hstep, voffA);
            PG8_WAIT_L(8); PG8_BAR; PG8_WAIT_L(0); PG8_MMA(0, 0, At, B0); PG8_BAR; PG8_SCHED;
            PG8_LDB(B1, 1, 1); PG8_STAGE(PG8_SB(1, 0), b3, voffB);
            PG8_BAR; PG8_WAIT_L(0); PG8_MMA(0, 1, At, B1); PG8_BAR;
            PG8_LDA(At, 1, 1); PG8_STAGE(PG8_SA(1, 0), a3, voffA);
            PG8_BAR; PG8_WAIT_L(0); PG8_MMA(1, 0, At, B0); PG8_BAR; PG8_SCHED;
            PG8_STAGE(PG8_SB(1, 1), b3 + hstep, voffB);
            PG8_WAIT_V(6); PG8_BAR; PG8_MMA(1, 1, At, B1); PG8_BAR;
        }
        PG8_STAMP();
        if constexpr (!Epi::AFTER_DRAIN) { E(acc, cur, wr, wc, fr, fq); S.done(cur); }
        PG8_STAMP();
        if (!has_next) break;
#pragma unroll
        for (int a = 0; a < 2; ++a)
#pragma unroll
            for (int b = 0; b < 2; ++b)
#pragma unroll
                for (int m = 0; m < 4; ++m)
#pragma unroll
                    for (int n = 0; n < 2; ++n) acc[a][b][m][n] = (f32x4){0.f, 0.f, 0.f, 0.f};
        cur = nxt; cA = nA; cB = nB; ++ui;
    }
    PG8_WAIT_V(0);
    if (wr == 0) PG8_BAR;
    PG8_BAR;
    if constexpr (Epi::AFTER_DRAIN) { E.fused(acc, cur, wr, wc, fr, fq, lds, wid, lane); S.done(cur); }
    PG8_STAMP();
    if (STAMP && wid == 0) { stamps[lane] = lane < nts ? (((unsigned long long)(unsigned)ts_hi << 32) | (unsigned)ts_lo) : 0ull;
        if (lane == 62) stamps[62] = rt_entry; if (lane == 63) stamps[63] = (unsigned long long)wall_clock64(); }
#undef PG8_STAMP
#undef PG8_SA
#undef PG8_SB
#undef PG8_STAGE
#undef PG8_LDA
#undef PG8_LDB
#undef PG8_MMA
#undef PG8_WAIT_V
#undef PG8_WAIT_L
#undef PG8_BAR
#undef PG8_SCHED
}
}

#define XB_TMO      128
#define XB_XCNT(j)  (256  + 64 * (j))
#define XB_XSUB(j)  (1280 + 64 * (j))
#define XB_XGEN(j)  (2304 + 64 * (j))
#define XB_TOP      3328
#define XB_TOPGEN   3392
#define XCD_BAR_WORDS 3456
#define XB_SPIN_CAP (1u << 22)
#define LAS __attribute__((address_space(3)))
DI unsigned xb_ld(unsigned* p) { return __hip_atomic_load(p, __ATOMIC_RELAXED, __HIP_MEMORY_SCOPE_AGENT); }
DI unsigned xb_add(unsigned* p, unsigned v) { return __hip_atomic_fetch_add(p, v, __ATOMIC_RELAXED, __HIP_MEMORY_SCOPE_AGENT); }
DI unsigned xb_xcc_id() { return (unsigned)__builtin_amdgcn_s_getreg((3 << 11) | 20) & 0xFu; }
#define XB_SPIN(cond, bar) do { unsigned _sp = 0; while (cond) { __builtin_amdgcn_s_sleep(1); \
    if ((++_sp & 255u) == 0u) { if (xb_ld(&(bar)[XB_TMO])) break; if (_sp > XB_SPIN_CAP) { atomicAdd(&(bar)[XB_TMO], 1u); break; } } } } while (0)
struct XcdBarrier { unsigned* bar; unsigned x; volatile LAS unsigned* st; };
DI XcdBarrier xcd_barrier_post(unsigned* bar, volatile LAS unsigned* st) {
  XcdBarrier b; b.bar = bar; b.x = xb_xcc_id(); b.st = st;
  if (threadIdx.x == 0) (void)xb_add(&bar[XB_XCNT(b.x)], 1u);
  return b;
}
DI void xcd_barrier_complete(unsigned* bar, unsigned x, unsigned& nloc, unsigned& nx) {
  const unsigned G = gridDim.x * gridDim.y * gridDim.z;
  unsigned sum, cnt, mine, sp = 0u;
  for (;;) {
    sum = 0u; cnt = 0u; mine = 0u;
#pragma unroll
    for (unsigned j = 0; j < 16; ++j) { const unsigned c = xb_ld(&bar[XB_XCNT(j)]); sum += c; cnt += (c > 0u) ? 1u : 0u; mine = (j == x) ? c : mine; }
    if (sum == G) break;
    __builtin_amdgcn_s_sleep(1);
    if ((++sp & 255u) == 0u) { if (xb_ld(&bar[XB_TMO])) break; if (sp > XB_SPIN_CAP) { atomicAdd(&bar[XB_TMO], 1u); break; } }
  }
  nloc = mine > 0u ? mine : 1u; nx = cnt > 0u ? cnt : 1u;
}
DI void xcd_barrier(const XcdBarrier& b) {
  asm volatile("s_waitcnt vmcnt(0)" ::: "memory");
  __syncthreads();
  if (threadIdx.x == 0) {
    unsigned* bar = b.bar;
    __builtin_amdgcn_s_waitcnt(0);
    unsigned nloc = b.st[0], nx = b.st[1];
    if (nloc == 0u) { xcd_barrier_complete(bar, b.x, nloc, nx); b.st[0] = nloc; b.st[1] = nx; }
    const unsigned old = xb_add(&bar[XB_XSUB(b.x)], 1u);
    const unsigned gen = old / nloc;
    if (old + 1u == (gen + 1u) * nloc) {
      __builtin_amdgcn_fence(__ATOMIC_RELEASE, "agent");
      asm volatile("s_waitcnt vmcnt(0)" ::: "memory");
      const unsigned og = xb_add(&bar[XB_TOP], 1u);
      const unsigned tg = og / nx;
      if (og + 1u == (tg + 1u) * nx) xb_add(&bar[XB_TOPGEN], 1u);
      else XB_SPIN(xb_ld(&bar[XB_TOPGEN]) == tg, bar);
      __builtin_amdgcn_fence(__ATOMIC_ACQUIRE, "agent");
      xb_add(&bar[XB_XGEN(b.x)], 1u);
      asm volatile("s_waitcnt vmcnt(0)" ::: "memory");
    } else {
      XB_SPIN(xb_ld(&bar[XB_XGEN(b.x)]) == gen, bar);
      __builtin_amdgcn_fence(__ATOMIC_ACQUIRE, "agent");
      asm volatile("s_waitcnt vmcnt(0)" ::: "memory");
    }
  }
  __syncthreads();
}

#define GPTR(T, x) ((T*)(__attribute__((address_space(1))) T*)(x))
__global__ void __launch_bounds__(NT) mega(P p) {
  extern __shared__ __attribute__((aligned(16))) unsigned char lds[];
  cg::grid_group grid = cg::this_grid();
  volatile LAS unsigned* st = (volatile LAS unsigned*)(lds + LDS_BYTES - 16);
  if (threadIdx.x < 4) st[threadIdx.x] = 0u;
  __syncthreads();
  const XcdBarrier xbar = xcd_barrier_post((unsigned*)(p.ws + WS_BAR), st);
  phase0(p, lds);
  grid.sync();
  const P& p0 = p;
  for (int step = 0; step < 90; ++step) {
    const int g = step / 45, rem = step - g * 45, layer = rem / 9, sub = rem - layer * 9;
    const int kind = layer % 3, jl = layer / 3;
    const int T = g ? 16384 : 8192, Lmask = g ? 4095 : 255;
    int op = -1;
    if (layer == 4) op = (sub == 0) ? 0 : -1;
    else if (sub == 0) op = 0;
    else if (kind == 0) op = sub == 1 ? 1 : (sub <= 5 ? 4 : (sub == 6 ? 2 : (sub == 7 ? 3 : 4)));
    else if (kind == 1) op = sub == 1 ? 5 : (sub == 2 ? 6 : (sub == 3 ? 4 : -1));
    else op = sub == 1 ? 4 : (sub == 2 ? 7 : (sub == 3 ? 4 : -1));
    if (op < 0) continue;
    P p = p0;
    { size_t zo_ = 0; asm volatile("" : "+s"(zo_)); p.ws = p0.ws + zo_; p.out = p0.out + zo_; }
    bf16_t* slots = (bf16_t*)(p.ws + WS_SLOT);
    const bf16_t* W = (const bf16_t*)(p.ws + WS_W);
    if (op == 0) {
      const float* xin = p.in[g]; float* xout = p.out + (g ? OUT_YS : OUT_YP);
      phase_norm(p, g, layer - 1, layer < 4 ? layer : -1, layer <= 1 ? xin : xout, xout, slots + SLOT_ELEMS, slots);
      if (kind == 1 && g == 1 && layer < 4) phase_cache_copy(p);
    } else if (op == 1) {
      phase_gemm<1, 0>(p, g, slots, W + (size_t)(RW_IN0 + jl * RW_STRIDE + 4096) * 1024, T, 256, p.in[11] + jl * 6144, Lmask, slots + SLOT_ELEMS, 1, lds, 32);
      phase_xsmix(p, g, jl);
    } else if (op == 2) {
      for (int rep = 0; rep < opq(REP_SCAN); ++rep) phase_scan(p, g, jl, lds);
    } else if (op == 3) {
      phase_rwkv_combine(p, g, jl);
    } else if (op == 4) {
      const bf16_t* A; const bf16_t* Bt; int N; bf16_t* dst;
      if (kind == 0 && sub <= 5) {
        const int m = sub - 2; A = slots + (size_t)(2 + m) * SLOT_ELEMS; Bt = W + (size_t)(RW_IN0 + jl * RW_STRIDE + m * 1024) * 1024; N = 1024; dst = slots + (size_t)(1 + m) * SLOT_ELEMS; }
      else if (kind == 2 && sub == 1) { A = slots; Bt = W + (size_t)CV_IN * 1024; N = 4096; dst = slots + 2 * SLOT_ELEMS; }
      else {
        N = 1024; dst = slots + SLOT_ELEMS;
        if (kind == 0) { A = slots + 4 * SLOT_ELEMS; Bt = W + (size_t)(RW_OUT0 + jl * RW_STRIDE) * 1024; }
        else if (kind == 1) { A = slots + 5 * SLOT_ELEMS; Bt = W + (size_t)AT_OUT * 1024; }
        else { A = slots; Bt = W + (size_t)CV_OUT * 1024; }
      }
      {
        pg8::Gemm gg{A, Bt, T, N, 1024}; pg8::StaticOrder S; S.init(T, N, (int)gridDim.x, (int)blockIdx.x);
        pg8::EpiBf16<0> E{dst, 1024, nullptr, N > 1024 ? 1024 : 0, SLOT_ELEMS};
        pg8::gemm_phase<pg8::EpiBf16<0>, pg8::StaticOrder, false>((PG8_LAS unsigned char*)(unsigned)(unsigned long long)lds, gg, S, E, nullptr);
      }
    } else if (op == 5) {
      for (int rep = 0; rep < opq(REP_GEMM); ++rep) phase_gemm<0, 1>(p, g, slots, W + (size_t)AT_IN * 1024, T, 2560, nullptr, 0, nullptr, 0, lds);
    } else if (op == 6) {
      for (int rep = 0; rep < opq(REP_ATTN); ++rep) phase_attn(p, g, lds);
    } else {
      phase_conv(p, g);
    }
    if (!(g == 1 && layer == 4)) for (int rep = 0; rep < opq(REP_SYNC); ++rep) xcd_barrier(xbar);
  }
}

extern "C" void kernel_launch(void* const* d_in, const int* in_sizes, int n_in, void* d_out, int out_size, void* d_ws, size_t ws_size, hipStream_t stream) {
  static int grid_blocks = 0;
  if (!grid_blocks) {
    int dev = 0, cus = 0, per_cu = 0;
    hipGetDevice(&dev);
    hipDeviceGetAttribute(&cus, hipDeviceAttributeMultiprocessorCount, dev);
    hipFuncSetAttribute((const void*)mega, hipFuncAttributeMaxDynamicSharedMemorySize, LDS_BYTES);
    hipOccupancyMaxActiveBlocksPerMultiprocessor(&per_cu, (const void*)mega, NT, LDS_BYTES);
    if (per_cu < 1) per_cu = 1;
    if (per_cu > 1) per_cu = 1;
    grid_blocks = cus * per_cu;
    if (ws_size < WS_SLOT + 6 * SLOT_ELEMS * 2) fprintf(stderr, "workspace too small: %zu\n", ws_size);
  }
  (void)hipMemsetAsync((unsigned char*)d_ws + WS_BAR, 0, XCD_BAR_WORDS * sizeof(unsigned), stream);
  P p{};
  for (int i = 0; i < 33; ++i) p.in[i] = (const float*)d_in[i];
  p.out = (float*)d_out; p.ws = (unsigned char*)d_ws;
  void* args[] = {&p};
  hipError_t e = hipLaunchCooperativeKernel((const void*)mega, dim3(grid_blocks), dim3(NT), args, LDS_BYTES, stream);
  if (e != hipSuccess) fprintf(stderr, "cooperative launch failed: %s (grid %d)\n", hipGetErrorString(e), grid_blocks);
}
```

```cpp
#include <hip/hip_runtime.h>
#include <hip/hip_cooperative_groups.h>
#include <cstdio>
namespace cg = cooperative_groups;

typedef unsigned short bf16_t;
using bf16x8 = __attribute__((ext_vector_type(8))) short;
using f32x16 = __attribute__((ext_vector_type(16))) float;
using u32x4 = __attribute__((ext_vector_type(4))) unsigned;
using u32x2 = __attribute__((ext_vector_type(2))) unsigned;

#define NT 512
#ifndef REP_GEMM
#define REP_GEMM 1
#endif
#ifndef REP_SCAN
#define REP_SCAN 1
#endif
#ifndef REP_ATTN
#define REP_ATTN 1
#endif
#ifndef REP_SYNC
#define REP_SYNC 1
#endif
#define DI __device__ __forceinline__
#define MFMA32(a, b, c) __builtin_amdgcn_mfma_f32_32x32x16_bf16((a), (b), (c), 0, 0, 0)

struct P { const float* in[33]; float* out; unsigned char* ws; };

constexpr size_t WS_ADA = 0;
constexpr size_t WS_ROPE = 262144;
constexpr size_t WS_BON = 327680;
constexpr size_t WS_HID = WS_BON + 2097152;
constexpr size_t WS_W = WS_HID + 8388608;
constexpr size_t WS_SLOT = WS_W + 39845888;
constexpr size_t SLOT_ELEMS = (size_t)16384 * 1024;
constexpr int RW_IN0 = 0, RW_OUT0 = 4352, RW_STRIDE = 5376, AT_IN = 10752, AT_OUT = 13312, CV_IN = 14336, CV_OUT = 18432;
constexpr size_t OUT_YP = 0, OUT_YS = 8388608, OUT_ST = 25165824, OUT_CK = 33554432, OUT_CV = 35651584;
constexpr int LDS_BYTES = 156416 + 16;
constexpr size_t WS_BAR = 278528;

typedef __bf16 bf16x2_t __attribute__((ext_vector_type(2)));
typedef float f32x2_t __attribute__((ext_vector_type(2)));
DI unsigned pack2(float a, float b) { f32x2_t v = {a, b}; return __builtin_bit_cast(unsigned, __builtin_convertvector(v, bf16x2_t)); }
DI unsigned f2bf(float x) { return (unsigned)__builtin_bit_cast(unsigned short, (__bf16)x); }
DI float bflo(unsigned u) { return __uint_as_float(u << 16); }
DI float bfhi(unsigned u) { return __uint_as_float(u & 0xffff0000u); }
DI float bf1(bf16_t u) { return __uint_as_float(((unsigned)u) << 16); }

template <int CTRL> DI float dppf(float v) { return __int_as_float(__builtin_amdgcn_update_dpp(0, __float_as_int(v), CTRL, 0xF, 0xF, true)); }
DI float reduce16(float v) { v += dppf<0xB1>(v); v += dppf<0x4E>(v); v += dppf<0x141>(v); v += dppf<0x140>(v); return v; }
DI float rdl(float v, int l) { return __int_as_float(__builtin_amdgcn_readlane(__float_as_int(v), l)); }
DI float wave_sum(float v) { v = reduce16(v); return (rdl(v, 0) + rdl(v, 16)) + (rdl(v, 32) + rdl(v, 48)); }
DI float xhalf_max(float x) { const auto r2 = __builtin_amdgcn_permlane32_swap(__float_as_uint(x), __float_as_uint(x), false, false); return fmaxf(__uint_as_float(r2[0]), __uint_as_float(r2[1])); }
DI float xhalf_sum(float x) { const auto r2 = __builtin_amdgcn_permlane32_swap(__float_as_uint(x), __float_as_uint(x), false, false); return __uint_as_float(r2[0]) + __uint_as_float(r2[1]); }
DI float quad_sum(float v) { v += dppf<0xB1>(v); v += dppf<0x4E>(v); return v; }
DI float silu(float x) { return x / (1.f + __expf(-x)); }
DI int opq(int v) { asm volatile("" : "+s"(v)); return v; }
DI int otid() { int t = threadIdx.x; asm volatile("" : "+v"(t)); return t; }

DI void conv_tiles(const float* __restrict__ src, int N, bf16_t* __restrict__ dst, float* lds) {
  const int tid = otid();
  const int tilesN = N >> 6, ntiles = 16 * tilesN;
  for (int tile = blockIdx.x; tile < ntiles; tile += gridDim.x) {
    const int kt = tile / tilesN, nt = tile - kt * tilesN, k0 = kt * 64, n0 = nt * 64;
#pragma unroll
    for (int i = 0; i < 8; ++i) { const int k = (tid >> 6) + 8 * i, n = tid & 63; lds[k * 65 + n] = src[(size_t)(k0 + k) * N + n0 + n]; }
    __syncthreads();
    { const int n = tid >> 3, kc = (tid & 7) * 8; u32x4 o;
#pragma unroll
      for (int j = 0; j < 4; ++j) o[j] = pack2(lds[(kc + 2 * j) * 65 + n], lds[(kc + 2 * j + 1) * 65 + n]);
      *(u32x4*)(dst + (size_t)(n0 + n) * 1024 + k0 + kc) = o; }
    __syncthreads();
  }
}

DI void phase0(const P& p, unsigned char* ldsb) {
  float* lds = (float*)ldsb;
  const int tid = otid();
  bf16_t* W = (bf16_t*)(p.ws + WS_W);
#pragma unroll 1
  for (int e = 0; e < opq(22); ++e) {
    const float* src; int N, drow;
    if (e < 18) {
      const int j = e / 9, q = e - j * 9;
      if (q < 4) { src = p.in[12] + (size_t)(j * 4 + q) * 1048576; N = 1024; drow = RW_IN0 + j * RW_STRIDE + q * 1024; }
      else if (q < 6) { src = p.in[14] + (size_t)(j * 2 + q - 4) * 65536; N = 64; drow = RW_IN0 + j * RW_STRIDE + 4096 + (q - 4) * 64; }
      else if (q < 8) { src = p.in[17] + (size_t)(j * 2 + q - 6) * 65536; N = 64; drow = RW_IN0 + j * RW_STRIDE + 4224 + (q - 6) * 64; }
      else { src = p.in[24] + (size_t)j * 1048576; N = 1024; drow = RW_OUT0 + j * RW_STRIDE; }
    } else if (e == 18) { src = p.in[25]; N = 2560; drow = AT_IN; }
    else if (e == 19) { src = p.in[28]; N = 1024; drow = AT_OUT; }
    else if (e == 20) { src = p.in[29]; N = 4096; drow = CV_IN; }
    else { src = p.in[32]; N = 1024; drow = CV_OUT; }
    conv_tiles(src, N, W + (size_t)drow * 1024, lds);
  }
  {
    float* scond = lds;
    float* red = lds + 5120;
    for (int e = tid; e < 5120; e += NT) { const int cnd = e >> 10, k = e & 1023; const float cv = cnd == 0 ? p.in[6][k] : p.in[5][(cnd - 1) * 1024 + k]; scond[e] = silu(cv); }
    __syncthreads();
    float* ada = (float*)(p.ws + WS_ADA);
    for (int task = blockIdx.x; task < 192; task += gridDim.x) {
      const int layer = task / 48, n0 = (task % 48) * 64, c = tid & 63, kg = tid >> 6;
      float a0 = 0.f, a1 = 0.f, a2 = 0.f, a3 = 0.f, a4 = 0.f;
      const float* wp = p.in[9] + ((size_t)layer * 1024 + kg * 128) * 3072 + n0 + c;
#pragma unroll 8
      for (int k = 0; k < 128; ++k) { const float w = wp[(size_t)k * 3072]; const int kk = kg * 128 + k;
        a0 += scond[kk] * w; a1 += scond[1024 + kk] * w; a2 += scond[2048 + kk] * w; a3 += scond[3072 + kk] * w; a4 += scond[4096 + kk] * w; }
      red[(kg * 5 + 0) * 64 + c] = a0; red[(kg * 5 + 1) * 64 + c] = a1; red[(kg * 5 + 2) * 64 + c] = a2; red[(kg * 5 + 3) * 64 + c] = a3; red[(kg * 5 + 4) * 64 + c] = a4;
      __syncthreads();
      if (tid < 320) { const int cnd = tid >> 6; float s = p.in[10][layer * 3072 + n0 + c];
#pragma unroll
        for (int q = 0; q < 8; ++q) s += red[(q * 5 + cnd) * 64 + c];
        ada[(cnd * 4 + layer) * 3072 + n0 + c] = s; }
      __syncthreads();
    }
  }
  if (blockIdx.x == gridDim.x - 1) {
    float* rope = (float*)(p.ws + WS_ROPE);
    for (int e = tid; e < 1024; e += NT) {
      const int pos = e >> 4, f = e & 15;
      double inv = 1.0; for (int q = 0; q < f; ++q) inv *= 0.5623413251903491;
      double ang = (double)pos * inv;
      const double twopi = 6.283185307179586476925286766559;
      double n = __builtin_rint(ang / twopi); double rr = ang - n * twopi;
      double r2 = rr * rr, sn = 0.0, cs = 0.0, ts = rr, tc = 1.0;
      for (int q = 0; q < 16; ++q) { cs += tc; sn += ts; tc = -tc * r2 / (double)((2 * q + 1) * (2 * q + 2)); ts = -ts * r2 / (double)((2 * q + 2) * (2 * q + 3)); }
      rope[e * 2] = (float)cs; rope[e * 2 + 1] = (float)sn;
    }
  }
}

DI void phase_norm(const P& p, int g, int lpost, int lpre, const float* __restrict__ xsrc, float* __restrict__ xdst,
                   const bf16_t* __restrict__ Mb, bf16_t* __restrict__ H) {
  const int T = g ? 16384 : 8192;
  const int tid = otid(); const int lane = tid & 63, wave = tid >> 6;
  const float* ada = (const float*)(p.ws + WS_ADA);
  float4 xn[4]; u32x2 mn[4];
  const int t0 = blockIdx.x * 8 + wave, tstep = gridDim.x * 8;
#pragma unroll
  for (int i = 0; i < 4; ++i) { xn[i] = make_float4(0.f, 0.f, 0.f, 0.f); mn[i] = (u32x2){0u, 0u}; }
  if (t0 < T) {
#pragma unroll
    for (int i = 0; i < 4; ++i) { xn[i] = *(const float4*)(xsrc + (size_t)t0 * 1024 + 256 * i + 4 * lane); if (lpost >= 0) mn[i] = *(const u32x2*)(Mb + (size_t)t0 * 1024 + 256 * i + 4 * lane); }
  }
  for (int t = t0; t < T; t += tstep) {
    const int cond = g ? 1 + (t >> 12) : 0;
    float4 x[4]; u32x2 mr[4];
#pragma unroll
    for (int i = 0; i < 4; ++i) { x[i] = xn[i]; mr[i] = mn[i]; }
    if (t + tstep < T) {
#pragma unroll
      for (int i = 0; i < 4; ++i) { xn[i] = *(const float4*)(xsrc + (size_t)(t + tstep) * 1024 + 256 * i + 4 * lane); if (lpost >= 0) mn[i] = *(const u32x2*)(Mb + (size_t)(t + tstep) * 1024 + 256 * i + 4 * lane); }
    }
    if (lpost >= 0) {
      float m[16]; float ss = 0.f;
#pragma unroll
      for (int i = 0; i < 4; ++i) { const u32x2 u = mr[i];
        m[4 * i] = bflo(u[0]); m[4 * i + 1] = bfhi(u[0]); m[4 * i + 2] = bflo(u[1]); m[4 * i + 3] = bfhi(u[1]); }
#pragma unroll
      for (int i = 0; i < 16; ++i) ss += m[i] * m[i];
      ss = wave_sum(ss);
      const float rs = rsqrtf(ss * (1.f / 1024.f) + 1e-6f);
      const float* gate = ada + (cond * 4 + lpost) * 3072 + 2048;
      const float* wpo = p.in[8] + lpost * 1024;
#pragma unroll
      for (int i = 0; i < 4; ++i) { const int c = 256 * i + 4 * lane; const float4 gt = *(const float4*)(gate + c); const float4 wv = *(const float4*)(wpo + c);
        x[i].x += gt.x * (m[4 * i] * rs * wv.x); x[i].y += gt.y * (m[4 * i + 1] * rs * wv.y); x[i].z += gt.z * (m[4 * i + 2] * rs * wv.z); x[i].w += gt.w * (m[4 * i + 3] * rs * wv.w);
        *(float4*)(xdst + (size_t)t * 1024 + c) = x[i]; }
    }
    if (lpre >= 0) {
      float ss = 0.f;
#pragma unroll
      for (int i = 0; i < 4; ++i) ss += x[i].x * x[i].x + x[i].y * x[i].y + x[i].z * x[i].z + x[i].w * x[i].w;
      ss = wave_sum(ss);
      const float rs = rsqrtf(ss * (1.f / 1024.f) + 1e-6f);
      const float* sh = ada + (cond * 4 + lpre) * 3072; const float* sc = sh + 1024; const float* wpr = p.in[7] + lpre * 1024;
#pragma unroll
      for (int i = 0; i < 4; ++i) { const int c = 256 * i + 4 * lane; const float4 s4 = *(const float4*)(sh + c); const float4 c4 = *(const float4*)(sc + c); const float4 wv = *(const float4*)(wpr + c);
        u32x2 o; o[0] = pack2(x[i].x * rs * wv.x * (1.f + c4.x) + s4.x, x[i].y * rs * wv.y * (1.f + c4.y) + s4.y);
        o[1] = pack2(x[i].z * rs * wv.z * (1.f + c4.z) + s4.z, x[i].w * rs * wv.w * (1.f + c4.w) + s4.w);
        *(u32x2*)(H + (size_t)t * 1024 + c) = o; }
    }
  }
}

DI void phase_xsmix(const P& p, int g, int jl) {
  const int T = g ? 16384 : 8192, Lmask = g ? 4095 : 255;
  const bf16_t* H = (const bf16_t*)(p.ws + WS_SLOT); bf16_t* XS = (bf16_t*)(p.ws + WS_SLOT) + 2 * SLOT_ELEMS;
  const float* mu = p.in[11] + jl * 6144;
  for (int e = blockIdx.x * NT + otid(); e < T * 128; e += gridDim.x * NT) {
    const int t = e >> 7, c = (e & 127) * 8; const size_t o = (size_t)t * 1024 + c; const int tl = t & Lmask;
    const u32x4 zz = {0u, 0u, 0u, 0u};
    const u32x4 hc = *(const u32x4*)(H + o);
    const u32x4 hp = tl != 0 ? *(const u32x4*)(H + o - 1024) : zz, hn = tl != Lmask ? *(const u32x4*)(H + o + 1024) : zz;
    float hv[8], xv[8];
#pragma unroll
    for (int i = 0; i < 4; ++i) { hv[2 * i] = bflo(hc[i]); hv[2 * i + 1] = bfhi(hc[i]);
      xv[2 * i] = 0.5f * (bflo(hp[i]) + bflo(hn[i])) - hv[2 * i]; xv[2 * i + 1] = 0.5f * (bfhi(hp[i]) + bfhi(hn[i])) - hv[2 * i + 1]; }
#pragma unroll
    for (int m = 0; m < 4; ++m) {
      const float4 m0 = *(const float4*)(mu + m * 1024 + c), m1 = *(const float4*)(mu + m * 1024 + c + 4);
      u32x4 w; w[0] = pack2(hv[0] + xv[0] * m0.x, hv[1] + xv[1] * m0.y); w[1] = pack2(hv[2] + xv[2] * m0.z, hv[3] + xv[3] * m0.w);
      w[2] = pack2(hv[4] + xv[4] * m1.x, hv[5] + xv[5] * m1.y); w[3] = pack2(hv[6] + xv[6] * m1.z, hv[7] + xv[7] * m1.w);
      *(u32x4*)(XS + (size_t)m * SLOT_ELEMS + o) = w;
    }
  }
}

DI void phase_cache_copy(const P& p) {
  bf16_t* Kb = (bf16_t*)(p.ws + WS_SLOT) + 4 * SLOT_ELEMS; bf16_t* Vt = Kb + SLOT_ELEMS / 2;
  for (int e = blockIdx.x * NT + otid(); e < 262144; e += gridDim.x * NT) {
    const int c = e & 255, pp = (e >> 8) & 255, b = e >> 16; const int kvh = c >> 6, d = c & 63;
    Kb[((size_t)b * 4352 + 4096 + pp) * 256 + c] = (bf16_t)f2bf(p.in[3][e]);
    Vt[((size_t)(b * 4 + kvh) * 64 + d) * 4352 + 4096 + pp] = (bf16_t)f2bf(p.in[4][e]);
  }
}

template <int SHIFT> DI void ld_half(const bf16_t* __restrict__ A, int t, int k, int Lmask, u32x4 (&raw)[4]) {
  raw[1] = *(const u32x4*)(A + (size_t)t * 1024 + k);
  raw[2] = *(const u32x4*)(A + (size_t)(t + 1) * 1024 + k);
  if (SHIFT) {
    raw[0] = (u32x4){0u, 0u, 0u, 0u}; raw[3] = (u32x4){0u, 0u, 0u, 0u};
    if ((t & Lmask) != 0) raw[0] = *(const u32x4*)(A + (size_t)(t - 1) * 1024 + k);
    if (((t + 1) & Lmask) != Lmask) raw[3] = *(const u32x4*)(A + (size_t)(t + 2) * 1024 + k);
  }
}
DI u32x4 mix3(const u32x4& c, const u32x4& pz, const u32x4& nz, const float* smu, int k) {
  const float4 m0 = *(const float4*)(smu + k), m1 = *(const float4*)(smu + k + 4);
  const float mu[8] = {m0.x, m0.y, m0.z, m0.w, m1.x, m1.y, m1.z, m1.w};
  u32x4 o;
#pragma unroll
  for (int i = 0; i < 4; ++i) {
    const float h0 = bflo(c[i]), h1 = bfhi(c[i]);
    const float x0 = h0 + (0.5f * (bflo(pz[i]) + bflo(nz[i])) - h0) * mu[2 * i];
    const float x1 = h1 + (0.5f * (bfhi(pz[i]) + bfhi(nz[i])) - h1) * mu[2 * i + 1];
    o[i] = pack2(x0, x1);
  }
  return o;
}
DI int swz(int row, int c) { return row * 128 + ((c ^ ((row >> 1) & 7)) << 4); }
template <int SHIFT> DI void st_half(unsigned char* base, int row, int c, const u32x4 (&raw)[4], const float* smu, int k) {
  if (!SHIFT) { *(u32x4*)(base + swz(row, c)) = raw[1]; *(u32x4*)(base + swz(row + 1, c)) = raw[2]; }
  else { *(u32x4*)(base + swz(row, c)) = mix3(raw[1], raw[0], raw[2], smu, k); *(u32x4*)(base + swz(row + 1, c)) = mix3(raw[2], raw[1], raw[3], smu, k); }
}

template <int SHIFT, int EPI>
DI void phase_gemm(const P& p, int g, const bf16_t* __restrict__ A, const bf16_t* __restrict__ Bt, int M, int N,
                   const float* __restrict__ mu, int Lmask, bf16_t* __restrict__ dst, int rw, unsigned char* lds, int nt0 = 0) {
  const int tid = otid(), lane = tid & 63, wave = tid >> 6;
  const int wm = wave >> 1, wn = wave & 1, r = lane & 31, h = lane >> 5;
  const int ntn = N >> 7, ntiles = ntn * (M >> 8);
  float* Cs = (float*)lds;
  float* smu = (float*)(lds + 110592);
  for (int tile = blockIdx.x; tile < ntiles; tile += gridDim.x) {
    const int mt = tile / ntn, nt = tile - mt * ntn; const int m0 = mt * 256, n0 = nt * 128;
    f32x16 acc[2][2];
#pragma unroll
    for (int a = 0; a < 2; ++a)
#pragma unroll
      for (int b = 0; b < 2; ++b)
#pragma unroll
        for (int i = 0; i < 16; ++i) acc[a][b][i] = 0.f;
    if (SHIFT) {
      const int ntm = nt + nt0; const float* mup = mu + (ntm < 32 ? (ntm >> 3) : (ntm == 32 ? 4 : 5)) * 1024;
      smu[tid] = mup[tid]; smu[tid + 512] = mup[tid + 512];
      __syncthreads();
    }
    if (!SHIFT) {
      u32x4 s0[6], s1[6];
      const int lrow = tid >> 3, lkc = (tid & 7) * 8;
#define G_LOAD(S, K0)  { _Pragma("unroll") for (int i = 0; i < 4; ++i) S[i] = *(const u32x4*)(A + (size_t)(m0 + lrow + 64 * i) * 1024 + (K0) + lkc); \
                         _Pragma("unroll") for (int i = 0; i < 2; ++i) S[4 + i] = *(const u32x4*)(Bt + (size_t)(n0 + lrow + 64 * i) * 1024 + (K0) + lkc); }
#define G_STORE(S, BUF) { _Pragma("unroll") for (int i = 0; i < 4; ++i) *(u32x4*)((BUF) + swz(lrow + 64 * i, tid & 7)) = S[i]; \
                          _Pragma("unroll") for (int i = 0; i < 2; ++i) *(u32x4*)((BUF) + 32768 + swz(lrow + 64 * i, tid & 7)) = S[4 + i]; }
#define G_COMPUTE(BUF) { _Pragma("unroll") for (int ks = 0; ks < 4; ++ks) { const int kc_ = ks * 2 + h; \
        const bf16x8 a0 = *(const bf16x8*)((BUF) + swz(wm * 64 + r, kc_)); const bf16x8 a1 = *(const bf16x8*)((BUF) + swz(wm * 64 + 32 + r, kc_)); \
        const bf16x8 b0 = *(const bf16x8*)((BUF) + 32768 + swz(wn * 64 + r, kc_)); const bf16x8 b1 = *(const bf16x8*)((BUF) + 32768 + swz(wn * 64 + 32 + r, kc_)); \
        acc[0][0] = MFMA32(a0, b0, acc[0][0]); acc[0][1] = MFMA32(a0, b1, acc[0][1]); acc[1][0] = MFMA32(a1, b0, acc[1][0]); acc[1][1] = MFMA32(a1, b1, acc[1][1]); } }
      G_LOAD(s0, 0) G_STORE(s0, lds)
      G_LOAD(s0, 64) G_LOAD(s1, 128)
      __syncthreads();
      for (int kt = 0; kt < 16; kt += 2) {
        G_COMPUTE(lds)
        G_STORE(s0, lds + 49152)
        if (kt + 3 < 16) G_LOAD(s0, (kt + 3) * 64)
        __syncthreads();
        G_COMPUTE(lds + 49152)
        if (kt + 2 < 16) G_STORE(s1, lds)
        if (kt + 4 < 16) G_LOAD(s1, (kt + 4) * 64)
        __syncthreads();
      }
#undef G_LOAD
#undef G_STORE
#undef G_COMPUTE
    } else {
    u32x4 raw[4], raw2[4], rb[2];
    const int arow = 4 * (tid >> 3), akc = (tid & 7) * 8;
#pragma unroll
    for (int hf = 0; hf < 2; ++hf) { ld_half<SHIFT>(A, m0 + arow + 2 * hf, akc, Lmask, raw); st_half<SHIFT>(lds, arow + 2 * hf, tid & 7, raw, smu, akc); }
#pragma unroll
    for (int i = 0; i < 2; ++i) { const int id = tid + 512 * i; rb[i] = *(const u32x4*)(Bt + (size_t)(n0 + (id >> 3)) * 1024 + (id & 7) * 8); }
#pragma unroll
    for (int i = 0; i < 2; ++i) { const int id = tid + 512 * i; *(u32x4*)(lds + 32768 + swz(id >> 3, id & 7)) = rb[i]; }
    __syncthreads();
    for (int kt = 0; kt < 16; ++kt) {
      unsigned char* cur = lds + (kt & 1) * 49152; unsigned char* nxt = lds + ((kt + 1) & 1) * 49152;
      const int k1 = (kt + 1) * 64;
      if (kt < 15) {
        ld_half<SHIFT>(A, m0 + arow, k1 + akc, Lmask, raw);
        ld_half<SHIFT>(A, m0 + arow + 2, k1 + akc, Lmask, raw2);
#pragma unroll
        for (int i = 0; i < 2; ++i) { const int id = tid + 512 * i; rb[i] = *(const u32x4*)(Bt + (size_t)(n0 + (id >> 3)) * 1024 + k1 + (id & 7) * 8); }
      }
#pragma unroll
      for (int ks = 0; ks < 4; ++ks) {
        const int kc_ = ks * 2 + h;
        const bf16x8 a0 = *(const bf16x8*)(cur + swz(wm * 64 + r, kc_));
        const bf16x8 a1 = *(const bf16x8*)(cur + swz(wm * 64 + 32 + r, kc_));
        const bf16x8 b0 = *(const bf16x8*)(cur + 32768 + swz(wn * 64 + r, kc_));
        const bf16x8 b1 = *(const bf16x8*)(cur + 32768 + swz(wn * 64 + 32 + r, kc_));
        acc[0][0] = MFMA32(a0, b0, acc[0][0]); acc[0][1] = MFMA32(a0, b1, acc[0][1]);
        acc[1][0] = MFMA32(a1, b0, acc[1][0]); acc[1][1] = MFMA32(a1, b1, acc[1][1]);
      }
      if (kt < 15) {
        st_half<SHIFT>(nxt, arow, tid & 7, raw, smu, k1 + akc);
        st_half<SHIFT>(nxt, arow + 2, tid & 7, raw2, smu, k1 + akc);
#pragma unroll
        for (int i = 0; i < 2; ++i) { const int id = tid + 512 * i; *(u32x4*)(nxt + 32768 + swz(id >> 3, id & 7)) = rb[i]; }
      }
      __syncthreads();
    }
    }
#pragma unroll
    for (int mi = 0; mi < 2; ++mi)
#pragma unroll
      for (int ni = 0; ni < 2; ++ni)
#pragma unroll
        for (int i = 0; i < 16; ++i) {
          const int row = wm * 64 + mi * 32 + (i & 3) + 8 * (i >> 2) + 4 * h, col = wn * 64 + ni * 32 + r;
          Cs[row * 132 + col] = acc[mi][ni][i];
        }
    __syncthreads();
    if (EPI == 0) {
#pragma unroll
      for (int i = 0; i < 8; ++i) {
        const int id = tid + 512 * i, row = id >> 4, cc = (id & 15) * 8;
        float4 v0 = *(const float4*)(Cs + row * 132 + cc), v1 = *(const float4*)(Cs + row * 132 + cc + 4);
        if (rw && nt + nt0 == 32) { v0.x = tanhf(v0.x); v0.y = tanhf(v0.y); v0.z = tanhf(v0.z); v0.w = tanhf(v0.w); v1.x = tanhf(v1.x); v1.y = tanhf(v1.y); v1.z = tanhf(v1.z); v1.w = tanhf(v1.w); }
        u32x4 o; o[0] = pack2(v0.x, v0.y); o[1] = pack2(v0.z, v0.w); o[2] = pack2(v1.x, v1.y); o[3] = pack2(v1.z, v1.w);
        if (rw && nt + nt0 >= 32) *(u32x4*)((bf16_t*)(p.ws + WS_HID) + (size_t)(m0 + row) * 256 + (nt + nt0 - 32) * 128 + cc) = o;
        else *(u32x4*)(dst + (size_t)(nt >> 3) * SLOT_ELEMS + (size_t)(m0 + row) * 1024 + (nt & 7) * 128 + cc) = o;
      }
    } else {
      const int row = tid & 255, hh = tid >> 8; const int t = m0 + row;
      float x[64];
#pragma unroll
      for (int q = 0; q < 16; ++q) { const float4 v = *(const float4*)(Cs + row * 132 + hh * 64 + 4 * q); x[4 * q] = v.x; x[4 * q + 1] = v.y; x[4 * q + 2] = v.z; x[4 * q + 3] = v.w; }
      bf16_t* slots = (bf16_t*)(p.ws + WS_SLOT);
      const int L = g ? 4096 : 256, Ltot = g ? 4352 : 256;
      const int b = g ? (t >> 12) : (t >> 8), s = t & (L - 1);
      if (nt < 10) {
        int vz = 0; asm volatile("" : "+v"(vz));
        const float* nw = (nt < 8 ? p.in[26] : p.in[27]) + vz;
        float ss = 0.f;
#pragma unroll
        for (int d = 0; d < 64; ++d) ss += x[d] * x[d];
        const float rs = rsqrtf(ss * (1.f / 64.f) + 1e-6f);
#pragma unroll
        for (int d = 0; d < 64; ++d) x[d] *= rs * nw[d];
        if (g == 0 && nt >= 8) {
          float* ck = p.out + OUT_CK + (size_t)t * 256 + ((nt - 8) * 2 + hh) * 64;
#pragma unroll
          for (int q = 0; q < 16; ++q) *(float4*)(ck + 4 * q) = make_float4(x[4 * q], x[4 * q + 1], x[4 * q + 2], x[4 * q + 3]);
        }
        if (g == 1) {
          const float2* rope = (const float2*)(p.ws + WS_ROPE);
          const int ri = s >> 6, ci = s & 63;
#pragma unroll
          for (int f = 0; f < 16; ++f) {
            const float2 cr = rope[ri * 16 + f]; const float x1 = x[f], x2 = x[16 + f];
            x[f] = x1 * cr.x - x2 * cr.y; x[16 + f] = x2 * cr.x + x1 * cr.y;
            const float2 cc = rope[ci * 16 + f]; const float y1 = x[32 + f], y2 = x[48 + f];
            x[32 + f] = y1 * cc.x - y2 * cc.y; x[48 + f] = y2 * cc.x + y1 * cc.y;
          }
        }
        bf16_t* dq = nt < 8 ? slots + 2 * SLOT_ELEMS + (size_t)t * 1024 + (nt * 2 + hh) * 64
                            : slots + 4 * SLOT_ELEMS + ((size_t)b * Ltot + s) * 256 + ((nt - 8) * 2 + hh) * 64;
#pragma unroll
        for (int q = 0; q < 8; ++q) { u32x4 o; o[0] = pack2(x[8 * q], x[8 * q + 1]); o[1] = pack2(x[8 * q + 2], x[8 * q + 3]); o[2] = pack2(x[8 * q + 4], x[8 * q + 5]); o[3] = pack2(x[8 * q + 6], x[8 * q + 7]); *(u32x4*)(dq + 8 * q) = o; }
      } else if (nt < 12) {
        const int kvh = (nt - 10) * 2 + hh;
        if (g == 0) {
          float* cv = p.out + OUT_CV + (size_t)t * 256 + kvh * 64;
#pragma unroll
          for (int q = 0; q < 16; ++q) *(float4*)(cv + 4 * q) = make_float4(x[4 * q], x[4 * q + 1], x[4 * q + 2], x[4 * q + 3]);
        }
        bf16_t* vt = slots + 4 * SLOT_ELEMS + SLOT_ELEMS / 2 + ((size_t)(b * 4 + kvh) * 64) * Ltot + s;
        { size_t vo = 0;
#pragma unroll
        for (int d = 0; d < 64; ++d) { vt[vo] = (bf16_t)f2bf(x[d]); vo += Ltot; asm volatile("" : "+v"(vo)); } }
      } else {
        bf16_t* dg = slots + 3 * SLOT_ELEMS + (size_t)t * 1024 + (nt - 12) * 128 + hh * 64;
#pragma unroll
        for (int q = 0; q < 8; ++q) { u32x4 o; o[0] = pack2(x[8 * q], x[8 * q + 1]); o[1] = pack2(x[8 * q + 2], x[8 * q + 3]); o[2] = pack2(x[8 * q + 4], x[8 * q + 5]); o[3] = pack2(x[8 * q + 6], x[8 * q + 7]); *(u32x4*)(dg + 8 * q) = o; }
      }
    }
    __syncthreads();
  }
}

DI u32x4 cat8(const u32x2 lo, const u32x2 hi) { u32x4 v; v[0] = lo[0]; v[1] = lo[1]; v[2] = hi[0]; v[3] = hi[1]; return v; }
DI void phase_scan(const P& p, int g, int jl, unsigned char* lds) {
  const int tid = otid(), lane = tid & 63, wave = tid >> 6, r = lane & 31, h = lane >> 5;
  const int L = g ? 4096 : 256, B = g ? 4 : 32, nsc = L >> 5;
  float* sR = (float*)lds; float* sW = sR + 2048; float* sKD = sW + 2048; float* sKK = sKD + 2048; float* sKKA = sKK + 2048;
  bf16_t* sHW = (bf16_t*)(lds + 40960); bf16_t* sHA = (bf16_t*)(lds + 45568);
  bf16_t* oAL = (bf16_t*)(lds + 50176); bf16_t* oRH = (bf16_t*)(lds + 54784); bf16_t* oBE = (bf16_t*)(lds + 59392); bf16_t* oGA = (bf16_t*)(lds + 64000);
  bf16_t* oBEt = (bf16_t*)(lds + 68608); bf16_t* oGAt = (bf16_t*)(lds + 73728); bf16_t* oUt = (bf16_t*)(lds + 78848); bf16_t* oZt = (bf16_t*)(lds + 83968);
  float* Bm = (float*)(lds + 89088); float* RHS = (float*)(lds + 93696); float* lamC = (float*)(lds + 101888); float* sP = (float*)(lds + 102144);
  unsigned char* frag = lds + 104192;
  const bf16_t* slots = (const bf16_t*)(p.ws + WS_SLOT);
  const bf16_t* Rg = slots + 1 * SLOT_ELEMS; const bf16_t* Kg = slots + 0 * SLOT_ELEMS; const bf16_t* Vg = slots + 2 * SLOT_ELEMS;
  const bf16_t* hid = (const bf16_t*)(p.ws + WS_HID);
  float* bon = (float*)(p.ws + WS_BON);
  const int ntasks = B * 32;
  for (int task = blockIdx.x; task < ntasks; task += gridDim.x) {
    const int z = task & 1, head = (task >> 1) & 15, b = task >> 5;
    bf16_t* Yg = (bf16_t*)(p.ws + WS_SLOT) + (z ? 4 : 5) * SLOT_ELEMS;
    const int mat = (wave >> 1) & 1, ntt = wave & 1;
    unsigned char* lfr = lds + 110336 + (wave & 3) * 4096;
    if (wave >= 4) {
      const float* W2 = (mat ? p.in[18] : p.in[15]) + (size_t)(jl * 2 + z) * 65536 + head * 64 + 32 * ntt + r;
#pragma unroll
      for (int kk = 0; kk < 4; ++kk) { u32x4 pk;
#pragma unroll
        for (int j = 0; j < 4; ++j) pk[j] = pack2(W2[(size_t)(16 * kk + 8 * h + 2 * j) * 1024], W2[(size_t)(16 * kk + 8 * h + 2 * j + 1) * 1024]);
        *(u32x4*)(lfr + (kk * 64 + lane) * 16) = pk; }
    }
    const float bias = (mat ? p.in[16] : p.in[13])[(jl * 2 + z) * 1024 + head * 64 + 32 * ntt + r];
    const float kkc = p.in[19][jl * 1024 + head * 64 + lane], kac = p.in[20][jl * 1024 + head * 64 + lane], rkc = p.in[21][jl * 1024 + head * 64 + lane];
    f32x16 st0, st1;
#pragma unroll
    for (int q = 0; q < 16; ++q) { st0[q] = 0.f; st1[q] = 0.f; }
    const size_t stbase = ((((size_t)(b * 2 + jl) * 2 + z) * 16 + head) * 64 + (32 * (wave & 1) + r)) * 64;
    if (g && wave < 2) {
#pragma unroll
      for (int gq = 0; gq < 4; ++gq) {
        const float4 s0 = *(const float4*)(p.in[2] + stbase + 8 * gq + 4 * h), s1 = *(const float4*)(p.in[2] + stbase + 32 + 8 * gq + 4 * h);
        st0[4 * gq] = s0.x; st0[4 * gq + 1] = s0.y; st0[4 * gq + 2] = s0.z; st0[4 * gq + 3] = s0.w;
        st1[4 * gq] = s1.x; st1[4 * gq + 1] = s1.y; st1[4 * gq + 2] = s1.z; st1[4 * gq + 3] = s1.w;
      }
    }
    u32x4 pre[5];
    const int ht = tid - 256;
#define SCAN_LOAD(sc_)                                                                                    \
    { const int ht2 = otid() - 256;                                                                       \
    _Pragma("unroll") for (int i = 0; i < 5; ++i) {                                                       \
      const int id = ht2 + 256 * i;                                                                       \
      const int arr = id >> 8, s = (id >> 3) & 31, cc = (id & 7) * 8;                                     \
      const int tl = z ? (L - 1 - ((sc_) * 32 + s)) : ((sc_) * 32 + s);                                   \
      const size_t tok = (size_t)b * L + tl;                                                              \
      if (arr < 3) pre[i] = *(const u32x4*)((arr == 0 ? Rg : (arr == 1 ? Kg : Vg)) + tok * 1024 + head * 64 + cc); \
      else pre[i] = *(const u32x4*)(hid + tok * 256 + (arr - 3) * 128 + z * 64 + cc);                     \
    } }
#define NQ(t_) ((((t_) + 3) / 4 + 1) / 2)
#define SOLVE_ROWS(T0, T1)                                                                                \
    _Pragma("unroll") for (int t = (T0); t < (T1); ++t) {                                                 \
      if (t + 2 < 32) {                                                                                   \
        n2rhs = RHo[(t + 2) * 64];                                                                        \
        _Pragma("unroll") for (int q = 0; q < NQ(t + 2); ++q) { const f4v q4 = *(const __attribute__((address_space(3))) f4v*)(Bmo + (t + 2) * 36 + 8 * q); nc8[q] = make_float4(q4[0], q4[1], q4[2], q4[3]); } \
      }                                                                                                   \
      float a0s = crhs * mh, a1s = 0.f;                                                                   \
      _Pragma("unroll") for (int q = 0; q < NQ(t); ++q) {                                                 \
        a0s -= cb[q].x * zv[4 * q]; a1s -= cb[q].y * zv[4 * q + 1]; a0s -= cb[q].z * zv[4 * q + 2]; a1s -= cb[q].w * zv[4 * q + 3]; } \
      float zt = xhalf_sum(a0s + a1s);                                                                    \
      asm volatile("" : "+v"(zt) :: "memory");                                                            \
      zv[4 * (t >> 3) + (t & 3)] = ((((t >> 2) & 1) == h)) ? zt : zv[4 * (t >> 3) + (t & 3)];             \
      crhs = nrhs; nrhs = n2rhs;                                                                          \
      _Pragma("unroll") for (int q = 0; q < 4; ++q) { cb[q] = nb8[q]; nb8[q] = nc8[q]; }                  \
    }
    typedef float f4v __attribute__((ext_vector_type(4)));
    if (wave >= 4) { SCAN_LOAD(0) }
    for (int sc = -1; sc < nsc; ++sc) {
      const bool st_on = sc >= 0, hl_on = sc + 1 < nsc;
      bf16_t* oUc = (bf16_t*)(lds + ((sc & 1) ? 126720 : 78848));
      bf16_t* oUn = (bf16_t*)(lds + ((sc & 1) ? 78848 : 126720));
      f32x16 y0;
      const int vloc = 32 * (wave & 1) + r;
      if (st_on) {
      {
        const int k = lane, tq = wave;
        float wq[4];
#pragma unroll
        for (int j = 0; j < 4; ++j) wq[j] = sW[(4 * tq + j) * 64 + k];
        sP[tq * 64 + k] = (wq[0] * wq[1]) * (wq[2] * wq[3]);
        __syncthreads();
        float lam = 1.f;
#pragma unroll
        for (int q = 0; q < 7; ++q) { const float pq = sP[q * 64 + k]; lam *= (q < tq) ? pq : 1.f; }
        u32x2 bt, gt; float nb[4], gg[4];
#pragma unroll
        for (int j = 0; j < 4; ++j) {
          const int t = 4 * tq + j;
          const float lamp = lam; lam = lamp * wq[j];
          const float inv = __builtin_amdgcn_rcpf(lam);
          const float al = lamp * sKK[t * 64 + k], be = sKKA[t * 64 + k] * inv, ga = sKD[t * 64 + k] * inv, rh = lam * sR[t * 64 + k];
          oAL[t * 72 + k] = (bf16_t)f2bf(al); oRH[t * 72 + k] = (bf16_t)f2bf(rh); oBE[t * 72 + k] = (bf16_t)f2bf(be); oGA[t * 72 + k] = (bf16_t)f2bf(ga);
          nb[j] = -be; gg[j] = ga;
        }
        bt[0] = pack2(nb[0], nb[1]); bt[1] = pack2(nb[2], nb[3]); gt[0] = pack2(gg[0], gg[1]); gt[1] = pack2(gg[2], gg[3]);
        *(u32x2*)(oBEt + k * 40 + 4 * tq) = bt; *(u32x2*)(oGAt + k * 40 + 4 * tq) = gt;
        if (tq == 7) lamC[k] = lam;
      }
      __syncthreads();
      {
      const int tid = otid(), lane = tid & 63, wave = tid >> 6, r = lane & 31, h = lane >> 5; (void)r; (void)h; (void)lane; (void)wave;
      if (wave < 4) {
        const bf16_t* As = (wave & 1) ? oGA : oBE; const bf16_t* Bs = (wave < 2) ? oAL : oRH;
        f32x16 x;
#pragma unroll
        for (int q = 0; q < 16; ++q) x[q] = 0.f;
#pragma unroll
        for (int s = 0; s < 4; ++s) { const bf16x8 a = *(const bf16x8*)(As + r * 72 + 16 * s + 8 * h); const bf16x8 bb = *(const bf16x8*)(Bs + r * 72 + 16 * s + 8 * h); x = MFMA32(a, bb, x); }
#pragma unroll
        for (int q = 0; q < 16; ++q) { const int i = (q & 3) + 8 * (q >> 2) + 4 * h; const bool keep = (wave < 2) ? (i < r) : (i <= r); x[q] = keep ? x[q] : 0.f; }
        if (wave == 0) {
#pragma unroll
          for (int gq = 0; gq < 4; ++gq) *(float4*)(Bm + r * 36 + 8 * gq + 4 * h) = make_float4(x[4 * gq], x[4 * gq + 1], x[4 * gq + 2], x[4 * gq + 3]);
        } else {
          const float sg = (wave == 2) ? -1.f : 1.f;
#pragma unroll
          for (int s = 0; s < 2; ++s) { u32x4 pk;
#pragma unroll
            for (int j = 0; j < 4; ++j) pk[j] = pack2(sg * x[8 * s + 2 * j], sg * x[8 * s + 2 * j + 1]);
            *(u32x4*)(frag + (((wave - 1) * 2 + s) * 64 + lane) * 16) = pk; }
        }
      }
      }
      __syncthreads();
      if (wave < 2) {
        f32x16 a0;
#pragma unroll
        for (int q = 0; q < 16; ++q) a0[q] = 0.f;
#pragma unroll
        for (int kb = 0; kb < 2; ++kb)
#pragma unroll
          for (int s = 0; s < 2; ++s) {
            u32x4 pk;
#pragma unroll
            for (int j = 0; j < 4; ++j) pk[j] = kb ? pack2(st1[8 * s + 2 * j], st1[8 * s + 2 * j + 1]) : pack2(st0[8 * s + 2 * j], st0[8 * s + 2 * j + 1]);
            const bf16x8 sf = __builtin_bit_cast(bf16x8, pk);
            const int ko = 32 * kb + 16 * s + 4 * h;
            const u32x4 aa = cat8(*(const u32x2*)(oAL + r * 72 + ko), *(const u32x2*)(oAL + r * 72 + ko + 8));
            a0 = MFMA32(__builtin_bit_cast(bf16x8, aa), sf, a0);
          }
#pragma unroll
        for (int s = 0; s < 2; ++s) {
          const bf16x8 fg = *(const bf16x8*)(frag + ((0 * 2 + s) * 64 + lane) * 16);
          const u32x4 ub = cat8(*(const u32x2*)(oUc + vloc * 40 + 16 * s + 4 * h), *(const u32x2*)(oUc + vloc * 40 + 16 * s + 4 * h + 8));
          a0 = MFMA32(fg, __builtin_bit_cast(bf16x8, ub), a0);
        }
#pragma unroll
        for (int q = 0; q < 16; ++q) RHS[((q & 3) + 8 * (q >> 2) + 4 * h) * 64 + vloc] = a0[q];
        float* park = (float*)(lds + 131840) + wave * 3072 + lane * 4;
#pragma unroll
        for (int gq = 0; gq < 4; ++gq) {
          *(float4*)(park + gq * 256) = make_float4(st0[4 * gq], st0[4 * gq + 1], st0[4 * gq + 2], st0[4 * gq + 3]);
          *(float4*)(park + 1024 + gq * 256) = make_float4(st1[4 * gq], st1[4 * gq + 1], st1[4 * gq + 2], st1[4 * gq + 3]);
        }
      }
      }
      float zv[16]; float4 cb[4], nb8[4], nc8[4]; float crhs = 0.f, nrhs = 0.f, n2rhs = 0.f;
      const float mh = h ? 0.f : 1.f;
#pragma unroll
      for (int t = 0; t < 16; ++t) zv[t] = 0.f;
#pragma unroll
      for (int q = 0; q < 4; ++q) { cb[q] = make_float4(0.f, 0.f, 0.f, 0.f); nb8[q] = make_float4(0.f, 0.f, 0.f, 0.f); nc8[q] = make_float4(0.f, 0.f, 0.f, 0.f); }
      const __attribute__((address_space(3))) float* Bmo = (const __attribute__((address_space(3))) float*)(unsigned)(unsigned long long)(Bm + 4 * h);
      const __attribute__((address_space(3))) float* RHo = (const __attribute__((address_space(3))) float*)(unsigned)(unsigned long long)(RHS + vloc);
      asm volatile("" : "+v"(Bmo), "+v"(RHo));
      if (wave < 2 && st_on) { crhs = RHo[0]; nrhs = RHo[64]; const f4v q4 = *(const __attribute__((address_space(3))) f4v*)(Bmo + 36); nb8[0] = make_float4(q4[0], q4[1], q4[2], q4[3]); }
      if (wave < 2) { if (st_on) { SOLVE_ROWS(0, 6) } }
      else if (wave >= 4 && hl_on) {
#pragma unroll
        for (int i = 0; i < 5; ++i) {
          const int id = ht + 256 * i; const int arr = id >> 8, s = (id >> 3) & 31, cc = (id & 7) * 8;
          const u32x4 u = pre[i];
          if (arr < 2) { float* d = (arr == 0 ? sR : sKD) + s * 64 + cc;
            *(float4*)d = make_float4(bflo(u[0]), bfhi(u[0]), bflo(u[1]), bfhi(u[1])); *(float4*)(d + 4) = make_float4(bflo(u[2]), bfhi(u[2]), bflo(u[3]), bfhi(u[3])); }
          else if (arr == 2) {
#pragma unroll
            for (int j = 0; j < 4; ++j) { oUn[(cc + 2 * j) * 40 + s] = (bf16_t)(u[j] & 0xffffu); oUn[(cc + 2 * j + 1) * 40 + s] = (bf16_t)(u[j] >> 16); }
          } else *(u32x4*)((arr == 3 ? sHW : sHA) + s * 72 + cc) = u;
        }
        if (sc + 2 < nsc) { SCAN_LOAD(sc + 2) }
      }
      __syncthreads();
      if (wave < 2) { if (st_on) { SOLVE_ROWS(6, 24) } }
      else if (wave < 4) { if (st_on) {
        const float* park = (const float*)(lds + 131840) + (wave - 2) * 3072 + lane * 4;
#pragma unroll
        for (int gq = 0; gq < 4; ++gq) {
          const float4 a = *(const float4*)(park + gq * 256), bq = *(const float4*)(park + 1024 + gq * 256);
          st0[4 * gq] = a.x; st0[4 * gq + 1] = a.y; st0[4 * gq + 2] = a.z; st0[4 * gq + 3] = a.w;
          st1[4 * gq] = bq.x; st1[4 * gq + 1] = bq.y; st1[4 * gq + 2] = bq.z; st1[4 * gq + 3] = bq.w;
        }
#pragma unroll
        for (int q = 0; q < 16; ++q) y0[q] = 0.f;
#pragma unroll
        for (int kb = 0; kb < 2; ++kb)
#pragma unroll
          for (int s = 0; s < 2; ++s) {
            u32x4 pk;
#pragma unroll
            for (int j = 0; j < 4; ++j) pk[j] = kb ? pack2(st1[8 * s + 2 * j], st1[8 * s + 2 * j + 1]) : pack2(st0[8 * s + 2 * j], st0[8 * s + 2 * j + 1]);
            const int ko = 32 * kb + 16 * s + 4 * h;
            const u32x4 ar = cat8(*(const u32x2*)(oRH + r * 72 + ko), *(const u32x2*)(oRH + r * 72 + ko + 8));
            y0 = MFMA32(__builtin_bit_cast(bf16x8, ar), __builtin_bit_cast(bf16x8, pk), y0);
          }
#pragma unroll
        for (int s = 0; s < 2; ++s) {
          const bf16x8 fpg = *(const bf16x8*)(frag + ((2 * 2 + s) * 64 + lane) * 16);
          const u32x4 ub = cat8(*(const u32x2*)(oUc + vloc * 40 + 16 * s + 4 * h), *(const u32x2*)(oUc + vloc * 40 + 16 * s + 4 * h + 8));
          y0 = MFMA32(fpg, __builtin_bit_cast(bf16x8, ub), y0);
        }
      } }
      else if (wave >= 4 && hl_on) {
        f32x16 acc;
#pragma unroll
        for (int i = 0; i < 16; ++i) acc[i] = 0.f;
        const bf16_t* sH = mat ? sHA : sHW;
#pragma unroll
        for (int kk = 0; kk < 4; ++kk) { const bf16x8 a = *(const bf16x8*)(sH + r * 72 + 16 * kk + 8 * h); const bf16x8 bw = *(const bf16x8*)(lfr + (kk * 64 + lane) * 16); acc = MFMA32(a, bw, acc); }
#pragma unroll
        for (int i = 0; i < 16; ++i) {
          const int srow = (i & 3) + 8 * (i >> 2) + 4 * h, c = 32 * ntt + r;
          const float xv = acc[i] + bias;
          const float sg = __builtin_amdgcn_rcpf(1.f + __expf(-xv));
          if (mat == 0) sW[srow * 64 + c] = __expf(-0.60653065971263342f * sg);
          else sKKA[srow * 64 + c] = sg;
        }
      }
      __syncthreads();
      if (wave < 2) { if (st_on) {
        SOLVE_ROWS(24, 32)
#pragma unroll
        for (int q = 0; q < 4; ++q) { u32x2 o; o[0] = pack2(zv[4 * q], zv[4 * q + 1]); o[1] = pack2(zv[4 * q + 2], zv[4 * q + 3]);
          *(u32x2*)(oZt + vloc * 40 + 4 * (2 * q + h)) = o; }
        } }
      else if (wave >= 4 && hl_on) {
#pragma unroll
        for (int i = 0; i < 8; ++i) {
          const int s = (wave - 4) + 4 * i; const int c = lane;
          const float kraw = sKD[s * 64 + c], a = sKKA[s * 64 + c], rr = sR[s * 64 + c];
          const float pk = kraw * kkc; const float ss = wave_sum(pk * pk);
          const float kk = pk * rsqrtf(fmaxf(ss, 1e-24f));
          const float kd = kraw * (1.f + (a - 1.f) * kac);
          const float bs = wave_sum(rr * kd * rkc);
          sKD[s * 64 + c] = kd; sKK[s * 64 + c] = kk; sKKA[s * 64 + c] = kk * a;
          if (c == 0) { const int tl = z ? (L - 1 - ((sc + 1) * 32 + s)) : ((sc + 1) * 32 + s); bon[(((size_t)b * L + tl) * 16 + head) * 2 + z] = bs; }
        }
      }
      __syncthreads();
      if (st_on) {
      {
      const int tid = otid(), lane = tid & 63, wave = tid >> 6, r = lane & 31, h = lane >> 5; (void)r; (void)h; (void)lane; (void)wave;
      if (wave < 2) {
        { const float* park = (const float*)(lds + 131840) + wave * 3072 + lane * 4;
#pragma unroll
          for (int gq = 0; gq < 4; ++gq) {
            const float4 a = *(const float4*)(park + gq * 256), bq = *(const float4*)(park + 1024 + gq * 256);
            st0[4 * gq] = a.x; st0[4 * gq + 1] = a.y; st0[4 * gq + 2] = a.z; st0[4 * gq + 3] = a.w;
            st1[4 * gq] = bq.x; st1[4 * gq + 1] = bq.y; st1[4 * gq + 2] = bq.z; st1[4 * gq + 3] = bq.w;
          } }
#pragma unroll
        for (int s = 0; s < 2; ++s) {
          const bf16x8 ub = *(const bf16x8*)(oUc + vloc * 40 + 16 * s + 8 * h), zb = *(const bf16x8*)(oZt + vloc * 40 + 16 * s + 8 * h);
          const bf16x8 g0 = *(const bf16x8*)(oGAt + r * 40 + 16 * s + 8 * h), g1 = *(const bf16x8*)(oGAt + (32 + r) * 40 + 16 * s + 8 * h);
          const bf16x8 b0 = *(const bf16x8*)(oBEt + r * 40 + 16 * s + 8 * h), b1 = *(const bf16x8*)(oBEt + (32 + r) * 40 + 16 * s + 8 * h);
          st0 = MFMA32(g0, ub, st0); st0 = MFMA32(b0, zb, st0);
          st1 = MFMA32(g1, ub, st1); st1 = MFMA32(b1, zb, st1);
        }
#pragma unroll
        for (int gq = 0; gq < 4; ++gq) {
          const float4 l0 = *(const float4*)(lamC + 8 * gq + 4 * h), l1 = *(const float4*)(lamC + 32 + 8 * gq + 4 * h);
          st0[4 * gq] *= l0.x; st0[4 * gq + 1] *= l0.y; st0[4 * gq + 2] *= l0.z; st0[4 * gq + 3] *= l0.w;
          st1[4 * gq] *= l1.x; st1[4 * gq + 1] *= l1.y; st1[4 * gq + 2] *= l1.z; st1[4 * gq + 3] *= l1.w;
        }
      } else if (wave < 4) {
#pragma unroll
        for (int s = 0; s < 2; ++s) {
          const bf16x8 fpb = *(const bf16x8*)(frag + ((1 * 2 + s) * 64 + lane) * 16);
          const u32x4 z8 = cat8(*(const u32x2*)(oZt + vloc * 40 + 16 * s + 4 * h), *(const u32x2*)(oZt + vloc * 40 + 16 * s + 4 * h + 8));
          y0 = MFMA32(fpb, __builtin_bit_cast(bf16x8, z8), y0);
        }
#pragma unroll
        for (int q = 0; q < 16; ++q) {
          const int t = (q & 3) + 8 * (q >> 2) + 4 * h; const int tl = z ? (L - 1 - (sc * 32 + t)) : (sc * 32 + t);
          Yg[((size_t)b * L + tl) * 1024 + head * 64 + vloc] = (bf16_t)f2bf(y0[q]);
        }
      }
      }
      __syncthreads();
      }
    }
#undef SOLVE_ROWS
#undef SCAN_LOAD
    if (g == 0 && wave < 2) {
#pragma unroll
      for (int gq = 0; gq < 4; ++gq) {
        *(float4*)(p.out + OUT_ST + stbase + 8 * gq + 4 * h) = make_float4(st0[4 * gq], st0[4 * gq + 1], st0[4 * gq + 2], st0[4 * gq + 3]);
        *(float4*)(p.out + OUT_ST + stbase + 32 + 8 * gq + 4 * h) = make_float4(st1[4 * gq], st1[4 * gq + 1], st1[4 * gq + 2], st1[4 * gq + 3]);
      }
    }
    __syncthreads();
  }
}

DI void phase_rwkv_combine(const P& p, int g, int jl) {
  const int T = g ? 16384 : 8192;
  const int tid = otid(); const int lane = tid & 63, wave = tid >> 6;
  bf16_t* slots = (bf16_t*)(p.ws + WS_SLOT);
  const float* bon = (const float*)(p.ws + WS_BON);
  for (int t = blockIdx.x * 8 + wave; t < T; t += gridDim.x * 8) {
    const size_t o = (size_t)t * 1024 + 16 * lane; const int head = lane >> 2;
    float y[16], v[16], gg[16];
#pragma unroll
    for (int q = 0; q < 2; ++q) {
      const u32x4 a = *(const u32x4*)(slots + 5 * SLOT_ELEMS + o + 8 * q), bq = *(const u32x4*)(slots + 4 * SLOT_ELEMS + o + 8 * q);
      const u32x4 vq = *(const u32x4*)(slots + 2 * SLOT_ELEMS + o + 8 * q), gq = *(const u32x4*)(slots + 3 * SLOT_ELEMS + o + 8 * q);
#pragma unroll
      for (int i = 0; i < 4; ++i) { y[8 * q + 2 * i] = bflo(a[i]) + bflo(bq[i]); y[8 * q + 2 * i + 1] = bfhi(a[i]) + bfhi(bq[i]);
        v[8 * q + 2 * i] = bflo(vq[i]); v[8 * q + 2 * i + 1] = bfhi(vq[i]); gg[8 * q + 2 * i] = bflo(gq[i]); gg[8 * q + 2 * i + 1] = bfhi(gq[i]); }
    }
    float s = 0.f;
#pragma unroll
    for (int i = 0; i < 16; ++i) s += y[i];
    const float mean = quad_sum(s) * (1.f / 64.f);
    float vs = 0.f;
#pragma unroll
    for (int i = 0; i < 16; ++i) { const float d = y[i] - mean; vs += d * d; }
    const float rstd = rsqrtf(quad_sum(vs) * (1.f / 64.f) + 64e-5f);
    const float bs = bon[((size_t)t * 16 + head) * 2] + bon[((size_t)t * 16 + head) * 2 + 1];
    const float* gw = p.in[22] + jl * 1024 + 16 * lane; const float* gb = p.in[23] + jl * 1024 + 16 * lane;
    float ov[16];
#pragma unroll
    for (int i = 0; i < 16; ++i) ov[i] = ((y[i] - mean) * rstd * gw[i] + gb[i] + bs * v[i]) * silu(gg[i]);
#pragma unroll
    for (int q = 0; q < 2; ++q) { u32x4 w; w[0] = pack2(ov[8 * q], ov[8 * q + 1]); w[1] = pack2(ov[8 * q + 2], ov[8 * q + 3]); w[2] = pack2(ov[8 * q + 4], ov[8 * q + 5]); w[3] = pack2(ov[8 * q + 6], ov[8 * q + 7]);
      *(u32x4*)(slots + 3 * SLOT_ELEMS + o + 8 * q) = w; }
  }
}

DI void phase_conv(const P& p, int g) {
  const int T = g ? 16384 : 8192, Lmask = g ? 4095 : 255;
  bf16_t* slots = (bf16_t*)(p.ws + WS_SLOT);
  const bf16_t* BG = slots + 2 * SLOT_ELEMS; const bf16_t* CG = slots + 3 * SLOT_ELEMS; const bf16_t* U = slots + 4 * SLOT_ELEMS; const bf16_t* G = slots + 5 * SLOT_ELEMS;
  bf16_t* O = slots;
  for (int e = blockIdx.x * NT + otid(); e < T * 128; e += gridDim.x * NT) {
    const int t = e >> 7, c = (e & 127) * 8; const size_t o = (size_t)t * 1024 + c; const int tl = t & Lmask;
    const u32x4 zz = {0u, 0u, 0u, 0u};
    const u32x4 c1 = *(const u32x4*)(CG + o), u1 = *(const u32x4*)(U + o);
    const u32x4 c0 = tl != 0 ? *(const u32x4*)(CG + o - 1024) : zz, u0 = tl != 0 ? *(const u32x4*)(U + o - 1024) : zz;
    const u32x4 c2 = tl != Lmask ? *(const u32x4*)(CG + o + 1024) : zz, u2 = tl != Lmask ? *(const u32x4*)(U + o + 1024) : zz;
    const u32x4 bg = *(const u32x4*)(BG + o), gg = *(const u32x4*)(G + o);
    const float* cw = p.in[30]; const float* cb = p.in[31];
    u32x4 w;
#pragma unroll
    for (int i = 0; i < 4; ++i) {
      const int ch = c + 2 * i;
      const float lo = bflo(bg[i]) * (cw[ch] * bflo(c0[i]) * bflo(u0[i]) + cw[1024 + ch] * bflo(c1[i]) * bflo(u1[i]) + cw[2048 + ch] * bflo(c2[i]) * bflo(u2[i]) + cb[ch]) * silu(bflo(gg[i]));
      const float hi = bfhi(bg[i]) * (cw[ch + 1] * bfhi(c0[i]) * bfhi(u0[i]) + cw[1024 + ch + 1] * bfhi(c1[i]) * bfhi(u1[i]) + cw[2048 + ch + 1] * bfhi(c2[i]) * bfhi(u2[i]) + cb[ch + 1]) * silu(bfhi(gg[i]));
      w[i] = pack2(lo, hi);
    }
    *(u32x4*)(O + o) = w;
  }
}

DI void phase_attn(const P& p, int g, unsigned char* lds) {
  const int tid = otid(), lane = tid & 63, wave = tid >> 6, r = lane & 31, h = lane >> 5;
  const int L = g ? 4096 : 256, Ltot = g ? 4352 : 256, B = g ? 4 : 32;
  const int nq = L >> 6, ntasks = B * 4 * nq, nkt = Ltot >> 6;
  bf16_t* slots = (bf16_t*)(p.ws + WS_SLOT);
  bf16_t* Q = slots + 2 * SLOT_ELEMS; const bf16_t* G = slots + 3 * SLOT_ELEMS;
  const bf16_t* Kb = slots + 4 * SLOT_ELEMS; const bf16_t* Vt = Kb + SLOT_ELEMS / 2;
  const float SC = 0.125f * 1.4426950408889634f;
  for (int task = blockIdx.x; task < ntasks; task += gridDim.x) {
    const int qt = task % nq, kvh = (task / nq) & 3, b = task / (nq * 4);
    const int head = kvh * 4 + (wave >> 1); const int q0 = qt * 64 + (wave & 1) * 32;
    const size_t tok = (size_t)b * L + q0 + r;
    bf16x8 qf[4];
#pragma unroll
    for (int ds = 0; ds < 4; ++ds) qf[ds] = *(const bf16x8*)(Q + tok * 1024 + head * 64 + ds * 16 + h * 8);
    float m = -1e30f, lsum = 0.f;
    f32x16 O0, O1;
#pragma unroll
    for (int i = 0; i < 16; ++i) { O0[i] = 0.f; O1[i] = 0.f; }
    const int lrow = tid >> 3, lc = (tid & 7) * 8;
    const bf16_t* gK = Kb + ((size_t)b * Ltot + lrow) * 256 + kvh * 64 + lc;
    const bf16_t* gV = Vt + ((size_t)(b * 4 + kvh) * 64 + lrow) * Ltot + lc;
    u32x4 rk = *(const u32x4*)gK, rv = *(const u32x4*)gV;
    *(u32x4*)(lds + lrow * 144 + lc * 2) = rk; *(u32x4*)(lds + 9216 + lrow * 144 + lc * 2) = rv;
    __syncthreads();
    for (int kt = 0; kt < nkt; ++kt) {
      const unsigned char* cur = lds + (kt & 1) * 18432; unsigned char* nxt = lds + ((kt + 1) & 1) * 18432;
      if (kt + 1 < nkt) { rk = *(const u32x4*)(gK + (size_t)(kt + 1) * 64 * 256); rv = *(const u32x4*)(gV + (kt + 1) * 64); }
      f32x16 s0, s1;
#pragma unroll
      for (int i = 0; i < 16; ++i) { s0[i] = 0.f; s1[i] = 0.f; }
#pragma unroll
      for (int ds = 0; ds < 4; ++ds) {
        const bf16x8 a0 = *(const bf16x8*)(cur + r * 144 + (ds * 16 + h * 8) * 2);
        const bf16x8 a1 = *(const bf16x8*)(cur + (32 + r) * 144 + (ds * 16 + h * 8) * 2);
        s0 = MFMA32(a0, qf[ds], s0); s1 = MFMA32(a1, qf[ds], s1);
      }
      float tmax = s0[0];
#pragma unroll
      for (int i = 1; i < 16; ++i) tmax = fmaxf(tmax, s0[i]);
#pragma unroll
      for (int i = 0; i < 16; ++i) tmax = fmaxf(tmax, s1[i]);
      tmax = xhalf_max(tmax);
      const float mnew = fmaxf(m, tmax * SC);
      const float alpha = __builtin_amdgcn_exp2f(m - mnew);
      float ps = 0.f;
#pragma unroll
      for (int i = 0; i < 16; ++i) { s0[i] = __builtin_amdgcn_exp2f(s0[i] * SC - mnew); s1[i] = __builtin_amdgcn_exp2f(s1[i] * SC - mnew); ps += s0[i] + s1[i]; }
      lsum = lsum * alpha + ps; m = mnew;
      if (__builtin_amdgcn_ballot_w64(alpha != 1.f) != 0ull) {
#pragma unroll
        for (int i = 0; i < 16; ++i) { O0[i] *= alpha; O1[i] *= alpha; }
      }
      const unsigned char* vs = cur + 9216;
#pragma unroll
      for (int kb = 0; kb < 2; ++kb)
#pragma unroll
        for (int s = 0; s < 2; ++s) {
          u32x4 pk;
#pragma unroll
          for (int j = 0; j < 4; ++j) pk[j] = kb ? pack2(s1[8 * s + 2 * j], s1[8 * s + 2 * j + 1]) : pack2(s0[8 * s + 2 * j], s0[8 * s + 2 * j + 1]);
          const bf16x8 pf = __builtin_bit_cast(bf16x8, pk);
          const int ko = (32 * kb + 16 * s + 4 * h) * 2;
          { const u32x2 lo = *(const u32x2*)(vs + r * 144 + ko), hi = *(const u32x2*)(vs + r * 144 + ko + 16);
            u32x4 av; av[0] = lo[0]; av[1] = lo[1]; av[2] = hi[0]; av[3] = hi[1];
            O0 = MFMA32(__builtin_bit_cast(bf16x8, av), pf, O0); }
          { const u32x2 lo = *(const u32x2*)(vs + (32 + r) * 144 + ko), hi = *(const u32x2*)(vs + (32 + r) * 144 + ko + 16);
            u32x4 av; av[0] = lo[0]; av[1] = lo[1]; av[2] = hi[0]; av[3] = hi[1];
            O1 = MFMA32(__builtin_bit_cast(bf16x8, av), pf, O1); }
        }
      if (kt + 1 < nkt) { *(u32x4*)(nxt + lrow * 144 + lc * 2) = rk; *(u32x4*)(nxt + 9216 + lrow * 144 + lc * 2) = rv; }
      __syncthreads();
    }
    lsum = xhalf_sum(lsum);
    const float inv = 1.f / lsum;
#pragma unroll
    for (int db = 0; db < 2; ++db)
#pragma unroll
      for (int i4 = 0; i4 < 4; ++i4) {
        const size_t o = tok * 1024 + head * 64 + 32 * db + 8 * i4 + 4 * h;
        const u32x2 gq = *(const u32x2*)(G + o);
        const float v0 = (db ? O1[4 * i4] : O0[4 * i4]) * inv, v1 = (db ? O1[4 * i4 + 1] : O0[4 * i4 + 1]) * inv;
        const float v2 = (db ? O1[4 * i4 + 2] : O0[4 * i4 + 2]) * inv, v3 = (db ? O1[4 * i4 + 3] : O0[4 * i4 + 3]) * inv;
        u32x2 w; w[0] = pack2(v0 * silu(bflo(gq[0])), v1 * silu(bfhi(gq[0]))); w[1] = pack2(v2 * silu(bflo(gq[1])), v3 * silu(bfhi(gq[1])));
        *(u32x2*)(slots + 5 * SLOT_ELEMS + o) = w;
      }
  }
}


namespace pg8 {
#define PG8_LAS __attribute__((address_space(3)))
typedef unsigned short bf16_t;
typedef short bf16x8 __attribute__((ext_vector_type(8)));
typedef float f32x4 __attribute__((ext_vector_type(4)));
typedef unsigned u32x4 __attribute__((ext_vector_type(4)));
constexpr int BM = 256, BK = 64, HALF = 128, HTB = HALF * BK * 2  , STAGE_BYTES = 8 * HTB, NXCD = 8, WGM = 8;

__host__ __device__ __forceinline__ int lds_byte(int r, int c) { const int st = (r >> 4) * 2 + (c >> 5), rr = r & 15, cc = c & 31, ob = rr * 64 + cc * 2; return st * 1024 + (ob ^ (((ob >> 9) & 1) << 5)); }
__host__ __device__ __forceinline__ void stage_rc(int b, int& R, int& C) { const int st = b / 1024, sb = b % 1024, swz = sb ^ (((sb >> 9) & 1) << 5); R = (st >> 1) * 16 + swz / 64; C = (st & 1) * 32 + (swz % 64) / 2; }
__host__ __device__ __forceinline__ int perm32(int rho) { const int n = rho >> 4, i = rho & 15; return 8 * (i >> 2) + 4 * n + (i & 3); }

struct Unit { int pm, pn; };
struct Gemm { const bf16_t* A; const bf16_t* Bt; int M, N, K; };

struct StaticOrder {
    int nM, nN, nwg, G, c;
    __host__ __device__ void init(int M, int N, int G_, int c_) { nM = M / BM; nN = N / BM; nwg = nM * nN; G = G_; c = c_; }
    __host__ __device__ bool next(int i, Unit& u) const {
        const long L = (long)i * G + c; if (L >= nwg) return false;
        int wgid = (int)L; { const int q = nwg / NXCD, r = nwg % NXCD, xcd = wgid % NXCD, off = wgid / NXCD; wgid = (xcd < r ? xcd * (q + 1) : r * (q + 1) + (xcd - r) * q) + off; }
        const int nig = WGM * nN, gid = wgid / nig, fm = gid * WGM, gsz = (nM - fm) < WGM ? (nM - fm) : WGM;
        u.pm = fm + ((wgid % nig) % gsz); u.pn = (wgid % nig) / gsz; return true;
    }
    __device__ __forceinline__ void a_ready(const Unit&) const {}
    __device__ __forceinline__ void done(const Unit&) const {}
};
struct CountedOrder : StaticOrder {
    const unsigned* ready; unsigned need; unsigned* tmo;
    __device__ __forceinline__ void a_ready(const Unit& u) const {
        if (threadIdx.x < 64) {
            const unsigned long long t0 = __builtin_amdgcn_s_memrealtime(); unsigned polls = 0;
            while ((unsigned)__builtin_amdgcn_readfirstlane(__hip_atomic_load(ready + 64 * u.pm, __ATOMIC_RELAXED, __HIP_MEMORY_SCOPE_AGENT)) < need) {
                if ((++polls & 255u) == 0u && __builtin_amdgcn_readfirstlane(__hip_atomic_load(tmo, __ATOMIC_RELAXED, __HIP_MEMORY_SCOPE_AGENT)) != 0u) break;
                if (__builtin_amdgcn_s_memrealtime() - t0 > 2000000ull) {
                    if (threadIdx.x == 0) { unsigned expect = 0u; __hip_atomic_compare_exchange_strong(tmo + 1, &expect, 0x600u | (unsigned)(u.pm & 0xff), __ATOMIC_RELAXED, __ATOMIC_RELAXED, __HIP_MEMORY_SCOPE_AGENT); __hip_atomic_store(tmo, 1u, __ATOMIC_RELAXED, __HIP_MEMORY_SCOPE_AGENT); }
                    break; }
                __builtin_amdgcn_s_sleep(2); }
            __builtin_amdgcn_fence(__ATOMIC_ACQUIRE, "agent");
            asm volatile("s_waitcnt vmcnt(0)" ::: "memory");
        }
#if !defined(BROKEN_HOOK_NO_BARRIER)
        asm volatile("" ::: "memory"); __builtin_amdgcn_s_barrier(); asm volatile("" ::: "memory");
#endif
    }
};

__device__ __forceinline__ unsigned cvt_pk_bf16(float lo, float hi) { unsigned r; asm volatile("v_cvt_pk_bf16_f32 %0, %1, %2" : "=v"(r) : "v"(lo), "v"(hi)); return r; }
typedef float f32x2 __attribute__((ext_vector_type(2)));
__device__ __forceinline__ f32x2 gelu_pk(f32x2 v) {
    const f32x2 av = __builtin_elementwise_abs(v), d = av * 0.2316418882f + 1.0f;
    f32x2 t; t.x = __builtin_amdgcn_rcpf(d.x); t.y = __builtin_amdgcn_rcpf(d.y);
    f32x2 q = t * 0.5307027145f + (-0.7265760135f); q = q * t + 0.7107068705f; q = q * t + (-0.142248368f); q = q * t + 0.127414796f; q = q * t;
    const f32x2 s = (v * v) * (-0.72134752044f);
    f32x2 e; e.x = __builtin_amdgcn_exp2f(s.x); e.y = __builtin_amdgcn_exp2f(s.y);
    const f32x2 m = v * (q * e), r = v - m;
    f32x2 o; o.x = v.x < 0.f ? m.x : r.x; o.y = v.y < 0.f ? m.y : r.y; return o;
}

struct EpiF32 {
    static constexpr bool PERM = false, AFTER_DRAIN = false;
    float* C; int ldc; const float* bias;
    __device__ __forceinline__ void operator()(const f32x4 (&acc)[2][2][4][2], const Unit& u, int wr, int wc, int fr, int fq) const {
        const int row0 = u.pm * BM + wr * 64 + fr, col0 = u.pn * BM + wc * 32 + 4 * fq;
        f32x4 bv[2][2];
#pragma unroll
        for (int bj = 0; bj < 2; ++bj)
#pragma unroll
            for (int n = 0; n < 2; ++n) bv[bj][n] = bias ? *(const f32x4*)(bias + col0 + bj * HALF + n * 16) : (f32x4){0.f, 0.f, 0.f, 0.f};
#pragma unroll
        for (int ai = 0; ai < 2; ++ai)
#pragma unroll
            for (int m = 0; m < 4; ++m) { float* rowp = C + (size_t)(row0 + ai * HALF + m * 16) * ldc + col0;
#pragma unroll
                for (int bj = 0; bj < 2; ++bj)
#pragma unroll
                    for (int n = 0; n < 2; ++n) *(f32x4*)(rowp + bj * HALF + n * 16) = acc[ai][bj][m][n] + bv[bj][n]; }
    }
};
template <int ACT  > struct EpiBf16 {
    static constexpr bool PERM = true, AFTER_DRAIN = false;
    bf16_t* O; int ldc; const float* bias; int split_cols; size_t split_stride;
    __device__ __forceinline__ void operator()(const f32x4 (&acc)[2][2][4][2], const Unit& u, int wr, int wc, int fr, int fq) const {
        const int row0 = u.pm * BM + wr * 64 + fr; int colt = u.pn * BM; bf16_t* base = O;
        if (split_cols) { const int t = colt / split_cols; base += (size_t)t * split_stride; colt -= t * split_cols; }
        const int col0 = colt + wc * 32 + 8 * fq, bcol0 = u.pn * BM + wc * 32 + 8 * fq;
        f32x4 bv[2][2];
#pragma unroll
        for (int bj = 0; bj < 2; ++bj)
#pragma unroll
            for (int n = 0; n < 2; ++n) bv[bj][n] = bias ? *(const f32x4*)(bias + bcol0 + bj * HALF + 4 * n) : (f32x4){0.f, 0.f, 0.f, 0.f};
#pragma unroll
        for (int ai = 0; ai < 2; ++ai)
#pragma unroll
            for (int m = 0; m < 4; ++m) { bf16_t* rowp = base + (size_t)(row0 + ai * HALF + m * 16) * ldc + col0;
#pragma unroll
                for (int bj = 0; bj < 2; ++bj) { f32x4 v0 = acc[ai][bj][m][0] + bv[bj][0], v1 = acc[ai][bj][m][1] + bv[bj][1];
                    if (ACT == 1) { f32x2 a = gelu_pk((f32x2){v0[0], v0[1]}), b = gelu_pk((f32x2){v0[2], v0[3]}), c = gelu_pk((f32x2){v1[0], v1[1]}), d = gelu_pk((f32x2){v1[2], v1[3]});
                        v0 = (f32x4){a.x, a.y, b.x, b.y}; v1 = (f32x4){c.x, c.y, d.x, d.y}; }
                    if (ACT == 2) {
#pragma unroll
                        for (int j = 0; j < 4; ++j) { v0[j] = 0.5f * v0[j] * (1.0f + erff(v0[j] * 0.70710678f)); v1[j] = 0.5f * v1[j] * (1.0f + erff(v1[j] * 0.70710678f)); } }
                    u32x4 w; w.x = cvt_pk_bf16(v0[0], v0[1]); w.y = cvt_pk_bf16(v0[2], v0[3]); w.z = cvt_pk_bf16(v1[0], v1[1]); w.w = cvt_pk_bf16(v1[2], v1[3]);
                    *(u32x4*)(rowp + bj * HALF) = w; } }
    }
};

struct PanelStats {
    unsigned* xbuf;
    unsigned* cnt;
    unsigned* tmo;
    int ntn; float eps;
    unsigned code;
    __device__ __forceinline__ bool run(const f32x4 (&v)[2][2][4][2], const Unit& u, int wr, int wc, int fr, int fq, PG8_LAS unsigned char* lds, int wid, int lane) const {
        typedef float f32x2v __attribute__((ext_vector_type(2)));
        PG8_LAS f32x2v* P = (PG8_LAS f32x2v*)lds;
        PG8_LAS f32x2v* S = (PG8_LAS f32x2v*)(lds + 8192);
        PG8_LAS unsigned* flag = (PG8_LAS unsigned*)(lds + 8192 + 2048);
#pragma unroll
        for (int ai = 0; ai < 2; ++ai)
#pragma unroll
            for (int m = 0; m < 4; ++m) {
                float s = 0.f;
#pragma unroll
                for (int bj = 0; bj < 2; ++bj)
#pragma unroll
                    for (int n = 0; n < 2; ++n) { const f32x4 x = v[ai][bj][m][n]; s += (x[0] + x[1]) + (x[2] + x[3]); }
                s += __shfl_xor(s, 16); s += __shfl_xor(s, 32);
                const float mw = s * (1.0f / 64.0f); float q = 0.f;
#pragma unroll
                for (int bj = 0; bj < 2; ++bj)
#pragma unroll
                    for (int n = 0; n < 2; ++n) { const f32x4 d = v[ai][bj][m][n] - mw; q += (d[0] * d[0] + d[1] * d[1]) + (d[2] * d[2] + d[3] * d[3]); }
                q += __shfl_xor(q, 16); q += __shfl_xor(q, 32);
                if (fq == 0) P[(ai * HALF + wr * 64 + m * 16 + fr) * 4 + wc] = (f32x2v){mw, q};
            }
        asm volatile("s_waitcnt lgkmcnt(0)" ::: "memory"); __builtin_amdgcn_s_barrier(); asm volatile("" ::: "memory");
#if defined(BROKEN_NO_WAIT)
        if (blockIdx.x >= 64) { const long long t0 = clock64(); while (clock64() - t0 < 60000) __builtin_amdgcn_s_sleep(8); }
#endif
        const int row = wid * 32 + (lane & 31);
        if (lane < 32) {
            const f32x2v a = P[row * 4 + 0], b = P[row * 4 + 1], c = P[row * 4 + 2], d = P[row * 4 + 3];
            const float mt = (a.x + b.x + c.x + d.x) * 0.25f;
            const float da = a.x - mt, db = b.x - mt, dc = c.x - mt, dd = d.x - mt;
            const float m2 = (a.y + b.y) + (c.y + d.y) + 64.0f * ((da * da + db * db) + (dc * dc + dd * dd));
            unsigned long long* slot = (unsigned long long*)xbuf + ((size_t)(u.pm * BM + row) * 4 + u.pn);
            __hip_atomic_store(slot, ((unsigned long long)__float_as_uint(m2) << 32) | __float_as_uint(mt), __ATOMIC_RELAXED, __HIP_MEMORY_SCOPE_AGENT);
        }
        asm volatile("s_waitcnt vmcnt(0)" ::: "memory");
        if (lane == 0) __hip_atomic_fetch_add(cnt + 64 * u.pm, 1u, __ATOMIC_RELAXED, __HIP_MEMORY_SCOPE_AGENT);
        if (wid == 0) {
            bool dead = false; const unsigned long long t0 = __builtin_amdgcn_s_memrealtime(); const unsigned want = 8u * (unsigned)ntn;
            for (;;) {
#if defined(BROKEN_NO_WAIT)
                break;
#endif
                if ((unsigned)__builtin_amdgcn_readfirstlane(__hip_atomic_load(cnt + 64 * u.pm, __ATOMIC_RELAXED, __HIP_MEMORY_SCOPE_AGENT)) >= want) break;
                if (__builtin_amdgcn_s_memrealtime() - t0 > 2000000ull) {
                    if (lane == 0) { unsigned expect = 0u; __hip_atomic_compare_exchange_strong(tmo + 1, &expect, code | (unsigned)(u.pm & 0xff), __ATOMIC_RELAXED, __ATOMIC_RELAXED, __HIP_MEMORY_SCOPE_AGENT);
                                     __hip_atomic_store(tmo, 1u, __ATOMIC_RELAXED, __HIP_MEMORY_SCOPE_AGENT); }
                    dead = true; break; }
                __builtin_amdgcn_s_sleep(2);
            }
            __builtin_amdgcn_fence(__ATOMIC_ACQUIRE, "agent");
            if (lane == 0) flag[0] = dead ? 1u : 0u;
        }
        asm volatile("s_waitcnt vmcnt(0) lgkmcnt(0)" ::: "memory"); __builtin_amdgcn_s_barrier(); asm volatile("" ::: "memory");
        const bool bad = flag[0] != 0u;
        if (lane < 32) {
            const unsigned long long* slot = (const unsigned long long*)xbuf + (size_t)(u.pm * BM + row) * 4; float mt[4], m2[4]; float ms = 0.f;
#pragma unroll
            for (int t = 0; t < 4; ++t) { if (t < ntn) { const unsigned long long w = __hip_atomic_load(slot + t, __ATOMIC_RELAXED, __HIP_MEMORY_SCOPE_AGENT); mt[t] = __uint_as_float((unsigned)w); m2[t] = __uint_as_float((unsigned)(w >> 32)); } else { mt[t] = 0.f; m2[t] = 0.f; } ms += mt[t]; }
            const float mean = ms / (float)ntn; float q = 0.f;
#pragma unroll
            for (int t = 0; t < 4; ++t) if (t < ntn) { const float dm = mt[t] - mean; q += m2[t] + 256.0f * dm * dm; }
            S[row] = (f32x2v){mean, 1.0f / sqrtf(q / (256.0f * (float)ntn) + eps)};
        }
        asm volatile("s_waitcnt lgkmcnt(0)" ::: "memory"); __builtin_amdgcn_s_barrier(); asm volatile("" ::: "memory");
        return bad;
    }
};
struct EpiLnRes {
    static constexpr bool PERM = false, AFTER_DRAIN = true;
    const float* base; float* out; int ldc; const float* bias; PanelStats st; unsigned poison;
    __device__ __forceinline__ void refuse(size_t i0, size_t stride, int M, int N) const { const float q = __builtin_nanf(""); for (size_t i = i0; i < (size_t)M * N; i += stride) out[(i / N) * ldc + i % N] = q;
        if (i0 == 0) { unsigned expect = 0u; __hip_atomic_compare_exchange_strong(st.tmo + 1, &expect, 0x7f0u, __ATOMIC_RELAXED, __ATOMIC_RELAXED, __HIP_MEMORY_SCOPE_AGENT); __hip_atomic_store(st.tmo, 1u, __ATOMIC_RELAXED, __HIP_MEMORY_SCOPE_AGENT); } }
    __device__ __forceinline__ void fused(f32x4 (&acc)[2][2][4][2], const Unit& u, int wr, int wc, int fr, int fq, PG8_LAS unsigned char* lds, int wid, int lane) const {
        typedef float f32x2v __attribute__((ext_vector_type(2)));
        const PG8_LAS f32x2v* S = (const PG8_LAS f32x2v*)(lds + 8192);
        const int col0 = u.pn * BM + wc * 32 + 4 * fq;
#pragma unroll
        for (int bj = 0; bj < 2; ++bj)
#pragma unroll
            for (int n = 0; n < 2; ++n) { const f32x4 bv = bias ? *(const f32x4*)(bias + col0 + bj * HALF + n * 16) : (f32x4){0.f, 0.f, 0.f, 0.f};
#pragma unroll
                for (int ai = 0; ai < 2; ++ai)
#pragma unroll
                    for (int m = 0; m < 4; ++m) acc[ai][bj][m][n] += bv; }
        const bool bad = st.run(acc, u, wr, wc, fr, fq, lds, wid, lane) || poison != 0u;
        const float qnan = __builtin_nanf("");
#pragma unroll
        for (int ai = 0; ai < 2; ++ai)
#pragma unroll
            for (int m = 0; m < 4; ++m) { const int r = ai * HALF + wr * 64 + m * 16 + fr; const f32x2v sr = S[r]; const size_t off = (size_t)(u.pm * BM + r) * ldc + col0;
#pragma unroll
                for (int bj = 0; bj < 2; ++bj)
#pragma unroll
                    for (int n = 0; n < 2; ++n) { const f32x4 bs = *(const f32x4*)(base + off + bj * HALF + n * 16); f32x4 o = bs + (acc[ai][bj][m][n] - sr.x) * sr.y;
                        if (bad) o = (f32x4){qnan, qnan, qnan, qnan}; *(f32x4*)(out + off + bj * HALF + n * 16) = o; }
                asm volatile("" ::: "memory"); }
    }
};
struct EpiLnResLn {
    static constexpr bool PERM = false, AFTER_DRAIN = true;
    const float* base; float* out; bf16_t* xn; int ldc; const float* bias; PanelStats st1, st2; unsigned poison;
    __device__ __forceinline__ void refuse(size_t i0, size_t stride, int M, int N) const { const float q = __builtin_nanf(""); for (size_t i = i0; i < (size_t)M * N; i += stride) { const size_t o = (i / N) * ldc + i % N; out[o] = q; xn[o] = (bf16_t)0x7fc0u; }
        if (i0 == 0) { unsigned expect = 0u; __hip_atomic_compare_exchange_strong(st1.tmo + 1, &expect, 0x7f0u, __ATOMIC_RELAXED, __ATOMIC_RELAXED, __HIP_MEMORY_SCOPE_AGENT); __hip_atomic_store(st1.tmo, 1u, __ATOMIC_RELAXED, __HIP_MEMORY_SCOPE_AGENT); } }
    __device__ __forceinline__ void fused(f32x4 (&acc)[2][2][4][2], const Unit& u, int wr, int wc, int fr, int fq, PG8_LAS unsigned char* lds, int wid, int lane) const {
        typedef float f32x2v __attribute__((ext_vector_type(2))); typedef unsigned u32x2v __attribute__((ext_vector_type(2)));
        const PG8_LAS f32x2v* S = (const PG8_LAS f32x2v*)(lds + 8192);
        const int col0 = u.pn * BM + wc * 32 + 4 * fq;
#pragma unroll
        for (int bj = 0; bj < 2; ++bj)
#pragma unroll
            for (int n = 0; n < 2; ++n) { const f32x4 bv = bias ? *(const f32x4*)(bias + col0 + bj * HALF + n * 16) : (f32x4){0.f, 0.f, 0.f, 0.f};
#pragma unroll
                for (int ai = 0; ai < 2; ++ai)
#pragma unroll
                    for (int m = 0; m < 4; ++m) acc[ai][bj][m][n] += bv; }
        bool bad = st1.run(acc, u, wr, wc, fr, fq, lds, wid, lane) || poison != 0u;
        const float qnan = __builtin_nanf("");
#pragma unroll
        for (int ai = 0; ai < 2; ++ai)
#pragma unroll
            for (int m = 0; m < 4; ++m) { const int r = ai * HALF + wr * 64 + m * 16 + fr; const f32x2v sr = S[r]; const size_t off = (size_t)(u.pm * BM + r) * ldc + col0;
#pragma unroll
                for (int bj = 0; bj < 2; ++bj)
#pragma unroll
                    for (int n = 0; n < 2; ++n) { const f32x4 bs = *(const f32x4*)(base + off + bj * HALF + n * 16); acc[ai][bj][m][n] = bs + (acc[ai][bj][m][n] - sr.x) * sr.y; }
                asm volatile("" : "+v"(acc[ai][0][m][0]), "+v"(acc[ai][0][m][1]), "+v"(acc[ai][1][m][0]), "+v"(acc[ai][1][m][1]));
                if (m & 1) asm volatile("" ::: "memory"); }
        const bool bad1 = bad;
        bad = st2.run(acc, u, wr, wc, fr, fq, lds, wid, lane) || bad;
#pragma unroll
        for (int ai = 0; ai < 2; ++ai)
#pragma unroll
            for (int m = 0; m < 4; ++m) { const int r = ai * HALF + wr * 64 + m * 16 + fr; const f32x2v sr = S[r]; const size_t off = (size_t)(u.pm * BM + r) * ldc + col0;
#pragma unroll
                for (int bj = 0; bj < 2; ++bj)
#pragma unroll
                    for (int n = 0; n < 2; ++n) { const f32x4 x1 = acc[ai][bj][m][n]; *(f32x4*)(out + off + bj * HALF + n * 16) = bad1 ? (f32x4){qnan, qnan, qnan, qnan} : x1;
                        const f32x4 o = (x1 - sr.x) * sr.y; u32x2v w; w.x = cvt_pk_bf16(o[0], o[1]); w.y = cvt_pk_bf16(o[2], o[3]);
                        if (bad) { w.x = 0x7fc07fc0u; w.y = 0x7fc07fc0u; } *(u32x2v*)(xn + off + bj * HALF + n * 16) = w; }
                asm volatile("" ::: "memory"); }
    }
};

template <class Epi, class Sched, bool STAMP = false>
__device__ __forceinline__ void gemm_phase(PG8_LAS unsigned char* lds, const Gemm g, const Sched& S, const Epi& E, unsigned long long* stamps) {
    const int tid = threadIdx.x, wid = __builtin_amdgcn_readfirstlane(tid >> 6), lane = tid & 63, wr = wid >> 2, wc = wid & 3, fr = lane & 15, fq = lane >> 4;
    const int K = g.K, nt = K / BK;
    int ts_lo = 0, ts_hi = 0, nts = 0; const unsigned long long rt_entry = STAMP ? (unsigned long long)wall_clock64() : 0ull;
#define PG8_STAMP() do { if (STAMP && wid == 0 && nts < 64) { const unsigned long long _c = (unsigned long long)clock64(); \
        ts_lo = (lane == nts) ? (int)(unsigned)_c : ts_lo; ts_hi = (lane == nts) ? (int)(unsigned)(_c >> 32) : ts_hi; ++nts; } } while (0)
    PG8_STAMP();
    unsigned voffA[2], voffB[2];
#pragma unroll
    for (int i = 0; i < 2; ++i) { int R, C; stage_rc(tid * 16 + i * 8192, R, C); const int Rb = Epi::PERM ? ((R & ~31) + perm32(R & 31)) : R;
        voffA[i] = (unsigned)(R * K + C) * 2u; voffB[i] = (unsigned)(Rb * K + C) * 2u; }
    const size_t kstep = (size_t)(BK * 2);
    const size_t hstep = (size_t)HALF * K * 2;
    const size_t tstep = 2 * hstep;
    const unsigned ldsw = (unsigned)wid * 1024u;
    const int aoff = lds_byte(wr * 64 + fr, fq * 8), boff = lds_byte(wc * 32 + fr, fq * 8);
#define PG8_SA(b, h) (((b) * 2 + (h)) * HTB)
#define PG8_SB(b, h) ((4 + (b) * 2 + (h)) * HTB)
#define PG8_STAGE(bufoff, gbase, voff) do { _Pragma("unroll") for (int _i = 0; _i < 2; ++_i) \
        __builtin_amdgcn_global_load_lds((const unsigned*)((const char*)(gbase) + (voff)[_i]), (PG8_LAS unsigned*)(lds + (bufoff) + ldsw + _i * 8192), 16, 0, 0); } while (0)
#define PG8_LDA(dst, b, h) do { _Pragma("unroll") for (int m = 0; m < 4; ++m) _Pragma("unroll") for (int k = 0; k < 2; ++k) dst[m][k] = *(const PG8_LAS bf16x8*)(lds + PG8_SA(b, h) + aoff + m * 2048 + k * 1024); } while (0)
#define PG8_LDB(dst, b, h) do { _Pragma("unroll") for (int n = 0; n < 2; ++n) _Pragma("unroll") for (int k = 0; k < 2; ++k) dst[n][k] = *(const PG8_LAS bf16x8*)(lds + PG8_SB(b, h) + boff + n * 2048 + k * 1024); } while (0)
#define PG8_MMA(ai, bj, At, Bt) do { __builtin_amdgcn_s_setprio(1); _Pragma("unroll") for (int m = 0; m < 4; ++m) _Pragma("unroll") for (int n = 0; n < 2; ++n) _Pragma("unroll") for (int k = 0; k < 2; ++k) \
        acc[ai][bj][m][n] = __builtin_amdgcn_mfma_f32_16x16x32_bf16(Bt[n][k], At[m][k], acc[ai][bj][m][n], 0, 0, 0); __builtin_amdgcn_s_setprio(0); } while (0)
#define PG8_WAIT_V(n) asm volatile("s_waitcnt vmcnt(" #n ")" ::: "memory")
#define PG8_WAIT_L(n) asm volatile("s_waitcnt lgkmcnt(" #n ")" ::: "memory")
#define PG8_BAR __builtin_amdgcn_s_barrier()
#define PG8_SCHED __builtin_amdgcn_sched_barrier(0)
    Unit cur, nxt; int ui = 0;
    if (!S.next(0, cur)) return;
    f32x4 acc[2][2][4][2];
#pragma unroll
    for (int a = 0; a < 2; ++a)
#pragma unroll
        for (int b = 0; b < 2; ++b)
#pragma unroll
            for (int m = 0; m < 4; ++m)
#pragma unroll
                for (int n = 0; n < 2; ++n) acc[a][b][m][n] = (f32x4){0.f, 0.f, 0.f, 0.f};
    bf16x8 At[4][2], B0[2][2], B1[2][2];
    const char* cA = (const char*)g.A + (size_t)cur.pm * tstep; const char* cB = (const char*)g.Bt + (size_t)cur.pn * tstep;
    S.a_ready(cur);
    PG8_STAGE(PG8_SB(0, 0), cB, voffB); PG8_STAGE(PG8_SA(0, 0), cA, voffA); PG8_STAGE(PG8_SB(0, 1), cB + hstep, voffB); PG8_STAGE(PG8_SA(0, 1), cA + hstep, voffA);
    if (wr == 1) PG8_BAR;
    PG8_WAIT_V(4); PG8_BAR;
    PG8_STAGE(PG8_SB(1, 0), cB + kstep, voffB); PG8_STAGE(PG8_SA(1, 0), cA + kstep, voffA); PG8_STAGE(PG8_SB(1, 1), cB + hstep + kstep, voffB);
    PG8_WAIT_V(6); PG8_BAR;
    PG8_STAMP();
    for (;;) {
        const bool has_next = S.next(ui + 1, nxt);
        const char* nA = has_next ? (const char*)g.A + (size_t)nxt.pm * tstep : cA; const char* nB = has_next ? (const char*)g.Bt + (size_t)nxt.pn * tstep : cB;
        for (int t = 0; t < nt; t += 2) {
            const bool last = (t == nt - 2);
            const char* a1 = cA + (size_t)(t + 1) * kstep;
            const char* a2 = last ? nA : cA + (size_t)(t + 2) * kstep; const char* b2 = last ? nB : cB + (size_t)(t + 2) * kstep;
            const char* a3 = a2 + kstep; const char* b3 = b2 + kstep;
            if (last && has_next) S.a_ready(nxt);
            PG8_LDB(B0, 0, 0); PG8_SCHED; PG8_LDA(At, 0, 0); PG8_STAGE(PG8_SA(1, 1), a1 + hstep, voffA);
            PG8_WAIT_L(8); PG8_BAR; PG8_WAIT_L(0); PG8_MMA(0, 0, At, B0); PG8_BAR; PG8_SCHED;
            PG8_LDB(B1, 0, 1); PG8_STAGE(PG8_SB(0, 0), b2, voffB);
            PG8_BAR; PG8_WAIT_L(0); PG8_MMA(0, 1, At, B1); PG8_BAR;
            PG8_LDA(At, 0, 1); PG8_STAGE(PG8_SA(0, 0), a2, voffA);
            PG8_BAR; PG8_WAIT_L(0); PG8_MMA(1, 0, At, B0); PG8_BAR; PG8_SCHED;
            PG8_STAGE(PG8_SB(0, 1), b2 + hstep, voffB);
            PG8_WAIT_V(6); PG8_BAR; PG8_MMA(1, 1, At, B1); PG8_BAR;
            PG8_LDB(B0, 1, 0); PG8_SCHED; PG8_LDA(At, 1, 0); PG8_STAGE(PG8_SA(0, 1), a2 + hstep, voffA);
            PG8_WAIT_L(8); PG8_BAR; PG8_WAIT_L(0); PG8_MMA(0, 0, At, B0); PG8_BAR; PG8_SCHED;
            PG8_LDB(B1, 1, 1); PG8_STAGE(PG8_SB(1, 0), b3, voffB);
            PG8_BAR; PG8_WAIT_L(0); PG8_MMA(0, 1, At, B1); PG8_BAR;
            PG8_LDA(At, 1, 1); PG8_STAGE(PG8_SA(1, 0), a3, voffA);
            PG8_BAR; PG8_WAIT_L(0); PG8_MMA(1, 0, At, B0); PG8_BAR; PG8_SCHED;
            PG8_STAGE(PG8_SB(1, 1), b3 + hstep, voffB);
            PG8_WAIT_V(6); PG8_BAR; PG8_MMA(1, 1, At, B1); PG8_BAR;
        }
        PG8_STAMP();
        if constexpr (!Epi::AFTER_DRAIN) { E(acc, cur, wr, wc, fr, fq); S.done(cur); }
        PG8_STAMP();
        if (!has_next) break;
#pragma unroll
        for (int a = 0; a < 2; ++a)
#pragma unroll
            for (int b = 0; b < 2; ++b)
#pragma unroll
                for (int m = 0; m < 4; ++m)
#pragma unroll
                    for (int n = 0; n < 2; ++n) acc[a][b][m][n] = (f32x4){0.f, 0.f, 0.f, 0.f};
        cur = nxt; cA = nA; cB = nB; ++ui;
    }
    PG8_WAIT_V(0);
    if (wr == 0) PG8_BAR;
    PG8_BAR;
    if constexpr (Epi::AFTER_DRAIN) { E.fused(acc, cur, wr, wc, fr, fq, lds, wid, lane); S.done(cur); }
    PG8_STAMP();
    if (STAMP && wid == 0) { stamps[lane] = lane < nts ? (((unsigned long long)(unsigned)ts_hi << 32) | (unsigned)ts_lo) : 0ull;
        if (lane == 62) stamps[62] = rt_entry; if (lane == 63) stamps[63] = (unsigned long long)wall_clock64(); }
#undef PG8_STAMP
#undef PG8_SA
#undef PG8_SB
#undef PG8_STAGE
#undef PG8_LDA
#undef PG8_LDB
#undef PG8_MMA
#undef PG8_WAIT_V
#undef PG8_WAIT_L
#undef PG8_BAR
#undef PG8_SCHED
}
}

#define XB_TMO      128
#define XB_XCNT(j)  (256  + 64 * (j))
#define XB_XSUB(j)  (1280 + 64 * (j))
#define XB_XGEN(j)  (2304 + 64 * (j))
#define XB_TOP      3328
#define XB_TOPGEN   3392
#define XCD_BAR_WORDS 3456
#define XB_SPIN_CAP (1u << 22)
#define LAS __attribute__((address_space(3)))
DI unsigned xb_ld(unsigned* p) { return __hip_atomic_load(p, __ATOMIC_RELAXED, __HIP_MEMORY_SCOPE_AGENT); }
DI unsigned xb_add(unsigned* p, unsigned v) { return __hip_atomic_fetch_add(p, v, __ATOMIC_RELAXED, __HIP_MEMORY_SCOPE_AGENT); }
DI unsigned xb_xcc_id() { return (unsigned)__builtin_amdgcn_s_getreg((3 << 11) | 20) & 0xFu; }
#define XB_SPIN(cond, bar) do { unsigned _sp = 0; while (cond) { __builtin_amdgcn_s_sleep(1); \
    if ((++_sp & 255u) == 0u) { if (xb_ld(&(bar)[XB_TMO])) break; if (_sp > XB_SPIN_CAP) { atomicAdd(&(bar)[XB_TMO], 1u); break; } } } } while (0)
struct XcdBarrier { unsigned* bar; unsigned x; volatile LAS unsigned* st; };
DI XcdBarrier xcd_barrier_post(unsigned* bar, volatile LAS unsigned* st) {
  XcdBarrier b; b.bar = bar; b.x = xb_xcc_id(); b.st = st;
  if (threadIdx.x == 0) (void)xb_add(&bar[XB_XCNT(b.x)], 1u);
  return b;
}
DI void xcd_barrier_complete(unsigned* bar, unsigned x, unsigned& nloc, unsigned& nx) {
  const unsigned G = gridDim.x * gridDim.y * gridDim.z;
  unsigned sum, cnt, mine, sp = 0u;
  for (;;) {
    sum = 0u; cnt = 0u; mine = 0u;
#pragma unroll
    for (unsigned j = 0; j < 16; ++j) { const unsigned c = xb_ld(&bar[XB_XCNT(j)]); sum += c; cnt += (c > 0u) ? 1u : 0u; mine = (j == x) ? c : mine; }
    if (sum == G) break;
    __builtin_amdgcn_s_sleep(1);
    if ((++sp & 255u) == 0u) { if (xb_ld(&bar[XB_TMO])) break; if (sp > XB_SPIN_CAP) { atomicAdd(&bar[XB_TMO], 1u); break; } }
  }
  nloc = mine > 0u ? mine : 1u; nx = cnt > 0u ? cnt : 1u;
}
DI void xcd_barrier(const XcdBarrier& b) {
  asm volatile("s_waitcnt vmcnt(0)" ::: "memory");
  __syncthreads();
  if (threadIdx.x == 0) {
    unsigned* bar = b.bar;
    __builtin_amdgcn_s_waitcnt(0);
    unsigned nloc = b.st[0], nx = b.st[1];
    if (nloc == 0u) { xcd_barrier_complete(bar, b.x, nloc, nx); b.st[0] = nloc; b.st[1] = nx; }
    const unsigned old = xb_add(&bar[XB_XSUB(b.x)], 1u);
    const unsigned gen = old / nloc;
    if (old + 1u == (gen + 1u) * nloc) {
      __builtin_amdgcn_fence(__ATOMIC_RELEASE, "agent");
      asm volatile("s_waitcnt vmcnt(0)" ::: "memory");
      const unsigned og = xb_add(&bar[XB_TOP], 1u);
      const unsigned tg = og / nx;
      if (og + 1u == (tg + 1u) * nx) xb_add(&bar[XB_TOPGEN], 1u);
      else XB_SPIN(xb_ld(&bar[XB_TOPGEN]) == tg, bar);
      __builtin_amdgcn_fence(__ATOMIC_ACQUIRE, "agent");
      xb_add(&bar[XB_XGEN(b.x)], 1u);
      asm volatile("s_waitcnt vmcnt(0)" ::: "memory");
    } else {
      XB_SPIN(xb_ld(&bar[XB_XGEN(b.x)]) == gen, bar);
      __builtin_amdgcn_fence(__ATOMIC_ACQUIRE, "agent");
      asm volatile("s_waitcnt vmcnt(0)" ::: "memory");
    }
  }
  __syncthreads();
}

#define GPTR(T, x) ((T*)(__attribute__((address_space(1))) T*)(x))
__global__ void __launch_bounds__(NT) mega(P p) {
  extern __shared__ __attribute__((aligned(16))) unsigned char lds[];
  cg::grid_group grid = cg::this_grid();
  volatile LAS unsigned* st = (volatile LAS unsigned*)(lds + LDS_BYTES - 16);
  if (threadIdx.x < 4) st[threadIdx.x] = 0u;
  __syncthreads();
  const XcdBarrier xbar = xcd_barrier_post((unsigned*)(p.ws + WS_BAR), st);
  phase0(p, lds);
  grid.sync();
  const P& p0 = p;
  for (int step = 0; step < 70; ++step) {
    const int g = step / 35, rem = step - g * 35, layer = rem / 7, sub = rem - layer * 7;
    const int kind = layer % 3, jl = layer / 3;
    const int T = g ? 16384 : 8192, Lmask = g ? 4095 : 255;
    int op = -1;
    if (layer == 4) op = (sub == 0) ? 0 : -1;
    else if (sub == 0) op = 0;
    else if (kind == 0) op = sub == 1 ? 1 : (sub <= 3 ? 4 : (sub == 4 ? 2 : (sub == 5 ? 3 : 4)));
    else if (kind == 1) op = sub == 1 ? 5 : (sub == 2 ? 6 : (sub == 3 ? 4 : -1));
    else op = sub == 1 ? 4 : (sub == 2 ? 7 : (sub == 3 ? 4 : -1));
    if (op < 0) continue;
    P p = p0;
    { size_t zo_ = 0; asm volatile("" : "+s"(zo_)); p.ws = p0.ws + zo_; p.out = p0.out + zo_; }
    bf16_t* slots = (bf16_t*)(p.ws + WS_SLOT);
    const bf16_t* W = (const bf16_t*)(p.ws + WS_W);
    if (op == 0) {
      const float* xin = p.in[g]; float* xout = p.out + (g ? OUT_YS : OUT_YP);
      phase_norm(p, g, layer - 1, layer < 4 ? layer : -1, layer <= 1 ? xin : xout, xout, slots + SLOT_ELEMS, slots);
      if (kind == 1 && g == 1 && layer < 4) phase_cache_copy(p);
    } else if (op == 1) {
      phase_gemm<1, 0>(p, g, slots, W + (size_t)(RW_IN0 + jl * RW_STRIDE + 4096) * 1024, T, 256, p.in[11] + jl * 6144, Lmask, slots + SLOT_ELEMS, 1, lds, 32);
      phase_xsmix(p, g, jl);
    } else if (op == 2) {
      for (int rep = 0; rep < opq(REP_SCAN); ++rep) phase_scan(p, g, jl, lds);
    } else if (op == 3) {
      phase_rwkv_combine(p, g, jl);
    } else if (op == 4) {
      const int npair = (kind == 0 && sub <= 3) ? 2 : 1;
      for (int q = 0; q < opq(npair); ++q) {
        const bf16_t* A; const bf16_t* Bt; int N; bf16_t* dst;
        if (kind == 0 && sub <= 3) {
          const int m = (sub - 2) * 2 + q; const int ds = m == 0 ? 1 : (m == 1 ? 0 : m);
          A = slots + (size_t)(2 + m) * SLOT_ELEMS; Bt = W + (size_t)(RW_IN0 + jl * RW_STRIDE + m * 1024) * 1024; N = 1024; dst = slots + (size_t)ds * SLOT_ELEMS;
        } else if (kind == 2 && sub == 1) { A = slots; Bt = W + (size_t)CV_IN * 1024; N = 4096; dst = slots + 2 * SLOT_ELEMS; }
        else {
          N = 1024; dst = slots + SLOT_ELEMS;
          if (kind == 0) { A = slots + 3 * SLOT_ELEMS; Bt = W + (size_t)(RW_OUT0 + jl * RW_STRIDE) * 1024; }
          else if (kind == 1) { A = slots + 5 * SLOT_ELEMS; Bt = W + (size_t)AT_OUT * 1024; }
          else { A = slots; Bt = W + (size_t)CV_OUT * 1024; }
        }
        pg8::Gemm gg{A, Bt, T, N, 1024}; pg8::StaticOrder S; S.init(T, N, (int)gridDim.x, (int)((blockIdx.x + 128 * q) & 255));
        pg8::EpiBf16<0> E{dst, 1024, nullptr, N > 1024 ? 1024 : 0, SLOT_ELEMS};
        pg8::gemm_phase<pg8::EpiBf16<0>, pg8::StaticOrder, false>((PG8_LAS unsigned char*)(unsigned)(unsigned long long)lds, gg, S, E, nullptr);
      }
    } else if (op == 5) {
      for (int rep = 0; rep < opq(REP_GEMM); ++rep) phase_gemm<0, 1>(p, g, slots, W + (size_t)AT_IN * 1024, T, 2560, nullptr, 0, nullptr, 0, lds);
    } else if (op == 6) {
      for (int rep = 0; rep < opq(REP_ATTN); ++rep) phase_attn(p, g, lds);
    } else {
      phase_conv(p, g);
    }
    if (!(g == 1 && layer == 4)) for (int rep = 0; rep < opq(REP_SYNC); ++rep) xcd_barrier(xbar);
  }
}

extern "C" void kernel_launch(void* const* d_in, const int* in_sizes, int n_in, void* d_out, int out_size, void* d_ws, size_t ws_size, hipStream_t stream) {
  static int grid_blocks = 0;
  if (!grid_blocks) {
    int dev = 0, cus = 0, per_cu = 0;
    hipGetDevice(&dev);
    hipDeviceGetAttribute(&cus, hipDeviceAttributeMultiprocessorCount, dev);
    hipFuncSetAttribute((const void*)mega, hipFuncAttributeMaxDynamicSharedMemorySize, LDS_BYTES);
    hipOccupancyMaxActiveBlocksPerMultiprocessor(&per_cu, (const void*)mega, NT, LDS_BYTES);
    if (per_cu < 1) per_cu = 1;
    if (per_cu > 1) per_cu = 1;
    grid_blocks = cus * per_cu;
    if (ws_size < WS_SLOT + 6 * SLOT_ELEMS * 2) fprintf(stderr, "workspace too small: %zu\n", ws_size);
  }
  (void)hipMemsetAsync((unsigned char*)d_ws + WS_BAR, 0, XCD_BAR_WORDS * sizeof(unsigned), stream);
  P p{};
  for (int i = 0; i < 33; ++i) p.in[i] = (const float*)d_in[i];
  p.out = (float*)d_out; p.ws = (unsigned char*)d_ws;
  void* args[] = {&p};
  hipError_t e = hipLaunchCooperativeKernel((const void*)mega, dim3(grid_blocks), dim3(NT), args, LDS_BYTES, stream);
  if (e != hipSuccess) fprintf(stderr, "cooperative launch failed: %s (grid %d)\n", hipGetErrorString(e), grid_blocks);
}
```

```cpp
#include <hip/hip_runtime.h>
#include <hip/hip_cooperative_groups.h>
#include <cstdio>
namespace cg = cooperative_groups;

typedef unsigned short bf16_t;
using bf16x8 = __attribute__((ext_vector_type(8))) short;
using f32x16 = __attribute__((ext_vector_type(16))) float;
using u32x4 = __attribute__((ext_vector_type(4))) unsigned;
using u32x2 = __attribute__((ext_vector_type(2))) unsigned;

#define NT 512
#ifndef REP_GEMM
#define REP_GEMM 1
#endif
#ifndef REP_SCAN
#define REP_SCAN 1
#endif
#ifndef REP_ATTN
#define REP_ATTN 1
#endif
#ifndef REP_SYNC
#define REP_SYNC 1
#endif
#define DI __device__ __forceinline__
#define MFMA32(a, b, c) __builtin_amdgcn_mfma_f32_32x32x16_bf16((a), (b), (c), 0, 0, 0)

struct P { const float* in[33]; float* out; unsigned char* ws; };

constexpr size_t WS_ADA = 0;
constexpr size_t WS_ROPE = 262144;
constexpr size_t WS_BON = 327680;
constexpr size_t WS_HID = WS_BON + 2097152;
constexpr size_t WS_W = WS_HID + 8388608;
constexpr size_t WS_SLOT = WS_W + 39845888;
constexpr size_t SLOT_ELEMS = (size_t)16384 * 1024;
constexpr int RW_IN0 = 0, RW_OUT0 = 4352, RW_STRIDE = 5376, AT_IN = 10752, AT_OUT = 13312, CV_IN = 14336, CV_OUT = 18432;
constexpr size_t OUT_YP = 0, OUT_YS = 8388608, OUT_ST = 25165824, OUT_CK = 33554432, OUT_CV = 35651584;
constexpr int LDS_BYTES = 156416 + 16;
constexpr size_t WS_BAR = 278528;

typedef __bf16 bf16x2_t __attribute__((ext_vector_type(2)));
typedef float f32x2_t __attribute__((ext_vector_type(2)));
DI unsigned pack2(float a, float b) { f32x2_t v = {a, b}; return __builtin_bit_cast(unsigned, __builtin_convertvector(v, bf16x2_t)); }
DI unsigned f2bf(float x) { return (unsigned)__builtin_bit_cast(unsigned short, (__bf16)x); }
DI float bflo(unsigned u) { return __uint_as_float(u << 16); }
DI float bfhi(unsigned u) { return __uint_as_float(u & 0xffff0000u); }
DI float bf1(bf16_t u) { return __uint_as_float(((unsigned)u) << 16); }

template <int CTRL> DI float dppf(float v) { return __int_as_float(__builtin_amdgcn_update_dpp(0, __float_as_int(v), CTRL, 0xF, 0xF, true)); }
DI float reduce16(float v) { v += dppf<0xB1>(v); v += dppf<0x4E>(v); v += dppf<0x141>(v); v += dppf<0x140>(v); return v; }
DI float rdl(float v, int l) { return __int_as_float(__builtin_amdgcn_readlane(__float_as_int(v), l)); }
DI float wave_sum(float v) { v = reduce16(v); return (rdl(v, 0) + rdl(v, 16)) + (rdl(v, 32) + rdl(v, 48)); }
DI float xhalf_max(float x) { const auto r2 = __builtin_amdgcn_permlane32_swap(__float_as_uint(x), __float_as_uint(x), false, false); return fmaxf(__uint_as_float(r2[0]), __uint_as_float(r2[1])); }
DI float xhalf_sum(float x) { const auto r2 = __builtin_amdgcn_permlane32_swap(__float_as_uint(x), __float_as_uint(x), false, false); return __uint_as_float(r2[0]) + __uint_as_float(r2[1]); }
DI float quad_sum(float v) { v += dppf<0xB1>(v); v += dppf<0x4E>(v); return v; }
DI float silu(float x) { return x / (1.f + __expf(-x)); }
DI int opq(int v) { asm volatile("" : "+s"(v)); return v; }
DI int otid() { int t = threadIdx.x; asm volatile("" : "+v"(t)); return t; }

DI void conv_tiles(const float* __restrict__ src, int N, bf16_t* __restrict__ dst, float* lds) {
  const int tid = otid();
  const int tilesN = N >> 6, ntiles = 16 * tilesN;
  for (int tile = blockIdx.x; tile < ntiles; tile += gridDim.x) {
    const int kt = tile / tilesN, nt = tile - kt * tilesN, k0 = kt * 64, n0 = nt * 64;
#pragma unroll
    for (int i = 0; i < 8; ++i) { const int k = (tid >> 6) + 8 * i, n = tid & 63; lds[k * 65 + n] = src[(size_t)(k0 + k) * N + n0 + n]; }
    __syncthreads();
    { const int n = tid >> 3, kc = (tid & 7) * 8; u32x4 o;
#pragma unroll
      for (int j = 0; j < 4; ++j) o[j] = pack2(lds[(kc + 2 * j) * 65 + n], lds[(kc + 2 * j + 1) * 65 + n]);
      *(u32x4*)(dst + (size_t)(n0 + n) * 1024 + k0 + kc) = o; }
    __syncthreads();
  }
}

DI void phase0(const P& p, unsigned char* ldsb) {
  float* lds = (float*)ldsb;
  const int tid = otid();
  bf16_t* W = (bf16_t*)(p.ws + WS_W);
#pragma unroll 1
  for (int e = 0; e < opq(22); ++e) {
    const float* src; int N, drow;
    if (e < 18) {
      const int j = e / 9, q = e - j * 9;
      if (q < 4) { src = p.in[12] + (size_t)(j * 4 + q) * 1048576; N = 1024; drow = RW_IN0 + j * RW_STRIDE + q * 1024; }
      else if (q < 6) { src = p.in[14] + (size_t)(j * 2 + q - 4) * 65536; N = 64; drow = RW_IN0 + j * RW_STRIDE + 4096 + (q - 4) * 64; }
      else if (q < 8) { src = p.in[17] + (size_t)(j * 2 + q - 6) * 65536; N = 64; drow = RW_IN0 + j * RW_STRIDE + 4224 + (q - 6) * 64; }
      else { src = p.in[24] + (size_t)j * 1048576; N = 1024; drow = RW_OUT0 + j * RW_STRIDE; }
    } else if (e == 18) { src = p.in[25]; N = 2560; drow = AT_IN; }
    else if (e == 19) { src = p.in[28]; N = 1024; drow = AT_OUT; }
    else if (e == 20) { src = p.in[29]; N = 4096; drow = CV_IN; }
    else { src = p.in[32]; N = 1024; drow = CV_OUT; }
    conv_tiles(src, N, W + (size_t)drow * 1024, lds);
  }
  {
    float* scond = lds;
    float* red = lds + 5120;
    for (int e = tid; e < 5120; e += NT) { const int cnd = e >> 10, k = e & 1023; const float cv = cnd == 0 ? p.in[6][k] : p.in[5][(cnd - 1) * 1024 + k]; scond[e] = silu(cv); }
    __syncthreads();
    float* ada = (float*)(p.ws + WS_ADA);
    for (int task = blockIdx.x; task < 192; task += gridDim.x) {
      const int layer = task / 48, n0 = (task % 48) * 64, c = tid & 63, kg = tid >> 6;
      float a0 = 0.f, a1 = 0.f, a2 = 0.f, a3 = 0.f, a4 = 0.f;
      const float* wp = p.in[9] + ((size_t)layer * 1024 + kg * 128) * 3072 + n0 + c;
#pragma unroll 8
      for (int k = 0; k < 128; ++k) { const float w = wp[(size_t)k * 3072]; const int kk = kg * 128 + k;
        a0 += scond[kk] * w; a1 += scond[1024 + kk] * w; a2 += scond[2048 + kk] * w; a3 += scond[3072 + kk] * w; a4 += scond[4096 + kk] * w; }
      red[(kg * 5 + 0) * 64 + c] = a0; red[(kg * 5 + 1) * 64 + c] = a1; red[(kg * 5 + 2) * 64 + c] = a2; red[(kg * 5 + 3) * 64 + c] = a3; red[(kg * 5 + 4) * 64 + c] = a4;
      __syncthreads();
      if (tid < 320) { const int cnd = tid >> 6; float s = p.in[10][layer * 3072 + n0 + c];
#pragma unroll
        for (int q = 0; q < 8; ++q) s += red[(q * 5 + cnd) * 64 + c];
        ada[(cnd * 4 + layer) * 3072 + n0 + c] = s; }
      __syncthreads();
    }
  }
  if (blockIdx.x == gridDim.x - 1) {
    float* rope = (float*)(p.ws + WS_ROPE);
    for (int e = tid; e < 1024; e += NT) {
      const int pos = e >> 4, f = e & 15;
      double inv = 1.0; for (int q = 0; q < f; ++q) inv *= 0.5623413251903491;
      double ang = (double)pos * inv;
      const double twopi = 6.283185307179586476925286766559;
      double n = __builtin_rint(ang / twopi); double rr = ang - n * twopi;
      double r2 = rr * rr, sn = 0.0, cs = 0.0, ts = rr, tc = 1.0;
      for (int q = 0; q < 16; ++q) { cs += tc; sn += ts; tc = -tc * r2 / (double)((2 * q + 1) * (2 * q + 2)); ts = -ts * r2 / (double)((2 * q + 2) * (2 * q + 3)); }
      rope[e * 2] = (float)cs; rope[e * 2 + 1] = (float)sn;
    }
  }
}

DI void phase_norm(const P& p, int g, int lpost, int lpre, const float* __restrict__ xsrc, float* __restrict__ xdst,
                   const bf16_t* __restrict__ Mb, bf16_t* __restrict__ H) {
  const int T = g ? 16384 : 8192;
  const int tid = otid(); const int lane = tid & 63, wave = tid >> 6;
  const float* ada = (const float*)(p.ws + WS_ADA);
  float4 xn[4]; u32x2 mn[4];
  const int t0 = blockIdx.x * 8 + wave, tstep = gridDim.x * 8;
#pragma unroll
  for (int i = 0; i < 4; ++i) { xn[i] = make_float4(0.f, 0.f, 0.f, 0.f); mn[i] = (u32x2){0u, 0u}; }
  if (t0 < T) {
#pragma unroll
    for (int i = 0; i < 4; ++i) { xn[i] = *(const float4*)(xsrc + (size_t)t0 * 1024 + 256 * i + 4 * lane); if (lpost >= 0) mn[i] = *(const u32x2*)(Mb + (size_t)t0 * 1024 + 256 * i + 4 * lane); }
  }
  for (int t = t0; t < T; t += tstep) {
    const int cond = g ? 1 + (t >> 12) : 0;
    float4 x[4]; u32x2 mr[4];
#pragma unroll
    for (int i = 0; i < 4; ++i) { x[i] = xn[i]; mr[i] = mn[i]; }
    if (t + tstep < T) {
#pragma unroll
      for (int i = 0; i < 4; ++i) { xn[i] = *(const float4*)(xsrc + (size_t)(t + tstep) * 1024 + 256 * i + 4 * lane); if (lpost >= 0) mn[i] = *(const u32x2*)(Mb + (size_t)(t + tstep) * 1024 + 256 * i + 4 * lane); }
    }
    if (lpost >= 0) {
      float m[16]; float ss = 0.f;
#pragma unroll
      for (int i = 0; i < 4; ++i) { const u32x2 u = mr[i];
        m[4 * i] = bflo(u[0]); m[4 * i + 1] = bfhi(u[0]); m[4 * i + 2] = bflo(u[1]); m[4 * i + 3] = bfhi(u[1]); }
#pragma unroll
      for (int i = 0; i < 16; ++i) ss += m[i] * m[i];
      ss = wave_sum(ss);
      const float rs = rsqrtf(ss * (1.f / 1024.f) + 1e-6f);
      const float* gate = ada + (cond * 4 + lpost) * 3072 + 2048;
      const float* wpo = p.in[8] + lpost * 1024;
#pragma unroll
      for (int i = 0; i < 4; ++i) { const int c = 256 * i + 4 * lane; const float4 gt = *(const float4*)(gate + c); const float4 wv = *(const float4*)(wpo + c);
        x[i].x += gt.x * (m[4 * i] * rs * wv.x); x[i].y += gt.y * (m[4 * i + 1] * rs * wv.y); x[i].z += gt.z * (m[4 * i + 2] * rs * wv.z); x[i].w += gt.w * (m[4 * i + 3] * rs * wv.w);
        *(float4*)(xdst + (size_t)t * 1024 + c) = x[i]; }
    }
    if (lpre >= 0) {
      float ss = 0.f;
#pragma unroll
      for (int i = 0; i < 4; ++i) ss += x[i].x * x[i].x + x[i].y * x[i].y + x[i].z * x[i].z + x[i].w * x[i].w;
      ss = wave_sum(ss);
      const float rs = rsqrtf(ss * (1.f / 1024.f) + 1e-6f);
      const float* sh = ada + (cond * 4 + lpre) * 3072; const float* sc = sh + 1024; const float* wpr = p.in[7] + lpre * 1024;
#pragma unroll
      for (int i = 0; i < 4; ++i) { const int c = 256 * i + 4 * lane; const float4 s4 = *(const float4*)(sh + c); const float4 c4 = *(const float4*)(sc + c); const float4 wv = *(const float4*)(wpr + c);
        u32x2 o; o[0] = pack2(x[i].x * rs * wv.x * (1.f + c4.x) + s4.x, x[i].y * rs * wv.y * (1.f + c4.y) + s4.y);
        o[1] = pack2(x[i].z * rs * wv.z * (1.f + c4.z) + s4.z, x[i].w * rs * wv.w * (1.f + c4.w) + s4.w);
        *(u32x2*)(H + (size_t)t * 1024 + c) = o; }
    }
  }
}

DI void phase_xsmix(const P& p, int g, int jl) {
  const int T = g ? 16384 : 8192, Lmask = g ? 4095 : 255;
  const bf16_t* H = (const bf16_t*)(p.ws + WS_SLOT); bf16_t* XS = (bf16_t*)(p.ws + WS_SLOT) + 2 * SLOT_ELEMS;
  const float* mu = p.in[11] + jl * 6144;
  for (int e = blockIdx.x * NT + otid(); e < T * 128; e += gridDim.x * NT) {
    const int t = e >> 7, c = (e & 127) * 8; const size_t o = (size_t)t * 1024 + c; const int tl = t & Lmask;
    const u32x4 zz = {0u, 0u, 0u, 0u};
    const u32x4 hc = *(const u32x4*)(H + o);
    const u32x4 hp = tl != 0 ? *(const u32x4*)(H + o - 1024) : zz, hn = tl != Lmask ? *(const u32x4*)(H + o + 1024) : zz;
    float hv[8], xv[8];
#pragma unroll
    for (int i = 0; i < 4; ++i) { hv[2 * i] = bflo(hc[i]); hv[2 * i + 1] = bfhi(hc[i]);
      xv[2 * i] = 0.5f * (bflo(hp[i]) + bflo(hn[i])) - hv[2 * i]; xv[2 * i + 1] = 0.5f * (bfhi(hp[i]) + bfhi(hn[i])) - hv[2 * i + 1]; }
#pragma unroll
    for (int m = 0; m < 4; ++m) {
      const float4 m0 = *(const float4*)(mu + m * 1024 + c), m1 = *(const float4*)(mu + m * 1024 + c + 4);
      u32x4 w; w[0] = pack2(hv[0] + xv[0] * m0.x, hv[1] + xv[1] * m0.y); w[1] = pack2(hv[2] + xv[2] * m0.z, hv[3] + xv[3] * m0.w);
      w[2] = pack2(hv[4] + xv[4] * m1.x, hv[5] + xv[5] * m1.y); w[3] = pack2(hv[6] + xv[6] * m1.z, hv[7] + xv[7] * m1.w);
      *(u32x4*)(XS + (size_t)m * SLOT_ELEMS + o) = w;
    }
  }
}

DI void phase_cache_copy(const P& p) {
  bf16_t* Kb = (bf16_t*)(p.ws + WS_SLOT) + 4 * SLOT_ELEMS; bf16_t* Vt = Kb + SLOT_ELEMS / 2;
  for (int e = blockIdx.x * NT + otid(); e < 262144; e += gridDim.x * NT) {
    const int c = e & 255, pp = (e >> 8) & 255, b = e >> 16; const int kvh = c >> 6, d = c & 63;
    Kb[((size_t)b * 4352 + 4096 + pp) * 256 + c] = (bf16_t)f2bf(p.in[3][e]);
    Vt[((size_t)(b * 4 + kvh) * 64 + d) * 4352 + 4096 + pp] = (bf16_t)f2bf(p.in[4][e]);
  }
}

template <int SHIFT> DI void ld_half(const bf16_t* __restrict__ A, int t, int k, int Lmask, u32x4 (&raw)[4]) {
  raw[1] = *(const u32x4*)(A + (size_t)t * 1024 + k);
  raw[2] = *(const u32x4*)(A + (size_t)(t + 1) * 1024 + k);
  if (SHIFT) {
    raw[0] = (u32x4){0u, 0u, 0u, 0u}; raw[3] = (u32x4){0u, 0u, 0u, 0u};
    if ((t & Lmask) != 0) raw[0] = *(const u32x4*)(A + (size_t)(t - 1) * 1024 + k);
    if (((t + 1) & Lmask) != Lmask) raw[3] = *(const u32x4*)(A + (size_t)(t + 2) * 1024 + k);
  }
}
DI u32x4 mix3(const u32x4& c, const u32x4& pz, const u32x4& nz, const float* smu, int k) {
  const float4 m0 = *(const float4*)(smu + k), m1 = *(const float4*)(smu + k + 4);
  const float mu[8] = {m0.x, m0.y, m0.z, m0.w, m1.x, m1.y, m1.z, m1.w};
  u32x4 o;
#pragma unroll
  for (int i = 0; i < 4; ++i) {
    const float h0 = bflo(c[i]), h1 = bfhi(c[i]);
    const float x0 = h0 + (0.5f * (bflo(pz[i]) + bflo(nz[i])) - h0) * mu[2 * i];
    const float x1 = h1 + (0.5f * (bfhi(pz[i]) + bfhi(nz[i])) - h1) * mu[2 * i + 1];
    o[i] = pack2(x0, x1);
  }
  return o;
}
DI int swz(int row, int c) { return row * 128 + ((c ^ ((row >> 1) & 7)) << 4); }
template <int SHIFT> DI void st_half(unsigned char* base, int row, int c, const u32x4 (&raw)[4], const float* smu, int k) {
  if (!SHIFT) { *(u32x4*)(base + swz(row, c)) = raw[1]; *(u32x4*)(base + swz(row + 1, c)) = raw[2]; }
  else { *(u32x4*)(base + swz(row, c)) = mix3(raw[1], raw[0], raw[2], smu, k); *(u32x4*)(base + swz(row + 1, c)) = mix3(raw[2], raw[1], raw[3], smu, k); }
}

template <int SHIFT, int EPI>
DI void phase_gemm(const P& p, int g, const bf16_t* __restrict__ A, const bf16_t* __restrict__ Bt, int M, int N,
                   const float* __restrict__ mu, int Lmask, bf16_t* __restrict__ dst, int rw, unsigned char* lds, int nt0 = 0) {
  const int tid = otid(), lane = tid & 63, wave = tid >> 6;
  const int wm = wave >> 1, wn = wave & 1, r = lane & 31, h = lane >> 5;
  const int ntn = N >> 7, ntiles = ntn * (M >> 8);
  float* Cs = (float*)lds;
  float* smu = (float*)(lds + 110592);
  for (int tile = blockIdx.x; tile < ntiles; tile += gridDim.x) {
    const int mt = tile / ntn, nt = tile - mt * ntn; const int m0 = mt * 256, n0 = nt * 128;
    f32x16 acc[2][2];
#pragma unroll
    for (int a = 0; a < 2; ++a)
#pragma unroll
      for (int b = 0; b < 2; ++b)
#pragma unroll
        for (int i = 0; i < 16; ++i) acc[a][b][i] = 0.f;
    if (SHIFT) {
      const int ntm = nt + nt0; const float* mup = mu + (ntm < 32 ? (ntm >> 3) : (ntm == 32 ? 4 : 5)) * 1024;
      smu[tid] = mup[tid]; smu[tid + 512] = mup[tid + 512];
      __syncthreads();
    }
    if (!SHIFT) {
      u32x4 s0[6], s1[6];
      const int lrow = tid >> 3, lkc = (tid & 7) * 8;
#define G_LOAD(S, K0)  { _Pragma("unroll") for (int i = 0; i < 4; ++i) S[i] = *(const u32x4*)(A + (size_t)(m0 + lrow + 64 * i) * 1024 + (K0) + lkc); \
                         _Pragma("unroll") for (int i = 0; i < 2; ++i) S[4 + i] = *(const u32x4*)(Bt + (size_t)(n0 + lrow + 64 * i) * 1024 + (K0) + lkc); }
#define G_STORE(S, BUF) { _Pragma("unroll") for (int i = 0; i < 4; ++i) *(u32x4*)((BUF) + swz(lrow + 64 * i, tid & 7)) = S[i]; \
                          _Pragma("unroll") for (int i = 0; i < 2; ++i) *(u32x4*)((BUF) + 32768 + swz(lrow + 64 * i, tid & 7)) = S[4 + i]; }
#define G_COMPUTE(BUF) { _Pragma("unroll") for (int ks = 0; ks < 4; ++ks) { const int kc_ = ks * 2 + h; \
        const bf16x8 a0 = *(const bf16x8*)((BUF) + swz(wm * 64 + r, kc_)); const bf16x8 a1 = *(const bf16x8*)((BUF) + swz(wm * 64 + 32 + r, kc_)); \
        const bf16x8 b0 = *(const bf16x8*)((BUF) + 32768 + swz(wn * 64 + r, kc_)); const bf16x8 b1 = *(const bf16x8*)((BUF) + 32768 + swz(wn * 64 + 32 + r, kc_)); \
        acc[0][0] = MFMA32(a0, b0, acc[0][0]); acc[0][1] = MFMA32(a0, b1, acc[0][1]); acc[1][0] = MFMA32(a1, b0, acc[1][0]); acc[1][1] = MFMA32(a1, b1, acc[1][1]); } }
      G_LOAD(s0, 0) G_STORE(s0, lds)
      G_LOAD(s0, 64) G_LOAD(s1, 128)
      __syncthreads();
      for (int kt = 0; kt < 16; kt += 2) {
        G_COMPUTE(lds)
        G_STORE(s0, lds + 49152)
        if (kt + 3 < 16) G_LOAD(s0, (kt + 3) * 64)
        __syncthreads();
        G_COMPUTE(lds + 49152)
        if (kt + 2 < 16) G_STORE(s1, lds)
        if (kt + 4 < 16) G_LOAD(s1, (kt + 4) * 64)
        __syncthreads();
      }
#undef G_LOAD
#undef G_STORE
#undef G_COMPUTE
    } else {
    u32x4 raw[4], raw2[4], rb[2];
    const int arow = 4 * (tid >> 3), akc = (tid & 7) * 8;
#pragma unroll
    for (int hf = 0; hf < 2; ++hf) { ld_half<SHIFT>(A, m0 + arow + 2 * hf, akc, Lmask, raw); st_half<SHIFT>(lds, arow + 2 * hf, tid & 7, raw, smu, akc); }
#pragma unroll
    for (int i = 0; i < 2; ++i) { const int id = tid + 512 * i; rb[i] = *(const u32x4*)(Bt + (size_t)(n0 + (id >> 3)) * 1024 + (id & 7) * 8); }
#pragma unroll
    for (int i = 0; i < 2; ++i) { const int id = tid + 512 * i; *(u32x4*)(lds + 32768 + swz(id >> 3, id & 7)) = rb[i]; }
    __syncthreads();
    for (int kt = 0; kt < 16; ++kt) {
      unsigned char* cur = lds + (kt & 1) * 49152; unsigned char* nxt = lds + ((kt + 1) & 1) * 49152;
      const int k1 = (kt + 1) * 64;
      if (kt < 15) {
        ld_half<SHIFT>(A, m0 + arow, k1 + akc, Lmask, raw);
        ld_half<SHIFT>(A, m0 + arow + 2, k1 + akc, Lmask, raw2);
#pragma unroll
        for (int i = 0; i < 2; ++i) { const int id = tid + 512 * i; rb[i] = *(const u32x4*)(Bt + (size_t)(n0 + (id >> 3)) * 1024 + k1 + (id & 7) * 8); }
      }
#pragma unroll
      for (int ks = 0; ks < 4; ++ks) {
        const int kc_ = ks * 2 + h;
        const bf16x8 a0 = *(const bf16x8*)(cur + swz(wm * 64 + r, kc_));
        const bf16x8 a1 = *(const bf16x8*)(cur + swz(wm * 64 + 32 + r, kc_));
        const bf16x8 b0 = *(const bf16x8*)(cur + 32768 + swz(wn * 64 + r, kc_));
        const bf16x8 b1 = *(const bf16x8*)(cur + 32768 + swz(wn * 64 + 32 + r, kc_));
        acc[0][0] = MFMA32(a0, b0, acc[0][0]); acc[0][1] = MFMA32(a0, b1, acc[0][1]);
        acc[1][0] = MFMA32(a1, b0, acc[1][0]); acc[1][1] = MFMA32(a1, b1, acc[1][1]);
      }
      if (kt < 15) {
        st_half<SHIFT>(nxt, arow, tid & 7, raw, smu, k1 + akc);
        st_half<SHIFT>(nxt, arow + 2, tid & 7, raw2, smu, k1 + akc);
#pragma unroll
        for (int i = 0; i < 2; ++i) { const int id = tid + 512 * i; *(u32x4*)(nxt + 32768 + swz(id >> 3, id & 7)) = rb[i]; }
      }
      __syncthreads();
    }
    }
#pragma unroll
    for (int mi = 0; mi < 2; ++mi)
#pragma unroll
      for (int ni = 0; ni < 2; ++ni)
#pragma unroll
        for (int i = 0; i < 16; ++i) {
          const int row = wm * 64 + mi * 32 + (i & 3) + 8 * (i >> 2) + 4 * h, col = wn * 64 + ni * 32 + r;
          Cs[row * 132 + col] = acc[mi][ni][i];
        }
    __syncthreads();
    if (EPI == 0) {
#pragma unroll
      for (int i = 0; i < 8; ++i) {
        const int id = tid + 512 * i, row = id >> 4, cc = (id & 15) * 8;
        float4 v0 = *(const float4*)(Cs + row * 132 + cc), v1 = *(const float4*)(Cs + row * 132 + cc + 4);
        if (rw && nt + nt0 == 32) { v0.x = tanhf(v0.x); v0.y = tanhf(v0.y); v0.z = tanhf(v0.z); v0.w = tanhf(v0.w); v1.x = tanhf(v1.x); v1.y = tanhf(v1.y); v1.z = tanhf(v1.z); v1.w = tanhf(v1.w); }
        u32x4 o; o[0] = pack2(v0.x, v0.y); o[1] = pack2(v0.z, v0.w); o[2] = pack2(v1.x, v1.y); o[3] = pack2(v1.z, v1.w);
        if (rw && nt + nt0 >= 32) *(u32x4*)((bf16_t*)(p.ws + WS_HID) + (size_t)(m0 + row) * 256 + (nt + nt0 - 32) * 128 + cc) = o;
        else *(u32x4*)(dst + (size_t)(nt >> 3) * SLOT_ELEMS + (size_t)(m0 + row) * 1024 + (nt & 7) * 128 + cc) = o;
      }
    } else {
      const int row = tid & 255, hh = tid >> 8; const int t = m0 + row;
      float x[64];
#pragma unroll
      for (int q = 0; q < 16; ++q) { const float4 v = *(const float4*)(Cs + row * 132 + hh * 64 + 4 * q); x[4 * q] = v.x; x[4 * q + 1] = v.y; x[4 * q + 2] = v.z; x[4 * q + 3] = v.w; }
      bf16_t* slots = (bf16_t*)(p.ws + WS_SLOT);
      const int L = g ? 4096 : 256, Ltot = g ? 4352 : 256;
      const int b = g ? (t >> 12) : (t >> 8), s = t & (L - 1);
      if (nt < 10) {
        int vz = 0; asm volatile("" : "+v"(vz));
        const float* nw = (nt < 8 ? p.in[26] : p.in[27]) + vz;
        float ss = 0.f;
#pragma unroll
        for (int d = 0; d < 64; ++d) ss += x[d] * x[d];
        const float rs = rsqrtf(ss * (1.f / 64.f) + 1e-6f);
#pragma unroll
        for (int d = 0; d < 64; ++d) x[d] *= rs * nw[d];
        if (g == 0 && nt >= 8) {
          float* ck = p.out + OUT_CK + (size_t)t * 256 + ((nt - 8) * 2 + hh) * 64;
#pragma unroll
          for (int q = 0; q < 16; ++q) *(float4*)(ck + 4 * q) = make_float4(x[4 * q], x[4 * q + 1], x[4 * q + 2], x[4 * q + 3]);
        }
        if (g == 1) {
          const float2* rope = (const float2*)(p.ws + WS_ROPE);
          const int ri = s >> 6, ci = s & 63;
#pragma unroll
          for (int f = 0; f < 16; ++f) {
            const float2 cr = rope[ri * 16 + f]; const float x1 = x[f], x2 = x[16 + f];
            x[f] = x1 * cr.x - x2 * cr.y; x[16 + f] = x2 * cr.x + x1 * cr.y;
            const float2 cc = rope[ci * 16 + f]; const float y1 = x[32 + f], y2 = x[48 + f];
            x[32 + f] = y1 * cc.x - y2 * cc.y; x[48 + f] = y2 * cc.x + y1 * cc.y;
          }
        }
        bf16_t* dq = nt < 8 ? slots + 2 * SLOT_ELEMS + (size_t)t * 1024 + (nt * 2 + hh) * 64
                            : slots + 4 * SLOT_ELEMS + ((size_t)b * Ltot + s) * 256 + ((nt - 8) * 2 + hh) * 64;
#pragma unroll
        for (int q = 0; q < 8; ++q) { u32x4 o; o[0] = pack2(x[8 * q], x[8 * q + 1]); o[1] = pack2(x[8 * q + 2], x[8 * q + 3]); o[2] = pack2(x[8 * q + 4], x[8 * q + 5]); o[3] = pack2(x[8 * q + 6], x[8 * q + 7]); *(u32x4*)(dq + 8 * q) = o; }
      } else if (nt < 12) {
        const int kvh = (nt - 10) * 2 + hh;
        if (g == 0) {
          float* cv = p.out + OUT_CV + (size_t)t * 256 + kvh * 64;
#pragma unroll
          for (int q = 0; q < 16; ++q) *(float4*)(cv + 4 * q) = make_float4(x[4 * q], x[4 * q + 1], x[4 * q + 2], x[4 * q + 3]);
        }
        bf16_t* vt = slots + 4 * SLOT_ELEMS + SLOT_ELEMS / 2 + ((size_t)(b * 4 + kvh) * 64) * Ltot + s;
        { size_t vo = 0;
#pragma unroll
        for (int d = 0; d < 64; ++d) { vt[vo] = (bf16_t)f2bf(x[d]); vo += Ltot; asm volatile("" : "+v"(vo)); } }
      } else {
        bf16_t* dg = slots + 3 * SLOT_ELEMS + (size_t)t * 1024 + (nt - 12) * 128 + hh * 64;
#pragma unroll
        for (int q = 0; q < 8; ++q) { u32x4 o; o[0] = pack2(x[8 * q], x[8 * q + 1]); o[1] = pack2(x[8 * q + 2], x[8 * q + 3]); o[2] = pack2(x[8 * q + 4], x[8 * q + 5]); o[3] = pack2(x[8 * q + 6], x[8 * q + 7]); *(u32x4*)(dg + 8 * q) = o; }
      }
    }
    __syncthreads();
  }
}

DI u32x4 cat8(const u32x2 lo, const u32x2 hi) { u32x4 v; v[0] = lo[0]; v[1] = lo[1]; v[2] = hi[0]; v[3] = hi[1]; return v; }
DI void phase_scan(const P& p, int g, int jl, unsigned char* lds) {
  const int tid = otid(), lane = tid & 63, wave = tid >> 6, r = lane & 31, h = lane >> 5;
  const int L = g ? 4096 : 256, B = g ? 4 : 32, nsc = L >> 5;
  float* sR = (float*)lds; float* sW = sR + 2048; float* sKD = sW + 2048; float* sKK = sKD + 2048; float* sKKA = sKK + 2048;
  bf16_t* sHW = (bf16_t*)(lds + 40960); bf16_t* sHA = (bf16_t*)(lds + 45568);
  bf16_t* oAL = (bf16_t*)(lds + 50176); bf16_t* oRH = (bf16_t*)(lds + 54784); bf16_t* oBE = (bf16_t*)(lds + 59392); bf16_t* oGA = (bf16_t*)(lds + 64000);
  bf16_t* oBEt = (bf16_t*)(lds + 68608); bf16_t* oGAt = (bf16_t*)(lds + 73728); bf16_t* oUt = (bf16_t*)(lds + 78848); bf16_t* oZt = (bf16_t*)(lds + 83968);
  float* Bm = (float*)(lds + 89088); float* RHS = (float*)(lds + 93696); float* lamC = (float*)(lds + 101888); float* sP = (float*)(lds + 102144);
  unsigned char* frag = lds + 104192;
  const bf16_t* slots = (const bf16_t*)(p.ws + WS_SLOT);
  const bf16_t* Rg = slots + 1 * SLOT_ELEMS; const bf16_t* Kg = slots + 0 * SLOT_ELEMS; const bf16_t* Vg = slots + 2 * SLOT_ELEMS;
  const bf16_t* hid = (const bf16_t*)(p.ws + WS_HID);
  float* bon = (float*)(p.ws + WS_BON);
  const int ntasks = B * 32;
  for (int task = blockIdx.x; task < ntasks; task += gridDim.x) {
    const int z = task & 1, head = (task >> 1) & 15, b = task >> 5;
    bf16_t* Yg = (bf16_t*)(p.ws + WS_SLOT) + (z ? 4 : 5) * SLOT_ELEMS;
    const int mat = (wave >> 1) & 1, ntt = wave & 1;
    unsigned char* lfr = lds + 110336 + (wave & 3) * 4096;
    if (wave >= 4) {
      const float* W2 = (mat ? p.in[18] : p.in[15]) + (size_t)(jl * 2 + z) * 65536 + head * 64 + 32 * ntt + r;
#pragma unroll
      for (int kk = 0; kk < 4; ++kk) { u32x4 pk;
#pragma unroll
        for (int j = 0; j < 4; ++j) pk[j] = pack2(W2[(size_t)(16 * kk + 8 * h + 2 * j) * 1024], W2[(size_t)(16 * kk + 8 * h + 2 * j + 1) * 1024]);
        *(u32x4*)(lfr + (kk * 64 + lane) * 16) = pk; }
    }
    const float bias = (mat ? p.in[16] : p.in[13])[(jl * 2 + z) * 1024 + head * 64 + 32 * ntt + r];
    const float kkc = p.in[19][jl * 1024 + head * 64 + lane], kac = p.in[20][jl * 1024 + head * 64 + lane], rkc = p.in[21][jl * 1024 + head * 64 + lane];
    f32x16 st0, st1;
#pragma unroll
    for (int q = 0; q < 16; ++q) { st0[q] = 0.f; st1[q] = 0.f; }
    const size_t stbase = ((((size_t)(b * 2 + jl) * 2 + z) * 16 + head) * 64 + (32 * (wave & 1) + r)) * 64;
    if (g && wave < 2) {
#pragma unroll
      for (int gq = 0; gq < 4; ++gq) {
        const float4 s0 = *(const float4*)(p.in[2] + stbase + 8 * gq + 4 * h), s1 = *(const float4*)(p.in[2] + stbase + 32 + 8 * gq + 4 * h);
        st0[4 * gq] = s0.x; st0[4 * gq + 1] = s0.y; st0[4 * gq + 2] = s0.z; st0[4 * gq + 3] = s0.w;
        st1[4 * gq] = s1.x; st1[4 * gq + 1] = s1.y; st1[4 * gq + 2] = s1.z; st1[4 * gq + 3] = s1.w;
      }
    }
    u32x4 pre[5];
    const int ht = tid - 256;
#define SCAN_LOAD(sc_)                                                                                    \
    { const int ht2 = otid() - 256;                                                                       \
    _Pragma("unroll") for (int i = 0; i < 5; ++i) {                                                       \
      const int id = ht2 + 256 * i;                                                                       \
      const int arr = id >> 8, s = (id >> 3) & 31, cc = (id & 7) * 8;                                     \
      const int tl = z ? (L - 1 - ((sc_) * 32 + s)) : ((sc_) * 32 + s);                                   \
      const size_t tok = (size_t)b * L + tl;                                                              \
      if (arr < 3) pre[i] = *(const u32x4*)((arr == 0 ? Rg : (arr == 1 ? Kg : Vg)) + tok * 1024 + head * 64 + cc); \
      else pre[i] = *(const u32x4*)(hid + tok * 256 + (arr - 3) * 128 + z * 64 + cc);                     \
    } }
#define NQ(t_) ((((t_) + 3) / 4 + 1) / 2)
#define SOLVE_ROWS(T0, T1)                                                                                \
    _Pragma("unroll") for (int t = (T0); t < (T1); ++t) {                                                 \
      if (t + 2 < 32) {                                                                                   \
        n2rhs = RHo[(t + 2) * 64];                                                                        \
        _Pragma("unroll") for (int q = 0; q < NQ(t + 2); ++q) { const f4v q4 = *(const __attribute__((address_space(3))) f4v*)(Bmo + (t + 2) * 36 + 8 * q); nc8[q] = make_float4(q4[0], q4[1], q4[2], q4[3]); } \
      }                                                                                                   \
      float a0s = crhs * mh, a1s = 0.f;                                                                   \
      _Pragma("unroll") for (int q = 0; q < NQ(t); ++q) {                                                 \
        a0s -= cb[q].x * zv[4 * q]; a1s -= cb[q].y * zv[4 * q + 1]; a0s -= cb[q].z * zv[4 * q + 2]; a1s -= cb[q].w * zv[4 * q + 3]; } \
      float zt = xhalf_sum(a0s + a1s);                                                                    \
      asm volatile("" : "+v"(zt) :: "memory");                                                            \
      zv[4 * (t >> 3) + (t & 3)] = ((((t >> 2) & 1) == h)) ? zt : zv[4 * (t >> 3) + (t & 3)];             \
      crhs = nrhs; nrhs = n2rhs;                                                                          \
      _Pragma("unroll") for (int q = 0; q < 4; ++q) { cb[q] = nb8[q]; nb8[q] = nc8[q]; }                  \
    }
    typedef float f4v __attribute__((ext_vector_type(4)));
    if (wave >= 4) { SCAN_LOAD(0) }
    for (int sc = -1; sc < nsc; ++sc) {
      const bool st_on = sc >= 0, hl_on = sc + 1 < nsc;
      bf16_t* oUc = (bf16_t*)(lds + ((sc & 1) ? 126720 : 78848));
      bf16_t* oUn = (bf16_t*)(lds + ((sc & 1) ? 78848 : 126720));
      f32x16 y0;
      const int vloc = 32 * (wave & 1) + r;
      if (st_on) {
      {
        const int k = lane, tq = wave;
        float wq[4];
#pragma unroll
        for (int j = 0; j < 4; ++j) wq[j] = sW[(4 * tq + j) * 64 + k];
        sP[tq * 64 + k] = (wq[0] * wq[1]) * (wq[2] * wq[3]);
        __syncthreads();
        float lam = 1.f;
#pragma unroll
        for (int q = 0; q < 7; ++q) { const float pq = sP[q * 64 + k]; lam *= (q < tq) ? pq : 1.f; }
        u32x2 bt, gt; float nb[4], gg[4];
#pragma unroll
        for (int j = 0; j < 4; ++j) {
          const int t = 4 * tq + j;
          const float lamp = lam; lam = lamp * wq[j];
          const float inv = __builtin_amdgcn_rcpf(lam);
          const float al = lamp * sKK[t * 64 + k], be = sKKA[t * 64 + k] * inv, ga = sKD[t * 64 + k] * inv, rh = lam * sR[t * 64 + k];
          oAL[t * 72 + k] = (bf16_t)f2bf(al); oRH[t * 72 + k] = (bf16_t)f2bf(rh); oBE[t * 72 + k] = (bf16_t)f2bf(be); oGA[t * 72 + k] = (bf16_t)f2bf(ga);
          nb[j] = -be; gg[j] = ga;
        }
        bt[0] = pack2(nb[0], nb[1]); bt[1] = pack2(nb[2], nb[3]); gt[0] = pack2(gg[0], gg[1]); gt[1] = pack2(gg[2], gg[3]);
        *(u32x2*)(oBEt + k * 40 + 4 * tq) = bt; *(u32x2*)(oGAt + k * 40 + 4 * tq) = gt;
        if (tq == 7) lamC[k] = lam;
      }
      __syncthreads();
      {
      const int tid = otid(), lane = tid & 63, wave = tid >> 6, r = lane & 31, h = lane >> 5; (void)r; (void)h; (void)lane; (void)wave;
      if (wave < 4) {
        const bf16_t* As = (wave & 1) ? oGA : oBE; const bf16_t* Bs = (wave < 2) ? oAL : oRH;
        f32x16 x;
#pragma unroll
        for (int q = 0; q < 16; ++q) x[q] = 0.f;
#pragma unroll
        for (int s = 0; s < 4; ++s) { const bf16x8 a = *(const bf16x8*)(As + r * 72 + 16 * s + 8 * h); const bf16x8 bb = *(const bf16x8*)(Bs + r * 72 + 16 * s + 8 * h); x = MFMA32(a, bb, x); }
#pragma unroll
        for (int q = 0; q < 16; ++q) { const int i = (q & 3) + 8 * (q >> 2) + 4 * h; const bool keep = (wave < 2) ? (i < r) : (i <= r); x[q] = keep ? x[q] : 0.f; }
        if (wave == 0) {
#pragma unroll
          for (int gq = 0; gq < 4; ++gq) *(float4*)(Bm + r * 36 + 8 * gq + 4 * h) = make_float4(x[4 * gq], x[4 * gq + 1], x[4 * gq + 2], x[4 * gq + 3]);
        } else {
          const float sg = (wave == 2) ? -1.f : 1.f;
#pragma unroll
          for (int s = 0; s < 2; ++s) { u32x4 pk;
#pragma unroll
            for (int j = 0; j < 4; ++j) pk[j] = pack2(sg * x[8 * s + 2 * j], sg * x[8 * s + 2 * j + 1]);
            *(u32x4*)(frag + (((wave - 1) * 2 + s) * 64 + lane) * 16) = pk; }
        }
      }
      }
      __syncthreads();
      if (wave < 2) {
        f32x16 a0;
#pragma unroll
        for (int q = 0; q < 16; ++q) a0[q] = 0.f;
#pragma unroll
        for (int kb = 0; kb < 2; ++kb)
#pragma unroll
          for (int s = 0; s < 2; ++s) {
            u32x4 pk;
#pragma unroll
            for (int j = 0; j < 4; ++j) pk[j] = kb ? pack2(st1[8 * s + 2 * j], st1[8 * s + 2 * j + 1]) : pack2(st0[8 * s + 2 * j], st0[8 * s + 2 * j + 1]);
            const bf16x8 sf = __builtin_bit_cast(bf16x8, pk);
            const int ko = 32 * kb + 16 * s + 4 * h;
            const u32x4 aa = cat8(*(const u32x2*)(oAL + r * 72 + ko), *(const u32x2*)(oAL + r * 72 + ko + 8));
            a0 = MFMA32(__builtin_bit_cast(bf16x8, aa), sf, a0);
          }
#pragma unroll
        for (int s = 0; s < 2; ++s) {
          const bf16x8 fg = *(const bf16x8*)(frag + ((0 * 2 + s) * 64 + lane) * 16);
          const u32x4 ub = cat8(*(const u32x2*)(oUc + vloc * 40 + 16 * s + 4 * h), *(const u32x2*)(oUc + vloc * 40 + 16 * s + 4 * h + 8));
          a0 = MFMA32(fg, __builtin_bit_cast(bf16x8, ub), a0);
        }
#pragma unroll
        for (int q = 0; q < 16; ++q) RHS[((q & 3) + 8 * (q >> 2) + 4 * h) * 64 + vloc] = a0[q];
        float* park = (float*)(lds + 131840) + wave * 3072 + lane * 4;
#pragma unroll
        for (int gq = 0; gq < 4; ++gq) {
          *(float4*)(park + gq * 256) = make_float4(st0[4 * gq], st0[4 * gq + 1], st0[4 * gq + 2], st0[4 * gq + 3]);
          *(float4*)(park + 1024 + gq * 256) = make_float4(st1[4 * gq], st1[4 * gq + 1], st1[4 * gq + 2], st1[4 * gq + 3]);
        }
      }
      }
      float zv[16]; float4 cb[4], nb8[4], nc8[4]; float crhs = 0.f, nrhs = 0.f, n2rhs = 0.f;
      const float mh = h ? 0.f : 1.f;
#pragma unroll
      for (int t = 0; t < 16; ++t) zv[t] = 0.f;
#pragma unroll
      for (int q = 0; q < 4; ++q) { cb[q] = make_float4(0.f, 0.f, 0.f, 0.f); nb8[q] = make_float4(0.f, 0.f, 0.f, 0.f); nc8[q] = make_float4(0.f, 0.f, 0.f, 0.f); }
      const __attribute__((address_space(3))) float* Bmo = (const __attribute__((address_space(3))) float*)(unsigned)(unsigned long long)(Bm + 4 * h);
      const __attribute__((address_space(3))) float* RHo = (const __attribute__((address_space(3))) float*)(unsigned)(unsigned long long)(RHS + vloc);
      asm volatile("" : "+v"(Bmo), "+v"(RHo));
      if (wave < 2 && st_on) { crhs = RHo[0]; nrhs = RHo[64]; const f4v q4 = *(const __attribute__((address_space(3))) f4v*)(Bmo + 36); nb8[0] = make_float4(q4[0], q4[1], q4[2], q4[3]); }
      if (wave < 2) { if (st_on) { SOLVE_ROWS(0, 6) } }
      else if (wave >= 4 && hl_on) {
#pragma unroll
        for (int i = 0; i < 5; ++i) {
          const int id = ht + 256 * i; const int arr = id >> 8, s = (id >> 3) & 31, cc = (id & 7) * 8;
          const u32x4 u = pre[i];
          if (arr < 2) { float* d = (arr == 0 ? sR : sKD) + s * 64 + cc;
            *(float4*)d = make_float4(bflo(u[0]), bfhi(u[0]), bflo(u[1]), bfhi(u[1])); *(float4*)(d + 4) = make_float4(bflo(u[2]), bfhi(u[2]), bflo(u[3]), bfhi(u[3])); }
          else if (arr == 2) {
#pragma unroll
            for (int j = 0; j < 4; ++j) { oUn[(cc + 2 * j) * 40 + s] = (bf16_t)(u[j] & 0xffffu); oUn[(cc + 2 * j + 1) * 40 + s] = (bf16_t)(u[j] >> 16); }
          } else *(u32x4*)((arr == 3 ? sHW : sHA) + s * 72 + cc) = u;
        }
        if (sc + 2 < nsc) { SCAN_LOAD(sc + 2) }
      }
      __syncthreads();
      if (wave < 2) { if (st_on) { SOLVE_ROWS(6, 24) } }
      else if (wave < 4) { if (st_on) {
        const float* park = (const float*)(lds + 131840) + (wave - 2) * 3072 + lane * 4;
#pragma unroll
        for (int gq = 0; gq < 4; ++gq) {
          const float4 a = *(const float4*)(park + gq * 256), bq = *(const float4*)(park + 1024 + gq * 256);
          st0[4 * gq] = a.x; st0[4 * gq + 1] = a.y; st0[4 * gq + 2] = a.z; st0[4 * gq + 3] = a.w;
          st1[4 * gq] = bq.x; st1[4 * gq + 1] = bq.y; st1[4 * gq + 2] = bq.z; st1[4 * gq + 3] = bq.w;
        }
#pragma unroll
        for (int q = 0; q < 16; ++q) y0[q] = 0.f;
#pragma unroll
        for (int kb = 0; kb < 2; ++kb)
#pragma unroll
          for (int s = 0; s < 2; ++s) {
            u32x4 pk;
#pragma unroll
            for (int j = 0; j < 4; ++j) pk[j] = kb ? pack2(st1[8 * s + 2 * j], st1[8 * s + 2 * j + 1]) : pack2(st0[8 * s + 2 * j], st0[8 * s + 2 * j + 1]);
            const int ko = 32 * kb + 16 * s + 4 * h;
            const u32x4 ar = cat8(*(const u32x2*)(oRH + r * 72 + ko), *(const u32x2*)(oRH + r * 72 + ko + 8));
            y0 = MFMA32(__builtin_bit_cast(bf16x8, ar), __builtin_bit_cast(bf16x8, pk), y0);
          }
#pragma unroll
        for (int s = 0; s < 2; ++s) {
          const bf16x8 fpg = *(const bf16x8*)(frag + ((2 * 2 + s) * 64 + lane) * 16);
          const u32x4 ub = cat8(*(const u32x2*)(oUc + vloc * 40 + 16 * s + 4 * h), *(const u32x2*)(oUc + vloc * 40 + 16 * s + 4 * h + 8));
          y0 = MFMA32(fpg, __builtin_bit_cast(bf16x8, ub), y0);
        }
      } }
      else if (wave >= 4 && hl_on) {
        f32x16 acc;
#pragma unroll
        for (int i = 0; i < 16; ++i) acc[i] = 0.f;
        const bf16_t* sH = mat ? sHA : sHW;
#pragma unroll
        for (int kk = 0; kk < 4; ++kk) { const bf16x8 a = *(const bf16x8*)(sH + r * 72 + 16 * kk + 8 * h); const bf16x8 bw = *(const bf16x8*)(lfr + (kk * 64 + lane) * 16); acc = MFMA32(a, bw, acc); }
#pragma unroll
        for (int i = 0; i < 16; ++i) {
          const int srow = (i & 3) + 8 * (i >> 2) + 4 * h, c = 32 * ntt + r;
          const float xv = acc[i] + bias;
          const float sg = __builtin_amdgcn_rcpf(1.f + __expf(-xv));
          if (mat == 0) sW[srow * 64 + c] = __expf(-0.60653065971263342f * sg);
          else sKKA[srow * 64 + c] = sg;
        }
      }
      __syncthreads();
      if (wave < 2) { if (st_on) {
        SOLVE_ROWS(24, 32)
#pragma unroll
        for (int q = 0; q < 4; ++q) { u32x2 o; o[0] = pack2(zv[4 * q], zv[4 * q + 1]); o[1] = pack2(zv[4 * q + 2], zv[4 * q + 3]);
          *(u32x2*)(oZt + vloc * 40 + 4 * (2 * q + h)) = o; }
        } }
      else if (wave >= 4 && hl_on) {
#pragma unroll
        for (int i = 0; i < 8; ++i) {
          const int s = (wave - 4) + 4 * i; const int c = lane;
          const float kraw = sKD[s * 64 + c], a = sKKA[s * 64 + c], rr = sR[s * 64 + c];
          const float pk = kraw * kkc; const float ss = wave_sum(pk * pk);
          const float kk = pk * rsqrtf(fmaxf(ss, 1e-24f));
          const float kd = kraw * (1.f + (a - 1.f) * kac);
          const float bs = wave_sum(rr * kd * rkc);
          sKD[s * 64 + c] = kd; sKK[s * 64 + c] = kk; sKKA[s * 64 + c] = kk * a;
          if (c == 0) { const int tl = z ? (L - 1 - ((sc + 1) * 32 + s)) : ((sc + 1) * 32 + s); bon[(((size_t)b * L + tl) * 16 + head) * 2 + z] = bs; }
        }
      }
      __syncthreads();
      if (st_on) {
      {
      const int tid = otid(), lane = tid & 63, wave = tid >> 6, r = lane & 31, h = lane >> 5; (void)r; (void)h; (void)lane; (void)wave;
      if (wave < 2) {
        { const float* park = (const float*)(lds + 131840) + wave * 3072 + lane * 4;
#pragma unroll
          for (int gq = 0; gq < 4; ++gq) {
            const float4 a = *(const float4*)(park + gq * 256), bq = *(const float4*)(park + 1024 + gq * 256);
            st0[4 * gq] = a.x; st0[4 * gq + 1] = a.y; st0[4 * gq + 2] = a.z; st0[4 * gq + 3] = a.w;
            st1[4 * gq] = bq.x; st1[4 * gq + 1] = bq.y; st1[4 * gq + 2] = bq.z; st1[4 * gq + 3] = bq.w;
          } }
#pragma unroll
        for (int s = 0; s < 2; ++s) {
          const bf16x8 ub = *(const bf16x8*)(oUc + vloc * 40 + 16 * s + 8 * h), zb = *(const bf16x8*)(oZt + vloc * 40 + 16 * s + 8 * h);
          const bf16x8 g0 = *(const bf16x8*)(oGAt + r * 40 + 16 * s + 8 * h), g1 = *(const bf16x8*)(oGAt + (32 + r) * 40 + 16 * s + 8 * h);
          const bf16x8 b0 = *(const bf16x8*)(oBEt + r * 40 + 16 * s + 8 * h), b1 = *(const bf16x8*)(oBEt + (32 + r) * 40 + 16 * s + 8 * h);
          st0 = MFMA32(g0, ub, st0); st0 = MFMA32(b0, zb, st0);
          st1 = MFMA32(g1, ub, st1); st1 = MFMA32(b1, zb, st1);
        }
#pragma unroll
        for (int gq = 0; gq < 4; ++gq) {
          const float4 l0 = *(const float4*)(lamC + 8 * gq + 4 * h), l1 = *(const float4*)(lamC + 32 + 8 * gq + 4 * h);
          st0[4 * gq] *= l0.x; st0[4 * gq + 1] *= l0.y; st0[4 * gq + 2] *= l0.z; st0[4 * gq + 3] *= l0.w;
          st1[4 * gq] *= l1.x; st1[4 * gq + 1] *= l1.y; st1[4 * gq + 2] *= l1.z; st1[4 * gq + 3] *= l1.w;
        }
      } else if (wave < 4) {
#pragma unroll
        for (int s = 0; s < 2; ++s) {
          const bf16x8 fpb = *(const bf16x8*)(frag + ((1 * 2 + s) * 64 + lane) * 16);
          const u32x4 z8 = cat8(*(const u32x2*)(oZt + vloc * 40 + 16 * s + 4 * h), *(const u32x2*)(oZt + vloc * 40 + 16 * s + 4 * h + 8));
          y0 = MFMA32(fpb, __builtin_bit_cast(bf16x8, z8), y0);
        }
#pragma unroll
        for (int q = 0; q < 16; ++q) {
          const int t = (q & 3) + 8 * (q >> 2) + 4 * h; const int tl = z ? (L - 1 - (sc * 32 + t)) : (sc * 32 + t);
          Yg[((size_t)b * L + tl) * 1024 + head * 64 + vloc] = (bf16_t)f2bf(y0[q]);
        }
      }
      }
      __syncthreads();
      }
    }
#undef SOLVE_ROWS
#undef SCAN_LOAD
    if (g == 0 && wave < 2) {
#pragma unroll
      for (int gq = 0; gq < 4; ++gq) {
        *(float4*)(p.out + OUT_ST + stbase + 8 * gq + 4 * h) = make_float4(st0[4 * gq], st0[4 * gq + 1], st0[4 * gq + 2], st0[4 * gq + 3]);
        *(float4*)(p.out + OUT_ST + stbase + 32 + 8 * gq + 4 * h) = make_float4(st1[4 * gq], st1[4 * gq + 1], st1[4 * gq + 2], st1[4 * gq + 3]);
      }
    }
    __syncthreads();
  }
}

DI void phase_rwkv_combine(const P& p, int g, int jl) {
  const int T = g ? 16384 : 8192;
  const int tid = otid(); const int lane = tid & 63, wave = tid >> 6;
  bf16_t* slots = (bf16_t*)(p.ws + WS_SLOT);
  const float* bon = (const float*)(p.ws + WS_BON);
  for (int t = blockIdx.x * 8 + wave; t < T; t += gridDim.x * 8) {
    const size_t o = (size_t)t * 1024 + 16 * lane; const int head = lane >> 2;
    float y[16], v[16], gg[16];
#pragma unroll
    for (int q = 0; q < 2; ++q) {
      const u32x4 a = *(const u32x4*)(slots + 5 * SLOT_ELEMS + o + 8 * q), bq = *(const u32x4*)(slots + 4 * SLOT_ELEMS + o + 8 * q);
      const u32x4 vq = *(const u32x4*)(slots + 2 * SLOT_ELEMS + o + 8 * q), gq = *(const u32x4*)(slots + 3 * SLOT_ELEMS + o + 8 * q);
#pragma unroll
      for (int i = 0; i < 4; ++i) { y[8 * q + 2 * i] = bflo(a[i]) + bflo(bq[i]); y[8 * q + 2 * i + 1] = bfhi(a[i]) + bfhi(bq[i]);
        v[8 * q + 2 * i] = bflo(vq[i]); v[8 * q + 2 * i + 1] = bfhi(vq[i]); gg[8 * q + 2 * i] = bflo(gq[i]); gg[8 * q + 2 * i + 1] = bfhi(gq[i]); }
    }
    float s = 0.f;
#pragma unroll
    for (int i = 0; i < 16; ++i) s += y[i];
    const float mean = quad_sum(s) * (1.f / 64.f);
    float vs = 0.f;
#pragma unroll
    for (int i = 0; i < 16; ++i) { const float d = y[i] - mean; vs += d * d; }
    const float rstd = rsqrtf(quad_sum(vs) * (1.f / 64.f) + 64e-5f);
    const float bs = bon[((size_t)t * 16 + head) * 2] + bon[((size_t)t * 16 + head) * 2 + 1];
    const float* gw = p.in[22] + jl * 1024 + 16 * lane; const float* gb = p.in[23] + jl * 1024 + 16 * lane;
    float ov[16];
#pragma unroll
    for (int i = 0; i < 16; ++i) ov[i] = ((y[i] - mean) * rstd * gw[i] + gb[i] + bs * v[i]) * silu(gg[i]);
#pragma unroll
    for (int q = 0; q < 2; ++q) { u32x4 w; w[0] = pack2(ov[8 * q], ov[8 * q + 1]); w[1] = pack2(ov[8 * q + 2], ov[8 * q + 3]); w[2] = pack2(ov[8 * q + 4], ov[8 * q + 5]); w[3] = pack2(ov[8 * q + 6], ov[8 * q + 7]);
      *(u32x4*)(slots + 3 * SLOT_ELEMS + o + 8 * q) = w; }
  }
}

DI void phase_conv(const P& p, int g) {
  const int T = g ? 16384 : 8192, Lmask = g ? 4095 : 255;
  bf16_t* slots = (bf16_t*)(p.ws + WS_SLOT);
  const bf16_t* BG = slots + 2 * SLOT_ELEMS; const bf16_t* CG = slots + 3 * SLOT_ELEMS; const bf16_t* U = slots + 4 * SLOT_ELEMS; const bf16_t* G = slots + 5 * SLOT_ELEMS;
  bf16_t* O = slots;
  for (int e = blockIdx.x * NT + otid(); e < T * 128; e += gridDim.x * NT) {
    const int t = e >> 7, c = (e & 127) * 8; const size_t o = (size_t)t * 1024 + c; const int tl = t & Lmask;
    const u32x4 zz = {0u, 0u, 0u, 0u};
    const u32x4 c1 = *(const u32x4*)(CG + o), u1 = *(const u32x4*)(U + o);
    const u32x4 c0 = tl != 0 ? *(const u32x4*)(CG + o - 1024) : zz, u0 = tl != 0 ? *(const u32x4*)(U + o - 1024) : zz;
    const u32x4 c2 = tl != Lmask ? *(const u32x4*)(CG + o + 1024) : zz, u2 = tl != Lmask ? *(const u32x4*)(U + o + 1024) : zz;
    const u32x4 bg = *(const u32x4*)(BG + o), gg = *(const u32x4*)(G + o);
    const float* cw = p.in[30]; const float* cb = p.in[31];
    u32x4 w;
#pragma unroll
    for (int i = 0; i < 4; ++i) {
      const int ch = c + 2 * i;
      const float lo = bflo(bg[i]) * (cw[ch] * bflo(c0[i]) * bflo(u0[i]) + cw[1024 + ch] * bflo(c1[i]) * bflo(u1[i]) + cw[2048 + ch] * bflo(c2[i]) * bflo(u2[i]) + cb[ch]) * silu(bflo(gg[i]));
      const float hi = bfhi(bg[i]) * (cw[ch + 1] * bfhi(c0[i]) * bfhi(u0[i]) + cw[1024 + ch + 1] * bfhi(c1[i]) * bfhi(u1[i]) + cw[2048 + ch + 1] * bfhi(c2[i]) * bfhi(u2[i]) + cb[ch + 1]) * silu(bfhi(gg[i]));
      w[i] = pack2(lo, hi);
    }
    *(u32x4*)(O + o) = w;
  }
}

DI void phase_attn(const P& p, int g, unsigned char* lds) {
  const int tid = otid(), lane = tid & 63, wave = tid >> 6, r = lane & 31, h = lane >> 5;
  const int L = g ? 4096 : 256, Ltot = g ? 4352 : 256, B = g ? 4 : 32;
  const int nq = L >> 6, ntasks = B * 4 * nq, nkt = Ltot >> 6;
  bf16_t* slots = (bf16_t*)(p.ws + WS_SLOT);
  bf16_t* Q = slots + 2 * SLOT_ELEMS; const bf16_t* G = slots + 3 * SLOT_ELEMS;
  const bf16_t* Kb = slots + 4 * SLOT_ELEMS; const bf16_t* Vt = Kb + SLOT_ELEMS / 2;
  const float SC = 0.125f * 1.4426950408889634f;
  for (int task = blockIdx.x; task < ntasks; task += gridDim.x) {
    const int qt = task % nq, kvh = (task / nq) & 3, b = task / (nq * 4);
    const int head = kvh * 4 + (wave >> 1); const int q0 = qt * 64 + (wave & 1) * 32;
    const size_t tok = (size_t)b * L + q0 + r;
    bf16x8 qf[4];
#pragma unroll
    for (int ds = 0; ds < 4; ++ds) qf[ds] = *(const bf16x8*)(Q + tok * 1024 + head * 64 + ds * 16 + h * 8);
    float m = -1e30f, lsum = 0.f;
    f32x16 O0, O1;
#pragma unroll
    for (int i = 0; i < 16; ++i) { O0[i] = 0.f; O1[i] = 0.f; }
    const int lrow = tid >> 3, lc = (tid & 7) * 8;
    const bf16_t* gK = Kb + ((size_t)b * Ltot + lrow) * 256 + kvh * 64 + lc;
    const bf16_t* gV = Vt + ((size_t)(b * 4 + kvh) * 64 + lrow) * Ltot + lc;
    u32x4 rk = *(const u32x4*)gK, rv = *(const u32x4*)gV;
    *(u32x4*)(lds + lrow * 144 + lc * 2) = rk; *(u32x4*)(lds + 9216 + lrow * 144 + lc * 2) = rv;
    __syncthreads();
    for (int kt = 0; kt < nkt; ++kt) {
      const unsigned char* cur = lds + (kt & 1) * 18432; unsigned char* nxt = lds + ((kt + 1) & 1) * 18432;
      if (kt + 1 < nkt) { rk = *(const u32x4*)(gK + (size_t)(kt + 1) * 64 * 256); rv = *(const u32x4*)(gV + (kt + 1) * 64); }
      f32x16 s0, s1;
#pragma unroll
      for (int i = 0; i < 16; ++i) { s0[i] = 0.f; s1[i] = 0.f; }
#pragma unroll
      for (int ds = 0; ds < 4; ++ds) {
        const bf16x8 a0 = *(const bf16x8*)(cur + r * 144 + (ds * 16 + h * 8) * 2);
        const bf16x8 a1 = *(const bf16x8*)(cur + (32 + r) * 144 + (ds * 16 + h * 8) * 2);
        s0 = MFMA32(a0, qf[ds], s0); s1 = MFMA32(a1, qf[ds], s1);
      }
      float tmax = s0[0];
#pragma unroll
      for (int i = 1; i < 16; ++i) tmax = fmaxf(tmax, s0[i]);
#pragma unroll
      for (int i = 0; i < 16; ++i) tmax = fmaxf(tmax, s1[i]);
      tmax = xhalf_max(tmax);
      const float tm = tmax * SC;
      if (__builtin_amdgcn_ballot_w64(tm - m > 8.f) != 0ull) {
        const float mnew = fmaxf(m, tm);
        const float alpha = __builtin_amdgcn_exp2f(m - mnew);
        lsum *= alpha; m = mnew;
#pragma unroll
        for (int i = 0; i < 16; ++i) { O0[i] *= alpha; O1[i] *= alpha; }
      }
      float ps = 0.f;
#pragma unroll
      for (int i = 0; i < 16; ++i) { s0[i] = __builtin_amdgcn_exp2f(s0[i] * SC - m); s1[i] = __builtin_amdgcn_exp2f(s1[i] * SC - m); ps += s0[i] + s1[i]; }
      lsum += ps;
      const unsigned char* vs = cur + 9216;
#pragma unroll
      for (int kb = 0; kb < 2; ++kb)
#pragma unroll
        for (int s = 0; s < 2; ++s) {
          u32x4 pk;
#pragma unroll
          for (int j = 0; j < 4; ++j) pk[j] = kb ? pack2(s1[8 * s + 2 * j], s1[8 * s + 2 * j + 1]) : pack2(s0[8 * s + 2 * j], s0[8 * s + 2 * j + 1]);
          const bf16x8 pf = __builtin_bit_cast(bf16x8, pk);
          const int ko = (32 * kb + 16 * s + 4 * h) * 2;
          { const u32x2 lo = *(const u32x2*)(vs + r * 144 + ko), hi = *(const u32x2*)(vs + r * 144 + ko + 16);
            u32x4 av; av[0] = lo[0]; av[1] = lo[1]; av[2] = hi[0]; av[3] = hi[1];
            O0 = MFMA32(__builtin_bit_cast(bf16x8, av), pf, O0); }
          { const u32x2 lo = *(const u32x2*)(vs + (32 + r) * 144 + ko), hi = *(const u32x2*)(vs + (32 + r) * 144 + ko + 16);
            u32x4 av; av[0] = lo[0]; av[1] = lo[1]; av[2] = hi[0]; av[3] = hi[1];
            O1 = MFMA32(__builtin_bit_cast(bf16x8, av), pf, O1); }
        }
      if (kt + 1 < nkt) { *(u32x4*)(nxt + lrow * 144 + lc * 2) = rk; *(u32x4*)(nxt + 9216 + lrow * 144 + lc * 2) = rv; }
      __syncthreads();
    }
    lsum = xhalf_sum(lsum);
    const float inv = 1.f / lsum;
#pragma unroll
    for (int db = 0; db < 2; ++db)
#pragma unroll
      for (int i4 = 0; i4 < 4; ++i4) {
        const size_t o = tok * 1024 + head * 64 + 32 * db + 8 * i4 + 4 * h;
        const u32x2 gq = *(const u32x2*)(G + o);
        const float v0 = (db ? O1[4 * i4] : O0[4 * i4]) * inv, v1 = (db ? O1[4 * i4 + 1] : O0[4 * i4 + 1]) * inv;
        const float v2 = (db ? O1[4 * i4 + 2] : O0[4 * i4 + 2]) * inv, v3 = (db ? O1[4 * i4 + 3] : O0[4 * i4 + 3]) * inv;
        u32x2 w; w[0] = pack2(v0 * silu(bflo(gq[0])), v1 * silu(bfhi(gq[0]))); w[1] = pack2(v2 * silu(bflo(gq[1])), v3 * silu(bfhi(gq[1])));
        *(u32x2*)(slots + 5 * SLOT_ELEMS + o) = w;
      }
  }
}


namespace pg8 {
#define PG8_LAS __attribute__((address_space(3)))
typedef unsigned short bf16_t;
typedef short bf16x8 __attribute__((ext_vector_type(8)));
typedef float f32x4 __attribute__((ext_vector_type(4)));
typedef unsigned u32x4 __attribute__((ext_vector_type(4)));
constexpr int BM = 256, BK = 64, HALF = 128, HTB = HALF * BK * 2  , STAGE_BYTES = 8 * HTB, NXCD = 8, WGM = 8;

__host__ __device__ __forceinline__ int lds_byte(int r, int c) { const int st = (r >> 4) * 2 + (c >> 5), rr = r & 15, cc = c & 31, ob = rr * 64 + cc * 2; return st * 1024 + (ob ^ (((ob >> 9) & 1) << 5)); }
__host__ __device__ __forceinline__ void stage_rc(int b, int& R, int& C) { const int st = b / 1024, sb = b % 1024, swz = sb ^ (((sb >> 9) & 1) << 5); R = (st >> 1) * 16 + swz / 64; C = (st & 1) * 32 + (swz % 64) / 2; }
__host__ __device__ __forceinline__ int perm32(int rho) { const int n = rho >> 4, i = rho & 15; return 8 * (i >> 2) + 4 * n + (i & 3); }

struct Unit { int pm, pn; };
struct Gemm { const bf16_t* A; const bf16_t* Bt; int M, N, K; };

struct StaticOrder {
    int nM, nN, nwg, G, c;
    __host__ __device__ void init(int M, int N, int G_, int c_) { nM = M / BM; nN = N / BM; nwg = nM * nN; G = G_; c = c_; }
    __host__ __device__ bool next(int i, Unit& u) const {
        const long L = (long)i * G + c; if (L >= nwg) return false;
        int wgid = (int)L; { const int q = nwg / NXCD, r = nwg % NXCD, xcd = wgid % NXCD, off = wgid / NXCD; wgid = (xcd < r ? xcd * (q + 1) : r * (q + 1) + (xcd - r) * q) + off; }
        const int nig = WGM * nN, gid = wgid / nig, fm = gid * WGM, gsz = (nM - fm) < WGM ? (nM - fm) : WGM;
        u.pm = fm + ((wgid % nig) % gsz); u.pn = (wgid % nig) / gsz; return true;
    }
    __device__ __forceinline__ void a_ready(const Unit&) const {}
    __device__ __forceinline__ void done(const Unit&) const {}
};
struct CountedOrder : StaticOrder {
    const unsigned* ready; unsigned need; unsigned* tmo;
    __device__ __forceinline__ void a_ready(const Unit& u) const {
        if (threadIdx.x < 64) {
            const unsigned long long t0 = __builtin_amdgcn_s_memrealtime(); unsigned polls = 0;
            while ((unsigned)__builtin_amdgcn_readfirstlane(__hip_atomic_load(ready + 64 * u.pm, __ATOMIC_RELAXED, __HIP_MEMORY_SCOPE_AGENT)) < need) {
                if ((++polls & 255u) == 0u && __builtin_amdgcn_readfirstlane(__hip_atomic_load(tmo, __ATOMIC_RELAXED, __HIP_MEMORY_SCOPE_AGENT)) != 0u) break;
                if (__builtin_amdgcn_s_memrealtime() - t0 > 2000000ull) {
                    if (threadIdx.x == 0) { unsigned expect = 0u; __hip_atomic_compare_exchange_strong(tmo + 1, &expect, 0x600u | (unsigned)(u.pm & 0xff), __ATOMIC_RELAXED, __ATOMIC_RELAXED, __HIP_MEMORY_SCOPE_AGENT); __hip_atomic_store(tmo, 1u, __ATOMIC_RELAXED, __HIP_MEMORY_SCOPE_AGENT); }
                    break; }
                __builtin_amdgcn_s_sleep(2); }
            __builtin_amdgcn_fence(__ATOMIC_ACQUIRE, "agent");
            asm volatile("s_waitcnt vmcnt(0)" ::: "memory");
        }
#if !defined(BROKEN_HOOK_NO_BARRIER)
        asm volatile("" ::: "memory"); __builtin_amdgcn_s_barrier(); asm volatile("" ::: "memory");
#endif
    }
};

__device__ __forceinline__ unsigned cvt_pk_bf16(float lo, float hi) { unsigned r; asm volatile("v_cvt_pk_bf16_f32 %0, %1, %2" : "=v"(r) : "v"(lo), "v"(hi)); return r; }
typedef float f32x2 __attribute__((ext_vector_type(2)));
__device__ __forceinline__ f32x2 gelu_pk(f32x2 v) {
    const f32x2 av = __builtin_elementwise_abs(v), d = av * 0.2316418882f + 1.0f;
    f32x2 t; t.x = __builtin_amdgcn_rcpf(d.x); t.y = __builtin_amdgcn_rcpf(d.y);
    f32x2 q = t * 0.5307027145f + (-0.7265760135f); q = q * t + 0.7107068705f; q = q * t + (-0.142248368f); q = q * t + 0.127414796f; q = q * t;
    const f32x2 s = (v * v) * (-0.72134752044f);
    f32x2 e; e.x = __builtin_amdgcn_exp2f(s.x); e.y = __builtin_amdgcn_exp2f(s.y);
    const f32x2 m = v * (q * e), r = v - m;
    f32x2 o; o.x = v.x < 0.f ? m.x : r.x; o.y = v.y < 0.f ? m.y : r.y; return o;
}

struct EpiF32 {
    static constexpr bool PERM = false, AFTER_DRAIN = false;
    float* C; int ldc; const float* bias;
    __device__ __forceinline__ void operator()(const f32x4 (&acc)[2][2][4][2], const Unit& u, int wr, int wc, int fr, int fq) const {
        const int row0 = u.pm * BM + wr * 64 + fr, col0 = u.pn * BM + wc * 32 + 4 * fq;
        f32x4 bv[2][2];
#pragma unroll
        for (int bj = 0; bj < 2; ++bj)
#pragma unroll
            for (int n = 0; n < 2; ++n) bv[bj][n] = bias ? *(const f32x4*)(bias + col0 + bj * HALF + n * 16) : (f32x4){0.f, 0.f, 0.f, 0.f};
#pragma unroll
        for (int ai = 0; ai < 2; ++ai)
#pragma unroll
            for (int m = 0; m < 4; ++m) { float* rowp = C + (size_t)(row0 + ai * HALF + m * 16) * ldc + col0;
#pragma unroll
                for (int bj = 0; bj < 2; ++bj)
#pragma unroll
                    for (int n = 0; n < 2; ++n) *(f32x4*)(rowp + bj * HALF + n * 16) = acc[ai][bj][m][n] + bv[bj][n]; }
    }
};
template <int ACT  > struct EpiBf16 {
    static constexpr bool PERM = true, AFTER_DRAIN = false;
    bf16_t* O; int ldc; const float* bias; int split_cols; size_t split_stride;
    __device__ __forceinline__ void operator()(const f32x4 (&acc)[2][2][4][2], const Unit& u, int wr, int wc, int fr, int fq) const {
        const int row0 = u.pm * BM + wr * 64 + fr; int colt = u.pn * BM; bf16_t* base = O;
        if (split_cols) { const int t = colt / split_cols; base += (size_t)t * split_stride; colt -= t * split_cols; }
        const int col0 = colt + wc * 32 + 8 * fq, bcol0 = u.pn * BM + wc * 32 + 8 * fq;
        f32x4 bv[2][2];
#pragma unroll
        for (int bj = 0; bj < 2; ++bj)
#pragma unroll
            for (int n = 0; n < 2; ++n) bv[bj][n] = bias ? *(const f32x4*)(bias + bcol0 + bj * HALF + 4 * n) : (f32x4){0.f, 0.f, 0.f, 0.f};
#pragma unroll
        for (int ai = 0; ai < 2; ++ai)
#pragma unroll
            for (int m = 0; m < 4; ++m) { bf16_t* rowp = base + (size_t)(row0 + ai * HALF + m * 16) * ldc + col0;
#pragma unroll
                for (int bj = 0; bj < 2; ++bj) { f32x4 v0 = acc[ai][bj][m][0] + bv[bj][0], v1 = acc[ai][bj][m][1] + bv[bj][1];
                    if (ACT == 1) { f32x2 a = gelu_pk((f32x2){v0[0], v0[1]}), b = gelu_pk((f32x2){v0[2], v0[3]}), c = gelu_pk((f32x2){v1[0], v1[1]}), d = gelu_pk((f32x2){v1[2], v1[3]});
                        v0 = (f32x4){a.x, a.y, b.x, b.y}; v1 = (f32x4){c.x, c.y, d.x, d.y}; }
                    if (ACT == 2) {
#pragma unroll
                        for (int j = 0; j < 4; ++j) { v0[j] = 0.5f * v0[j] * (1.0f + erff(v0[j] * 0.70710678f)); v1[j] = 0.5f * v1[j] * (1.0f + erff(v1[j] * 0.70710678f)); } }
                    u32x4 w; w.x = cvt_pk_bf16(v0[0], v0[1]); w.y = cvt_pk_bf16(v0[2], v0[3]); w.z = cvt_pk_bf16(v1[0], v1[1]); w.w = cvt_pk_bf16(v1[2], v1[3]);
                    *(u32x4*)(rowp + bj * HALF) = w; } }
    }
};

struct PanelStats {
    unsigned* xbuf;
    unsigned* cnt;
    unsigned* tmo;
    int ntn; float eps;
    unsigned code;
    __device__ __forceinline__ bool run(const f32x4 (&v)[2][2][4][2], const Unit& u, int wr, int wc, int fr, int fq, PG8_LAS unsigned char* lds, int wid, int lane) const {
        typedef float f32x2v __attribute__((ext_vector_type(2)));
        PG8_LAS f32x2v* P = (PG8_LAS f32x2v*)lds;
        PG8_LAS f32x2v* S = (PG8_LAS f32x2v*)(lds + 8192);
        PG8_LAS unsigned* flag = (PG8_LAS unsigned*)(lds + 8192 + 2048);
#pragma unroll
        for (int ai = 0; ai < 2; ++ai)
#pragma unroll
            for (int m = 0; m < 4; ++m) {
                float s = 0.f;
#pragma unroll
                for (int bj = 0; bj < 2; ++bj)
#pragma unroll
                    for (int n = 0; n < 2; ++n) { const f32x4 x = v[ai][bj][m][n]; s += (x[0] + x[1]) + (x[2] + x[3]); }
                s += __shfl_xor(s, 16); s += __shfl_xor(s, 32);
                const float mw = s * (1.0f / 64.0f); float q = 0.f;
#pragma unroll
                for (int bj = 0; bj < 2; ++bj)
#pragma unroll
                    for (int n = 0; n < 2; ++n) { const f32x4 d = v[ai][bj][m][n] - mw; q += (d[0] * d[0] + d[1] * d[1]) + (d[2] * d[2] + d[3] * d[3]); }
                q += __shfl_xor(q, 16); q += __shfl_xor(q, 32);
                if (fq == 0) P[(ai * HALF + wr * 64 + m * 16 + fr) * 4 + wc] = (f32x2v){mw, q};
            }
        asm volatile("s_waitcnt lgkmcnt(0)" ::: "memory"); __builtin_amdgcn_s_barrier(); asm volatile("" ::: "memory");
#if defined(BROKEN_NO_WAIT)
        if (blockIdx.x >= 64) { const long long t0 = clock64(); while (clock64() - t0 < 60000) __builtin_amdgcn_s_sleep(8); }
#endif
        const int row = wid * 32 + (lane & 31);
        if (lane < 32) {
            const f32x2v a = P[row * 4 + 0], b = P[row * 4 + 1], c = P[row * 4 + 2], d = P[row * 4 + 3];
            const float mt = (a.x + b.x + c.x + d.x) * 0.25f;
            const float da = a.x - mt, db = b.x - mt, dc = c.x - mt, dd = d.x - mt;
            const float m2 = (a.y + b.y) + (c.y + d.y) + 64.0f * ((da * da + db * db) + (dc * dc + dd * dd));
            unsigned long long* slot = (unsigned long long*)xbuf + ((size_t)(u.pm * BM + row) * 4 + u.pn);
            __hip_atomic_store(slot, ((unsigned long long)__float_as_uint(m2) << 32) | __float_as_uint(mt), __ATOMIC_RELAXED, __HIP_MEMORY_SCOPE_AGENT);
        }
        asm volatile("s_waitcnt vmcnt(0)" ::: "memory");
        if (lane == 0) __hip_atomic_fetch_add(cnt + 64 * u.pm, 1u, __ATOMIC_RELAXED, __HIP_MEMORY_SCOPE_AGENT);
        if (wid == 0) {
            bool dead = false; const unsigned long long t0 = __builtin_amdgcn_s_memrealtime(); const unsigned want = 8u * (unsigned)ntn;
            for (;;) {
#if defined(BROKEN_NO_WAIT)
                break;
#endif
                if ((unsigned)__builtin_amdgcn_readfirstlane(__hip_atomic_load(cnt + 64 * u.pm, __ATOMIC_RELAXED, __HIP_MEMORY_SCOPE_AGENT)) >= want) break;
                if (__builtin_amdgcn_s_memrealtime() - t0 > 2000000ull) {
                    if (lane == 0) { unsigned expect = 0u; __hip_atomic_compare_exchange_strong(tmo + 1, &expect, code | (unsigned)(u.pm & 0xff), __ATOMIC_RELAXED, __ATOMIC_RELAXED, __HIP_MEMORY_SCOPE_AGENT);
                                     __hip_atomic_store(tmo, 1u, __ATOMIC_RELAXED, __HIP_MEMORY_SCOPE_AGENT); }
                    dead = true; break; }
                __builtin_amdgcn_s_sleep(2);
            }
            __builtin_amdgcn_fence(__ATOMIC_ACQUIRE, "agent");
            if (lane == 0) flag[0] = dead ? 1u : 0u;
        }
        asm volatile("s_waitcnt vmcnt(0) lgkmcnt(0)" ::: "memory"); __builtin_amdgcn_s_barrier(); asm volatile("" ::: "memory");
        const bool bad = flag[0] != 0u;
        if (lane < 32) {
            const unsigned long long* slot = (const unsigned long long*)xbuf + (size_t)(u.pm * BM + row) * 4; float mt[4], m2[4]; float ms = 0.f;
#pragma unroll
            for (int t = 0; t < 4; ++t) { if (t < ntn) { const unsigned long long w = __hip_atomic_load(slot + t, __ATOMIC_RELAXED, __HIP_MEMORY_SCOPE_AGENT); mt[t] = __uint_as_float((unsigned)w); m2[t] = __uint_as_float((unsigned)(w >> 32)); } else { mt[t] = 0.f; m2[t] = 0.f; } ms += mt[t]; }
            const float mean = ms / (float)ntn; float q = 0.f;
#pragma unroll
            for (int t = 0; t < 4; ++t) if (t < ntn) { const float dm = mt[t] - mean; q += m2[t] + 256.0f * dm * dm; }
            S[row] = (f32x2v){mean, 1.0f / sqrtf(q / (256.0f * (float)ntn) + eps)};
        }
        asm volatile("s_waitcnt lgkmcnt(0)" ::: "memory"); __builtin_amdgcn_s_barrier(); asm volatile("" ::: "memory");
        return bad;
    }
};
struct EpiLnRes {
    static constexpr bool PERM = false, AFTER_DRAIN = true;
    const float* base; float* out; int ldc; const float* bias; PanelStats st; unsigned poison;
    __device__ __forceinline__ void refuse(size_t i0, size_t stride, int M, int N) const { const float q = __builtin_nanf(""); for (size_t i = i0; i < (size_t)M * N; i += stride) out[(i / N) * ldc + i % N] = q;
        if (i0 == 0) { unsigned expect = 0u; __hip_atomic_compare_exchange_strong(st.tmo + 1, &expect, 0x7f0u, __ATOMIC_RELAXED, __ATOMIC_RELAXED, __HIP_MEMORY_SCOPE_AGENT); __hip_atomic_store(st.tmo, 1u, __ATOMIC_RELAXED, __HIP_MEMORY_SCOPE_AGENT); } }
    __device__ __forceinline__ void fused(f32x4 (&acc)[2][2][4][2], const Unit& u, int wr, int wc, int fr, int fq, PG8_LAS unsigned char* lds, int wid, int lane) const {
        typedef float f32x2v __attribute__((ext_vector_type(2)));
        const PG8_LAS f32x2v* S = (const PG8_LAS f32x2v*)(lds + 8192);
        const int col0 = u.pn * BM + wc * 32 + 4 * fq;
#pragma unroll
        for (int bj = 0; bj < 2; ++bj)
#pragma unroll
            for (int n = 0; n < 2; ++n) { const f32x4 bv = bias ? *(const f32x4*)(bias + col0 + bj * HALF + n * 16) : (f32x4){0.f, 0.f, 0.f, 0.f};
#pragma unroll
                for (int ai = 0; ai < 2; ++ai)
#pragma unroll
                    for (int m = 0; m < 4; ++m) acc[ai][bj][m][n] += bv; }
        const bool bad = st.run(acc, u, wr, wc, fr, fq, lds, wid, lane) || poison != 0u;
        const float qnan = __builtin_nanf("");
#pragma unroll
        for (int ai = 0; ai < 2; ++ai)
#pragma unroll
            for (int m = 0; m < 4; ++m) { const int r = ai * HALF + wr * 64 + m * 16 + fr; const f32x2v sr = S[r]; const size_t off = (size_t)(u.pm * BM + r) * ldc + col0;
#pragma unroll
                for (int bj = 0; bj < 2; ++bj)
#pragma unroll
                    for (int n = 0; n < 2; ++n) { const f32x4 bs = *(const f32x4*)(base + off + bj * HALF + n * 16); f32x4 o = bs + (acc[ai][bj][m][n] - sr.x) * sr.y;
                        if (bad) o = (f32x4){qnan, qnan, qnan, qnan}; *(f32x4*)(out + off + bj * HALF + n * 16) = o; }
                asm volatile("" ::: "memory"); }
    }
};
struct EpiLnResLn {
    static constexpr bool PERM = false, AFTER_DRAIN = true;
    const float* base; float* out; bf16_t* xn; int ldc; const float* bias; PanelStats st1, st2; unsigned poison;
    __device__ __forceinline__ void refuse(size_t i0, size_t stride, int M, int N) const { const float q = __builtin_nanf(""); for (size_t i = i0; i < (size_t)M * N; i += stride) { const size_t o = (i / N) * ldc + i % N; out[o] = q; xn[o] = (bf16_t)0x7fc0u; }
        if (i0 == 0) { unsigned expect = 0u; __hip_atomic_compare_exchange_strong(st1.tmo + 1, &expect, 0x7f0u, __ATOMIC_RELAXED, __ATOMIC_RELAXED, __HIP_MEMORY_SCOPE_AGENT); __hip_atomic_store(st1.tmo, 1u, __ATOMIC_RELAXED, __HIP_MEMORY_SCOPE_AGENT); } }
    __device__ __forceinline__ void fused(f32x4 (&acc)[2][2][4][2], const Unit& u, int wr, int wc, int fr, int fq, PG8_LAS unsigned char* lds, int wid, int lane) const {
        typedef float f32x2v __attribute__((ext_vector_type(2))); typedef unsigned u32x2v __attribute__((ext_vector_type(2)));
        const PG8_LAS f32x2v* S = (const PG8_LAS f32x2v*)(lds + 8192);
        const int col0 = u.pn * BM + wc * 32 + 4 * fq;
#pragma unroll
        for (int bj = 0; bj < 2; ++bj)
#pragma unroll
            for (int n = 0; n < 2; ++n) { const f32x4 bv = bias ? *(const f32x4*)(bias + col0 + bj * HALF + n * 16) : (f32x4){0.f, 0.f, 0.f, 0.f};
#pragma unroll
                for (int ai = 0; ai < 2; ++ai)
#pragma unroll
                    for (int m = 0; m < 4; ++m) acc[ai][bj][m][n] += bv; }
        bool bad = st1.run(acc, u, wr, wc, fr, fq, lds, wid, lane) || poison != 0u;
        const float qnan = __builtin_nanf("");
#pragma unroll
        for (int ai = 0; ai < 2; ++ai)
#pragma unroll
            for (int m = 0; m < 4; ++m) { const int r = ai * HALF + wr * 64 + m * 16 + fr; const f32x2v sr = S[r]; const size_t off = (size_t)(u.pm * BM + r) * ldc + col0;
#pragma unroll
                for (int bj = 0; bj < 2; ++bj)
#pragma unroll
                    for (int n = 0; n < 2; ++n) { const f32x4 bs = *(const f32x4*)(base + off + bj * HALF + n * 16); acc[ai][bj][m][n] = bs + (acc[ai][bj][m][n] - sr.x) * sr.y; }
                asm volatile("" : "+v"(acc[ai][0][m][0]), "+v"(acc[ai][0][m][1]), "+v"(acc[ai][1][m][0]), "+v"(acc[ai][1][m][1]));
                if (m & 1) asm volatile("" ::: "memory"); }
        const bool bad1 = bad;
        bad = st2.run(acc, u, wr, wc, fr, fq, lds, wid, lane) || bad;
#pragma unroll
        for (int ai = 0; ai < 2; ++ai)
#pragma unroll
            for (int m = 0; m < 4; ++m) { const int r = ai * HALF + wr * 64 + m * 16 + fr; const f32x2v sr = S[r]; const size_t off = (size_t)(u.pm * BM + r) * ldc + col0;
#pragma unroll
                for (int bj = 0; bj < 2; ++bj)
#pragma unroll
                    for (int n = 0; n < 2; ++n) { const f32x4 x1 = acc[ai][bj][m][n]; *(f32x4*)(out + off + bj * HALF + n * 16) = bad1 ? (f32x4){qnan, qnan, qnan, qnan} : x1;
                        const f32x4 o = (x1 - sr.x) * sr.y; u32x2v w; w.x = cvt_pk_bf16(o[0], o[1]); w.y = cvt_pk_bf16(o[2], o[3]);
                        if (bad) { w.x = 0x7fc07fc0u; w.y = 0x7fc07fc0u; } *(u32x2v*)(xn + off + bj * HALF + n * 16) = w; }
                asm volatile("" ::: "memory"); }
    }
};

template <class Epi, class Sched, bool STAMP = false>
__device__ __forceinline__ void gemm_phase(PG8_LAS unsigned char* lds, const Gemm g, const Sched& S, const Epi& E, unsigned long long* stamps) {
    const int tid = threadIdx.x, wid = __builtin_amdgcn_readfirstlane(tid >> 6), lane = tid & 63, wr = wid >> 2, wc = wid & 3, fr = lane & 15, fq = lane >> 4;
    const int K = g.K, nt = K / BK;
    int ts_lo = 0, ts_hi = 0, nts = 0; const unsigned long long rt_entry = STAMP ? (unsigned long long)wall_clock64() : 0ull;
#define PG8_STAMP() do { if (STAMP && wid == 0 && nts < 64) { const unsigned long long _c = (unsigned long long)clock64(); \
        ts_lo = (lane == nts) ? (int)(unsigned)_c : ts_lo; ts_hi = (lane == nts) ? (int)(unsigned)(_c >> 32) : ts_hi; ++nts; } } while (0)
    PG8_STAMP();
    unsigned voffA[2], voffB[2];
#pragma unroll
    for (int i = 0; i < 2; ++i) { int R, C; stage_rc(tid * 16 + i * 8192, R, C); const int Rb = Epi::PERM ? ((R & ~31) + perm32(R & 31)) : R;
        voffA[i] = (unsigned)(R * K + C) * 2u; voffB[i] = (unsigned)(Rb * K + C) * 2u; }
    const size_t kstep = (size_t)(BK * 2);
    const size_t hstep = (size_t)HALF * K * 2;
    const size_t tstep = 2 * hstep;
    const unsigned ldsw = (unsigned)wid * 1024u;
    const int aoff = lds_byte(wr * 64 + fr, fq * 8), boff = lds_byte(wc * 32 + fr, fq * 8);
#define PG8_SA(b, h) (((b) * 2 + (h)) * HTB)
#define PG8_SB(b, h) ((4 + (b) * 2 + (h)) * HTB)
#define PG8_STAGE(bufoff, gbase, voff) do { _Pragma("unroll") for (int _i = 0; _i < 2; ++_i) \
        __builtin_amdgcn_global_load_lds((const unsigned*)((const char*)(gbase) + (voff)[_i]), (PG8_LAS unsigned*)(lds + (bufoff) + ldsw + _i * 8192), 16, 0, 0); } while (0)
#define PG8_LDA(dst, b, h) do { _Pragma("unroll") for (int m = 0; m < 4; ++m) _Pragma("unroll") for (int k = 0; k < 2; ++k) dst[m][k] = *(const PG8_LAS bf16x8*)(lds + PG8_SA(b, h) + aoff + m * 2048 + k * 1024); } while (0)
#define PG8_LDB(dst, b, h) do { _Pragma("unroll") for (int n = 0; n < 2; ++n) _Pragma("unroll") for (int k = 0; k < 2; ++k) dst[n][k] = *(const PG8_LAS bf16x8*)(lds + PG8_SB(b, h) + boff + n * 2048 + k * 1024); } while (0)
#define PG8_MMA(ai, bj, At, Bt) do { __builtin_amdgcn_s_setprio(1); _Pragma("unroll") for (int m = 0; m < 4; ++m) _Pragma("unroll") for (int n = 0; n < 2; ++n) _Pragma("unroll") for (int k = 0; k < 2; ++k) \
        acc[ai][bj][m][n] = __builtin_amdgcn_mfma_f32_16x16x32_bf16(Bt[n][k], At[m][k], acc[ai][bj][m][n], 0, 0, 0); __builtin_amdgcn_s_setprio(0); } while (0)
#define PG8_WAIT_V(n) asm volatile("s_waitcnt vmcnt(" #n ")" ::: "memory")
#define PG8_WAIT_L(n) asm volatile("s_waitcnt lgkmcnt(" #n ")" ::: "memory")
#define PG8_BAR __builtin_amdgcn_s_barrier()
#define PG8_SCHED __builtin_amdgcn_sched_barrier(0)
    Unit cur, nxt; int ui = 0;
    if (!S.next(0, cur)) return;
    f32x4 acc[2][2][4][2];
#pragma unroll
    for (int a = 0; a < 2; ++a)
#pragma unroll
        for (int b = 0; b < 2; ++b)
#pragma unroll
            for (int m = 0; m < 4; ++m)
#pragma unroll
                for (int n = 0; n < 2; ++n) acc[a][b][m][n] = (f32x4){0.f, 0.f, 0.f, 0.f};
    bf16x8 At[4][2], B0[2][2], B1[2][2];
    const char* cA = (const char*)g.A + (size_t)cur.pm * tstep; const char* cB = (const char*)g.Bt + (size_t)cur.pn * tstep;
    S.a_ready(cur);
    PG8_STAGE(PG8_SB(0, 0), cB, voffB); PG8_STAGE(PG8_SA(0, 0), cA, voffA); PG8_STAGE(PG8_SB(0, 1), cB + hstep, voffB); PG8_STAGE(PG8_SA(0, 1), cA + hstep, voffA);
    if (wr == 1) PG8_BAR;
    PG8_WAIT_V(4); PG8_BAR;
    PG8_STAGE(PG8_SB(1, 0), cB + kstep, voffB); PG8_STAGE(PG8_SA(1, 0), cA + kstep, voffA); PG8_STAGE(PG8_SB(1, 1), cB + hstep + kstep, voffB);
    PG8_WAIT_V(6); PG8_BAR;
    PG8_STAMP();
    for (;;) {
        const bool has_next = S.next(ui + 1, nxt);
        const char* nA = has_next ? (const char*)g.A + (size_t)nxt.pm * tstep : cA; const char* nB = has_next ? (const char*)g.Bt + (size_t)nxt.pn * tstep : cB;
        for (int t = 0; t < nt; t += 2) {
            const bool last = (t == nt - 2);
            const char* a1 = cA + (size_t)(t + 1) * kstep;
            const char* a2 = last ? nA : cA + (size_t)(t + 2) * kstep; const char* b2 = last ? nB : cB + (size_t)(t + 2) * kstep;
            const char* a3 = a2 + kstep; const char* b3 = b2 + kstep;
            if (last && has_next) S.a_ready(nxt);
            PG8_LDB(B0, 0, 0); PG8_SCHED; PG8_LDA(At, 0, 0); PG8_STAGE(PG8_SA(1, 1), a1 + hstep, voffA);
            PG8_WAIT_L(8); PG8_BAR; PG8_WAIT_L(0); PG8_MMA(0, 0, At, B0); PG8_BAR; PG8_SCHED;
            PG8_LDB(B1, 0, 1); PG8_STAGE(PG8_SB(0, 0), b2, voffB);
            PG8_BAR; PG8_WAIT_L(0); PG8_MMA(0, 1, At, B1); PG8_BAR;
            PG8_LDA(At, 0, 1); PG8_STAGE(PG8_SA(0, 0), a2, voffA);
            PG8_BAR; PG8_WAIT_L(0); PG8_MMA(1, 0, At, B0); PG8_BAR; PG8_SCHED;
            PG8_STAGE(PG8_SB(0, 1), b2 + hstep, voffB);
            PG8_WAIT_V(6); PG8_BAR; PG8_MMA(1, 1, At, B1); PG8_BAR;
            PG8_LDB(B0, 1, 0); PG8_SCHED; PG8_LDA(At, 1, 0); PG8_STAGE(PG8_SA(0, 1), a2 + hstep, voffA);
            PG8_WAIT_L(8); PG8_BAR; PG8_WAIT_L(0); PG8_MMA(0, 0, At, B0); PG8_BAR; PG8_SCHED;
            PG8_LDB(B1, 1, 1); PG8_STAGE(PG8_SB(1, 0), b3, voffB);
            PG8_BAR; PG8_WAIT_L(0); PG8_MMA(0, 1, At, B1); PG8_BAR;
            PG8_LDA(At, 1, 1); PG8_STAGE(PG8_SA(1, 0), a3, voffA);
            PG8_BAR; PG8_WAIT_L(0); PG8_MMA(1, 0, At, B0); PG8_BAR; PG8_SCHED;
            PG8_STAGE(PG8_SB(1, 1), b3 + hstep, voffB);
            PG8_WAIT_V(6); PG8_BAR; PG8_MMA(1, 1, At, B1); PG8_BAR;
        }
        PG8_STAMP();
        if constexpr (!Epi::AFTER_DRAIN) { E(acc, cur, wr, wc, fr, fq); S.done(cur); }
        PG8_STAMP();
        if (!has_next) break;
#pragma unroll
        for (int a = 0; a < 2; ++a)
#pragma unroll
            for (int b = 0; b < 2; ++b)
#pragma unroll
                for (int m = 0; m < 4; ++m)
#pragma unroll
                    for (int n = 0; n < 2; ++n) acc[a][b][m][n] = (f32x4){0.f, 0.f, 0.f, 0.f};
        cur = nxt; cA = nA; cB = nB; ++ui;
    }
    PG8_WAIT_V(0);
    if (wr == 0) PG8_BAR;
    PG8_BAR;
    if constexpr (Epi::AFTER_DRAIN) { E.fused(acc, cur, wr, wc, fr, fq, lds, wid, lane); S.done(cur); }
    PG8_STAMP();
    if (STAMP && wid == 0) { stamps[lane] = lane < nts ? (((unsigned long long)(unsigned)ts_hi << 32) | (unsigned)ts_lo) : 0ull;
        if (lane == 62) stamps[62] = rt_entry; if (lane == 63) stamps[63] = (unsigned long long)wall_clock64(); }
#undef PG8_STAMP
#undef PG8_SA
#undef PG8_SB
#undef PG8_STAGE
#undef PG8_LDA
#undef PG8_LDB
#undef PG8_MMA
#undef PG8_WAIT_V
#undef PG8_WAIT_L
#undef PG8_BAR
#undef PG8_SCHED
}
}

#define XB_TMO      128
#define XB_XCNT(j)  (256  + 64 * (j))
#define XB_XSUB(j)  (1280 + 64 * (j))
#define XB_XGEN(j)  (2304 + 64 * (j))
#define XB_TOP      3328
#define XB_TOPGEN   3392
#define XCD_BAR_WORDS 3456
#define XB_SPIN_CAP (1u << 22)
#define LAS __attribute__((address_space(3)))
DI unsigned xb_ld(unsigned* p) { return __hip_atomic_load(p, __ATOMIC_RELAXED, __HIP_MEMORY_SCOPE_AGENT); }
DI unsigned xb_add(unsigned* p, unsigned v) { return __hip_atomic_fetch_add(p, v, __ATOMIC_RELAXED, __HIP_MEMORY_SCOPE_AGENT); }
DI unsigned xb_xcc_id() { return (unsigned)__builtin_amdgcn_s_getreg((3 << 11) | 20) & 0xFu; }
#define XB_SPIN(cond, bar) do { unsigned _sp = 0; while (cond) { __builtin_amdgcn_s_sleep(1); \
    if ((++_sp & 255u) == 0u) { if (xb_ld(&(bar)[XB_TMO])) break; if (_sp > XB_SPIN_CAP) { atomicAdd(&(bar)[XB_TMO], 1u); break; } } } } while (0)
struct XcdBarrier { unsigned* bar; unsigned x; volatile LAS unsigned* st; };
DI XcdBarrier xcd_barrier_post(unsigned* bar, volatile LAS unsigned* st) {
  XcdBarrier b; b.bar = bar; b.x = xb_xcc_id(); b.st = st;
  if (threadIdx.x == 0) (void)xb_add(&bar[XB_XCNT(b.x)], 1u);
  return b;
}
DI void xcd_barrier_complete(unsigned* bar, unsigned x, unsigned& nloc, unsigned& nx) {
  const unsigned G = gridDim.x * gridDim.y * gridDim.z;
  unsigned sum, cnt, mine, sp = 0u;
  for (;;) {
    sum = 0u; cnt = 0u; mine = 0u;
#pragma unroll
    for (unsigned j = 0; j < 16; ++j) { const unsigned c = xb_ld(&bar[XB_XCNT(j)]); sum += c; cnt += (c > 0u) ? 1u : 0u; mine = (j == x) ? c : mine; }
    if (sum == G) break;
    __builtin_amdgcn_s_sleep(1);
    if ((++sp & 255u) == 0u) { if (xb_ld(&bar[XB_TMO])) break; if (sp > XB_SPIN_CAP) { atomicAdd(&bar[XB_TMO], 1u); break; } }
  }
  nloc = mine > 0u ? mine : 1u; nx = cnt > 0u ? cnt : 1u;
}
DI void xcd_barrier(const XcdBarrier& b) {
  asm volatile("s_waitcnt vmcnt(0)" ::: "memory");
  __syncthreads();
  if (threadIdx.x == 0) {
    unsigned* bar = b.bar;
    __builtin_amdgcn_s_waitcnt(0);
    unsigned nloc = b.st[0], nx = b.st[1];
    if (nloc == 0u) { xcd_barrier_complete(bar, b.x, nloc, nx); b.st[0] = nloc; b.st[1] = nx; }
    const unsigned old = xb_add(&bar[XB_XSUB(b.x)], 1u);
    const unsigned gen = old / nloc;
    if (old + 1u == (gen + 1u) * nloc) {
      __builtin_amdgcn_fence(__ATOMIC_RELEASE, "agent");
      asm volatile("s_waitcnt vmcnt(0)" ::: "memory");
      const unsigned og = xb_add(&bar[XB_TOP], 1u);
      const unsigned tg = og / nx;
      if (og + 1u == (tg + 1u) * nx) xb_add(&bar[XB_TOPGEN], 1u);
      else XB_SPIN(xb_ld(&bar[XB_TOPGEN]) == tg, bar);
      __builtin_amdgcn_fence(__ATOMIC_ACQUIRE, "agent");
      xb_add(&bar[XB_XGEN(b.x)], 1u);
      asm volatile("s_waitcnt vmcnt(0)" ::: "memory");
    } else {
      XB_SPIN(xb_ld(&bar[XB_XGEN(b.x)]) == gen, bar);
      __builtin_amdgcn_fence(__ATOMIC_ACQUIRE, "agent");
      asm volatile("s_waitcnt vmcnt(0)" ::: "memory");
    }
  }
  __syncthreads();
}

#define GPTR(T, x) ((T*)(__attribute__((address_space(1))) T*)(x))
__global__ void __launch_bounds__(NT) mega(P p) {
  extern __shared__ __attribute__((aligned(16))) unsigned char lds[];
  cg::grid_group grid = cg::this_grid();
  volatile LAS unsigned* st = (volatile LAS unsigned*)(lds + LDS_BYTES - 16);
  if (threadIdx.x < 4) st[threadIdx.x] = 0u;
  __syncthreads();
  const XcdBarrier xbar = xcd_barrier_post((unsigned*)(p.ws + WS_BAR), st);
  phase0(p, lds);
  grid.sync();
  const P& p0 = p;
  for (int step = 0; step < 70; ++step) {
    const int g = step / 35, rem = step - g * 35, layer = rem / 7, sub = rem - layer * 7;
    const int kind = layer % 3, jl = layer / 3;
    const int T = g ? 16384 : 8192, Lmask = g ? 4095 : 255;
    int op = -1;
    if (layer == 4) op = (sub == 0) ? 0 : -1;
    else if (sub == 0) op = 0;
    else if (kind == 0) op = sub == 1 ? 1 : (sub <= 3 ? 4 : (sub == 4 ? 2 : (sub == 5 ? 3 : 4)));
    else if (kind == 1) op = sub == 1 ? 5 : (sub == 2 ? 6 : (sub == 3 ? 4 : -1));
    else op = sub == 1 ? 4 : (sub == 2 ? 7 : (sub == 3 ? 4 : -1));
    if (op < 0) continue;
    P p = p0;
    { size_t zo_ = 0; asm volatile("" : "+s"(zo_)); p.ws = p0.ws + zo_; p.out = p0.out + zo_; }
    bf16_t* slots = (bf16_t*)(p.ws + WS_SLOT);
    const bf16_t* W = (const bf16_t*)(p.ws + WS_W);
    if (op == 0) {
      const float* xin = p.in[g]; float* xout = p.out + (g ? OUT_YS : OUT_YP);
      phase_norm(p, g, layer - 1, layer < 4 ? layer : -1, layer <= 1 ? xin : xout, xout, slots + SLOT_ELEMS, slots);
      if (kind == 1 && g == 1 && layer < 4) phase_cache_copy(p);
    } else if (op == 1) {
      phase_gemm<1, 0>(p, g, slots, W + (size_t)(RW_IN0 + jl * RW_STRIDE + 4096) * 1024, T, 256, p.in[11] + jl * 6144, Lmask, slots + SLOT_ELEMS, 1, lds, 32);
      phase_xsmix(p, g, jl);
    } else if (op == 2) {
      for (int rep = 0; rep < opq(REP_SCAN); ++rep) phase_scan(p, g, jl, lds);
    } else if (op == 3) {
      phase_rwkv_combine(p, g, jl);
    } else if (op == 4) {
      const int npair = (kind == 0 && sub <= 3) ? 2 : 1;
      for (int q = 0; q < opq(npair); ++q) {
        const bf16_t* A; const bf16_t* Bt; int N; bf16_t* dst;
        if (kind == 0 && sub <= 3) {
          const int m = (sub - 2) * 2 + q; const int ds = m == 0 ? 1 : (m == 1 ? 0 : m);
          A = slots + (size_t)(2 + m) * SLOT_ELEMS; Bt = W + (size_t)(RW_IN0 + jl * RW_STRIDE + m * 1024) * 1024; N = 1024; dst = slots + (size_t)ds * SLOT_ELEMS;
        } else if (kind == 2 && sub == 1) { A = slots; Bt = W + (size_t)CV_IN * 1024; N = 4096; dst = slots + 2 * SLOT_ELEMS; }
        else {
          N = 1024; dst = slots + SLOT_ELEMS;
          if (kind == 0) { A = slots + 3 * SLOT_ELEMS; Bt = W + (size_t)(RW_OUT0 + jl * RW_STRIDE) * 1024; }
          else if (kind == 1) { A = slots + 5 * SLOT_ELEMS; Bt = W + (size_t)AT_OUT * 1024; }
          else { A = slots; Bt = W + (size_t)CV_OUT * 1024; }
        }
        pg8::Gemm gg{A, Bt, T, N, 1024}; pg8::StaticOrder S; S.init(T, N, (int)gridDim.x, (int)((blockIdx.x + 128 * q) & 255));
        pg8::EpiBf16<0> E{dst, 1024, nullptr, N > 1024 ? 1024 : 0, SLOT_ELEMS};
        pg8::gemm_phase<pg8::EpiBf16<0>, pg8::StaticOrder, false>((PG8_LAS unsigned char*)(unsigned)(unsigned long long)lds, gg, S, E, nullptr);
      }
    } else if (op == 5) {
      for (int rep = 0; rep < opq(REP_GEMM); ++rep) phase_gemm<0, 1>(p, g, slots, W + (size_t)AT_IN * 1024, T, 2560, nullptr, 0, nullptr, 0, lds);
    } else if (op == 6) {
      for (int rep = 0; rep < opq(REP_ATTN); ++rep) phase_attn(p, g, lds);
    } else {
      phase_conv(p, g);
    }
    if (!(g == 1 && layer == 4)) for (int rep = 0; rep < opq(REP_SYNC); ++rep) xcd_barrier(xbar);
  }
}

extern "C" void kernel_launch(void* const* d_in, const int* in_sizes, int n_in, void* d_out, int out_size, void* d_ws, size_t ws_size, hipStream_t stream) {
  static int grid_blocks = 0;
  if (!grid_blocks) {
    int dev = 0, cus = 0, per_cu = 0;
    hipGetDevice(&dev);
    hipDeviceGetAttribute(&cus, hipDeviceAttributeMultiprocessorCount, dev);
    hipFuncSetAttribute((const void*)mega, hipFuncAttributeMaxDynamicSharedMemorySize, LDS_BYTES);
    hipOccupancyMaxActiveBlocksPerMultiprocessor(&per_cu, (const void*)mega, NT, LDS_BYTES);
    if (per_cu < 1) per_cu = 1;
    if (per_cu > 1) per_cu = 1;
    grid_blocks = cus * per_cu;
    if (ws_size < WS_SLOT + 6 * SLOT_ELEMS * 2) fprintf(stderr, "workspace too small: %zu\n", ws_size);
  }
  (void)hipMemsetAsync((unsigned char*)d_ws + WS_BAR, 0, XCD_BAR_WORDS * sizeof(unsigned), stream);
  P p{};
  for (int i = 0; i < 33; ++i) p.in[i] = (const float*)d_in[i];
  p.out = (float*)d_out; p.ws = (unsigned char*)d_ws;
  void* args[] = {&p};
  hipError_t e = hipLaunchCooperativeKernel((const void*)mega, dim3(grid_blocks), dim3(NT), args, LDS_BYTES, stream);
  if (e != hipSuccess) fprintf(stderr, "cooperative launch failed: %s (grid %d)\n", hipGetErrorString(e), grid_blocks);
}
```

```cpp
#include <hip/hip_runtime.h>
#include <hip/hip_cooperative_groups.h>
#include <cstdio>
namespace cg = cooperative_groups;

typedef unsigned short bf16_t;
using bf16x8 = __attribute__((ext_vector_type(8))) short;
using f32x16 = __attribute__((ext_vector_type(16))) float;
using u32x4 = __attribute__((ext_vector_type(4))) unsigned;
using u32x2 = __attribute__((ext_vector_type(2))) unsigned;

#define NT 512
#ifndef REP_GEMM
#define REP_GEMM 1
#endif
#ifndef REP_SCAN
#define REP_SCAN 1
#endif
#ifndef REP_ATTN
#define REP_ATTN 1
#endif
#ifndef REP_SYNC
#define REP_SYNC 1
#endif
#define DI __device__ __forceinline__
#define MFMA32(a, b, c) __builtin_amdgcn_mfma_f32_32x32x16_bf16((a), (b), (c), 0, 0, 0)

struct P { const float* in[33]; float* out; unsigned char* ws; };

constexpr size_t WS_ADA = 0;
constexpr size_t WS_ROPE = 262144;
constexpr size_t WS_BON = 327680;
constexpr size_t WS_HID = WS_BON + 2097152;
constexpr size_t WS_W = WS_HID + 8388608;
constexpr size_t WS_SLOT = WS_W + 39845888;
constexpr size_t SLOT_ELEMS = (size_t)16384 * 1024;
constexpr int RW_IN0 = 0, RW_OUT0 = 4352, RW_STRIDE = 5376, AT_IN = 10752, AT_OUT = 13312, CV_IN = 14336, CV_OUT = 18432;
constexpr size_t OUT_YP = 0, OUT_YS = 8388608, OUT_ST = 25165824, OUT_CK = 33554432, OUT_CV = 35651584;
constexpr int LDS_BYTES = 156416 + 16;
constexpr size_t WS_BAR = 278528;

typedef __bf16 bf16x2_t __attribute__((ext_vector_type(2)));
typedef float f32x2_t __attribute__((ext_vector_type(2)));
DI unsigned pack2(float a, float b) { f32x2_t v = {a, b}; return __builtin_bit_cast(unsigned, __builtin_convertvector(v, bf16x2_t)); }
DI unsigned f2bf(float x) { return (unsigned)__builtin_bit_cast(unsigned short, (__bf16)x); }
DI float bflo(unsigned u) { return __uint_as_float(u << 16); }
DI float bfhi(unsigned u) { return __uint_as_float(u & 0xffff0000u); }
DI float bf1(bf16_t u) { return __uint_as_float(((unsigned)u) << 16); }

template <int CTRL> DI float dppf(float v) { return __int_as_float(__builtin_amdgcn_update_dpp(0, __float_as_int(v), CTRL, 0xF, 0xF, true)); }
DI float reduce16(float v) { v += dppf<0xB1>(v); v += dppf<0x4E>(v); v += dppf<0x141>(v); v += dppf<0x140>(v); return v; }
DI float rdl(float v, int l) { return __int_as_float(__builtin_amdgcn_readlane(__float_as_int(v), l)); }
DI float wave_sum(float v) { v = reduce16(v); return (rdl(v, 0) + rdl(v, 16)) + (rdl(v, 32) + rdl(v, 48)); }
DI float xhalf_max(float x) { const auto r2 = __builtin_amdgcn_permlane32_swap(__float_as_uint(x), __float_as_uint(x), false, false); return fmaxf(__uint_as_float(r2[0]), __uint_as_float(r2[1])); }
DI float xhalf_sum(float x) { const auto r2 = __builtin_amdgcn_permlane32_swap(__float_as_uint(x), __float_as_uint(x), false, false); return __uint_as_float(r2[0]) + __uint_as_float(r2[1]); }
DI float quad_sum(float v) { v += dppf<0xB1>(v); v += dppf<0x4E>(v); return v; }
DI float silu(float x) { return x / (1.f + __expf(-x)); }
DI int opq(int v) { asm volatile("" : "+s"(v)); return v; }
DI int otid() { int t = threadIdx.x; asm volatile("" : "+v"(t)); return t; }

DI void conv_tiles(const float* __restrict__ src, int N, bf16_t* __restrict__ dst, float* lds) {
  const int tid = otid();
  const int tilesN = N >> 6, ntiles = 16 * tilesN;
  for (int tile = blockIdx.x; tile < ntiles; tile += gridDim.x) {
    const int kt = tile / tilesN, nt = tile - kt * tilesN, k0 = kt * 64, n0 = nt * 64;
#pragma unroll
    for (int i = 0; i < 8; ++i) { const int k = (tid >> 6) + 8 * i, n = tid & 63; lds[k * 65 + n] = src[(size_t)(k0 + k) * N + n0 + n]; }
    __syncthreads();
    { const int n = tid >> 3, kc = (tid & 7) * 8; u32x4 o;
#pragma unroll
      for (int j = 0; j < 4; ++j) o[j] = pack2(lds[(kc + 2 * j) * 65 + n], lds[(kc + 2 * j + 1) * 65 + n]);
      *(u32x4*)(dst + (size_t)(n0 + n) * 1024 + k0 + kc) = o; }
    __syncthreads();
  }
}

DI void phase0(const P& p, unsigned char* ldsb) {
  float* lds = (float*)ldsb;
  const int tid = otid();
  bf16_t* W = (bf16_t*)(p.ws + WS_W);
#pragma unroll 1
  for (int e = 0; e < opq(22); ++e) {
    const float* src; int N, drow;
    if (e < 18) {
      const int j = e / 9, q = e - j * 9;
      if (q < 4) { src = p.in[12] + (size_t)(j * 4 + q) * 1048576; N = 1024; drow = RW_IN0 + j * RW_STRIDE + q * 1024; }
      else if (q < 6) { src = p.in[14] + (size_t)(j * 2 + q - 4) * 65536; N = 64; drow = RW_IN0 + j * RW_STRIDE + 4096 + (q - 4) * 64; }
      else if (q < 8) { src = p.in[17] + (size_t)(j * 2 + q - 6) * 65536; N = 64; drow = RW_IN0 + j * RW_STRIDE + 4224 + (q - 6) * 64; }
      else { src = p.in[24] + (size_t)j * 1048576; N = 1024; drow = RW_OUT0 + j * RW_STRIDE; }
    } else if (e == 18) { src = p.in[25]; N = 2560; drow = AT_IN; }
    else if (e == 19) { src = p.in[28]; N = 1024; drow = AT_OUT; }
    else if (e == 20) { src = p.in[29]; N = 4096; drow = CV_IN; }
    else { src = p.in[32]; N = 1024; drow = CV_OUT; }
    conv_tiles(src, N, W + (size_t)drow * 1024, lds);
  }
  {
    float* scond = lds;
    float* red = lds + 5120;
    for (int e = tid; e < 5120; e += NT) { const int cnd = e >> 10, k = e & 1023; const float cv = cnd == 0 ? p.in[6][k] : p.in[5][(cnd - 1) * 1024 + k]; scond[e] = silu(cv); }
    __syncthreads();
    float* ada = (float*)(p.ws + WS_ADA);
    for (int task = blockIdx.x; task < 192; task += gridDim.x) {
      const int layer = task / 48, n0 = (task % 48) * 64, c = tid & 63, kg = tid >> 6;
      float a0 = 0.f, a1 = 0.f, a2 = 0.f, a3 = 0.f, a4 = 0.f;
      const float* wp = p.in[9] + ((size_t)layer * 1024 + kg * 128) * 3072 + n0 + c;
#pragma unroll 8
      for (int k = 0; k < 128; ++k) { const float w = wp[(size_t)k * 3072]; const int kk = kg * 128 + k;
        a0 += scond[kk] * w; a1 += scond[1024 + kk] * w; a2 += scond[2048 + kk] * w; a3 += scond[3072 + kk] * w; a4 += scond[4096 + kk] * w; }
      red[(kg * 5 + 0) * 64 + c] = a0; red[(kg * 5 + 1) * 64 + c] = a1; red[(kg * 5 + 2) * 64 + c] = a2; red[(kg * 5 + 3) * 64 + c] = a3; red[(kg * 5 + 4) * 64 + c] = a4;
      __syncthreads();
      if (tid < 320) { const int cnd = tid >> 6; float s = p.in[10][layer * 3072 + n0 + c];
#pragma unroll
        for (int q = 0; q < 8; ++q) s += red[(q * 5 + cnd) * 64 + c];
        ada[(cnd * 4 + layer) * 3072 + n0 + c] = s; }
      __syncthreads();
    }
  }
  if (blockIdx.x == gridDim.x - 1) {
    float* rope = (float*)(p.ws + WS_ROPE);
    for (int e = tid; e < 1024; e += NT) {
      const int pos = e >> 4, f = e & 15;
      double inv = 1.0; for (int q = 0; q < f; ++q) inv *= 0.5623413251903491;
      double ang = (double)pos * inv;
      const double twopi = 6.283185307179586476925286766559;
      double n = __builtin_rint(ang / twopi); double rr = ang - n * twopi;
      double r2 = rr * rr, sn = 0.0, cs = 0.0, ts = rr, tc = 1.0;
      for (int q = 0; q < 16; ++q) { cs += tc; sn += ts; tc = -tc * r2 / (double)((2 * q + 1) * (2 * q + 2)); ts = -ts * r2 / (double)((2 * q + 2) * (2 * q + 3)); }
      rope[e * 2] = (float)cs; rope[e * 2 + 1] = (float)sn;
    }
  }
}

DI void phase_norm(const P& p, int g, int lpost, int lpre, const float* __restrict__ xsrc, float* __restrict__ xdst,
                   const bf16_t* __restrict__ Mb, bf16_t* __restrict__ H) {
  const int T = g ? 16384 : 8192;
  const int tid = otid(); const int lane = tid & 63, wave = tid >> 6;
  const float* ada = (const float*)(p.ws + WS_ADA);
  float4 xn[4]; u32x2 mn[4];
  const int t0 = blockIdx.x * 8 + wave, tstep = gridDim.x * 8;
#pragma unroll
  for (int i = 0; i < 4; ++i) { xn[i] = make_float4(0.f, 0.f, 0.f, 0.f); mn[i] = (u32x2){0u, 0u}; }
  if (t0 < T) {
#pragma unroll
    for (int i = 0; i < 4; ++i) { xn[i] = *(const float4*)(xsrc + (size_t)t0 * 1024 + 256 * i + 4 * lane); if (lpost >= 0) mn[i] = *(const u32x2*)(Mb + (size_t)t0 * 1024 + 256 * i + 4 * lane); }
  }
  for (int t = t0; t < T; t += tstep) {
    const int cond = g ? 1 + (t >> 12) : 0;
    float4 x[4]; u32x2 mr[4];
#pragma unroll
    for (int i = 0; i < 4; ++i) { x[i] = xn[i]; mr[i] = mn[i]; }
    if (t + tstep < T) {
#pragma unroll
      for (int i = 0; i < 4; ++i) { xn[i] = *(const float4*)(xsrc + (size_t)(t + tstep) * 1024 + 256 * i + 4 * lane); if (lpost >= 0) mn[i] = *(const u32x2*)(Mb + (size_t)(t + tstep) * 1024 + 256 * i + 4 * lane); }
    }
    if (lpost >= 0) {
      float m[16]; float ss = 0.f;
#pragma unroll
      for (int i = 0; i < 4; ++i) { const u32x2 u = mr[i];
        m[4 * i] = bflo(u[0]); m[4 * i + 1] = bfhi(u[0]); m[4 * i + 2] = bflo(u[1]); m[4 * i + 3] = bfhi(u[1]); }
#pragma unroll
      for (int i = 0; i < 16; ++i) ss += m[i] * m[i];
      ss = wave_sum(ss);
      const float rs = rsqrtf(ss * (1.f / 1024.f) + 1e-6f);
      const float* gate = ada + (cond * 4 + lpost) * 3072 + 2048;
      const float* wpo = p.in[8] + lpost * 1024;
#pragma unroll
      for (int i = 0; i < 4; ++i) { const int c = 256 * i + 4 * lane; const float4 gt = *(const float4*)(gate + c); const float4 wv = *(const float4*)(wpo + c);
        x[i].x += gt.x * (m[4 * i] * rs * wv.x); x[i].y += gt.y * (m[4 * i + 1] * rs * wv.y); x[i].z += gt.z * (m[4 * i + 2] * rs * wv.z); x[i].w += gt.w * (m[4 * i + 3] * rs * wv.w);
        *(float4*)(xdst + (size_t)t * 1024 + c) = x[i]; }
    }
    if (lpre >= 0) {
      float ss = 0.f;
#pragma unroll
      for (int i = 0; i < 4; ++i) ss += x[i].x * x[i].x + x[i].y * x[i].y + x[i].z * x[i].z + x[i].w * x[i].w;
      ss = wave_sum(ss);
      const float rs = rsqrtf(ss * (1.f / 1024.f) + 1e-6f);
      const float* sh = ada + (cond * 4 + lpre) * 3072; const float* sc = sh + 1024; const float* wpr = p.in[7] + lpre * 1024;
#pragma unroll
      for (int i = 0; i < 4; ++i) { const int c = 256 * i + 4 * lane; const float4 s4 = *(const float4*)(sh + c); const float4 c4 = *(const float4*)(sc + c); const float4 wv = *(const float4*)(wpr + c);
        u32x2 o; o[0] = pack2(x[i].x * rs * wv.x * (1.f + c4.x) + s4.x, x[i].y * rs * wv.y * (1.f + c4.y) + s4.y);
        o[1] = pack2(x[i].z * rs * wv.z * (1.f + c4.z) + s4.z, x[i].w * rs * wv.w * (1.f + c4.w) + s4.w);
        *(u32x2*)(H + (size_t)t * 1024 + c) = o; }
    }
  }
}

DI void phase_xsmix(const P& p, int g, int jl) {
  const int T = g ? 16384 : 8192, Lmask = g ? 4095 : 255;
  const bf16_t* H = (const bf16_t*)(p.ws + WS_SLOT); bf16_t* XS = (bf16_t*)(p.ws + WS_SLOT) + 2 * SLOT_ELEMS;
  const float* mu = p.in[11] + jl * 6144;
#pragma unroll 2
  for (int e = blockIdx.x * NT + otid(); e < T * 128; e += gridDim.x * NT) {
    const int t = e >> 7, c = (e & 127) * 8; const size_t o = (size_t)t * 1024 + c; const int tl = t & Lmask;
    const u32x4 zz = {0u, 0u, 0u, 0u};
    const u32x4 hc = *(const u32x4*)(H + o);
    const u32x4 hp = tl != 0 ? *(const u32x4*)(H + o - 1024) : zz, hn = tl != Lmask ? *(const u32x4*)(H + o + 1024) : zz;
    float hv[8], xv[8];
#pragma unroll
    for (int i = 0; i < 4; ++i) { hv[2 * i] = bflo(hc[i]); hv[2 * i + 1] = bfhi(hc[i]);
      xv[2 * i] = 0.5f * (bflo(hp[i]) + bflo(hn[i])) - hv[2 * i]; xv[2 * i + 1] = 0.5f * (bfhi(hp[i]) + bfhi(hn[i])) - hv[2 * i + 1]; }
#pragma unroll
    for (int m = 0; m < 4; ++m) {
      const float4 m0 = *(const float4*)(mu + m * 1024 + c), m1 = *(const float4*)(mu + m * 1024 + c + 4);
      u32x4 w; w[0] = pack2(hv[0] + xv[0] * m0.x, hv[1] + xv[1] * m0.y); w[1] = pack2(hv[2] + xv[2] * m0.z, hv[3] + xv[3] * m0.w);
      w[2] = pack2(hv[4] + xv[4] * m1.x, hv[5] + xv[5] * m1.y); w[3] = pack2(hv[6] + xv[6] * m1.z, hv[7] + xv[7] * m1.w);
      *(u32x4*)(XS + (size_t)m * SLOT_ELEMS + o) = w;
    }
  }
}

DI void phase_cache_copy(const P& p) {
  bf16_t* Kb = (bf16_t*)(p.ws + WS_SLOT) + 4 * SLOT_ELEMS; bf16_t* Vt = Kb + SLOT_ELEMS / 2;
  for (int e = blockIdx.x * NT + otid(); e < 262144; e += gridDim.x * NT) {
    const int c = e & 255, pp = (e >> 8) & 255, b = e >> 16; const int kvh = c >> 6, d = c & 63;
    Kb[((size_t)b * 4352 + 4096 + pp) * 256 + c] = (bf16_t)f2bf(p.in[3][e]);
    Vt[((size_t)(b * 4 + kvh) * 64 + d) * 4352 + 4096 + pp] = (bf16_t)f2bf(p.in[4][e]);
  }
}

template <int SHIFT> DI void ld_half(const bf16_t* __restrict__ A, int t, int k, int Lmask, u32x4 (&raw)[4]) {
  raw[1] = *(const u32x4*)(A + (size_t)t * 1024 + k);
  raw[2] = *(const u32x4*)(A + (size_t)(t + 1) * 1024 + k);
  if (SHIFT) {
    raw[0] = (u32x4){0u, 0u, 0u, 0u}; raw[3] = (u32x4){0u, 0u, 0u, 0u};
    if ((t & Lmask) != 0) raw[0] = *(const u32x4*)(A + (size_t)(t - 1) * 1024 + k);
    if (((t + 1) & Lmask) != Lmask) raw[3] = *(const u32x4*)(A + (size_t)(t + 2) * 1024 + k);
  }
}
DI u32x4 mix3(const u32x4& c, const u32x4& pz, const u32x4& nz, const float* smu, int k) {
  const float4 m0 = *(const float4*)(smu + k), m1 = *(const float4*)(smu + k + 4);
  const float mu[8] = {m0.x, m0.y, m0.z, m0.w, m1.x, m1.y, m1.z, m1.w};
  u32x4 o;
#pragma unroll
  for (int i = 0; i < 4; ++i) {
    const float h0 = bflo(c[i]), h1 = bfhi(c[i]);
    const float x0 = h0 + (0.5f * (bflo(pz[i]) + bflo(nz[i])) - h0) * mu[2 * i];
    const float x1 = h1 + (0.5f * (bfhi(pz[i]) + bfhi(nz[i])) - h1) * mu[2 * i + 1];
    o[i] = pack2(x0, x1);
  }
  return o;
}
DI int swz(int row, int c) { return row * 128 + ((c ^ ((row >> 1) & 7)) << 4); }
template <int SHIFT> DI void st_half(unsigned char* base, int row, int c, const u32x4 (&raw)[4], const float* smu, int k) {
  if (!SHIFT) { *(u32x4*)(base + swz(row, c)) = raw[1]; *(u32x4*)(base + swz(row + 1, c)) = raw[2]; }
  else { *(u32x4*)(base + swz(row, c)) = mix3(raw[1], raw[0], raw[2], smu, k); *(u32x4*)(base + swz(row + 1, c)) = mix3(raw[2], raw[1], raw[3], smu, k); }
}

template <int SHIFT, int EPI>
DI void phase_gemm(const P& p, int g, const bf16_t* __restrict__ A, const bf16_t* __restrict__ Bt, int M, int N,
                   const float* __restrict__ mu, int Lmask, bf16_t* __restrict__ dst, int rw, unsigned char* lds, int nt0 = 0) {
  const int tid = otid(), lane = tid & 63, wave = tid >> 6;
  const int wm = wave >> 1, wn = wave & 1, r = lane & 31, h = lane >> 5;
  const int ntn = N >> 7, ntiles = ntn * (M >> 8);
  float* Cs = (float*)lds;
  float* smu = (float*)(lds + 110592);
  for (int tile = blockIdx.x; tile < ntiles; tile += gridDim.x) {
    const int mt = tile / ntn, nt = tile - mt * ntn; const int m0 = mt * 256, n0 = nt * 128;
    f32x16 acc[2][2];
#pragma unroll
    for (int a = 0; a < 2; ++a)
#pragma unroll
      for (int b = 0; b < 2; ++b)
#pragma unroll
        for (int i = 0; i < 16; ++i) acc[a][b][i] = 0.f;
    if (SHIFT) {
      const int ntm = nt + nt0; const float* mup = mu + (ntm < 32 ? (ntm >> 3) : (ntm == 32 ? 4 : 5)) * 1024;
      smu[tid] = mup[tid]; smu[tid + 512] = mup[tid + 512];
      __syncthreads();
    }
    if (!SHIFT) {
      u32x4 s0[6], s1[6];
      const int lrow = tid >> 3, lkc = (tid & 7) * 8;
#define G_LOAD(S, K0)  { _Pragma("unroll") for (int i = 0; i < 4; ++i) S[i] = *(const u32x4*)(A + (size_t)(m0 + lrow + 64 * i) * 1024 + (K0) + lkc); \
                         _Pragma("unroll") for (int i = 0; i < 2; ++i) S[4 + i] = *(const u32x4*)(Bt + (size_t)(n0 + lrow + 64 * i) * 1024 + (K0) + lkc); }
#define G_STORE(S, BUF) { _Pragma("unroll") for (int i = 0; i < 4; ++i) *(u32x4*)((BUF) + swz(lrow + 64 * i, tid & 7)) = S[i]; \
                          _Pragma("unroll") for (int i = 0; i < 2; ++i) *(u32x4*)((BUF) + 32768 + swz(lrow + 64 * i, tid & 7)) = S[4 + i]; }
#define G_COMPUTE(BUF) { _Pragma("unroll") for (int ks = 0; ks < 4; ++ks) { const int kc_ = ks * 2 + h; \
        const bf16x8 a0 = *(const bf16x8*)((BUF) + swz(wm * 64 + r, kc_)); const bf16x8 a1 = *(const bf16x8*)((BUF) + swz(wm * 64 + 32 + r, kc_)); \
        const bf16x8 b0 = *(const bf16x8*)((BUF) + 32768 + swz(wn * 64 + r, kc_)); const bf16x8 b1 = *(const bf16x8*)((BUF) + 32768 + swz(wn * 64 + 32 + r, kc_)); \
        acc[0][0] = MFMA32(a0, b0, acc[0][0]); acc[0][1] = MFMA32(a0, b1, acc[0][1]); acc[1][0] = MFMA32(a1, b0, acc[1][0]); acc[1][1] = MFMA32(a1, b1, acc[1][1]); } }
      G_LOAD(s0, 0) G_STORE(s0, lds)
      G_LOAD(s0, 64) G_LOAD(s1, 128)
      __syncthreads();
      for (int kt = 0; kt < 16; kt += 2) {
        G_COMPUTE(lds)
        G_STORE(s0, lds + 49152)
        if (kt + 3 < 16) G_LOAD(s0, (kt + 3) * 64)
        __syncthreads();
        G_COMPUTE(lds + 49152)
        if (kt + 2 < 16) G_STORE(s1, lds)
        if (kt + 4 < 16) G_LOAD(s1, (kt + 4) * 64)
        __syncthreads();
      }
#undef G_LOAD
#undef G_STORE
#undef G_COMPUTE
    } else {
    u32x4 raw[4], raw2[4], rb[2];
    const int arow = 4 * (tid >> 3), akc = (tid & 7) * 8;
#pragma unroll
    for (int hf = 0; hf < 2; ++hf) { ld_half<SHIFT>(A, m0 + arow + 2 * hf, akc, Lmask, raw); st_half<SHIFT>(lds, arow + 2 * hf, tid & 7, raw, smu, akc); }
#pragma unroll
    for (int i = 0; i < 2; ++i) { const int id = tid + 512 * i; rb[i] = *(const u32x4*)(Bt + (size_t)(n0 + (id >> 3)) * 1024 + (id & 7) * 8); }
#pragma unroll
    for (int i = 0; i < 2; ++i) { const int id = tid + 512 * i; *(u32x4*)(lds + 32768 + swz(id >> 3, id & 7)) = rb[i]; }
    __syncthreads();
    for (int kt = 0; kt < 16; ++kt) {
      unsigned char* cur = lds + (kt & 1) * 49152; unsigned char* nxt = lds + ((kt + 1) & 1) * 49152;
      const int k1 = (kt + 1) * 64;
      if (kt < 15) {
        ld_half<SHIFT>(A, m0 + arow, k1 + akc, Lmask, raw);
        ld_half<SHIFT>(A, m0 + arow + 2, k1 + akc, Lmask, raw2);
#pragma unroll
        for (int i = 0; i < 2; ++i) { const int id = tid + 512 * i; rb[i] = *(const u32x4*)(Bt + (size_t)(n0 + (id >> 3)) * 1024 + k1 + (id & 7) * 8); }
      }
#pragma unroll
      for (int ks = 0; ks < 4; ++ks) {
        const int kc_ = ks * 2 + h;
        const bf16x8 a0 = *(const bf16x8*)(cur + swz(wm * 64 + r, kc_));
        const bf16x8 a1 = *(const bf16x8*)(cur + swz(wm * 64 + 32 + r, kc_));
        const bf16x8 b0 = *(const bf16x8*)(cur + 32768 + swz(wn * 64 + r, kc_));
        const bf16x8 b1 = *(const bf16x8*)(cur + 32768 + swz(wn * 64 + 32 + r, kc_));
        acc[0][0] = MFMA32(a0, b0, acc[0][0]); acc[0][1] = MFMA32(a0, b1, acc[0][1]);
        acc[1][0] = MFMA32(a1, b0, acc[1][0]); acc[1][1] = MFMA32(a1, b1, acc[1][1]);
      }
      if (kt < 15) {
        st_half<SHIFT>(nxt, arow, tid & 7, raw, smu, k1 + akc);
        st_half<SHIFT>(nxt, arow + 2, tid & 7, raw2, smu, k1 + akc);
#pragma unroll
        for (int i = 0; i < 2; ++i) { const int id = tid + 512 * i; *(u32x4*)(nxt + 32768 + swz(id >> 3, id & 7)) = rb[i]; }
      }
      __syncthreads();
    }
    }
#pragma unroll
    for (int mi = 0; mi < 2; ++mi)
#pragma unroll
      for (int ni = 0; ni < 2; ++ni)
#pragma unroll
        for (int i = 0; i < 16; ++i) {
          const int row = wm * 64 + mi * 32 + (i & 3) + 8 * (i >> 2) + 4 * h, col = wn * 64 + ni * 32 + r;
          Cs[row * 132 + col] = acc[mi][ni][i];
        }
    __syncthreads();
    if (EPI == 0) {
#pragma unroll
      for (int i = 0; i < 8; ++i) {
        const int id = tid + 512 * i, row = id >> 4, cc = (id & 15) * 8;
        float4 v0 = *(const float4*)(Cs + row * 132 + cc), v1 = *(const float4*)(Cs + row * 132 + cc + 4);
        if (rw && nt + nt0 == 32) { v0.x = tanhf(v0.x); v0.y = tanhf(v0.y); v0.z = tanhf(v0.z); v0.w = tanhf(v0.w); v1.x = tanhf(v1.x); v1.y = tanhf(v1.y); v1.z = tanhf(v1.z); v1.w = tanhf(v1.w); }
        u32x4 o; o[0] = pack2(v0.x, v0.y); o[1] = pack2(v0.z, v0.w); o[2] = pack2(v1.x, v1.y); o[3] = pack2(v1.z, v1.w);
        if (rw && nt + nt0 >= 32) *(u32x4*)((bf16_t*)(p.ws + WS_HID) + (size_t)(m0 + row) * 256 + (nt + nt0 - 32) * 128 + cc) = o;
        else *(u32x4*)(dst + (size_t)(nt >> 3) * SLOT_ELEMS + (size_t)(m0 + row) * 1024 + (nt & 7) * 128 + cc) = o;
      }
    } else {
      const int row = tid & 255, hh = tid >> 8; const int t = m0 + row;
      float x[64];
#pragma unroll
      for (int q = 0; q < 16; ++q) { const float4 v = *(const float4*)(Cs + row * 132 + hh * 64 + 4 * q); x[4 * q] = v.x; x[4 * q + 1] = v.y; x[4 * q + 2] = v.z; x[4 * q + 3] = v.w; }
      bf16_t* slots = (bf16_t*)(p.ws + WS_SLOT);
      const int L = g ? 4096 : 256, Ltot = g ? 4352 : 256;
      const int b = g ? (t >> 12) : (t >> 8), s = t & (L - 1);
      if (nt < 10) {
        int vz = 0; asm volatile("" : "+v"(vz));
        const float* nw = (nt < 8 ? p.in[26] : p.in[27]) + vz;
        float ss = 0.f;
#pragma unroll
        for (int d = 0; d < 64; ++d) ss += x[d] * x[d];
        const float rs = rsqrtf(ss * (1.f / 64.f) + 1e-6f);
#pragma unroll
        for (int d = 0; d < 64; ++d) x[d] *= rs * nw[d];
        if (g == 0 && nt >= 8) {
          float* ck = p.out + OUT_CK + (size_t)t * 256 + ((nt - 8) * 2 + hh) * 64;
#pragma unroll
          for (int q = 0; q < 16; ++q) *(float4*)(ck + 4 * q) = make_float4(x[4 * q], x[4 * q + 1], x[4 * q + 2], x[4 * q + 3]);
        }
        if (g == 1) {
          const float2* rope = (const float2*)(p.ws + WS_ROPE);
          const int ri = s >> 6, ci = s & 63;
#pragma unroll
          for (int f = 0; f < 16; ++f) {
            const float2 cr = rope[ri * 16 + f]; const float x1 = x[f], x2 = x[16 + f];
            x[f] = x1 * cr.x - x2 * cr.y; x[16 + f] = x2 * cr.x + x1 * cr.y;
            const float2 cc = rope[ci * 16 + f]; const float y1 = x[32 + f], y2 = x[48 + f];
            x[32 + f] = y1 * cc.x - y2 * cc.y; x[48 + f] = y2 * cc.x + y1 * cc.y;
          }
        }
        bf16_t* dq = nt < 8 ? slots + 2 * SLOT_ELEMS + (size_t)t * 1024 + (nt * 2 + hh) * 64
                            : slots + 4 * SLOT_ELEMS + ((size_t)b * Ltot + s) * 256 + ((nt - 8) * 2 + hh) * 64;
#pragma unroll
        for (int q = 0; q < 8; ++q) { u32x4 o; o[0] = pack2(x[8 * q], x[8 * q + 1]); o[1] = pack2(x[8 * q + 2], x[8 * q + 3]); o[2] = pack2(x[8 * q + 4], x[8 * q + 5]); o[3] = pack2(x[8 * q + 6], x[8 * q + 7]); *(u32x4*)(dq + 8 * q) = o; }
      } else if (nt < 12) {
        const int kvh = (nt - 10) * 2 + hh;
        if (g == 0) {
          float* cv = p.out + OUT_CV + (size_t)t * 256 + kvh * 64;
#pragma unroll
          for (int q = 0; q < 16; ++q) *(float4*)(cv + 4 * q) = make_float4(x[4 * q], x[4 * q + 1], x[4 * q + 2], x[4 * q + 3]);
        }
        bf16_t* vt = slots + 4 * SLOT_ELEMS + SLOT_ELEMS / 2 + ((size_t)(b * 4 + kvh) * 64) * Ltot + s;
        { size_t vo = 0;
#pragma unroll
        for (int d = 0; d < 64; ++d) { vt[vo] = (bf16_t)f2bf(x[d]); vo += Ltot; asm volatile("" : "+v"(vo)); } }
      } else {
        bf16_t* dg = slots + 3 * SLOT_ELEMS + (size_t)t * 1024 + (nt - 12) * 128 + hh * 64;
#pragma unroll
        for (int q = 0; q < 8; ++q) { u32x4 o; o[0] = pack2(x[8 * q], x[8 * q + 1]); o[1] = pack2(x[8 * q + 2], x[8 * q + 3]); o[2] = pack2(x[8 * q + 4], x[8 * q + 5]); o[3] = pack2(x[8 * q + 6], x[8 * q + 7]); *(u32x4*)(dg + 8 * q) = o; }
      }
    }
    __syncthreads();
  }
}

DI u32x4 cat8(const u32x2 lo, const u32x2 hi) { u32x4 v; v[0] = lo[0]; v[1] = lo[1]; v[2] = hi[0]; v[3] = hi[1]; return v; }
DI void phase_scan(const P& p, int g, int jl, unsigned char* lds) {
  const int tid = otid(), lane = tid & 63, wave = tid >> 6, r = lane & 31, h = lane >> 5;
  const int L = g ? 4096 : 256, B = g ? 4 : 32, nsc = L >> 5;
  float* sR = (float*)lds; float* sW = sR + 2048; float* sKD = sW + 2048; float* sKK = sKD + 2048; float* sKKA = sKK + 2048;
  bf16_t* sHW = (bf16_t*)(lds + 40960); bf16_t* sHA = (bf16_t*)(lds + 45568);
  bf16_t* oAL = (bf16_t*)(lds + 50176); bf16_t* oRH = (bf16_t*)(lds + 54784); bf16_t* oBE = (bf16_t*)(lds + 59392); bf16_t* oGA = (bf16_t*)(lds + 64000);
  bf16_t* oBEt = (bf16_t*)(lds + 68608); bf16_t* oGAt = (bf16_t*)(lds + 73728); bf16_t* oUt = (bf16_t*)(lds + 78848); bf16_t* oZt = (bf16_t*)(lds + 83968);
  float* Bm = (float*)(lds + 89088); float* RHS = (float*)(lds + 93696); float* lamC = (float*)(lds + 101888); float* sP = (float*)(lds + 102144);
  unsigned char* frag = lds + 104192;
  const bf16_t* slots = (const bf16_t*)(p.ws + WS_SLOT);
  const bf16_t* Rg = slots + 1 * SLOT_ELEMS; const bf16_t* Kg = slots + 0 * SLOT_ELEMS; const bf16_t* Vg = slots + 2 * SLOT_ELEMS;
  const bf16_t* hid = (const bf16_t*)(p.ws + WS_HID);
  float* bon = (float*)(p.ws + WS_BON);
  const int ntasks = B * 32;
  for (int task = blockIdx.x; task < ntasks; task += gridDim.x) {
    const int z = task & 1, head = (task >> 1) & 15, b = task >> 5;
    bf16_t* Yg = (bf16_t*)(p.ws + WS_SLOT) + (z ? 4 : 5) * SLOT_ELEMS;
    const int mat = (wave >> 1) & 1, ntt = wave & 1;
    unsigned char* lfr = lds + 110336 + (wave & 3) * 4096;
    if (wave >= 4) {
      const float* W2 = (mat ? p.in[18] : p.in[15]) + (size_t)(jl * 2 + z) * 65536 + head * 64 + 32 * ntt + r;
#pragma unroll
      for (int kk = 0; kk < 4; ++kk) { u32x4 pk;
#pragma unroll
        for (int j = 0; j < 4; ++j) pk[j] = pack2(W2[(size_t)(16 * kk + 8 * h + 2 * j) * 1024], W2[(size_t)(16 * kk + 8 * h + 2 * j + 1) * 1024]);
        *(u32x4*)(lfr + (kk * 64 + lane) * 16) = pk; }
    }
    const float bias = (mat ? p.in[16] : p.in[13])[(jl * 2 + z) * 1024 + head * 64 + 32 * ntt + r];
    const float kkc = p.in[19][jl * 1024 + head * 64 + lane], kac = p.in[20][jl * 1024 + head * 64 + lane], rkc = p.in[21][jl * 1024 + head * 64 + lane];
    f32x16 st0, st1;
#pragma unroll
    for (int q = 0; q < 16; ++q) { st0[q] = 0.f; st1[q] = 0.f; }
    const size_t stbase = ((((size_t)(b * 2 + jl) * 2 + z) * 16 + head) * 64 + (32 * (wave & 1) + r)) * 64;
    if (g && wave < 2) {
#pragma unroll
      for (int gq = 0; gq < 4; ++gq) {
        const float4 s0 = *(const float4*)(p.in[2] + stbase + 8 * gq + 4 * h), s1 = *(const float4*)(p.in[2] + stbase + 32 + 8 * gq + 4 * h);
        st0[4 * gq] = s0.x; st0[4 * gq + 1] = s0.y; st0[4 * gq + 2] = s0.z; st0[4 * gq + 3] = s0.w;
        st1[4 * gq] = s1.x; st1[4 * gq + 1] = s1.y; st1[4 * gq + 2] = s1.z; st1[4 * gq + 3] = s1.w;
      }
    }
    u32x4 pre[5];
    const int ht = tid - 256;
#define SCAN_LOAD(sc_)                                                                                    \
    { const int ht2 = otid() - 256;                                                                       \
    _Pragma("unroll") for (int i = 0; i < 5; ++i) {                                                       \
      const int id = ht2 + 256 * i;                                                                       \
      const int arr = id >> 8, s = (id >> 3) & 31, cc = (id & 7) * 8;                                     \
      const int tl = z ? (L - 1 - ((sc_) * 32 + s)) : ((sc_) * 32 + s);                                   \
      const size_t tok = (size_t)b * L + tl;                                                              \
      if (arr < 3) pre[i] = *(const u32x4*)((arr == 0 ? Rg : (arr == 1 ? Kg : Vg)) + tok * 1024 + head * 64 + cc); \
      else pre[i] = *(const u32x4*)(hid + tok * 256 + (arr - 3) * 128 + z * 64 + cc);                     \
    } }
#define NQ(t_) ((((t_) + 3) / 4 + 1) / 2)
#define SOLVE_ROWS(T0, T1)                                                                                \
    _Pragma("unroll") for (int t = (T0); t < (T1); ++t) {                                                 \
      if (t + 2 < 32) {                                                                                   \
        n2rhs = RHo[(t + 2) * 64];                                                                        \
        _Pragma("unroll") for (int q = 0; q < NQ(t + 2); ++q) { const f4v q4 = *(const __attribute__((address_space(3))) f4v*)(Bmo + (t + 2) * 36 + 8 * q); nc8[q] = make_float4(q4[0], q4[1], q4[2], q4[3]); } \
      }                                                                                                   \
      float a0s = crhs * mh, a1s = 0.f;                                                                   \
      _Pragma("unroll") for (int q = 0; q < NQ(t); ++q) {                                                 \
        a0s -= cb[q].x * zv[4 * q]; a1s -= cb[q].y * zv[4 * q + 1]; a0s -= cb[q].z * zv[4 * q + 2]; a1s -= cb[q].w * zv[4 * q + 3]; } \
      float zt = xhalf_sum(a0s + a1s);                                                                    \
      asm volatile("" : "+v"(zt) :: "memory");                                                            \
      zv[4 * (t >> 3) + (t & 3)] = ((((t >> 2) & 1) == h)) ? zt : zv[4 * (t >> 3) + (t & 3)];             \
      crhs = nrhs; nrhs = n2rhs;                                                                          \
      _Pragma("unroll") for (int q = 0; q < 4; ++q) { cb[q] = nb8[q]; nb8[q] = nc8[q]; }                  \
    }
    typedef float f4v __attribute__((ext_vector_type(4)));
    if (wave >= 4) { SCAN_LOAD(0) }
    for (int sc = -1; sc < nsc; ++sc) {
      const bool st_on = sc >= 0, hl_on = sc + 1 < nsc;
      bf16_t* oUc = (bf16_t*)(lds + ((sc & 1) ? 126720 : 78848));
      bf16_t* oUn = (bf16_t*)(lds + ((sc & 1) ? 78848 : 126720));
      f32x16 y0;
      const int vloc = 32 * (wave & 1) + r;
      if (st_on) {
      {
        const int k = lane, tq = wave;
        float wq[4];
#pragma unroll
        for (int j = 0; j < 4; ++j) wq[j] = sW[(4 * tq + j) * 64 + k];
        sP[tq * 64 + k] = (wq[0] * wq[1]) * (wq[2] * wq[3]);
        __syncthreads();
        float lam = 1.f;
#pragma unroll
        for (int q = 0; q < 7; ++q) { const float pq = sP[q * 64 + k]; lam *= (q < tq) ? pq : 1.f; }
        u32x2 bt, gt; float nb[4], gg[4];
#pragma unroll
        for (int j = 0; j < 4; ++j) {
          const int t = 4 * tq + j;
          const float lamp = lam; lam = lamp * wq[j];
          const float inv = __builtin_amdgcn_rcpf(lam);
          const float al = lamp * sKK[t * 64 + k], be = sKKA[t * 64 + k] * inv, ga = sKD[t * 64 + k] * inv, rh = lam * sR[t * 64 + k];
          oAL[t * 72 + k] = (bf16_t)f2bf(al); oRH[t * 72 + k] = (bf16_t)f2bf(rh); oBE[t * 72 + k] = (bf16_t)f2bf(be); oGA[t * 72 + k] = (bf16_t)f2bf(ga);
          nb[j] = -be; gg[j] = ga;
        }
        bt[0] = pack2(nb[0], nb[1]); bt[1] = pack2(nb[2], nb[3]); gt[0] = pack2(gg[0], gg[1]); gt[1] = pack2(gg[2], gg[3]);
        *(u32x2*)(oBEt + k * 40 + 4 * tq) = bt; *(u32x2*)(oGAt + k * 40 + 4 * tq) = gt;
        if (tq == 7) lamC[k] = lam;
      }
      __syncthreads();
      {
      const int tid = otid(), lane = tid & 63, wave = tid >> 6, r = lane & 31, h = lane >> 5; (void)r; (void)h; (void)lane; (void)wave;
      if (wave < 4) {
        const bf16_t* As = (wave & 1) ? oGA : oBE; const bf16_t* Bs = (wave < 2) ? oAL : oRH;
        f32x16 x;
#pragma unroll
        for (int q = 0; q < 16; ++q) x[q] = 0.f;
#pragma unroll
        for (int s = 0; s < 4; ++s) { const bf16x8 a = *(const bf16x8*)(As + r * 72 + 16 * s + 8 * h); const bf16x8 bb = *(const bf16x8*)(Bs + r * 72 + 16 * s + 8 * h); x = MFMA32(a, bb, x); }
#pragma unroll
        for (int q = 0; q < 16; ++q) { const int i = (q & 3) + 8 * (q >> 2) + 4 * h; const bool keep = (wave < 2) ? (i < r) : (i <= r); x[q] = keep ? x[q] : 0.f; }
        if (wave == 0) {
#pragma unroll
          for (int gq = 0; gq < 4; ++gq) *(float4*)(Bm + r * 36 + 8 * gq + 4 * h) = make_float4(x[4 * gq], x[4 * gq + 1], x[4 * gq + 2], x[4 * gq + 3]);
        } else {
          const float sg = (wave == 2) ? -1.f : 1.f;
#pragma unroll
          for (int s = 0; s < 2; ++s) { u32x4 pk;
#pragma unroll
            for (int j = 0; j < 4; ++j) pk[j] = pack2(sg * x[8 * s + 2 * j], sg * x[8 * s + 2 * j + 1]);
            *(u32x4*)(frag + (((wave - 1) * 2 + s) * 64 + lane) * 16) = pk; }
        }
      }
      }
      __syncthreads();
      if (wave < 2) {
        f32x16 a0;
#pragma unroll
        for (int q = 0; q < 16; ++q) a0[q] = 0.f;
#pragma unroll
        for (int kb = 0; kb < 2; ++kb)
#pragma unroll
          for (int s = 0; s < 2; ++s) {
            u32x4 pk;
#pragma unroll
            for (int j = 0; j < 4; ++j) pk[j] = kb ? pack2(st1[8 * s + 2 * j], st1[8 * s + 2 * j + 1]) : pack2(st0[8 * s + 2 * j], st0[8 * s + 2 * j + 1]);
            const bf16x8 sf = __builtin_bit_cast(bf16x8, pk);
            const int ko = 32 * kb + 16 * s + 4 * h;
            const u32x4 aa = cat8(*(const u32x2*)(oAL + r * 72 + ko), *(const u32x2*)(oAL + r * 72 + ko + 8));
            a0 = MFMA32(__builtin_bit_cast(bf16x8, aa), sf, a0);
          }
#pragma unroll
        for (int s = 0; s < 2; ++s) {
          const bf16x8 fg = *(const bf16x8*)(frag + ((0 * 2 + s) * 64 + lane) * 16);
          const u32x4 ub = cat8(*(const u32x2*)(oUc + vloc * 40 + 16 * s + 4 * h), *(const u32x2*)(oUc + vloc * 40 + 16 * s + 4 * h + 8));
          a0 = MFMA32(fg, __builtin_bit_cast(bf16x8, ub), a0);
        }
#pragma unroll
        for (int q = 0; q < 16; ++q) RHS[((q & 3) + 8 * (q >> 2) + 4 * h) * 64 + vloc] = a0[q];
        float* park = (float*)(lds + 131840) + wave * 3072 + lane * 4;
#pragma unroll
        for (int gq = 0; gq < 4; ++gq) {
          *(float4*)(park + gq * 256) = make_float4(st0[4 * gq], st0[4 * gq + 1], st0[4 * gq + 2], st0[4 * gq + 3]);
          *(float4*)(park + 1024 + gq * 256) = make_float4(st1[4 * gq], st1[4 * gq + 1], st1[4 * gq + 2], st1[4 * gq + 3]);
        }
      }
      }
      float zv[16]; float4 cb[4], nb8[4], nc8[4]; float crhs = 0.f, nrhs = 0.f, n2rhs = 0.f;
      const float mh = h ? 0.f : 1.f;
#pragma unroll
      for (int t = 0; t < 16; ++t) zv[t] = 0.f;
#pragma unroll
      for (int q = 0; q < 4; ++q) { cb[q] = make_float4(0.f, 0.f, 0.f, 0.f); nb8[q] = make_float4(0.f, 0.f, 0.f, 0.f); nc8[q] = make_float4(0.f, 0.f, 0.f, 0.f); }
      const __attribute__((address_space(3))) float* Bmo = (const __attribute__((address_space(3))) float*)(unsigned)(unsigned long long)(Bm + 4 * h);
      const __attribute__((address_space(3))) float* RHo = (const __attribute__((address_space(3))) float*)(unsigned)(unsigned long long)(RHS + vloc);
      asm volatile("" : "+v"(Bmo), "+v"(RHo));
      if (wave < 2 && st_on) { crhs = RHo[0]; nrhs = RHo[64]; const f4v q4 = *(const __attribute__((address_space(3))) f4v*)(Bmo + 36); nb8[0] = make_float4(q4[0], q4[1], q4[2], q4[3]); }
      if (wave < 2) { if (st_on) { SOLVE_ROWS(0, 6) } }
      else if (wave >= 4 && hl_on) {
#pragma unroll
        for (int i = 0; i < 5; ++i) {
          const int id = ht + 256 * i; const int arr = id >> 8, s = (id >> 3) & 31, cc = (id & 7) * 8;
          const u32x4 u = pre[i];
          if (arr < 2) { float* d = (arr == 0 ? sR : sKD) + s * 64 + cc;
            *(float4*)d = make_float4(bflo(u[0]), bfhi(u[0]), bflo(u[1]), bfhi(u[1])); *(float4*)(d + 4) = make_float4(bflo(u[2]), bfhi(u[2]), bflo(u[3]), bfhi(u[3])); }
          else if (arr == 2) {
#pragma unroll
            for (int j = 0; j < 4; ++j) { oUn[(cc + 2 * j) * 40 + s] = (bf16_t)(u[j] & 0xffffu); oUn[(cc + 2 * j + 1) * 40 + s] = (bf16_t)(u[j] >> 16); }
          } else *(u32x4*)((arr == 3 ? sHW : sHA) + s * 72 + cc) = u;
        }
        if (sc + 2 < nsc) { SCAN_LOAD(sc + 2) }
      }
      __syncthreads();
      if (wave < 2) { if (st_on) { SOLVE_ROWS(6, 24) } }
      else if (wave < 4) { if (st_on) {
        const float* park = (const float*)(lds + 131840) + (wave - 2) * 3072 + lane * 4;
#pragma unroll
        for (int gq = 0; gq < 4; ++gq) {
          const float4 a = *(const float4*)(park + gq * 256), bq = *(const float4*)(park + 1024 + gq * 256);
          st0[4 * gq] = a.x; st0[4 * gq + 1] = a.y; st0[4 * gq + 2] = a.z; st0[4 * gq + 3] = a.w;
          st1[4 * gq] = bq.x; st1[4 * gq + 1] = bq.y; st1[4 * gq + 2] = bq.z; st1[4 * gq + 3] = bq.w;
        }
#pragma unroll
        for (int q = 0; q < 16; ++q) y0[q] = 0.f;
#pragma unroll
        for (int kb = 0; kb < 2; ++kb)
#pragma unroll
          for (int s = 0; s < 2; ++s) {
            u32x4 pk;
#pragma unroll
            for (int j = 0; j < 4; ++j) pk[j] = kb ? pack2(st1[8 * s + 2 * j], st1[8 * s + 2 * j + 1]) : pack2(st0[8 * s + 2 * j], st0[8 * s + 2 * j + 1]);
            const int ko = 32 * kb + 16 * s + 4 * h;
            const u32x4 ar = cat8(*(const u32x2*)(oRH + r * 72 + ko), *(const u32x2*)(oRH + r * 72 + ko + 8));
            y0 = MFMA32(__builtin_bit_cast(bf16x8, ar), __builtin_bit_cast(bf16x8, pk), y0);
          }
#pragma unroll
        for (int s = 0; s < 2; ++s) {
          const bf16x8 fpg = *(const bf16x8*)(frag + ((2 * 2 + s) * 64 + lane) * 16);
          const u32x4 ub = cat8(*(const u32x2*)(oUc + vloc * 40 + 16 * s + 4 * h), *(const u32x2*)(oUc + vloc * 40 + 16 * s + 4 * h + 8));
          y0 = MFMA32(fpg, __builtin_bit_cast(bf16x8, ub), y0);
        }
      } }
      else if (wave >= 4 && hl_on) {
        f32x16 acc;
#pragma unroll
        for (int i = 0; i < 16; ++i) acc[i] = 0.f;
        const bf16_t* sH = mat ? sHA : sHW;
#pragma unroll
        for (int kk = 0; kk < 4; ++kk) { const bf16x8 a = *(const bf16x8*)(sH + r * 72 + 16 * kk + 8 * h); const bf16x8 bw = *(const bf16x8*)(lfr + (kk * 64 + lane) * 16); acc = MFMA32(a, bw, acc); }
#pragma unroll
        for (int i = 0; i < 16; ++i) {
          const int srow = (i & 3) + 8 * (i >> 2) + 4 * h, c = 32 * ntt + r;
          const float xv = acc[i] + bias;
          const float sg = __builtin_amdgcn_rcpf(1.f + __expf(-xv));
          if (mat == 0) sW[srow * 64 + c] = __expf(-0.60653065971263342f * sg);
          else sKKA[srow * 64 + c] = sg;
        }
      }
      __syncthreads();
      if (wave < 2) { if (st_on) {
        SOLVE_ROWS(24, 32)
#pragma unroll
        for (int q = 0; q < 4; ++q) { u32x2 o; o[0] = pack2(zv[4 * q], zv[4 * q + 1]); o[1] = pack2(zv[4 * q + 2], zv[4 * q + 3]);
          *(u32x2*)(oZt + vloc * 40 + 4 * (2 * q + h)) = o; }
        } }
      else if (wave >= 4 && hl_on) {
#pragma unroll
        for (int i = 0; i < 8; ++i) {
          const int s = (wave - 4) + 4 * i; const int c = lane;
          const float kraw = sKD[s * 64 + c], a = sKKA[s * 64 + c], rr = sR[s * 64 + c];
          const float pk = kraw * kkc; const float ss = wave_sum(pk * pk);
          const float kk = pk * rsqrtf(fmaxf(ss, 1e-24f));
          const float kd = kraw * (1.f + (a - 1.f) * kac);
          const float bs = wave_sum(rr * kd * rkc);
          sKD[s * 64 + c] = kd; sKK[s * 64 + c] = kk; sKKA[s * 64 + c] = kk * a;
          if (c == 0) { const int tl = z ? (L - 1 - ((sc + 1) * 32 + s)) : ((sc + 1) * 32 + s); bon[(((size_t)b * L + tl) * 16 + head) * 2 + z] = bs; }
        }
      }
      __syncthreads();
      if (st_on) {
      {
      const int tid = otid(), lane = tid & 63, wave = tid >> 6, r = lane & 31, h = lane >> 5; (void)r; (void)h; (void)lane; (void)wave;
      if (wave < 2) {
        { const float* park = (const float*)(lds + 131840) + wave * 3072 + lane * 4;
#pragma unroll
          for (int gq = 0; gq < 4; ++gq) {
            const float4 a = *(const float4*)(park + gq * 256), bq = *(const float4*)(park + 1024 + gq * 256);
            st0[4 * gq] = a.x; st0[4 * gq + 1] = a.y; st0[4 * gq + 2] = a.z; st0[4 * gq + 3] = a.w;
            st1[4 * gq] = bq.x; st1[4 * gq + 1] = bq.y; st1[4 * gq + 2] = bq.z; st1[4 * gq + 3] = bq.w;
          } }
#pragma unroll
        for (int s = 0; s < 2; ++s) {
          const bf16x8 ub = *(const bf16x8*)(oUc + vloc * 40 + 16 * s + 8 * h), zb = *(const bf16x8*)(oZt + vloc * 40 + 16 * s + 8 * h);
          const bf16x8 g0 = *(const bf16x8*)(oGAt + r * 40 + 16 * s + 8 * h), g1 = *(const bf16x8*)(oGAt + (32 + r) * 40 + 16 * s + 8 * h);
          const bf16x8 b0 = *(const bf16x8*)(oBEt + r * 40 + 16 * s + 8 * h), b1 = *(const bf16x8*)(oBEt + (32 + r) * 40 + 16 * s + 8 * h);
          st0 = MFMA32(g0, ub, st0); st0 = MFMA32(b0, zb, st0);
          st1 = MFMA32(g1, ub, st1); st1 = MFMA32(b1, zb, st1);
        }
#pragma unroll
        for (int gq = 0; gq < 4; ++gq) {
          const float4 l0 = *(const float4*)(lamC + 8 * gq + 4 * h), l1 = *(const float4*)(lamC + 32 + 8 * gq + 4 * h);
          st0[4 * gq] *= l0.x; st0[4 * gq + 1] *= l0.y; st0[4 * gq + 2] *= l0.z; st0[4 * gq + 3] *= l0.w;
          st1[4 * gq] *= l1.x; st1[4 * gq + 1] *= l1.y; st1[4 * gq + 2] *= l1.z; st1[4 * gq + 3] *= l1.w;
        }
      } else if (wave < 4) {
#pragma unroll
        for (int s = 0; s < 2; ++s) {
          const bf16x8 fpb = *(const bf16x8*)(frag + ((1 * 2 + s) * 64 + lane) * 16);
          const u32x4 z8 = cat8(*(const u32x2*)(oZt + vloc * 40 + 16 * s + 4 * h), *(const u32x2*)(oZt + vloc * 40 + 16 * s + 4 * h + 8));
          y0 = MFMA32(fpb, __builtin_bit_cast(bf16x8, z8), y0);
        }
#pragma unroll
        for (int q = 0; q < 16; ++q) {
          const int t = (q & 3) + 8 * (q >> 2) + 4 * h; const int tl = z ? (L - 1 - (sc * 32 + t)) : (sc * 32 + t);
          Yg[((size_t)b * L + tl) * 1024 + head * 64 + vloc] = (bf16_t)f2bf(y0[q]);
        }
      }
      }
      __syncthreads();
      }
    }
#undef SOLVE_ROWS
#undef SCAN_LOAD
    if (g == 0 && wave < 2) {
#pragma unroll
      for (int gq = 0; gq < 4; ++gq) {
        *(float4*)(p.out + OUT_ST + stbase + 8 * gq + 4 * h) = make_float4(st0[4 * gq], st0[4 * gq + 1], st0[4 * gq + 2], st0[4 * gq + 3]);
        *(float4*)(p.out + OUT_ST + stbase + 32 + 8 * gq + 4 * h) = make_float4(st1[4 * gq], st1[4 * gq + 1], st1[4 * gq + 2], st1[4 * gq + 3]);
      }
    }
    __syncthreads();
  }
}

DI void phase_rwkv_combine(const P& p, int g, int jl) {
  const int T = g ? 16384 : 8192;
  const int tid = otid(); const int lane = tid & 63, wave = tid >> 6;
  bf16_t* slots = (bf16_t*)(p.ws + WS_SLOT);
  const float* bon = (const float*)(p.ws + WS_BON);
#pragma unroll 2
  for (int t = blockIdx.x * 8 + wave; t < T; t += gridDim.x * 8) {
    const size_t o = (size_t)t * 1024 + 16 * lane; const int head = lane >> 2;
    float y[16], v[16], gg[16];
#pragma unroll
    for (int q = 0; q < 2; ++q) {
      const u32x4 a = *(const u32x4*)(slots + 5 * SLOT_ELEMS + o + 8 * q), bq = *(const u32x4*)(slots + 4 * SLOT_ELEMS + o + 8 * q);
      const u32x4 vq = *(const u32x4*)(slots + 2 * SLOT_ELEMS + o + 8 * q), gq = *(const u32x4*)(slots + 3 * SLOT_ELEMS + o + 8 * q);
#pragma unroll
      for (int i = 0; i < 4; ++i) { y[8 * q + 2 * i] = bflo(a[i]) + bflo(bq[i]); y[8 * q + 2 * i + 1] = bfhi(a[i]) + bfhi(bq[i]);
        v[8 * q + 2 * i] = bflo(vq[i]); v[8 * q + 2 * i + 1] = bfhi(vq[i]); gg[8 * q + 2 * i] = bflo(gq[i]); gg[8 * q + 2 * i + 1] = bfhi(gq[i]); }
    }
    float s = 0.f;
#pragma unroll
    for (int i = 0; i < 16; ++i) s += y[i];
    const float mean = quad_sum(s) * (1.f / 64.f);
    float vs = 0.f;
#pragma unroll
    for (int i = 0; i < 16; ++i) { const float d = y[i] - mean; vs += d * d; }
    const float rstd = rsqrtf(quad_sum(vs) * (1.f / 64.f) + 64e-5f);
    const float bs = bon[((size_t)t * 16 + head) * 2] + bon[((size_t)t * 16 + head) * 2 + 1];
    const float* gw = p.in[22] + jl * 1024 + 16 * lane; const float* gb = p.in[23] + jl * 1024 + 16 * lane;
    float ov[16];
#pragma unroll
    for (int i = 0; i < 16; ++i) ov[i] = ((y[i] - mean) * rstd * gw[i] + gb[i] + bs * v[i]) * silu(gg[i]);
#pragma unroll
    for (int q = 0; q < 2; ++q) { u32x4 w; w[0] = pack2(ov[8 * q], ov[8 * q + 1]); w[1] = pack2(ov[8 * q + 2], ov[8 * q + 3]); w[2] = pack2(ov[8 * q + 4], ov[8 * q + 5]); w[3] = pack2(ov[8 * q + 6], ov[8 * q + 7]);
      *(u32x4*)(slots + 3 * SLOT_ELEMS + o + 8 * q) = w; }
  }
}

DI void phase_conv(const P& p, int g) {
  const int T = g ? 16384 : 8192, Lmask = g ? 4095 : 255;
  bf16_t* slots = (bf16_t*)(p.ws + WS_SLOT);
  const bf16_t* BG = slots + 2 * SLOT_ELEMS; const bf16_t* CG = slots + 3 * SLOT_ELEMS; const bf16_t* U = slots + 4 * SLOT_ELEMS; const bf16_t* G = slots + 5 * SLOT_ELEMS;
  bf16_t* O = slots;
#pragma unroll 2
  for (int e = blockIdx.x * NT + otid(); e < T * 128; e += gridDim.x * NT) {
    const int t = e >> 7, c = (e & 127) * 8; const size_t o = (size_t)t * 1024 + c; const int tl = t & Lmask;
    const u32x4 zz = {0u, 0u, 0u, 0u};
    const u32x4 c1 = *(const u32x4*)(CG + o), u1 = *(const u32x4*)(U + o);
    const u32x4 c0 = tl != 0 ? *(const u32x4*)(CG + o - 1024) : zz, u0 = tl != 0 ? *(const u32x4*)(U + o - 1024) : zz;
    const u32x4 c2 = tl != Lmask ? *(const u32x4*)(CG + o + 1024) : zz, u2 = tl != Lmask ? *(const u32x4*)(U + o + 1024) : zz;
    const u32x4 bg = *(const u32x4*)(BG + o), gg = *(const u32x4*)(G + o);
    const float* cw = p.in[30]; const float* cb = p.in[31];
    u32x4 w;
#pragma unroll
    for (int i = 0; i < 4; ++i) {
      const int ch = c + 2 * i;
      const float lo = bflo(bg[i]) * (cw[ch] * bflo(c0[i]) * bflo(u0[i]) + cw[1024 + ch] * bflo(c1[i]) * bflo(u1[i]) + cw[2048 + ch] * bflo(c2[i]) * bflo(u2[i]) + cb[ch]) * silu(bflo(gg[i]));
      const float hi = bfhi(bg[i]) * (cw[ch + 1] * bfhi(c0[i]) * bfhi(u0[i]) + cw[1024 + ch + 1] * bfhi(c1[i]) * bfhi(u1[i]) + cw[2048 + ch + 1] * bfhi(c2[i]) * bfhi(u2[i]) + cb[ch + 1]) * silu(bfhi(gg[i]));
      w[i] = pack2(lo, hi);
    }
    *(u32x4*)(O + o) = w;
  }
}

DI void phase_attn(const P& p, int g, unsigned char* lds) {
  const int tid = otid(), lane = tid & 63, wave = tid >> 6, r = lane & 31, h = lane >> 5;
  const int L = g ? 4096 : 256, Ltot = g ? 4352 : 256, B = g ? 4 : 32;
  const int nq = L >> 6, ntasks = B * 4 * nq, nkt = Ltot >> 6;
  bf16_t* slots = (bf16_t*)(p.ws + WS_SLOT);
  bf16_t* Q = slots + 2 * SLOT_ELEMS; const bf16_t* G = slots + 3 * SLOT_ELEMS;
  const bf16_t* Kb = slots + 4 * SLOT_ELEMS; const bf16_t* Vt = Kb + SLOT_ELEMS / 2;
  const float SC = 0.125f * 1.4426950408889634f;
  for (int task = blockIdx.x; task < ntasks; task += gridDim.x) {
    const int qt = task % nq, kvh = (task / nq) & 3, b = task / (nq * 4);
    const int head = kvh * 4 + (wave >> 1); const int q0 = qt * 64 + (wave & 1) * 32;
    const size_t tok = (size_t)b * L + q0 + r;
    bf16x8 qf[4];
#pragma unroll
    for (int ds = 0; ds < 4; ++ds) qf[ds] = *(const bf16x8*)(Q + tok * 1024 + head * 64 + ds * 16 + h * 8);
    float m = -1e30f, lsum = 0.f;
    f32x16 O0, O1;
#pragma unroll
    for (int i = 0; i < 16; ++i) { O0[i] = 0.f; O1[i] = 0.f; }
    const int lrow = tid >> 3, lc = (tid & 7) * 8;
    const bf16_t* gK = Kb + ((size_t)b * Ltot + lrow) * 256 + kvh * 64 + lc;
    const bf16_t* gV = Vt + ((size_t)(b * 4 + kvh) * 64 + lrow) * Ltot + lc;
    u32x4 rk = *(const u32x4*)gK, rv = *(const u32x4*)gV;
    *(u32x4*)(lds + lrow * 144 + lc * 2) = rk; *(u32x4*)(lds + 9216 + lrow * 144 + lc * 2) = rv;
    __syncthreads();
    for (int kt = 0; kt < nkt; ++kt) {
      const unsigned char* cur = lds + (kt & 1) * 18432; unsigned char* nxt = lds + ((kt + 1) & 1) * 18432;
      if (kt + 1 < nkt) { rk = *(const u32x4*)(gK + (size_t)(kt + 1) * 64 * 256); rv = *(const u32x4*)(gV + (kt + 1) * 64); }
      f32x16 s0, s1;
#pragma unroll
      for (int i = 0; i < 16; ++i) { s0[i] = 0.f; s1[i] = 0.f; }
#pragma unroll
      for (int ds = 0; ds < 4; ++ds) {
        const bf16x8 a0 = *(const bf16x8*)(cur + r * 144 + (ds * 16 + h * 8) * 2);
        const bf16x8 a1 = *(const bf16x8*)(cur + (32 + r) * 144 + (ds * 16 + h * 8) * 2);
        s0 = MFMA32(a0, qf[ds], s0); s1 = MFMA32(a1, qf[ds], s1);
      }
      float tmax = s0[0];
#pragma unroll
      for (int i = 1; i < 16; ++i) tmax = fmaxf(tmax, s0[i]);
#pragma unroll
      for (int i = 0; i < 16; ++i) tmax = fmaxf(tmax, s1[i]);
      tmax = xhalf_max(tmax);
      const float tm = tmax * SC;
      if (__builtin_amdgcn_ballot_w64(tm - m > 8.f) != 0ull) {
        const float mnew = fmaxf(m, tm);
        const float alpha = __builtin_amdgcn_exp2f(m - mnew);
        lsum *= alpha; m = mnew;
#pragma unroll
        for (int i = 0; i < 16; ++i) { O0[i] *= alpha; O1[i] *= alpha; }
      }
      float ps = 0.f;
#pragma unroll
      for (int i = 0; i < 16; ++i) { s0[i] = __builtin_amdgcn_exp2f(s0[i] * SC - m); s1[i] = __builtin_amdgcn_exp2f(s1[i] * SC - m); ps += s0[i] + s1[i]; }
      lsum += ps;
      const unsigned char* vs = cur + 9216;
#pragma unroll
      for (int kb = 0; kb < 2; ++kb)
#pragma unroll
        for (int s = 0; s < 2; ++s) {
          u32x4 pk;
#pragma unroll
          for (int j = 0; j < 4; ++j) pk[j] = kb ? pack2(s1[8 * s + 2 * j], s1[8 * s + 2 * j + 1]) : pack2(s0[8 * s + 2 * j], s0[8 * s + 2 * j + 1]);
          const bf16x8 pf = __builtin_bit_cast(bf16x8, pk);
          const int ko = (32 * kb + 16 * s + 4 * h) * 2;
          { const u32x2 lo = *(const u32x2*)(vs + r * 144 + ko), hi = *(const u32x2*)(vs + r * 144 + ko + 16);
            u32x4 av; av[0] = lo[0]; av[1] = lo[1]; av[2] = hi[0]; av[3] = hi[1];
            O0 = MFMA32(__builtin_bit_cast(bf16x8, av), pf, O0); }
          { const u32x2 lo = *(const u32x2*)(vs + (32 + r) * 144 + ko), hi = *(const u32x2*)(vs + (32 + r) * 144 + ko + 16);
            u32x4 av; av[0] = lo[0]; av[1] = lo[1]; av[2] = hi[0]; av[3] = hi[1];
            O1 = MFMA32(__builtin_bit_cast(bf16x8, av), pf, O1); }
        }
      if (kt + 1 < nkt) { *(u32x4*)(nxt + lrow * 144 + lc * 2) = rk; *(u32x4*)(nxt + 9216 + lrow * 144 + lc * 2) = rv; }
      __syncthreads();
    }
    lsum = xhalf_sum(lsum);
    const float inv = 1.f / lsum;
#pragma unroll
    for (int db = 0; db < 2; ++db)
#pragma unroll
      for (int i4 = 0; i4 < 4; ++i4) {
        const size_t o = tok * 1024 + head * 64 + 32 * db + 8 * i4 + 4 * h;
        const u32x2 gq = *(const u32x2*)(G + o);
        const float v0 = (db ? O1[4 * i4] : O0[4 * i4]) * inv, v1 = (db ? O1[4 * i4 + 1] : O0[4 * i4 + 1]) * inv;
        const float v2 = (db ? O1[4 * i4 + 2] : O0[4 * i4 + 2]) * inv, v3 = (db ? O1[4 * i4 + 3] : O0[4 * i4 + 3]) * inv;
        u32x2 w; w[0] = pack2(v0 * silu(bflo(gq[0])), v1 * silu(bfhi(gq[0]))); w[1] = pack2(v2 * silu(bflo(gq[1])), v3 * silu(bfhi(gq[1])));
        *(u32x2*)(slots + 5 * SLOT_ELEMS + o) = w;
      }
  }
}


namespace pg8 {
#define PG8_LAS __attribute__((address_space(3)))
typedef unsigned short bf16_t;
typedef short bf16x8 __attribute__((ext_vector_type(8)));
typedef float f32x4 __attribute__((ext_vector_type(4)));
typedef unsigned u32x4 __attribute__((ext_vector_type(4)));
constexpr int BM = 256, BK = 64, HALF = 128, HTB = HALF * BK * 2  , STAGE_BYTES = 8 * HTB, NXCD = 8, WGM = 8;

__host__ __device__ __forceinline__ int lds_byte(int r, int c) { const int st = (r >> 4) * 2 + (c >> 5), rr = r & 15, cc = c & 31, ob = rr * 64 + cc * 2; return st * 1024 + (ob ^ (((ob >> 9) & 1) << 5)); }
__host__ __device__ __forceinline__ void stage_rc(int b, int& R, int& C) { const int st = b / 1024, sb = b % 1024, swz = sb ^ (((sb >> 9) & 1) << 5); R = (st >> 1) * 16 + swz / 64; C = (st & 1) * 32 + (swz % 64) / 2; }
__host__ __device__ __forceinline__ int perm32(int rho) { const int n = rho >> 4, i = rho & 15; return 8 * (i >> 2) + 4 * n + (i & 3); }

struct Unit { int pm, pn; };
struct Gemm { const bf16_t* A; const bf16_t* Bt; int M, N, K; };

struct StaticOrder {
    int nM, nN, nwg, G, c;
    __host__ __device__ void init(int M, int N, int G_, int c_) { nM = M / BM; nN = N / BM; nwg = nM * nN; G = G_; c = c_; }
    __host__ __device__ bool next(int i, Unit& u) const {
        const long L = (long)i * G + c; if (L >= nwg) return false;
        int wgid = (int)L; { const int q = nwg / NXCD, r = nwg % NXCD, xcd = wgid % NXCD, off = wgid / NXCD; wgid = (xcd < r ? xcd * (q + 1) : r * (q + 1) + (xcd - r) * q) + off; }
        const int nig = WGM * nN, gid = wgid / nig, fm = gid * WGM, gsz = (nM - fm) < WGM ? (nM - fm) : WGM;
        u.pm = fm + ((wgid % nig) % gsz); u.pn = (wgid % nig) / gsz; return true;
    }
    __device__ __forceinline__ void a_ready(const Unit&) const {}
    __device__ __forceinline__ void done(const Unit&) const {}
};
struct CountedOrder : StaticOrder {
    const unsigned* ready; unsigned need; unsigned* tmo;
    __device__ __forceinline__ void a_ready(const Unit& u) const {
        if (threadIdx.x < 64) {
            const unsigned long long t0 = __builtin_amdgcn_s_memrealtime(); unsigned polls = 0;
            while ((unsigned)__builtin_amdgcn_readfirstlane(__hip_atomic_load(ready + 64 * u.pm, __ATOMIC_RELAXED, __HIP_MEMORY_SCOPE_AGENT)) < need) {
                if ((++polls & 255u) == 0u && __builtin_amdgcn_readfirstlane(__hip_atomic_load(tmo, __ATOMIC_RELAXED, __HIP_MEMORY_SCOPE_AGENT)) != 0u) break;
                if (__builtin_amdgcn_s_memrealtime() - t0 > 2000000ull) {
                    if (threadIdx.x == 0) { unsigned expect = 0u; __hip_atomic_compare_exchange_strong(tmo + 1, &expect, 0x600u | (unsigned)(u.pm & 0xff), __ATOMIC_RELAXED, __ATOMIC_RELAXED, __HIP_MEMORY_SCOPE_AGENT); __hip_atomic_store(tmo, 1u, __ATOMIC_RELAXED, __HIP_MEMORY_SCOPE_AGENT); }
                    break; }
                __builtin_amdgcn_s_sleep(2); }
            __builtin_amdgcn_fence(__ATOMIC_ACQUIRE, "agent");
            asm volatile("s_waitcnt vmcnt(0)" ::: "memory");
        }
#if !defined(BROKEN_HOOK_NO_BARRIER)
        asm volatile("" ::: "memory"); __builtin_amdgcn_s_barrier(); asm volatile("" ::: "memory");
#endif
    }
};

__device__ __forceinline__ unsigned cvt_pk_bf16(float lo, float hi) { unsigned r; asm volatile("v_cvt_pk_bf16_f32 %0, %1, %2" : "=v"(r) : "v"(lo), "v"(hi)); return r; }
typedef float f32x2 __attribute__((ext_vector_type(2)));
__device__ __forceinline__ f32x2 gelu_pk(f32x2 v) {
    const f32x2 av = __builtin_elementwise_abs(v), d = av * 0.2316418882f + 1.0f;
    f32x2 t; t.x = __builtin_amdgcn_rcpf(d.x); t.y = __builtin_amdgcn_rcpf(d.y);
    f32x2 q = t * 0.5307027145f + (-0.7265760135f); q = q * t + 0.7107068705f; q = q * t + (-0.142248368f); q = q * t + 0.127414796f; q = q * t;
    const f32x2 s = (v * v) * (-0.72134752044f);
    f32x2 e; e.x = __builtin_amdgcn_exp2f(s.x); e.y = __builtin_amdgcn_exp2f(s.y);
    const f32x2 m = v * (q * e), r = v - m;
    f32x2 o; o.x = v.x < 0.f ? m.x : r.x; o.y = v.y < 0.f ? m.y : r.y; return o;
}

struct EpiF32 {
    static constexpr bool PERM = false, AFTER_DRAIN = false;
    float* C; int ldc; const float* bias;
    __device__ __forceinline__ void operator()(const f32x4 (&acc)[2][2][4][2], const Unit& u, int wr, int wc, int fr, int fq) const {
        const int row0 = u.pm * BM + wr * 64 + fr, col0 = u.pn * BM + wc * 32 + 4 * fq;
        f32x4 bv[2][2];
#pragma unroll
        for (int bj = 0; bj < 2; ++bj)
#pragma unroll
            for (int n = 0; n < 2; ++n) bv[bj][n] = bias ? *(const f32x4*)(bias + col0 + bj * HALF + n * 16) : (f32x4){0.f, 0.f, 0.f, 0.f};
#pragma unroll
        for (int ai = 0; ai < 2; ++ai)
#pragma unroll
            for (int m = 0; m < 4; ++m) { float* rowp = C + (size_t)(row0 + ai * HALF + m * 16) * ldc + col0;
#pragma unroll
                for (int bj = 0; bj < 2; ++bj)
#pragma unroll
                    for (int n = 0; n < 2; ++n) *(f32x4*)(rowp + bj * HALF + n * 16) = acc[ai][bj][m][n] + bv[bj][n]; }
    }
};
template <int ACT  > struct EpiBf16 {
    static constexpr bool PERM = true, AFTER_DRAIN = false;
    bf16_t* O; int ldc; const float* bias; int split_cols; size_t split_stride;
    __device__ __forceinline__ void operator()(const f32x4 (&acc)[2][2][4][2], const Unit& u, int wr, int wc, int fr, int fq) const {
        const int row0 = u.pm * BM + wr * 64 + fr; int colt = u.pn * BM; bf16_t* base = O;
        if (split_cols) { const int t = colt / split_cols; base += (size_t)t * split_stride; colt -= t * split_cols; }
        const int col0 = colt + wc * 32 + 8 * fq, bcol0 = u.pn * BM + wc * 32 + 8 * fq;
        f32x4 bv[2][2];
#pragma unroll
        for (int bj = 0; bj < 2; ++bj)
#pragma unroll
            for (int n = 0; n < 2; ++n) bv[bj][n] = bias ? *(const f32x4*)(bias + bcol0 + bj * HALF + 4 * n) : (f32x4){0.f, 0.f, 0.f, 0.f};
#pragma unroll
        for (int ai = 0; ai < 2; ++ai)
#pragma unroll
            for (int m = 0; m < 4; ++m) { bf16_t* rowp = base + (size_t)(row0 + ai * HALF + m * 16) * ldc + col0;
#pragma unroll
                for (int bj = 0; bj < 2; ++bj) { f32x4 v0 = acc[ai][bj][m][0] + bv[bj][0], v1 = acc[ai][bj][m][1] + bv[bj][1];
                    if (ACT == 1) { f32x2 a = gelu_pk((f32x2){v0[0], v0[1]}), b = gelu_pk((f32x2){v0[2], v0[3]}), c = gelu_pk((f32x2){v1[0], v1[1]}), d = gelu_pk((f32x2){v1[2], v1[3]});
                        v0 = (f32x4){a.x, a.y, b.x, b.y}; v1 = (f32x4){c.x, c.y, d.x, d.y}; }
                    if (ACT == 2) {
#pragma unroll
                        for (int j = 0; j < 4; ++j) { v0[j] = 0.5f * v0[j] * (1.0f + erff(v0[j] * 0.70710678f)); v1[j] = 0.5f * v1[j] * (1.0f + erff(v1[j] * 0.70710678f)); } }
                    u32x4 w; w.x = cvt_pk_bf16(v0[0], v0[1]); w.y = cvt_pk_bf16(v0[2], v0[3]); w.z = cvt_pk_bf16(v1[0], v1[1]); w.w = cvt_pk_bf16(v1[2], v1[3]);
                    *(u32x4*)(rowp + bj * HALF) = w; } }
    }
};

struct PanelStats {
    unsigned* xbuf;
    unsigned* cnt;
    unsigned* tmo;
    int ntn; float eps;
    unsigned code;
    __device__ __forceinline__ bool run(const f32x4 (&v)[2][2][4][2], const Unit& u, int wr, int wc, int fr, int fq, PG8_LAS unsigned char* lds, int wid, int lane) const {
        typedef float f32x2v __attribute__((ext_vector_type(2)));
        PG8_LAS f32x2v* P = (PG8_LAS f32x2v*)lds;
        PG8_LAS f32x2v* S = (PG8_LAS f32x2v*)(lds + 8192);
        PG8_LAS unsigned* flag = (PG8_LAS unsigned*)(lds + 8192 + 2048);
#pragma unroll
        for (int ai = 0; ai < 2; ++ai)
#pragma unroll
            for (int m = 0; m < 4; ++m) {
                float s = 0.f;
#pragma unroll
                for (int bj = 0; bj < 2; ++bj)
#pragma unroll
                    for (int n = 0; n < 2; ++n) { const f32x4 x = v[ai][bj][m][n]; s += (x[0] + x[1]) + (x[2] + x[3]); }
                s += __shfl_xor(s, 16); s += __shfl_xor(s, 32);
                const float mw = s * (1.0f / 64.0f); float q = 0.f;
#pragma unroll
                for (int bj = 0; bj < 2; ++bj)
#pragma unroll
                    for (int n = 0; n < 2; ++n) { const f32x4 d = v[ai][bj][m][n] - mw; q += (d[0] * d[0] + d[1] * d[1]) + (d[2] * d[2] + d[3] * d[3]); }
                q += __shfl_xor(q, 16); q += __shfl_xor(q, 32);
                if (fq == 0) P[(ai * HALF + wr * 64 + m * 16 + fr) * 4 + wc] = (f32x2v){mw, q};
            }
        asm volatile("s_waitcnt lgkmcnt(0)" ::: "memory"); __builtin_amdgcn_s_barrier(); asm volatile("" ::: "memory");
#if defined(BROKEN_NO_WAIT)
        if (blockIdx.x >= 64) { const long long t0 = clock64(); while (clock64() - t0 < 60000) __builtin_amdgcn_s_sleep(8); }
#endif
        const int row = wid * 32 + (lane & 31);
        if (lane < 32) {
            const f32x2v a = P[row * 4 + 0], b = P[row * 4 + 1], c = P[row * 4 + 2], d = P[row * 4 + 3];
            const float mt = (a.x + b.x + c.x + d.x) * 0.25f;
            const float da = a.x - mt, db = b.x - mt, dc = c.x - mt, dd = d.x - mt;
            const float m2 = (a.y + b.y) + (c.y + d.y) + 64.0f * ((da * da + db * db) + (dc * dc + dd * dd));
            unsigned long long* slot = (unsigned long long*)xbuf + ((size_t)(u.pm * BM + row) * 4 + u.pn);
            __hip_atomic_store(slot, ((unsigned long long)__float_as_uint(m2) << 32) | __float_as_uint(mt), __ATOMIC_RELAXED, __HIP_MEMORY_SCOPE_AGENT);
        }
        asm volatile("s_waitcnt vmcnt(0)" ::: "memory");
        if (lane == 0) __hip_atomic_fetch_add(cnt + 64 * u.pm, 1u, __ATOMIC_RELAXED, __HIP_MEMORY_SCOPE_AGENT);
        if (wid == 0) {
            bool dead = false; const unsigned long long t0 = __builtin_amdgcn_s_memrealtime(); const unsigned want = 8u * (unsigned)ntn;
            for (;;) {
#if defined(BROKEN_NO_WAIT)
                break;
#endif
                if ((unsigned)__builtin_amdgcn_readfirstlane(__hip_atomic_load(cnt + 64 * u.pm, __ATOMIC_RELAXED, __HIP_MEMORY_SCOPE_AGENT)) >= want) break;
                if (__builtin_amdgcn_s_memrealtime() - t0 > 2000000ull) {
                    if (lane == 0) { unsigned expect = 0u; __hip_atomic_compare_exchange_strong(tmo + 1, &expect, code | (unsigned)(u.pm & 0xff), __ATOMIC_RELAXED, __ATOMIC_RELAXED, __HIP_MEMORY_SCOPE_AGENT);
                                     __hip_atomic_store(tmo, 1u, __ATOMIC_RELAXED, __HIP_MEMORY_SCOPE_AGENT); }
                    dead = true; break; }
                __builtin_amdgcn_s_sleep(2);
            }
            __builtin_amdgcn_fence(__ATOMIC_ACQUIRE, "agent");
            if (lane == 0) flag[0] = dead ? 1u : 0u;
        }
        asm volatile("s_waitcnt vmcnt(0) lgkmcnt(0)" ::: "memory"); __builtin_amdgcn_s_barrier(); asm volatile("" ::: "memory");
        const bool bad = flag[0] != 0u;
        if (lane < 32) {
            const unsigned long long* slot = (const unsigned long long*)xbuf + (size_t)(u.pm * BM + row) * 4; float mt[4], m2[4]; float ms = 0.f;
#pragma unroll
            for (int t = 0; t < 4; ++t) { if (t < ntn) { const unsigned long long w = __hip_atomic_load(slot + t, __ATOMIC_RELAXED, __HIP_MEMORY_SCOPE_AGENT); mt[t] = __uint_as_float((unsigned)w); m2[t] = __uint_as_float((unsigned)(w >> 32)); } else { mt[t] = 0.f; m2[t] = 0.f; } ms += mt[t]; }
            const float mean = ms / (float)ntn; float q = 0.f;
#pragma unroll
            for (int t = 0; t < 4; ++t) if (t < ntn) { const float dm = mt[t] - mean; q += m2[t] + 256.0f * dm * dm; }
            S[row] = (f32x2v){mean, 1.0f / sqrtf(q / (256.0f * (float)ntn) + eps)};
        }
        asm volatile("s_waitcnt lgkmcnt(0)" ::: "memory"); __builtin_amdgcn_s_barrier(); asm volatile("" ::: "memory");
        return bad;
    }
};
struct EpiLnRes {
    static constexpr bool PERM = false, AFTER_DRAIN = true;
    const float* base; float* out; int ldc; const float* bias; PanelStats st; unsigned poison;
    __device__ __forceinline__ void refuse(size_t i0, size_t stride, int M, int N) const { const float q = __builtin_nanf(""); for (size_t i = i0; i < (size_t)M * N; i += stride) out[(i / N) * ldc + i % N] = q;
        if (i0 == 0) { unsigned expect = 0u; __hip_atomic_compare_exchange_strong(st.tmo + 1, &expect, 0x7f0u, __ATOMIC_RELAXED, __ATOMIC_RELAXED, __HIP_MEMORY_SCOPE_AGENT); __hip_atomic_store(st.tmo, 1u, __ATOMIC_RELAXED, __HIP_MEMORY_SCOPE_AGENT); } }
    __device__ __forceinline__ void fused(f32x4 (&acc)[2][2][4][2], const Unit& u, int wr, int wc, int fr, int fq, PG8_LAS unsigned char* lds, int wid, int lane) const {
        typedef float f32x2v __attribute__((ext_vector_type(2)));
        const PG8_LAS f32x2v* S = (const PG8_LAS f32x2v*)(lds + 8192);
        const int col0 = u.pn * BM + wc * 32 + 4 * fq;
#pragma unroll
        for (int bj = 0; bj < 2; ++bj)
#pragma unroll
            for (int n = 0; n < 2; ++n) { const f32x4 bv = bias ? *(const f32x4*)(bias + col0 + bj * HALF + n * 16) : (f32x4){0.f, 0.f, 0.f, 0.f};
#pragma unroll
                for (int ai = 0; ai < 2; ++ai)
#pragma unroll
                    for (int m = 0; m < 4; ++m) acc[ai][bj][m][n] += bv; }
        const bool bad = st.run(acc, u, wr, wc, fr, fq, lds, wid, lane) || poison != 0u;
        const float qnan = __builtin_nanf("");
#pragma unroll
        for (int ai = 0; ai < 2; ++ai)
#pragma unroll
            for (int m = 0; m < 4; ++m) { const int r = ai * HALF + wr * 64 + m * 16 + fr; const f32x2v sr = S[r]; const size_t off = (size_t)(u.pm * BM + r) * ldc + col0;
#pragma unroll
                for (int bj = 0; bj < 2; ++bj)
#pragma unroll
                    for (int n = 0; n < 2; ++n) { const f32x4 bs = *(const f32x4*)(base + off + bj * HALF + n * 16); f32x4 o = bs + (acc[ai][bj][m][n] - sr.x) * sr.y;
                        if (bad) o = (f32x4){qnan, qnan, qnan, qnan}; *(f32x4*)(out + off + bj * HALF + n * 16) = o; }
                asm volatile("" ::: "memory"); }
    }
};
struct EpiLnResLn {
    static constexpr bool PERM = false, AFTER_DRAIN = true;
    const float* base; float* out; bf16_t* xn; int ldc; const float* bias; PanelStats st1, st2; unsigned poison;
    __device__ __forceinline__ void refuse(size_t i0, size_t stride, int M, int N) const { const float q = __builtin_nanf(""); for (size_t i = i0; i < (size_t)M * N; i += stride) { const size_t o = (i / N) * ldc + i % N; out[o] = q; xn[o] = (bf16_t)0x7fc0u; }
        if (i0 == 0) { unsigned expect = 0u; __hip_atomic_compare_exchange_strong(st1.tmo + 1, &expect, 0x7f0u, __ATOMIC_RELAXED, __ATOMIC_RELAXED, __HIP_MEMORY_SCOPE_AGENT); __hip_atomic_store(st1.tmo, 1u, __ATOMIC_RELAXED, __HIP_MEMORY_SCOPE_AGENT); } }
    __device__ __forceinline__ void fused(f32x4 (&acc)[2][2][4][2], const Unit& u, int wr, int wc, int fr, int fq, PG8_LAS unsigned char* lds, int wid, int lane) const {
        typedef float f32x2v __attribute__((ext_vector_type(2))); typedef unsigned u32x2v __attribute__((ext_vector_type(2)));
        const PG8_LAS f32x2v* S = (const PG8_LAS f32x2v*)(lds + 8192);
        const int col0 = u.pn * BM + wc * 32 + 4 * fq;
#pragma unroll
        for (int bj = 0; bj < 2; ++bj)
#pragma unroll
            for (int n = 0; n < 2; ++n) { const f32x4 bv = bias ? *(const f32x4*)(bias + col0 + bj * HALF + n * 16) : (f32x4){0.f, 0.f, 0.f, 0.f};
#pragma unroll
                for (int ai = 0; ai < 2; ++ai)
#pragma unroll
                    for (int m = 0; m < 4; ++m) acc[ai][bj][m][n] += bv; }
        bool bad = st1.run(acc, u, wr, wc, fr, fq, lds, wid, lane) || poison != 0u;
        const float qnan = __builtin_nanf("");
#pragma unroll
        for (int ai = 0; ai < 2; ++ai)
#pragma unroll
            for (int m = 0; m < 4; ++m) { const int r = ai * HALF + wr * 64 + m * 16 + fr; const f32x2v sr = S[r]; const size_t off = (size_t)(u.pm * BM + r) * ldc + col0;
#pragma unroll
                for (int bj = 0; bj < 2; ++bj)
#pragma unroll
                    for (int n = 0; n < 2; ++n) { const f32x4 bs = *(const f32x4*)(base + off + bj * HALF + n * 16); acc[ai][bj][m][n] = bs + (acc[ai][bj][m][n] - sr.x) * sr.y; }
                asm volatile("" : "+v"(acc[ai][0][m][0]), "+v"(acc[ai][0][m][1]), "+v"(acc[ai][1][m][0]), "+v"(acc[ai][1][m][1]));
                if (m & 1) asm volatile("" ::: "memory"); }
        const bool bad1 = bad;
        bad = st2.run(acc, u, wr, wc, fr, fq, lds, wid, lane) || bad;
#pragma unroll
        for (int ai = 0; ai < 2; ++ai)
#pragma unroll
            for (int m = 0; m < 4; ++m) { const int r = ai * HALF + wr * 64 + m * 16 + fr; const f32x2v sr = S[r]; const size_t off = (size_t)(u.pm * BM + r) * ldc + col0;
#pragma unroll
                for (int bj = 0; bj < 2; ++bj)
#pragma unroll
                    for (int n = 0; n < 2; ++n) { const f32x4 x1 = acc[ai][bj][m][n]; *(f32x4*)(out + off + bj * HALF + n * 16) = bad1 ? (f32x4){qnan, qnan, qnan, qnan} : x1;
                        const f32x4 o = (x1 - sr.x) * sr.y; u32x2v w; w.x = cvt_pk_bf16(o[0], o[1]); w.y = cvt_pk_bf16(o[2], o[3]);
                        if (bad) { w.x = 0x7fc07fc0u; w.y = 0x7fc07fc0u; } *(u32x2v*)(xn + off + bj * HALF + n * 16) = w; }
                asm volatile("" ::: "memory"); }
    }
};

template <class Epi, class Sched, bool STAMP = false>
__device__ __forceinline__ void gemm_phase(PG8_LAS unsigned char* lds, const Gemm g, const Sched& S, const Epi& E, unsigned long long* stamps) {
    const int tid = threadIdx.x, wid = __builtin_amdgcn_readfirstlane(tid >> 6), lane = tid & 63, wr = wid >> 2, wc = wid & 3, fr = lane & 15, fq = lane >> 4;
    const int K = g.K, nt = K / BK;
    int ts_lo = 0, ts_hi = 0, nts = 0; const unsigned long long rt_entry = STAMP ? (unsigned long long)wall_clock64() : 0ull;
#define PG8_STAMP() do { if (STAMP && wid == 0 && nts < 64) { const unsigned long long _c = (unsigned long long)clock64(); \
        ts_lo = (lane == nts) ? (int)(unsigned)_c : ts_lo; ts_hi = (lane == nts) ? (int)(unsigned)(_c >> 32) : ts_hi; ++nts; } } while (0)
    PG8_STAMP();
    unsigned voffA[2], voffB[2];
#pragma unroll
    for (int i = 0; i < 2; ++i) { int R, C; stage_rc(tid * 16 + i * 8192, R, C); const int Rb = Epi::PERM ? ((R & ~31) + perm32(R & 31)) : R;
        voffA[i] = (unsigned)(R * K + C) * 2u; voffB[i] = (unsigned)(Rb * K + C) * 2u; }
    const size_t kstep = (size_t)(BK * 2);
    const size_t hstep = (size_t)HALF * K * 2;
    const size_t tstep = 2 * hstep;
    const unsigned ldsw = (unsigned)wid * 1024u;
    const int aoff = lds_byte(wr * 64 + fr, fq * 8), boff = lds_byte(wc * 32 + fr, fq * 8);
#define PG8_SA(b, h) (((b) * 2 + (h)) * HTB)
#define PG8_SB(b, h) ((4 + (b) * 2 + (h)) * HTB)
#define PG8_STAGE(bufoff, gbase, voff) do { _Pragma("unroll") for (int _i = 0; _i < 2; ++_i) \
        __builtin_amdgcn_global_load_lds((const unsigned*)((const char*)(gbase) + (voff)[_i]), (PG8_LAS unsigned*)(lds + (bufoff) + ldsw + _i * 8192), 16, 0, 0); } while (0)
#define PG8_LDA(dst, b, h) do { _Pragma("unroll") for (int m = 0; m < 4; ++m) _Pragma("unroll") for (int k = 0; k < 2; ++k) dst[m][k] = *(const PG8_LAS bf16x8*)(lds + PG8_SA(b, h) + aoff + m * 2048 + k * 1024); } while (0)
#define PG8_LDB(dst, b, h) do { _Pragma("unroll") for (int n = 0; n < 2; ++n) _Pragma("unroll") for (int k = 0; k < 2; ++k) dst[n][k] = *(const PG8_LAS bf16x8*)(lds + PG8_SB(b, h) + boff + n * 2048 + k * 1024); } while (0)
#define PG8_MMA(ai, bj, At, Bt) do { __builtin_amdgcn_s_setprio(1); _Pragma("unroll") for (int m = 0; m < 4; ++m) _Pragma("unroll") for (int n = 0; n < 2; ++n) _Pragma("unroll") for (int k = 0; k < 2; ++k) \
        acc[ai][bj][m][n] = __builtin_amdgcn_mfma_f32_16x16x32_bf16(Bt[n][k], At[m][k], acc[ai][bj][m][n], 0, 0, 0); __builtin_amdgcn_s_setprio(0); } while (0)
#define PG8_WAIT_V(n) asm volatile("s_waitcnt vmcnt(" #n ")" ::: "memory")
#define PG8_WAIT_L(n) asm volatile("s_waitcnt lgkmcnt(" #n ")" ::: "memory")
#define PG8_BAR __builtin_amdgcn_s_barrier()
#define PG8_SCHED __builtin_amdgcn_sched_barrier(0)
    Unit cur, nxt; int ui = 0;
    if (!S.next(0, cur)) return;
    f32x4 acc[2][2][4][2];
#pragma unroll
    for (int a = 0; a < 2; ++a)
#pragma unroll
        for (int b = 0; b < 2; ++b)
#pragma unroll
            for (int m = 0; m < 4; ++m)
#pragma unroll
                for (int n = 0; n < 2; ++n) acc[a][b][m][n] = (f32x4){0.f, 0.f, 0.f, 0.f};
    bf16x8 At[4][2], B0[2][2], B1[2][2];
    const char* cA = (const char*)g.A + (size_t)cur.pm * tstep; const char* cB = (const char*)g.Bt + (size_t)cur.pn * tstep;
    S.a_ready(cur);
    PG8_STAGE(PG8_SB(0, 0), cB, voffB); PG8_STAGE(PG8_SA(0, 0), cA, voffA); PG8_STAGE(PG8_SB(0, 1), cB + hstep, voffB); PG8_STAGE(PG8_SA(0, 1), cA + hstep, voffA);
    if (wr == 1) PG8_BAR;
    PG8_WAIT_V(4); PG8_BAR;
    PG8_STAGE(PG8_SB(1, 0), cB + kstep, voffB); PG8_STAGE(PG8_SA(1, 0), cA + kstep, voffA); PG8_STAGE(PG8_SB(1, 1), cB + hstep + kstep, voffB);
    PG8_WAIT_V(6); PG8_BAR;
    PG8_STAMP();
    for (;;) {
        const bool has_next = S.next(ui + 1, nxt);
        const char* nA = has_next ? (const char*)g.A + (size_t)nxt.pm * tstep : cA; const char* nB = has_next ? (const char*)g.Bt + (size_t)nxt.pn * tstep : cB;
        for (int t = 0; t < nt; t += 2) {
            const bool last = (t == nt - 2);
            const char* a1 = cA + (size_t)(t + 1) * kstep;
            const char* a2 = last ? nA : cA + (size_t)(t + 2) * kstep; const char* b2 = last ? nB : cB + (size_t)(t + 2) * kstep;
            const char* a3 = a2 + kstep; const char* b3 = b2 + kstep;
            if (last && has_next) S.a_ready(nxt);
            PG8_LDB(B0, 0, 0); PG8_SCHED; PG8_LDA(At, 0, 0); PG8_STAGE(PG8_SA(1, 1), a1 + hstep, voffA);
            PG8_WAIT_L(8); PG8_BAR; PG8_WAIT_L(0); PG8_MMA(0, 0, At, B0); PG8_BAR; PG8_SCHED;
            PG8_LDB(B1, 0, 1); PG8_STAGE(PG8_SB(0, 0), b2, voffB);
            PG8_BAR; PG8_WAIT_L(0); PG8_MMA(0, 1, At, B1); PG8_BAR;
            PG8_LDA(At, 0, 1); PG8_STAGE(PG8_SA(0, 0), a2, voffA);
            PG8_BAR; PG8_WAIT_L(0); PG8_MMA(1, 0, At, B0); PG8_BAR; PG8_SCHED;
            PG8_STAGE(PG8_SB(0, 1), b2 + hstep, voffB);
            PG8_WAIT_V(6); PG8_BAR; PG8_MMA(1, 1, At, B1); PG8_BAR;
            PG8_LDB(B0, 1, 0); PG8_SCHED; PG8_LDA(At, 1, 0); PG8_STAGE(PG8_SA(0, 1), a2 + hstep, voffA);
            PG8_WAIT_L(8); PG8_BAR; PG8_WAIT_L(0); PG8_MMA(0, 0, At, B0); PG8_BAR; PG8_SCHED;
            PG8_LDB(B1, 1, 1); PG8_STAGE(PG8_SB(1, 0), b3, voffB);
            PG8_BAR; PG8_WAIT_L(0); PG8_MMA(0, 1, At, B1); PG8_BAR;
            PG8_LDA(At, 1, 1); PG8_STAGE(PG8_SA(1, 0), a3, voffA);
            PG8_BAR; PG8_WAIT_L(0); PG8_MMA(1, 0, At, B0); PG8_BAR; PG8_SCHED;
            PG8_STAGE(PG8_SB(1, 1), b3 + hstep, voffB);
            PG8_WAIT_V(6); PG8_BAR; PG8_MMA(1, 1, At, B1); PG8_BAR;
        }
        PG8_STAMP();
        if constexpr (!Epi::AFTER_DRAIN) { E(acc, cur, wr, wc, fr, fq); S.done(cur); }
        PG8_STAMP();
        if (!has_next) break;
#pragma unroll
        for (int a = 0; a < 2; ++a)
#pragma unroll
            for (int b = 0; b < 2; ++b)
#pragma unroll
                for (int m = 0; m < 4; ++m)
#pragma unroll
                    for (int n = 0; n < 2; ++n) acc[a][b][m][n] = (f32x4){0.f, 0.f, 0.f, 0.f};
        cur = nxt; cA = nA; cB = nB; ++ui;
    }
    PG8_WAIT_V(0);
    if (wr == 0) PG8_BAR;
    PG8_BAR;
    if constexpr (Epi::AFTER_DRAIN) { E.fused(acc, cur, wr, wc, fr, fq, lds, wid, lane); S.done(cur); }
    PG8_STAMP();
    if (STAMP && wid == 0) { stamps[lane] = lane < nts ? (((unsigned long long)(unsigned)ts_hi << 32) | (unsigned)ts_lo) : 0ull;
        if (lane == 62) stamps[62] = rt_entry; if (lane == 63) stamps[63] = (unsigned long long)wall_clock64(); }
#undef PG8_STAMP
#undef PG8_SA
#undef PG8_SB
#undef PG8_STAGE
#undef PG8_LDA
#undef PG8_LDB
#undef PG8_MMA
#undef PG8_WAIT_V
#undef PG8_WAIT_L
#undef PG8_BAR
#undef PG8_SCHED
}
}

#define XB_TMO      128
#define XB_XCNT(j)  (256  + 64 * (j))
#define XB_XSUB(j)  (1280 + 64 * (j))
#define XB_XGEN(j)  (2304 + 64 * (j))
#define XB_TOP      3328
#define XB_TOPGEN   3392
#define XCD_BAR_WORDS 3456
#define XB_SPIN_CAP (1u << 22)
#define LAS __attribute__((address_space(3)))
DI unsigned xb_ld(unsigned* p) { return __hip_atomic_load(p, __ATOMIC_RELAXED, __HIP_MEMORY_SCOPE_AGENT); }
DI unsigned xb_add(unsigned* p, unsigned v) { return __hip_atomic_fetch_add(p, v, __ATOMIC_RELAXED, __HIP_MEMORY_SCOPE_AGENT); }
DI unsigned xb_xcc_id() { return (unsigned)__builtin_amdgcn_s_getreg((3 << 11) | 20) & 0xFu; }
#define XB_SPIN(cond, bar) do { unsigned _sp = 0; while (cond) { __builtin_amdgcn_s_sleep(1); \
    if ((++_sp & 255u) == 0u) { if (xb_ld(&(bar)[XB_TMO])) break; if (_sp > XB_SPIN_CAP) { atomicAdd(&(bar)[XB_TMO], 1u); break; } } } } while (0)
struct XcdBarrier { unsigned* bar; unsigned x; volatile LAS unsigned* st; };
DI XcdBarrier xcd_barrier_post(unsigned* bar, volatile LAS unsigned* st) {
  XcdBarrier b; b.bar = bar; b.x = xb_xcc_id(); b.st = st;
  if (threadIdx.x == 0) (void)xb_add(&bar[XB_XCNT(b.x)], 1u);
  return b;
}
DI void xcd_barrier_complete(unsigned* bar, unsigned x, unsigned& nloc, unsigned& nx) {
  const unsigned G = gridDim.x * gridDim.y * gridDim.z;
  unsigned sum, cnt, mine, sp = 0u;
  for (;;) {
    sum = 0u; cnt = 0u; mine = 0u;
#pragma unroll
    for (unsigned j = 0; j < 16; ++j) { const unsigned c = xb_ld(&bar[XB_XCNT(j)]); sum += c; cnt += (c > 0u) ? 1u : 0u; mine = (j == x) ? c : mine; }
    if (sum == G) break;
    __builtin_amdgcn_s_sleep(1);
    if ((++sp & 255u) == 0u) { if (xb_ld(&bar[XB_TMO])) break; if (sp > XB_SPIN_CAP) { atomicAdd(&bar[XB_TMO], 1u); break; } }
  }
  nloc = mine > 0u ? mine : 1u; nx = cnt > 0u ? cnt : 1u;
}
DI void xcd_barrier(const XcdBarrier& b) {
  asm volatile("s_waitcnt vmcnt(0)" ::: "memory");
  __syncthreads();
  if (threadIdx.x == 0) {
    unsigned* bar = b.bar;
    __builtin_amdgcn_s_waitcnt(0);
    unsigned nloc = b.st[0], nx = b.st[1];
    if (nloc == 0u) { xcd_barrier_complete(bar, b.x, nloc, nx); b.st[0] = nloc; b.st[1] = nx; }
    const unsigned old = xb_add(&bar[XB_XSUB(b.x)], 1u);
    const unsigned gen = old / nloc;
    if (old + 1u == (gen + 1u) * nloc) {
      __builtin_amdgcn_fence(__ATOMIC_RELEASE, "agent");
      asm volatile("s_waitcnt vmcnt(0)" ::: "memory");
      const unsigned og = xb_add(&bar[XB_TOP], 1u);
      const unsigned tg = og / nx;
      if (og + 1u == (tg + 1u) * nx) xb_add(&bar[XB_TOPGEN], 1u);
      else XB_SPIN(xb_ld(&bar[XB_TOPGEN]) == tg, bar);
      __builtin_amdgcn_fence(__ATOMIC_ACQUIRE, "agent");
      xb_add(&bar[XB_XGEN(b.x)], 1u);
      asm volatile("s_waitcnt vmcnt(0)" ::: "memory");
    } else {
      XB_SPIN(xb_ld(&bar[XB_XGEN(b.x)]) == gen, bar);
      __builtin_amdgcn_fence(__ATOMIC_ACQUIRE, "agent");
      asm volatile("s_waitcnt vmcnt(0)" ::: "memory");
    }
  }
  __syncthreads();
}

#define GPTR(T, x) ((T*)(__attribute__((address_space(1))) T*)(x))
__global__ void __launch_bounds__(NT) mega(P p) {
  extern __shared__ __attribute__((aligned(16))) unsigned char lds[];
  cg::grid_group grid = cg::this_grid();
  volatile LAS unsigned* st = (volatile LAS unsigned*)(lds + LDS_BYTES - 16);
  if (threadIdx.x < 4) st[threadIdx.x] = 0u;
  __syncthreads();
  const XcdBarrier xbar = xcd_barrier_post((unsigned*)(p.ws + WS_BAR), st);
  phase0(p, lds);
  grid.sync();
  const P& p0 = p;
  for (int step = 0; step < 70; ++step) {
    const int g = step / 35, rem = step - g * 35, layer = rem / 7, sub = rem - layer * 7;
    const int kind = layer % 3, jl = layer / 3;
    const int T = g ? 16384 : 8192, Lmask = g ? 4095 : 255;
    int op = -1;
    if (layer == 4) op = (sub == 0) ? 0 : -1;
    else if (sub == 0) op = 0;
    else if (kind == 0) op = sub == 1 ? 1 : (sub <= 3 ? 4 : (sub == 4 ? 2 : (sub == 5 ? 3 : 4)));
    else if (kind == 1) op = sub == 1 ? 5 : (sub == 2 ? 6 : (sub == 3 ? 4 : -1));
    else op = sub == 1 ? 4 : (sub == 2 ? 7 : (sub == 3 ? 4 : -1));
    if (op < 0) continue;
    P p = p0;
    { size_t zo_ = 0; asm volatile("" : "+s"(zo_)); p.ws = p0.ws + zo_; p.out = p0.out + zo_; }
    bf16_t* slots = (bf16_t*)(p.ws + WS_SLOT);
    const bf16_t* W = (const bf16_t*)(p.ws + WS_W);
    if (op == 0) {
      const float* xin = p.in[g]; float* xout = p.out + (g ? OUT_YS : OUT_YP);
      phase_norm(p, g, layer - 1, layer < 4 ? layer : -1, layer <= 1 ? xin : xout, xout, slots + SLOT_ELEMS, slots);
      if (kind == 1 && g == 1 && layer < 4) phase_cache_copy(p);
    } else if (op == 1) {
      phase_gemm<1, 0>(p, g, slots, W + (size_t)(RW_IN0 + jl * RW_STRIDE + 4096) * 1024, T, 256, p.in[11] + jl * 6144, Lmask, slots + SLOT_ELEMS, 1, lds, 32);
      phase_xsmix(p, g, jl);
    } else if (op == 2) {
      for (int rep = 0; rep < opq(REP_SCAN); ++rep) phase_scan(p, g, jl, lds);
    } else if (op == 3) {
      phase_rwkv_combine(p, g, jl);
    } else if (op == 4) {
      const int npair = (kind == 0 && sub <= 3) ? 2 : 1;
      for (int q = 0; q < opq(npair); ++q) {
        const bf16_t* A; const bf16_t* Bt; int N; bf16_t* dst;
        if (kind == 0 && sub <= 3) {
          const int m = (sub - 2) * 2 + q; const int ds = m == 0 ? 1 : (m == 1 ? 0 : m);
          A = slots + (size_t)(2 + m) * SLOT_ELEMS; Bt = W + (size_t)(RW_IN0 + jl * RW_STRIDE + m * 1024) * 1024; N = 1024; dst = slots + (size_t)ds * SLOT_ELEMS;
        } else if (kind == 2 && sub == 1) { A = slots; Bt = W + (size_t)CV_IN * 1024; N = 4096; dst = slots + 2 * SLOT_ELEMS; }
        else {
          N = 1024; dst = slots + SLOT_ELEMS;
          if (kind == 0) { A = slots + 3 * SLOT_ELEMS; Bt = W + (size_t)(RW_OUT0 + jl * RW_STRIDE) * 1024; }
          else if (kind == 1) { A = slots + 5 * SLOT_ELEMS; Bt = W + (size_t)AT_OUT * 1024; }
          else { A = slots; Bt = W + (size_t)CV_OUT * 1024; }
        }
        pg8::Gemm gg{A, Bt, T, N, 1024}; pg8::StaticOrder S; S.init(T, N, (int)gridDim.x, (int)((blockIdx.x + 128 * q) & 255));
        pg8::EpiBf16<0> E{dst, 1024, nullptr, N > 1024 ? 1024 : 0, SLOT_ELEMS};
        pg8::gemm_phase<pg8::EpiBf16<0>, pg8::StaticOrder, false>((PG8_LAS unsigned char*)(unsigned)(unsigned long long)lds, gg, S, E, nullptr);
      }
    } else if (op == 5) {
      for (int rep = 0; rep < opq(REP_GEMM); ++rep) phase_gemm<0, 1>(p, g, slots, W + (size_t)AT_IN * 1024, T, 2560, nullptr, 0, nullptr, 0, lds);
    } else if (op == 6) {
      for (int rep = 0; rep < opq(REP_ATTN); ++rep) phase_attn(p, g, lds);
    } else {
      phase_conv(p, g);
    }
    if (!(g == 1 && layer == 4)) for (int rep = 0; rep < opq(REP_SYNC); ++rep) xcd_barrier(xbar);
  }
}

extern "C" void kernel_launch(void* const* d_in, const int* in_sizes, int n_in, void* d_out, int out_size, void* d_ws, size_t ws_size, hipStream_t stream) {
  static int grid_blocks = 0;
  if (!grid_blocks) {
    int dev = 0, cus = 0, per_cu = 0;
    hipGetDevice(&dev);
    hipDeviceGetAttribute(&cus, hipDeviceAttributeMultiprocessorCount, dev);
    hipFuncSetAttribute((const void*)mega, hipFuncAttributeMaxDynamicSharedMemorySize, LDS_BYTES);
    hipOccupancyMaxActiveBlocksPerMultiprocessor(&per_cu, (const void*)mega, NT, LDS_BYTES);
    if (per_cu < 1) per_cu = 1;
    if (per_cu > 1) per_cu = 1;
    grid_blocks = cus * per_cu;
    if (ws_size < WS_SLOT + 6 * SLOT_ELEMS * 2) fprintf(stderr, "workspace too small: %zu\n", ws_size);
  }
  (void)hipMemsetAsync((unsigned char*)d_ws + WS_BAR, 0, XCD_BAR_WORDS * sizeof(unsigned), stream);
  P p{};
  for (int i = 0; i < 33; ++i) p.in[i] = (const float*)d_in[i];
  p.out = (float*)d_out; p.ws = (unsigned char*)d_ws;
  void* args[] = {&p};
  hipError_t e = hipLaunchCooperativeKernel((const void*)mega, dim3(grid_blocks), dim3(NT), args, LDS_BYTES, stream);
  if (e != hipSuccess) fprintf(stderr, "cooperative launch failed: %s (grid %d)\n", hipGetErrorString(e), grid_blocks);
}
```
